# Optimizing an MI355X kernel written in HIP

```python
import math
import jax, jax.numpy as jnp
from jax import lax
import numpy as np

D_MODEL = 1024
BATCH = 8
SEQ = 4096
DEPTH = 2

GRID_W = 64
CTX_LEN = 256
HEAD_DIM = 64
D_FF = 2816
N_MOD = 9
NORM_EPS = 1e-6
ROPE_THETA = 10000.0
Q_BLOCK = 128

HY_CH = 256
HY_EMB = 33
HY_ORDER = 64
HY_FAST_PCT = 0.3
HY_SLOW_PCT = 1.5
HY_TARGET = 1e-2

GQA_HEADS = 4
GQA_KV_HEADS = 2
GQA_GROUP = GQA_HEADS // GQA_KV_HEADS

MLA_HEADS = 4
MLA_NOPE = 64
MLA_ROPE = 32
MLA_QK = MLA_NOPE + MLA_ROPE
MLA_V = 64
MLA_Q_RANK = 256
MLA_KV_RANK = 128

RW_HEADS = 4
RW_N = 64
RW_C = RW_HEADS * RW_N
RW_DECAY_LORA = 64
RW_AAA_LORA = 64
RW_GATE_LORA = 128
RW_GN_EPS = 64e-5

HY_COLS = 3 * HY_CH
GQA_COLS = (GQA_HEADS + 2 * GQA_KV_HEADS) * HEAD_DIM
MLA_COLS = MLA_Q_RANK + MLA_KV_RANK + MLA_ROPE
RW_COLS = 3 * RW_C + 2 * RW_DECAY_LORA + 2 * RW_AAA_LORA + RW_GATE_LORA
D_IN = HY_COLS + GQA_COLS + MLA_COLS + RW_COLS
D_MIX = HY_CH + GQA_HEADS * HEAD_DIM + MLA_HEADS * MLA_V + RW_C
IN_SPLITS = [HY_COLS, HY_COLS + GQA_COLS, HY_COLS + GQA_COLS + MLA_COLS]
RW_SPLITS = [RW_C, 2 * RW_C, 3 * RW_C, 3 * RW_C + RW_DECAY_LORA, 3 * RW_C + 2 * RW_DECAY_LORA,
             3 * RW_C + 2 * RW_DECAY_LORA + RW_AAA_LORA, 3 * RW_C + 2 * RW_DECAY_LORA + 2 * RW_AAA_LORA]

kernel_name = 'hybrid_head_group_flow_block'


def rms_norm(x, g):
    xf = x.astype(jnp.float32)
    y = xf * lax.rsqrt(jnp.mean(xf * xf, axis=-1, keepdims=True) + NORM_EPS)
    return (y * g.astype(jnp.float32)).astype(x.dtype)


def adaln(x, g, mod, i):
    return rms_norm(x, g) * (1.0 + mod[:, 3 * i + 1][:, None]) + mod[:, 3 * i][:, None]


def res_gate(mod, i):
    return mod[:, 3 * i + 2][:, None]


def swiglu(h, w_gate, w_up, w_down):
    return (jax.nn.silu(h @ w_gate) * (h @ w_up)) @ w_down


def centred_conv3(u, w, b):
    up = jnp.pad(u, ((0, 0), (1, 1), (0, 0)))
    return up[:, :-2] * w[0] + up[:, 1:-1] * w[1] + up[:, 2:] * w[2] + b


def token_shift(u, mu):
    up = jnp.pad(u, ((0, 0), (1, 1), (0, 0)))
    return u + mu * (0.5 * (up[:, :-2] + up[:, 2:]) - u)


def rope_tables(rows, d_rot):
    row = jnp.repeat(jnp.arange(rows, dtype=jnp.float32), GRID_W)
    col = jnp.tile(jnp.arange(GRID_W, dtype=jnp.float32), rows)
    n_freq = d_rot // 4
    inv = ROPE_THETA ** (-jnp.arange(n_freq, dtype=jnp.float32) / n_freq)
    ang = jnp.concatenate([row[:, None] * inv, col[:, None] * inv], axis=-1)
    return jnp.cos(ang), jnp.sin(ang)


def apply_rope(x, cos, sin):
    shp = (1, x.shape[1]) + (1,) * (x.ndim - 3) + (cos.shape[-1],)
    cos = cos.reshape(shp)
    sin = sin.reshape(shp)
    xf = x.astype(jnp.float32).reshape(x.shape[:-1] + (-1, 2))
    x0, x1 = xf[..., 0], xf[..., 1]
    out = jnp.stack([x0 * cos - x1 * sin, x0 * sin + x1 * cos], axis=-1)
    return out.reshape(x.shape).astype(x.dtype)


def attention(q, k, v, scale):
    s = jnp.einsum('bqhgd,bkhd->bhgqk', q, k, preferred_element_type=jnp.float32) * scale
    p = jax.nn.softmax(s, axis=-1)
    return jnp.einsum('bhgqk,bkhd->bqhgd', p.astype(v.dtype), v)


def blocked_attention(q, k, v, scale):
    B, L = q.shape[:2]
    nb = L // Q_BLOCK
    qb = jnp.moveaxis(q.reshape((B, nb, Q_BLOCK) + q.shape[2:]), 1, 0)
    ob = lax.map(lambda qi: attention(qi, k, v, scale), qb)
    return jnp.moveaxis(ob, 0, 1).reshape((B, L) + ob.shape[3:])


def hyena_filters(L, w1, b1, w2, b2, w3, b3, w4, freq):
    t01 = jnp.linspace(0.0, 1.0, L, dtype=jnp.float32)[:, None]
    bands = (HY_EMB - 1) // 2
    w_ang = 2.0 * math.pi * jnp.arange(L, dtype=jnp.float32)[:, None] / L
    f = jnp.linspace(1e-4, bands - 1, bands, dtype=jnp.float32)[None]
    z = jnp.concatenate([t01, jnp.cos(f * w_ang), -jnp.sin(f * w_ang)], axis=-1)
    h = jnp.sin(freq * (z @ w1 + b1))
    h = jnp.sin(freq * (h @ w2 + b2))
    h = jnp.sin(freq * (h @ w3 + b3))
    h = (h @ w4).astype(jnp.float32)
    max_decay = math.log(HY_TARGET) / HY_FAST_PCT
    min_decay = math.log(HY_TARGET) / HY_SLOW_PCT
    deltas = jnp.tile(jnp.abs(jnp.linspace(min_decay, max_decay, HY_CH, dtype=jnp.float32)), 2)
    return h * jnp.exp(-t01 * deltas)


def fft_long_conv(u, h_fwd, h_bwd):
    L = u.shape[1]
    n = 2 * L
    hf = jnp.fft.rfft(h_fwd, n=n, axis=0)
    hb = jnp.fft.rfft(h_bwd, n=n, axis=0)
    y_f = jnp.fft.irfft(jnp.fft.rfft(u, n=n, axis=1) * hf, n=n, axis=1)[:, :L]
    y_b = jnp.fft.irfft(jnp.fft.rfft(u[:, ::-1], n=n, axis=1) * hb, n=n, axis=1)[:, :L][:, ::-1]
    return y_f + y_b


def hyena_mixer(p, conv_w, conv_b, f_w1, f_b1, f_w2, f_b2, f_w3, f_b3, f_w4, f_freq, bias):
    L = p.shape[1]
    x1, x2, v = jnp.split(centred_conv3(p, conv_w, conv_b), [HY_CH, 2 * HY_CH], axis=-1)
    h = hyena_filters(L, f_w1, f_b1, f_w2, f_b2, f_w3, f_b3, f_w4, f_freq)
    u = (x1 * v).astype(jnp.float32)
    y = fft_long_conv(u, h[:, :HY_CH], h[:, HY_CH:]) + u * bias
    return (x2 * y).astype(p.dtype)


def gqa_mixer(p_lat, p_ctx, q_norm, k_norm, cos, sin, ctx_out):
    def heads(p):
        B, L = p.shape[:2]
        q, k, v = jnp.split(p, [GQA_HEADS * HEAD_DIM, (GQA_HEADS + GQA_KV_HEADS) * HEAD_DIM], axis=-1)
        q = rms_norm(q.reshape(B, L, GQA_KV_HEADS, GQA_GROUP, HEAD_DIM), q_norm)
        k = rms_norm(k.reshape(B, L, GQA_KV_HEADS, HEAD_DIM), k_norm)
        return q, k, v.reshape(B, L, GQA_KV_HEADS, HEAD_DIM)
    B, L = p_lat.shape[:2]
    q_l, k_l, v_l = heads(p_lat)
    q_c, k_c, v_c = heads(p_ctx)
    q_l = apply_rope(q_l, cos, sin)
    k_l = apply_rope(k_l, cos, sin)
    scale = HEAD_DIM ** -0.5
    y_lat = blocked_attention(q_l, jnp.concatenate([k_c, k_l], axis=1),
                              jnp.concatenate([v_c, v_l], axis=1), scale).reshape(B, L, -1)
    y_ctx = None
    if ctx_out:
        y_ctx = attention(q_c, k_c, v_c, scale).reshape(B, p_ctx.shape[1], -1)
    return y_lat, y_ctx


def mla_mixer(p_lat, p_ctx, cq_norm, ckv_norm, w_uq, w_ukv, q_norm, k_norm, cos, sin, ctx_out):
    def heads(p):
        B, L = p.shape[:2]
        c_q, c_kv, k_rope = jnp.split(p, [MLA_Q_RANK, MLA_Q_RANK + MLA_KV_RANK], axis=-1)
        q = (rms_norm(c_q, cq_norm) @ w_uq).reshape(B, L, MLA_HEADS, 1, MLA_QK)
        kv = (rms_norm(c_kv, ckv_norm) @ w_ukv).reshape(B, L, MLA_HEADS, MLA_NOPE + MLA_V)
        k_nope, v = jnp.split(kv, [MLA_NOPE], axis=-1)
        k_rope = jnp.broadcast_to(k_rope[:, :, None, :], (B, L, MLA_HEADS, MLA_ROPE))
        k = jnp.concatenate([k_nope, k_rope], axis=-1)
        return rms_norm(q, q_norm), rms_norm(k, k_norm), v
    def rot(t):
        return jnp.concatenate([t[..., :MLA_NOPE], apply_rope(t[..., MLA_NOPE:], cos, sin)], axis=-1)
    B, L = p_lat.shape[:2]
    q_l, k_l, v_l = heads(p_lat)
    q_c, k_c, v_c = heads(p_ctx)
    q_l = rot(q_l)
    k_l = rot(k_l)
    scale = MLA_QK ** -0.5
    y_lat = blocked_attention(q_l, jnp.concatenate([k_c, k_l], axis=1),
                              jnp.concatenate([v_c, v_l], axis=1), scale).reshape(B, L, -1)
    y_ctx = None
    if ctx_out:
        y_ctx = attention(q_c, k_c, v_c, scale).reshape(B, p_ctx.shape[1], -1)
    return y_lat, y_ctx


def rwkv_prepare(p, mu, w0, w2, a0, a2, g2, k_k, k_a):
    B, L = p.shape[:2]
    r, k, v, xw_f, xw_b, xa_f, xa_b, xg = jnp.split(token_shift(p, mu), RW_SPLITS, axis=-1)
    def heads(t):
        return t.reshape(B, L, RW_HEADS, RW_N)
    kk = heads(k * k_k).astype(jnp.float32)
    kk = kk / jnp.maximum(jnp.sqrt(jnp.sum(kk * kk, axis=-1, keepdims=True)), 1e-12)
    dirs = []
    for d, (xw, xa) in enumerate(((xw_f, xa_f), (xw_b, xa_b))):
        w_log = -jax.nn.softplus(-(w0[d] + jnp.tanh(xw) @ w2[d])) - 0.5
        decay = jnp.exp(-jnp.exp(w_log.astype(jnp.float32)))
        a = jax.nn.sigmoid(a0[d] + xa @ a2[d])
        k_d = k * (1.0 + (a - 1.0) * k_a)
        dirs.append((heads(decay), heads(k_d), heads(a)))
    g = jax.nn.sigmoid(xg) @ g2
    return heads(r), heads(v), kk, dirs, g


def rwkv_scan(r, w, k, v, kk, a, s0, reverse):
    def step(S, inp):
        r_t, w_t, k_t, v_t, kk_t, a_t = inp
        sa = jnp.einsum('bhvk,bhk->bhv', S, -kk_t)
        S = S * w_t[:, :, None, :] + sa[..., None] * (kk_t * a_t)[:, :, None, :] + v_t[..., None] * k_t[:, :, None, :]
        return S, jnp.einsum('bhvk,bhk->bhv', S, r_t)
    xs = tuple(jnp.moveaxis(t.astype(jnp.float32), 1, 0) for t in (r, w, k, v, kk, a))
    s_fin, ys = lax.scan(step, s0, xs, reverse=reverse)
    return jnp.moveaxis(ys, 0, 1), s_fin


def rwkv_directions(prep, s_init):
    r, v, kk, dirs, g = prep
    ys, finals = [], []
    for d, (decay, k_d, a) in enumerate(dirs):
        y_d, s_d = rwkv_scan(r, decay, k_d, v, kk, a, s_init[d], reverse=(d == 1))
        ys.append(y_d)
        finals.append(s_d)
    return ys, finals


def rwkv_readout(prep, ys, r_k, ln_w, ln_b, dtype):
    r, v, kk, dirs, g = prep
    B, L = r.shape[:2]
    y = ys[0] + ys[1]
    mean = jnp.mean(y, axis=-1, keepdims=True)
    var = jnp.mean(jnp.square(y - mean), axis=-1, keepdims=True)
    y = ((y - mean) * lax.rsqrt(var + RW_GN_EPS)).reshape(B, L, RW_C) * ln_w + ln_b
    bonus = sum(jnp.sum(r * k_d * r_k, axis=-1, keepdims=True) * v for (_, k_d, _) in dirs)
    return ((y + bonus.reshape(B, L, RW_C)) * g).astype(dtype)


def rwkv_mixer(p_lat, p_ctx, mu, w0, w2, a0, a2, g2, k_k, k_a, r_k, ln_w, ln_b, ctx_out):
    prep_c = rwkv_prepare(p_ctx, mu, w0, w2, a0, a2, g2, k_k, k_a)
    prep_l = rwkv_prepare(p_lat, mu, w0, w2, a0, a2, g2, k_k, k_a)
    zeros = jnp.zeros((p_ctx.shape[0], RW_HEADS, RW_N, RW_N), jnp.float32)
    ys_c, s_ctx = rwkv_directions(prep_c, (zeros, zeros))
    ys_l, _ = rwkv_directions(prep_l, s_ctx)
    y_lat = rwkv_readout(prep_l, ys_l, r_k, ln_w, ln_b, p_lat.dtype)
    y_ctx = rwkv_readout(prep_c, ys_c, r_k, ln_w, ln_b, p_ctx.dtype) if ctx_out else None
    return y_lat, y_ctx


def setup_inputs(seed: int = 0) -> dict:
    key = jax.random.key(seed)
    ks = iter(jax.random.split(key, 64))
    def nrm(shape, scale):
        return jax.random.normal(next(ks), shape, jnp.float32) * scale
    def gain(shape):
        return 1.0 + nrm(shape, 0.02)
    L = DEPTH
    return {
        'x': nrm((BATCH, SEQ, D_MODEL), 1.0),
        'c': nrm((BATCH, D_MODEL), 1.0),
        'ctx': nrm((BATCH, CTX_LEN, D_MODEL), 1.0),
        'c_ctx': nrm((D_MODEL,), 1.0),
        'ada_w': nrm((L, D_MODEL, N_MOD * D_MODEL), 0.5 * D_MODEL ** -0.5),
        'ada_b': nrm((L, N_MOD * D_MODEL), 0.02),
        'norm_ffn1': gain((L, D_MODEL)),
        'norm_mix': gain((L, D_MODEL)),
        'norm_ffn2': gain((L, D_MODEL)),
        'ffn1_gate': nrm((L, D_MODEL, D_FF), D_MODEL ** -0.5),
        'ffn1_up': nrm((L, D_MODEL, D_FF), D_MODEL ** -0.5),
        'ffn1_down': nrm((L, D_FF, D_MODEL), D_FF ** -0.5),
        'ffn2_gate': nrm((L, D_MODEL, D_FF), D_MODEL ** -0.5),
        'ffn2_up': nrm((L, D_MODEL, D_FF), D_MODEL ** -0.5),
        'ffn2_down': nrm((L, D_FF, D_MODEL), D_FF ** -0.5),
        'w_in': nrm((L, D_MODEL, D_IN), D_MODEL ** -0.5),
        'w_out': nrm((L, D_MIX, D_MODEL), D_MIX ** -0.5),
        'hy_conv_w': nrm((L, 3, HY_COLS), 3 ** -0.5),
        'hy_conv_b': nrm((L, HY_COLS), 0.02),
        'hy_f_w1': nrm((L, HY_EMB, HY_ORDER), HY_EMB ** -0.5),
        'hy_f_b1': nrm((L, HY_ORDER), 0.02),
        'hy_f_w2': nrm((L, HY_ORDER, HY_ORDER), HY_ORDER ** -0.5),
        'hy_f_b2': nrm((L, HY_ORDER), 0.02),
        'hy_f_w3': nrm((L, HY_ORDER, HY_ORDER), HY_ORDER ** -0.5),
        'hy_f_b3': nrm((L, HY_ORDER), 0.02),
        'hy_f_w4': nrm((L, HY_ORDER, 2 * HY_CH), 0.02),
        'hy_f_freq': gain((L, HY_ORDER)),
        'hy_bias': nrm((L, HY_CH), 0.5),
        'gqa_q_norm': gain((L, HEAD_DIM)),
        'gqa_k_norm': gain((L, HEAD_DIM)),
        'mla_cq_norm': gain((L, MLA_Q_RANK)),
        'mla_ckv_norm': gain((L, MLA_KV_RANK)),
        'mla_w_uq': nrm((L, MLA_Q_RANK, MLA_HEADS * MLA_QK), MLA_Q_RANK ** -0.5),
        'mla_w_ukv': nrm((L, MLA_KV_RANK, MLA_HEADS * (MLA_NOPE + MLA_V)), MLA_KV_RANK ** -0.5),
        'mla_q_norm': gain((L, MLA_QK)),
        'mla_k_norm': gain((L, MLA_QK)),
        'rw_mu': jax.random.uniform(next(ks), (L, RW_COLS), jnp.float32),
        'rw_w0': jnp.broadcast_to(jnp.linspace(-6.0, -1.0, RW_C, dtype=jnp.float32), (L, 2, RW_C)) + nrm((L, 2, RW_C), 0.1),
        'rw_w2': nrm((L, 2, RW_DECAY_LORA, RW_C), 0.1 * RW_DECAY_LORA ** -0.5),
        'rw_a0': nrm((L, 2, RW_C), 0.1),
        'rw_a2': nrm((L, 2, RW_AAA_LORA, RW_C), RW_AAA_LORA ** -0.5),
        'rw_g2': nrm((L, RW_GATE_LORA, RW_C), RW_GATE_LORA ** -0.5),
        'rw_k_k': 0.85 + nrm((L, RW_C), 0.02),
        'rw_k_a': gain((L, RW_C)),
        'rw_r_k': nrm((L, RW_HEADS, RW_N), 0.1),
        'rw_ln_w': gain((L, RW_C)),
        'rw_ln_b': nrm((L, RW_C), 0.02),
    }


def reference(x, c, ctx, c_ctx, ada_w, ada_b, norm_ffn1, norm_mix, norm_ffn2,
              ffn1_gate, ffn1_up, ffn1_down, ffn2_gate, ffn2_up, ffn2_down, w_in, w_out,
              hy_conv_w, hy_conv_b, hy_f_w1, hy_f_b1, hy_f_w2, hy_f_b2, hy_f_w3, hy_f_b3, hy_f_w4,
              hy_f_freq, hy_bias, gqa_q_norm, gqa_k_norm, mla_cq_norm, mla_ckv_norm, mla_w_uq, mla_w_ukv,
              mla_q_norm, mla_k_norm, rw_mu, rw_w0, rw_w2, rw_a0, rw_a2, rw_g2, rw_k_k, rw_k_a, rw_r_k,
              rw_ln_w, rw_ln_b):
    B, L, D = x.shape
    rows = L // GRID_W
    cos_g, sin_g = rope_tables(rows, HEAD_DIM)
    cos_m, sin_m = rope_tables(rows, MLA_ROPE)
    silu_c = jax.nn.silu(c)
    silu_cc = jax.nn.silu(c_ctx)[None]
    for l in range(DEPTH):
        ctx_out = l < DEPTH - 1
        mod_x = (silu_c @ ada_w[l] + ada_b[l]).reshape(B, N_MOD, D)
        mod_c = (silu_cc @ ada_w[l] + ada_b[l]).reshape(1, N_MOD, D)

        x = x + 0.5 * res_gate(mod_x, 0) * swiglu(adaln(x, norm_ffn1[l], mod_x, 0), ffn1_gate[l], ffn1_up[l], ffn1_down[l])
        ctx = ctx + 0.5 * res_gate(mod_c, 0) * swiglu(adaln(ctx, norm_ffn1[l], mod_c, 0), ffn1_gate[l], ffn1_up[l], ffn1_down[l])

        p_x = adaln(x, norm_mix[l], mod_x, 1) @ w_in[l]
        p_c = adaln(ctx, norm_mix[l], mod_c, 1) @ w_in[l]
        hy_x, gq_x, ml_x, rw_x = jnp.split(p_x, IN_SPLITS, axis=-1)
        hy_c, gq_c, ml_c, rw_c = jnp.split(p_c, IN_SPLITS, axis=-1)
        hy_par = (hy_conv_w[l], hy_conv_b[l], hy_f_w1[l], hy_f_b1[l], hy_f_w2[l], hy_f_b2[l],
                  hy_f_w3[l], hy_f_b3[l], hy_f_w4[l], hy_f_freq[l], hy_bias[l])
        y_hy_x = hyena_mixer(hy_x, *hy_par)
        y_gq_x, y_gq_c = gqa_mixer(gq_x, gq_c, gqa_q_norm[l], gqa_k_norm[l], cos_g, sin_g, ctx_out)
        y_ml_x, y_ml_c = mla_mixer(ml_x, ml_c, mla_cq_norm[l], mla_ckv_norm[l], mla_w_uq[l], mla_w_ukv[l],
                                   mla_q_norm[l], mla_k_norm[l], cos_m, sin_m, ctx_out)
        y_rw_x, y_rw_c = rwkv_mixer(rw_x, rw_c, rw_mu[l], rw_w0[l], rw_w2[l], rw_a0[l], rw_a2[l], rw_g2[l],
                                    rw_k_k[l], rw_k_a[l], rw_r_k[l], rw_ln_w[l], rw_ln_b[l], ctx_out)
        y_x = jnp.concatenate([y_hy_x, y_gq_x, y_ml_x, y_rw_x], axis=-1) @ w_out[l]
        x = x + res_gate(mod_x, 1) * y_x
        if ctx_out:
            y_hy_c = hyena_mixer(hy_c, *hy_par)
            y_c = jnp.concatenate([y_hy_c, y_gq_c, y_ml_c, y_rw_c], axis=-1) @ w_out[l]
            ctx = ctx + res_gate(mod_c, 1) * y_c

        x = x + 0.5 * res_gate(mod_x, 2) * swiglu(adaln(x, norm_ffn2[l], mod_x, 2), ffn2_gate[l], ffn2_up[l], ffn2_down[l])
        if ctx_out:
            ctx = ctx + 0.5 * res_gate(mod_c, 2) * swiglu(adaln(ctx, norm_ffn2[l], mod_c, 2), ffn2_gate[l], ffn2_up[l], ffn2_down[l])
    return x
```

```cpp
#include <hip/hip_runtime.h>
#include <hip/hip_bf16.h>
#include <hip/hip_cooperative_groups.h>
#include <cstdio>
namespace cg = cooperative_groups;

#define DI __device__ __forceinline__
typedef unsigned short u16;
using bf16x8 = __attribute__((ext_vector_type(8))) short;
using f32x16 = __attribute__((ext_vector_type(16))) float;
typedef __bf16 bf16x2_t __attribute__((ext_vector_type(2)));
typedef float f32x2_t __attribute__((ext_vector_type(2)));
#define MFMA32(a, b, c) __builtin_amdgcn_mfma_f32_32x32x16_bf16((a), (b), (c), 0, 0, 0)

constexpr int D = 1024, NB = 8, LQ = 4096, LC = 256, LT = 4352, T = NB * LT, DFF = 2816, DIN = 2848;
constexpr int NG = 2, BG = NB / NG, TG = BG * LT;
constexpr int NTHR = 256;
constexpr float EPS = 1e-6f;

constexpr size_t al(size_t x) { return (x + 255) & ~(size_t)255; }
constexpr size_t OFF_CTX = 0;
constexpr size_t OFF_MOD = OFF_CTX + al((size_t)NB * LC * D * 4);
constexpr size_t SZ_FILT_L = (size_t)(2 * LQ - 1) * 256 * 4;
constexpr size_t SZ_FILT_C = (size_t)(2 * LC - 1) * 256 * 4;
constexpr size_t OFF_FILT = OFF_MOD + al((size_t)2 * 9 * 9216 * 4);
constexpr size_t OFF_FILTC = OFF_FILT + 2 * al(SZ_FILT_L);
constexpr size_t OFF_W = OFF_FILTC + al(SZ_FILT_C);
constexpr size_t W_GU1 = 0;
constexpr size_t W_D1 = W_GU1 + (size_t)5632 * 1024;
constexpr size_t W_GU2 = W_D1 + (size_t)1024 * 2816;
constexpr size_t W_D2 = W_GU2 + (size_t)5632 * 1024;
constexpr size_t W_IN = W_D2 + (size_t)1024 * 2816;
constexpr size_t W_OUT = W_IN + (size_t)2944 * 1024;
constexpr size_t W_UQ = W_OUT + (size_t)1024 * 1024;
constexpr size_t W_UKV = W_UQ + (size_t)384 * 256;
constexpr size_t W_W2 = W_UKV + (size_t)512 * 128;
constexpr size_t W_A2 = W_W2 + (size_t)2 * 256 * 64;
constexpr size_t W_G2 = W_A2 + (size_t)2 * 256 * 64;
constexpr size_t W_LAYER = W_G2 + (size_t)256 * 128;
constexpr size_t OFF_H = OFF_W + al(2 * W_LAYER * 2);
constexpr size_t OFF_BIG = OFF_H + al((size_t)T * D * 2);
constexpr size_t M_P = 0;
constexpr size_t M_U = M_P + al((size_t)TG * DIN * 2);
constexpr size_t M_QG = M_U + al((size_t)TG * 256 * 2);
constexpr size_t M_KG = M_QG + al((size_t)TG * 256 * 2);
constexpr size_t M_VTG = M_KG + al((size_t)TG * 128 * 2);
constexpr size_t M_CQN = M_VTG + al((size_t)TG * 128 * 2);
constexpr size_t M_CKVN = M_CQN + al((size_t)TG * 256 * 2);
constexpr size_t M_QUP = M_CKVN + al((size_t)TG * 128 * 2);
constexpr size_t M_KVUP = M_QUP + al((size_t)TG * 384 * 2);
constexpr size_t M_QM = M_KVUP + al((size_t)TG * 512 * 2);
constexpr size_t M_KM = M_QM + al((size_t)TG * 384 * 2);
constexpr size_t M_VTM = M_KM + al((size_t)TG * 384 * 2);
constexpr size_t M_RR = M_VTM + al((size_t)TG * 256 * 2);
constexpr size_t M_RK = M_RR + al((size_t)TG * 256 * 2);
constexpr size_t M_RV = M_RK + al((size_t)TG * 256 * 2);
constexpr size_t M_RKK = M_RV + al((size_t)TG * 256 * 2);
constexpr size_t M_LWF = M_RKK + al((size_t)TG * 256 * 2);
constexpr size_t M_LWB = M_LWF + al((size_t)TG * 64 * 2);
constexpr size_t M_LAF = M_LWB + al((size_t)TG * 64 * 2);
constexpr size_t M_LAB = M_LAF + al((size_t)TG * 64 * 2);
constexpr size_t M_LG = M_LAB + al((size_t)TG * 64 * 2);
constexpr size_t M_EF = M_LG + al((size_t)TG * 128 * 2);
constexpr size_t M_EB = M_EF + al((size_t)TG * 256 * 2);
constexpr size_t M_AF = M_EB + al((size_t)TG * 256 * 2);
constexpr size_t M_AB = M_AF + al((size_t)TG * 256 * 2);
constexpr size_t M_GG = M_AB + al((size_t)TG * 256 * 2);
constexpr size_t M_YF = M_GG + al((size_t)TG * 256 * 2);
constexpr size_t M_YB = M_YF + al((size_t)TG * 256 * 4);
constexpr size_t M_END = M_YB + al((size_t)TG * 256 * 4);
constexpr size_t SZ_G = (size_t)T * DFF * 2;
constexpr size_t WS_NEED = OFF_BIG + (M_END > SZ_G ? M_END : SZ_G);
static_assert(WS_NEED <= (size_t)512 * 1024 * 1024, "workspace too large");

struct Params {
  const float *x, *c, *ctx, *c_ctx, *ada_w, *ada_b, *norm_ffn1, *norm_mix, *norm_ffn2;
  const float *ffn1_gate, *ffn1_up, *ffn1_down, *ffn2_gate, *ffn2_up, *ffn2_down, *w_in, *w_out;
  const float *hy_conv_w, *hy_conv_b, *hy_f_w1, *hy_f_b1, *hy_f_w2, *hy_f_b2, *hy_f_w3, *hy_f_b3, *hy_f_w4, *hy_f_freq, *hy_bias;
  const float *gqa_q_norm, *gqa_k_norm, *mla_cq_norm, *mla_ckv_norm, *mla_w_uq, *mla_w_ukv, *mla_q_norm, *mla_k_norm;
  const float *rw_mu, *rw_w0, *rw_w2, *rw_a0, *rw_a2, *rw_g2, *rw_k_k, *rw_k_a, *rw_r_k, *rw_ln_w, *rw_ln_b;
  float* out;
  char* ws;
};

DI u16 f2bf(float x) {
  unsigned u = __float_as_uint(x);
  u += 0x7fffu + ((u >> 16) & 1u);
  return (u16)(u >> 16);
}
DI float bf2f(u16 b) { return __uint_as_float(((unsigned)b) << 16); }
DI unsigned pack2(float a, float b) {
  f32x2_t v = {a, b};
  bf16x2_t r = __builtin_convertvector(v, bf16x2_t);
  return __builtin_bit_cast(unsigned, r);
}
DI int ltid() {
  int t = threadIdx.x;
  asm volatile("" : "+v"(t));
  return t;
}
DI float wave_sum(float v) {
#pragma unroll
  for (int o = 32; o > 0; o >>= 1) v += __shfl_xor(v, o);
  return v;
}
DI float wave_max(float v) {
#pragma unroll
  for (int o = 32; o > 0; o >>= 1) v = fmaxf(v, __shfl_xor(v, o));
  return v;
}
DI float sigmoidf_(float x) { return 1.f / (1.f + expf(-x)); }
DI int crow(int i, int h) { return (i & 3) + 8 * (i >> 2) + 4 * h; }

DI float rope_apply(float val, int idx, int nfreq, int t, int lane) {
  int pi = idx >> 1;
  int row = t >> 6, col = t & 63;
  float pos = pi < nfreq ? (float)row : (float)col;
  int f = pi < nfreq ? pi : pi - nfreq;
  float inv = exp2f(-(float)f / (float)nfreq * 13.287712379549449f);
  float ang = pos * inv;
  float cs = cosf(ang), sn = sinf(ang);
  float other = __shfl_xor(val, 1);
  return (lane & 1) ? other * sn + val * cs : val * cs - other * sn;
}

DI int gu_row(int n, int half) { return (n >> 6) * 128 + ((n >> 5) & 1) * 64 + half * 32 + (n & 31); }
DI void convT(const float* __restrict__ src, int K, int N, u16* __restrict__ dst, int mode, char* smem) {
  float* tile = (float*)smem;
  const int tk = K / 64, tn = (N + 63) / 64;
  const int tid_ = ltid();
  const int j = tid_ & 63, i0 = tid_ >> 6;
  for (int t = blockIdx.x; t < tk * tn; t += gridDim.x) {
    const int k0 = (t / tn) * 64, n0 = (t % tn) * 64;
    for (int i = i0; i < 64; i += 4) {
      int n = n0 + j;
      tile[i * 65 + j] = n < N ? src[(size_t)(k0 + i) * N + n] : 0.f;
    }
    __syncthreads();
    for (int i = i0; i < 64; i += 4) {
      int n = n0 + i;
      if (n < N) {
        int row = mode == 0 ? n : gu_row(n, mode - 1);
        dst[(size_t)row * K + k0 + j] = f2bf(tile[j * 65 + i]);
      }
    }
    __syncthreads();
  }
}

DI void mod_phase(const Params& p, float* __restrict__ mod, char* smem) {
  float* sc = (float*)smem;
  float* red = sc + 9 * 1024;
  const int tid_ = ltid();
  for (int i = tid_; i < 9 * 1024; i += NTHR) {
    float v = i < 8192 ? p.c[i] : p.c_ctx[i - 8192];
    sc[i] = v / (1.f + expf(-v));
  }
  __syncthreads();
  const int lane = tid_ & 63, kp = tid_ >> 6;
  for (int it = blockIdx.x; it < 2 * 144; it += gridDim.x) {
    const int l = it / 144, nb = (it % 144) * 64;
    const float* w = p.ada_w + (size_t)l * 1024 * 9216 + nb + lane;
    float acc[9];
#pragma unroll
    for (int b = 0; b < 9; ++b) acc[b] = 0.f;
    for (int k = kp * 256; k < kp * 256 + 256; ++k) {
      float wv = w[(size_t)k * 9216];
#pragma unroll
      for (int b = 0; b < 9; ++b) acc[b] += sc[b * 1024 + k] * wv;
    }
#pragma unroll
    for (int b = 0; b < 9; ++b) red[(kp * 9 + b) * 64 + lane] = acc[b];
    __syncthreads();
    for (int o = tid_; o < 9 * 64; o += NTHR) {
      int b = o >> 6, ln = o & 63;
      float s = red[(0 * 9 + b) * 64 + ln] + red[(1 * 9 + b) * 64 + ln] + red[(2 * 9 + b) * 64 + ln] + red[(3 * 9 + b) * 64 + ln];
      mod[((size_t)l * 9 + b) * 9216 + nb + ln] = s + p.ada_b[l * 9216 + nb + ln];
    }
    __syncthreads();
  }
}

DI void hyfilt_phase(const Params& p, int l, int L, float* __restrict__ gT, char* smem) {
  float* z = (float*)smem;
  float* h1 = z + 64;
  float* h2 = h1 + 64;
  float* h3 = h2 + 64;
  const float* w1 = p.hy_f_w1 + l * 33 * 64;
  const float* b1 = p.hy_f_b1 + l * 64;
  const float* w2 = p.hy_f_w2 + l * 4096;
  const float* b2 = p.hy_f_b2 + l * 64;
  const float* w3 = p.hy_f_w3 + l * 4096;
  const float* b3 = p.hy_f_b3 + l * 64;
  const float* w4 = p.hy_f_w4 + l * 64 * 512;
  const float* fr = p.hy_f_freq + l * 64;
  const int tid = ltid();
  const float min_decay = logf(1e-2f) / 1.5f, max_decay = logf(1e-2f) / 0.3f;
  for (int t = blockIdx.x; t < L; t += gridDim.x) {
    const float t01 = (float)t / (float)(L - 1);
    if (tid < 33) {
      float zz;
      if (tid == 0) zz = t01;
      else {
        int i = (tid - 1) & 15;
        float f = 1e-4f + (float)i * ((15.f - 1e-4f) / 15.f);
        float wang = 6.283185307179586f * (float)t / (float)L;
        zz = tid <= 16 ? cosf(f * wang) : -sinf(f * wang);
      }
      z[tid] = zz;
    }
    __syncthreads();
    if (tid < 64) {
      float a = b1[tid];
#pragma unroll 1
      for (int i = 0; i < 33; ++i) a += z[i] * w1[i * 64 + tid];
      h1[tid] = sinf(fr[tid] * a);
    }
    __syncthreads();
    if (tid < 64) {
      float a = b2[tid];
#pragma unroll 1
      for (int i = 0; i < 64; ++i) a += h1[i] * w2[i * 64 + tid];
      h2[tid] = sinf(fr[tid] * a);
    }
    __syncthreads();
    if (tid < 64) {
      float a = b3[tid];
#pragma unroll 1
      for (int i = 0; i < 64; ++i) a += h2[i] * w3[i * 64 + tid];
      h3[tid] = sinf(fr[tid] * a);
    }
    __syncthreads();
    float af = 0.f, ab = 0.f;
#pragma unroll 2
    for (int i = 0; i < 64; ++i) {
      af += h3[i] * w4[i * 512 + tid];
      ab += h3[i] * w4[i * 512 + 256 + tid];
    }
    float delta = fabsf(min_decay + (max_decay - min_decay) * (float)tid / 255.f);
    float dec = expf(-t01 * delta);
    af *= dec;
    ab *= dec;
    if (t == 0) gT[(size_t)(L - 1) * 256 + tid] = af + ab;
    else {
      gT[(size_t)(L - 1 + t) * 256 + tid] = af;
      gT[(size_t)(L - 1 - t) * 256 + tid] = ab;
    }
    __syncthreads();
  }
}

DI void adaln_phase(const float* __restrict__ lat, const float* __restrict__ ctxp, const float* __restrict__ gain,
                    const float* __restrict__ modl, int idx, u16* __restrict__ h, bool skip_ctx) {
  const int tid_ = ltid();
  const int wave = tid_ >> 6, lane = tid_ & 63;
  for (int r = blockIdx.x * 4 + wave; r < T; r += gridDim.x * 4) {
    const int b = r / LT, j = r - b * LT;
    if (skip_ctx && j < LC) continue;
    const float* xr = j < LC ? ctxp + ((size_t)(b * LC + j) << 10) : lat + ((size_t)(b * LQ + j - LC) << 10);
    const int bb = j < LC ? 8 : b;
    const float* shift = modl + bb * 9216 + (3 * idx) * 1024;
    const float* scale = shift + 1024;
    float4 v[4];
    float ss = 0.f;
#pragma unroll
    for (int q = 0; q < 4; ++q) {
      v[q] = *(const float4*)(xr + q * 256 + lane * 4);
      ss += v[q].x * v[q].x + v[q].y * v[q].y + v[q].z * v[q].z + v[q].w * v[q].w;
    }
    ss = wave_sum(ss);
    const float rstd = rsqrtf(ss * (1.f / 1024.f) + EPS);
#pragma unroll
    for (int q = 0; q < 4; ++q) {
      const int c = q * 256 + lane * 4;
      float4 g = *(const float4*)(gain + c), sc = *(const float4*)(scale + c), sh = *(const float4*)(shift + c);
      float y0 = v[q].x * rstd * g.x * (1.f + sc.x) + sh.x;
      float y1 = v[q].y * rstd * g.y * (1.f + sc.y) + sh.y;
      float y2 = v[q].z * rstd * g.z * (1.f + sc.z) + sh.z;
      float y3 = v[q].w * rstd * g.w * (1.f + sc.w) + sh.w;
      uint2 o;
      o.x = pack2(y0, y1);
      o.y = pack2(y2, y3);
      *(uint2*)(h + (size_t)r * D + c) = o;
    }
  }
}

template <bool PAIRED, class Epi>
DI void gemm_tile(const u16* __restrict__ A, int lda, const u16* __restrict__ Bt, int ldb, int K, int m0, int n0,
                  char* smem, Epi& epi) {
  u16* As = (u16*)smem;
  u16* Bs = As + 2 * 128 * 72;
  const int tid = ltid(), lane = tid & 63, wave = tid >> 6;
  const int wm = wave >> 1, wn = wave & 1, lr = lane & 31, lh = lane >> 5;
  f32x16 acc[2][2];
#pragma unroll
  for (int a = 0; a < 2; ++a)
#pragma unroll
    for (int b = 0; b < 2; ++b)
#pragma unroll
      for (int i = 0; i < 16; ++i) acc[a][b][i] = 0.f;
  const u16* Ag = A + (size_t)m0 * lda;
  const u16* Bg = Bt + (size_t)n0 * ldb;
  uint4 ra[4], rb[4];
  const int lrow = tid >> 3, lkc = (tid & 7) * 8;
#pragma unroll
  for (int i = 0; i < 4; ++i) {
    ra[i] = *(const uint4*)(Ag + (size_t)(lrow + 32 * i) * lda + lkc);
    rb[i] = *(const uint4*)(Bg + (size_t)(lrow + 32 * i) * ldb + lkc);
  }
#pragma unroll
  for (int i = 0; i < 4; ++i) {
    *(uint4*)(As + (lrow + 32 * i) * 72 + lkc) = ra[i];
    *(uint4*)(Bs + (lrow + 32 * i) * 72 + lkc) = rb[i];
  }
  __syncthreads();
  const int nk = K >> 6;
  for (int kt = 0; kt < nk; ++kt) {
    const int buf = kt & 1;
    if (kt + 1 < nk) {
      const int k0 = (kt + 1) << 6;
#pragma unroll
      for (int i = 0; i < 4; ++i) {
        ra[i] = *(const uint4*)(Ag + (size_t)(lrow + 32 * i) * lda + k0 + lkc);
        rb[i] = *(const uint4*)(Bg + (size_t)(lrow + 32 * i) * ldb + k0 + lkc);
      }
    }
    const u16* as = As + buf * 128 * 72 + (wm * 64 + lr) * 72 + lh * 8;
    const u16* bs = Bs + buf * 128 * 72 + (wn * 64 + lr) * 72 + lh * 8;
#pragma unroll
    for (int ks = 0; ks < 4; ++ks) {
      bf16x8 a0 = *(const bf16x8*)(as + ks * 16);
      bf16x8 a1 = *(const bf16x8*)(as + 32 * 72 + ks * 16);
      bf16x8 b0 = *(const bf16x8*)(bs + ks * 16);
      bf16x8 b1 = *(const bf16x8*)(bs + 32 * 72 + ks * 16);
      acc[0][0] = MFMA32(a0, b0, acc[0][0]);
      acc[0][1] = MFMA32(a0, b1, acc[0][1]);
      acc[1][0] = MFMA32(a1, b0, acc[1][0]);
      acc[1][1] = MFMA32(a1, b1, acc[1][1]);
    }
    if (kt + 1 < nk) {
      u16* ad = As + (buf ^ 1) * 128 * 72;
      u16* bd = Bs + (buf ^ 1) * 128 * 72;
#pragma unroll
      for (int i = 0; i < 4; ++i) {
        *(uint4*)(ad + (lrow + 32 * i) * 72 + lkc) = ra[i];
        *(uint4*)(bd + (lrow + 32 * i) * 72 + lkc) = rb[i];
      }
    }
    __syncthreads();
  }
#pragma unroll
  for (int mi = 0; mi < 2; ++mi) {
#pragma unroll
    for (int i = 0; i < 16; ++i) {
      const int row = m0 + wm * 64 + mi * 32 + crow(i, lh);
      if (PAIRED) {
        const int col = (n0 >> 1) + wn * 32 + lr;
        epi.pair(row, col, acc[mi][0][i], acc[mi][1][i]);
      } else {
        epi(row, n0 + wn * 64 + lr, acc[mi][0][i]);
        epi(row, n0 + wn * 64 + 32 + lr, acc[mi][1][i]);
      }
    }
  }
}

template <bool PAIRED, class Epi>
DI void gemm_phase(const u16* A, int lda, const u16* Bt, int ldb, int K, int mtiles, int ntiles, int mt_off, bool skip_ctx,
                   char* smem, Epi& epi) {
  const int total = mtiles * ntiles;
  for (int t = blockIdx.x; t < total; t += gridDim.x) {
    const int mt = t / ntiles, nt = t - mt * ntiles;
    if (skip_ctx && ((mt + mt_off) % 34) < 2) continue;
    gemm_tile<PAIRED>(A, lda, Bt, ldb, K, mt * 128, nt * 128, smem, epi);
  }
}

struct EpiGU {
  u16* G;
  DI void pair(int row, int col, float g, float u) const {
    float s = g / (1.f + __expf(-g));
    G[(size_t)row * DFF + col] = f2bf(s * u);
  }
  DI void operator()(int, int, float) const {}
};
struct EpiRes {
  const float* lat_in; const float* ctx_in; float* lat_out; float* ctx_out; const float* modl; int gate_chunk; float coef;
  DI void operator()(int row, int col, float v) const {
    const int b = row / LT, j = row - b * LT;
    const int bb = j < LC ? 8 : b;
    const float gate = modl[bb * 9216 + gate_chunk * 1024 + col];
    const size_t off = j < LC ? (((size_t)(b * LC + j)) << 10) + col : (((size_t)(b * LQ + j - LC)) << 10) + col;
    const float xin = j < LC ? ctx_in[off] : lat_in[off];
    const float y = xin + coef * gate * v;
    if (j < LC) ctx_out[off] = y; else lat_out[off] = y;
  }
  DI void pair(int, int, float, float) const {}
};
struct EpiStore {
  u16* C; int ldc; int N;
  DI void operator()(int row, int col, float v) const { if (col < N) C[(size_t)row * ldc + col] = f2bf(v); }
  DI void pair(int, int, float, float) const {}
};
struct EpiLoraW {
  u16* C; const float* w0;
  DI void operator()(int row, int col, float v) const {
    float zz = -(w0[col] + v);
    float sp = fmaxf(zz, 0.f) + log1pf(expf(-fabsf(zz)));
    C[(size_t)row * 256 + col] = f2bf(expf(-sp - 0.5f));
  }
  DI void pair(int, int, float, float) const {}
};
struct EpiLoraA {
  u16* C; const float* a0;
  DI void operator()(int row, int col, float v) const { C[(size_t)row * 256 + col] = f2bf(sigmoidf_(a0[col] + v)); }
  DI void pair(int, int, float, float) const {}
};

struct MixBufs {
  u16 *p, *u, *qg, *kg, *vtg, *cqn, *ckvn, *qup, *kvup, *qm, *km, *vtm, *rr, *rk, *rv, *rkk, *lwf, *lwb, *laf, *lab, *lg, *ef, *eb, *af, *ab, *gg;
  float *yf, *yb;
};
DI MixBufs mixbufs(char* big) {
  MixBufs m;
  m.p = (u16*)(big + M_P); m.u = (u16*)(big + M_U); m.qg = (u16*)(big + M_QG); m.kg = (u16*)(big + M_KG);
  m.vtg = (u16*)(big + M_VTG); m.cqn = (u16*)(big + M_CQN); m.ckvn = (u16*)(big + M_CKVN); m.qup = (u16*)(big + M_QUP);
  m.kvup = (u16*)(big + M_KVUP); m.qm = (u16*)(big + M_QM); m.km = (u16*)(big + M_KM); m.vtm = (u16*)(big + M_VTM);
  m.rr = (u16*)(big + M_RR); m.rk = (u16*)(big + M_RK); m.rv = (u16*)(big + M_RV); m.rkk = (u16*)(big + M_RKK);
  m.lwf = (u16*)(big + M_LWF); m.lwb = (u16*)(big + M_LWB); m.laf = (u16*)(big + M_LAF); m.lab = (u16*)(big + M_LAB);
  m.lg = (u16*)(big + M_LG); m.ef = (u16*)(big + M_EF); m.eb = (u16*)(big + M_EB); m.af = (u16*)(big + M_AF);
  m.ab = (u16*)(big + M_AB); m.gg = (u16*)(big + M_GG); m.yf = (float*)(big + M_YF); m.yb = (float*)(big + M_YB);
  return m;
}

DI void prep_phase(const Params& p, int l, int g, const MixBufs& m, char* smem) {
  float* red = (float*)smem;
  const int tid = ltid(), lane = tid & 63, wave = tid >> 6;
  const float* cw = p.hy_conv_w + l * 3 * 768;
  const float* cb = p.hy_conv_b + l * 768;
  const float* mu = p.rw_mu + l * 1152;
  for (int rl = blockIdx.x; rl < TG; rl += gridDim.x) {
    const int r = g * TG + rl;
    const int b = r / LT, j = r - b * LT, bl = b - g * BG;
    const bool lat = j >= LC;
    const bool hp = lat ? (j > LC) : (j > 0);
    const bool hn = lat ? (j < LT - 1) : (j < LC - 1);
    const u16* pc = m.p + (size_t)rl * DIN;
    const u16* pp = pc - DIN;
    const u16* pn = pc + DIN;
    {
      const int c0 = tid, c2 = 512 + tid;
      float x1 = bf2f(pc[c0]) * cw[768 + c0] + cb[c0];
      float vv = bf2f(pc[c2]) * cw[768 + c2] + cb[c2];
      if (hp) { x1 += bf2f(pp[c0]) * cw[c0]; vv += bf2f(pp[c2]) * cw[c2]; }
      if (hn) { x1 += bf2f(pn[c0]) * cw[1536 + c0]; vv += bf2f(pn[c2]) * cw[1536 + c2]; }
      m.u[(size_t)rl * 256 + tid] = f2bf(x1 * vv);
    }
    {
      auto tshift = [&](int crel) -> float {
        const int c = 1696 + crel;
        float u0 = bf2f(pc[c]);
        float nb = 0.f;
        if (hp) nb += bf2f(pp[c]);
        if (hn) nb += bf2f(pn[c]);
        return u0 + mu[crel] * (0.5f * nb - u0);
      };
      float sr = tshift(tid), sk = tshift(256 + tid), sv = tshift(512 + tid);
      m.rr[(size_t)rl * 256 + tid] = f2bf(sr);
      m.rk[(size_t)rl * 256 + tid] = f2bf(sk);
      m.rv[(size_t)rl * 256 + tid] = f2bf(sv);
      float kx = sk * p.rw_k_k[l * 256 + tid];
      float ss = wave_sum(kx * kx);
      m.rkk[(size_t)rl * 256 + tid] = f2bf(kx / fmaxf(sqrtf(ss), 1e-12f));
      float s4 = tshift(768 + tid);
      if (tid < 64) m.lwf[(size_t)rl * 64 + tid] = f2bf(tanhf(s4));
      else if (tid < 128) m.lwb[(size_t)rl * 64 + tid - 64] = f2bf(tanhf(s4));
      else if (tid < 192) m.laf[(size_t)rl * 64 + tid - 128] = f2bf(s4);
      else m.lab[(size_t)rl * 64 + tid - 192] = f2bf(s4);
      if (tid < 128) {
        float s5 = tshift(1024 + tid);
        m.lg[(size_t)rl * 128 + tid] = f2bf(sigmoidf_(s5));
      }
    }
    {
      float cq = bf2f(pc[1280 + tid]);
      float ckv = tid < 128 ? bf2f(pc[1536 + tid]) : 0.f;
      float s1 = wave_sum(cq * cq), s2 = wave_sum(ckv * ckv);
      if (lane == 0) { red[wave] = s1; red[4 + wave] = s2; }
      __syncthreads();
      s1 = red[0] + red[1] + red[2] + red[3];
      s2 = red[4] + red[5] + red[6] + red[7];
      __syncthreads();
      m.cqn[(size_t)rl * 256 + tid] = f2bf(cq * rsqrtf(s1 * (1.f / 256.f) + EPS) * p.mla_cq_norm[l * 256 + tid]);
      if (tid < 128) m.ckvn[(size_t)rl * 128 + tid] = f2bf(ckv * rsqrtf(s2 * (1.f / 128.f) + EPS) * p.mla_ckv_norm[l * 128 + tid]);
    }
    for (int hh = wave; hh < 6; hh += 4) {
      float val = bf2f(pc[768 + hh * 64 + lane]);
      float ss = wave_sum(val * val);
      float gn = hh < 4 ? p.gqa_q_norm[l * 64 + lane] : p.gqa_k_norm[l * 64 + lane];
      val = val * rsqrtf(ss * (1.f / 64.f) + EPS) * gn;
      float rv = rope_apply(val, lane, 16, j - LC, lane);
      if (lat) val = rv;
      if (hh < 4) m.qg[(size_t)rl * 256 + hh * 64 + lane] = f2bf(val);
      else m.kg[(size_t)rl * 128 + (hh - 4) * 64 + lane] = f2bf(val);
    }
    if (wave < 2) m.vtg[((size_t)(bl * 2 + wave) * 64 + lane) * LT + j] = pc[1152 + wave * 64 + lane];
  }
}

DI void mla_fin_phase(const Params& p, int l, int g, const MixBufs& m) {
  const int tid = ltid(), lane = tid & 63, wave = tid >> 6;
  for (int rl = blockIdx.x; rl < TG; rl += gridDim.x) {
    const int r = g * TG + rl;
    const int b = r / LT, j = r - b * LT, bl = b - g * BG;
    const bool lat = j >= LC;
    for (int s = wave; s < 8; s += 4) {
      const int hd = s & 3;
      const bool isq = s < 4;
      float x0, x1;
      if (isq) {
        x0 = bf2f(m.qup[(size_t)rl * 384 + hd * 96 + lane]);
        x1 = lane < 32 ? bf2f(m.qup[(size_t)rl * 384 + hd * 96 + 64 + lane]) : 0.f;
      } else {
        x0 = bf2f(m.kvup[(size_t)rl * 512 + hd * 128 + lane]);
        x1 = lane < 32 ? bf2f(m.p[(size_t)rl * DIN + 1664 + lane]) : 0.f;
      }
      float ss = wave_sum(x0 * x0 + x1 * x1);
      const float rstd = rsqrtf(ss * (1.f / 96.f) + EPS);
      const float* gn = isq ? p.mla_q_norm + l * 96 : p.mla_k_norm + l * 96;
      float y0 = x0 * rstd * gn[lane];
      float y1 = lane < 32 ? x1 * rstd * gn[64 + lane] : 0.f;
      float ry = rope_apply(y1, lane & 31, 8, j - LC, lane);
      if (lat) y1 = ry;
      u16* dst = (isq ? m.qm : m.km) + (size_t)rl * 384 + hd * 96;
      dst[lane] = f2bf(y0);
      if (lane < 32) dst[64 + lane] = f2bf(y1);
      if (!isq) m.vtm[((size_t)(bl * 4 + hd) * 64 + lane) * LT + j] = m.kvup[(size_t)rl * 512 + hd * 128 + 64 + lane];
    }
  }
}

template <int DQK, int QT>
DI void attn_item(const u16* __restrict__ q, int ldq, const u16* __restrict__ k, int ldk, const u16* __restrict__ vT,
                  u16* __restrict__ out, int ldo, int nkeys, float sl2, float sh2, char* smem) {
  constexpr int KS = DQK + 8;
  constexpr int NKS = DQK / 16;
  constexpr int KCH = DQK / 8;
  constexpr int KPT = 64 * KCH / NTHR;
  u16* Ks = (u16*)smem;
  u16* Vs = Ks + 2 * 64 * KS;
  const int tid = ltid(), lane = tid & 63, wave = tid >> 6, lr = lane & 31, lh = lane >> 5;
  bf16x8 qf[QT][NKS];
#pragma unroll
  for (int qt = 0; qt < QT; ++qt)
#pragma unroll
    for (int ks = 0; ks < NKS; ++ks)
      qf[qt][ks] = *(const bf16x8*)(q + (size_t)(wave * 32 * QT + qt * 32 + lr) * ldq + ks * 16 + lh * 8);
  f32x16 o[QT][2];
#pragma unroll
  for (int a = 0; a < QT; ++a)
#pragma unroll
    for (int b = 0; b < 2; ++b)
#pragma unroll
      for (int i = 0; i < 16; ++i) o[a][b][i] = 0.f;
  float lsum[QT];
#pragma unroll
  for (int a = 0; a < QT; ++a) lsum[a] = 0.f;
  uint4 rk[KPT], rv[2];
#define ATT_GLOAD(key0)                                                                   \
  {                                                                                       \
    _Pragma("unroll") for (int i = 0; i < KPT; ++i) {                                     \
      const int id = tid + NTHR * i, row = id / KCH, ch = id - row * KCH;                 \
      rk[i] = *(const uint4*)(k + (size_t)((key0) + row) * ldk + ch * 8);                 \
    }                                                                                     \
    _Pragma("unroll") for (int i = 0; i < 2; ++i) {                                       \
      const int id = tid + NTHR * i, row = id >> 3, ch = id & 7;                          \
      rv[i] = *(const uint4*)(vT + (size_t)row * LT + (key0) + ch * 8);                   \
    }                                                                                     \
  }
#define ATT_LSTORE(buf_)                                                                  \
  {                                                                                       \
    _Pragma("unroll") for (int i = 0; i < KPT; ++i) {                                     \
      const int id = tid + NTHR * i, row = id / KCH, ch = id - row * KCH;                 \
      *(uint4*)(Ks + (buf_) * 64 * KS + row * KS + ch * 8) = rk[i];                       \
    }                                                                                     \
    _Pragma("unroll") for (int i = 0; i < 2; ++i) {                                       \
      const int id = tid + NTHR * i, row = id >> 3, ch = id & 7;                          \
      *(uint4*)(Vs + (buf_) * 64 * 72 + row * 72 + ch * 8) = rv[i];                       \
    }                                                                                     \
  }
  ATT_GLOAD(0);
  ATT_LSTORE(0);
  __syncthreads();
  const int nkt = nkeys >> 6;
  for (int kt = 0; kt < nkt; ++kt) {
    const int buf = kt & 1;
    if (kt + 1 < nkt) ATT_GLOAD((kt + 1) << 6);
    const u16* kb = Ks + buf * 64 * KS;
    const u16* vb = Vs + buf * 64 * 72;
#pragma unroll
    for (int half = 0; half < 2; ++half) {
      f32x16 s[QT];
#pragma unroll
      for (int qt = 0; qt < QT; ++qt)
#pragma unroll
        for (int i = 0; i < 16; ++i) s[qt][i] = 0.f;
#pragma unroll
      for (int ks = 0; ks < NKS; ++ks) {
        bf16x8 kf = *(const bf16x8*)(kb + (half * 32 + lr) * KS + ks * 16 + lh * 8);
#pragma unroll
        for (int qt = 0; qt < QT; ++qt) s[qt] = MFMA32(kf, qf[qt][ks], s[qt]);
      }
#pragma unroll
      for (int qt = 0; qt < QT; ++qt)
#pragma unroll
        for (int i = 0; i < 16; ++i) {
          float pv = exp2f(s[qt][i] * sl2 - sh2);
          lsum[qt] += pv;
          s[qt][i] = pv;
        }
#pragma unroll
      for (int st = 0; st < 2; ++st) {
        bf16x8 pb[QT];
#pragma unroll
        for (int qt = 0; qt < QT; ++qt) {
          uint4 w;
          w.x = pack2(s[qt][8 * st + 0], s[qt][8 * st + 1]);
          w.y = pack2(s[qt][8 * st + 2], s[qt][8 * st + 3]);
          w.z = pack2(s[qt][8 * st + 4], s[qt][8 * st + 5]);
          w.w = pack2(s[qt][8 * st + 6], s[qt][8 * st + 7]);
          pb[qt] = __builtin_bit_cast(bf16x8, w);
        }
#pragma unroll
        for (int mt = 0; mt < 2; ++mt) {
          const u16* vp = vb + (mt * 32 + lr) * 72 + half * 32 + st * 16 + lh * 4;
          uint2 v0 = *(const uint2*)(vp);
          uint2 v1 = *(const uint2*)(vp + 8);
          uint4 w;
          w.x = v0.x; w.y = v0.y; w.z = v1.x; w.w = v1.y;
          bf16x8 vf = __builtin_bit_cast(bf16x8, w);
#pragma unroll
          for (int qt = 0; qt < QT; ++qt) o[qt][mt] = MFMA32(vf, pb[qt], o[qt][mt]);
        }
      }
    }
    if (kt + 1 < nkt) ATT_LSTORE(buf ^ 1);
    __syncthreads();
  }
#pragma unroll
  for (int qt = 0; qt < QT; ++qt) {
    float tot = lsum[qt] + __shfl_xor(lsum[qt], 32);
    float inv = 1.f / tot;
    const int row = wave * 32 * QT + qt * 32 + lr;
#pragma unroll
    for (int mt = 0; mt < 2; ++mt)
#pragma unroll
      for (int gq = 0; gq < 4; ++gq) {
        uint2 w;
        w.x = pack2(o[qt][mt][4 * gq + 0] * inv, o[qt][mt][4 * gq + 1] * inv);
        w.y = pack2(o[qt][mt][4 * gq + 2] * inv, o[qt][mt][4 * gq + 3] * inv);
        *(uint2*)(out + (size_t)row * ldo + mt * 32 + 8 * gq + 4 * lh) = w;
      }
  }
}

DI void hyena_item(const Params& p, int l, const MixBufs& m, const float* __restrict__ gT, int L, int rl0  ,
                   int t0, u16* __restrict__ ymix_seg  ) {
  const int c = ltid();
  float acc[16];
#pragma unroll
  for (int i = 0; i < 16; ++i) acc[i] = 0.f;
  const u16* ub = m.u + (size_t)rl0 * 256 + c;
  const float* gb = gT + (size_t)(L - 1 + t0) * 256 + c;
  for (int s0 = 0; s0 < L; s0 += 16) {
    float gw[31];
#pragma unroll
    for (int d = 0; d < 31; ++d) {
      int delta = t0 - s0 + d - 15;
      bool ok = delta >= -(L - 1) && delta <= (L - 1);
      gw[d] = ok ? gb[((long)(d - 15) - s0) * 256] : 0.f;
    }
#pragma unroll
    for (int mm = 0; mm < 16; ++mm) {
      float uv = bf2f(ub[(size_t)(s0 + mm) * 256]);
#pragma unroll
      for (int i = 0; i < 16; ++i) acc[i] += gw[i - mm + 15] * uv;
    }
  }
  const float* cw = p.hy_conv_w + l * 3 * 768;
  const float* cb = p.hy_conv_b + l * 768;
  const float bias = p.hy_bias[l * 256 + c];
  const int c1 = 256 + c;
#pragma unroll
  for (int i = 0; i < 16; ++i) {
    const int t = t0 + i;
    const u16* pc = m.p + (size_t)(rl0 + t) * DIN;
    float x2 = bf2f(pc[c1]) * cw[768 + c1] + cb[c1];
    if (t > 0) x2 += bf2f(pc[c1 - DIN]) * cw[c1];
    if (t < L - 1) x2 += bf2f(pc[c1 + DIN]) * cw[1536 + c1];
    float uv = bf2f(ub[(size_t)t * 256]);
    ymix_seg[(size_t)t * D + c] = f2bf(x2 * (acc[i] + uv * bias));
  }
}

DI void scan_item(const Params& p, int l, const MixBufs& m, int bl, int hd, int dir, char* smem) {
  constexpr int TC = 16;
  float* sk = (float*)smem;
  float* sw = sk + TC * 64;
  float* sb = sw + TC * 64;
  float* sd = sb + TC * 64;
  float* srr = sd + TC * 64;
  float* sv = srr + TC * 64;
  const int tid = ltid();
  const int v = tid >> 2, qq = tid & 3;
  const u16* eD = dir ? m.eb : m.ef;
  const u16* aD = dir ? m.ab : m.af;
  float* yD = dir ? m.yb : m.yf;
  const float* ka = p.rw_k_a + l * 256 + hd * 64;
  float S[16];
#pragma unroll
  for (int i = 0; i < 16; ++i) S[i] = 0.f;
  const size_t rbase = (size_t)bl * LT;
  for (int i0 = 0; i0 < LT; i0 += TC) {
    for (int e = tid; e < TC * 64; e += NTHR) {
      const int st = e >> 6, kx = e & 63;
      const int i = i0 + st;
      const int j = dir ? (i < LC ? LC - 1 - i : LT - 1 - (i - LC)) : i;
      const size_t o = (rbase + j) * 256 + hd * 64 + kx;
      const float kk = bf2f(m.rkk[o]), a = bf2f(aD[o]), kv = bf2f(m.rk[o]);
      sk[e] = kk;
      sw[e] = expf(-bf2f(eD[o]));
      sb[e] = kk * a;
      sd[e] = kv * (1.f + (a - 1.f) * ka[kx]);
      srr[e] = bf2f(m.rr[o]);
      sv[e] = bf2f(m.rv[o]);
    }
    __syncthreads();
    for (int st = 0; st < TC; ++st) {
      const float4* k4 = (const float4*)(sk + st * 64 + qq * 16);
      const float4* w4 = (const float4*)(sw + st * 64 + qq * 16);
      const float4* b4 = (const float4*)(sb + st * 64 + qq * 16);
      const float4* d4 = (const float4*)(sd + st * 64 + qq * 16);
      const float4* r4 = (const float4*)(srr + st * 64 + qq * 16);
      const float vv = sv[st * 64 + v];
      float sa = 0.f;
#pragma unroll
      for (int c4 = 0; c4 < 4; ++c4) {
        float4 kk = k4[c4];
        sa += S[4 * c4] * kk.x + S[4 * c4 + 1] * kk.y + S[4 * c4 + 2] * kk.z + S[4 * c4 + 3] * kk.w;
      }
      sa += __shfl_xor(sa, 1);
      sa += __shfl_xor(sa, 2);
      sa = -sa;
      float y = 0.f;
#pragma unroll
      for (int c4 = 0; c4 < 4; ++c4) {
        float4 ww = w4[c4], bb = b4[c4], dd = d4[c4], rr = r4[c4];
        S[4 * c4 + 0] = S[4 * c4 + 0] * ww.x + sa * bb.x + vv * dd.x;
        S[4 * c4 + 1] = S[4 * c4 + 1] * ww.y + sa * bb.y + vv * dd.y;
        S[4 * c4 + 2] = S[4 * c4 + 2] * ww.z + sa * bb.z + vv * dd.z;
        S[4 * c4 + 3] = S[4 * c4 + 3] * ww.w + sa * bb.w + vv * dd.w;
        y += S[4 * c4] * rr.x + S[4 * c4 + 1] * rr.y + S[4 * c4 + 2] * rr.z + S[4 * c4 + 3] * rr.w;
      }
      y += __shfl_xor(y, 1);
      y += __shfl_xor(y, 2);
      if (qq == 0) {
        const int i = i0 + st;
        const int j = dir ? (i < LC ? LC - 1 - i : LT - 1 - (i - LC)) : i;
        yD[(rbase + j) * 256 + hd * 64 + v] = y;
      }
    }
    __syncthreads();
  }
}

DI void readout_phase(const Params& p, int l, int g, const MixBufs& m, u16* __restrict__ ymix, bool skip_ctx) {
  const int tid = ltid();
  for (int rl = blockIdx.x; rl < TG; rl += gridDim.x) {
    const int r = g * TG + rl;
    const int j = r % LT;
    if (skip_ctx && j < LC) continue;
    const size_t o = (size_t)rl * 256 + tid;
    float y = m.yf[o] + m.yb[o];
    float mean = wave_sum(y) * (1.f / 64.f);
    float dv = y - mean;
    float var = wave_sum(dv * dv) * (1.f / 64.f);
    float yn = dv * rsqrtf(var + 64e-5f) * p.rw_ln_w[l * 256 + tid] + p.rw_ln_b[l * 256 + tid];
    const float rr = bf2f(m.rr[o]), kv = bf2f(m.rk[o]), vv = bf2f(m.rv[o]);
    const float kaa = p.rw_k_a[l * 256 + tid], rk = p.rw_r_k[l * 256 + tid];
    const float af = bf2f(m.af[o]), ab = bf2f(m.ab[o]);
    float t1 = rr * kv * (1.f + (af - 1.f) * kaa) * rk + rr * kv * (1.f + (ab - 1.f) * kaa) * rk;
    float bonus = wave_sum(t1) * vv;
    ymix[(size_t)r * D + 768 + tid] = f2bf((yn + bonus) * bf2f(m.gg[o]));
  }
}

__global__ void __launch_bounds__(NTHR, 2) fwd_megakernel(Params p) {
  cg::grid_group grid = cg::this_grid();
  __shared__ __attribute__((aligned(16))) char smem[73728];
  char* ws = p.ws;
  float* ctxs = (float*)(ws + OFF_CTX);
  float* mod = (float*)(ws + OFF_MOD);
  u16* hbuf = (u16*)(ws + OFF_H);
  char* big = ws + OFF_BIG;
  u16* Gbuf = (u16*)big;
  const MixBufs m = mixbufs(big);

  for (int l = 0; l < 2; ++l) {
    u16* W = (u16*)(ws + OFF_W) + (size_t)l * W_LAYER;
    convT(p.ffn1_gate + (size_t)l * D * DFF, D, DFF, W + W_GU1, 1, smem);
    convT(p.ffn1_up + (size_t)l * D * DFF, D, DFF, W + W_GU1, 2, smem);
    convT(p.ffn1_down + (size_t)l * D * DFF, DFF, D, W + W_D1, 0, smem);
    convT(p.ffn2_gate + (size_t)l * D * DFF, D, DFF, W + W_GU2, 1, smem);
    convT(p.ffn2_up + (size_t)l * D * DFF, D, DFF, W + W_GU2, 2, smem);
    convT(p.ffn2_down + (size_t)l * D * DFF, DFF, D, W + W_D2, 0, smem);
    convT(p.w_in + (size_t)l * D * DIN, D, DIN, W + W_IN, 0, smem);
    convT(p.w_out + (size_t)l * D * D, D, D, W + W_OUT, 0, smem);
    convT(p.mla_w_uq + (size_t)l * 256 * 384, 256, 384, W + W_UQ, 0, smem);
    convT(p.mla_w_ukv + (size_t)l * 128 * 512, 128, 512, W + W_UKV, 0, smem);
    for (int d = 0; d < 2; ++d) {
      convT(p.rw_w2 + (size_t)(l * 2 + d) * 64 * 256, 64, 256, W + W_W2 + (size_t)d * 256 * 64, 0, smem);
      convT(p.rw_a2 + (size_t)(l * 2 + d) * 64 * 256, 64, 256, W + W_A2 + (size_t)d * 256 * 64, 0, smem);
    }
    convT(p.rw_g2 + (size_t)l * 128 * 256, 128, 256, W + W_G2, 0, smem);
    hyfilt_phase(p, l, LQ, (float*)(ws + OFF_FILT + (size_t)l * al(SZ_FILT_L)), smem);
  }
  hyfilt_phase(p, 0, LC, (float*)(ws + OFF_FILTC), smem);
  mod_phase(p, mod, smem);
  grid.sync();

  for (int l = 0; l < 2; ++l) {
    const bool last = (l == 1);
    const u16* W = (u16*)(ws + OFF_W) + (size_t)l * W_LAYER;
    const float* modl = mod + (size_t)l * 9 * 9216;
    const float* lat_in = (l == 0) ? p.x : p.out;
    const float* ctx_in = (l == 0) ? p.ctx : ctxs;

    adaln_phase(lat_in, ctx_in, p.norm_ffn1 + l * D, modl, 0, hbuf, false);
    grid.sync();
    {
      EpiGU e{Gbuf};
      gemm_phase<true>(hbuf, D, W + W_GU1, D, D, T / 128, 44, 0, false, smem, e);
    }
    grid.sync();
    {
      EpiRes e{lat_in, ctx_in, p.out, ctxs, modl, 2, 0.5f};
      gemm_phase<false>(Gbuf, DFF, W + W_D1, DFF, DFF, T / 128, 8, 0, false, smem, e);
    }
    grid.sync();
    adaln_phase(p.out, ctxs, p.norm_mix + l * D, modl, 1, hbuf, false);
    grid.sync();
    for (int g = 0; g < NG; ++g) {
      const u16* hg = hbuf + (size_t)g * TG * D;
      {
        EpiStore e{m.p, DIN, DIN};
        gemm_phase<false>(hg, D, W + W_IN, D, D, TG / 128, 23, 0, false, smem, e);
      }
      grid.sync();
      prep_phase(p, l, g, m, smem);
      grid.sync();
      {
        EpiStore e1{m.qup, 384, 384};
        gemm_phase<false>(m.cqn, 256, W + W_UQ, 256, 256, TG / 128, 3, 0, false, smem, e1);
        EpiStore e2{m.kvup, 512, 512};
        gemm_phase<false>(m.ckvn, 128, W + W_UKV, 128, 128, TG / 128, 4, 0, false, smem, e2);
        EpiLoraW e3{m.ef, p.rw_w0 + (l * 2 + 0) * 256};
        gemm_phase<false>(m.lwf, 64, W + W_W2, 64, 64, TG / 128, 2, 0, false, smem, e3);
        EpiLoraW e4{m.eb, p.rw_w0 + (l * 2 + 1) * 256};
        gemm_phase<false>(m.lwb, 64, W + W_W2 + 256 * 64, 64, 64, TG / 128, 2, 0, false, smem, e4);
        EpiLoraA e5{m.af, p.rw_a0 + (l * 2 + 0) * 256};
        gemm_phase<false>(m.laf, 64, W + W_A2, 64, 64, TG / 128, 2, 0, false, smem, e5);
        EpiLoraA e6{m.ab, p.rw_a0 + (l * 2 + 1) * 256};
        gemm_phase<false>(m.lab, 64, W + W_A2 + 256 * 64, 64, 64, TG / 128, 2, 0, false, smem, e6);
        EpiStore e7{m.gg, 256, 256};
        gemm_phase<false>(m.lg, 128, W + W_G2, 128, 128, TG / 128, 2, 0, false, smem, e7);
      }
      grid.sync();
      mla_fin_phase(p, l, g, m);
      grid.sync();
      {
        u16* ymix = hbuf;
        const int n_scan = BG * 4 * 2;
        const int qt_per_b = last ? 32 : 34;
        const int n_att = BG * 4 * qt_per_b;
        const int hy_per_b = last ? 256 : 272;
        const int n_hy = BG * hy_per_b;
        const int total = n_scan + 2 * n_att + n_hy;
        float gq = 0.f, gk = 0.f, mq = 0.f, mk = 0.f;
        for (int i = 0; i < 64; ++i) { gq = fmaxf(gq, fabsf(p.gqa_q_norm[l * 64 + i])); gk = fmaxf(gk, fabsf(p.gqa_k_norm[l * 64 + i])); }
        for (int i = 0; i < 96; ++i) { mq = fmaxf(mq, fabsf(p.mla_q_norm[l * 96 + i])); mk = fmaxf(mk, fabsf(p.mla_k_norm[l * 96 + i])); }
        const float L2E = 1.4426950408889634f;
        const float sc_g = 0.125f, sc_m = 0.10206207261596575f;
        const float sh_g = (64.f * gq * gk * sc_g * 1.02f + 0.5f) * L2E;
        const float sh_m = (96.f * mq * mk * sc_m * 1.02f + 0.5f) * L2E;
        for (int it = blockIdx.x; it < total; it += gridDim.x) {
          if (it < n_scan) {
            const int bl = it >> 3, hd = (it >> 1) & 3, dir = it & 1;
            scan_item(p, l, m, bl, hd, dir, smem);
          } else if (it < n_scan + 2 * n_att) {
            int a = it - n_scan;
            const int kind = a / n_att;
            a -= kind * n_att;
            const int bl = a / (4 * qt_per_b);
            int rem = a - bl * 4 * qt_per_b;
            const int hd = rem / qt_per_b;
            const int qt = rem - hd * qt_per_b;
            const int j0 = qt < 32 ? LC + qt * 128 : (qt - 32) * 128;
            const int nkeys = qt < 32 ? LT : LC;
            const size_t rl0 = (size_t)bl * LT + j0;
            const size_t rg0 = (size_t)(g * BG + bl) * LT + j0;
            if (kind == 0) {
              const int kvh = hd >> 1;
              attn_item<64, 1>(m.qg + rl0 * 256 + hd * 64, 256, m.kg + (size_t)bl * LT * 128 + kvh * 64, 128,
                            m.vtg + (size_t)(bl * 2 + kvh) * 64 * LT, ymix + rg0 * D + 256 + hd * 64, D, nkeys, sc_g * L2E, sh_g, smem);
            } else {
              attn_item<96, 1>(m.qm + rl0 * 384 + hd * 96, 384, m.km + (size_t)bl * LT * 384 + hd * 96, 384,
                            m.vtm + (size_t)(bl * 4 + hd) * 64 * LT, ymix + rg0 * D + 512 + hd * 64, D, nkeys, sc_m * L2E, sh_m, smem);
            }
          } else {
            int a = it - n_scan - 2 * n_att;
            const int bl = a / hy_per_b;
            const int tt = a - bl * hy_per_b;
            const size_t rg = (size_t)(g * BG + bl) * LT;
            if (tt < 256) {
              hyena_item(p, l, m, (const float*)(ws + OFF_FILT + (size_t)l * al(SZ_FILT_L)), LQ, bl * LT + LC, tt * 16, ymix + (rg + LC) * D);
            } else {
              hyena_item(p, l, m, (const float*)(ws + OFF_FILTC), LC, bl * LT, (tt - 256) * 16, ymix + rg * D);
            }
          }
        }
        grid.sync();
        readout_phase(p, l, g, m, ymix, last);
        grid.sync();
      }
    }
    {
      EpiRes e{p.out, ctxs, p.out, ctxs, modl, 5, 1.0f};
      gemm_phase<false>(hbuf, D, W + W_OUT, D, D, T / 128, 8, 0, last, smem, e);
    }
    grid.sync();
    adaln_phase(p.out, ctxs, p.norm_ffn2 + l * D, modl, 2, hbuf, last);
    grid.sync();
    {
      EpiGU e{Gbuf};
      gemm_phase<true>(hbuf, D, W + W_GU2, D, D, T / 128, 44, 0, last, smem, e);
    }
    grid.sync();
    {
      EpiRes e{p.out, ctxs, p.out, ctxs, modl, 8, 0.5f};
      gemm_phase<false>(Gbuf, DFF, W + W_D2, DFF, DFF, T / 128, 8, 0, last, smem, e);
    }
    grid.sync();
  }
}

extern "C" void kernel_launch(void* const* d_in, const int* in_sizes, int n_in, void* d_out, int out_size, void* d_ws,
                              size_t ws_size, hipStream_t stream) {
  static int grid_blocks = 0;
  if (!grid_blocks) {
    int dev = 0, cus = 0, per_cu = 0;
    (void)hipGetDevice(&dev);
    (void)hipDeviceGetAttribute(&cus, hipDeviceAttributeMultiprocessorCount, dev);
    (void)hipOccupancyMaxActiveBlocksPerMultiprocessor(&per_cu, fwd_megakernel, NTHR, 0);
    if (per_cu > 2) per_cu = 2;
    if (per_cu < 1) per_cu = 1;
    grid_blocks = cus * per_cu;
  }
  Params p{};
  const float** pp = (const float**)&p;
  for (int i = 0; i < 47; ++i) pp[i] = (const float*)d_in[i];
  p.out = (float*)d_out;
  p.ws = (char*)d_ws;
  void* args[] = {&p};
  hipError_t e = hipLaunchCooperativeKernel((void*)fwd_megakernel, dim3(grid_blocks), dim3(NTHR), args, 0, stream);
  if (e != hipSuccess) fprintf(stderr, "cooperative launch failed: %s (grid %d)\n", hipGetErrorString(e), grid_blocks);
}
```

```cpp
#include <hip/hip_runtime.h>
#include <hip/hip_bf16.h>
#include <hip/hip_cooperative_groups.h>
#include <cstdio>
namespace cg = cooperative_groups;

#define DI __device__ __forceinline__
typedef unsigned short u16;
using bf16x8 = __attribute__((ext_vector_type(8))) short;
using f32x16 = __attribute__((ext_vector_type(16))) float;
typedef __bf16 bf16x2_t __attribute__((ext_vector_type(2)));
typedef float f32x2_t __attribute__((ext_vector_type(2)));
#define MFMA32(a, b, c) __builtin_amdgcn_mfma_f32_32x32x16_bf16((a), (b), (c), 0, 0, 0)

constexpr int D = 1024, NB = 8, LQ = 4096, LC = 256, LT = 4352, T = NB * LT, DFF = 2816, DIN = 2848;
constexpr int NG = 2, BG = NB / NG, TG = BG * LT;
constexpr int NTHR = 256;
#define REP_MIX 1
#define REP_GU 1
#define REP_MISC 1
constexpr float EPS = 1e-6f;

constexpr size_t al(size_t x) { return (x + 255) & ~(size_t)255; }
constexpr size_t OFF_CTX = 0;
constexpr size_t OFF_MOD = OFF_CTX + al((size_t)NB * LC * D * 4);
constexpr size_t SZ_FILT_L = (size_t)(2 * LQ - 1) * 256 * 4;
constexpr size_t SZ_FILT_C = (size_t)(2 * LC - 1) * 256 * 4;
constexpr size_t OFF_CNT = OFF_MOD + al((size_t)2 * 9 * 9216 * 4);
constexpr size_t OFF_FILT = OFF_CNT + 256;
constexpr size_t OFF_FILTC = OFF_FILT + 2 * al(SZ_FILT_L);
constexpr size_t OFF_W = OFF_FILTC + al(SZ_FILT_C);
constexpr size_t W_GU1 = 0;
constexpr size_t W_D1 = W_GU1 + (size_t)5632 * 1024;
constexpr size_t W_GU2 = W_D1 + (size_t)1024 * 2816;
constexpr size_t W_D2 = W_GU2 + (size_t)5632 * 1024;
constexpr size_t W_IN = W_D2 + (size_t)1024 * 2816;
constexpr size_t W_OUT = W_IN + (size_t)2944 * 1024;
constexpr size_t W_UQ = W_OUT + (size_t)1024 * 1024;
constexpr size_t W_UKV = W_UQ + (size_t)384 * 256;
constexpr size_t W_W2 = W_UKV + (size_t)512 * 128;
constexpr size_t W_A2 = W_W2 + (size_t)2 * 256 * 64;
constexpr size_t W_G2 = W_A2 + (size_t)2 * 256 * 64;
constexpr size_t W_LAYER = W_G2 + (size_t)256 * 128;
constexpr size_t OFF_H = OFF_W + al(2 * W_LAYER * 2);
constexpr size_t OFF_BIG = OFF_H + al((size_t)T * D * 2);
constexpr size_t M_P = 0;
constexpr size_t M_U = M_P + al((size_t)TG * DIN * 2);
constexpr size_t M_QG = M_U + al((size_t)TG * 256 * 2);
constexpr size_t M_KG = M_QG + al((size_t)TG * 256 * 2);
constexpr size_t M_VTG = M_KG + al((size_t)TG * 128 * 2);
constexpr size_t M_CQN = M_VTG + al((size_t)TG * 128 * 2);
constexpr size_t M_CKVN = M_CQN + al((size_t)TG * 256 * 2);
constexpr size_t M_QUP = M_CKVN + al((size_t)TG * 128 * 2);
constexpr size_t M_KVUP = M_QUP + al((size_t)TG * 384 * 2);
constexpr size_t M_QM = M_KVUP + al((size_t)TG * 512 * 2);
constexpr size_t M_KM = M_QM + al((size_t)TG * 384 * 2);
constexpr size_t M_VTM = M_KM + al((size_t)TG * 384 * 2);
constexpr size_t M_RR = M_VTM + al((size_t)TG * 256 * 2);
constexpr size_t M_RK = M_RR + al((size_t)TG * 256 * 2);
constexpr size_t M_RV = M_RK + al((size_t)TG * 256 * 2);
constexpr size_t M_RKK = M_RV + al((size_t)TG * 256 * 2);
constexpr size_t M_LWF = M_RKK + al((size_t)TG * 256 * 2);
constexpr size_t M_LWB = M_LWF + al((size_t)TG * 64 * 2);
constexpr size_t M_LAF = M_LWB + al((size_t)TG * 64 * 2);
constexpr size_t M_LAB = M_LAF + al((size_t)TG * 64 * 2);
constexpr size_t M_LG = M_LAB + al((size_t)TG * 64 * 2);
constexpr size_t M_EF = M_LG + al((size_t)TG * 128 * 2);
constexpr size_t M_EB = M_EF + al((size_t)TG * 256 * 2);
constexpr size_t M_AF = M_EB + al((size_t)TG * 256 * 2);
constexpr size_t M_AB = M_AF + al((size_t)TG * 256 * 2);
constexpr size_t M_GG = M_AB + al((size_t)TG * 256 * 2);
constexpr size_t M_YF = M_GG + al((size_t)TG * 256 * 2);
constexpr size_t M_YB = M_YF + al((size_t)TG * 256 * 4);
constexpr size_t M_END = M_YB + al((size_t)TG * 256 * 4);
constexpr size_t SZ_G = (size_t)T * DFF * 2;
constexpr size_t WS_NEED = OFF_BIG + (M_END > SZ_G ? M_END : SZ_G);
static_assert(WS_NEED <= (size_t)512 * 1024 * 1024, "workspace too large");

struct Params {
  const float *x, *c, *ctx, *c_ctx, *ada_w, *ada_b, *norm_ffn1, *norm_mix, *norm_ffn2;
  const float *ffn1_gate, *ffn1_up, *ffn1_down, *ffn2_gate, *ffn2_up, *ffn2_down, *w_in, *w_out;
  const float *hy_conv_w, *hy_conv_b, *hy_f_w1, *hy_f_b1, *hy_f_w2, *hy_f_b2, *hy_f_w3, *hy_f_b3, *hy_f_w4, *hy_f_freq, *hy_bias;
  const float *gqa_q_norm, *gqa_k_norm, *mla_cq_norm, *mla_ckv_norm, *mla_w_uq, *mla_w_ukv, *mla_q_norm, *mla_k_norm;
  const float *rw_mu, *rw_w0, *rw_w2, *rw_a0, *rw_a2, *rw_g2, *rw_k_k, *rw_k_a, *rw_r_k, *rw_ln_w, *rw_ln_b;
  float* out;
  char* ws;
};

DI u16 f2bf(float x) {
  unsigned u = __float_as_uint(x);
  u += 0x7fffu + ((u >> 16) & 1u);
  return (u16)(u >> 16);
}
DI float bf2f(u16 b) { return __uint_as_float(((unsigned)b) << 16); }
DI unsigned pack2(float a, float b) {
  f32x2_t v = {a, b};
  bf16x2_t r = __builtin_convertvector(v, bf16x2_t);
  return __builtin_bit_cast(unsigned, r);
}
DI int ltid() {
  int t = threadIdx.x;
  asm volatile("" : "+v"(t));
  return t;
}
DI float wave_sum(float v) {
#pragma unroll
  for (int o = 32; o > 0; o >>= 1) v += __shfl_xor(v, o);
  return v;
}
DI float wave_max(float v) {
#pragma unroll
  for (int o = 32; o > 0; o >>= 1) v = fmaxf(v, __shfl_xor(v, o));
  return v;
}
DI float sigmoidf_(float x) { return 1.f / (1.f + expf(-x)); }
DI int crow(int i, int h) { return (i & 3) + 8 * (i >> 2) + 4 * h; }

DI float rope_apply(float val, int idx, int nfreq, int t, int lane) {
  int pi = idx >> 1;
  int row = t >> 6, col = t & 63;
  float pos = pi < nfreq ? (float)row : (float)col;
  int f = pi < nfreq ? pi : pi - nfreq;
  float inv = exp2f(-(float)f / (float)nfreq * 13.287712379549449f);
  float ang = pos * inv;
  float cs = cosf(ang), sn = sinf(ang);
  float other = __shfl_xor(val, 1);
  return (lane & 1) ? other * sn + val * cs : val * cs - other * sn;
}

DI int gu_row(int n, int half) { return (n >> 6) * 128 + ((n >> 5) & 1) * 64 + half * 32 + (n & 31); }
DI void convT(const float* __restrict__ src, int K, int N, u16* __restrict__ dst, int mode, char* smem) {
  float* tile = (float*)smem;
  const int tk = K / 64, tn = (N + 63) / 64;
  const int tid_ = ltid();
  const int j = tid_ & 63, i0 = tid_ >> 6;
  for (int t = blockIdx.x; t < tk * tn; t += gridDim.x) {
    const int k0 = (t / tn) * 64, n0 = (t % tn) * 64;
    for (int i = i0; i < 64; i += 4) {
      int n = n0 + j;
      tile[i * 65 + j] = n < N ? src[(size_t)(k0 + i) * N + n] : 0.f;
    }
    __syncthreads();
    for (int i = i0; i < 64; i += 4) {
      int n = n0 + i;
      if (n < N) {
        int row = mode == 0 ? n : gu_row(n, mode - 1);
        dst[(size_t)row * K + k0 + j] = f2bf(tile[j * 65 + i]);
      }
    }
    __syncthreads();
  }
}

DI void mod_phase(const Params& p, float* __restrict__ mod, char* smem) {
  float* sc = (float*)smem;
  float* red = sc + 9 * 1024;
  const int tid_ = ltid();
  for (int i = tid_; i < 9 * 1024; i += NTHR) {
    float v = i < 8192 ? p.c[i] : p.c_ctx[i - 8192];
    sc[i] = v / (1.f + expf(-v));
  }
  __syncthreads();
  const int lane = tid_ & 63, kp = tid_ >> 6;
  for (int it = blockIdx.x; it < 2 * 144; it += gridDim.x) {
    const int l = it / 144, nb = (it % 144) * 64;
    const float* w = p.ada_w + (size_t)l * 1024 * 9216 + nb + lane;
    float acc[9];
#pragma unroll
    for (int b = 0; b < 9; ++b) acc[b] = 0.f;
    for (int k = kp * 256; k < kp * 256 + 256; ++k) {
      float wv = w[(size_t)k * 9216];
#pragma unroll
      for (int b = 0; b < 9; ++b) acc[b] += sc[b * 1024 + k] * wv;
    }
#pragma unroll
    for (int b = 0; b < 9; ++b) red[(kp * 9 + b) * 64 + lane] = acc[b];
    __syncthreads();
    for (int o = tid_; o < 9 * 64; o += NTHR) {
      int b = o >> 6, ln = o & 63;
      float s = red[(0 * 9 + b) * 64 + ln] + red[(1 * 9 + b) * 64 + ln] + red[(2 * 9 + b) * 64 + ln] + red[(3 * 9 + b) * 64 + ln];
      mod[((size_t)l * 9 + b) * 9216 + nb + ln] = s + p.ada_b[l * 9216 + nb + ln];
    }
    __syncthreads();
  }
}

DI void hyfilt_phase(const Params& p, int l, int L, float* __restrict__ gT, char* smem) {
  float* z = (float*)smem;
  float* h1 = z + 64;
  float* h2 = h1 + 64;
  float* h3 = h2 + 64;
  const float* w1 = p.hy_f_w1 + l * 33 * 64;
  const float* b1 = p.hy_f_b1 + l * 64;
  const float* w2 = p.hy_f_w2 + l * 4096;
  const float* b2 = p.hy_f_b2 + l * 64;
  const float* w3 = p.hy_f_w3 + l * 4096;
  const float* b3 = p.hy_f_b3 + l * 64;
  const float* w4 = p.hy_f_w4 + l * 64 * 512;
  const float* fr = p.hy_f_freq + l * 64;
  const int tid = ltid();
  const float min_decay = logf(1e-2f) / 1.5f, max_decay = logf(1e-2f) / 0.3f;
  for (int t = blockIdx.x; t < L; t += gridDim.x) {
    const float t01 = (float)t / (float)(L - 1);
    if (tid < 33) {
      float zz;
      if (tid == 0) zz = t01;
      else {
        int i = (tid - 1) & 15;
        float f = 1e-4f + (float)i * ((15.f - 1e-4f) / 15.f);
        float wang = 6.283185307179586f * (float)t / (float)L;
        zz = tid <= 16 ? cosf(f * wang) : -sinf(f * wang);
      }
      z[tid] = zz;
    }
    __syncthreads();
    if (tid < 64) {
      float a = b1[tid];
#pragma unroll 1
      for (int i = 0; i < 33; ++i) a += z[i] * w1[i * 64 + tid];
      h1[tid] = sinf(fr[tid] * a);
    }
    __syncthreads();
    if (tid < 64) {
      float a = b2[tid];
#pragma unroll 1
      for (int i = 0; i < 64; ++i) a += h1[i] * w2[i * 64 + tid];
      h2[tid] = sinf(fr[tid] * a);
    }
    __syncthreads();
    if (tid < 64) {
      float a = b3[tid];
#pragma unroll 1
      for (int i = 0; i < 64; ++i) a += h2[i] * w3[i * 64 + tid];
      h3[tid] = sinf(fr[tid] * a);
    }
    __syncthreads();
    float af = 0.f, ab = 0.f;
#pragma unroll 2
    for (int i = 0; i < 64; ++i) {
      af += h3[i] * w4[i * 512 + tid];
      ab += h3[i] * w4[i * 512 + 256 + tid];
    }
    float delta = fabsf(min_decay + (max_decay - min_decay) * (float)tid / 255.f);
    float dec = expf(-t01 * delta);
    af *= dec;
    ab *= dec;
    if (t == 0) gT[(size_t)(L - 1) * 256 + tid] = af + ab;
    else {
      gT[(size_t)(L - 1 + t) * 256 + tid] = af;
      gT[(size_t)(L - 1 - t) * 256 + tid] = ab;
    }
    __syncthreads();
  }
}

DI void adaln_phase(const float* __restrict__ lat, const float* __restrict__ ctxp, const float* __restrict__ gain,
                    const float* __restrict__ modl, int idx, u16* __restrict__ h, bool skip_ctx) {
  const int tid_ = ltid();
  const int wave = tid_ >> 6, lane = tid_ & 63;
  for (int r = blockIdx.x * 4 + wave; r < T; r += gridDim.x * 4) {
    const int b = r / LT, j = r - b * LT;
    if (skip_ctx && j < LC) continue;
    const float* xr = j < LC ? ctxp + ((size_t)(b * LC + j) << 10) : lat + ((size_t)(b * LQ + j - LC) << 10);
    const int bb = j < LC ? 8 : b;
    const float* shift = modl + bb * 9216 + (3 * idx) * 1024;
    const float* scale = shift + 1024;
    float4 v[4];
    float ss = 0.f;
#pragma unroll
    for (int q = 0; q < 4; ++q) {
      v[q] = *(const float4*)(xr + q * 256 + lane * 4);
      ss += v[q].x * v[q].x + v[q].y * v[q].y + v[q].z * v[q].z + v[q].w * v[q].w;
    }
    ss = wave_sum(ss);
    const float rstd = rsqrtf(ss * (1.f / 1024.f) + EPS);
#pragma unroll
    for (int q = 0; q < 4; ++q) {
      const int c = q * 256 + lane * 4;
      float4 g = *(const float4*)(gain + c), sc = *(const float4*)(scale + c), sh = *(const float4*)(shift + c);
      float y0 = v[q].x * rstd * g.x * (1.f + sc.x) + sh.x;
      float y1 = v[q].y * rstd * g.y * (1.f + sc.y) + sh.y;
      float y2 = v[q].z * rstd * g.z * (1.f + sc.z) + sh.z;
      float y3 = v[q].w * rstd * g.w * (1.f + sc.w) + sh.w;
      uint2 o;
      o.x = pack2(y0, y1);
      o.y = pack2(y2, y3);
      *(uint2*)(h + (size_t)r * D + c) = o;
    }
  }
}

template <bool PAIRED, class Epi>
DI void gemm_tile(const u16* __restrict__ A, int lda, const u16* __restrict__ Bt, int ldb, int K, int m0, int n0,
                  char* smem, Epi& epi) {
  u16* As = (u16*)smem;
  u16* Bs = As + 2 * 128 * 72;
  const int tid = ltid(), lane = tid & 63, wave = tid >> 6;
  const int wm = wave >> 1, wn = wave & 1, lr = lane & 31, lh = lane >> 5;
  f32x16 acc[2][2];
#pragma unroll
  for (int a = 0; a < 2; ++a)
#pragma unroll
    for (int b = 0; b < 2; ++b)
#pragma unroll
      for (int i = 0; i < 16; ++i) acc[a][b][i] = 0.f;
  const u16* Ag = A + (size_t)m0 * lda;
  const u16* Bg = Bt + (size_t)n0 * ldb;
  uint4 ra[4], rb[4];
  const int lrow = tid >> 3, lkc = (tid & 7) * 8;
#pragma unroll
  for (int i = 0; i < 4; ++i) {
    ra[i] = *(const uint4*)(Ag + (size_t)(lrow + 32 * i) * lda + lkc);
    rb[i] = *(const uint4*)(Bg + (size_t)(lrow + 32 * i) * ldb + lkc);
  }
#pragma unroll
  for (int i = 0; i < 4; ++i) {
    *(uint4*)(As + (lrow + 32 * i) * 72 + lkc) = ra[i];
    *(uint4*)(Bs + (lrow + 32 * i) * 72 + lkc) = rb[i];
  }
  __syncthreads();
  const int nk = K >> 6;
  for (int kt = 0; kt < nk; ++kt) {
    const int buf = kt & 1;
    if (kt + 1 < nk) {
      const int k0 = (kt + 1) << 6;
#pragma unroll
      for (int i = 0; i < 4; ++i) {
        ra[i] = *(const uint4*)(Ag + (size_t)(lrow + 32 * i) * lda + k0 + lkc);
        rb[i] = *(const uint4*)(Bg + (size_t)(lrow + 32 * i) * ldb + k0 + lkc);
      }
    }
    const u16* as = As + buf * 128 * 72 + (wm * 64 + lr) * 72 + lh * 8;
    const u16* bs = Bs + buf * 128 * 72 + (wn * 64 + lr) * 72 + lh * 8;
#pragma unroll
    for (int ks = 0; ks < 4; ++ks) {
      bf16x8 a0 = *(const bf16x8*)(as + ks * 16);
      bf16x8 a1 = *(const bf16x8*)(as + 32 * 72 + ks * 16);
      bf16x8 b0 = *(const bf16x8*)(bs + ks * 16);
      bf16x8 b1 = *(const bf16x8*)(bs + 32 * 72 + ks * 16);
      acc[0][0] = MFMA32(a0, b0, acc[0][0]);
      acc[0][1] = MFMA32(a0, b1, acc[0][1]);
      acc[1][0] = MFMA32(a1, b0, acc[1][0]);
      acc[1][1] = MFMA32(a1, b1, acc[1][1]);
    }
    if (kt + 1 < nk) {
      u16* ad = As + (buf ^ 1) * 128 * 72;
      u16* bd = Bs + (buf ^ 1) * 128 * 72;
#pragma unroll
      for (int i = 0; i < 4; ++i) {
        *(uint4*)(ad + (lrow + 32 * i) * 72 + lkc) = ra[i];
        *(uint4*)(bd + (lrow + 32 * i) * 72 + lkc) = rb[i];
      }
    }
    __syncthreads();
  }
#pragma unroll
  for (int mi = 0; mi < 2; ++mi) {
#pragma unroll
    for (int i = 0; i < 16; ++i) {
      const int row = m0 + wm * 64 + mi * 32 + crow(i, lh);
      if (PAIRED) {
        const int col = (n0 >> 1) + wn * 32 + lr;
        epi.pair(row, col, acc[mi][0][i], acc[mi][1][i]);
      } else {
        epi(row, n0 + wn * 64 + lr, acc[mi][0][i]);
        epi(row, n0 + wn * 64 + 32 + lr, acc[mi][1][i]);
      }
    }
  }
}

template <bool PAIRED, class Epi>
DI void gemm_phase(const u16* A, int lda, const u16* Bt, int ldb, int K, int mtiles, int ntiles, int mt_off, bool skip_ctx,
                   char* smem, Epi& epi) {
  const int total = mtiles * ntiles;
  for (int t = blockIdx.x; t < total; t += gridDim.x) {
    const int mt = t / ntiles, nt = t - mt * ntiles;
    if (skip_ctx && ((mt + mt_off) % 34) < 2) continue;
    gemm_tile<PAIRED>(A, lda, Bt, ldb, K, mt * 128, nt * 128, smem, epi);
  }
}

struct EpiGU {
  u16* G;
  DI void pair(int row, int col, float g, float u) const {
    float s = g / (1.f + __expf(-g));
    G[(size_t)row * DFF + col] = f2bf(s * u);
  }
  DI void operator()(int, int, float) const {}
};
struct EpiRes {
  const float* lat_in; const float* ctx_in; float* lat_out; float* ctx_out; const float* modl; int gate_chunk; float coef;
  DI void operator()(int row, int col, float v) const {
    const int b = row / LT, j = row - b * LT;
    const int bb = j < LC ? 8 : b;
    const float gate = modl[bb * 9216 + gate_chunk * 1024 + col];
    const size_t off = j < LC ? (((size_t)(b * LC + j)) << 10) + col : (((size_t)(b * LQ + j - LC)) << 10) + col;
    const float xin = j < LC ? ctx_in[off] : lat_in[off];
    const float y = xin + coef * gate * v;
    if (j < LC) ctx_out[off] = y; else lat_out[off] = y;
  }
  DI void pair(int, int, float, float) const {}
};
struct EpiStore {
  u16* C; int ldc; int N;
  DI void operator()(int row, int col, float v) const { if (col < N) C[(size_t)row * ldc + col] = f2bf(v); }
  DI void pair(int, int, float, float) const {}
};
struct EpiLoraW {
  u16* C; const float* w0;
  DI void operator()(int row, int col, float v) const {
    float zz = -(w0[col] + v);
    float sp = fmaxf(zz, 0.f) + log1pf(expf(-fabsf(zz)));
    C[(size_t)row * 256 + col] = f2bf(expf(-sp - 0.5f));
  }
  DI void pair(int, int, float, float) const {}
};
struct EpiLoraA {
  u16* C; const float* a0;
  DI void operator()(int row, int col, float v) const { C[(size_t)row * 256 + col] = f2bf(sigmoidf_(a0[col] + v)); }
  DI void pair(int, int, float, float) const {}
};

struct MixBufs {
  u16 *p, *u, *qg, *kg, *vtg, *cqn, *ckvn, *qup, *kvup, *qm, *km, *vtm, *rr, *rk, *rv, *rkk, *lwf, *lwb, *laf, *lab, *lg, *ef, *eb, *af, *ab, *gg;
  float *yf, *yb;
};
DI MixBufs mixbufs(char* big) {
  MixBufs m;
  m.p = (u16*)(big + M_P); m.u = (u16*)(big + M_U); m.qg = (u16*)(big + M_QG); m.kg = (u16*)(big + M_KG);
  m.vtg = (u16*)(big + M_VTG); m.cqn = (u16*)(big + M_CQN); m.ckvn = (u16*)(big + M_CKVN); m.qup = (u16*)(big + M_QUP);
  m.kvup = (u16*)(big + M_KVUP); m.qm = (u16*)(big + M_QM); m.km = (u16*)(big + M_KM); m.vtm = (u16*)(big + M_VTM);
  m.rr = (u16*)(big + M_RR); m.rk = (u16*)(big + M_RK); m.rv = (u16*)(big + M_RV); m.rkk = (u16*)(big + M_RKK);
  m.lwf = (u16*)(big + M_LWF); m.lwb = (u16*)(big + M_LWB); m.laf = (u16*)(big + M_LAF); m.lab = (u16*)(big + M_LAB);
  m.lg = (u16*)(big + M_LG); m.ef = (u16*)(big + M_EF); m.eb = (u16*)(big + M_EB); m.af = (u16*)(big + M_AF);
  m.ab = (u16*)(big + M_AB); m.gg = (u16*)(big + M_GG); m.yf = (float*)(big + M_YF); m.yb = (float*)(big + M_YB);
  return m;
}

DI void prep_phase(const Params& p, int l, int g, const MixBufs& m, char* smem) {
  float* red = (float*)smem;
  const int tid = ltid(), lane = tid & 63, wave = tid >> 6;
  const float* cw = p.hy_conv_w + l * 3 * 768;
  const float* cb = p.hy_conv_b + l * 768;
  const float* mu = p.rw_mu + l * 1152;
  for (int rl = blockIdx.x; rl < TG; rl += gridDim.x) {
    const int r = g * TG + rl;
    const int b = r / LT, j = r - b * LT, bl = b - g * BG;
    const bool lat = j >= LC;
    const bool hp = lat ? (j > LC) : (j > 0);
    const bool hn = lat ? (j < LT - 1) : (j < LC - 1);
    const u16* pc = m.p + (size_t)rl * DIN;
    const u16* pp = pc - DIN;
    const u16* pn = pc + DIN;
    {
      const int c0 = tid, c2 = 512 + tid;
      float x1 = bf2f(pc[c0]) * cw[768 + c0] + cb[c0];
      float vv = bf2f(pc[c2]) * cw[768 + c2] + cb[c2];
      if (hp) { x1 += bf2f(pp[c0]) * cw[c0]; vv += bf2f(pp[c2]) * cw[c2]; }
      if (hn) { x1 += bf2f(pn[c0]) * cw[1536 + c0]; vv += bf2f(pn[c2]) * cw[1536 + c2]; }
      m.u[(size_t)rl * 256 + tid] = f2bf(x1 * vv);
    }
    {
      auto tshift = [&](int crel) -> float {
        const int c = 1696 + crel;
        float u0 = bf2f(pc[c]);
        float nb = 0.f;
        if (hp) nb += bf2f(pp[c]);
        if (hn) nb += bf2f(pn[c]);
        return u0 + mu[crel] * (0.5f * nb - u0);
      };
      float sr = tshift(tid), sk = tshift(256 + tid), sv = tshift(512 + tid);
      m.rr[(size_t)rl * 256 + tid] = f2bf(sr);
      m.rk[(size_t)rl * 256 + tid] = f2bf(sk);
      m.rv[(size_t)rl * 256 + tid] = f2bf(sv);
      float kx = sk * p.rw_k_k[l * 256 + tid];
      float ss = wave_sum(kx * kx);
      m.rkk[(size_t)rl * 256 + tid] = f2bf(kx / fmaxf(sqrtf(ss), 1e-12f));
      float s4 = tshift(768 + tid);
      if (tid < 64) m.lwf[(size_t)rl * 64 + tid] = f2bf(tanhf(s4));
      else if (tid < 128) m.lwb[(size_t)rl * 64 + tid - 64] = f2bf(tanhf(s4));
      else if (tid < 192) m.laf[(size_t)rl * 64 + tid - 128] = f2bf(s4);
      else m.lab[(size_t)rl * 64 + tid - 192] = f2bf(s4);
      if (tid < 128) {
        float s5 = tshift(1024 + tid);
        m.lg[(size_t)rl * 128 + tid] = f2bf(sigmoidf_(s5));
      }
    }
    {
      float cq = bf2f(pc[1280 + tid]);
      float ckv = tid < 128 ? bf2f(pc[1536 + tid]) : 0.f;
      float s1 = wave_sum(cq * cq), s2 = wave_sum(ckv * ckv);
      if (lane == 0) { red[wave] = s1; red[4 + wave] = s2; }
      __syncthreads();
      s1 = red[0] + red[1] + red[2] + red[3];
      s2 = red[4] + red[5] + red[6] + red[7];
      __syncthreads();
      m.cqn[(size_t)rl * 256 + tid] = f2bf(cq * rsqrtf(s1 * (1.f / 256.f) + EPS) * p.mla_cq_norm[l * 256 + tid]);
      if (tid < 128) m.ckvn[(size_t)rl * 128 + tid] = f2bf(ckv * rsqrtf(s2 * (1.f / 128.f) + EPS) * p.mla_ckv_norm[l * 128 + tid]);
    }
    for (int hh = wave; hh < 6; hh += 4) {
      float val = bf2f(pc[768 + hh * 64 + lane]);
      float ss = wave_sum(val * val);
      float gn = hh < 4 ? p.gqa_q_norm[l * 64 + lane] : p.gqa_k_norm[l * 64 + lane];
      val = val * rsqrtf(ss * (1.f / 64.f) + EPS) * gn;
      float rv = rope_apply(val, lane, 16, j - LC, lane);
      if (lat) val = rv;
      if (hh < 4) m.qg[(size_t)rl * 256 + hh * 64 + lane] = f2bf(val);
      else m.kg[(size_t)rl * 128 + (hh - 4) * 64 + lane] = f2bf(val);
    }
    if (wave < 2) m.vtg[((size_t)(bl * 2 + wave) * 64 + lane) * LT + j] = pc[1152 + wave * 64 + lane];
  }
}

DI void mla_fin_phase(const Params& p, int l, int g, const MixBufs& m) {
  const int tid = ltid(), lane = tid & 63, wave = tid >> 6;
  for (int rl = blockIdx.x; rl < TG; rl += gridDim.x) {
    const int r = g * TG + rl;
    const int b = r / LT, j = r - b * LT, bl = b - g * BG;
    const bool lat = j >= LC;
    for (int s = wave; s < 8; s += 4) {
      const int hd = s & 3;
      const bool isq = s < 4;
      float x0, x1;
      if (isq) {
        x0 = bf2f(m.qup[(size_t)rl * 384 + hd * 96 + lane]);
        x1 = lane < 32 ? bf2f(m.qup[(size_t)rl * 384 + hd * 96 + 64 + lane]) : 0.f;
      } else {
        x0 = bf2f(m.kvup[(size_t)rl * 512 + hd * 128 + lane]);
        x1 = lane < 32 ? bf2f(m.p[(size_t)rl * DIN + 1664 + lane]) : 0.f;
      }
      float ss = wave_sum(x0 * x0 + x1 * x1);
      const float rstd = rsqrtf(ss * (1.f / 96.f) + EPS);
      const float* gn = isq ? p.mla_q_norm + l * 96 : p.mla_k_norm + l * 96;
      float y0 = x0 * rstd * gn[lane];
      float y1 = lane < 32 ? x1 * rstd * gn[64 + lane] : 0.f;
      float ry = rope_apply(y1, lane & 31, 8, j - LC, lane);
      if (lat) y1 = ry;
      u16* dst = (isq ? m.qm : m.km) + (size_t)rl * 384 + hd * 96;
      dst[lane] = f2bf(y0);
      if (lane < 32) dst[64 + lane] = f2bf(y1);
      if (!isq) m.vtm[((size_t)(bl * 4 + hd) * 64 + lane) * LT + j] = m.kvup[(size_t)rl * 512 + hd * 128 + 64 + lane];
    }
  }
}

template <int DQK, int QT>
DI void attn_item(const u16* __restrict__ q, int ldq, const u16* __restrict__ k, int ldk, const u16* __restrict__ vT,
                  u16* __restrict__ out, int ldo, int nkeys, float sl2, float sh2, char* smem) {
  constexpr int KS = DQK + 8;
  constexpr int NKS = DQK / 16;
  constexpr int KCH = DQK / 8;
  constexpr int KPT = 64 * KCH / NTHR;
  u16* Ks = (u16*)smem;
  u16* Vs = Ks + 2 * 64 * KS;
  const int tid = ltid(), lane = tid & 63, wave = tid >> 6, lr = lane & 31, lh = lane >> 5;
  bf16x8 qf[QT][NKS];
#pragma unroll
  for (int qt = 0; qt < QT; ++qt)
#pragma unroll
    for (int ks = 0; ks < NKS; ++ks)
      qf[qt][ks] = *(const bf16x8*)(q + (size_t)(wave * 32 * QT + qt * 32 + lr) * ldq + ks * 16 + lh * 8);
  f32x16 o[QT][2];
#pragma unroll
  for (int a = 0; a < QT; ++a)
#pragma unroll
    for (int b = 0; b < 2; ++b)
#pragma unroll
      for (int i = 0; i < 16; ++i) o[a][b][i] = 0.f;
  float lsum[QT];
#pragma unroll
  for (int a = 0; a < QT; ++a) lsum[a] = 0.f;
  uint4 rk[KPT], rv[2];
#define ATT_GLOAD(key0)                                                                   \
  {                                                                                       \
    _Pragma("unroll") for (int i = 0; i < KPT; ++i) {                                     \
      const int id = tid + NTHR * i, row = id / KCH, ch = id - row * KCH;                 \
      rk[i] = *(const uint4*)(k + (size_t)((key0) + row) * ldk + ch * 8);                 \
    }                                                                                     \
    _Pragma("unroll") for (int i = 0; i < 2; ++i) {                                       \
      const int id = tid + NTHR * i, row = id >> 3, ch = id & 7;                          \
      rv[i] = *(const uint4*)(vT + (size_t)row * LT + (key0) + ch * 8);                   \
    }                                                                                     \
  }
#define ATT_LSTORE(buf_)                                                                  \
  {                                                                                       \
    _Pragma("unroll") for (int i = 0; i < KPT; ++i) {                                     \
      const int id = tid + NTHR * i, row = id / KCH, ch = id - row * KCH;                 \
      *(uint4*)(Ks + (buf_) * 64 * KS + row * KS + ch * 8) = rk[i];                       \
    }                                                                                     \
    _Pragma("unroll") for (int i = 0; i < 2; ++i) {                                       \
      const int id = tid + NTHR * i, row = id >> 3, ch = id & 7;                          \
      *(uint4*)(Vs + (buf_) * 64 * 72 + row * 72 + ch * 8) = rv[i];                       \
    }                                                                                     \
  }
  ATT_GLOAD(0);
  ATT_LSTORE(0);
  __syncthreads();
  const int nkt = nkeys >> 6;
  for (int kt = 0; kt < nkt; ++kt) {
    const int buf = kt & 1;
    if (kt + 1 < nkt) ATT_GLOAD((kt + 1) << 6);
    const u16* kb = Ks + buf * 64 * KS;
    const u16* vb = Vs + buf * 64 * 72;
#pragma unroll
    for (int half = 0; half < 2; ++half) {
      f32x16 s[QT];
#pragma unroll
      for (int qt = 0; qt < QT; ++qt)
#pragma unroll
        for (int i = 0; i < 16; ++i) s[qt][i] = 0.f;
#pragma unroll
      for (int ks = 0; ks < NKS; ++ks) {
        bf16x8 kf = *(const bf16x8*)(kb + (half * 32 + lr) * KS + ks * 16 + lh * 8);
#pragma unroll
        for (int qt = 0; qt < QT; ++qt) s[qt] = MFMA32(kf, qf[qt][ks], s[qt]);
      }
#pragma unroll
      for (int qt = 0; qt < QT; ++qt)
#pragma unroll
        for (int i = 0; i < 16; ++i) {
          float pv = exp2f(s[qt][i] * sl2 - sh2);
          lsum[qt] += pv;
          s[qt][i] = pv;
        }
#pragma unroll
      for (int st = 0; st < 2; ++st) {
        bf16x8 pb[QT];
#pragma unroll
        for (int qt = 0; qt < QT; ++qt) {
          uint4 w;
          w.x = pack2(s[qt][8 * st + 0], s[qt][8 * st + 1]);
          w.y = pack2(s[qt][8 * st + 2], s[qt][8 * st + 3]);
          w.z = pack2(s[qt][8 * st + 4], s[qt][8 * st + 5]);
          w.w = pack2(s[qt][8 * st + 6], s[qt][8 * st + 7]);
          pb[qt] = __builtin_bit_cast(bf16x8, w);
        }
#pragma unroll
        for (int mt = 0; mt < 2; ++mt) {
          const u16* vp = vb + (mt * 32 + lr) * 72 + half * 32 + st * 16 + lh * 4;
          uint2 v0 = *(const uint2*)(vp);
          uint2 v1 = *(const uint2*)(vp + 8);
          uint4 w;
          w.x = v0.x; w.y = v0.y; w.z = v1.x; w.w = v1.y;
          bf16x8 vf = __builtin_bit_cast(bf16x8, w);
#pragma unroll
          for (int qt = 0; qt < QT; ++qt) o[qt][mt] = MFMA32(vf, pb[qt], o[qt][mt]);
        }
      }
    }
    if (kt + 1 < nkt) ATT_LSTORE(buf ^ 1);
    __syncthreads();
  }
#pragma unroll
  for (int qt = 0; qt < QT; ++qt) {
    float tot = lsum[qt] + __shfl_xor(lsum[qt], 32);
    float inv = 1.f / tot;
    const int row = wave * 32 * QT + qt * 32 + lr;
#pragma unroll
    for (int mt = 0; mt < 2; ++mt)
#pragma unroll
      for (int gq = 0; gq < 4; ++gq) {
        uint2 w;
        w.x = pack2(o[qt][mt][4 * gq + 0] * inv, o[qt][mt][4 * gq + 1] * inv);
        w.y = pack2(o[qt][mt][4 * gq + 2] * inv, o[qt][mt][4 * gq + 3] * inv);
        *(uint2*)(out + (size_t)row * ldo + mt * 32 + 8 * gq + 4 * lh) = w;
      }
  }
}

DI void hyena_item(const Params& p, int l, const MixBufs& m, const float* __restrict__ gT, int L, int rl0  ,
                   int t0, u16* __restrict__ ymix_seg  ) {
  const int c = ltid();
  float acc[16];
#pragma unroll
  for (int i = 0; i < 16; ++i) acc[i] = 0.f;
  const u16* ub = m.u + (size_t)rl0 * 256 + c;
  const float* gb = gT + (size_t)(L - 1 + t0) * 256 + c;
  for (int s0 = 0; s0 < L; s0 += 16) {
    float gw[31];
#pragma unroll
    for (int d = 0; d < 31; ++d) {
      int delta = t0 - s0 + d - 15;
      bool ok = delta >= -(L - 1) && delta <= (L - 1);
      gw[d] = ok ? gb[((long)(d - 15) - s0) * 256] : 0.f;
    }
#pragma unroll
    for (int mm = 0; mm < 16; ++mm) {
      float uv = bf2f(ub[(size_t)(s0 + mm) * 256]);
#pragma unroll
      for (int i = 0; i < 16; ++i) acc[i] += gw[i - mm + 15] * uv;
    }
  }
  const float* cw = p.hy_conv_w + l * 3 * 768;
  const float* cb = p.hy_conv_b + l * 768;
  const float bias = p.hy_bias[l * 256 + c];
  const int c1 = 256 + c;
#pragma unroll
  for (int i = 0; i < 16; ++i) {
    const int t = t0 + i;
    const u16* pc = m.p + (size_t)(rl0 + t) * DIN;
    float x2 = bf2f(pc[c1]) * cw[768 + c1] + cb[c1];
    if (t > 0) x2 += bf2f(pc[c1 - DIN]) * cw[c1];
    if (t < L - 1) x2 += bf2f(pc[c1 + DIN]) * cw[1536 + c1];
    float uv = bf2f(ub[(size_t)t * 256]);
    ymix_seg[(size_t)t * D + c] = f2bf(x2 * (acc[i] + uv * bias));
  }
}

#define DPP_ROR(v, n) __builtin_bit_cast(float, __builtin_amdgcn_update_dpp(0, __builtin_bit_cast(int, (v)), 0x120 + (n), 0xf, 0xf, true))
DI float row_allsum(float v) {
  v += DPP_ROR(v, 8);
  v += DPP_ROR(v, 4);
  v += DPP_ROR(v, 2);
  v += DPP_ROR(v, 1);
  return v;
}
DI float bflo(unsigned w) { return __uint_as_float(w << 16); }
DI float bfhi(unsigned w) { return __uint_as_float(w & 0xffff0000u); }
DI void scan_item(const Params& p, int l, const MixBufs& m, int bl, int hd, int dir, int rq, char* smem) {
  constexpr int TC = 16;
  constexpr int NCH = LT / TC;
  constexpr int BUF = 5 * TC * 64 + TC * 16;
  float* sbase = (float*)smem;
  float* sy = sbase + 2 * BUF;
  const int tid = ltid(), lane = tid & 63, wave = tid >> 6;
  const int kq = lane & 15, rloc = wave * 4 + (lane >> 4);
  const u16* eD = dir ? m.eb : m.ef;
  const u16* aD = dir ? m.ab : m.af;
  float* yD = dir ? m.yb : m.yf;
  const size_t rbase = (size_t)bl * LT;
  const int ss = tid >> 4, su = tid & 15, sc = su & 7;
  float kav[8];
#pragma unroll
  for (int i = 0; i < 8; ++i) kav[i] = p.rw_k_a[l * 256 + hd * 64 + sc * 8 + i];
  uint4 g0, g1, g2;
  g2.x = g2.y = g2.z = g2.w = 0u;
#define SCAN_JMAP(i) (dir ? ((i) < LC ? LC - 1 - (i) : LT - 1 - ((i) - LC)) : (i))
#define SCAN_GLOAD(i0)                                                                         \
  {                                                                                            \
    const int ii_ = (i0) + ss;                                                                 \
    const int j_ = SCAN_JMAP(ii_);                                                             \
    const size_t o_ = (rbase + j_) * 256 + hd * 64 + sc * 8;                                   \
    if (su < 8) {                                                                              \
      g0 = *(const uint4*)(m.rkk + o_);                                                        \
      g1 = *(const uint4*)(aD + o_);                                                           \
      g2 = *(const uint4*)(m.rk + o_);                                                         \
    } else {                                                                                   \
      g0 = *(const uint4*)(eD + o_);                                                           \
      g1 = *(const uint4*)(m.rr + o_);                                                         \
      if (sc < 2) g2 = *(const uint4*)(m.rv + (rbase + j_) * 256 + hd * 64 + rq * 16 + sc * 8); \
    }                                                                                          \
  }
#define SCAN_LSTORE(buf_)                                                                      \
  {                                                                                            \
    float* B_ = sbase + (buf_) * BUF;                                                          \
    const unsigned w0_[4] = {g0.x, g0.y, g0.z, g0.w};                                          \
    const unsigned w1_[4] = {g1.x, g1.y, g1.z, g1.w};                                          \
    const unsigned w2_[4] = {g2.x, g2.y, g2.z, g2.w};                                          \
    if (su < 8) {                                                                              \
      float kk_[8], bb_[8], dd_[8];                                                            \
      _Pragma("unroll") for (int q_ = 0; q_ < 4; ++q_) {                                       \
        const float k0_ = bflo(w0_[q_]), k1_ = bfhi(w0_[q_]);                                  \
        const float a0_ = bflo(w1_[q_]), a1_ = bfhi(w1_[q_]);                                  \
        const float v0_ = bflo(w2_[q_]), v1_ = bfhi(w2_[q_]);                                  \
        kk_[2 * q_] = k0_; kk_[2 * q_ + 1] = k1_;                                              \
        bb_[2 * q_] = k0_ * a0_; bb_[2 * q_ + 1] = k1_ * a1_;                                  \
        dd_[2 * q_] = v0_ * (1.f + (a0_ - 1.f) * kav[2 * q_]);                                 \
        dd_[2 * q_ + 1] = v1_ * (1.f + (a1_ - 1.f) * kav[2 * q_ + 1]);                         \
      }                                                                                        \
      float* d0_ = B_ + ss * 64 + sc * 8;                                                      \
      *(float4*)(d0_) = make_float4(kk_[0], kk_[1], kk_[2], kk_[3]);                           \
      *(float4*)(d0_ + 4) = make_float4(kk_[4], kk_[5], kk_[6], kk_[7]);                       \
      *(float4*)(d0_ + 2048) = make_float4(bb_[0], bb_[1], bb_[2], bb_[3]);                    \
      *(float4*)(d0_ + 2052) = make_float4(bb_[4], bb_[5], bb_[6], bb_[7]);                    \
      *(float4*)(d0_ + 3072) = make_float4(dd_[0], dd_[1], dd_[2], dd_[3]);                    \
      *(float4*)(d0_ + 3076) = make_float4(dd_[4], dd_[5], dd_[6], dd_[7]);                    \
    } else {                                                                                   \
      float ww_[8], rr_[8], vv_[8];                                                            \
      _Pragma("unroll") for (int q_ = 0; q_ < 4; ++q_) {                                       \
        ww_[2 * q_] = expf(-bflo(w0_[q_])); ww_[2 * q_ + 1] = expf(-bfhi(w0_[q_]));            \
        rr_[2 * q_] = bflo(w1_[q_]); rr_[2 * q_ + 1] = bfhi(w1_[q_]);                          \
        vv_[2 * q_] = bflo(w2_[q_]); vv_[2 * q_ + 1] = bfhi(w2_[q_]);                          \
      }                                                                                        \
      float* d0_ = B_ + ss * 64 + sc * 8;                                                      \
      *(float4*)(d0_ + 1024) = make_float4(ww_[0], ww_[1], ww_[2], ww_[3]);                    \
      *(float4*)(d0_ + 1028) = make_float4(ww_[4], ww_[5], ww_[6], ww_[7]);                    \
      *(float4*)(d0_ + 4096) = make_float4(rr_[0], rr_[1], rr_[2], rr_[3]);                    \
      *(float4*)(d0_ + 4100) = make_float4(rr_[4], rr_[5], rr_[6], rr_[7]);                    \
      if (sc < 2) {                                                                            \
        float* d1_ = B_ + 5120 + ss * 16 + sc * 8;                                             \
        *(float4*)(d1_) = make_float4(vv_[0], vv_[1], vv_[2], vv_[3]);                         \
        *(float4*)(d1_ + 4) = make_float4(vv_[4], vv_[5], vv_[6], vv_[7]);                     \
      }                                                                                        \
    }                                                                                          \
  }
  float S0 = 0.f, S1 = 0.f, S2 = 0.f, S3 = 0.f;
  SCAN_GLOAD(0);
  SCAN_LSTORE(0);
  __syncthreads();
  for (int c = 0; c < NCH; ++c) {
    const int buf = c & 1;
    if (c + 1 < NCH) SCAN_GLOAD((c + 1) * TC);
    const float* B = sbase + buf * BUF;
    float* syb = sy + buf * TC * 16;
#pragma unroll
    for (int st = 0; st < TC; ++st) {
      const float4 kk = *(const float4*)(B + st * 64 + kq * 4);
      const float4 ww = *(const float4*)(B + 1024 + st * 64 + kq * 4);
      const float4 bb = *(const float4*)(B + 2048 + st * 64 + kq * 4);
      const float4 dd = *(const float4*)(B + 3072 + st * 64 + kq * 4);
      const float4 rr = *(const float4*)(B + 4096 + st * 64 + kq * 4);
      const float vv = B[5120 + st * 16 + rloc];
      const float part = (S0 * kk.x + S1 * kk.y) + (S2 * kk.z + S3 * kk.w);
      const float c0 = S0 * ww.x + vv * dd.x, c1 = S1 * ww.y + vv * dd.y, c2 = S2 * ww.z + vv * dd.z, c3 = S3 * ww.w + vv * dd.w;
      const float sa = -row_allsum(part);
      S0 = c0 + sa * bb.x;
      S1 = c1 + sa * bb.y;
      S2 = c2 + sa * bb.z;
      S3 = c3 + sa * bb.w;
      const float yp = (S0 * rr.x + S1 * rr.y) + (S2 * rr.z + S3 * rr.w);
      const float y = row_allsum(yp);
      if (kq == 0) syb[st * 16 + rloc] = y;
    }
    if (c + 1 < NCH) SCAN_LSTORE(buf ^ 1);
    __syncthreads();
    {
      const int st = tid >> 4, r_ = tid & 15;
      const int ii = c * TC + st;
      const int j = SCAN_JMAP(ii);
      yD[(rbase + j) * 256 + hd * 64 + rq * 16 + r_] = syb[st * 16 + r_];
    }
  }
  __syncthreads();
}

DI void readout_phase(const Params& p, int l, int g, const MixBufs& m, u16* __restrict__ ymix, bool skip_ctx) {
  const int tid = ltid();
  for (int rl = blockIdx.x; rl < TG; rl += gridDim.x) {
    const int r = g * TG + rl;
    const int j = r % LT;
    if (skip_ctx && j < LC) continue;
    const size_t o = (size_t)rl * 256 + tid;
    float y = m.yf[o] + m.yb[o];
    float mean = wave_sum(y) * (1.f / 64.f);
    float dv = y - mean;
    float var = wave_sum(dv * dv) * (1.f / 64.f);
    float yn = dv * rsqrtf(var + 64e-5f) * p.rw_ln_w[l * 256 + tid] + p.rw_ln_b[l * 256 + tid];
    const float rr = bf2f(m.rr[o]), kv = bf2f(m.rk[o]), vv = bf2f(m.rv[o]);
    const float kaa = p.rw_k_a[l * 256 + tid], rk = p.rw_r_k[l * 256 + tid];
    const float af = bf2f(m.af[o]), ab = bf2f(m.ab[o]);
    float t1 = rr * kv * (1.f + (af - 1.f) * kaa) * rk + rr * kv * (1.f + (ab - 1.f) * kaa) * rk;
    float bonus = wave_sum(t1) * vv;
    ymix[(size_t)r * D + 768 + tid] = f2bf((yn + bonus) * bf2f(m.gg[o]));
  }
}

__global__ void __launch_bounds__(NTHR, 2) fwd_megakernel(Params p) {
  cg::grid_group grid = cg::this_grid();
  __shared__ __attribute__((aligned(16))) char smem[73728];
  __shared__ int s_item;
  char* ws = p.ws;
  float* ctxs = (float*)(ws + OFF_CTX);
  float* mod = (float*)(ws + OFF_MOD);
  u16* hbuf = (u16*)(ws + OFF_H);
  char* big = ws + OFF_BIG;
  u16* Gbuf = (u16*)big;
  const MixBufs m = mixbufs(big);

  if (blockIdx.x == 0 && threadIdx.x < 64) ((int*)(ws + OFF_CNT))[threadIdx.x] = 0;
  for (int rep = 0; rep < REP_MISC; ++rep)
  for (int l = 0; l < 2; ++l) {
    u16* W = (u16*)(ws + OFF_W) + (size_t)l * W_LAYER;
    convT(p.ffn1_gate + (size_t)l * D * DFF, D, DFF, W + W_GU1, 1, smem);
    convT(p.ffn1_up + (size_t)l * D * DFF, D, DFF, W + W_GU1, 2, smem);
    convT(p.ffn1_down + (size_t)l * D * DFF, DFF, D, W + W_D1, 0, smem);
    convT(p.ffn2_gate + (size_t)l * D * DFF, D, DFF, W + W_GU2, 1, smem);
    convT(p.ffn2_up + (size_t)l * D * DFF, D, DFF, W + W_GU2, 2, smem);
    convT(p.ffn2_down + (size_t)l * D * DFF, DFF, D, W + W_D2, 0, smem);
    convT(p.w_in + (size_t)l * D * DIN, D, DIN, W + W_IN, 0, smem);
    convT(p.w_out + (size_t)l * D * D, D, D, W + W_OUT, 0, smem);
    convT(p.mla_w_uq + (size_t)l * 256 * 384, 256, 384, W + W_UQ, 0, smem);
    convT(p.mla_w_ukv + (size_t)l * 128 * 512, 128, 512, W + W_UKV, 0, smem);
    for (int d = 0; d < 2; ++d) {
      convT(p.rw_w2 + (size_t)(l * 2 + d) * 64 * 256, 64, 256, W + W_W2 + (size_t)d * 256 * 64, 0, smem);
      convT(p.rw_a2 + (size_t)(l * 2 + d) * 64 * 256, 64, 256, W + W_A2 + (size_t)d * 256 * 64, 0, smem);
    }
    convT(p.rw_g2 + (size_t)l * 128 * 256, 128, 256, W + W_G2, 0, smem);
    hyfilt_phase(p, l, LQ, (float*)(ws + OFF_FILT + (size_t)l * al(SZ_FILT_L)), smem);
  }
  hyfilt_phase(p, 0, LC, (float*)(ws + OFF_FILTC), smem);
  mod_phase(p, mod, smem);
  grid.sync();

  for (int l = 0; l < 2; ++l) {
    const bool last = (l == 1);
    const u16* W = (u16*)(ws + OFF_W) + (size_t)l * W_LAYER;
    const float* modl = mod + (size_t)l * 9 * 9216;
    const float* lat_in = (l == 0) ? p.x : p.out;
    const float* ctx_in = (l == 0) ? p.ctx : ctxs;

    adaln_phase(lat_in, ctx_in, p.norm_ffn1 + l * D, modl, 0, hbuf, false);
    grid.sync();
    {
      EpiGU e{Gbuf};
      for (int rep = 0; rep < REP_GU; ++rep) gemm_phase<true>(hbuf, D, W + W_GU1, D, D, T / 128, 44, 0, false, smem, e);
    }
    grid.sync();
    {
      EpiRes e{lat_in, ctx_in, p.out, ctxs, modl, 2, 0.5f};
      gemm_phase<false>(Gbuf, DFF, W + W_D1, DFF, DFF, T / 128, 8, 0, false, smem, e);
    }
    grid.sync();
    adaln_phase(p.out, ctxs, p.norm_mix + l * D, modl, 1, hbuf, false);
    grid.sync();
    for (int g = 0; g < NG; ++g) {
      const u16* hg = hbuf + (size_t)g * TG * D;
      {
        EpiStore e{m.p, DIN, DIN};
        gemm_phase<false>(hg, D, W + W_IN, D, D, TG / 128, 23, 0, false, smem, e);
      }
      grid.sync();
      prep_phase(p, l, g, m, smem);
      grid.sync();
      {
        EpiStore e1{m.qup, 384, 384};
        gemm_phase<false>(m.cqn, 256, W + W_UQ, 256, 256, TG / 128, 3, 0, false, smem, e1);
        EpiStore e2{m.kvup, 512, 512};
        gemm_phase<false>(m.ckvn, 128, W + W_UKV, 128, 128, TG / 128, 4, 0, false, smem, e2);
        EpiLoraW e3{m.ef, p.rw_w0 + (l * 2 + 0) * 256};
        gemm_phase<false>(m.lwf, 64, W + W_W2, 64, 64, TG / 128, 2, 0, false, smem, e3);
        EpiLoraW e4{m.eb, p.rw_w0 + (l * 2 + 1) * 256};
        gemm_phase<false>(m.lwb, 64, W + W_W2 + 256 * 64, 64, 64, TG / 128, 2, 0, false, smem, e4);
        EpiLoraA e5{m.af, p.rw_a0 + (l * 2 + 0) * 256};
        gemm_phase<false>(m.laf, 64, W + W_A2, 64, 64, TG / 128, 2, 0, false, smem, e5);
        EpiLoraA e6{m.ab, p.rw_a0 + (l * 2 + 1) * 256};
        gemm_phase<false>(m.lab, 64, W + W_A2 + 256 * 64, 64, 64, TG / 128, 2, 0, false, smem, e6);
        EpiStore e7{m.gg, 256, 256};
        gemm_phase<false>(m.lg, 128, W + W_G2, 128, 128, TG / 128, 2, 0, false, smem, e7);
      }
      grid.sync();
      mla_fin_phase(p, l, g, m);
      grid.sync();
      {
        u16* ymix = hbuf;
        const int n_scan = BG * 4 * 2 * 4;
        const int qt_per_b = last ? 32 : 34;
        const int n_att = BG * 4 * qt_per_b;
        const int hy_per_b = last ? 256 : 272;
        const int n_hy = BG * hy_per_b;
        const int total = n_scan + 2 * n_att + n_hy;
        float gq = 0.f, gk = 0.f, mq = 0.f, mk = 0.f;
        for (int i = 0; i < 64; ++i) { gq = fmaxf(gq, fabsf(p.gqa_q_norm[l * 64 + i])); gk = fmaxf(gk, fabsf(p.gqa_k_norm[l * 64 + i])); }
        for (int i = 0; i < 96; ++i) { mq = fmaxf(mq, fabsf(p.mla_q_norm[l * 96 + i])); mk = fmaxf(mk, fabsf(p.mla_k_norm[l * 96 + i])); }
        const float L2E = 1.4426950408889634f;
        const float sc_g = 0.125f, sc_m = 0.10206207261596575f;
        const float sh_g = (64.f * gq * gk * sc_g * 1.02f + 0.5f) * L2E;
        const float sh_m = (96.f * mq * mk * sc_m * 1.02f + 0.5f) * L2E;
        int* cnt = (int*)(ws + OFF_CNT) + (l * NG + g);
        for (;;) {
          if (threadIdx.x == 0) s_item = atomicAdd(cnt, 1);
          __syncthreads();
          const int it = s_item;
          __syncthreads();
          if (it >= total) break;
          if (it < n_scan) {
            const int bl = it >> 5, hd = (it >> 3) & 3, dir = (it >> 2) & 1, rq = it & 3;
            scan_item(p, l, m, bl, hd, dir, rq, smem);
          } else if (it < n_scan + 2 * n_att) {
            int a = it - n_scan;
            const int kind = a / n_att;
            a -= kind * n_att;
            const int bl = a / (4 * qt_per_b);
            int rem = a - bl * 4 * qt_per_b;
            const int hd = rem / qt_per_b;
            const int qt = rem - hd * qt_per_b;
            const int j0 = qt < 32 ? LC + qt * 128 : (qt - 32) * 128;
            const int nkeys = qt < 32 ? LT : LC;
            const size_t rl0 = (size_t)bl * LT + j0;
            const size_t rg0 = (size_t)(g * BG + bl) * LT + j0;
            if (kind == 0) {
              const int kvh = hd >> 1;
              attn_item<64, 1>(m.qg + rl0 * 256 + hd * 64, 256, m.kg + (size_t)bl * LT * 128 + kvh * 64, 128,
                            m.vtg + (size_t)(bl * 2 + kvh) * 64 * LT, ymix + rg0 * D + 256 + hd * 64, D, nkeys, sc_g * L2E, sh_g, smem);
            } else {
              attn_item<96, 1>(m.qm + rl0 * 384 + hd * 96, 384, m.km + (size_t)bl * LT * 384 + hd * 96, 384,
                            m.vtm + (size_t)(bl * 4 + hd) * 64 * LT, ymix + rg0 * D + 512 + hd * 64, D, nkeys, sc_m * L2E, sh_m, smem);
            }
          } else {
            int a = it - n_scan - 2 * n_att;
            const int bl = a / hy_per_b;
            const int tt = a - bl * hy_per_b;
            const size_t rg = (size_t)(g * BG + bl) * LT;
            if (tt < 256) {
              hyena_item(p, l, m, (const float*)(ws + OFF_FILT + (size_t)l * al(SZ_FILT_L)), LQ, bl * LT + LC, tt * 16, ymix + (rg + LC) * D);
            } else {
              hyena_item(p, l, m, (const float*)(ws + OFF_FILTC), LC, bl * LT, (tt - 256) * 16, ymix + rg * D);
            }
          }
        }
        grid.sync();
        readout_phase(p, l, g, m, ymix, last);
        grid.sync();
      }
    }
    {
      EpiRes e{p.out, ctxs, p.out, ctxs, modl, 5, 1.0f};
      gemm_phase<false>(hbuf, D, W + W_OUT, D, D, T / 128, 8, 0, last, smem, e);
    }
    grid.sync();
    adaln_phase(p.out, ctxs, p.norm_ffn2 + l * D, modl, 2, hbuf, last);
    grid.sync();
    {
      EpiGU e{Gbuf};
      for (int rep = 0; rep < REP_GU; ++rep) gemm_phase<true>(hbuf, D, W + W_GU2, D, D, T / 128, 44, 0, last, smem, e);
    }
    grid.sync();
    {
      EpiRes e{p.out, ctxs, p.out, ctxs, modl, 8, 0.5f};
      gemm_phase<false>(Gbuf, DFF, W + W_D2, DFF, DFF, T / 128, 8, 0, last, smem, e);
    }
    grid.sync();
  }
}

extern "C" void kernel_launch(void* const* d_in, const int* in_sizes, int n_in, void* d_out, int out_size, void* d_ws,
                              size_t ws_size, hipStream_t stream) {
  static int grid_blocks = 0;
  if (!grid_blocks) {
    int dev = 0, cus = 0, per_cu = 0;
    (void)hipGetDevice(&dev);
    (void)hipDeviceGetAttribute(&cus, hipDeviceAttributeMultiprocessorCount, dev);
    (void)hipOccupancyMaxActiveBlocksPerMultiprocessor(&per_cu, fwd_megakernel, NTHR, 0);
    if (per_cu > 2) per_cu = 2;
    if (per_cu < 1) per_cu = 1;
    grid_blocks = cus * per_cu;
  }
  Params p{};
  const float** pp = (const float**)&p;
  for (int i = 0; i < 47; ++i) pp[i] = (const float*)d_in[i];
  p.out = (float*)d_out;
  p.ws = (char*)d_ws;
  void* args[] = {&p};
  hipError_t e = hipLaunchCooperativeKernel((void*)fwd_megakernel, dim3(grid_blocks), dim3(NTHR), args, 0, stream);
  if (e != hipSuccess) fprintf(stderr, "cooperative launch failed: %s (grid %d)\n", hipGetErrorString(e), grid_blocks);
}
```

```cpp
#include <hip/hip_runtime.h>
#include <hip/hip_bf16.h>
#include <hip/hip_cooperative_groups.h>
#include <cstdio>
namespace cg = cooperative_groups;

#define DI __device__ __forceinline__
typedef unsigned short u16;
using bf16x8 = __attribute__((ext_vector_type(8))) short;
using f32x16 = __attribute__((ext_vector_type(16))) float;
typedef __bf16 bf16x2_t __attribute__((ext_vector_type(2)));
typedef float f32x2_t __attribute__((ext_vector_type(2)));
#define MFMA32(a, b, c) __builtin_amdgcn_mfma_f32_32x32x16_bf16((a), (b), (c), 0, 0, 0)

constexpr int D = 1024, NB = 8, LQ = 4096, LC = 256, LT = 4352, T = NB * LT, DFF = 2816, DIN = 2848;
constexpr int HYC = 768, DINP = DIN - HYC;
constexpr int NG = 2, BG = NB / NG, TG = BG * LT;
constexpr int NTHR = 256;
#define REP_MIX 1
#define REP_GU 1
#define REP_MISC 1
#define REP_ROW 1
constexpr float EPS = 1e-6f;

constexpr size_t al(size_t x) { return (x + 255) & ~(size_t)255; }
constexpr size_t OFF_CTX = 0;
constexpr size_t OFF_MOD = OFF_CTX + al((size_t)NB * LC * D * 4);
constexpr size_t SZ_FILT_L = (size_t)(2 * LQ - 1) * 256 * 4;
constexpr size_t SZ_FILT_C = (size_t)(2 * LC - 1) * 256 * 4;
constexpr size_t OFF_CNT = OFF_MOD + al((size_t)2 * 9 * 9216 * 4);
constexpr size_t OFF_FILT = OFF_CNT + 256;
constexpr size_t OFF_FILTC = OFF_FILT + 2 * al(SZ_FILT_L);
constexpr size_t OFF_W = OFF_FILTC + al(SZ_FILT_C);
constexpr size_t W_GU1 = 0;
constexpr size_t W_D1 = W_GU1 + (size_t)5632 * 1024;
constexpr size_t W_GU2 = W_D1 + (size_t)1024 * 2816;
constexpr size_t W_D2 = W_GU2 + (size_t)5632 * 1024;
constexpr size_t W_IN = W_D2 + (size_t)1024 * 2816;
constexpr size_t W_OUT = W_IN + (size_t)2944 * 1024;
constexpr size_t W_UQ = W_OUT + (size_t)1024 * 1024;
constexpr size_t W_UKV = W_UQ + (size_t)384 * 256;
constexpr size_t W_W2 = W_UKV + (size_t)512 * 128;
constexpr size_t W_A2 = W_W2 + (size_t)2 * 256 * 64;
constexpr size_t W_G2 = W_A2 + (size_t)2 * 256 * 64;
constexpr size_t W_LAYER = W_G2 + (size_t)256 * 128;
constexpr size_t OFF_H = OFF_W + al(2 * W_LAYER * 2);
constexpr size_t OFF_BIG = OFF_H + al((size_t)T * D * 2);
constexpr size_t M_P = 0;
constexpr size_t M_PT = M_P + al((size_t)TG * DINP * 2);
constexpr size_t M_U = M_PT + al((size_t)HYC * TG * 2);
constexpr size_t M_QG = M_U + al((size_t)TG * 256 * 2);
constexpr size_t M_KG = M_QG + al((size_t)TG * 256 * 2);
constexpr size_t M_VTG = M_KG + al((size_t)TG * 128 * 2);
constexpr size_t M_CQN = M_VTG + al((size_t)TG * 128 * 2);
constexpr size_t M_CKVN = M_CQN + al((size_t)TG * 256 * 2);
constexpr size_t M_QUP = M_CKVN + al((size_t)TG * 128 * 2);
constexpr size_t M_KVUP = M_QUP + al((size_t)TG * 384 * 2);
constexpr size_t M_QM = M_KVUP + al((size_t)TG * 512 * 2);
constexpr size_t M_KM = M_QM + al((size_t)TG * 384 * 2);
constexpr size_t M_VTM = M_KM + al((size_t)TG * 384 * 2);
constexpr size_t M_RR = M_VTM + al((size_t)TG * 256 * 2);
constexpr size_t M_RK = M_RR + al((size_t)TG * 256 * 2);
constexpr size_t M_RV = M_RK + al((size_t)TG * 256 * 2);
constexpr size_t M_RKK = M_RV + al((size_t)TG * 256 * 2);
constexpr size_t M_LWF = M_RKK + al((size_t)TG * 256 * 2);
constexpr size_t M_LWB = M_LWF + al((size_t)TG * 64 * 2);
constexpr size_t M_LAF = M_LWB + al((size_t)TG * 64 * 2);
constexpr size_t M_LAB = M_LAF + al((size_t)TG * 64 * 2);
constexpr size_t M_LG = M_LAB + al((size_t)TG * 64 * 2);
constexpr size_t M_EF = M_LG + al((size_t)TG * 128 * 2);
constexpr size_t M_EB = M_EF + al((size_t)TG * 256 * 2);
constexpr size_t M_AF = M_EB + al((size_t)TG * 256 * 2);
constexpr size_t M_AB = M_AF + al((size_t)TG * 256 * 2);
constexpr size_t M_GG = M_AB + al((size_t)TG * 256 * 2);
constexpr size_t M_YF = M_GG + al((size_t)TG * 256 * 2);
constexpr size_t M_YB = M_YF + al((size_t)TG * 256 * 4);
constexpr size_t M_END = M_YB + al((size_t)TG * 256 * 4);
constexpr size_t SZ_G = (size_t)T * DFF * 2;
constexpr size_t WS_NEED = OFF_BIG + (M_END > SZ_G ? M_END : SZ_G);
static_assert(WS_NEED <= (size_t)512 * 1024 * 1024, "workspace too large");

struct Params {
  const float *x, *c, *ctx, *c_ctx, *ada_w, *ada_b, *norm_ffn1, *norm_mix, *norm_ffn2;
  const float *ffn1_gate, *ffn1_up, *ffn1_down, *ffn2_gate, *ffn2_up, *ffn2_down, *w_in, *w_out;
  const float *hy_conv_w, *hy_conv_b, *hy_f_w1, *hy_f_b1, *hy_f_w2, *hy_f_b2, *hy_f_w3, *hy_f_b3, *hy_f_w4, *hy_f_freq, *hy_bias;
  const float *gqa_q_norm, *gqa_k_norm, *mla_cq_norm, *mla_ckv_norm, *mla_w_uq, *mla_w_ukv, *mla_q_norm, *mla_k_norm;
  const float *rw_mu, *rw_w0, *rw_w2, *rw_a0, *rw_a2, *rw_g2, *rw_k_k, *rw_k_a, *rw_r_k, *rw_ln_w, *rw_ln_b;
  float* out;
  char* ws;
};

DI u16 f2bf(float x) {
  unsigned u = __float_as_uint(x);
  u += 0x7fffu + ((u >> 16) & 1u);
  return (u16)(u >> 16);
}
DI float bf2f(u16 b) { return __uint_as_float(((unsigned)b) << 16); }
DI float bflo_(unsigned w) { return __uint_as_float(w << 16); }
DI float bfhi_(unsigned w) { return __uint_as_float(w & 0xffff0000u); }
DI unsigned pack2(float a, float b) {
  f32x2_t v = {a, b};
  bf16x2_t r = __builtin_convertvector(v, bf16x2_t);
  return __builtin_bit_cast(unsigned, r);
}
DI int ltid() {
  int t = threadIdx.x;
  asm volatile("" : "+v"(t));
  return t;
}
DI float wave_sum(float v) {
#pragma unroll
  for (int o = 32; o > 0; o >>= 1) v += __shfl_xor(v, o);
  return v;
}
DI float wave_max(float v) {
#pragma unroll
  for (int o = 32; o > 0; o >>= 1) v = fmaxf(v, __shfl_xor(v, o));
  return v;
}
DI float sigmoidf_(float x) { return 1.f / (1.f + expf(-x)); }
DI int crow(int i, int h) { return (i & 3) + 8 * (i >> 2) + 4 * h; }

DI float rope_apply(float val, int idx, int nfreq, int t, int lane) {
  int pi = idx >> 1;
  int row = t >> 6, col = t & 63;
  float pos = pi < nfreq ? (float)row : (float)col;
  int f = pi < nfreq ? pi : pi - nfreq;
  float inv = exp2f(-(float)f / (float)nfreq * 13.287712379549449f);
  float ang = pos * inv;
  float cs = cosf(ang), sn = sinf(ang);
  float other = __shfl_xor(val, 1);
  return (lane & 1) ? other * sn + val * cs : val * cs - other * sn;
}

DI int gu_row(int n, int half) { return (n >> 6) * 128 + ((n >> 5) & 1) * 64 + half * 32 + (n & 31); }
DI void convT(const float* __restrict__ src, int K, int N, u16* __restrict__ dst, int mode, char* smem) {
  float* tile = (float*)smem;
  const int tk = K / 64, tn = (N + 63) / 64;
  const int tid_ = ltid();
  const int j = tid_ & 63, i0 = tid_ >> 6;
  for (int t = blockIdx.x; t < tk * tn; t += gridDim.x) {
    const int k0 = (t / tn) * 64, n0 = (t % tn) * 64;
    for (int i = i0; i < 64; i += 4) {
      int n = n0 + j;
      tile[i * 65 + j] = n < N ? src[(size_t)(k0 + i) * N + n] : 0.f;
    }
    __syncthreads();
    for (int i = i0; i < 64; i += 4) {
      int n = n0 + i;
      if (n < N) {
        int row = mode == 0 ? n : gu_row(n, mode - 1);
        dst[(size_t)row * K + k0 + j] = f2bf(tile[j * 65 + i]);
      }
    }
    __syncthreads();
  }
}

DI void mod_phase(const Params& p, float* __restrict__ mod, char* smem) {
  float* sc = (float*)smem;
  float* red = sc + 9 * 1024;
  const int tid_ = ltid();
  for (int i = tid_; i < 9 * 1024; i += NTHR) {
    float v = i < 8192 ? p.c[i] : p.c_ctx[i - 8192];
    sc[i] = v / (1.f + expf(-v));
  }
  __syncthreads();
  const int lane = tid_ & 63, kp = tid_ >> 6;
  for (int it = blockIdx.x; it < 2 * 144; it += gridDim.x) {
    const int l = it / 144, nb = (it % 144) * 64;
    const float* w = p.ada_w + (size_t)l * 1024 * 9216 + nb + lane;
    float acc[9];
#pragma unroll
    for (int b = 0; b < 9; ++b) acc[b] = 0.f;
    for (int k = kp * 256; k < kp * 256 + 256; ++k) {
      float wv = w[(size_t)k * 9216];
#pragma unroll
      for (int b = 0; b < 9; ++b) acc[b] += sc[b * 1024 + k] * wv;
    }
#pragma unroll
    for (int b = 0; b < 9; ++b) red[(kp * 9 + b) * 64 + lane] = acc[b];
    __syncthreads();
    for (int o = tid_; o < 9 * 64; o += NTHR) {
      int b = o >> 6, ln = o & 63;
      float s = red[(0 * 9 + b) * 64 + ln] + red[(1 * 9 + b) * 64 + ln] + red[(2 * 9 + b) * 64 + ln] + red[(3 * 9 + b) * 64 + ln];
      mod[((size_t)l * 9 + b) * 9216 + nb + ln] = s + p.ada_b[l * 9216 + nb + ln];
    }
    __syncthreads();
  }
}

DI void hyfilt_phase(const Params& p, int l, int L, float* __restrict__ gT, char* smem) {
  float* z = (float*)smem;
  float* h1 = z + 64;
  float* h2 = h1 + 64;
  float* h3 = h2 + 64;
  const float* w1 = p.hy_f_w1 + l * 33 * 64;
  const float* b1 = p.hy_f_b1 + l * 64;
  const float* w2 = p.hy_f_w2 + l * 4096;
  const float* b2 = p.hy_f_b2 + l * 64;
  const float* w3 = p.hy_f_w3 + l * 4096;
  const float* b3 = p.hy_f_b3 + l * 64;
  const float* w4 = p.hy_f_w4 + l * 64 * 512;
  const float* fr = p.hy_f_freq + l * 64;
  const int tid = ltid();
  const float min_decay = logf(1e-2f) / 1.5f, max_decay = logf(1e-2f) / 0.3f;
  for (int t = blockIdx.x; t < L; t += gridDim.x) {
    const float t01 = (float)t / (float)(L - 1);
    if (tid < 33) {
      float zz;
      if (tid == 0) zz = t01;
      else {
        int i = (tid - 1) & 15;
        float f = 1e-4f + (float)i * ((15.f - 1e-4f) / 15.f);
        float wang = 6.283185307179586f * (float)t / (float)L;
        zz = tid <= 16 ? cosf(f * wang) : -sinf(f * wang);
      }
      z[tid] = zz;
    }
    __syncthreads();
    if (tid < 64) {
      float a = b1[tid];
#pragma unroll 1
      for (int i = 0; i < 33; ++i) a += z[i] * w1[i * 64 + tid];
      h1[tid] = sinf(fr[tid] * a);
    }
    __syncthreads();
    if (tid < 64) {
      float a = b2[tid];
#pragma unroll 1
      for (int i = 0; i < 64; ++i) a += h1[i] * w2[i * 64 + tid];
      h2[tid] = sinf(fr[tid] * a);
    }
    __syncthreads();
    if (tid < 64) {
      float a = b3[tid];
#pragma unroll 1
      for (int i = 0; i < 64; ++i) a += h2[i] * w3[i * 64 + tid];
      h3[tid] = sinf(fr[tid] * a);
    }
    __syncthreads();
    float af = 0.f, ab = 0.f;
#pragma unroll 2
    for (int i = 0; i < 64; ++i) {
      af += h3[i] * w4[i * 512 + tid];
      ab += h3[i] * w4[i * 512 + 256 + tid];
    }
    float delta = fabsf(min_decay + (max_decay - min_decay) * (float)tid / 255.f);
    float dec = expf(-t01 * delta);
    af *= dec;
    ab *= dec;
    if (t == 0) gT[(size_t)(L - 1) * 256 + tid] = af + ab;
    else {
      gT[(size_t)(L - 1 + t) * 256 + tid] = af;
      gT[(size_t)(L - 1 - t) * 256 + tid] = ab;
    }
    __syncthreads();
  }
}

DI void adaln_phase(const float* __restrict__ lat, const float* __restrict__ ctxp, const float* __restrict__ gain,
                    const float* __restrict__ modl, int idx, u16* __restrict__ h, bool skip_ctx) {
  const int tid_ = ltid();
  const int wave = tid_ >> 6, lane = tid_ & 63;
  for (int r = blockIdx.x * 4 + wave; r < T; r += gridDim.x * 4) {
    const int b = r / LT, j = r - b * LT;
    if (skip_ctx && j < LC) continue;
    const float* xr = j < LC ? ctxp + ((size_t)(b * LC + j) << 10) : lat + ((size_t)(b * LQ + j - LC) << 10);
    const int bb = j < LC ? 8 : b;
    const float* shift = modl + bb * 9216 + (3 * idx) * 1024;
    const float* scale = shift + 1024;
    float4 v[4];
    float ss = 0.f;
#pragma unroll
    for (int q = 0; q < 4; ++q) {
      v[q] = *(const float4*)(xr + q * 256 + lane * 4);
      ss += v[q].x * v[q].x + v[q].y * v[q].y + v[q].z * v[q].z + v[q].w * v[q].w;
    }
    ss = wave_sum(ss);
    const float rstd = rsqrtf(ss * (1.f / 1024.f) + EPS);
#pragma unroll
    for (int q = 0; q < 4; ++q) {
      const int c = q * 256 + lane * 4;
      float4 g = *(const float4*)(gain + c), sc = *(const float4*)(scale + c), sh = *(const float4*)(shift + c);
      float y0 = v[q].x * rstd * g.x * (1.f + sc.x) + sh.x;
      float y1 = v[q].y * rstd * g.y * (1.f + sc.y) + sh.y;
      float y2 = v[q].z * rstd * g.z * (1.f + sc.z) + sh.z;
      float y3 = v[q].w * rstd * g.w * (1.f + sc.w) + sh.w;
      uint2 o;
      o.x = pack2(y0, y1);
      o.y = pack2(y2, y3);
      *(uint2*)(h + (size_t)r * D + c) = o;
    }
  }
}

template <bool PAIRED, class Epi>
DI void gemm_tile(const u16* __restrict__ A, int lda, const u16* __restrict__ Bt, int ldb, int K, int m0, int n0,
                  char* smem, Epi& epi) {
  u16* As = (u16*)smem;
  u16* Bs = As + 2 * 128 * 72;
  const int tid = ltid(), lane = tid & 63, wave = tid >> 6;
  const int wm = wave >> 1, wn = wave & 1, lr = lane & 31, lh = lane >> 5;
  f32x16 acc[2][2];
#pragma unroll
  for (int a = 0; a < 2; ++a)
#pragma unroll
    for (int b = 0; b < 2; ++b)
#pragma unroll
      for (int i = 0; i < 16; ++i) acc[a][b][i] = 0.f;
  const u16* Ag = A + (size_t)m0 * lda;
  const u16* Bg = Bt + (size_t)n0 * ldb;
  uint4 ra00, ra01, ra02, ra03, rb00, rb01, rb02, rb03, ra10, ra11, ra12, ra13, rb10, rb11, rb12, rb13;
  const int lrow = tid >> 3, lkc = (tid & 7) * 8;
  const u16* Agl = Ag + (size_t)lrow * lda + lkc;
  const u16* Bgl = Bg + (size_t)lrow * ldb + lkc;
#define GEMM_GLOAD(S, kt_)                                            \
  {                                                                   \
    const int k0_ = (kt_) << 6;                                       \
    ra##S##0 = *(const uint4*)(Agl + k0_);                            \
    ra##S##1 = *(const uint4*)(Agl + (size_t)32 * lda + k0_);         \
    ra##S##2 = *(const uint4*)(Agl + (size_t)64 * lda + k0_);         \
    ra##S##3 = *(const uint4*)(Agl + (size_t)96 * lda + k0_);         \
    rb##S##0 = *(const uint4*)(Bgl + k0_);                            \
    rb##S##1 = *(const uint4*)(Bgl + (size_t)32 * ldb + k0_);         \
    rb##S##2 = *(const uint4*)(Bgl + (size_t)64 * ldb + k0_);         \
    rb##S##3 = *(const uint4*)(Bgl + (size_t)96 * ldb + k0_);         \
  }
#define GEMM_LSTORE(S, buf_)                                          \
  {                                                                   \
    u16* ad_ = As + (buf_) * 128 * 72 + lrow * 72 + lkc;              \
    u16* bd_ = Bs + (buf_) * 128 * 72 + lrow * 72 + lkc;              \
    *(uint4*)(ad_) = ra##S##0;                                        \
    *(uint4*)(ad_ + 32 * 72) = ra##S##1;                              \
    *(uint4*)(ad_ + 64 * 72) = ra##S##2;                              \
    *(uint4*)(ad_ + 96 * 72) = ra##S##3;                              \
    *(uint4*)(bd_) = rb##S##0;                                        \
    *(uint4*)(bd_ + 32 * 72) = rb##S##1;                              \
    *(uint4*)(bd_ + 64 * 72) = rb##S##2;                              \
    *(uint4*)(bd_ + 96 * 72) = rb##S##3;                              \
  }
#define GEMM_COMPUTE(buf_)                                                        \
  {                                                                               \
    const u16* as = As + (buf_) * 128 * 72 + (wm * 64 + lr) * 72 + lh * 8;        \
    const u16* bs = Bs + (buf_) * 128 * 72 + (wn * 64 + lr) * 72 + lh * 8;        \
    _Pragma("unroll") for (int ks = 0; ks < 4; ++ks) {                            \
      bf16x8 a0 = *(const bf16x8*)(as + ks * 16);                                 \
      bf16x8 a1 = *(const bf16x8*)(as + 32 * 72 + ks * 16);                       \
      bf16x8 b0 = *(const bf16x8*)(bs + ks * 16);                                 \
      bf16x8 b1 = *(const bf16x8*)(bs + 32 * 72 + ks * 16);                       \
      acc[0][0] = MFMA32(a0, b0, acc[0][0]);                                      \
      acc[0][1] = MFMA32(a0, b1, acc[0][1]);                                      \
      acc[1][0] = MFMA32(a1, b0, acc[1][0]);                                      \
      acc[1][1] = MFMA32(a1, b1, acc[1][1]);                                      \
    }                                                                             \
  }
  const int nk = K >> 6;
  GEMM_GLOAD(0, 0);
  GEMM_LSTORE(0, 0);
  __syncthreads();
  if (nk > 1) GEMM_GLOAD(0, 1);
  for (int kt = 0; kt < nk; kt += 2) {
    if (kt + 2 < nk) GEMM_GLOAD(1, kt + 2);
    GEMM_COMPUTE(0);
    if (kt + 1 < nk) GEMM_LSTORE(0, 1);
    __syncthreads();
    if (kt + 1 >= nk) break;
    if (kt + 3 < nk) GEMM_GLOAD(0, kt + 3);
    GEMM_COMPUTE(1);
    if (kt + 2 < nk) GEMM_LSTORE(1, 0);
    __syncthreads();
  }
  epi.tile(m0);
#pragma unroll
  for (int mi = 0; mi < 2; ++mi) {
#pragma unroll
    for (int gq = 0; gq < 4; ++gq) {
      const int row0 = m0 + wm * 64 + mi * 32 + 8 * gq + 4 * lh;
      if (PAIRED) {
        const int col = (n0 >> 1) + wn * 32 + lr;
#pragma unroll
        for (int e = 0; e < 4; ++e) epi.pair(row0 + e, col, acc[mi][0][4 * gq + e], acc[mi][1][4 * gq + e]);
      } else {
        epi.quad(row0, n0 + wn * 64 + lr, acc[mi][0][4 * gq], acc[mi][0][4 * gq + 1], acc[mi][0][4 * gq + 2], acc[mi][0][4 * gq + 3]);
        epi.quad(row0, n0 + wn * 64 + 32 + lr, acc[mi][1][4 * gq], acc[mi][1][4 * gq + 1], acc[mi][1][4 * gq + 2], acc[mi][1][4 * gq + 3]);
      }
    }
  }
}

template <bool PAIRED, class Epi>
DI void gemm_phase(const u16* A, int lda, const u16* Bt, int ldb, int K, int mtiles, int ntiles, int mt_off, bool skip_ctx,
                   char* smem, Epi& epi) {
  const int total = mtiles * ntiles;
  for (int t = blockIdx.x; t < total; t += gridDim.x) {
    const int mt = t / ntiles, nt = t - mt * ntiles;
    if (skip_ctx && ((mt + mt_off) % 34) < 2) continue;
    gemm_tile<PAIRED>(A, lda, Bt, ldb, K, mt * 128, nt * 128, smem, epi);
  }
}

#define EPI_DEFAULT_QUAD                                                   \
  DI void tile(int) {}                                                     \
  DI void quad(int row0, int col, float a, float b, float c, float d) const { \
    (*this)(row0, col, a);                                                 \
    (*this)(row0 + 1, col, b);                                             \
    (*this)(row0 + 2, col, c);                                             \
    (*this)(row0 + 3, col, d);                                             \
  }
struct EpiGU {
  u16* G;
  DI void pair(int row, int col, float g, float u) const {
    float s = g / (1.f + __expf(-g));
    G[(size_t)row * DFF + col] = f2bf(s * u);
  }
  DI void operator()(int, int, float) const {}
  EPI_DEFAULT_QUAD
};
struct EpiRes {
  const float* lat_in; const float* ctx_in; float* lat_out; float* ctx_out; const float* modl; int gate_chunk; float coef;
  const float* tin; float* tout; const float* gate; int tm0;
  DI void tile(int m0) {
    const int b = m0 / LT, j = m0 - b * LT;
    const bool isc = j < LC;
    const size_t off = isc ? (((size_t)(b * LC + j)) << 10) : (((size_t)(b * LQ + j - LC)) << 10);
    tin = (isc ? ctx_in : lat_in) + off;
    tout = (isc ? ctx_out : lat_out) + off;
    gate = modl + (isc ? 8 : b) * 9216 + gate_chunk * 1024;
    tm0 = m0;
  }
  DI void operator()(int row, int col, float v) const {
    const size_t o = ((size_t)(row - tm0) << 10) + col;
    tout[o] = tin[o] + coef * gate[col] * v;
  }
  DI void pair(int, int, float, float) const {}
  DI void quad(int row0, int col, float a, float b, float c, float d) const {
    const float gc = coef * gate[col];
    const size_t o = ((size_t)(row0 - tm0) << 10) + col;
    tout[o] = tin[o] + gc * a;
    tout[o + 1024] = tin[o + 1024] + gc * b;
    tout[o + 2048] = tin[o + 2048] + gc * c;
    tout[o + 3072] = tin[o + 3072] + gc * d;
  }
};
struct EpiStore {
  u16* C; int ldc; int N;
  DI void operator()(int row, int col, float v) const { if (col < N) C[(size_t)row * ldc + col] = f2bf(v); }
  DI void pair(int, int, float, float) const {}
  EPI_DEFAULT_QUAD
};
struct EpiWin {
  u16* p; u16* pT;
  DI void tile(int) {}
  DI void quad(int row0, int col, float a, float b, float c, float d) const {
    if (col < HYC) {
      uint2 w;
      w.x = pack2(a, b);
      w.y = pack2(c, d);
      *(uint2*)(pT + (size_t)col * TG + row0) = w;
    } else if (col < DIN) {
      u16* q = p + (size_t)row0 * DINP + (col - HYC);
      q[0] = f2bf(a);
      q[DINP] = f2bf(b);
      q[2 * DINP] = f2bf(c);
      q[3 * DINP] = f2bf(d);
    }
  }
  DI void pair(int, int, float, float) const {}
};
struct EpiLoraW {
  u16* C; const float* w0;
  DI void operator()(int row, int col, float v) const {
    float zz = -(w0[col] + v);
    float sp = fmaxf(zz, 0.f) + log1pf(expf(-fabsf(zz)));
    C[(size_t)row * 256 + col] = f2bf(expf(-sp - 0.5f));
  }
  DI void pair(int, int, float, float) const {}
  EPI_DEFAULT_QUAD
};
struct EpiLoraA {
  u16* C; const float* a0;
  DI void operator()(int row, int col, float v) const { C[(size_t)row * 256 + col] = f2bf(sigmoidf_(a0[col] + v)); }
  DI void pair(int, int, float, float) const {}
  EPI_DEFAULT_QUAD
};

struct MixBufs {
  u16 *p, *pt, *u, *qg, *kg, *vtg, *cqn, *ckvn, *qup, *kvup, *qm, *km, *vtm, *rr, *rk, *rv, *rkk, *lwf, *lwb, *laf, *lab, *lg, *ef, *eb, *af, *ab, *gg;
  float *yf, *yb;
};
DI MixBufs mixbufs(char* big) {
  MixBufs m;
  m.p = (u16*)(big + M_P); m.pt = (u16*)(big + M_PT); m.u = (u16*)(big + M_U); m.qg = (u16*)(big + M_QG); m.kg = (u16*)(big + M_KG);
  m.vtg = (u16*)(big + M_VTG); m.cqn = (u16*)(big + M_CQN); m.ckvn = (u16*)(big + M_CKVN); m.qup = (u16*)(big + M_QUP);
  m.kvup = (u16*)(big + M_KVUP); m.qm = (u16*)(big + M_QM); m.km = (u16*)(big + M_KM); m.vtm = (u16*)(big + M_VTM);
  m.rr = (u16*)(big + M_RR); m.rk = (u16*)(big + M_RK); m.rv = (u16*)(big + M_RV); m.rkk = (u16*)(big + M_RKK);
  m.lwf = (u16*)(big + M_LWF); m.lwb = (u16*)(big + M_LWB); m.laf = (u16*)(big + M_LAF); m.lab = (u16*)(big + M_LAB);
  m.lg = (u16*)(big + M_LG); m.ef = (u16*)(big + M_EF); m.eb = (u16*)(big + M_EB); m.af = (u16*)(big + M_AF);
  m.ab = (u16*)(big + M_AB); m.gg = (u16*)(big + M_GG); m.yf = (float*)(big + M_YF); m.yb = (float*)(big + M_YB);
  return m;
}

DI void prep_phase(const Params& p, int l, int g, const MixBufs& m, char* smem) {
  float* red = (float*)smem;
  const int tid = ltid(), lane = tid & 63, wave = tid >> 6;
  const float* mu = p.rw_mu + l * 1152;
  for (int rl = blockIdx.x; rl < TG; rl += gridDim.x) {
    const int r = g * TG + rl;
    const int b = r / LT, j = r - b * LT, bl = b - g * BG;
    const bool lat = j >= LC;
    const bool hp = lat ? (j > LC) : (j > 0);
    const bool hn = lat ? (j < LT - 1) : (j < LC - 1);
    const u16* pc = m.p + (size_t)rl * DINP;
    const u16* pp = pc - DINP;
    const u16* pn = pc + DINP;
    {
      auto tshift = [&](int crel) -> float {
        const int c = 1696 - HYC + crel;
        float u0 = bf2f(pc[c]);
        float nb = 0.f;
        if (hp) nb += bf2f(pp[c]);
        if (hn) nb += bf2f(pn[c]);
        return u0 + mu[crel] * (0.5f * nb - u0);
      };
      float sr = tshift(tid), sk = tshift(256 + tid), sv = tshift(512 + tid);
      m.rr[(size_t)rl * 256 + tid] = f2bf(sr);
      m.rk[(size_t)rl * 256 + tid] = f2bf(sk);
      m.rv[(size_t)rl * 256 + tid] = f2bf(sv);
      float kx = sk * p.rw_k_k[l * 256 + tid];
      float ss = wave_sum(kx * kx);
      m.rkk[(size_t)rl * 256 + tid] = f2bf(kx / fmaxf(sqrtf(ss), 1e-12f));
      float s4 = tshift(768 + tid);
      if (tid < 64) m.lwf[(size_t)rl * 64 + tid] = f2bf(tanhf(s4));
      else if (tid < 128) m.lwb[(size_t)rl * 64 + tid - 64] = f2bf(tanhf(s4));
      else if (tid < 192) m.laf[(size_t)rl * 64 + tid - 128] = f2bf(s4);
      else m.lab[(size_t)rl * 64 + tid - 192] = f2bf(s4);
      if (tid < 128) {
        float s5 = tshift(1024 + tid);
        m.lg[(size_t)rl * 128 + tid] = f2bf(sigmoidf_(s5));
      }
    }
    {
      float cq = bf2f(pc[1280 - HYC + tid]);
      float ckv = tid < 128 ? bf2f(pc[1536 - HYC + tid]) : 0.f;
      float s1 = wave_sum(cq * cq), s2 = wave_sum(ckv * ckv);
      if (lane == 0) { red[wave] = s1; red[4 + wave] = s2; }
      __syncthreads();
      s1 = red[0] + red[1] + red[2] + red[3];
      s2 = red[4] + red[5] + red[6] + red[7];
      __syncthreads();
      m.cqn[(size_t)rl * 256 + tid] = f2bf(cq * rsqrtf(s1 * (1.f / 256.f) + EPS) * p.mla_cq_norm[l * 256 + tid]);
      if (tid < 128) m.ckvn[(size_t)rl * 128 + tid] = f2bf(ckv * rsqrtf(s2 * (1.f / 128.f) + EPS) * p.mla_ckv_norm[l * 128 + tid]);
    }
    for (int hh = wave; hh < 6; hh += 4) {
      float val = bf2f(pc[hh * 64 + lane]);
      float ss = wave_sum(val * val);
      float gn = hh < 4 ? p.gqa_q_norm[l * 64 + lane] : p.gqa_k_norm[l * 64 + lane];
      val = val * rsqrtf(ss * (1.f / 64.f) + EPS) * gn;
      float rv = rope_apply(val, lane, 16, j - LC, lane);
      if (lat) val = rv;
      if (hh < 4) m.qg[(size_t)rl * 256 + hh * 64 + lane] = f2bf(val);
      else m.kg[(size_t)rl * 128 + (hh - 4) * 64 + lane] = f2bf(val);
    }
    if (wave < 2) m.vtg[((size_t)(bl * 2 + wave) * 64 + lane) * LT + j] = pc[1152 - HYC + wave * 64 + lane];
  }
}

DI void mla_fin_phase(const Params& p, int l, int g, const MixBufs& m) {
  const int tid = ltid(), lane = tid & 63, wave = tid >> 6;
  for (int rl = blockIdx.x; rl < TG; rl += gridDim.x) {
    const int r = g * TG + rl;
    const int b = r / LT, j = r - b * LT, bl = b - g * BG;
    const bool lat = j >= LC;
    for (int s = wave; s < 8; s += 4) {
      const int hd = s & 3;
      const bool isq = s < 4;
      float x0, x1;
      if (isq) {
        x0 = bf2f(m.qup[(size_t)rl * 384 + hd * 96 + lane]);
        x1 = lane < 32 ? bf2f(m.qup[(size_t)rl * 384 + hd * 96 + 64 + lane]) : 0.f;
      } else {
        x0 = bf2f(m.kvup[(size_t)rl * 512 + hd * 128 + lane]);
        x1 = lane < 32 ? bf2f(m.p[(size_t)rl * DINP + 1664 - HYC + lane]) : 0.f;
      }
      float ss = wave_sum(x0 * x0 + x1 * x1);
      const float rstd = rsqrtf(ss * (1.f / 96.f) + EPS);
      const float* gn = isq ? p.mla_q_norm + l * 96 : p.mla_k_norm + l * 96;
      float y0 = x0 * rstd * gn[lane];
      float y1 = lane < 32 ? x1 * rstd * gn[64 + lane] : 0.f;
      float ry = rope_apply(y1, lane & 31, 8, j - LC, lane);
      if (lat) y1 = ry;
      u16* dst = (isq ? m.qm : m.km) + (size_t)rl * 384 + hd * 96;
      dst[lane] = f2bf(y0);
      if (lane < 32) dst[64 + lane] = f2bf(y1);
      if (!isq) m.vtm[((size_t)(bl * 4 + hd) * 64 + lane) * LT + j] = m.kvup[(size_t)rl * 512 + hd * 128 + 64 + lane];
    }
  }
}

template <int DQK, int QT>
DI void attn_item(const u16* __restrict__ q, int ldq, const u16* __restrict__ k, int ldk, const u16* __restrict__ vT,
                  u16* __restrict__ out, int ldo, int nkeys, float sl2, float sh2, char* smem) {
  constexpr int KS = DQK + 8;
  constexpr int NKS = DQK / 16;
  constexpr int KCH = DQK / 8;
  constexpr int KPT = 64 * KCH / NTHR;
  u16* Ks = (u16*)smem;
  u16* Vs = Ks + 2 * 64 * KS;
  const int tid = ltid(), lane = tid & 63, wave = tid >> 6, lr = lane & 31, lh = lane >> 5;
  bf16x8 qf[QT][NKS];
#pragma unroll
  for (int qt = 0; qt < QT; ++qt)
#pragma unroll
    for (int ks = 0; ks < NKS; ++ks)
      qf[qt][ks] = *(const bf16x8*)(q + (size_t)(wave * 32 * QT + qt * 32 + lr) * ldq + ks * 16 + lh * 8);
  f32x16 o[QT][2];
#pragma unroll
  for (int a = 0; a < QT; ++a)
#pragma unroll
    for (int b = 0; b < 2; ++b)
#pragma unroll
      for (int i = 0; i < 16; ++i) o[a][b][i] = 0.f;
  float lsum[QT];
#pragma unroll
  for (int a = 0; a < QT; ++a) lsum[a] = 0.f;
  uint4 rk[KPT], rv[2];
#define ATT_GLOAD(key0)                                                                   \
  {                                                                                       \
    _Pragma("unroll") for (int i = 0; i < KPT; ++i) {                                     \
      const int id = tid + NTHR * i, row = id / KCH, ch = id - row * KCH;                 \
      rk[i] = *(const uint4*)(k + (size_t)((key0) + row) * ldk + ch * 8);                 \
    }                                                                                     \
    _Pragma("unroll") for (int i = 0; i < 2; ++i) {                                       \
      const int id = tid + NTHR * i, row = id >> 3, ch = id & 7;                          \
      rv[i] = *(const uint4*)(vT + (size_t)row * LT + (key0) + ch * 8);                   \
    }                                                                                     \
  }
#define ATT_LSTORE(buf_)                                                                  \
  {                                                                                       \
    _Pragma("unroll") for (int i = 0; i < KPT; ++i) {                                     \
      const int id = tid + NTHR * i, row = id / KCH, ch = id - row * KCH;                 \
      *(uint4*)(Ks + (buf_) * 64 * KS + row * KS + ch * 8) = rk[i];                       \
    }                                                                                     \
    _Pragma("unroll") for (int i = 0; i < 2; ++i) {                                       \
      const int id = tid + NTHR * i, row = id >> 3, ch = id & 7;                          \
      *(uint4*)(Vs + (buf_) * 64 * 72 + row * 72 + ch * 8) = rv[i];                       \
    }                                                                                     \
  }
  ATT_GLOAD(0);
  ATT_LSTORE(0);
  __syncthreads();
  const int nkt = nkeys >> 6;
  for (int kt = 0; kt < nkt; ++kt) {
    const int buf = kt & 1;
    if (kt + 1 < nkt) ATT_GLOAD((kt + 1) << 6);
    const u16* kb = Ks + buf * 64 * KS;
    const u16* vb = Vs + buf * 64 * 72;
#pragma unroll
    for (int half = 0; half < 2; ++half) {
      f32x16 s[QT];
#pragma unroll
      for (int qt = 0; qt < QT; ++qt)
#pragma unroll
        for (int i = 0; i < 16; ++i) s[qt][i] = 0.f;
#pragma unroll
      for (int ks = 0; ks < NKS; ++ks) {
        bf16x8 kf = *(const bf16x8*)(kb + (half * 32 + lr) * KS + ks * 16 + lh * 8);
#pragma unroll
        for (int qt = 0; qt < QT; ++qt) s[qt] = MFMA32(kf, qf[qt][ks], s[qt]);
      }
#pragma unroll
      for (int qt = 0; qt < QT; ++qt)
#pragma unroll
        for (int i = 0; i < 16; ++i) {
          float pv = exp2f(s[qt][i] * sl2 - sh2);
          lsum[qt] += pv;
          s[qt][i] = pv;
        }
#pragma unroll
      for (int st = 0; st < 2; ++st) {
        bf16x8 pb[QT];
#pragma unroll
        for (int qt = 0; qt < QT; ++qt) {
          uint4 w;
          w.x = pack2(s[qt][8 * st + 0], s[qt][8 * st + 1]);
          w.y = pack2(s[qt][8 * st + 2], s[qt][8 * st + 3]);
          w.z = pack2(s[qt][8 * st + 4], s[qt][8 * st + 5]);
          w.w = pack2(s[qt][8 * st + 6], s[qt][8 * st + 7]);
          pb[qt] = __builtin_bit_cast(bf16x8, w);
        }
#pragma unroll
        for (int mt = 0; mt < 2; ++mt) {
          const u16* vp = vb + (mt * 32 + lr) * 72 + half * 32 + st * 16 + lh * 4;
          uint2 v0 = *(const uint2*)(vp);
          uint2 v1 = *(const uint2*)(vp + 8);
          uint4 w;
          w.x = v0.x; w.y = v0.y; w.z = v1.x; w.w = v1.y;
          bf16x8 vf = __builtin_bit_cast(bf16x8, w);
#pragma unroll
          for (int qt = 0; qt < QT; ++qt) o[qt][mt] = MFMA32(vf, pb[qt], o[qt][mt]);
        }
      }
    }
    if (kt + 1 < nkt) ATT_LSTORE(buf ^ 1);
    __syncthreads();
  }
#pragma unroll
  for (int qt = 0; qt < QT; ++qt) {
    float tot = lsum[qt] + __shfl_xor(lsum[qt], 32);
    float inv = 1.f / tot;
    const int row = wave * 32 * QT + qt * 32 + lr;
#pragma unroll
    for (int mt = 0; mt < 2; ++mt)
#pragma unroll
      for (int gq = 0; gq < 4; ++gq) {
        uint2 w;
        w.x = pack2(o[qt][mt][4 * gq + 0] * inv, o[qt][mt][4 * gq + 1] * inv);
        w.y = pack2(o[qt][mt][4 * gq + 2] * inv, o[qt][mt][4 * gq + 3] * inv);
        *(uint2*)(out + (size_t)row * ldo + mt * 32 + 8 * gq + 4 * lh) = w;
      }
  }
}

DI void hyena_pass(const Params& p, int l, const MixBufs& m, const float* __restrict__ gT, int L, int segoff, int c, char* smem) {
  const int RS = L + 16, US = L + 16;
  unsigned* Rc = (unsigned*)smem;
  u16* U = (u16*)(smem + (size_t)2 * RS * 4);
  const int tid = ltid(), lane = tid & 63, wave = tid >> 6;
  for (int d = tid; d < L; d += NTHR) {
    const int q = 2 * d;
    const float r0 = gT[(size_t)(2 * L - 2 - q) * 256 + c];
    const float r1 = (q + 1 <= 2 * L - 2) ? gT[(size_t)(2 * L - 3 - q) * 256 + c] : 0.f;
    const float r2 = (q + 2 <= 2 * L - 2) ? gT[(size_t)(2 * L - 4 - q) * 256 + c] : 0.f;
    Rc[d] = pack2(r0, r1);
    Rc[RS + d] = pack2(r1, r2);
  }
  const float* cw = p.hy_conv_w + l * 3 * 768;
  const float* cb = p.hy_conv_b + l * 768;
  {
    const float w0a = cw[c], w1a = cw[768 + c], w2a = cw[1536 + c], ba = cb[c];
    const float w0v = cw[512 + c], w1v = cw[768 + 512 + c], w2v = cw[1536 + 512 + c], bv = cb[512 + c];
    for (int b = 0; b < BG; ++b) {
      const u16* x1p = m.pt + (size_t)c * TG + b * LT + segoff;
      const u16* vp = m.pt + (size_t)(512 + c) * TG + b * LT + segoff;
      for (int t = tid; t < L; t += NTHR) {
        float x1 = bf2f(x1p[t]) * w1a + ba;
        float vv = bf2f(vp[t]) * w1v + bv;
        if (t > 0) { x1 += bf2f(x1p[t - 1]) * w0a; vv += bf2f(vp[t - 1]) * w0v; }
        if (t < L - 1) { x1 += bf2f(x1p[t + 1]) * w2a; vv += bf2f(vp[t + 1]) * w2v; }
        U[b * US + t] = f2bf(x1 * vv);
      }
    }
  }
  __syncthreads();
  const int i = lane & 31, h = lane >> 5, bn = i & 3, mb = i >> 2;
  const int par = (L - 1 - i) & 1;
  const float bias = p.hy_bias[l * 256 + c];
  const float w0x = cw[256 + c], w1x = cw[768 + 256 + c], w2x = cw[1536 + 256 + c], bx = cb[256 + c];
  const int nsteps = (L + 208) / 16 + 1;
  for (int sp = wave; sp < L / 256; sp += 4) {
    const int T0 = sp * 256;
    f32x16 acc;
#pragma unroll
    for (int r = 0; r < 16; ++r) acc[r] = 0.f;
    const int delta0 = T0 + 224;
    const int q0 = (L - 1) - delta0 - i + 8 * h;
    const unsigned* ap = Rc + par * RS + (q0 >> 1);
    int s0 = T0 + 32 * mb - delta0;
    const u16* bp = U + bn * US + s0 + 8 * h;
#pragma unroll 2
    for (int st = 0; st < nsteps; ++st) {
      uint4 aw;
      aw.x = ap[0]; aw.y = ap[1]; aw.z = ap[2]; aw.w = ap[3];
      uint4 bw = make_uint4(0u, 0u, 0u, 0u);
      if (s0 >= 0 && s0 <= L - 16) bw = *(const uint4*)bp;
      acc = MFMA32(__builtin_bit_cast(bf16x8, aw), __builtin_bit_cast(bf16x8, bw), acc);
      ap += 8;
      s0 += 16;
      bp += 16;
    }
    const u16* x2p = m.pt + (size_t)(256 + c) * TG + bn * LT + segoff;
    u16* yp = m.u + (size_t)c * TG + bn * LT + segoff;
#pragma unroll
    for (int gq = 0; gq < 4; ++gq) {
      const int t4 = T0 + 32 * mb + 8 * gq + 4 * h;
      float e[6];
#pragma unroll
      for (int k = 0; k < 6; ++k) {
        const int tt = t4 - 1 + k;
        e[k] = (tt >= 0 && tt < L) ? bf2f(x2p[tt]) : 0.f;
      }
      const uint2 uu = *(const uint2*)(U + bn * US + t4);
      const float u0 = bflo_(uu.x), u1 = bfhi_(uu.x), u2 = bflo_(uu.y), u3 = bfhi_(uu.y);
      const float y0 = (e[0] * w0x + e[1] * w1x + e[2] * w2x + bx) * (acc[4 * gq + 0] + u0 * bias);
      const float y1 = (e[1] * w0x + e[2] * w1x + e[3] * w2x + bx) * (acc[4 * gq + 1] + u1 * bias);
      const float y2 = (e[2] * w0x + e[3] * w1x + e[4] * w2x + bx) * (acc[4 * gq + 2] + u2 * bias);
      const float y3 = (e[3] * w0x + e[4] * w1x + e[5] * w2x + bx) * (acc[4 * gq + 3] + u3 * bias);
      uint2 w;
      w.x = pack2(y0, y1);
      w.y = pack2(y2, y3);
      *(uint2*)(yp + t4) = w;
    }
  }
  __syncthreads();
}

#define DPP_ROR(v, n) __builtin_bit_cast(float, __builtin_amdgcn_update_dpp(0, __builtin_bit_cast(int, (v)), 0x120 + (n), 0xf, 0xf, true))
DI float row_allsum(float v) {
  v += DPP_ROR(v, 8);
  v += DPP_ROR(v, 4);
  v += DPP_ROR(v, 2);
  v += DPP_ROR(v, 1);
  return v;
}
DI float bflo(unsigned w) { return __uint_as_float(w << 16); }
DI float bfhi(unsigned w) { return __uint_as_float(w & 0xffff0000u); }
DI void scan_item(const Params& p, int l, const MixBufs& m, int bl, int hd, int dir, int rq, char* smem) {
  constexpr int TC = 16;
  constexpr int NCH = LT / TC;
  constexpr int BUF = 5 * TC * 64 + TC * 16;
  float* sbase = (float*)smem;
  float* sy = sbase + 2 * BUF;
  const int tid = ltid(), lane = tid & 63, wave = tid >> 6;
  const int kq = lane & 15, rloc = wave * 4 + (lane >> 4);
  const u16* eD = dir ? m.eb : m.ef;
  const u16* aD = dir ? m.ab : m.af;
  float* yD = dir ? m.yb : m.yf;
  const size_t rbase = (size_t)bl * LT;
  const int ss = tid >> 4, su = tid & 15, sc = su & 7;
  float kav[8];
#pragma unroll
  for (int i = 0; i < 8; ++i) kav[i] = p.rw_k_a[l * 256 + hd * 64 + sc * 8 + i];
  uint4 g0, g1, g2;
  g2.x = g2.y = g2.z = g2.w = 0u;
#define SCAN_JMAP(i) (dir ? ((i) < LC ? LC - 1 - (i) : LT - 1 - ((i) - LC)) : (i))
#define SCAN_GLOAD(i0)                                                                         \
  {                                                                                            \
    const int ii_ = (i0) + ss;                                                                 \
    const int j_ = SCAN_JMAP(ii_);                                                             \
    const size_t o_ = (rbase + j_) * 256 + hd * 64 + sc * 8;                                   \
    if (su < 8) {                                                                              \
      g0 = *(const uint4*)(m.rkk + o_);                                                        \
      g1 = *(const uint4*)(aD + o_);                                                           \
      g2 = *(const uint4*)(m.rk + o_);                                                         \
    } else {                                                                                   \
      g0 = *(const uint4*)(eD + o_);                                                           \
      g1 = *(const uint4*)(m.rr + o_);                                                         \
      if (sc < 2) g2 = *(const uint4*)(m.rv + (rbase + j_) * 256 + hd * 64 + rq * 16 + sc * 8); \
    }                                                                                          \
  }
#define SCAN_LSTORE(buf_)                                                                      \
  {                                                                                            \
    float* B_ = sbase + (buf_) * BUF;                                                          \
    const unsigned w0_[4] = {g0.x, g0.y, g0.z, g0.w};                                          \
    const unsigned w1_[4] = {g1.x, g1.y, g1.z, g1.w};                                          \
    const unsigned w2_[4] = {g2.x, g2.y, g2.z, g2.w};                                          \
    if (su < 8) {                                                                              \
      float kk_[8], bb_[8], dd_[8];                                                            \
      _Pragma("unroll") for (int q_ = 0; q_ < 4; ++q_) {                                       \
        const float k0_ = bflo(w0_[q_]), k1_ = bfhi(w0_[q_]);                                  \
        const float a0_ = bflo(w1_[q_]), a1_ = bfhi(w1_[q_]);                                  \
        const float v0_ = bflo(w2_[q_]), v1_ = bfhi(w2_[q_]);                                  \
        kk_[2 * q_] = k0_; kk_[2 * q_ + 1] = k1_;                                              \
        bb_[2 * q_] = k0_ * a0_; bb_[2 * q_ + 1] = k1_ * a1_;                                  \
        dd_[2 * q_] = v0_ * (1.f + (a0_ - 1.f) * kav[2 * q_]);                                 \
        dd_[2 * q_ + 1] = v1_ * (1.f + (a1_ - 1.f) * kav[2 * q_ + 1]);                         \
      }                                                                                        \
      float* d0_ = B_ + ss * 64 + sc * 8;                                                      \
      *(float4*)(d0_) = make_float4(kk_[0], kk_[1], kk_[2], kk_[3]);                           \
      *(float4*)(d0_ + 4) = make_float4(kk_[4], kk_[5], kk_[6], kk_[7]);                       \
      *(float4*)(d0_ + 2048) = make_float4(bb_[0], bb_[1], bb_[2], bb_[3]);                    \
      *(float4*)(d0_ + 2052) = make_float4(bb_[4], bb_[5], bb_[6], bb_[7]);                    \
      *(float4*)(d0_ + 3072) = make_float4(dd_[0], dd_[1], dd_[2], dd_[3]);                    \
      *(float4*)(d0_ + 3076) = make_float4(dd_[4], dd_[5], dd_[6], dd_[7]);                    \
    } else {                                                                                   \
      float ww_[8], rr_[8], vv_[8];                                                            \
      _Pragma("unroll") for (int q_ = 0; q_ < 4; ++q_) {                                       \
        ww_[2 * q_] = expf(-bflo(w0_[q_])); ww_[2 * q_ + 1] = expf(-bfhi(w0_[q_]));            \
        rr_[2 * q_] = bflo(w1_[q_]); rr_[2 * q_ + 1] = bfhi(w1_[q_]);                          \
        vv_[2 * q_] = bflo(w2_[q_]); vv_[2 * q_ + 1] = bfhi(w2_[q_]);                          \
      }                                                                                        \
      float* d0_ = B_ + ss * 64 + sc * 8;                                                      \
      *(float4*)(d0_ + 1024) = make_float4(ww_[0], ww_[1], ww_[2], ww_[3]);                    \
      *(float4*)(d0_ + 1028) = make_float4(ww_[4], ww_[5], ww_[6], ww_[7]);                    \
      *(float4*)(d0_ + 4096) = make_float4(rr_[0], rr_[1], rr_[2], rr_[3]);                    \
      *(float4*)(d0_ + 4100) = make_float4(rr_[4], rr_[5], rr_[6], rr_[7]);                    \
      if (sc < 2) {                                                                            \
        float* d1_ = B_ + 5120 + ss * 16 + sc * 8;                                             \
        *(float4*)(d1_) = make_float4(vv_[0], vv_[1], vv_[2], vv_[3]);                         \
        *(float4*)(d1_ + 4) = make_float4(vv_[4], vv_[5], vv_[6], vv_[7]);                     \
      }                                                                                        \
    }                                                                                          \
  }
  float S0 = 0.f, S1 = 0.f, S2 = 0.f, S3 = 0.f;
  SCAN_GLOAD(0);
  SCAN_LSTORE(0);
  __syncthreads();
  for (int c = 0; c < NCH; ++c) {
    const int buf = c & 1;
    if (c + 1 < NCH) SCAN_GLOAD((c + 1) * TC);
    const float* B = sbase + buf * BUF;
    float* syb = sy + buf * TC * 16;
#pragma unroll
    for (int st = 0; st < TC; ++st) {
      const float4 kk = *(const float4*)(B + st * 64 + kq * 4);
      const float4 ww = *(const float4*)(B + 1024 + st * 64 + kq * 4);
      const float4 bb = *(const float4*)(B + 2048 + st * 64 + kq * 4);
      const float4 dd = *(const float4*)(B + 3072 + st * 64 + kq * 4);
      const float4 rr = *(const float4*)(B + 4096 + st * 64 + kq * 4);
      const float vv = B[5120 + st * 16 + rloc];
      const float part = (S0 * kk.x + S1 * kk.y) + (S2 * kk.z + S3 * kk.w);
      const float c0 = S0 * ww.x + vv * dd.x, c1 = S1 * ww.y + vv * dd.y, c2 = S2 * ww.z + vv * dd.z, c3 = S3 * ww.w + vv * dd.w;
      const float sa = -row_allsum(part);
      S0 = c0 + sa * bb.x;
      S1 = c1 + sa * bb.y;
      S2 = c2 + sa * bb.z;
      S3 = c3 + sa * bb.w;
      const float yp = (S0 * rr.x + S1 * rr.y) + (S2 * rr.z + S3 * rr.w);
      const float y = row_allsum(yp);
      if (kq == 0) syb[st * 16 + rloc] = y;
    }
    if (c + 1 < NCH) SCAN_LSTORE(buf ^ 1);
    __syncthreads();
    {
      const int st = tid >> 4, r_ = tid & 15;
      const int ii = c * TC + st;
      const int j = SCAN_JMAP(ii);
      yD[(rbase + j) * 256 + hd * 64 + rq * 16 + r_] = syb[st * 16 + r_];
    }
  }
  __syncthreads();
}

DI void readout_phase(const Params& p, int l, int g, const MixBufs& m, u16* __restrict__ ymix, bool skip_ctx, char* smem) {
  const int tid = ltid();
  {
    u16* tile = (u16*)smem;
    for (int tl = blockIdx.x; tl < (TG / 64) * 4; tl += gridDim.x) {
      const int rl0 = (tl >> 2) * 64, c0 = (tl & 3) * 64;
      const int r0 = g * TG + rl0;
      if (skip_ctx && (r0 % LT) < LC) continue;
#pragma unroll
      for (int k = 0; k < 2; ++k) {
        const int id = tid + NTHR * k, ch = id >> 3, part = id & 7;
        *(uint4*)(tile + ch * 72 + part * 8) = *(const uint4*)(m.u + (size_t)(c0 + ch) * TG + rl0 + part * 8);
      }
      __syncthreads();
#pragma unroll
      for (int k = 0; k < 2; ++k) {
        const int id = tid + NTHR * k, tok = id >> 3, part = id & 7;
        const u16* tp = tile + (part * 8) * 72 + tok;
        uint4 w;
        w.x = (unsigned)tp[0] | ((unsigned)tp[72] << 16);
        w.y = (unsigned)tp[2 * 72] | ((unsigned)tp[3 * 72] << 16);
        w.z = (unsigned)tp[4 * 72] | ((unsigned)tp[5 * 72] << 16);
        w.w = (unsigned)tp[6 * 72] | ((unsigned)tp[7 * 72] << 16);
        *(uint4*)(ymix + (size_t)(r0 + tok) * D + c0 + part * 8) = w;
      }
      __syncthreads();
    }
  }
  for (int rl = blockIdx.x; rl < TG; rl += gridDim.x) {
    const int r = g * TG + rl;
    const int j = r % LT;
    if (skip_ctx && j < LC) continue;
    const size_t o = (size_t)rl * 256 + tid;
    float y = m.yf[o] + m.yb[o];
    float mean = wave_sum(y) * (1.f / 64.f);
    float dv = y - mean;
    float var = wave_sum(dv * dv) * (1.f / 64.f);
    float yn = dv * rsqrtf(var + 64e-5f) * p.rw_ln_w[l * 256 + tid] + p.rw_ln_b[l * 256 + tid];
    const float rr = bf2f(m.rr[o]), kv = bf2f(m.rk[o]), vv = bf2f(m.rv[o]);
    const float kaa = p.rw_k_a[l * 256 + tid], rk = p.rw_r_k[l * 256 + tid];
    const float af = bf2f(m.af[o]), ab = bf2f(m.ab[o]);
    float t1 = rr * kv * (1.f + (af - 1.f) * kaa) * rk + rr * kv * (1.f + (ab - 1.f) * kaa) * rk;
    float bonus = wave_sum(t1) * vv;
    ymix[(size_t)r * D + 768 + tid] = f2bf((yn + bonus) * bf2f(m.gg[o]));
  }
}

__global__ void __launch_bounds__(NTHR, 2) fwd_megakernel(Params p) {
  cg::grid_group grid = cg::this_grid();
  __shared__ __attribute__((aligned(16))) char smem[73728];
  __shared__ int s_item;
  char* ws = p.ws;
  float* ctxs = (float*)(ws + OFF_CTX);
  float* mod = (float*)(ws + OFF_MOD);
  u16* hbuf = (u16*)(ws + OFF_H);
  char* big = ws + OFF_BIG;
  u16* Gbuf = (u16*)big;
  const MixBufs m = mixbufs(big);

  if (blockIdx.x == 0 && threadIdx.x < 64) ((int*)(ws + OFF_CNT))[threadIdx.x] = 0;
  for (int rep = 0; rep < REP_MISC; ++rep)
  for (int l = 0; l < 2; ++l) {
    u16* W = (u16*)(ws + OFF_W) + (size_t)l * W_LAYER;
    convT(p.ffn1_gate + (size_t)l * D * DFF, D, DFF, W + W_GU1, 1, smem);
    convT(p.ffn1_up + (size_t)l * D * DFF, D, DFF, W + W_GU1, 2, smem);
    convT(p.ffn1_down + (size_t)l * D * DFF, DFF, D, W + W_D1, 0, smem);
    convT(p.ffn2_gate + (size_t)l * D * DFF, D, DFF, W + W_GU2, 1, smem);
    convT(p.ffn2_up + (size_t)l * D * DFF, D, DFF, W + W_GU2, 2, smem);
    convT(p.ffn2_down + (size_t)l * D * DFF, DFF, D, W + W_D2, 0, smem);
    convT(p.w_in + (size_t)l * D * DIN, D, DIN, W + W_IN, 0, smem);
    convT(p.w_out + (size_t)l * D * D, D, D, W + W_OUT, 0, smem);
    convT(p.mla_w_uq + (size_t)l * 256 * 384, 256, 384, W + W_UQ, 0, smem);
    convT(p.mla_w_ukv + (size_t)l * 128 * 512, 128, 512, W + W_UKV, 0, smem);
    for (int d = 0; d < 2; ++d) {
      convT(p.rw_w2 + (size_t)(l * 2 + d) * 64 * 256, 64, 256, W + W_W2 + (size_t)d * 256 * 64, 0, smem);
      convT(p.rw_a2 + (size_t)(l * 2 + d) * 64 * 256, 64, 256, W + W_A2 + (size_t)d * 256 * 64, 0, smem);
    }
    convT(p.rw_g2 + (size_t)l * 128 * 256, 128, 256, W + W_G2, 0, smem);
    hyfilt_phase(p, l, LQ, (float*)(ws + OFF_FILT + (size_t)l * al(SZ_FILT_L)), smem);
  }
  hyfilt_phase(p, 0, LC, (float*)(ws + OFF_FILTC), smem);
  mod_phase(p, mod, smem);
  grid.sync();

  for (int l = 0; l < 2; ++l) {
    const bool last = (l == 1);
    const u16* W = (u16*)(ws + OFF_W) + (size_t)l * W_LAYER;
    const float* modl = mod + (size_t)l * 9 * 9216;
    const float* lat_in = (l == 0) ? p.x : p.out;
    const float* ctx_in = (l == 0) ? p.ctx : ctxs;

    adaln_phase(lat_in, ctx_in, p.norm_ffn1 + l * D, modl, 0, hbuf, false);
    grid.sync();
    {
      EpiGU e{Gbuf};
      for (int rep = 0; rep < REP_GU; ++rep) gemm_phase<true>(hbuf, D, W + W_GU1, D, D, T / 128, 44, 0, false, smem, e);
    }
    grid.sync();
    {
      EpiRes e{lat_in, ctx_in, p.out, ctxs, modl, 2, 0.5f, nullptr, nullptr, nullptr, 0};
      gemm_phase<false>(Gbuf, DFF, W + W_D1, DFF, DFF, T / 128, 8, 0, false, smem, e);
    }
    grid.sync();
    adaln_phase(p.out, ctxs, p.norm_mix + l * D, modl, 1, hbuf, false);
    grid.sync();
    for (int g = 0; g < NG; ++g) {
      const u16* hg = hbuf + (size_t)g * TG * D;
      {
        EpiWin e{m.p, m.pt};
        gemm_phase<false>(hg, D, W + W_IN, D, D, TG / 128, 23, 0, false, smem, e);
      }
      grid.sync();
      for (int rep = 0; rep < REP_ROW; ++rep) prep_phase(p, l, g, m, smem);
      grid.sync();
      {
        EpiStore e1{m.qup, 384, 384};
        gemm_phase<false>(m.cqn, 256, W + W_UQ, 256, 256, TG / 128, 3, 0, false, smem, e1);
        EpiStore e2{m.kvup, 512, 512};
        gemm_phase<false>(m.ckvn, 128, W + W_UKV, 128, 128, TG / 128, 4, 0, false, smem, e2);
        EpiLoraW e3{m.ef, p.rw_w0 + (l * 2 + 0) * 256};
        gemm_phase<false>(m.lwf, 64, W + W_W2, 64, 64, TG / 128, 2, 0, false, smem, e3);
        EpiLoraW e4{m.eb, p.rw_w0 + (l * 2 + 1) * 256};
        gemm_phase<false>(m.lwb, 64, W + W_W2 + 256 * 64, 64, 64, TG / 128, 2, 0, false, smem, e4);
        EpiLoraA e5{m.af, p.rw_a0 + (l * 2 + 0) * 256};
        gemm_phase<false>(m.laf, 64, W + W_A2, 64, 64, TG / 128, 2, 0, false, smem, e5);
        EpiLoraA e6{m.ab, p.rw_a0 + (l * 2 + 1) * 256};
        gemm_phase<false>(m.lab, 64, W + W_A2 + 256 * 64, 64, 64, TG / 128, 2, 0, false, smem, e6);
        EpiStore e7{m.gg, 256, 256};
        gemm_phase<false>(m.lg, 128, W + W_G2, 128, 128, TG / 128, 2, 0, false, smem, e7);
      }
      grid.sync();
      for (int rep = 0; rep < REP_ROW; ++rep) mla_fin_phase(p, l, g, m);
      grid.sync();
      {
        u16* ymix = hbuf;
        const int n_scan = BG * 4 * 2 * 4;
        const int qt_per_b = last ? 32 : 34;
        const int n_att = BG * 4 * qt_per_b;
        const int n_hy = 256;
        const int total = n_scan + 2 * n_att + n_hy;
        float gq = 0.f, gk = 0.f, mq = 0.f, mk = 0.f;
        for (int i = 0; i < 64; ++i) { gq = fmaxf(gq, fabsf(p.gqa_q_norm[l * 64 + i])); gk = fmaxf(gk, fabsf(p.gqa_k_norm[l * 64 + i])); }
        for (int i = 0; i < 96; ++i) { mq = fmaxf(mq, fabsf(p.mla_q_norm[l * 96 + i])); mk = fmaxf(mk, fabsf(p.mla_k_norm[l * 96 + i])); }
        const float L2E = 1.4426950408889634f;
        const float sc_g = 0.125f, sc_m = 0.10206207261596575f;
        const float sh_g = (64.f * gq * gk * sc_g * 1.02f + 0.5f) * L2E;
        const float sh_m = (96.f * mq * mk * sc_m * 1.02f + 0.5f) * L2E;
        int* cnt = (int*)(ws + OFF_CNT) + (l * NG + g);
        for (;;) {
          if (threadIdx.x == 0) s_item = atomicAdd(cnt, 1);
          __syncthreads();
          const int it = s_item;
          __syncthreads();
          if (it >= total) break;
          if (it < n_scan) {
            const int bl = it >> 5, hd = (it >> 3) & 3, dir = (it >> 2) & 1, rq = it & 3;
            scan_item(p, l, m, bl, hd, dir, rq, smem);
          } else if (it < n_scan + 2 * n_att) {
            int a = it - n_scan;
            const int kind = a / n_att;
            a -= kind * n_att;
            const int bl = a / (4 * qt_per_b);
            int rem = a - bl * 4 * qt_per_b;
            const int hd = rem / qt_per_b;
            const int qt = rem - hd * qt_per_b;
            const int j0 = qt < 32 ? LC + qt * 128 : (qt - 32) * 128;
            const int nkeys = qt < 32 ? LT : LC;
            const size_t rl0 = (size_t)bl * LT + j0;
            const size_t rg0 = (size_t)(g * BG + bl) * LT + j0;
            if (kind == 0) {
              const int kvh = hd >> 1;
              attn_item<64, 1>(m.qg + rl0 * 256 + hd * 64, 256, m.kg + (size_t)bl * LT * 128 + kvh * 64, 128,
                            m.vtg + (size_t)(bl * 2 + kvh) * 64 * LT, ymix + rg0 * D + 256 + hd * 64, D, nkeys, sc_g * L2E, sh_g, smem);
            } else {
              attn_item<96, 1>(m.qm + rl0 * 384 + hd * 96, 384, m.km + (size_t)bl * LT * 384 + hd * 96, 384,
                            m.vtm + (size_t)(bl * 4 + hd) * 64 * LT, ymix + rg0 * D + 512 + hd * 64, D, nkeys, sc_m * L2E, sh_m, smem);
            }
          } else {
            const int c = it - n_scan - 2 * n_att;
            hyena_pass(p, l, m, (const float*)(ws + OFF_FILT + (size_t)l * al(SZ_FILT_L)), LQ, LC, c, smem);
            if (!last) hyena_pass(p, l, m, (const float*)(ws + OFF_FILTC), LC, 0, c, smem);
          }
        }
        grid.sync();
        for (int rep = 0; rep < REP_ROW; ++rep) readout_phase(p, l, g, m, ymix, last, smem);
        grid.sync();
      }
    }
    {
      EpiRes e{p.out, ctxs, p.out, ctxs, modl, 5, 1.0f, nullptr, nullptr, nullptr, 0};
      gemm_phase<false>(hbuf, D, W + W_OUT, D, D, T / 128, 8, 0, last, smem, e);
    }
    grid.sync();
    adaln_phase(p.out, ctxs, p.norm_ffn2 + l * D, modl, 2, hbuf, last);
    grid.sync();
    {
      EpiGU e{Gbuf};
      for (int rep = 0; rep < REP_GU; ++rep) gemm_phase<true>(hbuf, D, W + W_GU2, D, D, T / 128, 44, 0, last, smem, e);
    }
    grid.sync();
    {
      EpiRes e{p.out, ctxs, p.out, ctxs, modl, 8, 0.5f, nullptr, nullptr, nullptr, 0};
      gemm_phase<false>(Gbuf, DFF, W + W_D2, DFF, DFF, T / 128, 8, 0, last, smem, e);
    }
    grid.sync();
  }
}

extern "C" void kernel_launch(void* const* d_in, const int* in_sizes, int n_in, void* d_out, int out_size, void* d_ws,
                              size_t ws_size, hipStream_t stream) {
  static int grid_blocks = 0;
  if (!grid_blocks) {
    int dev = 0, cus = 0, per_cu = 0;
    (void)hipGetDevice(&dev);
    (void)hipDeviceGetAttribute(&cus, hipDeviceAttributeMultiprocessorCount, dev);
    (void)hipOccupancyMaxActiveBlocksPerMultiprocessor(&per_cu, fwd_megakernel, NTHR, 0);
    if (per_cu > 2) per_cu = 2;
    if (per_cu < 1) per_cu = 1;
    grid_blocks = cus * per_cu;
  }
  Params p{};
  const float** pp = (const float**)&p;
  for (int i = 0; i < 47; ++i) pp[i] = (const float*)d_in[i];
  p.out = (float*)d_out;
  p.ws = (char*)d_ws;
  void* args[] = {&p};
  hipError_t e = hipLaunchCooperativeKernel((void*)fwd_megakernel, dim3(grid_blocks), dim3(NTHR), args, 0, stream);
  if (e != hipSuccess) fprintf(stderr, "cooperative launch failed: %s (grid %d)\n", hipGetErrorString(e), grid_blocks);
}
```

```cpp
#include <hip/hip_runtime.h>
#include <hip/hip_bf16.h>
#include <hip/hip_cooperative_groups.h>
#include <cstdio>
namespace cg = cooperative_groups;

#define DI __device__ __forceinline__
typedef unsigned short u16;
using bf16x8 = __attribute__((ext_vector_type(8))) short;
using f32x16 = __attribute__((ext_vector_type(16))) float;
typedef __bf16 bf16x2_t __attribute__((ext_vector_type(2)));
typedef float f32x2_t __attribute__((ext_vector_type(2)));
#define MFMA32(a, b, c) __builtin_amdgcn_mfma_f32_32x32x16_bf16((a), (b), (c), 0, 0, 0)

constexpr int D = 1024, NB = 8, LQ = 4096, LC = 256, LT = 4352, T = NB * LT, DFF = 2816, DIN = 2848;
constexpr int HYC = 768, DINP = DIN - HYC;
constexpr int NG = 2, BG = NB / NG, TG = BG * LT;
constexpr int NTHR = 256;
#define REP_MIX 1
#define REP_GU 1
#define REP_MISC 1
#define REP_ROW 1
constexpr float EPS = 1e-6f;

constexpr size_t al(size_t x) { return (x + 255) & ~(size_t)255; }
constexpr size_t OFF_CTX = 0;
constexpr size_t OFF_MOD = OFF_CTX + al((size_t)NB * LC * D * 4);
constexpr size_t SZ_FILT_L = (size_t)(2 * LQ - 1) * 256 * 4;
constexpr size_t SZ_FILT_C = (size_t)(2 * LC - 1) * 256 * 4;
constexpr size_t OFF_CNT = OFF_MOD + al((size_t)2 * 9 * 9216 * 4);
constexpr size_t OFF_BAR = OFF_CNT + 256;
constexpr size_t OFF_FILT = OFF_BAR + al((size_t)3456 * 4);
constexpr size_t OFF_FILTC = OFF_FILT + 2 * al(SZ_FILT_L);
constexpr size_t OFF_W = OFF_FILTC + al(SZ_FILT_C);
constexpr size_t W_GU1 = 0;
constexpr size_t W_D1 = W_GU1 + (size_t)5632 * 1024;
constexpr size_t W_GU2 = W_D1 + (size_t)1024 * 2816;
constexpr size_t W_D2 = W_GU2 + (size_t)5632 * 1024;
constexpr size_t W_IN = W_D2 + (size_t)1024 * 2816;
constexpr size_t W_OUT = W_IN + (size_t)2944 * 1024;
constexpr size_t W_UQ = W_OUT + (size_t)1024 * 1024;
constexpr size_t W_UKV = W_UQ + (size_t)384 * 256;
constexpr size_t W_W2 = W_UKV + (size_t)512 * 128;
constexpr size_t W_A2 = W_W2 + (size_t)2 * 256 * 64;
constexpr size_t W_G2 = W_A2 + (size_t)2 * 256 * 64;
constexpr size_t W_LAYER = W_G2 + (size_t)256 * 128;
constexpr size_t OFF_H = OFF_W + al(2 * W_LAYER * 2);
constexpr size_t OFF_BIG = OFF_H + al((size_t)T * D * 2);
constexpr size_t M_P = 0;
constexpr size_t M_PT = M_P + al((size_t)TG * DINP * 2);
constexpr size_t M_U = M_PT + al((size_t)HYC * TG * 2);
constexpr size_t M_QG = M_U + al((size_t)TG * 256 * 2);
constexpr size_t M_KG = M_QG + al((size_t)TG * 256 * 2);
constexpr size_t M_VTG = M_KG + al((size_t)TG * 128 * 2);
constexpr size_t M_CQN = M_VTG + al((size_t)TG * 128 * 2);
constexpr size_t M_CKVN = M_CQN + al((size_t)TG * 256 * 2);
constexpr size_t M_QUP = M_CKVN + al((size_t)TG * 128 * 2);
constexpr size_t M_KVUP = M_QUP + al((size_t)TG * 384 * 2);
constexpr size_t M_QM = M_KVUP + al((size_t)TG * 512 * 2);
constexpr size_t M_KM = M_QM + al((size_t)TG * 384 * 2);
constexpr size_t M_VTM = M_KM + al((size_t)TG * 384 * 2);
constexpr size_t M_RR = M_VTM + al((size_t)TG * 256 * 2);
constexpr size_t M_RK = M_RR + al((size_t)TG * 256 * 2);
constexpr size_t M_RV = M_RK + al((size_t)TG * 256 * 2);
constexpr size_t M_RKK = M_RV + al((size_t)TG * 256 * 2);
constexpr size_t M_LWF = M_RKK + al((size_t)TG * 256 * 2);
constexpr size_t M_LWB = M_LWF + al((size_t)TG * 64 * 2);
constexpr size_t M_LAF = M_LWB + al((size_t)TG * 64 * 2);
constexpr size_t M_LAB = M_LAF + al((size_t)TG * 64 * 2);
constexpr size_t M_LG = M_LAB + al((size_t)TG * 64 * 2);
constexpr size_t M_EF = M_LG + al((size_t)TG * 128 * 2);
constexpr size_t M_EB = M_EF + al((size_t)TG * 256 * 2);
constexpr size_t M_AF = M_EB + al((size_t)TG * 256 * 2);
constexpr size_t M_AB = M_AF + al((size_t)TG * 256 * 2);
constexpr size_t M_GG = M_AB + al((size_t)TG * 256 * 2);
constexpr size_t M_YF = M_GG + al((size_t)TG * 256 * 2);
constexpr size_t M_YB = M_YF + al((size_t)TG * 256 * 4);
constexpr size_t M_END = M_YB + al((size_t)TG * 256 * 4);
constexpr size_t SZ_G = (size_t)T * DFF * 2;
constexpr size_t WS_NEED = OFF_BIG + (M_END > SZ_G ? M_END : SZ_G);
static_assert(WS_NEED <= (size_t)512 * 1024 * 1024, "workspace too large");

struct Params {
  const float *x, *c, *ctx, *c_ctx, *ada_w, *ada_b, *norm_ffn1, *norm_mix, *norm_ffn2;
  const float *ffn1_gate, *ffn1_up, *ffn1_down, *ffn2_gate, *ffn2_up, *ffn2_down, *w_in, *w_out;
  const float *hy_conv_w, *hy_conv_b, *hy_f_w1, *hy_f_b1, *hy_f_w2, *hy_f_b2, *hy_f_w3, *hy_f_b3, *hy_f_w4, *hy_f_freq, *hy_bias;
  const float *gqa_q_norm, *gqa_k_norm, *mla_cq_norm, *mla_ckv_norm, *mla_w_uq, *mla_w_ukv, *mla_q_norm, *mla_k_norm;
  const float *rw_mu, *rw_w0, *rw_w2, *rw_a0, *rw_a2, *rw_g2, *rw_k_k, *rw_k_a, *rw_r_k, *rw_ln_w, *rw_ln_b;
  float* out;
  char* ws;
};

DI u16 f2bf(float x) {
  unsigned u = __float_as_uint(x);
  u += 0x7fffu + ((u >> 16) & 1u);
  return (u16)(u >> 16);
}
DI float bf2f(u16 b) { return __uint_as_float(((unsigned)b) << 16); }
DI float bflo_(unsigned w) { return __uint_as_float(w << 16); }
DI float bfhi_(unsigned w) { return __uint_as_float(w & 0xffff0000u); }
DI unsigned pack2(float a, float b) {
  f32x2_t v = {a, b};
  bf16x2_t r = __builtin_convertvector(v, bf16x2_t);
  return __builtin_bit_cast(unsigned, r);
}
DI int ltid() {
  int t = threadIdx.x;
  asm volatile("" : "+v"(t));
  return t;
}
DI float wave_sum(float v) {
#pragma unroll
  for (int o = 32; o > 0; o >>= 1) v += __shfl_xor(v, o);
  return v;
}
DI float wave_max(float v) {
#pragma unroll
  for (int o = 32; o > 0; o >>= 1) v = fmaxf(v, __shfl_xor(v, o));
  return v;
}
DI float sigmoidf_(float x) { return 1.f / (1.f + expf(-x)); }
DI int crow(int i, int h) { return (i & 3) + 8 * (i >> 2) + 4 * h; }

DI float rope_apply(float val, int idx, int nfreq, int t, int lane) {
  int pi = idx >> 1;
  int row = t >> 6, col = t & 63;
  float pos = pi < nfreq ? (float)row : (float)col;
  int f = pi < nfreq ? pi : pi - nfreq;
  float inv = exp2f(-(float)f / (float)nfreq * 13.287712379549449f);
  float ang = pos * inv;
  float cs = cosf(ang), sn = sinf(ang);
  float other = __shfl_xor(val, 1);
  return (lane & 1) ? other * sn + val * cs : val * cs - other * sn;
}

DI int gu_row(int n, int half) { return (n >> 6) * 128 + ((n >> 5) & 1) * 64 + half * 32 + (n & 31); }
DI void convT(const float* __restrict__ src, int K, int N, u16* __restrict__ dst, int mode, char* smem) {
  float* tile = (float*)smem;
  const int tk = K / 64, tn = (N + 63) / 64;
  const int tid_ = ltid();
  const int j = tid_ & 63, i0 = tid_ >> 6;
  for (int t = blockIdx.x; t < tk * tn; t += gridDim.x) {
    const int k0 = (t / tn) * 64, n0 = (t % tn) * 64;
    for (int i = i0; i < 64; i += 4) {
      int n = n0 + j;
      tile[i * 65 + j] = n < N ? src[(size_t)(k0 + i) * N + n] : 0.f;
    }
    __syncthreads();
    for (int i = i0; i < 64; i += 4) {
      int n = n0 + i;
      if (n < N) {
        int row = mode == 0 ? n : gu_row(n, mode - 1);
        dst[(size_t)row * K + k0 + j] = f2bf(tile[j * 65 + i]);
      }
    }
    __syncthreads();
  }
}

DI void mod_phase(const Params& p, float* __restrict__ mod, char* smem) {
  float* sc = (float*)smem;
  float* red = sc + 9 * 1024;
  const int tid_ = ltid();
  for (int i = tid_; i < 9 * 1024; i += NTHR) {
    float v = i < 8192 ? p.c[i] : p.c_ctx[i - 8192];
    sc[i] = v / (1.f + expf(-v));
  }
  __syncthreads();
  const int lane = tid_ & 63, kp = tid_ >> 6;
  for (int it = blockIdx.x; it < 2 * 144; it += gridDim.x) {
    const int l = it / 144, nb = (it % 144) * 64;
    const float* w = p.ada_w + (size_t)l * 1024 * 9216 + nb + lane;
    float acc[9];
#pragma unroll
    for (int b = 0; b < 9; ++b) acc[b] = 0.f;
    for (int k = kp * 256; k < kp * 256 + 256; ++k) {
      float wv = w[(size_t)k * 9216];
#pragma unroll
      for (int b = 0; b < 9; ++b) acc[b] += sc[b * 1024 + k] * wv;
    }
#pragma unroll
    for (int b = 0; b < 9; ++b) red[(kp * 9 + b) * 64 + lane] = acc[b];
    __syncthreads();
    for (int o = tid_; o < 9 * 64; o += NTHR) {
      int b = o >> 6, ln = o & 63;
      float s = red[(0 * 9 + b) * 64 + ln] + red[(1 * 9 + b) * 64 + ln] + red[(2 * 9 + b) * 64 + ln] + red[(3 * 9 + b) * 64 + ln];
      mod[((size_t)l * 9 + b) * 9216 + nb + ln] = s + p.ada_b[l * 9216 + nb + ln];
    }
    __syncthreads();
  }
}

DI void hyfilt_phase(const Params& p, int l, int L, float* __restrict__ gT, char* smem) {
  float* z = (float*)smem;
  float* h1 = z + 64;
  float* h2 = h1 + 64;
  float* h3 = h2 + 64;
  const float* w1 = p.hy_f_w1 + l * 33 * 64;
  const float* b1 = p.hy_f_b1 + l * 64;
  const float* w2 = p.hy_f_w2 + l * 4096;
  const float* b2 = p.hy_f_b2 + l * 64;
  const float* w3 = p.hy_f_w3 + l * 4096;
  const float* b3 = p.hy_f_b3 + l * 64;
  const float* w4 = p.hy_f_w4 + l * 64 * 512;
  const float* fr = p.hy_f_freq + l * 64;
  const int tid = ltid();
  const float min_decay = logf(1e-2f) / 1.5f, max_decay = logf(1e-2f) / 0.3f;
  for (int t = blockIdx.x; t < L; t += gridDim.x) {
    const float t01 = (float)t / (float)(L - 1);
    if (tid < 33) {
      float zz;
      if (tid == 0) zz = t01;
      else {
        int i = (tid - 1) & 15;
        float f = 1e-4f + (float)i * ((15.f - 1e-4f) / 15.f);
        float wang = 6.283185307179586f * (float)t / (float)L;
        zz = tid <= 16 ? cosf(f * wang) : -sinf(f * wang);
      }
      z[tid] = zz;
    }
    __syncthreads();
    if (tid < 64) {
      float a = b1[tid];
#pragma unroll 1
      for (int i = 0; i < 33; ++i) a += z[i] * w1[i * 64 + tid];
      h1[tid] = sinf(fr[tid] * a);
    }
    __syncthreads();
    if (tid < 64) {
      float a = b2[tid];
#pragma unroll 1
      for (int i = 0; i < 64; ++i) a += h1[i] * w2[i * 64 + tid];
      h2[tid] = sinf(fr[tid] * a);
    }
    __syncthreads();
    if (tid < 64) {
      float a = b3[tid];
#pragma unroll 1
      for (int i = 0; i < 64; ++i) a += h2[i] * w3[i * 64 + tid];
      h3[tid] = sinf(fr[tid] * a);
    }
    __syncthreads();
    float af = 0.f, ab = 0.f;
#pragma unroll 2
    for (int i = 0; i < 64; ++i) {
      af += h3[i] * w4[i * 512 + tid];
      ab += h3[i] * w4[i * 512 + 256 + tid];
    }
    float delta = fabsf(min_decay + (max_decay - min_decay) * (float)tid / 255.f);
    float dec = expf(-t01 * delta);
    af *= dec;
    ab *= dec;
    if (t == 0) gT[(size_t)(L - 1) * 256 + tid] = af + ab;
    else {
      gT[(size_t)(L - 1 + t) * 256 + tid] = af;
      gT[(size_t)(L - 1 - t) * 256 + tid] = ab;
    }
    __syncthreads();
  }
}

DI void adaln_phase(const float* __restrict__ lat, const float* __restrict__ ctxp, const float* __restrict__ gain,
                    const float* __restrict__ modl, int idx, u16* __restrict__ h, bool skip_ctx) {
  const int tid_ = ltid();
  const int wave = tid_ >> 6, lane = tid_ & 63;
  for (int r = blockIdx.x * 4 + wave; r < T; r += gridDim.x * 4) {
    const int b = r / LT, j = r - b * LT;
    if (skip_ctx && j < LC) continue;
    const float* xr = j < LC ? ctxp + ((size_t)(b * LC + j) << 10) : lat + ((size_t)(b * LQ + j - LC) << 10);
    const int bb = j < LC ? 8 : b;
    const float* shift = modl + bb * 9216 + (3 * idx) * 1024;
    const float* scale = shift + 1024;
    float4 v[4];
    float ss = 0.f;
#pragma unroll
    for (int q = 0; q < 4; ++q) {
      v[q] = *(const float4*)(xr + q * 256 + lane * 4);
      ss += v[q].x * v[q].x + v[q].y * v[q].y + v[q].z * v[q].z + v[q].w * v[q].w;
    }
    ss = wave_sum(ss);
    const float rstd = rsqrtf(ss * (1.f / 1024.f) + EPS);
#pragma unroll
    for (int q = 0; q < 4; ++q) {
      const int c = q * 256 + lane * 4;
      float4 g = *(const float4*)(gain + c), sc = *(const float4*)(scale + c), sh = *(const float4*)(shift + c);
      float y0 = v[q].x * rstd * g.x * (1.f + sc.x) + sh.x;
      float y1 = v[q].y * rstd * g.y * (1.f + sc.y) + sh.y;
      float y2 = v[q].z * rstd * g.z * (1.f + sc.z) + sh.z;
      float y3 = v[q].w * rstd * g.w * (1.f + sc.w) + sh.w;
      uint2 o;
      o.x = pack2(y0, y1);
      o.y = pack2(y2, y3);
      *(uint2*)(h + (size_t)r * D + c) = o;
    }
  }
}

template <bool PAIRED, class Epi>
DI void gemm_tile(const u16* __restrict__ A, int lda, const u16* __restrict__ Bt, int ldb, int K, int m0, int n0,
                  char* smem, Epi& epi) {
  u16* As = (u16*)smem;
  u16* Bs = As + 2 * 128 * 72;
  const int tid = ltid(), lane = tid & 63, wave = tid >> 6;
  const int wm = wave >> 1, wn = wave & 1, lr = lane & 31, lh = lane >> 5;
  f32x16 acc[2][2];
#pragma unroll
  for (int a = 0; a < 2; ++a)
#pragma unroll
    for (int b = 0; b < 2; ++b)
#pragma unroll
      for (int i = 0; i < 16; ++i) acc[a][b][i] = 0.f;
  const u16* Ag = A + (size_t)m0 * lda;
  const u16* Bg = Bt + (size_t)n0 * ldb;
  uint4 ra00, ra01, ra02, ra03, rb00, rb01, rb02, rb03, ra10, ra11, ra12, ra13, rb10, rb11, rb12, rb13;
  const int lrow = tid >> 3, lkc = (tid & 7) * 8;
  const u16* Agl = Ag + (size_t)lrow * lda + lkc;
  const u16* Bgl = Bg + (size_t)lrow * ldb + lkc;
#define GEMM_GLOAD(S, kt_)                                            \
  {                                                                   \
    const int k0_ = (kt_) << 6;                                       \
    ra##S##0 = *(const uint4*)(Agl + k0_);                            \
    ra##S##1 = *(const uint4*)(Agl + (size_t)32 * lda + k0_);         \
    ra##S##2 = *(const uint4*)(Agl + (size_t)64 * lda + k0_);         \
    ra##S##3 = *(const uint4*)(Agl + (size_t)96 * lda + k0_);         \
    rb##S##0 = *(const uint4*)(Bgl + k0_);                            \
    rb##S##1 = *(const uint4*)(Bgl + (size_t)32 * ldb + k0_);         \
    rb##S##2 = *(const uint4*)(Bgl + (size_t)64 * ldb + k0_);         \
    rb##S##3 = *(const uint4*)(Bgl + (size_t)96 * ldb + k0_);         \
  }
#define GEMM_LSTORE(S, buf_)                                          \
  {                                                                   \
    u16* ad_ = As + (buf_) * 128 * 72 + lrow * 72 + lkc;              \
    u16* bd_ = Bs + (buf_) * 128 * 72 + lrow * 72 + lkc;              \
    *(uint4*)(ad_) = ra##S##0;                                        \
    *(uint4*)(ad_ + 32 * 72) = ra##S##1;                              \
    *(uint4*)(ad_ + 64 * 72) = ra##S##2;                              \
    *(uint4*)(ad_ + 96 * 72) = ra##S##3;                              \
    *(uint4*)(bd_) = rb##S##0;                                        \
    *(uint4*)(bd_ + 32 * 72) = rb##S##1;                              \
    *(uint4*)(bd_ + 64 * 72) = rb##S##2;                              \
    *(uint4*)(bd_ + 96 * 72) = rb##S##3;                              \
  }
#define GEMM_COMPUTE(buf_)                                                        \
  {                                                                               \
    const u16* as = As + (buf_) * 128 * 72 + (wm * 64 + lr) * 72 + lh * 8;        \
    const u16* bs = Bs + (buf_) * 128 * 72 + (wn * 64 + lr) * 72 + lh * 8;        \
    _Pragma("unroll") for (int ks = 0; ks < 4; ++ks) {                            \
      bf16x8 a0 = *(const bf16x8*)(as + ks * 16);                                 \
      bf16x8 a1 = *(const bf16x8*)(as + 32 * 72 + ks * 16);                       \
      bf16x8 b0 = *(const bf16x8*)(bs + ks * 16);                                 \
      bf16x8 b1 = *(const bf16x8*)(bs + 32 * 72 + ks * 16);                       \
      acc[0][0] = MFMA32(a0, b0, acc[0][0]);                                      \
      acc[0][1] = MFMA32(a0, b1, acc[0][1]);                                      \
      acc[1][0] = MFMA32(a1, b0, acc[1][0]);                                      \
      acc[1][1] = MFMA32(a1, b1, acc[1][1]);                                      \
    }                                                                             \
  }
  const int nk = K >> 6;
  GEMM_GLOAD(0, 0);
  GEMM_LSTORE(0, 0);
  __syncthreads();
  if (nk > 1) GEMM_GLOAD(0, 1);
  for (int kt = 0; kt < nk; kt += 2) {
    if (kt + 2 < nk) GEMM_GLOAD(1, kt + 2);
    GEMM_COMPUTE(0);
    if (kt + 1 < nk) GEMM_LSTORE(0, 1);
    __syncthreads();
    if (kt + 1 >= nk) break;
    if (kt + 3 < nk) GEMM_GLOAD(0, kt + 3);
    GEMM_COMPUTE(1);
    if (kt + 2 < nk) GEMM_LSTORE(1, 0);
    __syncthreads();
  }
  epi.tile(m0);
#pragma unroll
  for (int mi = 0; mi < 2; ++mi) {
#pragma unroll
    for (int gq = 0; gq < 4; ++gq) {
      const int row0 = m0 + wm * 64 + mi * 32 + 8 * gq + 4 * lh;
      if (PAIRED) {
        const int col = (n0 >> 1) + wn * 32 + lr;
#pragma unroll
        for (int e = 0; e < 4; ++e) epi.pair(row0 + e, col, acc[mi][0][4 * gq + e], acc[mi][1][4 * gq + e]);
      } else {
        epi.quad(row0, n0 + wn * 64 + lr, acc[mi][0][4 * gq], acc[mi][0][4 * gq + 1], acc[mi][0][4 * gq + 2], acc[mi][0][4 * gq + 3]);
        epi.quad(row0, n0 + wn * 64 + 32 + lr, acc[mi][1][4 * gq], acc[mi][1][4 * gq + 1], acc[mi][1][4 * gq + 2], acc[mi][1][4 * gq + 3]);
      }
    }
  }
}

template <bool PAIRED, class Epi>
DI void gemm_phase(const u16* A, int lda, const u16* Bt, int ldb, int K, int mtiles, int ntiles, int mt_off, bool skip_ctx,
                   char* smem, Epi& epi) {
  const int total = mtiles * ntiles;
  for (int t = blockIdx.x; t < total; t += gridDim.x) {
    const int mt = t / ntiles, nt = t - mt * ntiles;
    if (skip_ctx && ((mt + mt_off) % 34) < 2) continue;
    gemm_tile<PAIRED>(A, lda, Bt, ldb, K, mt * 128, nt * 128, smem, epi);
  }
}

#define EPI_DEFAULT_QUAD                                                   \
  DI void tile(int) {}                                                     \
  DI void quad(int row0, int col, float a, float b, float c, float d) const { \
    (*this)(row0, col, a);                                                 \
    (*this)(row0 + 1, col, b);                                             \
    (*this)(row0 + 2, col, c);                                             \
    (*this)(row0 + 3, col, d);                                             \
  }
struct EpiGU {
  u16* G;
  DI void pair(int row, int col, float g, float u) const {
    float s = g / (1.f + __expf(-g));
    G[(size_t)row * DFF + col] = f2bf(s * u);
  }
  DI void operator()(int, int, float) const {}
  EPI_DEFAULT_QUAD
};
struct EpiRes {
  const float* lat_in; const float* ctx_in; float* lat_out; float* ctx_out; const float* modl; int gate_chunk; float coef;
  const float* tin; float* tout; const float* gate; int tm0;
  DI void tile(int m0) {
    const int b = m0 / LT, j = m0 - b * LT;
    const bool isc = j < LC;
    const size_t off = isc ? (((size_t)(b * LC + j)) << 10) : (((size_t)(b * LQ + j - LC)) << 10);
    tin = (isc ? ctx_in : lat_in) + off;
    tout = (isc ? ctx_out : lat_out) + off;
    gate = modl + (isc ? 8 : b) * 9216 + gate_chunk * 1024;
    tm0 = m0;
  }
  DI void operator()(int row, int col, float v) const {
    const size_t o = ((size_t)(row - tm0) << 10) + col;
    tout[o] = tin[o] + coef * gate[col] * v;
  }
  DI void pair(int, int, float, float) const {}
  DI void quad(int row0, int col, float a, float b, float c, float d) const {
    const float gc = coef * gate[col];
    const size_t o = ((size_t)(row0 - tm0) << 10) + col;
    tout[o] = tin[o] + gc * a;
    tout[o + 1024] = tin[o + 1024] + gc * b;
    tout[o + 2048] = tin[o + 2048] + gc * c;
    tout[o + 3072] = tin[o + 3072] + gc * d;
  }
};
struct EpiStore {
  u16* C; int ldc; int N;
  DI void operator()(int row, int col, float v) const { if (col < N) C[(size_t)row * ldc + col] = f2bf(v); }
  DI void pair(int, int, float, float) const {}
  EPI_DEFAULT_QUAD
};
struct EpiWin {
  u16* p; u16* pT;
  DI void tile(int) {}
  DI void quad(int row0, int col, float a, float b, float c, float d) const {
    if (col < HYC) {
      uint2 w;
      w.x = pack2(a, b);
      w.y = pack2(c, d);
      *(uint2*)(pT + (size_t)col * TG + row0) = w;
    } else if (col < DIN) {
      u16* q = p + (size_t)row0 * DINP + (col - HYC);
      q[0] = f2bf(a);
      q[DINP] = f2bf(b);
      q[2 * DINP] = f2bf(c);
      q[3 * DINP] = f2bf(d);
    }
  }
  DI void pair(int, int, float, float) const {}
};
struct EpiLoraW {
  u16* C; const float* w0;
  DI void operator()(int row, int col, float v) const {
    float zz = -(w0[col] + v);
    float sp = fmaxf(zz, 0.f) + log1pf(expf(-fabsf(zz)));
    C[(size_t)row * 256 + col] = f2bf(-expm1f(-expf(-sp - 0.5f)));
  }
  DI void pair(int, int, float, float) const {}
  EPI_DEFAULT_QUAD
};
struct EpiLoraA {
  u16* C; const float* a0;
  DI void operator()(int row, int col, float v) const { C[(size_t)row * 256 + col] = f2bf(sigmoidf_(a0[col] + v)); }
  DI void pair(int, int, float, float) const {}
  EPI_DEFAULT_QUAD
};

struct MixBufs {
  u16 *p, *pt, *u, *qg, *kg, *vtg, *cqn, *ckvn, *qup, *kvup, *qm, *km, *vtm, *rr, *rk, *rv, *rkk, *lwf, *lwb, *laf, *lab, *lg, *ef, *eb, *af, *ab, *gg;
  float *yf, *yb;
};
DI MixBufs mixbufs(char* big) {
  MixBufs m;
  m.p = (u16*)(big + M_P); m.pt = (u16*)(big + M_PT); m.u = (u16*)(big + M_U); m.qg = (u16*)(big + M_QG); m.kg = (u16*)(big + M_KG);
  m.vtg = (u16*)(big + M_VTG); m.cqn = (u16*)(big + M_CQN); m.ckvn = (u16*)(big + M_CKVN); m.qup = (u16*)(big + M_QUP);
  m.kvup = (u16*)(big + M_KVUP); m.qm = (u16*)(big + M_QM); m.km = (u16*)(big + M_KM); m.vtm = (u16*)(big + M_VTM);
  m.rr = (u16*)(big + M_RR); m.rk = (u16*)(big + M_RK); m.rv = (u16*)(big + M_RV); m.rkk = (u16*)(big + M_RKK);
  m.lwf = (u16*)(big + M_LWF); m.lwb = (u16*)(big + M_LWB); m.laf = (u16*)(big + M_LAF); m.lab = (u16*)(big + M_LAB);
  m.lg = (u16*)(big + M_LG); m.ef = (u16*)(big + M_EF); m.eb = (u16*)(big + M_EB); m.af = (u16*)(big + M_AF);
  m.ab = (u16*)(big + M_AB); m.gg = (u16*)(big + M_GG); m.yf = (float*)(big + M_YF); m.yb = (float*)(big + M_YB);
  return m;
}

DI void prep_phase(const Params& p, int l, int g, const MixBufs& m, char* smem) {
  float* red = (float*)smem;
  const int tid = ltid(), lane = tid & 63, wave = tid >> 6;
  const float* mu = p.rw_mu + l * 1152;
  for (int rl = blockIdx.x; rl < TG; rl += gridDim.x) {
    const int r = g * TG + rl;
    const int b = r / LT, j = r - b * LT, bl = b - g * BG;
    const bool lat = j >= LC;
    const bool hp = lat ? (j > LC) : (j > 0);
    const bool hn = lat ? (j < LT - 1) : (j < LC - 1);
    const u16* pc = m.p + (size_t)rl * DINP;
    const u16* pp = pc - DINP;
    const u16* pn = pc + DINP;
    {
      auto tshift = [&](int crel) -> float {
        const int c = 1696 - HYC + crel;
        float u0 = bf2f(pc[c]);
        float nb = 0.f;
        if (hp) nb += bf2f(pp[c]);
        if (hn) nb += bf2f(pn[c]);
        return u0 + mu[crel] * (0.5f * nb - u0);
      };
      float sr = tshift(tid), sk = tshift(256 + tid), sv = tshift(512 + tid);
      m.rr[(size_t)rl * 256 + tid] = f2bf(sr);
      m.rk[(size_t)rl * 256 + tid] = f2bf(sk);
      m.rv[(size_t)rl * 256 + tid] = f2bf(sv);
      float kx = sk * p.rw_k_k[l * 256 + tid];
      float ss = wave_sum(kx * kx);
      m.rkk[(size_t)rl * 256 + tid] = f2bf(kx / fmaxf(sqrtf(ss), 1e-12f));
      float s4 = tshift(768 + tid);
      if (tid < 64) m.lwf[(size_t)rl * 64 + tid] = f2bf(tanhf(s4));
      else if (tid < 128) m.lwb[(size_t)rl * 64 + tid - 64] = f2bf(tanhf(s4));
      else if (tid < 192) m.laf[(size_t)rl * 64 + tid - 128] = f2bf(s4);
      else m.lab[(size_t)rl * 64 + tid - 192] = f2bf(s4);
      if (tid < 128) {
        float s5 = tshift(1024 + tid);
        m.lg[(size_t)rl * 128 + tid] = f2bf(sigmoidf_(s5));
      }
    }
    {
      float cq = bf2f(pc[1280 - HYC + tid]);
      float ckv = tid < 128 ? bf2f(pc[1536 - HYC + tid]) : 0.f;
      float s1 = wave_sum(cq * cq), s2 = wave_sum(ckv * ckv);
      if (lane == 0) { red[wave] = s1; red[4 + wave] = s2; }
      __syncthreads();
      s1 = red[0] + red[1] + red[2] + red[3];
      s2 = red[4] + red[5] + red[6] + red[7];
      __syncthreads();
      m.cqn[(size_t)rl * 256 + tid] = f2bf(cq * rsqrtf(s1 * (1.f / 256.f) + EPS) * p.mla_cq_norm[l * 256 + tid]);
      if (tid < 128) m.ckvn[(size_t)rl * 128 + tid] = f2bf(ckv * rsqrtf(s2 * (1.f / 128.f) + EPS) * p.mla_ckv_norm[l * 128 + tid]);
    }
    for (int hh = wave; hh < 6; hh += 4) {
      float val = bf2f(pc[hh * 64 + lane]);
      float ss = wave_sum(val * val);
      float gn = hh < 4 ? p.gqa_q_norm[l * 64 + lane] : p.gqa_k_norm[l * 64 + lane];
      val = val * rsqrtf(ss * (1.f / 64.f) + EPS) * gn;
      float rv = rope_apply(val, lane, 16, j - LC, lane);
      if (lat) val = rv;
      if (hh < 4) m.qg[(size_t)rl * 256 + hh * 64 + lane] = f2bf(val);
      else m.kg[(size_t)rl * 128 + (hh - 4) * 64 + lane] = f2bf(val);
    }
    if (wave < 2) m.vtg[((size_t)(bl * 2 + wave) * 64 + lane) * LT + j] = pc[1152 - HYC + wave * 64 + lane];
  }
}

DI void mla_fin_phase(const Params& p, int l, int g, const MixBufs& m) {
  const int tid = ltid(), lane = tid & 63, wave = tid >> 6;
  for (int rl = blockIdx.x; rl < TG; rl += gridDim.x) {
    const int r = g * TG + rl;
    const int b = r / LT, j = r - b * LT, bl = b - g * BG;
    const bool lat = j >= LC;
    for (int s = wave; s < 8; s += 4) {
      const int hd = s & 3;
      const bool isq = s < 4;
      float x0, x1;
      if (isq) {
        x0 = bf2f(m.qup[(size_t)rl * 384 + hd * 96 + lane]);
        x1 = lane < 32 ? bf2f(m.qup[(size_t)rl * 384 + hd * 96 + 64 + lane]) : 0.f;
      } else {
        x0 = bf2f(m.kvup[(size_t)rl * 512 + hd * 128 + lane]);
        x1 = lane < 32 ? bf2f(m.p[(size_t)rl * DINP + 1664 - HYC + lane]) : 0.f;
      }
      float ss = wave_sum(x0 * x0 + x1 * x1);
      const float rstd = rsqrtf(ss * (1.f / 96.f) + EPS);
      const float* gn = isq ? p.mla_q_norm + l * 96 : p.mla_k_norm + l * 96;
      float y0 = x0 * rstd * gn[lane];
      float y1 = lane < 32 ? x1 * rstd * gn[64 + lane] : 0.f;
      float ry = rope_apply(y1, lane & 31, 8, j - LC, lane);
      if (lat) y1 = ry;
      u16* dst = (isq ? m.qm : m.km) + (size_t)rl * 384 + hd * 96;
      dst[lane] = f2bf(y0);
      if (lane < 32) dst[64 + lane] = f2bf(y1);
      if (!isq) m.vtm[((size_t)(bl * 4 + hd) * 64 + lane) * LT + j] = m.kvup[(size_t)rl * 512 + hd * 128 + 64 + lane];
    }
  }
}

template <int DQK, int QT>
DI void attn_item(const u16* __restrict__ q, int ldq, const u16* __restrict__ k, int ldk, const u16* __restrict__ vT,
                  u16* __restrict__ out, int ldo, int nkeys, float sl2, float sh2, char* smem) {
  constexpr int KS = DQK + 8;
  constexpr int NKS = DQK / 16;
  constexpr int KCH = DQK / 8;
  constexpr int KPT = 64 * KCH / NTHR;
  u16* Ks = (u16*)smem;
  u16* Vs = Ks + 2 * 64 * KS;
  const int tid = ltid(), lane = tid & 63, wave = tid >> 6, lr = lane & 31, lh = lane >> 5;
  bf16x8 qf[QT][NKS];
#pragma unroll
  for (int qt = 0; qt < QT; ++qt)
#pragma unroll
    for (int ks = 0; ks < NKS; ++ks)
      qf[qt][ks] = *(const bf16x8*)(q + (size_t)(wave * 32 * QT + qt * 32 + lr) * ldq + ks * 16 + lh * 8);
  f32x16 o[QT][2];
#pragma unroll
  for (int a = 0; a < QT; ++a)
#pragma unroll
    for (int b = 0; b < 2; ++b)
#pragma unroll
      for (int i = 0; i < 16; ++i) o[a][b][i] = 0.f;
  float lsum[QT];
#pragma unroll
  for (int a = 0; a < QT; ++a) lsum[a] = 0.f;
  uint4 rk[KPT], rv[2];
#define ATT_GLOAD(key0)                                                                   \
  {                                                                                       \
    _Pragma("unroll") for (int i = 0; i < KPT; ++i) {                                     \
      const int id = tid + NTHR * i, row = id / KCH, ch = id - row * KCH;                 \
      rk[i] = *(const uint4*)(k + (size_t)((key0) + row) * ldk + ch * 8);                 \
    }                                                                                     \
    _Pragma("unroll") for (int i = 0; i < 2; ++i) {                                       \
      const int id = tid + NTHR * i, row = id >> 3, ch = id & 7;                          \
      rv[i] = *(const uint4*)(vT + (size_t)row * LT + (key0) + ch * 8);                   \
    }                                                                                     \
  }
#define ATT_LSTORE(buf_)                                                                  \
  {                                                                                       \
    _Pragma("unroll") for (int i = 0; i < KPT; ++i) {                                     \
      const int id = tid + NTHR * i, row = id / KCH, ch = id - row * KCH;                 \
      *(uint4*)(Ks + (buf_) * 64 * KS + row * KS + ch * 8) = rk[i];                       \
    }                                                                                     \
    _Pragma("unroll") for (int i = 0; i < 2; ++i) {                                       \
      const int id = tid + NTHR * i, row = id >> 3, ch = id & 7;                          \
      *(uint4*)(Vs + (buf_) * 64 * 72 + row * 72 + ch * 8) = rv[i];                       \
    }                                                                                     \
  }
  ATT_GLOAD(0);
  ATT_LSTORE(0);
  __syncthreads();
  const int nkt = nkeys >> 6;
  for (int kt = 0; kt < nkt; ++kt) {
    const int buf = kt & 1;
    if (kt + 1 < nkt) ATT_GLOAD((kt + 1) << 6);
    const u16* kb = Ks + buf * 64 * KS;
    const u16* vb = Vs + buf * 64 * 72;
#pragma unroll
    for (int half = 0; half < 2; ++half) {
      f32x16 s[QT];
#pragma unroll
      for (int qt = 0; qt < QT; ++qt)
#pragma unroll
        for (int i = 0; i < 16; ++i) s[qt][i] = 0.f;
#pragma unroll
      for (int ks = 0; ks < NKS; ++ks) {
        bf16x8 kf = *(const bf16x8*)(kb + (half * 32 + lr) * KS + ks * 16 + lh * 8);
#pragma unroll
        for (int qt = 0; qt < QT; ++qt) s[qt] = MFMA32(kf, qf[qt][ks], s[qt]);
      }
#pragma unroll
      for (int qt = 0; qt < QT; ++qt)
#pragma unroll
        for (int i = 0; i < 16; ++i) {
          float pv = exp2f(s[qt][i] * sl2 - sh2);
          lsum[qt] += pv;
          s[qt][i] = pv;
        }
#pragma unroll
      for (int st = 0; st < 2; ++st) {
        bf16x8 pb[QT];
#pragma unroll
        for (int qt = 0; qt < QT; ++qt) {
          uint4 w;
          w.x = pack2(s[qt][8 * st + 0], s[qt][8 * st + 1]);
          w.y = pack2(s[qt][8 * st + 2], s[qt][8 * st + 3]);
          w.z = pack2(s[qt][8 * st + 4], s[qt][8 * st + 5]);
          w.w = pack2(s[qt][8 * st + 6], s[qt][8 * st + 7]);
          pb[qt] = __builtin_bit_cast(bf16x8, w);
        }
#pragma unroll
        for (int mt = 0; mt < 2; ++mt) {
          const u16* vp = vb + (mt * 32 + lr) * 72 + half * 32 + st * 16 + lh * 4;
          uint2 v0 = *(const uint2*)(vp);
          uint2 v1 = *(const uint2*)(vp + 8);
          uint4 w;
          w.x = v0.x; w.y = v0.y; w.z = v1.x; w.w = v1.y;
          bf16x8 vf = __builtin_bit_cast(bf16x8, w);
#pragma unroll
          for (int qt = 0; qt < QT; ++qt) o[qt][mt] = MFMA32(vf, pb[qt], o[qt][mt]);
        }
      }
    }
    if (kt + 1 < nkt) ATT_LSTORE(buf ^ 1);
    __syncthreads();
  }
#pragma unroll
  for (int qt = 0; qt < QT; ++qt) {
    float tot = lsum[qt] + __shfl_xor(lsum[qt], 32);
    float inv = 1.f / tot;
    const int row = wave * 32 * QT + qt * 32 + lr;
#pragma unroll
    for (int mt = 0; mt < 2; ++mt)
#pragma unroll
      for (int gq = 0; gq < 4; ++gq) {
        uint2 w;
        w.x = pack2(o[qt][mt][4 * gq + 0] * inv, o[qt][mt][4 * gq + 1] * inv);
        w.y = pack2(o[qt][mt][4 * gq + 2] * inv, o[qt][mt][4 * gq + 3] * inv);
        *(uint2*)(out + (size_t)row * ldo + mt * 32 + 8 * gq + 4 * lh) = w;
      }
  }
}

DI void hyena_pass(const Params& p, int l, const MixBufs& m, const float* __restrict__ gT, int L, int segoff, int c, char* smem) {
  const int RS = L + 16, US = L + 16;
  unsigned* Rc = (unsigned*)smem;
  u16* U = (u16*)(smem + (size_t)2 * RS * 4);
  const int tid = ltid(), lane = tid & 63, wave = tid >> 6;
  for (int d = tid; d < L; d += NTHR) {
    const int q = 2 * d;
    const float r0 = gT[(size_t)(2 * L - 2 - q) * 256 + c];
    const float r1 = (q + 1 <= 2 * L - 2) ? gT[(size_t)(2 * L - 3 - q) * 256 + c] : 0.f;
    const float r2 = (q + 2 <= 2 * L - 2) ? gT[(size_t)(2 * L - 4 - q) * 256 + c] : 0.f;
    Rc[d] = pack2(r0, r1);
    Rc[RS + d] = pack2(r1, r2);
  }
  const float* cw = p.hy_conv_w + l * 3 * 768;
  const float* cb = p.hy_conv_b + l * 768;
  {
    const float w0a = cw[c], w1a = cw[768 + c], w2a = cw[1536 + c], ba = cb[c];
    const float w0v = cw[512 + c], w1v = cw[768 + 512 + c], w2v = cw[1536 + 512 + c], bv = cb[512 + c];
    for (int b = 0; b < BG; ++b) {
      const u16* x1p = m.pt + (size_t)c * TG + b * LT + segoff;
      const u16* vp = m.pt + (size_t)(512 + c) * TG + b * LT + segoff;
      for (int t = tid; t < L; t += NTHR) {
        float x1 = bf2f(x1p[t]) * w1a + ba;
        float vv = bf2f(vp[t]) * w1v + bv;
        if (t > 0) { x1 += bf2f(x1p[t - 1]) * w0a; vv += bf2f(vp[t - 1]) * w0v; }
        if (t < L - 1) { x1 += bf2f(x1p[t + 1]) * w2a; vv += bf2f(vp[t + 1]) * w2v; }
        U[b * US + t] = f2bf(x1 * vv);
      }
    }
  }
  __syncthreads();
  const int i = lane & 31, h = lane >> 5, bn = i & 3, mb = i >> 2;
  const int par = (L - 1 - i) & 1;
  const float bias = p.hy_bias[l * 256 + c];
  const float w0x = cw[256 + c], w1x = cw[768 + 256 + c], w2x = cw[1536 + 256 + c], bx = cb[256 + c];
  const int nsteps = (L + 208) / 16 + 1;
  for (int sp = wave; sp < L / 256; sp += 4) {
    const int T0 = sp * 256;
    f32x16 acc;
#pragma unroll
    for (int r = 0; r < 16; ++r) acc[r] = 0.f;
    const int delta0 = T0 + 224;
    const int q0 = (L - 1) - delta0 - i + 8 * h;
    const unsigned* ap = Rc + par * RS + (q0 >> 1);
    int s0 = T0 + 32 * mb - delta0;
    const u16* bp = U + bn * US + s0 + 8 * h;
#pragma unroll 2
    for (int st = 0; st < nsteps; ++st) {
      uint4 aw;
      aw.x = ap[0]; aw.y = ap[1]; aw.z = ap[2]; aw.w = ap[3];
      uint4 bw = make_uint4(0u, 0u, 0u, 0u);
      if (s0 >= 0 && s0 <= L - 16) bw = *(const uint4*)bp;
      acc = MFMA32(__builtin_bit_cast(bf16x8, aw), __builtin_bit_cast(bf16x8, bw), acc);
      ap += 8;
      s0 += 16;
      bp += 16;
    }
    const u16* x2p = m.pt + (size_t)(256 + c) * TG + bn * LT + segoff;
    u16* yp = m.u + (size_t)c * TG + bn * LT + segoff;
#pragma unroll
    for (int gq = 0; gq < 4; ++gq) {
      const int t4 = T0 + 32 * mb + 8 * gq + 4 * h;
      float e[6];
#pragma unroll
      for (int k = 0; k < 6; ++k) {
        const int tt = t4 - 1 + k;
        e[k] = (tt >= 0 && tt < L) ? bf2f(x2p[tt]) : 0.f;
      }
      const uint2 uu = *(const uint2*)(U + bn * US + t4);
      const float u0 = bflo_(uu.x), u1 = bfhi_(uu.x), u2 = bflo_(uu.y), u3 = bfhi_(uu.y);
      const float y0 = (e[0] * w0x + e[1] * w1x + e[2] * w2x + bx) * (acc[4 * gq + 0] + u0 * bias);
      const float y1 = (e[1] * w0x + e[2] * w1x + e[3] * w2x + bx) * (acc[4 * gq + 1] + u1 * bias);
      const float y2 = (e[2] * w0x + e[3] * w1x + e[4] * w2x + bx) * (acc[4 * gq + 2] + u2 * bias);
      const float y3 = (e[3] * w0x + e[4] * w1x + e[5] * w2x + bx) * (acc[4 * gq + 3] + u3 * bias);
      uint2 w;
      w.x = pack2(y0, y1);
      w.y = pack2(y2, y3);
      *(uint2*)(yp + t4) = w;
    }
  }
  __syncthreads();
}

#define DPP_ROR(v, n) __builtin_bit_cast(float, __builtin_amdgcn_update_dpp(0, __builtin_bit_cast(int, (v)), 0x120 + (n), 0xf, 0xf, true))
DI float row_allsum(float v) {
  v += DPP_ROR(v, 8);
  v += DPP_ROR(v, 4);
  v += DPP_ROR(v, 2);
  v += DPP_ROR(v, 1);
  return v;
}
DI float bflo(unsigned w) { return __uint_as_float(w << 16); }
DI float bfhi(unsigned w) { return __uint_as_float(w & 0xffff0000u); }
DI void scan_item(const Params& p, int l, const MixBufs& m, int bl, int hd, int dir, int rq, char* smem) {
  constexpr int TC = 16;
  constexpr int NCH = LT / TC;
  constexpr int BUF = 5 * TC * 64 + TC * 16;
  float* sbase = (float*)smem;
  float* sy = sbase + 2 * BUF;
  const int tid = ltid(), lane = tid & 63, wave = tid >> 6;
  const int kq = lane & 15, rloc = wave * 4 + (lane >> 4);
  const u16* eD = dir ? m.eb : m.ef;
  const u16* aD = dir ? m.ab : m.af;
  float* yD = dir ? m.yb : m.yf;
  const size_t rbase = (size_t)bl * LT;
  const int ss = tid >> 4, su = tid & 15, sc = su & 7;
  float kav[8];
#pragma unroll
  for (int i = 0; i < 8; ++i) kav[i] = p.rw_k_a[l * 256 + hd * 64 + sc * 8 + i];
  uint4 g0, g1, g2;
  g2.x = g2.y = g2.z = g2.w = 0u;
#define SCAN_JMAP(i) (dir ? ((i) < LC ? LC - 1 - (i) : LT - 1 - ((i) - LC)) : (i))
#define SCAN_GLOAD(i0)                                                                         \
  {                                                                                            \
    const int ii_ = (i0) + ss;                                                                 \
    const int j_ = SCAN_JMAP(ii_);                                                             \
    const size_t o_ = (rbase + j_) * 256 + hd * 64 + sc * 8;                                   \
    if (su < 8) {                                                                              \
      g0 = *(const uint4*)(m.rkk + o_);                                                        \
      g1 = *(const uint4*)(aD + o_);                                                           \
      g2 = *(const uint4*)(m.rk + o_);                                                         \
    } else {                                                                                   \
      g0 = *(const uint4*)(eD + o_);                                                           \
      g1 = *(const uint4*)(m.rr + o_);                                                         \
      if (sc < 2) g2 = *(const uint4*)(m.rv + (rbase + j_) * 256 + hd * 64 + rq * 16 + sc * 8); \
    }                                                                                          \
  }
#define SCAN_LSTORE(buf_)                                                                      \
  {                                                                                            \
    float* B_ = sbase + (buf_) * BUF;                                                          \
    const unsigned w0_[4] = {g0.x, g0.y, g0.z, g0.w};                                          \
    const unsigned w1_[4] = {g1.x, g1.y, g1.z, g1.w};                                          \
    const unsigned w2_[4] = {g2.x, g2.y, g2.z, g2.w};                                          \
    if (su < 8) {                                                                              \
      float kk_[8], bb_[8], dd_[8];                                                            \
      _Pragma("unroll") for (int q_ = 0; q_ < 4; ++q_) {                                       \
        const float k0_ = bflo(w0_[q_]), k1_ = bfhi(w0_[q_]);                                  \
        const float a0_ = bflo(w1_[q_]), a1_ = bfhi(w1_[q_]);                                  \
        const float v0_ = bflo(w2_[q_]), v1_ = bfhi(w2_[q_]);                                  \
        kk_[2 * q_] = k0_; kk_[2 * q_ + 1] = k1_;                                              \
        bb_[2 * q_] = k0_ * a0_; bb_[2 * q_ + 1] = k1_ * a1_;                                  \
        dd_[2 * q_] = v0_ * (1.f + (a0_ - 1.f) * kav[2 * q_]);                                 \
        dd_[2 * q_ + 1] = v1_ * (1.f + (a1_ - 1.f) * kav[2 * q_ + 1]);                         \
      }                                                                                        \
      float* d0_ = B_ + ss * 64 + sc * 8;                                                      \
      *(float4*)(d0_) = make_float4(kk_[0], kk_[1], kk_[2], kk_[3]);                           \
      *(float4*)(d0_ + 4) = make_float4(kk_[4], kk_[5], kk_[6], kk_[7]);                       \
      *(float4*)(d0_ + 2048) = make_float4(bb_[0], bb_[1], bb_[2], bb_[3]);                    \
      *(float4*)(d0_ + 2052) = make_float4(bb_[4], bb_[5], bb_[6], bb_[7]);                    \
      *(float4*)(d0_ + 3072) = make_float4(dd_[0], dd_[1], dd_[2], dd_[3]);                    \
      *(float4*)(d0_ + 3076) = make_float4(dd_[4], dd_[5], dd_[6], dd_[7]);                    \
    } else {                                                                                   \
      float ww_[8], rr_[8], vv_[8];                                                            \
      _Pragma("unroll") for (int q_ = 0; q_ < 4; ++q_) {                                       \
        ww_[2 * q_] = 1.f - bflo(w0_[q_]); ww_[2 * q_ + 1] = 1.f - bfhi(w0_[q_]);              \
        rr_[2 * q_] = bflo(w1_[q_]); rr_[2 * q_ + 1] = bfhi(w1_[q_]);                          \
        vv_[2 * q_] = bflo(w2_[q_]); vv_[2 * q_ + 1] = bfhi(w2_[q_]);                          \
      }                                                                                        \
      float* d0_ = B_ + ss * 64 + sc * 8;                                                      \
      *(float4*)(d0_ + 1024) = make_float4(ww_[0], ww_[1], ww_[2], ww_[3]);                    \
      *(float4*)(d0_ + 1028) = make_float4(ww_[4], ww_[5], ww_[6], ww_[7]);                    \
      *(float4*)(d0_ + 4096) = make_float4(rr_[0], rr_[1], rr_[2], rr_[3]);                    \
      *(float4*)(d0_ + 4100) = make_float4(rr_[4], rr_[5], rr_[6], rr_[7]);                    \
      if (sc < 2) {                                                                            \
        float* d1_ = B_ + 5120 + ss * 16 + sc * 8;                                             \
        *(float4*)(d1_) = make_float4(vv_[0], vv_[1], vv_[2], vv_[3]);                         \
        *(float4*)(d1_ + 4) = make_float4(vv_[4], vv_[5], vv_[6], vv_[7]);                     \
      }                                                                                        \
    }                                                                                          \
  }
  f32x2_t SA = {0.f, 0.f}, SB = {0.f, 0.f};
  SCAN_GLOAD(0);
  SCAN_LSTORE(0);
  __syncthreads();
  for (int c = 0; c < NCH; ++c) {
    const int buf = c & 1;
    if (c + 1 < NCH) SCAN_GLOAD((c + 1) * TC);
    const float* B = sbase + buf * BUF;
    float* syb = sy + buf * TC * 16;
    float ypart[TC];
    float4 kk = *(const float4*)(B + kq * 4);
    float4 ww = *(const float4*)(B + 1024 + kq * 4);
    float4 bb = *(const float4*)(B + 2048 + kq * 4);
    float4 dd = *(const float4*)(B + 3072 + kq * 4);
    float4 rr = *(const float4*)(B + 4096 + kq * 4);
    float vv = B[5120 + rloc];
#pragma unroll
    for (int st = 0; st < TC; ++st) {
      float4 kkn = kk, wwn = ww, bbn = bb, ddn = dd, rrn = rr;
      float vvn = vv;
      if (st + 1 < TC) {
        kkn = *(const float4*)(B + (st + 1) * 64 + kq * 4);
        wwn = *(const float4*)(B + 1024 + (st + 1) * 64 + kq * 4);
        bbn = *(const float4*)(B + 2048 + (st + 1) * 64 + kq * 4);
        ddn = *(const float4*)(B + 3072 + (st + 1) * 64 + kq * 4);
        rrn = *(const float4*)(B + 4096 + (st + 1) * 64 + kq * 4);
        vvn = B[5120 + (st + 1) * 16 + rloc];
      }
      const f32x2_t k01 = {kk.x, kk.y}, k23 = {kk.z, kk.w}, w01 = {ww.x, ww.y}, w23 = {ww.z, ww.w};
      const f32x2_t b01 = {bb.x, bb.y}, b23 = {bb.z, bb.w}, d01 = {dd.x, dd.y}, d23 = {dd.z, dd.w};
      const f32x2_t r01 = {rr.x, rr.y}, r23 = {rr.z, rr.w}, v2 = {vv, vv};
      const f32x2_t pp2 = SA * k01 + SB * k23;
      const float part = pp2.x + pp2.y;
      const f32x2_t cA = SA * w01 + v2 * d01, cB = SB * w23 + v2 * d23;
      const float sa = -row_allsum(part);
      const f32x2_t sa2 = {sa, sa};
      SA = cA + sa2 * b01;
      SB = cB + sa2 * b23;
      const f32x2_t yy2 = SA * r01 + SB * r23;
      ypart[st] = yy2.x + yy2.y;
      kk = kkn; ww = wwn; bb = bbn; dd = ddn; rr = rrn; vv = vvn;
    }
#pragma unroll
    for (int st = 0; st < TC; ++st) ypart[st] = row_allsum(ypart[st]);
    if (kq == 0) {
#pragma unroll
      for (int st = 0; st < TC; ++st) syb[st * 16 + rloc] = ypart[st];
    }
    if (c + 1 < NCH) SCAN_LSTORE(buf ^ 1);
    __syncthreads();
    {
      const int st = tid >> 4, r_ = tid & 15;
      const int ii = c * TC + st;
      const int j = SCAN_JMAP(ii);
      yD[(rbase + j) * 256 + hd * 64 + rq * 16 + r_] = syb[st * 16 + r_];
    }
  }
  __syncthreads();
}

DI void readout_phase(const Params& p, int l, int g, const MixBufs& m, u16* __restrict__ ymix, bool skip_ctx, char* smem) {
  const int tid = ltid();
  {
    u16* tile = (u16*)smem;
    for (int tl = blockIdx.x; tl < (TG / 64) * 4; tl += gridDim.x) {
      const int rl0 = (tl >> 2) * 64, c0 = (tl & 3) * 64;
      const int r0 = g * TG + rl0;
      if (skip_ctx && (r0 % LT) < LC) continue;
#pragma unroll
      for (int k = 0; k < 2; ++k) {
        const int id = tid + NTHR * k, ch = id >> 3, part = id & 7;
        *(uint4*)(tile + ch * 72 + part * 8) = *(const uint4*)(m.u + (size_t)(c0 + ch) * TG + rl0 + part * 8);
      }
      __syncthreads();
#pragma unroll
      for (int k = 0; k < 2; ++k) {
        const int id = tid + NTHR * k, tok = id >> 3, part = id & 7;
        const u16* tp = tile + (part * 8) * 72 + tok;
        uint4 w;
        w.x = (unsigned)tp[0] | ((unsigned)tp[72] << 16);
        w.y = (unsigned)tp[2 * 72] | ((unsigned)tp[3 * 72] << 16);
        w.z = (unsigned)tp[4 * 72] | ((unsigned)tp[5 * 72] << 16);
        w.w = (unsigned)tp[6 * 72] | ((unsigned)tp[7 * 72] << 16);
        *(uint4*)(ymix + (size_t)(r0 + tok) * D + c0 + part * 8) = w;
      }
      __syncthreads();
    }
  }
  for (int rl = blockIdx.x; rl < TG; rl += gridDim.x) {
    const int r = g * TG + rl;
    const int j = r % LT;
    if (skip_ctx && j < LC) continue;
    const size_t o = (size_t)rl * 256 + tid;
    float y = m.yf[o] + m.yb[o];
    float mean = wave_sum(y) * (1.f / 64.f);
    float dv = y - mean;
    float var = wave_sum(dv * dv) * (1.f / 64.f);
    float yn = dv * rsqrtf(var + 64e-5f) * p.rw_ln_w[l * 256 + tid] + p.rw_ln_b[l * 256 + tid];
    const float rr = bf2f(m.rr[o]), kv = bf2f(m.rk[o]), vv = bf2f(m.rv[o]);
    const float kaa = p.rw_k_a[l * 256 + tid], rk = p.rw_r_k[l * 256 + tid];
    const float af = bf2f(m.af[o]), ab = bf2f(m.ab[o]);
    float t1 = rr * kv * (1.f + (af - 1.f) * kaa) * rk + rr * kv * (1.f + (ab - 1.f) * kaa) * rk;
    float bonus = wave_sum(t1) * vv;
    ymix[(size_t)r * D + 768 + tid] = f2bf((yn + bonus) * bf2f(m.gg[o]));
  }
}

#define XB_TMO      128
#define XB_XCNT(j)  (256  + 64 * (j))
#define XB_XSUB(j)  (1280 + 64 * (j))
#define XB_XGEN(j)  (2304 + 64 * (j))
#define XB_TOP      3328
#define XB_TOPGEN   3392
#define XCD_BAR_WORDS 3456
#define XB_SPIN_CAP (1u << 18)
#define LAS __attribute__((address_space(3)))
DI unsigned xb_ld(unsigned* p) { return __hip_atomic_load(p, __ATOMIC_RELAXED, __HIP_MEMORY_SCOPE_AGENT); }
DI unsigned xb_add(unsigned* p, unsigned v) { return __hip_atomic_fetch_add(p, v, __ATOMIC_RELAXED, __HIP_MEMORY_SCOPE_AGENT); }
DI unsigned xb_xcc_id() { return (unsigned)__builtin_amdgcn_s_getreg((3 << 11) | 20) & 0xFu; }
#define XB_SPIN(cond, bar) do { unsigned _sp = 0; while (cond) { __builtin_amdgcn_s_sleep(1); \
    if ((++_sp & 255u) == 0u) { if (xb_ld(&(bar)[XB_TMO])) break; if (_sp > XB_SPIN_CAP) { atomicAdd(&(bar)[XB_TMO], 1u); break; } } } } while (0)
struct XcdBarrier { unsigned* bar; unsigned x; volatile LAS unsigned* st; };
DI XcdBarrier xcd_barrier_post(unsigned* bar, volatile LAS unsigned* st) {
  XcdBarrier b; b.bar = bar; b.x = xb_xcc_id(); b.st = st;
  if (threadIdx.x == 0) (void)xb_add(&bar[XB_XCNT(b.x)], 1u);
  return b;
}
DI void xcd_barrier_complete(unsigned* bar, unsigned x, unsigned& nloc, unsigned& nx) {
  const unsigned G = gridDim.x * gridDim.y * gridDim.z;
  unsigned sum, cnt, mine, sp = 0u;
  for (;;) {
    sum = 0u; cnt = 0u; mine = 0u;
#pragma unroll
    for (unsigned j = 0; j < 16; ++j) { const unsigned c = xb_ld(&bar[XB_XCNT(j)]); sum += c; cnt += (c > 0u) ? 1u : 0u; mine = (j == x) ? c : mine; }
    if (sum == G) break;
    __builtin_amdgcn_s_sleep(1);
    if ((++sp & 255u) == 0u) { if (xb_ld(&bar[XB_TMO])) break; if (sp > XB_SPIN_CAP) { atomicAdd(&bar[XB_TMO], 1u); break; } }
  }
  nloc = mine > 0u ? mine : 1u; nx = cnt > 0u ? cnt : 1u;
}
DI void xcd_barrier(const XcdBarrier& b) {
  asm volatile("s_waitcnt vmcnt(0)" ::: "memory");
  __syncthreads();
  if (threadIdx.x == 0) {
    unsigned* bar = b.bar;
    __builtin_amdgcn_s_waitcnt(0);
    unsigned nloc = b.st[0], nx = b.st[1];
    if (nloc == 0u) { xcd_barrier_complete(bar, b.x, nloc, nx); b.st[0] = nloc; b.st[1] = nx; }
    const unsigned old = xb_add(&bar[XB_XSUB(b.x)], 1u);
    const unsigned gen = old / nloc;
    if (old + 1u == (gen + 1u) * nloc) {
      __builtin_amdgcn_fence(__ATOMIC_RELEASE, "agent");
      asm volatile("s_waitcnt vmcnt(0)" ::: "memory");
      const unsigned og = xb_add(&bar[XB_TOP], 1u);
      const unsigned tg = og / nx;
      if (og + 1u == (tg + 1u) * nx) xb_add(&bar[XB_TOPGEN], 1u);
      else XB_SPIN(xb_ld(&bar[XB_TOPGEN]) == tg, bar);
      __builtin_amdgcn_fence(__ATOMIC_ACQUIRE, "agent");
      xb_add(&bar[XB_XGEN(b.x)], 1u);
      asm volatile("s_waitcnt vmcnt(0)" ::: "memory");
    } else {
      XB_SPIN(xb_ld(&bar[XB_XGEN(b.x)]) == gen, bar);
      __builtin_amdgcn_fence(__ATOMIC_ACQUIRE, "agent");
      asm volatile("s_waitcnt vmcnt(0)" ::: "memory");
    }
  }
  __syncthreads();
}

__global__ void __launch_bounds__(NTHR, 2) fwd_megakernel(Params p) {
  cg::grid_group grid = cg::this_grid();
  __shared__ __attribute__((aligned(16))) char smem[73728];
  __shared__ int s_item;
  __shared__ uint4 xb_words;
  if (threadIdx.x == 0) xb_words = make_uint4(0u, 0u, 0u, 0u);
  __syncthreads();
  const XcdBarrier xb = xcd_barrier_post((unsigned*)(p.ws + OFF_BAR), (volatile LAS unsigned*)&xb_words);
  char* ws = p.ws;
  float* ctxs = (float*)(ws + OFF_CTX);
  float* mod = (float*)(ws + OFF_MOD);
  u16* hbuf = (u16*)(ws + OFF_H);
  char* big = ws + OFF_BIG;
  u16* Gbuf = (u16*)big;
  const MixBufs m = mixbufs(big);

  for (int rep = 0; rep < REP_MISC; ++rep)
  for (int l = 0; l < 2; ++l) {
    u16* W = (u16*)(ws + OFF_W) + (size_t)l * W_LAYER;
    convT(p.ffn1_gate + (size_t)l * D * DFF, D, DFF, W + W_GU1, 1, smem);
    convT(p.ffn1_up + (size_t)l * D * DFF, D, DFF, W + W_GU1, 2, smem);
    convT(p.ffn1_down + (size_t)l * D * DFF, DFF, D, W + W_D1, 0, smem);
    convT(p.ffn2_gate + (size_t)l * D * DFF, D, DFF, W + W_GU2, 1, smem);
    convT(p.ffn2_up + (size_t)l * D * DFF, D, DFF, W + W_GU2, 2, smem);
    convT(p.ffn2_down + (size_t)l * D * DFF, DFF, D, W + W_D2, 0, smem);
    convT(p.w_in + (size_t)l * D * DIN, D, DIN, W + W_IN, 0, smem);
    convT(p.w_out + (size_t)l * D * D, D, D, W + W_OUT, 0, smem);
    convT(p.mla_w_uq + (size_t)l * 256 * 384, 256, 384, W + W_UQ, 0, smem);
    convT(p.mla_w_ukv + (size_t)l * 128 * 512, 128, 512, W + W_UKV, 0, smem);
    for (int d = 0; d < 2; ++d) {
      convT(p.rw_w2 + (size_t)(l * 2 + d) * 64 * 256, 64, 256, W + W_W2 + (size_t)d * 256 * 64, 0, smem);
      convT(p.rw_a2 + (size_t)(l * 2 + d) * 64 * 256, 64, 256, W + W_A2 + (size_t)d * 256 * 64, 0, smem);
    }
    convT(p.rw_g2 + (size_t)l * 128 * 256, 128, 256, W + W_G2, 0, smem);
    hyfilt_phase(p, l, LQ, (float*)(ws + OFF_FILT + (size_t)l * al(SZ_FILT_L)), smem);
  }
  hyfilt_phase(p, 0, LC, (float*)(ws + OFF_FILTC), smem);
  mod_phase(p, mod, smem);
  grid.sync();

  for (int l = 0; l < 2; ++l) {
    const bool last = (l == 1);
    const u16* W = (u16*)(ws + OFF_W) + (size_t)l * W_LAYER;
    const float* modl = mod + (size_t)l * 9 * 9216;
    const float* lat_in = (l == 0) ? p.x : p.out;
    const float* ctx_in = (l == 0) ? p.ctx : ctxs;

    adaln_phase(lat_in, ctx_in, p.norm_ffn1 + l * D, modl, 0, hbuf, false);
    xcd_barrier(xb);
    {
      EpiGU e{Gbuf};
      for (int rep = 0; rep < REP_GU; ++rep) gemm_phase<true>(hbuf, D, W + W_GU1, D, D, T / 128, 44, 0, false, smem, e);
    }
    xcd_barrier(xb);
    {
      EpiRes e{lat_in, ctx_in, p.out, ctxs, modl, 2, 0.5f, nullptr, nullptr, nullptr, 0};
      gemm_phase<false>(Gbuf, DFF, W + W_D1, DFF, DFF, T / 128, 8, 0, false, smem, e);
    }
    xcd_barrier(xb);
    adaln_phase(p.out, ctxs, p.norm_mix + l * D, modl, 1, hbuf, false);
    xcd_barrier(xb);
    for (int g = 0; g < NG; ++g) {
      const u16* hg = hbuf + (size_t)g * TG * D;
      {
        EpiWin e{m.p, m.pt};
        gemm_phase<false>(hg, D, W + W_IN, D, D, TG / 128, 23, 0, false, smem, e);
      }
      xcd_barrier(xb);
      for (int rep = 0; rep < REP_ROW; ++rep) prep_phase(p, l, g, m, smem);
      xcd_barrier(xb);
      {
        EpiStore e1{m.qup, 384, 384};
        gemm_phase<false>(m.cqn, 256, W + W_UQ, 256, 256, TG / 128, 3, 0, false, smem, e1);
        EpiStore e2{m.kvup, 512, 512};
        gemm_phase<false>(m.ckvn, 128, W + W_UKV, 128, 128, TG / 128, 4, 0, false, smem, e2);
        EpiLoraW e3{m.ef, p.rw_w0 + (l * 2 + 0) * 256};
        gemm_phase<false>(m.lwf, 64, W + W_W2, 64, 64, TG / 128, 2, 0, false, smem, e3);
        EpiLoraW e4{m.eb, p.rw_w0 + (l * 2 + 1) * 256};
        gemm_phase<false>(m.lwb, 64, W + W_W2 + 256 * 64, 64, 64, TG / 128, 2, 0, false, smem, e4);
        EpiLoraA e5{m.af, p.rw_a0 + (l * 2 + 0) * 256};
        gemm_phase<false>(m.laf, 64, W + W_A2, 64, 64, TG / 128, 2, 0, false, smem, e5);
        EpiLoraA e6{m.ab, p.rw_a0 + (l * 2 + 1) * 256};
        gemm_phase<false>(m.lab, 64, W + W_A2 + 256 * 64, 64, 64, TG / 128, 2, 0, false, smem, e6);
        EpiStore e7{m.gg, 256, 256};
        gemm_phase<false>(m.lg, 128, W + W_G2, 128, 128, TG / 128, 2, 0, false, smem, e7);
      }
      xcd_barrier(xb);
      for (int rep = 0; rep < REP_ROW; ++rep) mla_fin_phase(p, l, g, m);
      xcd_barrier(xb);
      {
        u16* ymix = hbuf;
        const int n_scan = BG * 4 * 2 * 4;
        const int qt_per_b = last ? 32 : 34;
        const int n_att = BG * 4 * qt_per_b;
        const int n_hy = 256;
        const int total = n_scan + 2 * n_att + n_hy;
        float gq = 0.f, gk = 0.f, mq = 0.f, mk = 0.f;
        for (int i = 0; i < 64; ++i) { gq = fmaxf(gq, fabsf(p.gqa_q_norm[l * 64 + i])); gk = fmaxf(gk, fabsf(p.gqa_k_norm[l * 64 + i])); }
        for (int i = 0; i < 96; ++i) { mq = fmaxf(mq, fabsf(p.mla_q_norm[l * 96 + i])); mk = fmaxf(mk, fabsf(p.mla_k_norm[l * 96 + i])); }
        const float L2E = 1.4426950408889634f;
        const float sc_g = 0.125f, sc_m = 0.10206207261596575f;
        const float sh_g = (64.f * gq * gk * sc_g * 1.02f + 0.5f) * L2E;
        const float sh_m = (96.f * mq * mk * sc_m * 1.02f + 0.5f) * L2E;
        int* cnt = (int*)(ws + OFF_CNT) + (l * NG + g);
        for (;;) {
          if (threadIdx.x == 0) s_item = atomicAdd(cnt, 1);
          __syncthreads();
          const int it = s_item;
          __syncthreads();
          if (it >= total) break;
          if (it < n_scan) {
            const int bl = it >> 5, hd = (it >> 3) & 3, dir = (it >> 2) & 1, rq = it & 3;
            scan_item(p, l, m, bl, hd, dir, rq, smem);
          } else if (it < n_scan + 2 * n_att) {
            int a = it - n_scan;
            const int kind = a / n_att;
            a -= kind * n_att;
            const int bl = a / (4 * qt_per_b);
            int rem = a - bl * 4 * qt_per_b;
            const int hd = rem / qt_per_b;
            const int qt = rem - hd * qt_per_b;
            const int j0 = qt < 32 ? LC + qt * 128 : (qt - 32) * 128;
            const int nkeys = qt < 32 ? LT : LC;
            const size_t rl0 = (size_t)bl * LT + j0;
            const size_t rg0 = (size_t)(g * BG + bl) * LT + j0;
            if (kind == 0) {
              const int kvh = hd >> 1;
              attn_item<64, 1>(m.qg + rl0 * 256 + hd * 64, 256, m.kg + (size_t)bl * LT * 128 + kvh * 64, 128,
                            m.vtg + (size_t)(bl * 2 + kvh) * 64 * LT, ymix + rg0 * D + 256 + hd * 64, D, nkeys, sc_g * L2E, sh_g, smem);
            } else {
              attn_item<96, 1>(m.qm + rl0 * 384 + hd * 96, 384, m.km + (size_t)bl * LT * 384 + hd * 96, 384,
                            m.vtm + (size_t)(bl * 4 + hd) * 64 * LT, ymix + rg0 * D + 512 + hd * 64, D, nkeys, sc_m * L2E, sh_m, smem);
            }
          } else {
            const int c = it - n_scan - 2 * n_att;
            hyena_pass(p, l, m, (const float*)(ws + OFF_FILT + (size_t)l * al(SZ_FILT_L)), LQ, LC, c, smem);
            if (!last) hyena_pass(p, l, m, (const float*)(ws + OFF_FILTC), LC, 0, c, smem);
          }
        }
        xcd_barrier(xb);
        for (int rep = 0; rep < REP_ROW; ++rep) readout_phase(p, l, g, m, ymix, last, smem);
        xcd_barrier(xb);
      }
    }
    {
      EpiRes e{p.out, ctxs, p.out, ctxs, modl, 5, 1.0f, nullptr, nullptr, nullptr, 0};
      gemm_phase<false>(hbuf, D, W + W_OUT, D, D, T / 128, 8, 0, last, smem, e);
    }
    xcd_barrier(xb);
    adaln_phase(p.out, ctxs, p.norm_ffn2 + l * D, modl, 2, hbuf, last);
    xcd_barrier(xb);
    {
      EpiGU e{Gbuf};
      for (int rep = 0; rep < REP_GU; ++rep) gemm_phase<true>(hbuf, D, W + W_GU2, D, D, T / 128, 44, 0, last, smem, e);
    }
    xcd_barrier(xb);
    {
      EpiRes e{p.out, ctxs, p.out, ctxs, modl, 8, 0.5f, nullptr, nullptr, nullptr, 0};
      gemm_phase<false>(Gbuf, DFF, W + W_D2, DFF, DFF, T / 128, 8, 0, last, smem, e);
    }
    xcd_barrier(xb);
  }
}

extern "C" void kernel_launch(void* const* d_in, const int* in_sizes, int n_in, void* d_out, int out_size, void* d_ws,
                              size_t ws_size, hipStream_t stream) {
  static int grid_blocks = 0;
  if (!grid_blocks) {
    int dev = 0, cus = 0, per_cu = 0;
    (void)hipGetDevice(&dev);
    (void)hipDeviceGetAttribute(&cus, hipDeviceAttributeMultiprocessorCount, dev);
    (void)hipOccupancyMaxActiveBlocksPerMultiprocessor(&per_cu, fwd_megakernel, NTHR, 0);
    if (per_cu > 2) per_cu = 2;
    if (per_cu < 1) per_cu = 1;
    grid_blocks = cus * per_cu;
  }
  Params p{};
  const float** pp = (const float**)&p;
  for (int i = 0; i < 47; ++i) pp[i] = (const float*)d_in[i];
  p.out = (float*)d_out;
  p.ws = (char*)d_ws;
  (void)hipMemsetAsync((char*)d_ws + OFF_CNT, 0, 256 + 3456 * 4, stream);
  void* args[] = {&p};
  hipError_t e = hipLaunchCooperativeKernel((void*)fwd_megakernel, dim3(grid_blocks), dim3(NTHR), args, 0, stream);
  if (e != hipSuccess) fprintf(stderr, "cooperative launch failed: %s (grid %d)\n", hipGetErrorString(e), grid_blocks);
}
```

```cpp
#include <hip/hip_runtime.h>
#include <hip/hip_bf16.h>
#include <hip/hip_cooperative_groups.h>
#include <cstdio>
namespace cg = cooperative_groups;

#define DI __device__ __forceinline__
typedef unsigned short u16;
using bf16x8 = __attribute__((ext_vector_type(8))) short;
using f32x16 = __attribute__((ext_vector_type(16))) float;
typedef __bf16 bf16x2_t __attribute__((ext_vector_type(2)));
typedef float f32x2_t __attribute__((ext_vector_type(2)));
#define MFMA32(a, b, c) __builtin_amdgcn_mfma_f32_32x32x16_bf16((a), (b), (c), 0, 0, 0)

constexpr int D = 1024, NB = 8, LQ = 4096, LC = 256, LT = 4352, T = NB * LT, DFF = 2816, DIN = 2848;
constexpr int HYC = 768, DINP = DIN - HYC;
constexpr int NG = 2, BG = NB / NG, TG = BG * LT;
constexpr int NTHR = 256;
#define REP_MIX 1
#define REP_GU 1
#define REP_MISC 1
#define REP_ROW 1
constexpr float EPS = 1e-6f;

constexpr size_t al(size_t x) { return (x + 255) & ~(size_t)255; }
constexpr size_t OFF_CTX = 0;
constexpr size_t OFF_MOD = OFF_CTX + al((size_t)NB * LC * D * 4);
constexpr size_t SZ_FILT_L = (size_t)(2 * LQ - 1) * 256 * 4;
constexpr size_t SZ_FILT_C = (size_t)(2 * LC - 1) * 256 * 4;
constexpr size_t OFF_CNT = OFF_MOD + al((size_t)2 * 9 * 9216 * 4);
constexpr size_t OFF_BAR = OFF_CNT + 256;
constexpr size_t OFF_FILT = OFF_BAR + al((size_t)3456 * 4);
constexpr size_t OFF_FILTC = OFF_FILT + 2 * al(SZ_FILT_L);
constexpr size_t OFF_ROPEG = OFF_FILTC + al(SZ_FILT_C);
constexpr size_t OFF_ROPEM = OFF_ROPEG + al((size_t)LQ * 32 * 8);
constexpr size_t OFF_W = OFF_ROPEM + al((size_t)LQ * 16 * 8);
constexpr size_t W_GU1 = 0;
constexpr size_t W_D1 = W_GU1 + (size_t)5632 * 1024;
constexpr size_t W_GU2 = W_D1 + (size_t)1024 * 2816;
constexpr size_t W_D2 = W_GU2 + (size_t)5632 * 1024;
constexpr size_t W_IN = W_D2 + (size_t)1024 * 2816;
constexpr size_t W_OUT = W_IN + (size_t)2944 * 1024;
constexpr size_t W_UQ = W_OUT + (size_t)1024 * 1024;
constexpr size_t W_UKV = W_UQ + (size_t)384 * 256;
constexpr size_t W_W2 = W_UKV + (size_t)512 * 128;
constexpr size_t W_A2 = W_W2 + (size_t)2 * 256 * 64;
constexpr size_t W_G2 = W_A2 + (size_t)2 * 256 * 64;
constexpr size_t W_LAYER = W_G2 + (size_t)256 * 128;
constexpr size_t OFF_H = OFF_W + al(2 * W_LAYER * 2);
constexpr size_t OFF_BIG = OFF_H + al((size_t)T * D * 2);
constexpr size_t M_P = 0;
constexpr size_t M_PT = M_P + al((size_t)TG * DINP * 2);
constexpr size_t M_U = M_PT + al((size_t)HYC * TG * 2);
constexpr size_t M_QG = M_U + al((size_t)TG * 256 * 2);
constexpr size_t M_KG = M_QG + al((size_t)TG * 256 * 2);
constexpr size_t M_VTG = M_KG + al((size_t)TG * 128 * 2);
constexpr size_t M_CQN = M_VTG + al((size_t)TG * 128 * 2);
constexpr size_t M_CKVN = M_CQN + al((size_t)TG * 256 * 2);
constexpr size_t M_QUP = M_CKVN + al((size_t)TG * 128 * 2);
constexpr size_t M_KVUP = M_QUP + al((size_t)TG * 384 * 2);
constexpr size_t M_QM = M_KVUP + al((size_t)TG * 512 * 2);
constexpr size_t M_KM = M_QM + al((size_t)TG * 384 * 2);
constexpr size_t M_VTM = M_KM + al((size_t)TG * 384 * 2);
constexpr size_t M_RR = M_VTM + al((size_t)TG * 256 * 2);
constexpr size_t M_RK = M_RR + al((size_t)TG * 256 * 2);
constexpr size_t M_RV = M_RK + al((size_t)TG * 256 * 2);
constexpr size_t M_RKK = M_RV + al((size_t)TG * 256 * 2);
constexpr size_t M_LWF = M_RKK + al((size_t)TG * 256 * 2);
constexpr size_t M_LWB = M_LWF + al((size_t)TG * 64 * 2);
constexpr size_t M_LAF = M_LWB + al((size_t)TG * 64 * 2);
constexpr size_t M_LAB = M_LAF + al((size_t)TG * 64 * 2);
constexpr size_t M_LG = M_LAB + al((size_t)TG * 64 * 2);
constexpr size_t M_EF = M_LG + al((size_t)TG * 128 * 2);
constexpr size_t M_EB = M_EF + al((size_t)TG * 256 * 2);
constexpr size_t M_AF = M_EB + al((size_t)TG * 256 * 2);
constexpr size_t M_AB = M_AF + al((size_t)TG * 256 * 2);
constexpr size_t M_GG = M_AB + al((size_t)TG * 256 * 2);
constexpr size_t M_YF = M_GG + al((size_t)TG * 256 * 2);
constexpr size_t M_YB = M_YF + al((size_t)TG * 256 * 4);
constexpr size_t M_END = M_YB + al((size_t)TG * 256 * 4);
constexpr size_t SZ_G = (size_t)T * DFF * 2;
constexpr size_t WS_NEED = OFF_BIG + (M_END > SZ_G ? M_END : SZ_G);
static_assert(WS_NEED <= (size_t)512 * 1024 * 1024, "workspace too large");

struct Params {
  const float *x, *c, *ctx, *c_ctx, *ada_w, *ada_b, *norm_ffn1, *norm_mix, *norm_ffn2;
  const float *ffn1_gate, *ffn1_up, *ffn1_down, *ffn2_gate, *ffn2_up, *ffn2_down, *w_in, *w_out;
  const float *hy_conv_w, *hy_conv_b, *hy_f_w1, *hy_f_b1, *hy_f_w2, *hy_f_b2, *hy_f_w3, *hy_f_b3, *hy_f_w4, *hy_f_freq, *hy_bias;
  const float *gqa_q_norm, *gqa_k_norm, *mla_cq_norm, *mla_ckv_norm, *mla_w_uq, *mla_w_ukv, *mla_q_norm, *mla_k_norm;
  const float *rw_mu, *rw_w0, *rw_w2, *rw_a0, *rw_a2, *rw_g2, *rw_k_k, *rw_k_a, *rw_r_k, *rw_ln_w, *rw_ln_b;
  float* out;
  char* ws;
};

DI u16 f2bf(float x) {
  unsigned u = __float_as_uint(x);
  u += 0x7fffu + ((u >> 16) & 1u);
  return (u16)(u >> 16);
}
DI float bf2f(u16 b) { return __uint_as_float(((unsigned)b) << 16); }
DI float bflo_(unsigned w) { return __uint_as_float(w << 16); }
DI float bfhi_(unsigned w) { return __uint_as_float(w & 0xffff0000u); }
DI unsigned pack2(float a, float b) {
  f32x2_t v = {a, b};
  bf16x2_t r = __builtin_convertvector(v, bf16x2_t);
  return __builtin_bit_cast(unsigned, r);
}
DI int ltid() {
  int t = threadIdx.x;
  asm volatile("" : "+v"(t));
  return t;
}
DI float wave_sum(float v) {
#pragma unroll
  for (int o = 32; o > 0; o >>= 1) v += __shfl_xor(v, o);
  return v;
}
DI float wave_max(float v) {
#pragma unroll
  for (int o = 32; o > 0; o >>= 1) v = fmaxf(v, __shfl_xor(v, o));
  return v;
}
DI float sigmoidf_(float x) { return 1.f / (1.f + expf(-x)); }
DI int crow(int i, int h) { return (i & 3) + 8 * (i >> 2) + 4 * h; }

DI float rope_apply(float val, int idx, int nfreq, int t, int lane) {
  int pi = idx >> 1;
  int row = t >> 6, col = t & 63;
  float pos = pi < nfreq ? (float)row : (float)col;
  int f = pi < nfreq ? pi : pi - nfreq;
  float inv = exp2f(-(float)f / (float)nfreq * 13.287712379549449f);
  float ang = pos * inv;
  float cs = cosf(ang), sn = sinf(ang);
  float other = __shfl_xor(val, 1);
  return (lane & 1) ? other * sn + val * cs : val * cs - other * sn;
}

DI float rope_tab(float val, int idx, const float2* __restrict__ tab, int lane) {
  const float2 cs = tab[idx >> 1];
  const float other = __shfl_xor(val, 1);
  return (lane & 1) ? other * cs.y + val * cs.x : val * cs.x - other * cs.y;
}
DI void rope_table_phase(float2* __restrict__ tg, float2* __restrict__ tm) {
  const int tid = ltid();
  for (int e = blockIdx.x * NTHR + tid; e < LQ * 48; e += gridDim.x * NTHR) {
    const int t = e / 48, k = e - t * 48;
    const bool isg = k < 32;
    const int pi = isg ? k : k - 32, nfreq = isg ? 16 : 8;
    const int row = t >> 6, col = t & 63;
    const float pos = pi < nfreq ? (float)row : (float)col;
    const int f = pi < nfreq ? pi : pi - nfreq;
    const float inv = exp2f(-(float)f / (float)nfreq * 13.287712379549449f);
    const float ang = pos * inv;
    const float2 v = make_float2(cosf(ang), sinf(ang));
    if (isg) tg[t * 32 + pi] = v; else tm[t * 16 + pi] = v;
  }
}

DI int gu_row(int n, int half) { return (n >> 6) * 128 + ((n >> 5) & 1) * 64 + half * 32 + (n & 31); }
DI void convT(const float* __restrict__ src, int K, int N, u16* __restrict__ dst, int mode, char* smem) {
  float* tile = (float*)smem;
  const int tk = K / 64, tn = (N + 63) / 64;
  const int tid_ = ltid();
  const int j = tid_ & 63, i0 = tid_ >> 6;
  for (int t = blockIdx.x; t < tk * tn; t += gridDim.x) {
    const int k0 = (t / tn) * 64, n0 = (t % tn) * 64;
    for (int i = i0; i < 64; i += 4) {
      int n = n0 + j;
      tile[i * 65 + j] = n < N ? src[(size_t)(k0 + i) * N + n] : 0.f;
    }
    __syncthreads();
    for (int i = i0; i < 64; i += 4) {
      int n = n0 + i;
      if (n < N) {
        int row = mode == 0 ? n : gu_row(n, mode - 1);
        dst[(size_t)row * K + k0 + j] = f2bf(tile[j * 65 + i]);
      }
    }
    __syncthreads();
  }
}

DI void mod_phase(const Params& p, float* __restrict__ mod, char* smem) {
  float* sc = (float*)smem;
  float* red = sc + 9 * 1024;
  const int tid_ = ltid();
  for (int i = tid_; i < 9 * 1024; i += NTHR) {
    float v = i < 8192 ? p.c[i] : p.c_ctx[i - 8192];
    sc[i] = v / (1.f + expf(-v));
  }
  __syncthreads();
  const int lane = tid_ & 63, kp = tid_ >> 6;
  for (int it = blockIdx.x; it < 2 * 144; it += gridDim.x) {
    const int l = it / 144, nb = (it % 144) * 64;
    const float* w = p.ada_w + (size_t)l * 1024 * 9216 + nb + lane;
    float acc[9];
#pragma unroll
    for (int b = 0; b < 9; ++b) acc[b] = 0.f;
    for (int k = kp * 256; k < kp * 256 + 256; ++k) {
      float wv = w[(size_t)k * 9216];
#pragma unroll
      for (int b = 0; b < 9; ++b) acc[b] += sc[b * 1024 + k] * wv;
    }
#pragma unroll
    for (int b = 0; b < 9; ++b) red[(kp * 9 + b) * 64 + lane] = acc[b];
    __syncthreads();
    for (int o = tid_; o < 9 * 64; o += NTHR) {
      int b = o >> 6, ln = o & 63;
      float s = red[(0 * 9 + b) * 64 + ln] + red[(1 * 9 + b) * 64 + ln] + red[(2 * 9 + b) * 64 + ln] + red[(3 * 9 + b) * 64 + ln];
      mod[((size_t)l * 9 + b) * 9216 + nb + ln] = s + p.ada_b[l * 9216 + nb + ln];
    }
    __syncthreads();
  }
}

DI void hyfilt_phase(const Params& p, int l, int L, float* __restrict__ gT, char* smem) {
  float* z = (float*)smem;
  float* h1 = z + 64;
  float* h2 = h1 + 64;
  float* h3 = h2 + 64;
  float* w1s = z + 256;
  float* w2s = w1s + 33 * 64;
  float* w3s = w2s + 64 * 64;
  const float* w4 = p.hy_f_w4 + l * 64 * 512;
  const int tid = ltid();
  for (int i = tid; i < 33 * 64; i += NTHR) w1s[i] = p.hy_f_w1[l * 33 * 64 + i];
  for (int i = tid; i < 64 * 64; i += NTHR) { w2s[i] = p.hy_f_w2[l * 4096 + i]; w3s[i] = p.hy_f_w3[l * 4096 + i]; }
  float b1v = 0.f, b2v = 0.f, b3v = 0.f, frv = 0.f;
  if (tid < 64) { b1v = p.hy_f_b1[l * 64 + tid]; b2v = p.hy_f_b2[l * 64 + tid]; b3v = p.hy_f_b3[l * 64 + tid]; frv = p.hy_f_freq[l * 64 + tid]; }
  const float min_decay = logf(1e-2f) / 1.5f, max_decay = logf(1e-2f) / 0.3f;
  const float delta = fabsf(min_decay + (max_decay - min_decay) * (float)tid / 255.f);
  __syncthreads();
  for (int t = blockIdx.x; t < L; t += gridDim.x) {
    const float t01 = (float)t / (float)(L - 1);
    if (tid < 33) {
      float zz;
      if (tid == 0) zz = t01;
      else {
        int i = (tid - 1) & 15;
        float f = 1e-4f + (float)i * ((15.f - 1e-4f) / 15.f);
        float wang = 6.283185307179586f * (float)t / (float)L;
        zz = tid <= 16 ? cosf(f * wang) : -sinf(f * wang);
      }
      z[tid] = zz;
    }
    __syncthreads();
    if (tid < 64) {
      float a = b1v;
#pragma unroll 11
      for (int i = 0; i < 33; ++i) a += z[i] * w1s[i * 64 + tid];
      h1[tid] = sinf(frv * a);
    }
    __syncthreads();
    if (tid < 64) {
      float a = b2v;
#pragma unroll 16
      for (int i = 0; i < 64; ++i) a += h1[i] * w2s[i * 64 + tid];
      h2[tid] = sinf(frv * a);
    }
    __syncthreads();
    if (tid < 64) {
      float a = b3v;
#pragma unroll 16
      for (int i = 0; i < 64; ++i) a += h2[i] * w3s[i * 64 + tid];
      h3[tid] = sinf(frv * a);
    }
    __syncthreads();
    float af = 0.f, ab = 0.f;
#pragma unroll 8
    for (int i = 0; i < 64; ++i) {
      af += h3[i] * w4[i * 512 + tid];
      ab += h3[i] * w4[i * 512 + 256 + tid];
    }
    const float dec = expf(-t01 * delta);
    af *= dec;
    ab *= dec;
    if (t == 0) gT[(size_t)(L - 1) * 256 + tid] = af + ab;
    else {
      gT[(size_t)(L - 1 + t) * 256 + tid] = af;
      gT[(size_t)(L - 1 - t) * 256 + tid] = ab;
    }
    __syncthreads();
  }
  __syncthreads();
}

DI void adaln_phase(const float* __restrict__ lat, const float* __restrict__ ctxp, const float* __restrict__ gain,
                    const float* __restrict__ modl, int idx, u16* __restrict__ h, bool skip_ctx) {
  const int tid_ = ltid();
  const int wave = tid_ >> 6, lane = tid_ & 63;
  for (int r = blockIdx.x * 4 + wave; r < T; r += gridDim.x * 4) {
    const int b = r / LT, j = r - b * LT;
    if (skip_ctx && j < LC) continue;
    const float* xr = j < LC ? ctxp + ((size_t)(b * LC + j) << 10) : lat + ((size_t)(b * LQ + j - LC) << 10);
    const int bb = j < LC ? 8 : b;
    const float* shift = modl + bb * 9216 + (3 * idx) * 1024;
    const float* scale = shift + 1024;
    float4 v[4];
    float ss = 0.f;
#pragma unroll
    for (int q = 0; q < 4; ++q) {
      v[q] = *(const float4*)(xr + q * 256 + lane * 4);
      ss += v[q].x * v[q].x + v[q].y * v[q].y + v[q].z * v[q].z + v[q].w * v[q].w;
    }
    ss = wave_sum(ss);
    const float rstd = rsqrtf(ss * (1.f / 1024.f) + EPS);
#pragma unroll
    for (int q = 0; q < 4; ++q) {
      const int c = q * 256 + lane * 4;
      float4 g = *(const float4*)(gain + c), sc = *(const float4*)(scale + c), sh = *(const float4*)(shift + c);
      float y0 = v[q].x * rstd * g.x * (1.f + sc.x) + sh.x;
      float y1 = v[q].y * rstd * g.y * (1.f + sc.y) + sh.y;
      float y2 = v[q].z * rstd * g.z * (1.f + sc.z) + sh.z;
      float y3 = v[q].w * rstd * g.w * (1.f + sc.w) + sh.w;
      uint2 o;
      o.x = pack2(y0, y1);
      o.y = pack2(y2, y3);
      *(uint2*)(h + (size_t)r * D + c) = o;
    }
  }
}

template <bool PAIRED, class Epi>
DI void gemm_tile(const u16* __restrict__ A, int lda, const u16* __restrict__ Bt, int ldb, int K, int m0, int n0,
                  char* smem, Epi& epi) {
  u16* As = (u16*)smem;
  u16* Bs = As + 2 * 128 * 72;
  const int tid = ltid(), lane = tid & 63, wave = tid >> 6;
  const int wm = wave >> 1, wn = wave & 1, lr = lane & 31, lh = lane >> 5;
  f32x16 acc[2][2];
#pragma unroll
  for (int a = 0; a < 2; ++a)
#pragma unroll
    for (int b = 0; b < 2; ++b)
#pragma unroll
      for (int i = 0; i < 16; ++i) acc[a][b][i] = 0.f;
  const u16* Ag = A + (size_t)m0 * lda;
  const u16* Bg = Bt + (size_t)n0 * ldb;
  uint4 ra00, ra01, ra02, ra03, rb00, rb01, rb02, rb03, ra10, ra11, ra12, ra13, rb10, rb11, rb12, rb13;
  const int lrow = tid >> 3, lkc = (tid & 7) * 8;
  const u16* Agl = Ag + (size_t)lrow * lda + lkc;
  const u16* Bgl = Bg + (size_t)lrow * ldb + lkc;
#define GEMM_GLOAD(S, kt_)                                            \
  {                                                                   \
    const int k0_ = (kt_) << 6;                                       \
    ra##S##0 = *(const uint4*)(Agl + k0_);                            \
    ra##S##1 = *(const uint4*)(Agl + (size_t)32 * lda + k0_);         \
    ra##S##2 = *(const uint4*)(Agl + (size_t)64 * lda + k0_);         \
    ra##S##3 = *(const uint4*)(Agl + (size_t)96 * lda + k0_);         \
    rb##S##0 = *(const uint4*)(Bgl + k0_);                            \
    rb##S##1 = *(const uint4*)(Bgl + (size_t)32 * ldb + k0_);         \
    rb##S##2 = *(const uint4*)(Bgl + (size_t)64 * ldb + k0_);         \
    rb##S##3 = *(const uint4*)(Bgl + (size_t)96 * ldb + k0_);         \
  }
#define GEMM_LSTORE(S, buf_)                                          \
  {                                                                   \
    u16* ad_ = As + (buf_) * 128 * 72 + lrow * 72 + lkc;              \
    u16* bd_ = Bs + (buf_) * 128 * 72 + lrow * 72 + lkc;              \
    *(uint4*)(ad_) = ra##S##0;                                        \
    *(uint4*)(ad_ + 32 * 72) = ra##S##1;                              \
    *(uint4*)(ad_ + 64 * 72) = ra##S##2;                              \
    *(uint4*)(ad_ + 96 * 72) = ra##S##3;                              \
    *(uint4*)(bd_) = rb##S##0;                                        \
    *(uint4*)(bd_ + 32 * 72) = rb##S##1;                              \
    *(uint4*)(bd_ + 64 * 72) = rb##S##2;                              \
    *(uint4*)(bd_ + 96 * 72) = rb##S##3;                              \
  }
#define GEMM_COMPUTE(buf_)                                                        \
  {                                                                               \
    const u16* as = As + (buf_) * 128 * 72 + (wm * 64 + lr) * 72 + lh * 8;        \
    const u16* bs = Bs + (buf_) * 128 * 72 + (wn * 64 + lr) * 72 + lh * 8;        \
    _Pragma("unroll") for (int ks = 0; ks < 4; ++ks) {                            \
      bf16x8 a0 = *(const bf16x8*)(as + ks * 16);                                 \
      bf16x8 a1 = *(const bf16x8*)(as + 32 * 72 + ks * 16);                       \
      bf16x8 b0 = *(const bf16x8*)(bs + ks * 16);                                 \
      bf16x8 b1 = *(const bf16x8*)(bs + 32 * 72 + ks * 16);                       \
      acc[0][0] = MFMA32(a0, b0, acc[0][0]);                                      \
      acc[0][1] = MFMA32(a0, b1, acc[0][1]);                                      \
      acc[1][0] = MFMA32(a1, b0, acc[1][0]);                                      \
      acc[1][1] = MFMA32(a1, b1, acc[1][1]);                                      \
    }                                                                             \
  }
  const int nk = K >> 6;
  GEMM_GLOAD(0, 0);
  GEMM_LSTORE(0, 0);
  __syncthreads();
  if (nk > 1) GEMM_GLOAD(0, 1);
  for (int kt = 0; kt < nk; kt += 2) {
    if (kt + 2 < nk) GEMM_GLOAD(1, kt + 2);
    GEMM_COMPUTE(0);
    if (kt + 1 < nk) GEMM_LSTORE(0, 1);
    __syncthreads();
    if (kt + 1 >= nk) break;
    if (kt + 3 < nk) GEMM_GLOAD(0, kt + 3);
    GEMM_COMPUTE(1);
    if (kt + 2 < nk) GEMM_LSTORE(1, 0);
    __syncthreads();
  }
  epi.tile(m0);
  if constexpr (Epi::kStaged) {
    float* stg = (float*)smem + wave * 64 * 68;
#pragma unroll
    for (int mi = 0; mi < 2; ++mi)
#pragma unroll
      for (int ni = 0; ni < 2; ++ni)
#pragma unroll
        for (int i = 0; i < 16; ++i) stg[(mi * 32 + crow(i, lh)) * 68 + ni * 32 + lr] = acc[mi][ni][i];
    __syncthreads();
#pragma unroll 4
    for (int k = 0; k < 16; ++k) {
      const int idx = lane + 64 * k, row = idx >> 4, c4 = idx & 15;
      const float4 v = *(const float4*)(stg + row * 68 + c4 * 4);
      epi.row4(m0 + wm * 64 + row, n0 + wn * 64 + c4 * 4, v);
    }
    __syncthreads();
  } else {
#pragma unroll
  for (int mi = 0; mi < 2; ++mi) {
#pragma unroll
    for (int gq = 0; gq < 4; ++gq) {
      const int row0 = m0 + wm * 64 + mi * 32 + 8 * gq + 4 * lh;
      if (PAIRED) {
        const int col = (n0 >> 1) + wn * 32 + lr;
#pragma unroll
        for (int e = 0; e < 4; ++e) epi.pair(row0 + e, col, acc[mi][0][4 * gq + e], acc[mi][1][4 * gq + e]);
      } else {
        epi.quad(row0, n0 + wn * 64 + lr, acc[mi][0][4 * gq], acc[mi][0][4 * gq + 1], acc[mi][0][4 * gq + 2], acc[mi][0][4 * gq + 3]);
        epi.quad(row0, n0 + wn * 64 + 32 + lr, acc[mi][1][4 * gq], acc[mi][1][4 * gq + 1], acc[mi][1][4 * gq + 2], acc[mi][1][4 * gq + 3]);
      }
    }
  }
  }
}

template <bool PAIRED, class Epi>
DI void gemm_phase(const u16* A, int lda, const u16* Bt, int ldb, int K, int mtiles, int ntiles, int mt_off, bool skip_ctx,
                   char* smem, Epi& epi) {
  const int total = mtiles * ntiles;
  const int mtx = mtiles >> 3;
  for (int t = blockIdx.x; t < total; t += gridDim.x) {
    const int xcd = t & 7, q = t >> 3;
    const int sr = q / (8 * ntiles);
    const int rem = q - sr * 8 * ntiles;
    const int rows_in = min(8, mtx - sr * 8);
    const int sc = rem / (rows_in * 8);
    const int r2 = rem - sc * rows_in * 8;
    const int i = r2 % rows_in, j = r2 / rows_in;
    const int mt = (sr * 8 + i) * 8 + xcd, nt = sc * 8 + j;
    if (skip_ctx && ((mt + mt_off) % 34) < 2) continue;
    gemm_tile<PAIRED>(A, lda, Bt, ldb, K, mt * 128, nt * 128, smem, epi);
  }
}

#define EPI_DEFAULT_QUAD                                                   \
  static constexpr bool kStaged = false;                                   \
  DI void row4(int, int, float4) const {}                                  \
  DI void tile(int) {}                                                     \
  DI void quad(int row0, int col, float a, float b, float c, float d) const { \
    (*this)(row0, col, a);                                                 \
    (*this)(row0 + 1, col, b);                                             \
    (*this)(row0 + 2, col, c);                                             \
    (*this)(row0 + 3, col, d);                                             \
  }
struct EpiGU {
  u16* G;
  DI void pair(int row, int col, float g, float u) const {
    float s = g / (1.f + __expf(-g));
    G[(size_t)row * DFF + col] = f2bf(s * u);
  }
  DI void operator()(int, int, float) const {}
  EPI_DEFAULT_QUAD
};
struct EpiRes {
  const float* lat_in; const float* ctx_in; float* lat_out; float* ctx_out; const float* modl; int gate_chunk; float coef;
  const float* tin; float* tout; const float* gate; int tm0;
  static constexpr bool kStaged = true;
  DI void row4(int row, int col, float4 v) const {
    const size_t o = ((size_t)(row - tm0) << 10) + col;
    const float4 x = *(const float4*)(tin + o);
    const float4 g = *(const float4*)(gate + col);
    float4 y;
    y.x = x.x + coef * g.x * v.x;
    y.y = x.y + coef * g.y * v.y;
    y.z = x.z + coef * g.z * v.z;
    y.w = x.w + coef * g.w * v.w;
    *(float4*)(tout + o) = y;
  }
  DI void tile(int m0) {
    const int b = m0 / LT, j = m0 - b * LT;
    const bool isc = j < LC;
    const size_t off = isc ? (((size_t)(b * LC + j)) << 10) : (((size_t)(b * LQ + j - LC)) << 10);
    tin = (isc ? ctx_in : lat_in) + off;
    tout = (isc ? ctx_out : lat_out) + off;
    gate = modl + (isc ? 8 : b) * 9216 + gate_chunk * 1024;
    tm0 = m0;
  }
  DI void operator()(int row, int col, float v) const {
    const size_t o = ((size_t)(row - tm0) << 10) + col;
    tout[o] = tin[o] + coef * gate[col] * v;
  }
  DI void pair(int, int, float, float) const {}
  DI void quad(int row0, int col, float a, float b, float c, float d) const {
    const float gc = coef * gate[col];
    const size_t o = ((size_t)(row0 - tm0) << 10) + col;
    tout[o] = tin[o] + gc * a;
    tout[o + 1024] = tin[o + 1024] + gc * b;
    tout[o + 2048] = tin[o + 2048] + gc * c;
    tout[o + 3072] = tin[o + 3072] + gc * d;
  }
};
struct EpiStore {
  u16* C; int ldc; int N;
  DI void operator()(int row, int col, float v) const { if (col < N) C[(size_t)row * ldc + col] = f2bf(v); }
  DI void pair(int, int, float, float) const {}
  EPI_DEFAULT_QUAD
};
struct EpiWin {
  u16* p; u16* pT;
  static constexpr bool kStaged = false;
  DI void row4(int, int, float4) const {}
  DI void tile(int) {}
  DI void quad(int row0, int col, float a, float b, float c, float d) const {
    if (col < HYC) {
      uint2 w;
      w.x = pack2(a, b);
      w.y = pack2(c, d);
      *(uint2*)(pT + (size_t)col * TG + row0) = w;
    } else if (col < DIN) {
      u16* q = p + (size_t)row0 * DINP + (col - HYC);
      q[0] = f2bf(a);
      q[DINP] = f2bf(b);
      q[2 * DINP] = f2bf(c);
      q[3 * DINP] = f2bf(d);
    }
  }
  DI void pair(int, int, float, float) const {}
};
struct EpiLoraW {
  u16* C; const float* w0;
  DI void operator()(int row, int col, float v) const {
    float zz = -(w0[col] + v);
    float sp = fmaxf(zz, 0.f) + log1pf(expf(-fabsf(zz)));
    C[(size_t)row * 256 + col] = f2bf(-expm1f(-expf(-sp - 0.5f)));
  }
  DI void pair(int, int, float, float) const {}
  EPI_DEFAULT_QUAD
};
struct EpiLoraA {
  u16* C; const float* a0;
  DI void operator()(int row, int col, float v) const { C[(size_t)row * 256 + col] = f2bf(sigmoidf_(a0[col] + v)); }
  DI void pair(int, int, float, float) const {}
  EPI_DEFAULT_QUAD
};

struct MixBufs {
  u16 *p, *pt, *u, *qg, *kg, *vtg, *cqn, *ckvn, *qup, *kvup, *qm, *km, *vtm, *rr, *rk, *rv, *rkk, *lwf, *lwb, *laf, *lab, *lg, *ef, *eb, *af, *ab, *gg;
  float *yf, *yb;
};
DI MixBufs mixbufs(char* big) {
  MixBufs m;
  m.p = (u16*)(big + M_P); m.pt = (u16*)(big + M_PT); m.u = (u16*)(big + M_U); m.qg = (u16*)(big + M_QG); m.kg = (u16*)(big + M_KG);
  m.vtg = (u16*)(big + M_VTG); m.cqn = (u16*)(big + M_CQN); m.ckvn = (u16*)(big + M_CKVN); m.qup = (u16*)(big + M_QUP);
  m.kvup = (u16*)(big + M_KVUP); m.qm = (u16*)(big + M_QM); m.km = (u16*)(big + M_KM); m.vtm = (u16*)(big + M_VTM);
  m.rr = (u16*)(big + M_RR); m.rk = (u16*)(big + M_RK); m.rv = (u16*)(big + M_RV); m.rkk = (u16*)(big + M_RKK);
  m.lwf = (u16*)(big + M_LWF); m.lwb = (u16*)(big + M_LWB); m.laf = (u16*)(big + M_LAF); m.lab = (u16*)(big + M_LAB);
  m.lg = (u16*)(big + M_LG); m.ef = (u16*)(big + M_EF); m.eb = (u16*)(big + M_EB); m.af = (u16*)(big + M_AF);
  m.ab = (u16*)(big + M_AB); m.gg = (u16*)(big + M_GG); m.yf = (float*)(big + M_YF); m.yb = (float*)(big + M_YB);
  return m;
}

DI void prep_phase(const Params& p, int l, int g, const MixBufs& m, const float2* __restrict__ ropeg, char* smem) {
  float* red = (float*)smem;
  const int tid = ltid(), lane = tid & 63, wave = tid >> 6;
  const float* mu = p.rw_mu + l * 1152;
  for (int rl = blockIdx.x; rl < TG; rl += gridDim.x) {
    const int r = g * TG + rl;
    const int b = r / LT, j = r - b * LT, bl = b - g * BG;
    const bool lat = j >= LC;
    const bool hp = lat ? (j > LC) : (j > 0);
    const bool hn = lat ? (j < LT - 1) : (j < LC - 1);
    const u16* pc = m.p + (size_t)rl * DINP;
    const u16* pp = pc - DINP;
    const u16* pn = pc + DINP;
    {
      auto tshift = [&](int crel) -> float {
        const int c = 1696 - HYC + crel;
        float u0 = bf2f(pc[c]);
        float nb = 0.f;
        if (hp) nb += bf2f(pp[c]);
        if (hn) nb += bf2f(pn[c]);
        return u0 + mu[crel] * (0.5f * nb - u0);
      };
      float sr = tshift(tid), sk = tshift(256 + tid), sv = tshift(512 + tid);
      m.rr[(size_t)rl * 256 + tid] = f2bf(sr);
      m.rk[(size_t)rl * 256 + tid] = f2bf(sk);
      m.rv[(size_t)rl * 256 + tid] = f2bf(sv);
      float kx = sk * p.rw_k_k[l * 256 + tid];
      float ss = wave_sum(kx * kx);
      m.rkk[(size_t)rl * 256 + tid] = f2bf(kx / fmaxf(sqrtf(ss), 1e-12f));
      float s4 = tshift(768 + tid);
      if (tid < 64) m.lwf[(size_t)rl * 64 + tid] = f2bf(tanhf(s4));
      else if (tid < 128) m.lwb[(size_t)rl * 64 + tid - 64] = f2bf(tanhf(s4));
      else if (tid < 192) m.laf[(size_t)rl * 64 + tid - 128] = f2bf(s4);
      else m.lab[(size_t)rl * 64 + tid - 192] = f2bf(s4);
      if (tid < 128) {
        float s5 = tshift(1024 + tid);
        m.lg[(size_t)rl * 128 + tid] = f2bf(sigmoidf_(s5));
      }
    }
    {
      float cq = bf2f(pc[1280 - HYC + tid]);
      float ckv = tid < 128 ? bf2f(pc[1536 - HYC + tid]) : 0.f;
      float s1 = wave_sum(cq * cq), s2 = wave_sum(ckv * ckv);
      if (lane == 0) { red[wave] = s1; red[4 + wave] = s2; }
      __syncthreads();
      s1 = red[0] + red[1] + red[2] + red[3];
      s2 = red[4] + red[5] + red[6] + red[7];
      __syncthreads();
      m.cqn[(size_t)rl * 256 + tid] = f2bf(cq * rsqrtf(s1 * (1.f / 256.f) + EPS) * p.mla_cq_norm[l * 256 + tid]);
      if (tid < 128) m.ckvn[(size_t)rl * 128 + tid] = f2bf(ckv * rsqrtf(s2 * (1.f / 128.f) + EPS) * p.mla_ckv_norm[l * 128 + tid]);
    }
    for (int hh = wave; hh < 6; hh += 4) {
      float val = bf2f(pc[hh * 64 + lane]);
      float ss = wave_sum(val * val);
      float gn = hh < 4 ? p.gqa_q_norm[l * 64 + lane] : p.gqa_k_norm[l * 64 + lane];
      val = val * rsqrtf(ss * (1.f / 64.f) + EPS) * gn;
      float rv = rope_tab(val, lane, ropeg + (size_t)(lat ? j - LC : 0) * 32, lane);
      if (lat) val = rv;
      if (hh < 4) m.qg[(size_t)rl * 256 + hh * 64 + lane] = f2bf(val);
      else m.kg[(size_t)rl * 128 + (hh - 4) * 64 + lane] = f2bf(val);
    }
    if (wave < 2) m.vtg[((size_t)(bl * 2 + wave) * 64 + lane) * LT + j] = pc[1152 - HYC + wave * 64 + lane];
  }
}

DI void mla_fin_phase(const Params& p, int l, int g, const MixBufs& m, const float2* __restrict__ ropem) {
  const int tid = ltid(), lane = tid & 63, wave = tid >> 6;
  for (int rl = blockIdx.x; rl < TG; rl += gridDim.x) {
    const int r = g * TG + rl;
    const int b = r / LT, j = r - b * LT, bl = b - g * BG;
    const bool lat = j >= LC;
    for (int s = wave; s < 8; s += 4) {
      const int hd = s & 3;
      const bool isq = s < 4;
      float x0, x1;
      if (isq) {
        x0 = bf2f(m.qup[(size_t)rl * 384 + hd * 96 + lane]);
        x1 = lane < 32 ? bf2f(m.qup[(size_t)rl * 384 + hd * 96 + 64 + lane]) : 0.f;
      } else {
        x0 = bf2f(m.kvup[(size_t)rl * 512 + hd * 128 + lane]);
        x1 = lane < 32 ? bf2f(m.p[(size_t)rl * DINP + 1664 - HYC + lane]) : 0.f;
      }
      float ss = wave_sum(x0 * x0 + x1 * x1);
      const float rstd = rsqrtf(ss * (1.f / 96.f) + EPS);
      const float* gn = isq ? p.mla_q_norm + l * 96 : p.mla_k_norm + l * 96;
      float y0 = x0 * rstd * gn[lane];
      float y1 = lane < 32 ? x1 * rstd * gn[64 + lane] : 0.f;
      float ry = rope_tab(y1, lane & 31, ropem + (size_t)(lat ? j - LC : 0) * 16, lane);
      if (lat) y1 = ry;
      u16* dst = (isq ? m.qm : m.km) + (size_t)rl * 384 + hd * 96;
      dst[lane] = f2bf(y0);
      if (lane < 32) dst[64 + lane] = f2bf(y1);
      if (!isq) m.vtm[((size_t)(bl * 4 + hd) * 64 + lane) * LT + j] = m.kvup[(size_t)rl * 512 + hd * 128 + 64 + lane];
    }
  }
}

template <int DQK, int QT>
DI void attn_item(const u16* __restrict__ q, int ldq, const u16* __restrict__ k, int ldk, const u16* __restrict__ vT,
                  u16* __restrict__ out, int ldo, int nkeys, float sl2, float sh2, char* smem) {
  constexpr int KS = DQK + 8;
  constexpr int NKS = DQK / 16;
  constexpr int KCH = DQK / 8;
  constexpr int KPT = 64 * KCH / NTHR;
  u16* Ks = (u16*)smem;
  u16* Vs = Ks + 2 * 64 * KS;
  const int tid = ltid(), lane = tid & 63, wave = tid >> 6, lr = lane & 31, lh = lane >> 5;
  bf16x8 qf[QT][NKS];
#pragma unroll
  for (int qt = 0; qt < QT; ++qt)
#pragma unroll
    for (int ks = 0; ks < NKS; ++ks)
      qf[qt][ks] = *(const bf16x8*)(q + (size_t)(wave * 32 * QT + qt * 32 + lr) * ldq + ks * 16 + lh * 8);
  f32x16 o[QT][2];
#pragma unroll
  for (int a = 0; a < QT; ++a)
#pragma unroll
    for (int b = 0; b < 2; ++b)
#pragma unroll
      for (int i = 0; i < 16; ++i) o[a][b][i] = 0.f;
  float lsum[QT];
#pragma unroll
  for (int a = 0; a < QT; ++a) lsum[a] = 0.f;
  uint4 rk[KPT], rv[2];
#define ATT_GLOAD(key0)                                                                   \
  {                                                                                       \
    _Pragma("unroll") for (int i = 0; i < KPT; ++i) {                                     \
      const int id = tid + NTHR * i, row = id / KCH, ch = id - row * KCH;                 \
      rk[i] = *(const uint4*)(k + (size_t)((key0) + row) * ldk + ch * 8);                 \
    }                                                                                     \
    _Pragma("unroll") for (int i = 0; i < 2; ++i) {                                       \
      const int id = tid + NTHR * i, row = id >> 3, ch = id & 7;                          \
      rv[i] = *(const uint4*)(vT + (size_t)row * LT + (key0) + ch * 8);                   \
    }                                                                                     \
  }
#define ATT_LSTORE(buf_)                                                                  \
  {                                                                                       \
    _Pragma("unroll") for (int i = 0; i < KPT; ++i) {                                     \
      const int id = tid + NTHR * i, row = id / KCH, ch = id - row * KCH;                 \
      *(uint4*)(Ks + (buf_) * 64 * KS + row * KS + ch * 8) = rk[i];                       \
    }                                                                                     \
    _Pragma("unroll") for (int i = 0; i < 2; ++i) {                                       \
      const int id = tid + NTHR * i, row = id >> 3, ch = id & 7;                          \
      *(uint4*)(Vs + (buf_) * 64 * 72 + row * 72 + ch * 8) = rv[i];                       \
    }                                                                                     \
  }
  ATT_GLOAD(0);
  ATT_LSTORE(0);
  __syncthreads();
  const int nkt = nkeys >> 6;
  for (int kt = 0; kt < nkt; ++kt) {
    const int buf = kt & 1;
    if (kt + 1 < nkt) ATT_GLOAD((kt + 1) << 6);
    const u16* kb = Ks + buf * 64 * KS;
    const u16* vb = Vs + buf * 64 * 72;
#pragma unroll
    for (int half = 0; half < 2; ++half) {
      f32x16 s[QT];
#pragma unroll
      for (int qt = 0; qt < QT; ++qt)
#pragma unroll
        for (int i = 0; i < 16; ++i) s[qt][i] = 0.f;
#pragma unroll
      for (int ks = 0; ks < NKS; ++ks) {
        bf16x8 kf = *(const bf16x8*)(kb + (half * 32 + lr) * KS + ks * 16 + lh * 8);
#pragma unroll
        for (int qt = 0; qt < QT; ++qt) s[qt] = MFMA32(kf, qf[qt][ks], s[qt]);
      }
#pragma unroll
      for (int qt = 0; qt < QT; ++qt)
#pragma unroll
        for (int i = 0; i < 16; ++i) {
          float pv = exp2f(s[qt][i] * sl2 - sh2);
          lsum[qt] += pv;
          s[qt][i] = pv;
        }
#pragma unroll
      for (int st = 0; st < 2; ++st) {
        bf16x8 pb[QT];
#pragma unroll
        for (int qt = 0; qt < QT; ++qt) {
          uint4 w;
          w.x = pack2(s[qt][8 * st + 0], s[qt][8 * st + 1]);
          w.y = pack2(s[qt][8 * st + 2], s[qt][8 * st + 3]);
          w.z = pack2(s[qt][8 * st + 4], s[qt][8 * st + 5]);
          w.w = pack2(s[qt][8 * st + 6], s[qt][8 * st + 7]);
          pb[qt] = __builtin_bit_cast(bf16x8, w);
        }
#pragma unroll
        for (int mt = 0; mt < 2; ++mt) {
          const u16* vp = vb + (mt * 32 + lr) * 72 + half * 32 + st * 16 + lh * 4;
          uint2 v0 = *(const uint2*)(vp);
          uint2 v1 = *(const uint2*)(vp + 8);
          uint4 w;
          w.x = v0.x; w.y = v0.y; w.z = v1.x; w.w = v1.y;
          bf16x8 vf = __builtin_bit_cast(bf16x8, w);
#pragma unroll
          for (int qt = 0; qt < QT; ++qt) o[qt][mt] = MFMA32(vf, pb[qt], o[qt][mt]);
        }
      }
    }
    if (kt + 1 < nkt) ATT_LSTORE(buf ^ 1);
    __syncthreads();
  }
#pragma unroll
  for (int qt = 0; qt < QT; ++qt) {
    float tot = lsum[qt] + __shfl_xor(lsum[qt], 32);
    float inv = 1.f / tot;
    const int row = wave * 32 * QT + qt * 32 + lr;
#pragma unroll
    for (int mt = 0; mt < 2; ++mt)
#pragma unroll
      for (int gq = 0; gq < 4; ++gq) {
        uint2 w;
        w.x = pack2(o[qt][mt][4 * gq + 0] * inv, o[qt][mt][4 * gq + 1] * inv);
        w.y = pack2(o[qt][mt][4 * gq + 2] * inv, o[qt][mt][4 * gq + 3] * inv);
        *(uint2*)(out + (size_t)row * ldo + mt * 32 + 8 * gq + 4 * lh) = w;
      }
  }
}

DI void hyena_pass(const Params& p, int l, const MixBufs& m, const float* __restrict__ gT, int L, int segoff, int c, char* smem) {
  const int RS = L + 16, US = L + 16;
  unsigned* Rc = (unsigned*)smem;
  u16* U = (u16*)(smem + (size_t)2 * RS * 4);
  const int tid = ltid(), lane = tid & 63, wave = tid >> 6;
  for (int d = tid; d < L; d += NTHR) {
    const int q = 2 * d;
    const float r0 = gT[(size_t)(2 * L - 2 - q) * 256 + c];
    const float r1 = (q + 1 <= 2 * L - 2) ? gT[(size_t)(2 * L - 3 - q) * 256 + c] : 0.f;
    const float r2 = (q + 2 <= 2 * L - 2) ? gT[(size_t)(2 * L - 4 - q) * 256 + c] : 0.f;
    Rc[d] = pack2(r0, r1);
    Rc[RS + d] = pack2(r1, r2);
  }
  const float* cw = p.hy_conv_w + l * 3 * 768;
  const float* cb = p.hy_conv_b + l * 768;
  {
    const float w0a = cw[c], w1a = cw[768 + c], w2a = cw[1536 + c], ba = cb[c];
    const float w0v = cw[512 + c], w1v = cw[768 + 512 + c], w2v = cw[1536 + 512 + c], bv = cb[512 + c];
    for (int b = 0; b < BG; ++b) {
      const u16* x1p = m.pt + (size_t)c * TG + b * LT + segoff;
      const u16* vp = m.pt + (size_t)(512 + c) * TG + b * LT + segoff;
      for (int t = tid; t < L; t += NTHR) {
        float x1 = bf2f(x1p[t]) * w1a + ba;
        float vv = bf2f(vp[t]) * w1v + bv;
        if (t > 0) { x1 += bf2f(x1p[t - 1]) * w0a; vv += bf2f(vp[t - 1]) * w0v; }
        if (t < L - 1) { x1 += bf2f(x1p[t + 1]) * w2a; vv += bf2f(vp[t + 1]) * w2v; }
        U[b * US + t] = f2bf(x1 * vv);
      }
    }
  }
  __syncthreads();
  const int i = lane & 31, h = lane >> 5, bn = i & 3, mb = i >> 2;
  const int par = (L - 1 - i) & 1;
  const float bias = p.hy_bias[l * 256 + c];
  const float w0x = cw[256 + c], w1x = cw[768 + 256 + c], w2x = cw[1536 + 256 + c], bx = cb[256 + c];
  const int nsteps = (L + 208) / 16 + 1;
  for (int sp = wave; sp < L / 256; sp += 4) {
    const int T0 = sp * 256;
    f32x16 acc;
#pragma unroll
    for (int r = 0; r < 16; ++r) acc[r] = 0.f;
    const int delta0 = T0 + 224;
    const int q0 = (L - 1) - delta0 - i + 8 * h;
    const unsigned* ap = Rc + par * RS + (q0 >> 1);
    int s0 = T0 + 32 * mb - delta0;
    const u16* bp = U + bn * US + s0 + 8 * h;
#pragma unroll 2
    for (int st = 0; st < nsteps; ++st) {
      uint4 aw;
      aw.x = ap[0]; aw.y = ap[1]; aw.z = ap[2]; aw.w = ap[3];
      uint4 bw = make_uint4(0u, 0u, 0u, 0u);
      if (s0 >= 0 && s0 <= L - 16) bw = *(const uint4*)bp;
      acc = MFMA32(__builtin_bit_cast(bf16x8, aw), __builtin_bit_cast(bf16x8, bw), acc);
      ap += 8;
      s0 += 16;
      bp += 16;
    }
    const u16* x2p = m.pt + (size_t)(256 + c) * TG + bn * LT + segoff;
    u16* yp = m.u + (size_t)c * TG + bn * LT + segoff;
#pragma unroll
    for (int gq = 0; gq < 4; ++gq) {
      const int t4 = T0 + 32 * mb + 8 * gq + 4 * h;
      float e[6];
#pragma unroll
      for (int k = 0; k < 6; ++k) {
        const int tt = t4 - 1 + k;
        e[k] = (tt >= 0 && tt < L) ? bf2f(x2p[tt]) : 0.f;
      }
      const uint2 uu = *(const uint2*)(U + bn * US + t4);
      const float u0 = bflo_(uu.x), u1 = bfhi_(uu.x), u2 = bflo_(uu.y), u3 = bfhi_(uu.y);
      const float y0 = (e[0] * w0x + e[1] * w1x + e[2] * w2x + bx) * (acc[4 * gq + 0] + u0 * bias);
      const float y1 = (e[1] * w0x + e[2] * w1x + e[3] * w2x + bx) * (acc[4 * gq + 1] + u1 * bias);
      const float y2 = (e[2] * w0x + e[3] * w1x + e[4] * w2x + bx) * (acc[4 * gq + 2] + u2 * bias);
      const float y3 = (e[3] * w0x + e[4] * w1x + e[5] * w2x + bx) * (acc[4 * gq + 3] + u3 * bias);
      uint2 w;
      w.x = pack2(y0, y1);
      w.y = pack2(y2, y3);
      *(uint2*)(yp + t4) = w;
    }
  }
  __syncthreads();
}

#define DPP_ROR(v, n) __builtin_bit_cast(float, __builtin_amdgcn_update_dpp(0, __builtin_bit_cast(int, (v)), 0x120 + (n), 0xf, 0xf, true))
DI float row_allsum(float v) {
  v += DPP_ROR(v, 8);
  v += DPP_ROR(v, 4);
  v += DPP_ROR(v, 2);
  v += DPP_ROR(v, 1);
  return v;
}
DI float bflo(unsigned w) { return __uint_as_float(w << 16); }
DI float bfhi(unsigned w) { return __uint_as_float(w & 0xffff0000u); }
DI void scan_item(const Params& p, int l, const MixBufs& m, int bl, int hd, int dir, int rq, char* smem) {
  constexpr int TC = 16;
  constexpr int NCH = LT / TC;
  constexpr int BUF = 5 * TC * 64 + TC * 16;
  float* sbase = (float*)smem;
  float* sy = sbase + 2 * BUF;
  const int tid = ltid(), lane = tid & 63, wave = tid >> 6;
  const int kq = lane & 15, rloc = wave * 4 + (lane >> 4);
  const u16* eD = dir ? m.eb : m.ef;
  const u16* aD = dir ? m.ab : m.af;
  float* yD = dir ? m.yb : m.yf;
  const size_t rbase = (size_t)bl * LT;
  const int ss = tid >> 4, su = tid & 15, sc = su & 7;
  float kav[8];
#pragma unroll
  for (int i = 0; i < 8; ++i) kav[i] = p.rw_k_a[l * 256 + hd * 64 + sc * 8 + i];
  uint4 g0, g1, g2;
  g2.x = g2.y = g2.z = g2.w = 0u;
#define SCAN_JMAP(i) (dir ? ((i) < LC ? LC - 1 - (i) : LT - 1 - ((i) - LC)) : (i))
#define SCAN_GLOAD(i0)                                                                         \
  {                                                                                            \
    const int ii_ = (i0) + ss;                                                                 \
    const int j_ = SCAN_JMAP(ii_);                                                             \
    const size_t o_ = (rbase + j_) * 256 + hd * 64 + sc * 8;                                   \
    if (su < 8) {                                                                              \
      g0 = *(const uint4*)(m.rkk + o_);                                                        \
      g1 = *(const uint4*)(aD + o_);                                                           \
      g2 = *(const uint4*)(m.rk + o_);                                                         \
    } else {                                                                                   \
      g0 = *(const uint4*)(eD + o_);                                                           \
      g1 = *(const uint4*)(m.rr + o_);                                                         \
      if (sc < 2) g2 = *(const uint4*)(m.rv + (rbase + j_) * 256 + hd * 64 + rq * 16 + sc * 8); \
    }                                                                                          \
  }
#define SCAN_LSTORE(buf_)                                                                      \
  {                                                                                            \
    float* B_ = sbase + (buf_) * BUF;                                                          \
    const unsigned w0_[4] = {g0.x, g0.y, g0.z, g0.w};                                          \
    const unsigned w1_[4] = {g1.x, g1.y, g1.z, g1.w};                                          \
    const unsigned w2_[4] = {g2.x, g2.y, g2.z, g2.w};                                          \
    if (su < 8) {                                                                              \
      float kk_[8], bb_[8], dd_[8];                                                            \
      _Pragma("unroll") for (int q_ = 0; q_ < 4; ++q_) {                                       \
        const float k0_ = bflo(w0_[q_]), k1_ = bfhi(w0_[q_]);                                  \
        const float a0_ = bflo(w1_[q_]), a1_ = bfhi(w1_[q_]);                                  \
        const float v0_ = bflo(w2_[q_]), v1_ = bfhi(w2_[q_]);                                  \
        kk_[2 * q_] = k0_; kk_[2 * q_ + 1] = k1_;                                              \
        bb_[2 * q_] = k0_ * a0_; bb_[2 * q_ + 1] = k1_ * a1_;                                  \
        dd_[2 * q_] = v0_ * (1.f + (a0_ - 1.f) * kav[2 * q_]);                                 \
        dd_[2 * q_ + 1] = v1_ * (1.f + (a1_ - 1.f) * kav[2 * q_ + 1]);                         \
      }                                                                                        \
      float* d0_ = B_ + ss * 64 + sc * 8;                                                      \
      *(float4*)(d0_) = make_float4(kk_[0], kk_[1], kk_[2], kk_[3]);                           \
      *(float4*)(d0_ + 4) = make_float4(kk_[4], kk_[5], kk_[6], kk_[7]);                       \
      *(float4*)(d0_ + 2048) = make_float4(bb_[0], bb_[1], bb_[2], bb_[3]);                    \
      *(float4*)(d0_ + 2052) = make_float4(bb_[4], bb_[5], bb_[6], bb_[7]);                    \
      *(float4*)(d0_ + 3072) = make_float4(dd_[0], dd_[1], dd_[2], dd_[3]);                    \
      *(float4*)(d0_ + 3076) = make_float4(dd_[4], dd_[5], dd_[6], dd_[7]);                    \
    } else {                                                                                   \
      float ww_[8], rr_[8], vv_[8];                                                            \
      _Pragma("unroll") for (int q_ = 0; q_ < 4; ++q_) {                                       \
        ww_[2 * q_] = 1.f - bflo(w0_[q_]); ww_[2 * q_ + 1] = 1.f - bfhi(w0_[q_]);              \
        rr_[2 * q_] = bflo(w1_[q_]); rr_[2 * q_ + 1] = bfhi(w1_[q_]);                          \
        vv_[2 * q_] = bflo(w2_[q_]); vv_[2 * q_ + 1] = bfhi(w2_[q_]);                          \
      }                                                                                        \
      float* d0_ = B_ + ss * 64 + sc * 8;                                                      \
      *(float4*)(d0_ + 1024) = make_float4(ww_[0], ww_[1], ww_[2], ww_[3]);                    \
      *(float4*)(d0_ + 1028) = make_float4(ww_[4], ww_[5], ww_[6], ww_[7]);                    \
      *(float4*)(d0_ + 4096) = make_float4(rr_[0], rr_[1], rr_[2], rr_[3]);                    \
      *(float4*)(d0_ + 4100) = make_float4(rr_[4], rr_[5], rr_[6], rr_[7]);                    \
      if (sc < 2) {                                                                            \
        float* d1_ = B_ + 5120 + ss * 16 + sc * 8;                                             \
        *(float4*)(d1_) = make_float4(vv_[0], vv_[1], vv_[2], vv_[3]);                         \
        *(float4*)(d1_ + 4) = make_float4(vv_[4], vv_[5], vv_[6], vv_[7]);                     \
      }                                                                                        \
    }                                                                                          \
  }
  f32x2_t SA = {0.f, 0.f}, SB = {0.f, 0.f};
  __builtin_amdgcn_s_setprio(3);
  SCAN_GLOAD(0);
  SCAN_LSTORE(0);
  __syncthreads();
  for (int c = 0; c < NCH; ++c) {
    const int buf = c & 1;
    if (c + 1 < NCH) SCAN_GLOAD((c + 1) * TC);
    const float* B = sbase + buf * BUF;
    float* syb = sy + buf * TC * 16;
    float ypart[TC];
    float4 kk = *(const float4*)(B + kq * 4);
    float4 ww = *(const float4*)(B + 1024 + kq * 4);
    float4 bb = *(const float4*)(B + 2048 + kq * 4);
    float4 dd = *(const float4*)(B + 3072 + kq * 4);
    float4 rr = *(const float4*)(B + 4096 + kq * 4);
    float vv = B[5120 + rloc];
#pragma unroll
    for (int st = 0; st < TC; ++st) {
      float4 kkn = kk, wwn = ww, bbn = bb, ddn = dd, rrn = rr;
      float vvn = vv;
      if (st + 1 < TC) {
        kkn = *(const float4*)(B + (st + 1) * 64 + kq * 4);
        wwn = *(const float4*)(B + 1024 + (st + 1) * 64 + kq * 4);
        bbn = *(const float4*)(B + 2048 + (st + 1) * 64 + kq * 4);
        ddn = *(const float4*)(B + 3072 + (st + 1) * 64 + kq * 4);
        rrn = *(const float4*)(B + 4096 + (st + 1) * 64 + kq * 4);
        vvn = B[5120 + (st + 1) * 16 + rloc];
      }
      const f32x2_t k01 = {kk.x, kk.y}, k23 = {kk.z, kk.w}, w01 = {ww.x, ww.y}, w23 = {ww.z, ww.w};
      const f32x2_t b01 = {bb.x, bb.y}, b23 = {bb.z, bb.w}, d01 = {dd.x, dd.y}, d23 = {dd.z, dd.w};
      const f32x2_t r01 = {rr.x, rr.y}, r23 = {rr.z, rr.w}, v2 = {vv, vv};
      const f32x2_t pp2 = SA * k01 + SB * k23;
      const float part = pp2.x + pp2.y;
      const f32x2_t cA = SA * w01 + v2 * d01, cB = SB * w23 + v2 * d23;
      const float sa = -row_allsum(part);
      const f32x2_t sa2 = {sa, sa};
      SA = cA + sa2 * b01;
      SB = cB + sa2 * b23;
      const f32x2_t yy2 = SA * r01 + SB * r23;
      ypart[st] = yy2.x + yy2.y;
      kk = kkn; ww = wwn; bb = bbn; dd = ddn; rr = rrn; vv = vvn;
    }
#pragma unroll
    for (int st = 0; st < TC; ++st) ypart[st] = row_allsum(ypart[st]);
    if (kq == 0) {
#pragma unroll
      for (int st = 0; st < TC; ++st) syb[st * 16 + rloc] = ypart[st];
    }
    if (c + 1 < NCH) SCAN_LSTORE(buf ^ 1);
    __syncthreads();
    {
      const int st = tid >> 4, r_ = tid & 15;
      const int ii = c * TC + st;
      const int j = SCAN_JMAP(ii);
      yD[(rbase + j) * 256 + hd * 64 + rq * 16 + r_] = syb[st * 16 + r_];
    }
  }
  __builtin_amdgcn_s_setprio(0);
  __syncthreads();
}

DI void readout_phase(const Params& p, int l, int g, const MixBufs& m, u16* __restrict__ ymix, bool skip_ctx, char* smem) {
  const int tid = ltid();
  {
    u16* tile = (u16*)smem;
    for (int tl = blockIdx.x; tl < (TG / 64) * 4; tl += gridDim.x) {
      const int rl0 = (tl >> 2) * 64, c0 = (tl & 3) * 64;
      const int r0 = g * TG + rl0;
      if (skip_ctx && (r0 % LT) < LC) continue;
#pragma unroll
      for (int k = 0; k < 2; ++k) {
        const int id = tid + NTHR * k, ch = id >> 3, part = id & 7;
        *(uint4*)(tile + ch * 72 + part * 8) = *(const uint4*)(m.u + (size_t)(c0 + ch) * TG + rl0 + part * 8);
      }
      __syncthreads();
#pragma unroll
      for (int k = 0; k < 2; ++k) {
        const int id = tid + NTHR * k, tok = id >> 3, part = id & 7;
        const u16* tp = tile + (part * 8) * 72 + tok;
        uint4 w;
        w.x = (unsigned)tp[0] | ((unsigned)tp[72] << 16);
        w.y = (unsigned)tp[2 * 72] | ((unsigned)tp[3 * 72] << 16);
        w.z = (unsigned)tp[4 * 72] | ((unsigned)tp[5 * 72] << 16);
        w.w = (unsigned)tp[6 * 72] | ((unsigned)tp[7 * 72] << 16);
        *(uint4*)(ymix + (size_t)(r0 + tok) * D + c0 + part * 8) = w;
      }
      __syncthreads();
    }
  }
  for (int rl = blockIdx.x; rl < TG; rl += gridDim.x) {
    const int r = g * TG + rl;
    const int j = r % LT;
    if (skip_ctx && j < LC) continue;
    const size_t o = (size_t)rl * 256 + tid;
    float y = m.yf[o] + m.yb[o];
    float mean = wave_sum(y) * (1.f / 64.f);
    float dv = y - mean;
    float var = wave_sum(dv * dv) * (1.f / 64.f);
    float yn = dv * rsqrtf(var + 64e-5f) * p.rw_ln_w[l * 256 + tid] + p.rw_ln_b[l * 256 + tid];
    const float rr = bf2f(m.rr[o]), kv = bf2f(m.rk[o]), vv = bf2f(m.rv[o]);
    const float kaa = p.rw_k_a[l * 256 + tid], rk = p.rw_r_k[l * 256 + tid];
    const float af = bf2f(m.af[o]), ab = bf2f(m.ab[o]);
    float t1 = rr * kv * (1.f + (af - 1.f) * kaa) * rk + rr * kv * (1.f + (ab - 1.f) * kaa) * rk;
    float bonus = wave_sum(t1) * vv;
    ymix[(size_t)r * D + 768 + tid] = f2bf((yn + bonus) * bf2f(m.gg[o]));
  }
}

#define XB_TMO      128
#define XB_XCNT(j)  (256  + 64 * (j))
#define XB_XSUB(j)  (1280 + 64 * (j))
#define XB_XGEN(j)  (2304 + 64 * (j))
#define XB_TOP      3328
#define XB_TOPGEN   3392
#define XCD_BAR_WORDS 3456
#define XB_SPIN_CAP (1u << 18)
#define LAS __attribute__((address_space(3)))
DI unsigned xb_ld(unsigned* p) { return __hip_atomic_load(p, __ATOMIC_RELAXED, __HIP_MEMORY_SCOPE_AGENT); }
DI unsigned xb_add(unsigned* p, unsigned v) { return __hip_atomic_fetch_add(p, v, __ATOMIC_RELAXED, __HIP_MEMORY_SCOPE_AGENT); }
DI unsigned xb_xcc_id() { return (unsigned)__builtin_amdgcn_s_getreg((3 << 11) | 20) & 0xFu; }
#define XB_SPIN(cond, bar) do { unsigned _sp = 0; while (cond) { __builtin_amdgcn_s_sleep(1); \
    if ((++_sp & 255u) == 0u) { if (xb_ld(&(bar)[XB_TMO])) break; if (_sp > XB_SPIN_CAP) { atomicAdd(&(bar)[XB_TMO], 1u); break; } } } } while (0)
struct XcdBarrier { unsigned* bar; unsigned x; volatile LAS unsigned* st; };
DI XcdBarrier xcd_barrier_post(unsigned* bar, volatile LAS unsigned* st) {
  XcdBarrier b; b.bar = bar; b.x = xb_xcc_id(); b.st = st;
  if (threadIdx.x == 0) (void)xb_add(&bar[XB_XCNT(b.x)], 1u);
  return b;
}
DI void xcd_barrier_complete(unsigned* bar, unsigned x, unsigned& nloc, unsigned& nx) {
  const unsigned G = gridDim.x * gridDim.y * gridDim.z;
  unsigned sum, cnt, mine, sp = 0u;
  for (;;) {
    sum = 0u; cnt = 0u; mine = 0u;
#pragma unroll
    for (unsigned j = 0; j < 16; ++j) { const unsigned c = xb_ld(&bar[XB_XCNT(j)]); sum += c; cnt += (c > 0u) ? 1u : 0u; mine = (j == x) ? c : mine; }
    if (sum == G) break;
    __builtin_amdgcn_s_sleep(1);
    if ((++sp & 255u) == 0u) { if (xb_ld(&bar[XB_TMO])) break; if (sp > XB_SPIN_CAP) { atomicAdd(&bar[XB_TMO], 1u); break; } }
  }
  nloc = mine > 0u ? mine : 1u; nx = cnt > 0u ? cnt : 1u;
}
DI void xcd_barrier(const XcdBarrier& b) {
  asm volatile("s_waitcnt vmcnt(0)" ::: "memory");
  __syncthreads();
  if (threadIdx.x == 0) {
    unsigned* bar = b.bar;
    __builtin_amdgcn_s_waitcnt(0);
    unsigned nloc = b.st[0], nx = b.st[1];
    if (nloc == 0u) { xcd_barrier_complete(bar, b.x, nloc, nx); b.st[0] = nloc; b.st[1] = nx; }
    const unsigned old = xb_add(&bar[XB_XSUB(b.x)], 1u);
    const unsigned gen = old / nloc;
    if (old + 1u == (gen + 1u) * nloc) {
      __builtin_amdgcn_fence(__ATOMIC_RELEASE, "agent");
      asm volatile("s_waitcnt vmcnt(0)" ::: "memory");
      const unsigned og = xb_add(&bar[XB_TOP], 1u);
      const unsigned tg = og / nx;
      if (og + 1u == (tg + 1u) * nx) xb_add(&bar[XB_TOPGEN], 1u);
      else XB_SPIN(xb_ld(&bar[XB_TOPGEN]) == tg, bar);
      __builtin_amdgcn_fence(__ATOMIC_ACQUIRE, "agent");
      xb_add(&bar[XB_XGEN(b.x)], 1u);
      asm volatile("s_waitcnt vmcnt(0)" ::: "memory");
    } else {
      XB_SPIN(xb_ld(&bar[XB_XGEN(b.x)]) == gen, bar);
      __builtin_amdgcn_fence(__ATOMIC_ACQUIRE, "agent");
      asm volatile("s_waitcnt vmcnt(0)" ::: "memory");
    }
  }
  __syncthreads();
}

__global__ void __launch_bounds__(NTHR, 2) fwd_megakernel(Params p) {
  cg::grid_group grid = cg::this_grid();
  __shared__ __attribute__((aligned(16))) char smem[73728];
  __shared__ int s_item;
  __shared__ uint4 xb_words;
  if (threadIdx.x == 0) xb_words = make_uint4(0u, 0u, 0u, 0u);
  __syncthreads();
  const XcdBarrier xb = xcd_barrier_post((unsigned*)(p.ws + OFF_BAR), (volatile LAS unsigned*)&xb_words);
  char* ws = p.ws;
  float* ctxs = (float*)(ws + OFF_CTX);
  float* mod = (float*)(ws + OFF_MOD);
  u16* hbuf = (u16*)(ws + OFF_H);
  char* big = ws + OFF_BIG;
  u16* Gbuf = (u16*)big;
  const MixBufs m = mixbufs(big);

  for (int rep = 0; rep < REP_MISC; ++rep)
  for (int l = 0; l < 2; ++l) {
    u16* W = (u16*)(ws + OFF_W) + (size_t)l * W_LAYER;
    convT(p.ffn1_gate + (size_t)l * D * DFF, D, DFF, W + W_GU1, 1, smem);
    convT(p.ffn1_up + (size_t)l * D * DFF, D, DFF, W + W_GU1, 2, smem);
    convT(p.ffn1_down + (size_t)l * D * DFF, DFF, D, W + W_D1, 0, smem);
    convT(p.ffn2_gate + (size_t)l * D * DFF, D, DFF, W + W_GU2, 1, smem);
    convT(p.ffn2_up + (size_t)l * D * DFF, D, DFF, W + W_GU2, 2, smem);
    convT(p.ffn2_down + (size_t)l * D * DFF, DFF, D, W + W_D2, 0, smem);
    convT(p.w_in + (size_t)l * D * DIN, D, DIN, W + W_IN, 0, smem);
    convT(p.w_out + (size_t)l * D * D, D, D, W + W_OUT, 0, smem);
    convT(p.mla_w_uq + (size_t)l * 256 * 384, 256, 384, W + W_UQ, 0, smem);
    convT(p.mla_w_ukv + (size_t)l * 128 * 512, 128, 512, W + W_UKV, 0, smem);
    for (int d = 0; d < 2; ++d) {
      convT(p.rw_w2 + (size_t)(l * 2 + d) * 64 * 256, 64, 256, W + W_W2 + (size_t)d * 256 * 64, 0, smem);
      convT(p.rw_a2 + (size_t)(l * 2 + d) * 64 * 256, 64, 256, W + W_A2 + (size_t)d * 256 * 64, 0, smem);
    }
    convT(p.rw_g2 + (size_t)l * 128 * 256, 128, 256, W + W_G2, 0, smem);
    hyfilt_phase(p, l, LQ, (float*)(ws + OFF_FILT + (size_t)l * al(SZ_FILT_L)), smem);
  }
  hyfilt_phase(p, 0, LC, (float*)(ws + OFF_FILTC), smem);
  rope_table_phase((float2*)(ws + OFF_ROPEG), (float2*)(ws + OFF_ROPEM));
  mod_phase(p, mod, smem);
  grid.sync();

  for (int l = 0; l < 2; ++l) {
    const bool last = (l == 1);
    const u16* W = (u16*)(ws + OFF_W) + (size_t)l * W_LAYER;
    const float* modl = mod + (size_t)l * 9 * 9216;
    const float* lat_in = (l == 0) ? p.x : p.out;
    const float* ctx_in = (l == 0) ? p.ctx : ctxs;

    adaln_phase(lat_in, ctx_in, p.norm_ffn1 + l * D, modl, 0, hbuf, false);
    xcd_barrier(xb);
    {
      EpiGU e{Gbuf};
      for (int rep = 0; rep < REP_GU; ++rep) gemm_phase<true>(hbuf, D, W + W_GU1, D, D, T / 128, 44, 0, false, smem, e);
    }
    xcd_barrier(xb);
    {
      EpiRes e{lat_in, ctx_in, p.out, ctxs, modl, 2, 0.5f, nullptr, nullptr, nullptr, 0};
      gemm_phase<false>(Gbuf, DFF, W + W_D1, DFF, DFF, T / 128, 8, 0, false, smem, e);
    }
    xcd_barrier(xb);
    adaln_phase(p.out, ctxs, p.norm_mix + l * D, modl, 1, hbuf, false);
    xcd_barrier(xb);
    for (int g = 0; g < NG; ++g) {
      const u16* hg = hbuf + (size_t)g * TG * D;
      {
        EpiWin e{m.p, m.pt};
        gemm_phase<false>(hg, D, W + W_IN, D, D, TG / 128, 23, 0, false, smem, e);
      }
      xcd_barrier(xb);
      for (int rep = 0; rep < REP_ROW; ++rep) prep_phase(p, l, g, m, (const float2*)(ws + OFF_ROPEG), smem);
      xcd_barrier(xb);
      {
        EpiStore e1{m.qup, 384, 384};
        gemm_phase<false>(m.cqn, 256, W + W_UQ, 256, 256, TG / 128, 3, 0, false, smem, e1);
        EpiStore e2{m.kvup, 512, 512};
        gemm_phase<false>(m.ckvn, 128, W + W_UKV, 128, 128, TG / 128, 4, 0, false, smem, e2);
        EpiLoraW e3{m.ef, p.rw_w0 + (l * 2 + 0) * 256};
        gemm_phase<false>(m.lwf, 64, W + W_W2, 64, 64, TG / 128, 2, 0, false, smem, e3);
        EpiLoraW e4{m.eb, p.rw_w0 + (l * 2 + 1) * 256};
        gemm_phase<false>(m.lwb, 64, W + W_W2 + 256 * 64, 64, 64, TG / 128, 2, 0, false, smem, e4);
        EpiLoraA e5{m.af, p.rw_a0 + (l * 2 + 0) * 256};
        gemm_phase<false>(m.laf, 64, W + W_A2, 64, 64, TG / 128, 2, 0, false, smem, e5);
        EpiLoraA e6{m.ab, p.rw_a0 + (l * 2 + 1) * 256};
        gemm_phase<false>(m.lab, 64, W + W_A2 + 256 * 64, 64, 64, TG / 128, 2, 0, false, smem, e6);
        EpiStore e7{m.gg, 256, 256};
        gemm_phase<false>(m.lg, 128, W + W_G2, 128, 128, TG / 128, 2, 0, false, smem, e7);
      }
      xcd_barrier(xb);
      for (int rep = 0; rep < REP_ROW; ++rep) mla_fin_phase(p, l, g, m, (const float2*)(ws + OFF_ROPEM));
      xcd_barrier(xb);
      {
        u16* ymix = hbuf;
        const int n_scan = BG * 4 * 2 * 4;
        const int qt_per_b = last ? 32 : 34;
        const int n_att = BG * 4 * qt_per_b;
        const int n_hy = 256;
        const int total = n_scan + 2 * n_att + n_hy;
        float gq = 0.f, gk = 0.f, mq = 0.f, mk = 0.f;
        for (int i = 0; i < 64; ++i) { gq = fmaxf(gq, fabsf(p.gqa_q_norm[l * 64 + i])); gk = fmaxf(gk, fabsf(p.gqa_k_norm[l * 64 + i])); }
        for (int i = 0; i < 96; ++i) { mq = fmaxf(mq, fabsf(p.mla_q_norm[l * 96 + i])); mk = fmaxf(mk, fabsf(p.mla_k_norm[l * 96 + i])); }
        const float L2E = 1.4426950408889634f;
        const float sc_g = 0.125f, sc_m = 0.10206207261596575f;
        const float sh_g = (64.f * gq * gk * sc_g * 1.02f + 0.5f) * L2E;
        const float sh_m = (96.f * mq * mk * sc_m * 1.02f + 0.5f) * L2E;
        int* cnt = (int*)(ws + OFF_CNT) + (l * NG + g);
        for (;;) {
          if (threadIdx.x == 0) s_item = atomicAdd(cnt, 1);
          __syncthreads();
          const int it = s_item;
          __syncthreads();
          if (it >= total) break;
          if (it < n_scan) {
            const int bl = it >> 5, hd = (it >> 3) & 3, dir = (it >> 2) & 1, rq = it & 3;
            scan_item(p, l, m, bl, hd, dir, rq, smem);
          } else if (it < n_scan + 2 * n_att) {
            int a = it - n_scan;
            const int kind = a / n_att;
            a -= kind * n_att;
            const int bl = a / (4 * qt_per_b);
            int rem = a - bl * 4 * qt_per_b;
            const int hd = rem / qt_per_b;
            const int qt = rem - hd * qt_per_b;
            const int j0 = qt < 32 ? LC + qt * 128 : (qt - 32) * 128;
            const int nkeys = qt < 32 ? LT : LC;
            const size_t rl0 = (size_t)bl * LT + j0;
            const size_t rg0 = (size_t)(g * BG + bl) * LT + j0;
            if (kind == 0) {
              const int kvh = hd >> 1;
              attn_item<64, 1>(m.qg + rl0 * 256 + hd * 64, 256, m.kg + (size_t)bl * LT * 128 + kvh * 64, 128,
                            m.vtg + (size_t)(bl * 2 + kvh) * 64 * LT, ymix + rg0 * D + 256 + hd * 64, D, nkeys, sc_g * L2E, sh_g, smem);
            } else {
              attn_item<96, 1>(m.qm + rl0 * 384 + hd * 96, 384, m.km + (size_t)bl * LT * 384 + hd * 96, 384,
                            m.vtm + (size_t)(bl * 4 + hd) * 64 * LT, ymix + rg0 * D + 512 + hd * 64, D, nkeys, sc_m * L2E, sh_m, smem);
            }
          } else {
            const int c = it - n_scan - 2 * n_att;
            hyena_pass(p, l, m, (const float*)(ws + OFF_FILT + (size_t)l * al(SZ_FILT_L)), LQ, LC, c, smem);
            if (!last) hyena_pass(p, l, m, (const float*)(ws + OFF_FILTC), LC, 0, c, smem);
          }
        }
        xcd_barrier(xb);
        for (int rep = 0; rep < REP_ROW; ++rep) readout_phase(p, l, g, m, ymix, last, smem);
        xcd_barrier(xb);
      }
    }
    {
      EpiRes e{p.out, ctxs, p.out, ctxs, modl, 5, 1.0f, nullptr, nullptr, nullptr, 0};
      gemm_phase<false>(hbuf, D, W + W_OUT, D, D, T / 128, 8, 0, last, smem, e);
    }
    xcd_barrier(xb);
    adaln_phase(p.out, ctxs, p.norm_ffn2 + l * D, modl, 2, hbuf, last);
    xcd_barrier(xb);
    {
      EpiGU e{Gbuf};
      for (int rep = 0; rep < REP_GU; ++rep) gemm_phase<true>(hbuf, D, W + W_GU2, D, D, T / 128, 44, 0, last, smem, e);
    }
    xcd_barrier(xb);
    {
      EpiRes e{p.out, ctxs, p.out, ctxs, modl, 8, 0.5f, nullptr, nullptr, nullptr, 0};
      gemm_phase<false>(Gbuf, DFF, W + W_D2, DFF, DFF, T / 128, 8, 0, last, smem, e);
    }
    xcd_barrier(xb);
  }
}

extern "C" void kernel_launch(void* const* d_in, const int* in_sizes, int n_in, void* d_out, int out_size, void* d_ws,
                              size_t ws_size, hipStream_t stream) {
  static int grid_blocks = 0;
  if (!grid_blocks) {
    int dev = 0, cus = 0, per_cu = 0;
    (void)hipGetDevice(&dev);
    (void)hipDeviceGetAttribute(&cus, hipDeviceAttributeMultiprocessorCount, dev);
    (void)hipOccupancyMaxActiveBlocksPerMultiprocessor(&per_cu, fwd_megakernel, NTHR, 0);
    if (per_cu > 2) per_cu = 2;
    if (per_cu < 1) per_cu = 1;
    grid_blocks = cus * per_cu;
  }
  Params p{};
  const float** pp = (const float**)&p;
  for (int i = 0; i < 47; ++i) pp[i] = (const float*)d_in[i];
  p.out = (float*)d_out;
  p.ws = (char*)d_ws;
  (void)hipMemsetAsync((char*)d_ws + OFF_CNT, 0, 256 + 3456 * 4, stream);
  void* args[] = {&p};
  hipError_t e = hipLaunchCooperativeKernel((void*)fwd_megakernel, dim3(grid_blocks), dim3(NTHR), args, 0, stream);
  if (e != hipSuccess) fprintf(stderr, "cooperative launch failed: %s (grid %d)\n", hipGetErrorString(e), grid_blocks);
}
```

```cpp
#include <hip/hip_runtime.h>
#include <hip/hip_bf16.h>
#include <hip/hip_cooperative_groups.h>
#include <cstdio>
namespace cg = cooperative_groups;

#define DI __device__ __forceinline__
typedef unsigned short u16;
using bf16x8 = __attribute__((ext_vector_type(8))) short;
using f32x16 = __attribute__((ext_vector_type(16))) float;
typedef __bf16 bf16x2_t __attribute__((ext_vector_type(2)));
typedef float f32x2_t __attribute__((ext_vector_type(2)));
#define MFMA32(a, b, c) __builtin_amdgcn_mfma_f32_32x32x16_bf16((a), (b), (c), 0, 0, 0)

constexpr int D = 1024, NB = 8, LQ = 4096, LC = 256, LT = 4352, T = NB * LT, DFF = 2816, DIN = 2848;
constexpr int HYC = 768, DINP = DIN - HYC;
constexpr int NG = 2, BG = NB / NG, TG = BG * LT;
constexpr int NTHR = 256;
#define REP_MIX 1
#define REP_GU 1
#define REP_MISC 1
#define REP_ROW 1
constexpr float EPS = 1e-6f;

constexpr size_t al(size_t x) { return (x + 255) & ~(size_t)255; }
constexpr size_t OFF_CTX = 0;
constexpr size_t OFF_MOD = OFF_CTX + al((size_t)NB * LC * D * 4);
constexpr size_t SZ_FILT_L = (size_t)(2 * LQ - 1) * 256 * 4;
constexpr size_t SZ_FILT_C = (size_t)(2 * LC - 1) * 256 * 4;
constexpr size_t OFF_CNT = OFF_MOD + al((size_t)2 * 9 * 9216 * 4);
constexpr size_t OFF_BAR = OFF_CNT + 256;
constexpr size_t OFF_FILT = OFF_BAR + al((size_t)3456 * 4);
constexpr size_t OFF_FILTC = OFF_FILT + 2 * al(SZ_FILT_L);
constexpr size_t OFF_ROPEG = OFF_FILTC + al(SZ_FILT_C);
constexpr size_t OFF_ROPEM = OFF_ROPEG + al((size_t)LQ * 32 * 8);
constexpr size_t OFF_W = OFF_ROPEM + al((size_t)LQ * 16 * 8);
constexpr size_t W_GU1 = 0;
constexpr size_t W_D1 = W_GU1 + (size_t)5632 * 1024;
constexpr size_t W_GU2 = W_D1 + (size_t)1024 * 2816;
constexpr size_t W_D2 = W_GU2 + (size_t)5632 * 1024;
constexpr size_t W_IN = W_D2 + (size_t)1024 * 2816;
constexpr size_t W_OUT = W_IN + (size_t)2944 * 1024;
constexpr size_t W_UQ = W_OUT + (size_t)1024 * 1024;
constexpr size_t W_UKV = W_UQ + (size_t)384 * 256;
constexpr size_t W_W2 = W_UKV + (size_t)512 * 128;
constexpr size_t W_A2 = W_W2 + (size_t)2 * 256 * 64;
constexpr size_t W_G2 = W_A2 + (size_t)2 * 256 * 64;
constexpr size_t W_LAYER = W_G2 + (size_t)256 * 128;
constexpr size_t OFF_H = OFF_W + al(2 * W_LAYER * 2);
constexpr size_t OFF_BIG = OFF_H + al((size_t)T * D * 2);
constexpr size_t M_P = 0;
constexpr size_t M_PT = M_P + al((size_t)TG * DINP * 2);
constexpr size_t M_U = M_PT + al((size_t)HYC * TG * 2);
constexpr size_t M_QG = M_U + al((size_t)TG * 256 * 2);
constexpr size_t M_KG = M_QG + al((size_t)TG * 256 * 2);
constexpr size_t M_VTG = M_KG + al((size_t)TG * 128 * 2);
constexpr size_t M_CQN = M_VTG + al((size_t)TG * 128 * 2);
constexpr size_t M_CKVN = M_CQN + al((size_t)TG * 256 * 2);
constexpr size_t M_QUP = M_CKVN + al((size_t)TG * 128 * 2);
constexpr size_t M_KVUP = M_QUP + al((size_t)TG * 384 * 2);
constexpr size_t M_QM = M_KVUP + al((size_t)TG * 512 * 2);
constexpr size_t M_KM = M_QM + al((size_t)TG * 384 * 2);
constexpr size_t M_VTM = M_KM + al((size_t)TG * 384 * 2);
constexpr size_t M_RR = M_VTM + al((size_t)TG * 256 * 2);
constexpr size_t M_RK = M_RR + al((size_t)TG * 256 * 2);
constexpr size_t M_RV = M_RK + al((size_t)TG * 256 * 2);
constexpr size_t M_RKK = M_RV + al((size_t)TG * 256 * 2);
constexpr size_t M_LWF = M_RKK + al((size_t)TG * 256 * 2);
constexpr size_t M_LWB = M_LWF + al((size_t)TG * 64 * 2);
constexpr size_t M_LAF = M_LWB + al((size_t)TG * 64 * 2);
constexpr size_t M_LAB = M_LAF + al((size_t)TG * 64 * 2);
constexpr size_t M_LG = M_LAB + al((size_t)TG * 64 * 2);
constexpr size_t M_EF = M_LG + al((size_t)TG * 128 * 2);
constexpr size_t M_EB = M_EF + al((size_t)TG * 256 * 2);
constexpr size_t M_AF = M_EB + al((size_t)TG * 256 * 2);
constexpr size_t M_AB = M_AF + al((size_t)TG * 256 * 2);
constexpr size_t M_GG = M_AB + al((size_t)TG * 256 * 2);
constexpr size_t M_YF = M_GG + al((size_t)TG * 256 * 2);
constexpr size_t M_YB = M_YF + al((size_t)TG * 256 * 4);
constexpr size_t M_END = M_YB + al((size_t)TG * 256 * 4);
constexpr size_t SZ_G = (size_t)T * DFF * 2;
constexpr size_t WS_NEED = OFF_BIG + (M_END > SZ_G ? M_END : SZ_G);
static_assert(WS_NEED <= (size_t)512 * 1024 * 1024, "workspace too large");

struct Params {
  const float *x, *c, *ctx, *c_ctx, *ada_w, *ada_b, *norm_ffn1, *norm_mix, *norm_ffn2;
  const float *ffn1_gate, *ffn1_up, *ffn1_down, *ffn2_gate, *ffn2_up, *ffn2_down, *w_in, *w_out;
  const float *hy_conv_w, *hy_conv_b, *hy_f_w1, *hy_f_b1, *hy_f_w2, *hy_f_b2, *hy_f_w3, *hy_f_b3, *hy_f_w4, *hy_f_freq, *hy_bias;
  const float *gqa_q_norm, *gqa_k_norm, *mla_cq_norm, *mla_ckv_norm, *mla_w_uq, *mla_w_ukv, *mla_q_norm, *mla_k_norm;
  const float *rw_mu, *rw_w0, *rw_w2, *rw_a0, *rw_a2, *rw_g2, *rw_k_k, *rw_k_a, *rw_r_k, *rw_ln_w, *rw_ln_b;
  float* out;
  char* ws;
};

DI u16 f2bf(float x) {
  unsigned u = __float_as_uint(x);
  u += 0x7fffu + ((u >> 16) & 1u);
  return (u16)(u >> 16);
}
DI float bf2f(u16 b) { return __uint_as_float(((unsigned)b) << 16); }
DI float bflo_(unsigned w) { return __uint_as_float(w << 16); }
DI float bfhi_(unsigned w) { return __uint_as_float(w & 0xffff0000u); }
DI unsigned pack2(float a, float b) {
  f32x2_t v = {a, b};
  bf16x2_t r = __builtin_convertvector(v, bf16x2_t);
  return __builtin_bit_cast(unsigned, r);
}
DI int ltid() {
  int t = threadIdx.x;
  asm volatile("" : "+v"(t));
  return t;
}
DI float wave_sum(float v) {
#pragma unroll
  for (int o = 32; o > 0; o >>= 1) v += __shfl_xor(v, o);
  return v;
}
DI float wave_max(float v) {
#pragma unroll
  for (int o = 32; o > 0; o >>= 1) v = fmaxf(v, __shfl_xor(v, o));
  return v;
}
DI float sigmoidf_(float x) { return __builtin_amdgcn_rcpf(1.f + __expf(-x)); }
DI int crow(int i, int h) { return (i & 3) + 8 * (i >> 2) + 4 * h; }

DI float rope_apply(float val, int idx, int nfreq, int t, int lane) {
  int pi = idx >> 1;
  int row = t >> 6, col = t & 63;
  float pos = pi < nfreq ? (float)row : (float)col;
  int f = pi < nfreq ? pi : pi - nfreq;
  float inv = exp2f(-(float)f / (float)nfreq * 13.287712379549449f);
  float ang = pos * inv;
  float cs = cosf(ang), sn = sinf(ang);
  float other = __shfl_xor(val, 1);
  return (lane & 1) ? other * sn + val * cs : val * cs - other * sn;
}

DI float rope_tab(float val, int idx, const float2* __restrict__ tab, int lane) {
  const float2 cs = tab[idx >> 1];
  const float other = __shfl_xor(val, 1);
  return (lane & 1) ? other * cs.y + val * cs.x : val * cs.x - other * cs.y;
}
DI void rope_table_phase(float2* __restrict__ tg, float2* __restrict__ tm) {
  const int tid = ltid();
  for (int e = blockIdx.x * NTHR + tid; e < LQ * 48; e += gridDim.x * NTHR) {
    const int t = e / 48, k = e - t * 48;
    const bool isg = k < 32;
    const int pi = isg ? k : k - 32, nfreq = isg ? 16 : 8;
    const int row = t >> 6, col = t & 63;
    const float pos = pi < nfreq ? (float)row : (float)col;
    const int f = pi < nfreq ? pi : pi - nfreq;
    const float inv = exp2f(-(float)f / (float)nfreq * 13.287712379549449f);
    const float ang = pos * inv;
    const float2 v = make_float2(cosf(ang), sinf(ang));
    if (isg) tg[t * 32 + pi] = v; else tm[t * 16 + pi] = v;
  }
}

DI int gu_row(int n, int half) { return (n >> 6) * 128 + ((n >> 5) & 1) * 64 + half * 32 + (n & 31); }
DI void convT(const float* __restrict__ src, int K, int N, u16* __restrict__ dst, int mode, char* smem) {
  float* tile = (float*)smem;
  const int tk = K / 64, tn = (N + 63) / 64;
  const int tid_ = ltid();
  const int j = tid_ & 63, i0 = tid_ >> 6;
  for (int t = blockIdx.x; t < tk * tn; t += gridDim.x) {
    const int k0 = (t / tn) * 64, n0 = (t % tn) * 64;
    for (int i = i0; i < 64; i += 4) {
      int n = n0 + j;
      tile[i * 65 + j] = n < N ? src[(size_t)(k0 + i) * N + n] : 0.f;
    }
    __syncthreads();
    for (int i = i0; i < 64; i += 4) {
      int n = n0 + i;
      if (n < N) {
        int row = mode == 0 ? n : gu_row(n, mode - 1);
        dst[(size_t)row * K + k0 + j] = f2bf(tile[j * 65 + i]);
      }
    }
    __syncthreads();
  }
}

DI void mod_phase(const Params& p, float* __restrict__ mod, char* smem) {
  float* sc = (float*)smem;
  float* red = sc + 9 * 1024;
  const int tid_ = ltid();
  for (int i = tid_; i < 9 * 1024; i += NTHR) {
    float v = i < 8192 ? p.c[i] : p.c_ctx[i - 8192];
    sc[i] = v / (1.f + expf(-v));
  }
  __syncthreads();
  const int lane = tid_ & 63, kp = tid_ >> 6;
  for (int it = blockIdx.x; it < 2 * 144; it += gridDim.x) {
    const int l = it / 144, nb = (it % 144) * 64;
    const float* w = p.ada_w + (size_t)l * 1024 * 9216 + nb + lane;
    float acc[9];
#pragma unroll
    for (int b = 0; b < 9; ++b) acc[b] = 0.f;
    for (int k = kp * 256; k < kp * 256 + 256; ++k) {
      float wv = w[(size_t)k * 9216];
#pragma unroll
      for (int b = 0; b < 9; ++b) acc[b] += sc[b * 1024 + k] * wv;
    }
#pragma unroll
    for (int b = 0; b < 9; ++b) red[(kp * 9 + b) * 64 + lane] = acc[b];
    __syncthreads();
    for (int o = tid_; o < 9 * 64; o += NTHR) {
      int b = o >> 6, ln = o & 63;
      float s = red[(0 * 9 + b) * 64 + ln] + red[(1 * 9 + b) * 64 + ln] + red[(2 * 9 + b) * 64 + ln] + red[(3 * 9 + b) * 64 + ln];
      mod[((size_t)l * 9 + b) * 9216 + nb + ln] = s + p.ada_b[l * 9216 + nb + ln];
    }
    __syncthreads();
  }
}

DI void hyfilt_phase(const Params& p, int l, int L, float* __restrict__ gT, char* smem) {
  float* z = (float*)smem;
  float* h1 = z + 64;
  float* h2 = h1 + 64;
  float* h3 = h2 + 64;
  float* w1s = z + 256;
  float* w2s = w1s + 33 * 64;
  float* w3s = w2s + 64 * 64;
  const float* w4 = p.hy_f_w4 + l * 64 * 512;
  const int tid = ltid();
  for (int i = tid; i < 33 * 64; i += NTHR) w1s[i] = p.hy_f_w1[l * 33 * 64 + i];
  for (int i = tid; i < 64 * 64; i += NTHR) { w2s[i] = p.hy_f_w2[l * 4096 + i]; w3s[i] = p.hy_f_w3[l * 4096 + i]; }
  float b1v = 0.f, b2v = 0.f, b3v = 0.f, frv = 0.f;
  if (tid < 64) { b1v = p.hy_f_b1[l * 64 + tid]; b2v = p.hy_f_b2[l * 64 + tid]; b3v = p.hy_f_b3[l * 64 + tid]; frv = p.hy_f_freq[l * 64 + tid]; }
  const float min_decay = logf(1e-2f) / 1.5f, max_decay = logf(1e-2f) / 0.3f;
  const float delta = fabsf(min_decay + (max_decay - min_decay) * (float)tid / 255.f);
  __syncthreads();
  for (int t = blockIdx.x; t < L; t += gridDim.x) {
    const float t01 = (float)t / (float)(L - 1);
    if (tid < 33) {
      float zz;
      if (tid == 0) zz = t01;
      else {
        int i = (tid - 1) & 15;
        float f = 1e-4f + (float)i * ((15.f - 1e-4f) / 15.f);
        float wang = 6.283185307179586f * (float)t / (float)L;
        zz = tid <= 16 ? cosf(f * wang) : -sinf(f * wang);
      }
      z[tid] = zz;
    }
    __syncthreads();
    if (tid < 64) {
      float a = b1v;
#pragma unroll 11
      for (int i = 0; i < 33; ++i) a += z[i] * w1s[i * 64 + tid];
      h1[tid] = sinf(frv * a);
    }
    __syncthreads();
    if (tid < 64) {
      float a = b2v;
#pragma unroll 16
      for (int i = 0; i < 64; ++i) a += h1[i] * w2s[i * 64 + tid];
      h2[tid] = sinf(frv * a);
    }
    __syncthreads();
    if (tid < 64) {
      float a = b3v;
#pragma unroll 16
      for (int i = 0; i < 64; ++i) a += h2[i] * w3s[i * 64 + tid];
      h3[tid] = sinf(frv * a);
    }
    __syncthreads();
    float af = 0.f, ab = 0.f;
#pragma unroll 8
    for (int i = 0; i < 64; ++i) {
      af += h3[i] * w4[i * 512 + tid];
      ab += h3[i] * w4[i * 512 + 256 + tid];
    }
    const float dec = expf(-t01 * delta);
    af *= dec;
    ab *= dec;
    if (t == 0) gT[(size_t)(L - 1) * 256 + tid] = af + ab;
    else {
      gT[(size_t)(L - 1 + t) * 256 + tid] = af;
      gT[(size_t)(L - 1 - t) * 256 + tid] = ab;
    }
    __syncthreads();
  }
  __syncthreads();
}

DI void adaln_phase(const float* __restrict__ lat, const float* __restrict__ ctxp, const float* __restrict__ gain,
                    const float* __restrict__ modl, int idx, u16* __restrict__ h, bool skip_ctx) {
  const int tid_ = ltid();
  const int wave = tid_ >> 6, lane = tid_ & 63;
  for (int r = blockIdx.x * 4 + wave; r < T; r += gridDim.x * 4) {
    const int b = r / LT, j = r - b * LT;
    if (skip_ctx && j < LC) continue;
    const float* xr = j < LC ? ctxp + ((size_t)(b * LC + j) << 10) : lat + ((size_t)(b * LQ + j - LC) << 10);
    const int bb = j < LC ? 8 : b;
    const float* shift = modl + bb * 9216 + (3 * idx) * 1024;
    const float* scale = shift + 1024;
    float4 v[4];
    float ss = 0.f;
#pragma unroll
    for (int q = 0; q < 4; ++q) {
      v[q] = *(const float4*)(xr + q * 256 + lane * 4);
      ss += v[q].x * v[q].x + v[q].y * v[q].y + v[q].z * v[q].z + v[q].w * v[q].w;
    }
    ss = wave_sum(ss);
    const float rstd = rsqrtf(ss * (1.f / 1024.f) + EPS);
#pragma unroll
    for (int q = 0; q < 4; ++q) {
      const int c = q * 256 + lane * 4;
      float4 g = *(const float4*)(gain + c), sc = *(const float4*)(scale + c), sh = *(const float4*)(shift + c);
      float y0 = v[q].x * rstd * g.x * (1.f + sc.x) + sh.x;
      float y1 = v[q].y * rstd * g.y * (1.f + sc.y) + sh.y;
      float y2 = v[q].z * rstd * g.z * (1.f + sc.z) + sh.z;
      float y3 = v[q].w * rstd * g.w * (1.f + sc.w) + sh.w;
      uint2 o;
      o.x = pack2(y0, y1);
      o.y = pack2(y2, y3);
      *(uint2*)(h + (size_t)r * D + c) = o;
    }
  }
}

DI bool gemm_decode(int t, int mtiles, int ntiles, int mt_off, bool skip_ctx, int& mt, int& nt) {
  const int mtx = mtiles >> 3;
  const int xcd = t & 7, q = t >> 3;
  const int sr = q / (8 * ntiles);
  const int rem = q - sr * 8 * ntiles;
  const int rows_in = min(8, mtx - sr * 8);
  const int sc = rem / (rows_in * 8);
  const int r2 = rem - sc * rows_in * 8;
  const int i = r2 % rows_in, j = r2 / rows_in;
  mt = (sr * 8 + i) * 8 + xcd;
  nt = sc * 8 + j;
  return !(skip_ctx && ((mt + mt_off) % 34) < 2);
}
template <bool PAIRED, class Epi>
DI void gemm_phase(const u16* __restrict__ A, int lda, const u16* __restrict__ Bt, int ldb, int K, int mtiles, int ntiles,
                   int mt_off, bool skip_ctx, char* smem, Epi& epi) {
  u16* As = (u16*)smem;
  u16* Bs = As + 2 * 128 * 72;
  const int tid = ltid(), lane = tid & 63, wave = tid >> 6;
  const int wm = wave >> 1, wn = wave & 1, lr = lane & 31, lh = lane >> 5;
  const int lrow = tid >> 3, lkc = (tid & 7) * 8;
  const int total = mtiles * ntiles, nk = K >> 6;
  uint4 ra00, ra01, ra02, ra03, rb00, rb01, rb02, rb03, ra10, ra11, ra12, ra13, rb10, rb11, rb12, rb13;
  const u16* Agl;
  const u16* Bgl;
#define GEMM_GLOAD(S, kt_)                                            \
  {                                                                   \
    const int k0_ = (kt_) << 6;                                       \
    ra##S##0 = *(const uint4*)(Agl + k0_);                            \
    ra##S##1 = *(const uint4*)(Agl + (size_t)32 * lda + k0_);         \
    ra##S##2 = *(const uint4*)(Agl + (size_t)64 * lda + k0_);         \
    ra##S##3 = *(const uint4*)(Agl + (size_t)96 * lda + k0_);         \
    rb##S##0 = *(const uint4*)(Bgl + k0_);                            \
    rb##S##1 = *(const uint4*)(Bgl + (size_t)32 * ldb + k0_);         \
    rb##S##2 = *(const uint4*)(Bgl + (size_t)64 * ldb + k0_);         \
    rb##S##3 = *(const uint4*)(Bgl + (size_t)96 * ldb + k0_);         \
  }
#define GEMM_LSTORE(S, buf_)                                          \
  {                                                                   \
    u16* ad_ = As + (buf_) * 128 * 72 + lrow * 72 + lkc;              \
    u16* bd_ = Bs + (buf_) * 128 * 72 + lrow * 72 + lkc;              \
    *(uint4*)(ad_) = ra##S##0;                                        \
    *(uint4*)(ad_ + 32 * 72) = ra##S##1;                              \
    *(uint4*)(ad_ + 64 * 72) = ra##S##2;                              \
    *(uint4*)(ad_ + 96 * 72) = ra##S##3;                              \
    *(uint4*)(bd_) = rb##S##0;                                        \
    *(uint4*)(bd_ + 32 * 72) = rb##S##1;                              \
    *(uint4*)(bd_ + 64 * 72) = rb##S##2;                              \
    *(uint4*)(bd_ + 96 * 72) = rb##S##3;                              \
  }
#define GEMM_COMPUTE(buf_)                                                        \
  {                                                                               \
    const u16* as = As + (buf_) * 128 * 72 + (wm * 64 + lr) * 72 + lh * 8;        \
    const u16* bs = Bs + (buf_) * 128 * 72 + (wn * 64 + lr) * 72 + lh * 8;        \
    _Pragma("unroll") for (int ks = 0; ks < 4; ++ks) {                            \
      bf16x8 a0 = *(const bf16x8*)(as + ks * 16);                                 \
      bf16x8 a1 = *(const bf16x8*)(as + 32 * 72 + ks * 16);                       \
      bf16x8 b0 = *(const bf16x8*)(bs + ks * 16);                                 \
      bf16x8 b1 = *(const bf16x8*)(bs + 32 * 72 + ks * 16);                       \
      acc[0][0] = MFMA32(a0, b0, acc[0][0]);                                      \
      acc[0][1] = MFMA32(a0, b1, acc[0][1]);                                      \
      acc[1][0] = MFMA32(a1, b0, acc[1][0]);                                      \
      acc[1][1] = MFMA32(a1, b1, acc[1][1]);                                      \
    }                                                                             \
  }
  int t = blockIdx.x, mt = 0, nt = 0;
  while (t < total && !gemm_decode(t, mtiles, ntiles, mt_off, skip_ctx, mt, nt)) t += gridDim.x;
  if (t < total) {
    Agl = A + (size_t)(mt * 128 + lrow) * lda + lkc;
    Bgl = Bt + (size_t)(nt * 128 + lrow) * ldb + lkc;
    GEMM_GLOAD(0, 0);
  }
  while (t < total) {
    const int m0 = mt * 128, n0 = nt * 128;
    int tn = t + gridDim.x, mtn = 0, ntn = 0;
    while (tn < total && !gemm_decode(tn, mtiles, ntiles, mt_off, skip_ctx, mtn, ntn)) tn += gridDim.x;
    f32x16 acc[2][2];
#pragma unroll
    for (int a = 0; a < 2; ++a)
#pragma unroll
      for (int b = 0; b < 2; ++b)
#pragma unroll
        for (int i = 0; i < 16; ++i) acc[a][b][i] = 0.f;
    GEMM_LSTORE(0, 0);
    __syncthreads();
    if (nk > 1) GEMM_GLOAD(0, 1);
    for (int kt = 0; kt < nk; kt += 2) {
      if (kt + 2 < nk) GEMM_GLOAD(1, kt + 2);
      GEMM_COMPUTE(0);
      if (kt + 1 < nk) GEMM_LSTORE(0, 1);
      __syncthreads();
      if (kt + 1 >= nk) break;
      if (kt + 3 < nk) GEMM_GLOAD(0, kt + 3);
      GEMM_COMPUTE(1);
      if (kt + 2 < nk) GEMM_LSTORE(1, 0);
      __syncthreads();
    }
    if (tn < total) {
      Agl = A + (size_t)(mtn * 128 + lrow) * lda + lkc;
      Bgl = Bt + (size_t)(ntn * 128 + lrow) * ldb + lkc;
      GEMM_GLOAD(0, 0);
    }
    epi.tile(m0);
    if constexpr (PAIRED) {
      float* stg = (float*)smem + wave * 64 * 36;
#pragma unroll
      for (int mi = 0; mi < 2; ++mi)
#pragma unroll
        for (int i = 0; i < 16; ++i) stg[(mi * 32 + crow(i, lh)) * 36 + lr] = epi.combine(acc[mi][0][i], acc[mi][1][i]);
      __syncthreads();
#pragma unroll
      for (int k = 0; k < 8; ++k) {
        const int idx = lane + 64 * k, row = idx >> 3, c4 = idx & 7;
        const float4 v = *(const float4*)(stg + row * 36 + c4 * 4);
        epi.store4(m0 + wm * 64 + row, (n0 >> 1) + wn * 32 + c4 * 4, v);
      }
      __syncthreads();
    } else if constexpr (Epi::kStaged) {
      float* stg = (float*)smem + wave * 64 * 68;
#pragma unroll
      for (int mi = 0; mi < 2; ++mi)
#pragma unroll
        for (int ni = 0; ni < 2; ++ni)
#pragma unroll
          for (int i = 0; i < 16; ++i) stg[(mi * 32 + crow(i, lh)) * 68 + ni * 32 + lr] = acc[mi][ni][i];
      __syncthreads();
#pragma unroll 4
      for (int k = 0; k < 16; ++k) {
        const int idx = lane + 64 * k, row = idx >> 4, c4 = idx & 15;
        const float4 v = *(const float4*)(stg + row * 68 + c4 * 4);
        epi.row4(m0 + wm * 64 + row, n0 + wn * 64 + c4 * 4, v);
      }
      __syncthreads();
    } else {
#pragma unroll
      for (int mi = 0; mi < 2; ++mi) {
#pragma unroll
        for (int gq = 0; gq < 4; ++gq) {
          const int row0 = m0 + wm * 64 + mi * 32 + 8 * gq + 4 * lh;
          if (PAIRED) {
            const int col = (n0 >> 1) + wn * 32 + lr;
#pragma unroll
            for (int e = 0; e < 4; ++e) epi.pair(row0 + e, col, acc[mi][0][4 * gq + e], acc[mi][1][4 * gq + e]);
          } else {
            epi.quad(row0, n0 + wn * 64 + lr, acc[mi][0][4 * gq], acc[mi][0][4 * gq + 1], acc[mi][0][4 * gq + 2], acc[mi][0][4 * gq + 3]);
            epi.quad(row0, n0 + wn * 64 + 32 + lr, acc[mi][1][4 * gq], acc[mi][1][4 * gq + 1], acc[mi][1][4 * gq + 2], acc[mi][1][4 * gq + 3]);
          }
        }
      }
    }
    t = tn; mt = mtn; nt = ntn;
  }
}

#define EPI_DEFAULT_QUAD                                                   \
  static constexpr bool kStaged = false;                                   \
  DI void row4(int, int, float4) const {}                                  \
  DI void tile(int) {}                                                     \
  DI void quad(int row0, int col, float a, float b, float c, float d) const { \
    (*this)(row0, col, a);                                                 \
    (*this)(row0 + 1, col, b);                                             \
    (*this)(row0 + 2, col, c);                                             \
    (*this)(row0 + 3, col, d);                                             \
  }
struct EpiGU {
  u16* G;
  DI float combine(float g, float u) const { return g * __builtin_amdgcn_rcpf(1.f + __expf(-g)) * u; }
  DI void store4(int row, int col, float4 v) const {
    uint2 w;
    w.x = pack2(v.x, v.y);
    w.y = pack2(v.z, v.w);
    *(uint2*)(G + (size_t)row * DFF + col) = w;
  }
  DI void pair(int row, int col, float g, float u) const {
    float s = g / (1.f + __expf(-g));
    G[(size_t)row * DFF + col] = f2bf(s * u);
  }
  DI void operator()(int, int, float) const {}
  EPI_DEFAULT_QUAD
};
struct EpiRes {
  const float* lat_in; const float* ctx_in; float* lat_out; float* ctx_out; const float* modl; int gate_chunk; float coef;
  const float* tin; float* tout; const float* gate; int tm0;
  static constexpr bool kStaged = true;
  DI void row4(int row, int col, float4 v) const {
    const size_t o = ((size_t)(row - tm0) << 10) + col;
    const float4 x = *(const float4*)(tin + o);
    const float4 g = *(const float4*)(gate + col);
    float4 y;
    y.x = x.x + coef * g.x * v.x;
    y.y = x.y + coef * g.y * v.y;
    y.z = x.z + coef * g.z * v.z;
    y.w = x.w + coef * g.w * v.w;
    *(float4*)(tout + o) = y;
  }
  DI void tile(int m0) {
    const int b = m0 / LT, j = m0 - b * LT;
    const bool isc = j < LC;
    const size_t off = isc ? (((size_t)(b * LC + j)) << 10) : (((size_t)(b * LQ + j - LC)) << 10);
    tin = (isc ? ctx_in : lat_in) + off;
    tout = (isc ? ctx_out : lat_out) + off;
    gate = modl + (isc ? 8 : b) * 9216 + gate_chunk * 1024;
    tm0 = m0;
  }
  DI void operator()(int row, int col, float v) const {
    const size_t o = ((size_t)(row - tm0) << 10) + col;
    tout[o] = tin[o] + coef * gate[col] * v;
  }
  DI void pair(int, int, float, float) const {}
  DI void quad(int row0, int col, float a, float b, float c, float d) const {
    const float gc = coef * gate[col];
    const size_t o = ((size_t)(row0 - tm0) << 10) + col;
    tout[o] = tin[o] + gc * a;
    tout[o + 1024] = tin[o + 1024] + gc * b;
    tout[o + 2048] = tin[o + 2048] + gc * c;
    tout[o + 3072] = tin[o + 3072] + gc * d;
  }
};
struct EpiStore {
  u16* C; int ldc; int N;
  DI void operator()(int row, int col, float v) const { if (col < N) C[(size_t)row * ldc + col] = f2bf(v); }
  DI void pair(int, int, float, float) const {}
  EPI_DEFAULT_QUAD
};
struct EpiWin {
  u16* p; u16* pT;
  static constexpr bool kStaged = false;
  DI void row4(int, int, float4) const {}
  DI void tile(int) {}
  DI void quad(int row0, int col, float a, float b, float c, float d) const {
    if (col < HYC) {
      uint2 w;
      w.x = pack2(a, b);
      w.y = pack2(c, d);
      *(uint2*)(pT + (size_t)col * TG + row0) = w;
    } else if (col < DIN) {
      u16* q = p + (size_t)row0 * DINP + (col - HYC);
      q[0] = f2bf(a);
      q[DINP] = f2bf(b);
      q[2 * DINP] = f2bf(c);
      q[3 * DINP] = f2bf(d);
    }
  }
  DI void pair(int, int, float, float) const {}
};
struct EpiLoraW {
  u16* C; const float* w0;
  DI void operator()(int row, int col, float v) const {
    float zz = -(w0[col] + v);
    float sp = fmaxf(zz, 0.f) + log1pf(expf(-fabsf(zz)));
    C[(size_t)row * 256 + col] = f2bf(-expm1f(-expf(-sp - 0.5f)));
  }
  DI void pair(int, int, float, float) const {}
  EPI_DEFAULT_QUAD
};
struct EpiLoraA {
  u16* C; const float* a0;
  DI void operator()(int row, int col, float v) const { C[(size_t)row * 256 + col] = f2bf(sigmoidf_(a0[col] + v)); }
  DI void pair(int, int, float, float) const {}
  EPI_DEFAULT_QUAD
};

struct MixBufs {
  u16 *p, *pt, *u, *qg, *kg, *vtg, *cqn, *ckvn, *qup, *kvup, *qm, *km, *vtm, *rr, *rk, *rv, *rkk, *lwf, *lwb, *laf, *lab, *lg, *ef, *eb, *af, *ab, *gg;
  float *yf, *yb;
};
DI MixBufs mixbufs(char* big) {
  MixBufs m;
  m.p = (u16*)(big + M_P); m.pt = (u16*)(big + M_PT); m.u = (u16*)(big + M_U); m.qg = (u16*)(big + M_QG); m.kg = (u16*)(big + M_KG);
  m.vtg = (u16*)(big + M_VTG); m.cqn = (u16*)(big + M_CQN); m.ckvn = (u16*)(big + M_CKVN); m.qup = (u16*)(big + M_QUP);
  m.kvup = (u16*)(big + M_KVUP); m.qm = (u16*)(big + M_QM); m.km = (u16*)(big + M_KM); m.vtm = (u16*)(big + M_VTM);
  m.rr = (u16*)(big + M_RR); m.rk = (u16*)(big + M_RK); m.rv = (u16*)(big + M_RV); m.rkk = (u16*)(big + M_RKK);
  m.lwf = (u16*)(big + M_LWF); m.lwb = (u16*)(big + M_LWB); m.laf = (u16*)(big + M_LAF); m.lab = (u16*)(big + M_LAB);
  m.lg = (u16*)(big + M_LG); m.ef = (u16*)(big + M_EF); m.eb = (u16*)(big + M_EB); m.af = (u16*)(big + M_AF);
  m.ab = (u16*)(big + M_AB); m.gg = (u16*)(big + M_GG); m.yf = (float*)(big + M_YF); m.yb = (float*)(big + M_YB);
  return m;
}

DI void prep_phase(const Params& p, int l, int g, const MixBufs& m, const float2* __restrict__ ropeg, char* smem) {
  const int tid = ltid(), lane = tid & 63, wave = tid >> 6;
  const float* mu = p.rw_mu + l * 1152;
  for (int rl = blockIdx.x * 4 + wave; rl < TG; rl += gridDim.x * 4) {
    const int r = g * TG + rl;
    const int b = r / LT, j = r - b * LT, bl = b - g * BG;
    const bool lat = j >= LC;
    const bool hp = lat ? (j > LC) : (j > 0);
    const bool hn = lat ? (j < LT - 1) : (j < LC - 1);
    const u16* pc = m.p + (size_t)rl * DINP;
    const u16* pp = pc - DINP;
    const u16* pn = pc + DINP;
    auto tshift = [&](int crel) -> float {
      const int c = 1696 - HYC + crel;
      float u0 = bf2f(pc[c]);
      float nb = 0.f;
      if (hp) nb += bf2f(pp[c]);
      if (hn) nb += bf2f(pn[c]);
      return u0 + mu[crel] * (0.5f * nb - u0);
    };
#pragma unroll
    for (int hd = 0; hd < 4; ++hd) {
      const int c = hd * 64 + lane;
      const float sr = tshift(c), sk = tshift(256 + c), sv = tshift(512 + c);
      m.rr[(size_t)rl * 256 + c] = f2bf(sr);
      m.rk[(size_t)rl * 256 + c] = f2bf(sk);
      m.rv[(size_t)rl * 256 + c] = f2bf(sv);
      const float kx = sk * p.rw_k_k[l * 256 + c];
      const float ss = wave_sum(kx * kx);
      m.rkk[(size_t)rl * 256 + c] = f2bf(kx / fmaxf(sqrtf(ss), 1e-12f));
    }
    {
      const float s0 = tshift(768 + lane), s1 = tshift(832 + lane), s2 = tshift(896 + lane), s3 = tshift(960 + lane);
      const float s4 = tshift(1024 + lane), s5 = tshift(1088 + lane);
      m.lwf[(size_t)rl * 64 + lane] = f2bf(tanhf(s0));
      m.lwb[(size_t)rl * 64 + lane] = f2bf(tanhf(s1));
      m.laf[(size_t)rl * 64 + lane] = f2bf(s2);
      m.lab[(size_t)rl * 64 + lane] = f2bf(s3);
      m.lg[(size_t)rl * 128 + lane] = f2bf(sigmoidf_(s4));
      m.lg[(size_t)rl * 128 + 64 + lane] = f2bf(sigmoidf_(s5));
    }
    {
      float cq[4], ckv[2];
      float s1 = 0.f, s2 = 0.f;
#pragma unroll
      for (int q = 0; q < 4; ++q) { cq[q] = bf2f(pc[1280 - HYC + lane + 64 * q]); s1 += cq[q] * cq[q]; }
#pragma unroll
      for (int q = 0; q < 2; ++q) { ckv[q] = bf2f(pc[1536 - HYC + lane + 64 * q]); s2 += ckv[q] * ckv[q]; }
      s1 = wave_sum(s1);
      s2 = wave_sum(s2);
      const float r1 = rsqrtf(s1 * (1.f / 256.f) + EPS), r2 = rsqrtf(s2 * (1.f / 128.f) + EPS);
#pragma unroll
      for (int q = 0; q < 4; ++q) m.cqn[(size_t)rl * 256 + lane + 64 * q] = f2bf(cq[q] * r1 * p.mla_cq_norm[l * 256 + lane + 64 * q]);
#pragma unroll
      for (int q = 0; q < 2; ++q) m.ckvn[(size_t)rl * 128 + lane + 64 * q] = f2bf(ckv[q] * r2 * p.mla_ckv_norm[l * 128 + lane + 64 * q]);
    }
    const float2* rt = ropeg + (size_t)(lat ? j - LC : 0) * 32;
    const float gq_ = p.gqa_q_norm[l * 64 + lane], gk_ = p.gqa_k_norm[l * 64 + lane];
#pragma unroll
    for (int hh = 0; hh < 6; ++hh) {
      float val = bf2f(pc[hh * 64 + lane]);
      const float ss = wave_sum(val * val);
      val = val * rsqrtf(ss * (1.f / 64.f) + EPS) * (hh < 4 ? gq_ : gk_);
      const float rv = rope_tab(val, lane, rt, lane);
      if (lat) val = rv;
      if (hh < 4) m.qg[(size_t)rl * 256 + hh * 64 + lane] = f2bf(val);
      else m.kg[(size_t)rl * 128 + (hh - 4) * 64 + lane] = f2bf(val);
    }
#pragma unroll
    for (int kvh = 0; kvh < 2; ++kvh) m.vtg[((size_t)(bl * 2 + kvh) * 64 + lane) * LT + j] = pc[1152 - HYC + kvh * 64 + lane];
  }
}

DI void mla_fin_phase(const Params& p, int l, int g, const MixBufs& m, const float2* __restrict__ ropem) {
  const int tid = ltid(), lane = tid & 63, wave = tid >> 6;
  for (int rl = blockIdx.x; rl < TG; rl += gridDim.x) {
    const int r = g * TG + rl;
    const int b = r / LT, j = r - b * LT, bl = b - g * BG;
    const bool lat = j >= LC;
    for (int s = wave; s < 8; s += 4) {
      const int hd = s & 3;
      const bool isq = s < 4;
      float x0, x1;
      if (isq) {
        x0 = bf2f(m.qup[(size_t)rl * 384 + hd * 96 + lane]);
        x1 = lane < 32 ? bf2f(m.qup[(size_t)rl * 384 + hd * 96 + 64 + lane]) : 0.f;
      } else {
        x0 = bf2f(m.kvup[(size_t)rl * 512 + hd * 128 + lane]);
        x1 = lane < 32 ? bf2f(m.p[(size_t)rl * DINP + 1664 - HYC + lane]) : 0.f;
      }
      float ss = wave_sum(x0 * x0 + x1 * x1);
      const float rstd = rsqrtf(ss * (1.f / 96.f) + EPS);
      const float* gn = isq ? p.mla_q_norm + l * 96 : p.mla_k_norm + l * 96;
      float y0 = x0 * rstd * gn[lane];
      float y1 = lane < 32 ? x1 * rstd * gn[64 + lane] : 0.f;
      float ry = rope_tab(y1, lane & 31, ropem + (size_t)(lat ? j - LC : 0) * 16, lane);
      if (lat) y1 = ry;
      u16* dst = (isq ? m.qm : m.km) + (size_t)rl * 384 + hd * 96;
      dst[lane] = f2bf(y0);
      if (lane < 32) dst[64 + lane] = f2bf(y1);
      if (!isq) m.vtm[((size_t)(bl * 4 + hd) * 64 + lane) * LT + j] = m.kvup[(size_t)rl * 512 + hd * 128 + 64 + lane];
    }
  }
}

template <int DQK, int QT>
DI void attn_item(const u16* __restrict__ q, int ldq, const u16* __restrict__ k, int ldk, const u16* __restrict__ vT,
                  u16* __restrict__ out, int ldo, int nkeys, float sl2, float sh2, char* smem) {
  constexpr int KS = DQK + 8;
  constexpr int NKS = DQK / 16;
  constexpr int KCH = DQK / 8;
  constexpr int KPT = 64 * KCH / NTHR;
  u16* Ks = (u16*)smem;
  u16* Vs = Ks + 2 * 64 * KS;
  const int tid = ltid(), lane = tid & 63, wave = tid >> 6, lr = lane & 31, lh = lane >> 5;
  bf16x8 qf[QT][NKS];
#pragma unroll
  for (int qt = 0; qt < QT; ++qt)
#pragma unroll
    for (int ks = 0; ks < NKS; ++ks)
      qf[qt][ks] = *(const bf16x8*)(q + (size_t)(wave * 32 * QT + qt * 32 + lr) * ldq + ks * 16 + lh * 8);
  f32x16 o[QT][2];
#pragma unroll
  for (int a = 0; a < QT; ++a)
#pragma unroll
    for (int b = 0; b < 2; ++b)
#pragma unroll
      for (int i = 0; i < 16; ++i) o[a][b][i] = 0.f;
  float lsum[QT];
#pragma unroll
  for (int a = 0; a < QT; ++a) lsum[a] = 0.f;
  uint4 rk[KPT], rv[2];
#define ATT_GLOAD(key0)                                                                   \
  {                                                                                       \
    _Pragma("unroll") for (int i = 0; i < KPT; ++i) {                                     \
      const int id = tid + NTHR * i, row = id / KCH, ch = id - row * KCH;                 \
      rk[i] = *(const uint4*)(k + (size_t)((key0) + row) * ldk + ch * 8);                 \
    }                                                                                     \
    _Pragma("unroll") for (int i = 0; i < 2; ++i) {                                       \
      const int id = tid + NTHR * i, row = id >> 3, ch = id & 7;                          \
      rv[i] = *(const uint4*)(vT + (size_t)row * LT + (key0) + ch * 8);                   \
    }                                                                                     \
  }
#define ATT_LSTORE(buf_)                                                                  \
  {                                                                                       \
    _Pragma("unroll") for (int i = 0; i < KPT; ++i) {                                     \
      const int id = tid + NTHR * i, row = id / KCH, ch = id - row * KCH;                 \
      *(uint4*)(Ks + (buf_) * 64 * KS + row * KS + ch * 8) = rk[i];                       \
    }                                                                                     \
    _Pragma("unroll") for (int i = 0; i < 2; ++i) {                                       \
      const int id = tid + NTHR * i, row = id >> 3, ch = id & 7;                          \
      *(uint4*)(Vs + (buf_) * 64 * 72 + row * 72 + ch * 8) = rv[i];                       \
    }                                                                                     \
  }
  ATT_GLOAD(0);
  ATT_LSTORE(0);
  __syncthreads();
  const int nkt = nkeys >> 6;
  for (int kt = 0; kt < nkt; ++kt) {
    const int buf = kt & 1;
    if (kt + 1 < nkt) ATT_GLOAD((kt + 1) << 6);
    const u16* kb = Ks + buf * 64 * KS;
    const u16* vb = Vs + buf * 64 * 72;
#pragma unroll
    for (int half = 0; half < 2; ++half) {
      f32x16 s[QT];
#pragma unroll
      for (int qt = 0; qt < QT; ++qt)
#pragma unroll
        for (int i = 0; i < 16; ++i) s[qt][i] = 0.f;
      bf16x8 kf[NKS];
#pragma unroll
      for (int ks = 0; ks < NKS; ++ks) kf[ks] = *(const bf16x8*)(kb + (half * 32 + lr) * KS + ks * 16 + lh * 8);
#pragma unroll
      for (int ks = 0; ks < NKS; ++ks) {
#pragma unroll
        for (int qt = 0; qt < QT; ++qt) s[qt] = MFMA32(kf[ks], qf[qt][ks], s[qt]);
      }
#pragma unroll
      for (int qt = 0; qt < QT; ++qt)
#pragma unroll
        for (int i = 0; i < 16; ++i) {
          float pv = __builtin_amdgcn_exp2f(s[qt][i] * sl2 - sh2);
          lsum[qt] += pv;
          s[qt][i] = pv;
        }
#pragma unroll
      for (int st = 0; st < 2; ++st) {
        bf16x8 pb[QT];
#pragma unroll
        for (int qt = 0; qt < QT; ++qt) {
          uint4 w;
          w.x = pack2(s[qt][8 * st + 0], s[qt][8 * st + 1]);
          w.y = pack2(s[qt][8 * st + 2], s[qt][8 * st + 3]);
          w.z = pack2(s[qt][8 * st + 4], s[qt][8 * st + 5]);
          w.w = pack2(s[qt][8 * st + 6], s[qt][8 * st + 7]);
          pb[qt] = __builtin_bit_cast(bf16x8, w);
        }
#pragma unroll
        for (int mt = 0; mt < 2; ++mt) {
          const u16* vp = vb + (mt * 32 + lr) * 72 + half * 32 + st * 16 + lh * 4;
          uint2 v0 = *(const uint2*)(vp);
          uint2 v1 = *(const uint2*)(vp + 8);
          uint4 w;
          w.x = v0.x; w.y = v0.y; w.z = v1.x; w.w = v1.y;
          bf16x8 vf = __builtin_bit_cast(bf16x8, w);
#pragma unroll
          for (int qt = 0; qt < QT; ++qt) o[qt][mt] = MFMA32(vf, pb[qt], o[qt][mt]);
        }
      }
    }
    if (kt + 1 < nkt) ATT_LSTORE(buf ^ 1);
    __syncthreads();
  }
#pragma unroll
  for (int qt = 0; qt < QT; ++qt) {
    float tot = lsum[qt] + __shfl_xor(lsum[qt], 32);
    float inv = 1.f / tot;
    const int row = wave * 32 * QT + qt * 32 + lr;
#pragma unroll
    for (int mt = 0; mt < 2; ++mt)
#pragma unroll
      for (int gq = 0; gq < 4; ++gq) {
        uint2 w;
        w.x = pack2(o[qt][mt][4 * gq + 0] * inv, o[qt][mt][4 * gq + 1] * inv);
        w.y = pack2(o[qt][mt][4 * gq + 2] * inv, o[qt][mt][4 * gq + 3] * inv);
        *(uint2*)(out + (size_t)row * ldo + mt * 32 + 8 * gq + 4 * lh) = w;
      }
  }
}

DI void hyena_pass(const Params& p, int l, const MixBufs& m, const float* __restrict__ gT, int L, int segoff, int c, char* smem) {
  const int RS = L + 16, US = L + 16;
  unsigned* Rc = (unsigned*)smem;
  u16* U = (u16*)(smem + (size_t)2 * RS * 4);
  const int tid = ltid(), lane = tid & 63, wave = tid >> 6;
  for (int d = tid; d < L; d += NTHR) {
    const int q = 2 * d;
    const float r0 = gT[(size_t)(2 * L - 2 - q) * 256 + c];
    const float r1 = (q + 1 <= 2 * L - 2) ? gT[(size_t)(2 * L - 3 - q) * 256 + c] : 0.f;
    const float r2 = (q + 2 <= 2 * L - 2) ? gT[(size_t)(2 * L - 4 - q) * 256 + c] : 0.f;
    Rc[d] = pack2(r0, r1);
    Rc[RS + d] = pack2(r1, r2);
  }
  const float* cw = p.hy_conv_w + l * 3 * 768;
  const float* cb = p.hy_conv_b + l * 768;
  {
    const float w0a = cw[c], w1a = cw[768 + c], w2a = cw[1536 + c], ba = cb[c];
    const float w0v = cw[512 + c], w1v = cw[768 + 512 + c], w2v = cw[1536 + 512 + c], bv = cb[512 + c];
    for (int b = 0; b < BG; ++b) {
      const u16* x1p = m.pt + (size_t)c * TG + b * LT + segoff;
      const u16* vp = m.pt + (size_t)(512 + c) * TG + b * LT + segoff;
      for (int t = tid; t < L; t += NTHR) {
        float x1 = bf2f(x1p[t]) * w1a + ba;
        float vv = bf2f(vp[t]) * w1v + bv;
        if (t > 0) { x1 += bf2f(x1p[t - 1]) * w0a; vv += bf2f(vp[t - 1]) * w0v; }
        if (t < L - 1) { x1 += bf2f(x1p[t + 1]) * w2a; vv += bf2f(vp[t + 1]) * w2v; }
        U[b * US + t] = f2bf(x1 * vv);
      }
    }
  }
  __syncthreads();
  const int i = lane & 31, h = lane >> 5, bn = i & 3, mb = i >> 2;
  const int par = (L - 1 - i) & 1;
  const float bias = p.hy_bias[l * 256 + c];
  const float w0x = cw[256 + c], w1x = cw[768 + 256 + c], w2x = cw[1536 + 256 + c], bx = cb[256 + c];
  const int nsteps = (L + 208) / 16 + 1;
  for (int sp = wave; sp < L / 256; sp += 4) {
    const int T0 = sp * 256;
    f32x16 acc;
#pragma unroll
    for (int r = 0; r < 16; ++r) acc[r] = 0.f;
    const int delta0 = T0 + 224;
    const int q0 = (L - 1) - delta0 - i + 8 * h;
    const unsigned* ap = Rc + par * RS + (q0 >> 1);
    int s0 = T0 + 32 * mb - delta0;
    const u16* bp = U + bn * US + s0 + 8 * h;
#pragma unroll 2
    for (int st = 0; st < nsteps; ++st) {
      uint4 aw;
      aw.x = ap[0]; aw.y = ap[1]; aw.z = ap[2]; aw.w = ap[3];
      uint4 bw = make_uint4(0u, 0u, 0u, 0u);
      if (s0 >= 0 && s0 <= L - 16) bw = *(const uint4*)bp;
      acc = MFMA32(__builtin_bit_cast(bf16x8, aw), __builtin_bit_cast(bf16x8, bw), acc);
      ap += 8;
      s0 += 16;
      bp += 16;
    }
    const u16* x2p = m.pt + (size_t)(256 + c) * TG + bn * LT + segoff;
    u16* yp = m.u + (size_t)c * TG + bn * LT + segoff;
#pragma unroll
    for (int gq = 0; gq < 4; ++gq) {
      const int t4 = T0 + 32 * mb + 8 * gq + 4 * h;
      float e[6];
#pragma unroll
      for (int k = 0; k < 6; ++k) {
        const int tt = t4 - 1 + k;
        e[k] = (tt >= 0 && tt < L) ? bf2f(x2p[tt]) : 0.f;
      }
      const uint2 uu = *(const uint2*)(U + bn * US + t4);
      const float u0 = bflo_(uu.x), u1 = bfhi_(uu.x), u2 = bflo_(uu.y), u3 = bfhi_(uu.y);
      const float y0 = (e[0] * w0x + e[1] * w1x + e[2] * w2x + bx) * (acc[4 * gq + 0] + u0 * bias);
      const float y1 = (e[1] * w0x + e[2] * w1x + e[3] * w2x + bx) * (acc[4 * gq + 1] + u1 * bias);
      const float y2 = (e[2] * w0x + e[3] * w1x + e[4] * w2x + bx) * (acc[4 * gq + 2] + u2 * bias);
      const float y3 = (e[3] * w0x + e[4] * w1x + e[5] * w2x + bx) * (acc[4 * gq + 3] + u3 * bias);
      uint2 w;
      w.x = pack2(y0, y1);
      w.y = pack2(y2, y3);
      *(uint2*)(yp + t4) = w;
    }
  }
  __syncthreads();
}

#define DPP_ROR(v, n) __builtin_bit_cast(float, __builtin_amdgcn_update_dpp(0, __builtin_bit_cast(int, (v)), 0x120 + (n), 0xf, 0xf, true))
DI float row_allsum(float v) {
  v += DPP_ROR(v, 8);
  v += DPP_ROR(v, 4);
  v += DPP_ROR(v, 2);
  v += DPP_ROR(v, 1);
  return v;
}
DI float bflo(unsigned w) { return __uint_as_float(w << 16); }
DI float bfhi(unsigned w) { return __uint_as_float(w & 0xffff0000u); }
DI void scan_item(const Params& p, int l, const MixBufs& m, int bl, int hd, int dir, int rq, char* smem) {
  constexpr int TC = 16;
  constexpr int NCH = LT / TC;
  constexpr int BUF = 5 * TC * 64 + TC * 16;
  float* sbase = (float*)smem;
  float* sy = sbase + 2 * BUF;
  const int tid = ltid(), lane = tid & 63, wave = tid >> 6;
  const int kq = lane & 15, rloc = wave * 4 + (lane >> 4);
  const u16* eD = dir ? m.eb : m.ef;
  const u16* aD = dir ? m.ab : m.af;
  float* yD = dir ? m.yb : m.yf;
  const size_t rbase = (size_t)bl * LT;
  const int ss = tid >> 4, su = tid & 15, sc = su & 7;
  float kav[8];
#pragma unroll
  for (int i = 0; i < 8; ++i) kav[i] = p.rw_k_a[l * 256 + hd * 64 + sc * 8 + i];
  uint4 g0, g1, g2;
  g2.x = g2.y = g2.z = g2.w = 0u;
#define SCAN_JMAP(i) (dir ? ((i) < LC ? LC - 1 - (i) : LT - 1 - ((i) - LC)) : (i))
#define SCAN_GLOAD(i0)                                                                         \
  {                                                                                            \
    const int ii_ = (i0) + ss;                                                                 \
    const int j_ = SCAN_JMAP(ii_);                                                             \
    const size_t o_ = (rbase + j_) * 256 + hd * 64 + sc * 8;                                   \
    if (su < 8) {                                                                              \
      g0 = *(const uint4*)(m.rkk + o_);                                                        \
      g1 = *(const uint4*)(aD + o_);                                                           \
      g2 = *(const uint4*)(m.rk + o_);                                                         \
    } else {                                                                                   \
      g0 = *(const uint4*)(eD + o_);                                                           \
      g1 = *(const uint4*)(m.rr + o_);                                                         \
      if (sc < 2) g2 = *(const uint4*)(m.rv + (rbase + j_) * 256 + hd * 64 + rq * 16 + sc * 8); \
    }                                                                                          \
  }
#define SCAN_LSTORE(buf_)                                                                      \
  {                                                                                            \
    float* B_ = sbase + (buf_) * BUF;                                                          \
    const unsigned w0_[4] = {g0.x, g0.y, g0.z, g0.w};                                          \
    const unsigned w1_[4] = {g1.x, g1.y, g1.z, g1.w};                                          \
    const unsigned w2_[4] = {g2.x, g2.y, g2.z, g2.w};                                          \
    if (su < 8) {                                                                              \
      float kk_[8], bb_[8], dd_[8];                                                            \
      _Pragma("unroll") for (int q_ = 0; q_ < 4; ++q_) {                                       \
        const float k0_ = bflo(w0_[q_]), k1_ = bfhi(w0_[q_]);                                  \
        const float a0_ = bflo(w1_[q_]), a1_ = bfhi(w1_[q_]);                                  \
        const float v0_ = bflo(w2_[q_]), v1_ = bfhi(w2_[q_]);                                  \
        kk_[2 * q_] = k0_; kk_[2 * q_ + 1] = k1_;                                              \
        bb_[2 * q_] = k0_ * a0_; bb_[2 * q_ + 1] = k1_ * a1_;                                  \
        dd_[2 * q_] = v0_ * (1.f + (a0_ - 1.f) * kav[2 * q_]);                                 \
        dd_[2 * q_ + 1] = v1_ * (1.f + (a1_ - 1.f) * kav[2 * q_ + 1]);                         \
      }                                                                                        \
      float* d0_ = B_ + ss * 64 + sc * 8;                                                      \
      *(float4*)(d0_) = make_float4(kk_[0], kk_[1], kk_[2], kk_[3]);                           \
      *(float4*)(d0_ + 4) = make_float4(kk_[4], kk_[5], kk_[6], kk_[7]);                       \
      *(float4*)(d0_ + 2048) = make_float4(bb_[0], bb_[1], bb_[2], bb_[3]);                    \
      *(float4*)(d0_ + 2052) = make_float4(bb_[4], bb_[5], bb_[6], bb_[7]);                    \
      *(float4*)(d0_ + 3072) = make_float4(dd_[0], dd_[1], dd_[2], dd_[3]);                    \
      *(float4*)(d0_ + 3076) = make_float4(dd_[4], dd_[5], dd_[6], dd_[7]);                    \
    } else {                                                                                   \
      float ww_[8], rr_[8], vv_[8];                                                            \
      _Pragma("unroll") for (int q_ = 0; q_ < 4; ++q_) {                                       \
        ww_[2 * q_] = 1.f - bflo(w0_[q_]); ww_[2 * q_ + 1] = 1.f - bfhi(w0_[q_]);              \
        rr_[2 * q_] = bflo(w1_[q_]); rr_[2 * q_ + 1] = bfhi(w1_[q_]);                          \
        vv_[2 * q_] = bflo(w2_[q_]); vv_[2 * q_ + 1] = bfhi(w2_[q_]);                          \
      }                                                                                        \
      float* d0_ = B_ + ss * 64 + sc * 8;                                                      \
      *(float4*)(d0_ + 1024) = make_float4(ww_[0], ww_[1], ww_[2], ww_[3]);                    \
      *(float4*)(d0_ + 1028) = make_float4(ww_[4], ww_[5], ww_[6], ww_[7]);                    \
      *(float4*)(d0_ + 4096) = make_float4(rr_[0], rr_[1], rr_[2], rr_[3]);                    \
      *(float4*)(d0_ + 4100) = make_float4(rr_[4], rr_[5], rr_[6], rr_[7]);                    \
      if (sc < 2) {                                                                            \
        float* d1_ = B_ + 5120 + ss * 16 + sc * 8;                                             \
        *(float4*)(d1_) = make_float4(vv_[0], vv_[1], vv_[2], vv_[3]);                         \
        *(float4*)(d1_ + 4) = make_float4(vv_[4], vv_[5], vv_[6], vv_[7]);                     \
      }                                                                                        \
    }                                                                                          \
  }
  f32x2_t SA = {0.f, 0.f}, SB = {0.f, 0.f};
  __builtin_amdgcn_s_setprio(3);
  SCAN_GLOAD(0);
  SCAN_LSTORE(0);
  __syncthreads();
  for (int c = 0; c < NCH; ++c) {
    const int buf = c & 1;
    if (c + 1 < NCH) SCAN_GLOAD((c + 1) * TC);
    const float* B = sbase + buf * BUF;
    float* syb = sy + buf * TC * 16;
    float ypart[TC];
    float4 kkv[TC], wwv[TC], bbv[TC], ddv[TC], rrv[TC];
    float vvv[TC];
    constexpr int PF = 2;
#pragma unroll
    for (int st = 0; st < PF; ++st) {
      kkv[st] = *(const float4*)(B + st * 64 + kq * 4);
      wwv[st] = *(const float4*)(B + 1024 + st * 64 + kq * 4);
      bbv[st] = *(const float4*)(B + 2048 + st * 64 + kq * 4);
      ddv[st] = *(const float4*)(B + 3072 + st * 64 + kq * 4);
      rrv[st] = *(const float4*)(B + 4096 + st * 64 + kq * 4);
      vvv[st] = B[5120 + st * 16 + rloc];
    }
    __builtin_amdgcn_sched_barrier(0);
#pragma unroll
    for (int st = 0; st < TC; ++st) {
      if (st + PF < TC) {
        kkv[st + PF] = *(const float4*)(B + (st + PF) * 64 + kq * 4);
        wwv[st + PF] = *(const float4*)(B + 1024 + (st + PF) * 64 + kq * 4);
        bbv[st + PF] = *(const float4*)(B + 2048 + (st + PF) * 64 + kq * 4);
        ddv[st + PF] = *(const float4*)(B + 3072 + (st + PF) * 64 + kq * 4);
        rrv[st + PF] = *(const float4*)(B + 4096 + (st + PF) * 64 + kq * 4);
        vvv[st + PF] = B[5120 + (st + PF) * 16 + rloc];
      }
      __builtin_amdgcn_sched_barrier(0);
      const float4 kk = kkv[st], ww = wwv[st], bb = bbv[st], dd = ddv[st], rr = rrv[st];
      const float vv = vvv[st];
      const f32x2_t k01 = {kk.x, kk.y}, k23 = {kk.z, kk.w}, w01 = {ww.x, ww.y}, w23 = {ww.z, ww.w};
      const f32x2_t b01 = {bb.x, bb.y}, b23 = {bb.z, bb.w}, d01 = {dd.x, dd.y}, d23 = {dd.z, dd.w};
      const f32x2_t r01 = {rr.x, rr.y}, r23 = {rr.z, rr.w}, v2 = {vv, vv};
      const f32x2_t pp2 = SA * k01 + SB * k23;
      const float part = pp2.x + pp2.y;
      const f32x2_t cA = SA * w01 + v2 * d01, cB = SB * w23 + v2 * d23;
      const float sa = -row_allsum(part);
      const f32x2_t sa2 = {sa, sa};
      SA = cA + sa2 * b01;
      SB = cB + sa2 * b23;
      const f32x2_t yy2 = SA * r01 + SB * r23;
      ypart[st] = yy2.x + yy2.y;
    }
#pragma unroll
    for (int st = 0; st < TC; ++st) ypart[st] = row_allsum(ypart[st]);
    if (kq == 0) {
#pragma unroll
      for (int st = 0; st < TC; ++st) syb[st * 16 + rloc] = ypart[st];
    }
    if (c + 1 < NCH) SCAN_LSTORE(buf ^ 1);
    __syncthreads();
    {
      const int st = tid >> 4, r_ = tid & 15;
      const int ii = c * TC + st;
      const int j = SCAN_JMAP(ii);
      yD[(rbase + j) * 256 + hd * 64 + rq * 16 + r_] = syb[st * 16 + r_];
    }
  }
  __builtin_amdgcn_s_setprio(0);
  __syncthreads();
}

DI void readout_phase(const Params& p, int l, int g, const MixBufs& m, u16* __restrict__ ymix, bool skip_ctx, char* smem) {
  const int tid = ltid();
  {
    u16* tile = (u16*)smem;
    for (int tl = blockIdx.x; tl < (TG / 64) * 4; tl += gridDim.x) {
      const int rl0 = (tl >> 2) * 64, c0 = (tl & 3) * 64;
      const int r0 = g * TG + rl0;
      if (skip_ctx && (r0 % LT) < LC) continue;
#pragma unroll
      for (int k = 0; k < 2; ++k) {
        const int id = tid + NTHR * k, ch = id >> 3, part = id & 7;
        *(uint4*)(tile + ch * 72 + part * 8) = *(const uint4*)(m.u + (size_t)(c0 + ch) * TG + rl0 + part * 8);
      }
      __syncthreads();
#pragma unroll
      for (int k = 0; k < 2; ++k) {
        const int id = tid + NTHR * k, tok = id >> 3, part = id & 7;
        const u16* tp = tile + (part * 8) * 72 + tok;
        uint4 w;
        w.x = (unsigned)tp[0] | ((unsigned)tp[72] << 16);
        w.y = (unsigned)tp[2 * 72] | ((unsigned)tp[3 * 72] << 16);
        w.z = (unsigned)tp[4 * 72] | ((unsigned)tp[5 * 72] << 16);
        w.w = (unsigned)tp[6 * 72] | ((unsigned)tp[7 * 72] << 16);
        *(uint4*)(ymix + (size_t)(r0 + tok) * D + c0 + part * 8) = w;
      }
      __syncthreads();
    }
  }
  for (int rl = blockIdx.x; rl < TG; rl += gridDim.x) {
    const int r = g * TG + rl;
    const int j = r % LT;
    if (skip_ctx && j < LC) continue;
    const size_t o = (size_t)rl * 256 + tid;
    float y = m.yf[o] + m.yb[o];
    float mean = wave_sum(y) * (1.f / 64.f);
    float dv = y - mean;
    float var = wave_sum(dv * dv) * (1.f / 64.f);
    float yn = dv * rsqrtf(var + 64e-5f) * p.rw_ln_w[l * 256 + tid] + p.rw_ln_b[l * 256 + tid];
    const float rr = bf2f(m.rr[o]), kv = bf2f(m.rk[o]), vv = bf2f(m.rv[o]);
    const float kaa = p.rw_k_a[l * 256 + tid], rk = p.rw_r_k[l * 256 + tid];
    const float af = bf2f(m.af[o]), ab = bf2f(m.ab[o]);
    float t1 = rr * kv * (1.f + (af - 1.f) * kaa) * rk + rr * kv * (1.f + (ab - 1.f) * kaa) * rk;
    float bonus = wave_sum(t1) * vv;
    ymix[(size_t)r * D + 768 + tid] = f2bf((yn + bonus) * bf2f(m.gg[o]));
  }
}

#define XB_TMO      128
#define XB_XCNT(j)  (256  + 64 * (j))
#define XB_XSUB(j)  (1280 + 64 * (j))
#define XB_XGEN(j)  (2304 + 64 * (j))
#define XB_TOP      3328
#define XB_TOPGEN   3392
#define XCD_BAR_WORDS 3456
#define XB_SPIN_CAP (1u << 21)
#define LAS __attribute__((address_space(3)))
DI unsigned xb_ld(unsigned* p) { return __hip_atomic_load(p, __ATOMIC_RELAXED, __HIP_MEMORY_SCOPE_AGENT); }
DI unsigned xb_add(unsigned* p, unsigned v) { return __hip_atomic_fetch_add(p, v, __ATOMIC_RELAXED, __HIP_MEMORY_SCOPE_AGENT); }
DI unsigned xb_xcc_id() { return (unsigned)__builtin_amdgcn_s_getreg((3 << 11) | 20) & 0xFu; }
#define XB_SPIN(cond, bar) do { unsigned _sp = 0; while (cond) { __builtin_amdgcn_s_sleep(1); \
    if ((++_sp & 255u) == 0u) { if (xb_ld(&(bar)[XB_TMO])) break; if (_sp > XB_SPIN_CAP) { atomicAdd(&(bar)[XB_TMO], 1u); break; } } } } while (0)
struct XcdBarrier { unsigned* bar; unsigned x; volatile LAS unsigned* st; };
DI XcdBarrier xcd_barrier_post(unsigned* bar, volatile LAS unsigned* st) {
  XcdBarrier b; b.bar = bar; b.x = xb_xcc_id(); b.st = st;
  if (threadIdx.x == 0) (void)xb_add(&bar[XB_XCNT(b.x)], 1u);
  return b;
}
DI void xcd_barrier_complete(unsigned* bar, unsigned x, unsigned& nloc, unsigned& nx) {
  const unsigned G = gridDim.x * gridDim.y * gridDim.z;
  unsigned sum, cnt, mine, sp = 0u;
  for (;;) {
    sum = 0u; cnt = 0u; mine = 0u;
#pragma unroll
    for (unsigned j = 0; j < 16; ++j) { const unsigned c = xb_ld(&bar[XB_XCNT(j)]); sum += c; cnt += (c > 0u) ? 1u : 0u; mine = (j == x) ? c : mine; }
    if (sum == G) break;
    __builtin_amdgcn_s_sleep(1);
    if ((++sp & 255u) == 0u) { if (xb_ld(&bar[XB_TMO])) break; if (sp > XB_SPIN_CAP) { atomicAdd(&bar[XB_TMO], 1u); break; } }
  }
  nloc = mine > 0u ? mine : 1u; nx = cnt > 0u ? cnt : 1u;
}
DI void xcd_barrier(const XcdBarrier& b) {
  asm volatile("s_waitcnt vmcnt(0)" ::: "memory");
  __syncthreads();
  if (threadIdx.x == 0) {
    unsigned* bar = b.bar;
    __builtin_amdgcn_s_waitcnt(0);
    unsigned nloc = b.st[0], nx = b.st[1];
    if (nloc == 0u) { xcd_barrier_complete(bar, b.x, nloc, nx); b.st[0] = nloc; b.st[1] = nx; }
    const unsigned old = xb_add(&bar[XB_XSUB(b.x)], 1u);
    const unsigned gen = old / nloc;
    if (old + 1u == (gen + 1u) * nloc) {
      __builtin_amdgcn_fence(__ATOMIC_RELEASE, "agent");
      asm volatile("s_waitcnt vmcnt(0)" ::: "memory");
      const unsigned og = xb_add(&bar[XB_TOP], 1u);
      const unsigned tg = og / nx;
      if (og + 1u == (tg + 1u) * nx) xb_add(&bar[XB_TOPGEN], 1u);
      else XB_SPIN(xb_ld(&bar[XB_TOPGEN]) == tg, bar);
      __builtin_amdgcn_fence(__ATOMIC_ACQUIRE, "agent");
      xb_add(&bar[XB_XGEN(b.x)], 1u);
      asm volatile("s_waitcnt vmcnt(0)" ::: "memory");
    } else {
      XB_SPIN(xb_ld(&bar[XB_XGEN(b.x)]) == gen, bar);
      __builtin_amdgcn_fence(__ATOMIC_ACQUIRE, "agent");
      asm volatile("s_waitcnt vmcnt(0)" ::: "memory");
    }
  }
  __syncthreads();
}

__global__ void __launch_bounds__(NTHR, 2) fwd_megakernel(Params p) {
  cg::grid_group grid = cg::this_grid();
  __shared__ __attribute__((aligned(16))) char smem[73728];
  __shared__ int s_item;
  __shared__ uint4 xb_words;
  if (threadIdx.x == 0) xb_words = make_uint4(0u, 0u, 0u, 0u);
  __syncthreads();
  const XcdBarrier xb = xcd_barrier_post((unsigned*)(p.ws + OFF_BAR), (volatile LAS unsigned*)&xb_words);
  char* ws = p.ws;
  float* ctxs = (float*)(ws + OFF_CTX);
  float* mod = (float*)(ws + OFF_MOD);
  u16* hbuf = (u16*)(ws + OFF_H);
  char* big = ws + OFF_BIG;
  u16* Gbuf = (u16*)big;
  const MixBufs m = mixbufs(big);

  for (int rep = 0; rep < REP_MISC; ++rep)
  for (int l = 0; l < 2; ++l) {
    u16* W = (u16*)(ws + OFF_W) + (size_t)l * W_LAYER;
    convT(p.ffn1_gate + (size_t)l * D * DFF, D, DFF, W + W_GU1, 1, smem);
    convT(p.ffn1_up + (size_t)l * D * DFF, D, DFF, W + W_GU1, 2, smem);
    convT(p.ffn1_down + (size_t)l * D * DFF, DFF, D, W + W_D1, 0, smem);
    convT(p.ffn2_gate + (size_t)l * D * DFF, D, DFF, W + W_GU2, 1, smem);
    convT(p.ffn2_up + (size_t)l * D * DFF, D, DFF, W + W_GU2, 2, smem);
    convT(p.ffn2_down + (size_t)l * D * DFF, DFF, D, W + W_D2, 0, smem);
    convT(p.w_in + (size_t)l * D * DIN, D, DIN, W + W_IN, 0, smem);
    convT(p.w_out + (size_t)l * D * D, D, D, W + W_OUT, 0, smem);
    convT(p.mla_w_uq + (size_t)l * 256 * 384, 256, 384, W + W_UQ, 0, smem);
    convT(p.mla_w_ukv + (size_t)l * 128 * 512, 128, 512, W + W_UKV, 0, smem);
    for (int d = 0; d < 2; ++d) {
      convT(p.rw_w2 + (size_t)(l * 2 + d) * 64 * 256, 64, 256, W + W_W2 + (size_t)d * 256 * 64, 0, smem);
      convT(p.rw_a2 + (size_t)(l * 2 + d) * 64 * 256, 64, 256, W + W_A2 + (size_t)d * 256 * 64, 0, smem);
    }
    convT(p.rw_g2 + (size_t)l * 128 * 256, 128, 256, W + W_G2, 0, smem);
    hyfilt_phase(p, l, LQ, (float*)(ws + OFF_FILT + (size_t)l * al(SZ_FILT_L)), smem);
  }
  hyfilt_phase(p, 0, LC, (float*)(ws + OFF_FILTC), smem);
  rope_table_phase((float2*)(ws + OFF_ROPEG), (float2*)(ws + OFF_ROPEM));
  mod_phase(p, mod, smem);
  grid.sync();

  for (int l = 0; l < 2; ++l) {
    const bool last = (l == 1);
    const u16* W = (u16*)(ws + OFF_W) + (size_t)l * W_LAYER;
    const float* modl = mod + (size_t)l * 9 * 9216;
    const float* lat_in = (l == 0) ? p.x : p.out;
    const float* ctx_in = (l == 0) ? p.ctx : ctxs;

    adaln_phase(lat_in, ctx_in, p.norm_ffn1 + l * D, modl, 0, hbuf, false);
    xcd_barrier(xb);
    {
      EpiGU e{Gbuf};
      for (int rep = 0; rep < REP_GU; ++rep) gemm_phase<true>(hbuf, D, W + W_GU1, D, D, T / 128, 44, 0, false, smem, e);
    }
    xcd_barrier(xb);
    {
      EpiRes e{lat_in, ctx_in, p.out, ctxs, modl, 2, 0.5f, nullptr, nullptr, nullptr, 0};
      gemm_phase<false>(Gbuf, DFF, W + W_D1, DFF, DFF, T / 128, 8, 0, false, smem, e);
    }
    xcd_barrier(xb);
    adaln_phase(p.out, ctxs, p.norm_mix + l * D, modl, 1, hbuf, false);
    xcd_barrier(xb);
    for (int g = 0; g < NG; ++g) {
      const u16* hg = hbuf + (size_t)g * TG * D;
      {
        EpiWin e{m.p, m.pt};
        gemm_phase<false>(hg, D, W + W_IN, D, D, TG / 128, 23, 0, false, smem, e);
      }
      xcd_barrier(xb);
      for (int rep = 0; rep < REP_ROW; ++rep) prep_phase(p, l, g, m, (const float2*)(ws + OFF_ROPEG), smem);
      xcd_barrier(xb);
      {
        EpiStore e1{m.qup, 384, 384};
        gemm_phase<false>(m.cqn, 256, W + W_UQ, 256, 256, TG / 128, 3, 0, false, smem, e1);
        EpiStore e2{m.kvup, 512, 512};
        gemm_phase<false>(m.ckvn, 128, W + W_UKV, 128, 128, TG / 128, 4, 0, false, smem, e2);
        EpiLoraW e3{m.ef, p.rw_w0 + (l * 2 + 0) * 256};
        gemm_phase<false>(m.lwf, 64, W + W_W2, 64, 64, TG / 128, 2, 0, false, smem, e3);
        EpiLoraW e4{m.eb, p.rw_w0 + (l * 2 + 1) * 256};
        gemm_phase<false>(m.lwb, 64, W + W_W2 + 256 * 64, 64, 64, TG / 128, 2, 0, false, smem, e4);
        EpiLoraA e5{m.af, p.rw_a0 + (l * 2 + 0) * 256};
        gemm_phase<false>(m.laf, 64, W + W_A2, 64, 64, TG / 128, 2, 0, false, smem, e5);
        EpiLoraA e6{m.ab, p.rw_a0 + (l * 2 + 1) * 256};
        gemm_phase<false>(m.lab, 64, W + W_A2 + 256 * 64, 64, 64, TG / 128, 2, 0, false, smem, e6);
        EpiStore e7{m.gg, 256, 256};
        gemm_phase<false>(m.lg, 128, W + W_G2, 128, 128, TG / 128, 2, 0, false, smem, e7);
      }
      xcd_barrier(xb);
      for (int rep = 0; rep < REP_ROW; ++rep) mla_fin_phase(p, l, g, m, (const float2*)(ws + OFF_ROPEM));
      xcd_barrier(xb);
      {
        u16* ymix = hbuf;
        const int n_scan = BG * 4 * 2 * 4;
        const int qt_per_b = last ? 32 : 34;
        const int n_att = BG * 4 * qt_per_b;
        const int n_hy = 256;
        const int total = n_scan + 2 * n_att + n_hy;
        float gq = 0.f, gk = 0.f, mq = 0.f, mk = 0.f;
        for (int i = 0; i < 64; ++i) { gq = fmaxf(gq, fabsf(p.gqa_q_norm[l * 64 + i])); gk = fmaxf(gk, fabsf(p.gqa_k_norm[l * 64 + i])); }
        for (int i = 0; i < 96; ++i) { mq = fmaxf(mq, fabsf(p.mla_q_norm[l * 96 + i])); mk = fmaxf(mk, fabsf(p.mla_k_norm[l * 96 + i])); }
        const float L2E = 1.4426950408889634f;
        const float sc_g = 0.125f, sc_m = 0.10206207261596575f;
        const float sh_g = (64.f * gq * gk * sc_g * 1.02f + 0.5f) * L2E;
        const float sh_m = (96.f * mq * mk * sc_m * 1.02f + 0.5f) * L2E;
        int* cnt = (int*)(ws + OFF_CNT) + (l * NG + g);
        for (;;) {
          if (threadIdx.x == 0) s_item = atomicAdd(cnt, 1);
          __syncthreads();
          const int it = s_item;
          __syncthreads();
          if (it >= total) break;
          if (it < n_scan) {
            const int bl = it >> 5, hd = (it >> 3) & 3, dir = (it >> 2) & 1, rq = it & 3;
            scan_item(p, l, m, bl, hd, dir, rq, smem);
          } else if (it < n_scan + 2 * n_att) {
            int a = it - n_scan;
            const int kind = a / n_att;
            a -= kind * n_att;
            const int bl = a / (4 * qt_per_b);
            int rem = a - bl * 4 * qt_per_b;
            const int hd = rem / qt_per_b;
            const int qt = rem - hd * qt_per_b;
            const int j0 = qt < 32 ? LC + qt * 128 : (qt - 32) * 128;
            const int nkeys = qt < 32 ? LT : LC;
            const size_t rl0 = (size_t)bl * LT + j0;
            const size_t rg0 = (size_t)(g * BG + bl) * LT + j0;
            if (kind == 0) {
              const int kvh = hd >> 1;
              attn_item<64, 1>(m.qg + rl0 * 256 + hd * 64, 256, m.kg + (size_t)bl * LT * 128 + kvh * 64, 128,
                            m.vtg + (size_t)(bl * 2 + kvh) * 64 * LT, ymix + rg0 * D + 256 + hd * 64, D, nkeys, sc_g * L2E, sh_g, smem);
            } else {
              attn_item<96, 1>(m.qm + rl0 * 384 + hd * 96, 384, m.km + (size_t)bl * LT * 384 + hd * 96, 384,
                            m.vtm + (size_t)(bl * 4 + hd) * 64 * LT, ymix + rg0 * D + 512 + hd * 64, D, nkeys, sc_m * L2E, sh_m, smem);
            }
          } else {
            const int c = it - n_scan - 2 * n_att;
            hyena_pass(p, l, m, (const float*)(ws + OFF_FILT + (size_t)l * al(SZ_FILT_L)), LQ, LC, c, smem);
            if (!last) hyena_pass(p, l, m, (const float*)(ws + OFF_FILTC), LC, 0, c, smem);
          }
        }
        xcd_barrier(xb);
        for (int rep = 0; rep < REP_ROW; ++rep) readout_phase(p, l, g, m, ymix, last, smem);
        xcd_barrier(xb);
      }
    }
    {
      EpiRes e{p.out, ctxs, p.out, ctxs, modl, 5, 1.0f, nullptr, nullptr, nullptr, 0};
      gemm_phase<false>(hbuf, D, W + W_OUT, D, D, T / 128, 8, 0, last, smem, e);
    }
    xcd_barrier(xb);
    adaln_phase(p.out, ctxs, p.norm_ffn2 + l * D, modl, 2, hbuf, last);
    xcd_barrier(xb);
    {
      EpiGU e{Gbuf};
      for (int rep = 0; rep < REP_GU; ++rep) gemm_phase<true>(hbuf, D, W + W_GU2, D, D, T / 128, 44, 0, last, smem, e);
    }
    xcd_barrier(xb);
    {
      EpiRes e{p.out, ctxs, p.out, ctxs, modl, 8, 0.5f, nullptr, nullptr, nullptr, 0};
      gemm_phase<false>(Gbuf, DFF, W + W_D2, DFF, DFF, T / 128, 8, 0, last, smem, e);
    }
    xcd_barrier(xb);
  }
}

extern "C" void kernel_launch(void* const* d_in, const int* in_sizes, int n_in, void* d_out, int out_size, void* d_ws,
                              size_t ws_size, hipStream_t stream) {
  static int grid_blocks = 0;
  if (!grid_blocks) {
    int dev = 0, cus = 0, per_cu = 0;
    (void)hipGetDevice(&dev);
    (void)hipDeviceGetAttribute(&cus, hipDeviceAttributeMultiprocessorCount, dev);
    (void)hipOccupancyMaxActiveBlocksPerMultiprocessor(&per_cu, fwd_megakernel, NTHR, 0);
    if (per_cu > 2) per_cu = 2;
    if (per_cu < 1) per_cu = 1;
    grid_blocks = cus * per_cu;
  }
  Params p{};
  const float** pp = (const float**)&p;
  for (int i = 0; i < 47; ++i) pp[i] = (const float*)d_in[i];
  p.out = (float*)d_out;
  p.ws = (char*)d_ws;
  (void)hipMemsetAsync((char*)d_ws + OFF_CNT, 0, 256 + 3456 * 4, stream);
  void* args[] = {&p};
  hipError_t e = hipLaunchCooperativeKernel((void*)fwd_megakernel, dim3(grid_blocks), dim3(NTHR), args, 0, stream);
  if (e != hipSuccess) fprintf(stderr, "cooperative launch failed: %s (grid %d)\n", hipGetErrorString(e), grid_blocks);
}
```

```cpp
#include <hip/hip_runtime.h>
#include <hip/hip_bf16.h>
#include <hip/hip_cooperative_groups.h>
#include <cstdio>
namespace cg = cooperative_groups;

#define DI __device__ __forceinline__
typedef unsigned short u16;
using bf16x8 = __attribute__((ext_vector_type(8))) short;
using f32x16 = __attribute__((ext_vector_type(16))) float;
typedef __bf16 bf16x2_t __attribute__((ext_vector_type(2)));
typedef float f32x2_t __attribute__((ext_vector_type(2)));
#define MFMA32(a, b, c) __builtin_amdgcn_mfma_f32_32x32x16_bf16((a), (b), (c), 0, 0, 0)

constexpr int D = 1024, NB = 8, LQ = 4096, LC = 256, LT = 4352, T = NB * LT, DFF = 2816, DIN = 2848;
constexpr int HYC = 768, DINP = DIN - HYC;
constexpr int NG = 2, BG = NB / NG, TG = BG * LT;
constexpr int NTHR = 256;
#define REP_MIX 1
#define REP_GU 1
#define REP_MISC 1
#define REP_ROW 1
constexpr float EPS = 1e-6f;

constexpr size_t al(size_t x) { return (x + 255) & ~(size_t)255; }
constexpr size_t OFF_CTX = 0;
constexpr size_t OFF_MOD = OFF_CTX + al((size_t)NB * LC * D * 4);
constexpr size_t SZ_FILT_L = (size_t)(2 * LQ - 1) * 256 * 4;
constexpr size_t SZ_FILT_C = (size_t)(2 * LC - 1) * 256 * 4;
constexpr size_t OFF_CNT = OFF_MOD + al((size_t)2 * 9 * 9216 * 4);
constexpr size_t OFF_BAR = OFF_CNT + 256;
constexpr size_t OFF_FILT = OFF_BAR + al((size_t)3456 * 4);
constexpr size_t OFF_FILTC = OFF_FILT + al(SZ_FILT_L);
constexpr size_t OFF_ROPEG = OFF_FILTC + al(SZ_FILT_C);
constexpr size_t OFF_ROPEM = OFF_ROPEG + al((size_t)LQ * 32 * 8);
constexpr size_t OFF_W = OFF_ROPEM + al((size_t)LQ * 16 * 8);
constexpr size_t W_GU1 = 0;
constexpr size_t W_D1 = W_GU1 + (size_t)5632 * 1024;
constexpr size_t W_GU2 = W_D1 + (size_t)1024 * 2816;
constexpr size_t W_D2 = W_GU2 + (size_t)5632 * 1024;
constexpr size_t W_IN = W_D2 + (size_t)1024 * 2816;
constexpr size_t W_OUT = W_IN + (size_t)2944 * 1024;
constexpr size_t W_UQ = W_OUT + (size_t)1024 * 1024;
constexpr size_t W_UKV = W_UQ + (size_t)384 * 256;
constexpr size_t W_W2 = W_UKV + (size_t)512 * 128;
constexpr size_t W_A2 = W_W2 + (size_t)2 * 256 * 64;
constexpr size_t W_G2 = W_A2 + (size_t)2 * 256 * 64;
constexpr size_t W_LAYER = W_G2 + (size_t)256 * 128;
constexpr size_t OFF_H = OFF_W + al(W_LAYER * 2);
constexpr size_t OFF_BIG = OFF_H + al((size_t)T * D * 2);
constexpr size_t M_P = 0;
constexpr size_t M_PT = M_P + al((size_t)TG * DINP * 2);
constexpr size_t M_U = M_PT + al((size_t)HYC * TG * 2);
constexpr size_t M_QG = M_U + al((size_t)TG * 256 * 2);
constexpr size_t M_KG = M_QG + al((size_t)TG * 256 * 2);
constexpr size_t M_VTG = M_KG + al((size_t)TG * 128 * 2);
constexpr size_t M_CQN = M_VTG + al((size_t)TG * 128 * 2);
constexpr size_t M_CKVN = M_CQN + al((size_t)TG * 256 * 2);
constexpr size_t M_QUP = M_CKVN + al((size_t)TG * 128 * 2);
constexpr size_t M_KVUP = M_QUP + al((size_t)TG * 384 * 2);
constexpr size_t M_QM = M_KVUP + al((size_t)TG * 512 * 2);
constexpr size_t M_KM = M_QM + al((size_t)TG * 384 * 2);
constexpr size_t M_VTM = M_KM + al((size_t)TG * 384 * 2);
constexpr size_t M_LWF = M_VTM + al((size_t)TG * 256 * 2);
constexpr size_t M_LWB = M_LWF + al((size_t)TG * 64 * 2);
constexpr size_t M_LAF = M_LWB + al((size_t)TG * 64 * 2);
constexpr size_t M_LAB = M_LAF + al((size_t)TG * 64 * 2);
constexpr size_t M_LG = M_LAB + al((size_t)TG * 64 * 2);
constexpr size_t SZ_SC = al((size_t)TG * 256 * 2);
constexpr size_t M_SCAN = M_LG + al((size_t)TG * 128 * 2);
constexpr size_t SCAN_STRIDE = 9 * SZ_SC;
constexpr size_t M_END = M_SCAN + 2 * SCAN_STRIDE;
static_assert((size_t)4 * TG * 256 * 4 <= al((size_t)TG * DINP * 2), "yf/yb do not fit the p region");
constexpr size_t SZ_G = (size_t)T * DFF * 2;
constexpr size_t WS_NEED = OFF_BIG + (M_END > SZ_G ? M_END : SZ_G);
static_assert(WS_NEED <= (size_t)512 * 1024 * 1024, "workspace too large");

struct Params {
  const float *x, *c, *ctx, *c_ctx, *ada_w, *ada_b, *norm_ffn1, *norm_mix, *norm_ffn2;
  const float *ffn1_gate, *ffn1_up, *ffn1_down, *ffn2_gate, *ffn2_up, *ffn2_down, *w_in, *w_out;
  const float *hy_conv_w, *hy_conv_b, *hy_f_w1, *hy_f_b1, *hy_f_w2, *hy_f_b2, *hy_f_w3, *hy_f_b3, *hy_f_w4, *hy_f_freq, *hy_bias;
  const float *gqa_q_norm, *gqa_k_norm, *mla_cq_norm, *mla_ckv_norm, *mla_w_uq, *mla_w_ukv, *mla_q_norm, *mla_k_norm;
  const float *rw_mu, *rw_w0, *rw_w2, *rw_a0, *rw_a2, *rw_g2, *rw_k_k, *rw_k_a, *rw_r_k, *rw_ln_w, *rw_ln_b;
  float* out;
  char* ws;
};

DI u16 f2bf(float x) {
  unsigned u = __float_as_uint(x);
  u += 0x7fffu + ((u >> 16) & 1u);
  return (u16)(u >> 16);
}
DI float bf2f(u16 b) { return __uint_as_float(((unsigned)b) << 16); }
DI float bflo_(unsigned w) { return __uint_as_float(w << 16); }
DI float bfhi_(unsigned w) { return __uint_as_float(w & 0xffff0000u); }
DI unsigned pack2(float a, float b) {
  f32x2_t v = {a, b};
  bf16x2_t r = __builtin_convertvector(v, bf16x2_t);
  return __builtin_bit_cast(unsigned, r);
}
DI int ltid() {
  int t = threadIdx.x;
  asm volatile("" : "+v"(t));
  return t;
}
DI float wave_sum(float v) {
#pragma unroll
  for (int o = 32; o > 0; o >>= 1) v += __shfl_xor(v, o);
  return v;
}
DI float wave_max(float v) {
#pragma unroll
  for (int o = 32; o > 0; o >>= 1) v = fmaxf(v, __shfl_xor(v, o));
  return v;
}
DI float sigmoidf_(float x) { return __builtin_amdgcn_rcpf(1.f + __expf(-x)); }
DI int crow(int i, int h) { return (i & 3) + 8 * (i >> 2) + 4 * h; }

DI float rope_apply(float val, int idx, int nfreq, int t, int lane) {
  int pi = idx >> 1;
  int row = t >> 6, col = t & 63;
  float pos = pi < nfreq ? (float)row : (float)col;
  int f = pi < nfreq ? pi : pi - nfreq;
  float inv = exp2f(-(float)f / (float)nfreq * 13.287712379549449f);
  float ang = pos * inv;
  float cs = cosf(ang), sn = sinf(ang);
  float other = __shfl_xor(val, 1);
  return (lane & 1) ? other * sn + val * cs : val * cs - other * sn;
}

DI float rope_tab(float val, int idx, const float2* __restrict__ tab, int lane) {
  const float2 cs = tab[idx >> 1];
  const float other = __shfl_xor(val, 1);
  return (lane & 1) ? other * cs.y + val * cs.x : val * cs.x - other * cs.y;
}
DI void rope_table_phase(float2* __restrict__ tg, float2* __restrict__ tm) {
  const int tid = ltid();
  for (int e = blockIdx.x * NTHR + tid; e < LQ * 48; e += gridDim.x * NTHR) {
    const int t = e / 48, k = e - t * 48;
    const bool isg = k < 32;
    const int pi = isg ? k : k - 32, nfreq = isg ? 16 : 8;
    const int row = t >> 6, col = t & 63;
    const float pos = pi < nfreq ? (float)row : (float)col;
    const int f = pi < nfreq ? pi : pi - nfreq;
    const float inv = exp2f(-(float)f / (float)nfreq * 13.287712379549449f);
    const float ang = pos * inv;
    const float2 v = make_float2(cosf(ang), sinf(ang));
    if (isg) tg[t * 32 + pi] = v; else tm[t * 16 + pi] = v;
  }
}

DI int gu_row(int n, int half) { return (n >> 6) * 128 + ((n >> 5) & 1) * 64 + half * 32 + (n & 31); }
DI void convT(const float* __restrict__ src, int K, int N, u16* __restrict__ dst, int mode, char* smem) {
  float* tile = (float*)smem;
  const int tk = K / 64, tn = (N + 63) / 64;
  const int tid_ = ltid();
  const int j = tid_ & 63, i0 = tid_ >> 6;
  for (int t = blockIdx.x; t < tk * tn; t += gridDim.x) {
    const int k0 = (t / tn) * 64, n0 = (t % tn) * 64;
    for (int i = i0; i < 64; i += 4) {
      int n = n0 + j;
      tile[i * 65 + j] = n < N ? src[(size_t)(k0 + i) * N + n] : 0.f;
    }
    __syncthreads();
    for (int i = i0; i < 64; i += 4) {
      int n = n0 + i;
      if (n < N) {
        int row = mode == 0 ? n : gu_row(n, mode - 1);
        dst[(size_t)row * K + k0 + j] = f2bf(tile[j * 65 + i]);
      }
    }
    __syncthreads();
  }
}

DI void mod_phase(const Params& p, float* __restrict__ mod, char* smem) {
  float* sc = (float*)smem;
  float* red = sc + 9 * 1024;
  const int tid_ = ltid();
  for (int i = tid_; i < 9 * 1024; i += NTHR) {
    float v = i < 8192 ? p.c[i] : p.c_ctx[i - 8192];
    sc[i] = v / (1.f + expf(-v));
  }
  __syncthreads();
  const int lane = tid_ & 63, kp = tid_ >> 6;
  for (int it = blockIdx.x; it < 2 * 144; it += gridDim.x) {
    const int l = it / 144, nb = (it % 144) * 64;
    const float* w = p.ada_w + (size_t)l * 1024 * 9216 + nb + lane;
    float acc[9];
#pragma unroll
    for (int b = 0; b < 9; ++b) acc[b] = 0.f;
    for (int k = kp * 256; k < kp * 256 + 256; ++k) {
      float wv = w[(size_t)k * 9216];
#pragma unroll
      for (int b = 0; b < 9; ++b) acc[b] += sc[b * 1024 + k] * wv;
    }
#pragma unroll
    for (int b = 0; b < 9; ++b) red[(kp * 9 + b) * 64 + lane] = acc[b];
    __syncthreads();
    for (int o = tid_; o < 9 * 64; o += NTHR) {
      int b = o >> 6, ln = o & 63;
      float s = red[(0 * 9 + b) * 64 + ln] + red[(1 * 9 + b) * 64 + ln] + red[(2 * 9 + b) * 64 + ln] + red[(3 * 9 + b) * 64 + ln];
      mod[((size_t)l * 9 + b) * 9216 + nb + ln] = s + p.ada_b[l * 9216 + nb + ln];
    }
    __syncthreads();
  }
}

DI void hyfilt_phase(const Params& p, int l, int L, float* __restrict__ gT, char* smem) {
  float* z = (float*)smem;
  float* h1 = z + 64;
  float* h2 = h1 + 64;
  float* h3 = h2 + 64;
  float* w1s = z + 256;
  float* w2s = w1s + 33 * 64;
  float* w3s = w2s + 64 * 64;
  const float* w4 = p.hy_f_w4 + l * 64 * 512;
  const int tid = ltid();
  for (int i = tid; i < 33 * 64; i += NTHR) w1s[i] = p.hy_f_w1[l * 33 * 64 + i];
  for (int i = tid; i < 64 * 64; i += NTHR) { w2s[i] = p.hy_f_w2[l * 4096 + i]; w3s[i] = p.hy_f_w3[l * 4096 + i]; }
  float b1v = 0.f, b2v = 0.f, b3v = 0.f, frv = 0.f;
  if (tid < 64) { b1v = p.hy_f_b1[l * 64 + tid]; b2v = p.hy_f_b2[l * 64 + tid]; b3v = p.hy_f_b3[l * 64 + tid]; frv = p.hy_f_freq[l * 64 + tid]; }
  const float min_decay = logf(1e-2f) / 1.5f, max_decay = logf(1e-2f) / 0.3f;
  const float delta = fabsf(min_decay + (max_decay - min_decay) * (float)tid / 255.f);
  __syncthreads();
  for (int t = blockIdx.x; t < L; t += gridDim.x) {
    const float t01 = (float)t / (float)(L - 1);
    if (tid < 33) {
      float zz;
      if (tid == 0) zz = t01;
      else {
        int i = (tid - 1) & 15;
        float f = 1e-4f + (float)i * ((15.f - 1e-4f) / 15.f);
        float wang = 6.283185307179586f * (float)t / (float)L;
        zz = tid <= 16 ? cosf(f * wang) : -sinf(f * wang);
      }
      z[tid] = zz;
    }
    __syncthreads();
    if (tid < 64) {
      float a = b1v;
#pragma unroll 11
      for (int i = 0; i < 33; ++i) a += z[i] * w1s[i * 64 + tid];
      h1[tid] = sinf(frv * a);
    }
    __syncthreads();
    if (tid < 64) {
      float a = b2v;
#pragma unroll 16
      for (int i = 0; i < 64; ++i) a += h1[i] * w2s[i * 64 + tid];
      h2[tid] = sinf(frv * a);
    }
    __syncthreads();
    if (tid < 64) {
      float a = b3v;
#pragma unroll 16
      for (int i = 0; i < 64; ++i) a += h2[i] * w3s[i * 64 + tid];
      h3[tid] = sinf(frv * a);
    }
    __syncthreads();
    float af = 0.f, ab = 0.f;
#pragma unroll 8
    for (int i = 0; i < 64; ++i) {
      af += h3[i] * w4[i * 512 + tid];
      ab += h3[i] * w4[i * 512 + 256 + tid];
    }
    const float dec = expf(-t01 * delta);
    af *= dec;
    ab *= dec;
    if (t == 0) gT[(size_t)(L - 1) * 256 + tid] = af + ab;
    else {
      gT[(size_t)(L - 1 + t) * 256 + tid] = af;
      gT[(size_t)(L - 1 - t) * 256 + tid] = ab;
    }
    __syncthreads();
  }
  __syncthreads();
}

DI void adaln_phase(const float* __restrict__ lat, const float* __restrict__ ctxp, const float* __restrict__ gain,
                    const float* __restrict__ modl, int idx, u16* __restrict__ h, bool skip_ctx) {
  const int tid_ = ltid();
  const int wave = tid_ >> 6, lane = tid_ & 63;
  for (int r = blockIdx.x * 4 + wave; r < T; r += gridDim.x * 4) {
    const int b = r / LT, j = r - b * LT;
    if (skip_ctx && j < LC) continue;
    const float* xr = j < LC ? ctxp + ((size_t)(b * LC + j) << 10) : lat + ((size_t)(b * LQ + j - LC) << 10);
    const int bb = j < LC ? 8 : b;
    const float* shift = modl + bb * 9216 + (3 * idx) * 1024;
    const float* scale = shift + 1024;
    float4 v[4];
    float ss = 0.f;
#pragma unroll
    for (int q = 0; q < 4; ++q) {
      v[q] = *(const float4*)(xr + q * 256 + lane * 4);
      ss += v[q].x * v[q].x + v[q].y * v[q].y + v[q].z * v[q].z + v[q].w * v[q].w;
    }
    ss = wave_sum(ss);
    const float rstd = rsqrtf(ss * (1.f / 1024.f) + EPS);
#pragma unroll
    for (int q = 0; q < 4; ++q) {
      const int c = q * 256 + lane * 4;
      float4 g = *(const float4*)(gain + c), sc = *(const float4*)(scale + c), sh = *(const float4*)(shift + c);
      float y0 = v[q].x * rstd * g.x * (1.f + sc.x) + sh.x;
      float y1 = v[q].y * rstd * g.y * (1.f + sc.y) + sh.y;
      float y2 = v[q].z * rstd * g.z * (1.f + sc.z) + sh.z;
      float y3 = v[q].w * rstd * g.w * (1.f + sc.w) + sh.w;
      uint2 o;
      o.x = pack2(y0, y1);
      o.y = pack2(y2, y3);
      *(uint2*)(h + (size_t)r * D + c) = o;
    }
  }
}

DI bool gemm_decode(int t, int mtiles, int ntiles, int mt_off, bool skip_ctx, int& mt, int& nt) {
  const int mtx = mtiles >> 3;
  const int xcd = t & 7, q = t >> 3;
  const int sr = q / (8 * ntiles);
  const int rem = q - sr * 8 * ntiles;
  const int rows_in = min(8, mtx - sr * 8);
  const int sc = rem / (rows_in * 8);
  const int r2 = rem - sc * rows_in * 8;
  const int i = r2 % rows_in, j = r2 / rows_in;
  mt = (sr * 8 + i) * 8 + xcd;
  nt = sc * 8 + j;
  return !(skip_ctx && ((mt + mt_off) % 34) < 2);
}
template <bool PAIRED, class Epi>
DI void gemm_phase(const u16* __restrict__ A, int lda, const u16* __restrict__ Bt, int ldb, int K, int mtiles, int ntiles,
                   int mt_off, bool skip_ctx, char* smem, Epi& epi) {
  u16* As = (u16*)smem;
  u16* Bs = As + 2 * 128 * 72;
  const int tid = ltid(), lane = tid & 63, wave = tid >> 6;
  const int wm = wave >> 1, wn = wave & 1, lr = lane & 31, lh = lane >> 5;
  const int lrow = tid >> 3, lkc = (tid & 7) * 8;
  const int total = mtiles * ntiles, nk = K >> 6;
  uint4 ra00, ra01, ra02, ra03, rb00, rb01, rb02, rb03, ra10, ra11, ra12, ra13, rb10, rb11, rb12, rb13;
  const u16* Agl;
  const u16* Bgl;
#define GEMM_GLOAD(S, kt_)                                            \
  {                                                                   \
    const int k0_ = (kt_) << 6;                                       \
    ra##S##0 = *(const uint4*)(Agl + k0_);                            \
    ra##S##1 = *(const uint4*)(Agl + (size_t)32 * lda + k0_);         \
    ra##S##2 = *(const uint4*)(Agl + (size_t)64 * lda + k0_);         \
    ra##S##3 = *(const uint4*)(Agl + (size_t)96 * lda + k0_);         \
    rb##S##0 = *(const uint4*)(Bgl + k0_);                            \
    rb##S##1 = *(const uint4*)(Bgl + (size_t)32 * ldb + k0_);         \
    rb##S##2 = *(const uint4*)(Bgl + (size_t)64 * ldb + k0_);         \
    rb##S##3 = *(const uint4*)(Bgl + (size_t)96 * ldb + k0_);         \
  }
#define GEMM_LSTORE(S, buf_)                                          \
  {                                                                   \
    u16* ad_ = As + (buf_) * 128 * 72 + lrow * 72 + lkc;              \
    u16* bd_ = Bs + (buf_) * 128 * 72 + lrow * 72 + lkc;              \
    *(uint4*)(ad_) = ra##S##0;                                        \
    *(uint4*)(ad_ + 32 * 72) = ra##S##1;                              \
    *(uint4*)(ad_ + 64 * 72) = ra##S##2;                              \
    *(uint4*)(ad_ + 96 * 72) = ra##S##3;                              \
    *(uint4*)(bd_) = rb##S##0;                                        \
    *(uint4*)(bd_ + 32 * 72) = rb##S##1;                              \
    *(uint4*)(bd_ + 64 * 72) = rb##S##2;                              \
    *(uint4*)(bd_ + 96 * 72) = rb##S##3;                              \
  }
#define GEMM_COMPUTE(buf_)                                                        \
  {                                                                               \
    const u16* as = As + (buf_) * 128 * 72 + (wm * 64 + lr) * 72 + lh * 8;        \
    const u16* bs = Bs + (buf_) * 128 * 72 + (wn * 64 + lr) * 72 + lh * 8;        \
    _Pragma("unroll") for (int ks = 0; ks < 4; ++ks) {                            \
      bf16x8 a0 = *(const bf16x8*)(as + ks * 16);                                 \
      bf16x8 a1 = *(const bf16x8*)(as + 32 * 72 + ks * 16);                       \
      bf16x8 b0 = *(const bf16x8*)(bs + ks * 16);                                 \
      bf16x8 b1 = *(const bf16x8*)(bs + 32 * 72 + ks * 16);                       \
      acc[0][0] = MFMA32(a0, b0, acc[0][0]);                                      \
      acc[0][1] = MFMA32(a0, b1, acc[0][1]);                                      \
      acc[1][0] = MFMA32(a1, b0, acc[1][0]);                                      \
      acc[1][1] = MFMA32(a1, b1, acc[1][1]);                                      \
    }                                                                             \
  }
  int t = blockIdx.x, mt = 0, nt = 0;
  while (t < total && !gemm_decode(t, mtiles, ntiles, mt_off, skip_ctx, mt, nt)) t += gridDim.x;
  if (t < total) {
    Agl = A + (size_t)(mt * 128 + lrow) * lda + lkc;
    Bgl = Bt + (size_t)(nt * 128 + lrow) * ldb + lkc;
    GEMM_GLOAD(0, 0);
  }
  while (t < total) {
    const int m0 = mt * 128, n0 = nt * 128;
    int tn = t + gridDim.x, mtn = 0, ntn = 0;
    while (tn < total && !gemm_decode(tn, mtiles, ntiles, mt_off, skip_ctx, mtn, ntn)) tn += gridDim.x;
    f32x16 acc[2][2];
#pragma unroll
    for (int a = 0; a < 2; ++a)
#pragma unroll
      for (int b = 0; b < 2; ++b)
#pragma unroll
        for (int i = 0; i < 16; ++i) acc[a][b][i] = 0.f;
    GEMM_LSTORE(0, 0);
    __syncthreads();
    if (nk > 1) GEMM_GLOAD(0, 1);
    for (int kt = 0; kt < nk; kt += 2) {
      if (kt + 2 < nk) GEMM_GLOAD(1, kt + 2);
      GEMM_COMPUTE(0);
      if (kt + 1 < nk) GEMM_LSTORE(0, 1);
      __syncthreads();
      if (kt + 1 >= nk) break;
      if (kt + 3 < nk) GEMM_GLOAD(0, kt + 3);
      GEMM_COMPUTE(1);
      if (kt + 2 < nk) GEMM_LSTORE(1, 0);
      __syncthreads();
    }
    if (tn < total) {
      Agl = A + (size_t)(mtn * 128 + lrow) * lda + lkc;
      Bgl = Bt + (size_t)(ntn * 128 + lrow) * ldb + lkc;
      GEMM_GLOAD(0, 0);
    }
    epi.tile(m0);
    if constexpr (PAIRED) {
      float* stg = (float*)smem + wave * 64 * 36;
#pragma unroll
      for (int mi = 0; mi < 2; ++mi)
#pragma unroll
        for (int i = 0; i < 16; ++i) stg[(mi * 32 + crow(i, lh)) * 36 + lr] = epi.combine(acc[mi][0][i], acc[mi][1][i]);
      __syncthreads();
#pragma unroll
      for (int k = 0; k < 8; ++k) {
        const int idx = lane + 64 * k, row = idx >> 3, c4 = idx & 7;
        const float4 v = *(const float4*)(stg + row * 36 + c4 * 4);
        epi.store4(m0 + wm * 64 + row, (n0 >> 1) + wn * 32 + c4 * 4, v);
      }
      __syncthreads();
    } else if constexpr (Epi::kStaged) {
      float* stg = (float*)smem + wave * 64 * 68;
#pragma unroll
      for (int mi = 0; mi < 2; ++mi)
#pragma unroll
        for (int ni = 0; ni < 2; ++ni)
#pragma unroll
          for (int i = 0; i < 16; ++i) stg[(mi * 32 + crow(i, lh)) * 68 + ni * 32 + lr] = acc[mi][ni][i];
      __syncthreads();
#pragma unroll 4
      for (int k = 0; k < 16; ++k) {
        const int idx = lane + 64 * k, row = idx >> 4, c4 = idx & 15;
        const float4 v = *(const float4*)(stg + row * 68 + c4 * 4);
        epi.row4(m0 + wm * 64 + row, n0 + wn * 64 + c4 * 4, v);
      }
      __syncthreads();
    } else {
#pragma unroll
      for (int mi = 0; mi < 2; ++mi) {
#pragma unroll
        for (int gq = 0; gq < 4; ++gq) {
          const int row0 = m0 + wm * 64 + mi * 32 + 8 * gq + 4 * lh;
          if (PAIRED) {
            const int col = (n0 >> 1) + wn * 32 + lr;
#pragma unroll
            for (int e = 0; e < 4; ++e) epi.pair(row0 + e, col, acc[mi][0][4 * gq + e], acc[mi][1][4 * gq + e]);
          } else {
            epi.quad(row0, n0 + wn * 64 + lr, acc[mi][0][4 * gq], acc[mi][0][4 * gq + 1], acc[mi][0][4 * gq + 2], acc[mi][0][4 * gq + 3]);
            epi.quad(row0, n0 + wn * 64 + 32 + lr, acc[mi][1][4 * gq], acc[mi][1][4 * gq + 1], acc[mi][1][4 * gq + 2], acc[mi][1][4 * gq + 3]);
          }
        }
      }
    }
    t = tn; mt = mtn; nt = ntn;
  }
}

#define EPI_DEFAULT_QUAD                                                   \
  static constexpr bool kStaged = false;                                   \
  DI void row4(int, int, float4) const {}                                  \
  DI void tile(int) {}                                                     \
  DI void quad(int row0, int col, float a, float b, float c, float d) const { \
    (*this)(row0, col, a);                                                 \
    (*this)(row0 + 1, col, b);                                             \
    (*this)(row0 + 2, col, c);                                             \
    (*this)(row0 + 3, col, d);                                             \
  }
struct EpiGU {
  u16* G;
  DI float combine(float g, float u) const { return g * __builtin_amdgcn_rcpf(1.f + __expf(-g)) * u; }
  DI void store4(int row, int col, float4 v) const {
    uint2 w;
    w.x = pack2(v.x, v.y);
    w.y = pack2(v.z, v.w);
    *(uint2*)(G + (size_t)row * DFF + col) = w;
  }
  DI void pair(int row, int col, float g, float u) const {
    float s = g / (1.f + __expf(-g));
    G[(size_t)row * DFF + col] = f2bf(s * u);
  }
  DI void operator()(int, int, float) const {}
  EPI_DEFAULT_QUAD
};
struct EpiRes {
  const float* lat_in; const float* ctx_in; float* lat_out; float* ctx_out; const float* modl; int gate_chunk; float coef;
  const float* tin; float* tout; const float* gate; int tm0;
  static constexpr bool kStaged = true;
  DI void row4(int row, int col, float4 v) const {
    const size_t o = ((size_t)(row - tm0) << 10) + col;
    const float4 x = *(const float4*)(tin + o);
    const float4 g = *(const float4*)(gate + col);
    float4 y;
    y.x = x.x + coef * g.x * v.x;
    y.y = x.y + coef * g.y * v.y;
    y.z = x.z + coef * g.z * v.z;
    y.w = x.w + coef * g.w * v.w;
    *(float4*)(tout + o) = y;
  }
  DI void tile(int m0) {
    const int b = m0 / LT, j = m0 - b * LT;
    const bool isc = j < LC;
    const size_t off = isc ? (((size_t)(b * LC + j)) << 10) : (((size_t)(b * LQ + j - LC)) << 10);
    tin = (isc ? ctx_in : lat_in) + off;
    tout = (isc ? ctx_out : lat_out) + off;
    gate = modl + (isc ? 8 : b) * 9216 + gate_chunk * 1024;
    tm0 = m0;
  }
  DI void operator()(int row, int col, float v) const {
    const size_t o = ((size_t)(row - tm0) << 10) + col;
    tout[o] = tin[o] + coef * gate[col] * v;
  }
  DI void pair(int, int, float, float) const {}
  DI void quad(int row0, int col, float a, float b, float c, float d) const {
    const float gc = coef * gate[col];
    const size_t o = ((size_t)(row0 - tm0) << 10) + col;
    tout[o] = tin[o] + gc * a;
    tout[o + 1024] = tin[o + 1024] + gc * b;
    tout[o + 2048] = tin[o + 2048] + gc * c;
    tout[o + 3072] = tin[o + 3072] + gc * d;
  }
};
struct EpiStore {
  u16* C; int ldc; int N;
  DI void operator()(int row, int col, float v) const { if (col < N) C[(size_t)row * ldc + col] = f2bf(v); }
  DI void pair(int, int, float, float) const {}
  EPI_DEFAULT_QUAD
};
struct EpiWin {
  u16* p; u16* pT;
  static constexpr bool kStaged = false;
  DI void row4(int, int, float4) const {}
  DI void tile(int) {}
  DI void quad(int row0, int col, float a, float b, float c, float d) const {
    if (col < HYC) {
      uint2 w;
      w.x = pack2(a, b);
      w.y = pack2(c, d);
      *(uint2*)(pT + (size_t)col * TG + row0) = w;
    } else if (col < DIN) {
      u16* q = p + (size_t)row0 * DINP + (col - HYC);
      q[0] = f2bf(a);
      q[DINP] = f2bf(b);
      q[2 * DINP] = f2bf(c);
      q[3 * DINP] = f2bf(d);
    }
  }
  DI void pair(int, int, float, float) const {}
};
struct EpiLoraW {
  u16* C; const float* w0;
  DI void operator()(int row, int col, float v) const {
    float zz = -(w0[col] + v);
    float sp = fmaxf(zz, 0.f) + log1pf(expf(-fabsf(zz)));
    C[(size_t)row * 256 + col] = f2bf(-expm1f(-expf(-sp - 0.5f)));
  }
  DI void pair(int, int, float, float) const {}
  EPI_DEFAULT_QUAD
};
struct EpiLoraA {
  u16* C; const float* a0;
  DI void operator()(int row, int col, float v) const { C[(size_t)row * 256 + col] = f2bf(sigmoidf_(a0[col] + v)); }
  DI void pair(int, int, float, float) const {}
  EPI_DEFAULT_QUAD
};

struct MixBufs {
  u16 *p, *pt, *u, *qg, *kg, *vtg, *cqn, *ckvn, *qup, *kvup, *qm, *km, *vtm, *rr, *rk, *rv, *rkk, *lwf, *lwb, *laf, *lab, *lg, *ef, *eb, *af, *ab, *gg;
  float *yf, *yb;
};
DI MixBufs mixbufs(char* big, int g) {
  MixBufs m;
  m.p = (u16*)(big + M_P); m.pt = (u16*)(big + M_PT); m.u = (u16*)(big + M_U); m.qg = (u16*)(big + M_QG); m.kg = (u16*)(big + M_KG);
  m.vtg = (u16*)(big + M_VTG); m.cqn = (u16*)(big + M_CQN); m.ckvn = (u16*)(big + M_CKVN); m.qup = (u16*)(big + M_QUP);
  m.kvup = (u16*)(big + M_KVUP); m.qm = (u16*)(big + M_QM); m.km = (u16*)(big + M_KM); m.vtm = (u16*)(big + M_VTM);
  m.lwf = (u16*)(big + M_LWF); m.lwb = (u16*)(big + M_LWB); m.laf = (u16*)(big + M_LAF); m.lab = (u16*)(big + M_LAB);
  m.lg = (u16*)(big + M_LG);
  char* sc = big + M_SCAN + (size_t)g * SCAN_STRIDE;
  m.rr = (u16*)(sc + 0 * SZ_SC); m.rk = (u16*)(sc + 1 * SZ_SC); m.rv = (u16*)(sc + 2 * SZ_SC); m.rkk = (u16*)(sc + 3 * SZ_SC);
  m.ef = (u16*)(sc + 4 * SZ_SC); m.eb = (u16*)(sc + 5 * SZ_SC); m.af = (u16*)(sc + 6 * SZ_SC); m.ab = (u16*)(sc + 7 * SZ_SC);
  m.gg = (u16*)(sc + 8 * SZ_SC);
  m.yf = (float*)(big + M_P) + (size_t)g * 2 * TG * 256;
  m.yb = m.yf + (size_t)TG * 256;
  return m;
}

DI void prep_phase(const Params& p, int l, int g, const MixBufs& m, const float2* __restrict__ ropeg, char* smem) {
  const int tid = ltid(), lane = tid & 63, wave = tid >> 6;
  const float* mu = p.rw_mu + l * 1152;
  for (int rl = blockIdx.x * 4 + wave; rl < TG; rl += gridDim.x * 4) {
    const int r = g * TG + rl;
    const int b = r / LT, j = r - b * LT, bl = b - g * BG;
    const bool lat = j >= LC;
    const bool hp = lat ? (j > LC) : (j > 0);
    const bool hn = lat ? (j < LT - 1) : (j < LC - 1);
    const u16* pc = m.p + (size_t)rl * DINP;
    const u16* pp = pc - DINP;
    const u16* pn = pc + DINP;
    auto tshift = [&](int crel) -> float {
      const int c = 1696 - HYC + crel;
      float u0 = bf2f(pc[c]);
      float nb = 0.f;
      if (hp) nb += bf2f(pp[c]);
      if (hn) nb += bf2f(pn[c]);
      return u0 + mu[crel] * (0.5f * nb - u0);
    };
#pragma unroll
    for (int hd = 0; hd < 4; ++hd) {
      const int c = hd * 64 + lane;
      const float sr = tshift(c), sk = tshift(256 + c), sv = tshift(512 + c);
      m.rr[(size_t)rl * 256 + c] = f2bf(sr);
      m.rk[(size_t)rl * 256 + c] = f2bf(sk);
      m.rv[(size_t)rl * 256 + c] = f2bf(sv);
      const float kx = sk * p.rw_k_k[l * 256 + c];
      const float ss = wave_sum(kx * kx);
      m.rkk[(size_t)rl * 256 + c] = f2bf(kx / fmaxf(sqrtf(ss), 1e-12f));
    }
    {
      const float s0 = tshift(768 + lane), s1 = tshift(832 + lane), s2 = tshift(896 + lane), s3 = tshift(960 + lane);
      const float s4 = tshift(1024 + lane), s5 = tshift(1088 + lane);
      m.lwf[(size_t)rl * 64 + lane] = f2bf(tanhf(s0));
      m.lwb[(size_t)rl * 64 + lane] = f2bf(tanhf(s1));
      m.laf[(size_t)rl * 64 + lane] = f2bf(s2);
      m.lab[(size_t)rl * 64 + lane] = f2bf(s3);
      m.lg[(size_t)rl * 128 + lane] = f2bf(sigmoidf_(s4));
      m.lg[(size_t)rl * 128 + 64 + lane] = f2bf(sigmoidf_(s5));
    }
    {
      float cq[4], ckv[2];
      float s1 = 0.f, s2 = 0.f;
#pragma unroll
      for (int q = 0; q < 4; ++q) { cq[q] = bf2f(pc[1280 - HYC + lane + 64 * q]); s1 += cq[q] * cq[q]; }
#pragma unroll
      for (int q = 0; q < 2; ++q) { ckv[q] = bf2f(pc[1536 - HYC + lane + 64 * q]); s2 += ckv[q] * ckv[q]; }
      s1 = wave_sum(s1);
      s2 = wave_sum(s2);
      const float r1 = rsqrtf(s1 * (1.f / 256.f) + EPS), r2 = rsqrtf(s2 * (1.f / 128.f) + EPS);
#pragma unroll
      for (int q = 0; q < 4; ++q) m.cqn[(size_t)rl * 256 + lane + 64 * q] = f2bf(cq[q] * r1 * p.mla_cq_norm[l * 256 + lane + 64 * q]);
#pragma unroll
      for (int q = 0; q < 2; ++q) m.ckvn[(size_t)rl * 128 + lane + 64 * q] = f2bf(ckv[q] * r2 * p.mla_ckv_norm[l * 128 + lane + 64 * q]);
    }
    const float2* rt = ropeg + (size_t)(lat ? j - LC : 0) * 32;
    const float gq_ = p.gqa_q_norm[l * 64 + lane], gk_ = p.gqa_k_norm[l * 64 + lane];
#pragma unroll
    for (int hh = 0; hh < 6; ++hh) {
      float val = bf2f(pc[hh * 64 + lane]);
      const float ss = wave_sum(val * val);
      val = val * rsqrtf(ss * (1.f / 64.f) + EPS) * (hh < 4 ? gq_ : gk_);
      const float rv = rope_tab(val, lane, rt, lane);
      if (lat) val = rv;
      if (hh < 4) m.qg[(size_t)rl * 256 + hh * 64 + lane] = f2bf(val);
      else m.kg[(size_t)rl * 128 + (hh - 4) * 64 + lane] = f2bf(val);
    }
#pragma unroll
    for (int kvh = 0; kvh < 2; ++kvh) m.vtg[((size_t)(bl * 2 + kvh) * 64 + lane) * LT + j] = pc[1152 - HYC + kvh * 64 + lane];
  }
}

DI void mla_fin_phase(const Params& p, int l, int g, const MixBufs& m, const float2* __restrict__ ropem) {
  const int tid = ltid(), lane = tid & 63, wave = tid >> 6;
  for (int rl = blockIdx.x; rl < TG; rl += gridDim.x) {
    const int r = g * TG + rl;
    const int b = r / LT, j = r - b * LT, bl = b - g * BG;
    const bool lat = j >= LC;
    for (int s = wave; s < 8; s += 4) {
      const int hd = s & 3;
      const bool isq = s < 4;
      float x0, x1;
      if (isq) {
        x0 = bf2f(m.qup[(size_t)rl * 384 + hd * 96 + lane]);
        x1 = lane < 32 ? bf2f(m.qup[(size_t)rl * 384 + hd * 96 + 64 + lane]) : 0.f;
      } else {
        x0 = bf2f(m.kvup[(size_t)rl * 512 + hd * 128 + lane]);
        x1 = lane < 32 ? bf2f(m.p[(size_t)rl * DINP + 1664 - HYC + lane]) : 0.f;
      }
      float ss = wave_sum(x0 * x0 + x1 * x1);
      const float rstd = rsqrtf(ss * (1.f / 96.f) + EPS);
      const float* gn = isq ? p.mla_q_norm + l * 96 : p.mla_k_norm + l * 96;
      float y0 = x0 * rstd * gn[lane];
      float y1 = lane < 32 ? x1 * rstd * gn[64 + lane] : 0.f;
      float ry = rope_tab(y1, lane & 31, ropem + (size_t)(lat ? j - LC : 0) * 16, lane);
      if (lat) y1 = ry;
      u16* dst = (isq ? m.qm : m.km) + (size_t)rl * 384 + hd * 96;
      dst[lane] = f2bf(y0);
      if (lane < 32) dst[64 + lane] = f2bf(y1);
      if (!isq) m.vtm[((size_t)(bl * 4 + hd) * 64 + lane) * LT + j] = m.kvup[(size_t)rl * 512 + hd * 128 + 64 + lane];
    }
  }
}

template <int DQK, int QT>
DI void attn_item(const u16* __restrict__ q, int ldq, const u16* __restrict__ k, int ldk, const u16* __restrict__ vT,
                  u16* __restrict__ out, int ldo, int nkeys, float sl2, float sh2, char* smem) {
  constexpr int KS = DQK + 8;
  constexpr int NKS = DQK / 16;
  constexpr int KCH = DQK / 8;
  constexpr int KPT = 64 * KCH / NTHR;
  u16* Ks = (u16*)smem;
  u16* Vs = Ks + 2 * 64 * KS;
  const int tid = ltid(), lane = tid & 63, wave = tid >> 6, lr = lane & 31, lh = lane >> 5;
  bf16x8 qf[QT][NKS];
#pragma unroll
  for (int qt = 0; qt < QT; ++qt)
#pragma unroll
    for (int ks = 0; ks < NKS; ++ks)
      qf[qt][ks] = *(const bf16x8*)(q + (size_t)(wave * 32 * QT + qt * 32 + lr) * ldq + ks * 16 + lh * 8);
  f32x16 o[QT][2];
#pragma unroll
  for (int a = 0; a < QT; ++a)
#pragma unroll
    for (int b = 0; b < 2; ++b)
#pragma unroll
      for (int i = 0; i < 16; ++i) o[a][b][i] = 0.f;
  float lsum[QT];
#pragma unroll
  for (int a = 0; a < QT; ++a) lsum[a] = 0.f;
  uint4 rk[KPT], rv[2];
#define ATT_GLOAD(key0)                                                                   \
  {                                                                                       \
    _Pragma("unroll") for (int i = 0; i < KPT; ++i) {                                     \
      const int id = tid + NTHR * i, row = id / KCH, ch = id - row * KCH;                 \
      rk[i] = *(const uint4*)(k + (size_t)((key0) + row) * ldk + ch * 8);                 \
    }                                                                                     \
    _Pragma("unroll") for (int i = 0; i < 2; ++i) {                                       \
      const int id = tid + NTHR * i, row = id >> 3, ch = id & 7;                          \
      rv[i] = *(const uint4*)(vT + (size_t)row * LT + (key0) + ch * 8);                   \
    }                                                                                     \
  }
#define ATT_LSTORE(buf_)                                                                  \
  {                                                                                       \
    _Pragma("unroll") for (int i = 0; i < KPT; ++i) {                                     \
      const int id = tid + NTHR * i, row = id / KCH, ch = id - row * KCH;                 \
      *(uint4*)(Ks + (buf_) * 64 * KS + row * KS + ch * 8) = rk[i];                       \
    }                                                                                     \
    _Pragma("unroll") for (int i = 0; i < 2; ++i) {                                       \
      const int id = tid + NTHR * i, row = id >> 3, ch = id & 7;                          \
      *(uint4*)(Vs + (buf_) * 64 * 72 + row * 72 + ch * 8) = rv[i];                       \
    }                                                                                     \
  }
  ATT_GLOAD(0);
  ATT_LSTORE(0);
  __syncthreads();
  const int nkt = nkeys >> 6;
  for (int kt = 0; kt < nkt; ++kt) {
    const int buf = kt & 1;
    if (kt + 1 < nkt) ATT_GLOAD((kt + 1) << 6);
    const u16* kb = Ks + buf * 64 * KS;
    const u16* vb = Vs + buf * 64 * 72;
#pragma unroll
    for (int half = 0; half < 2; ++half) {
      f32x16 s[QT];
#pragma unroll
      for (int qt = 0; qt < QT; ++qt)
#pragma unroll
        for (int i = 0; i < 16; ++i) s[qt][i] = 0.f;
      bf16x8 kf[NKS];
#pragma unroll
      for (int ks = 0; ks < NKS; ++ks) kf[ks] = *(const bf16x8*)(kb + (half * 32 + lr) * KS + ks * 16 + lh * 8);
#pragma unroll
      for (int ks = 0; ks < NKS; ++ks) {
#pragma unroll
        for (int qt = 0; qt < QT; ++qt) s[qt] = MFMA32(kf[ks], qf[qt][ks], s[qt]);
      }
#pragma unroll
      for (int qt = 0; qt < QT; ++qt)
#pragma unroll
        for (int i = 0; i < 16; ++i) {
          float pv = __builtin_amdgcn_exp2f(s[qt][i] * sl2 - sh2);
          lsum[qt] += pv;
          s[qt][i] = pv;
        }
#pragma unroll
      for (int st = 0; st < 2; ++st) {
        bf16x8 pb[QT];
#pragma unroll
        for (int qt = 0; qt < QT; ++qt) {
          uint4 w;
          w.x = pack2(s[qt][8 * st + 0], s[qt][8 * st + 1]);
          w.y = pack2(s[qt][8 * st + 2], s[qt][8 * st + 3]);
          w.z = pack2(s[qt][8 * st + 4], s[qt][8 * st + 5]);
          w.w = pack2(s[qt][8 * st + 6], s[qt][8 * st + 7]);
          pb[qt] = __builtin_bit_cast(bf16x8, w);
        }
#pragma unroll
        for (int mt = 0; mt < 2; ++mt) {
          const u16* vp = vb + (mt * 32 + lr) * 72 + half * 32 + st * 16 + lh * 4;
          uint2 v0 = *(const uint2*)(vp);
          uint2 v1 = *(const uint2*)(vp + 8);
          uint4 w;
          w.x = v0.x; w.y = v0.y; w.z = v1.x; w.w = v1.y;
          bf16x8 vf = __builtin_bit_cast(bf16x8, w);
#pragma unroll
          for (int qt = 0; qt < QT; ++qt) o[qt][mt] = MFMA32(vf, pb[qt], o[qt][mt]);
        }
      }
    }
    if (kt + 1 < nkt) ATT_LSTORE(buf ^ 1);
    __syncthreads();
  }
#pragma unroll
  for (int qt = 0; qt < QT; ++qt) {
    float tot = lsum[qt] + __shfl_xor(lsum[qt], 32);
    float inv = 1.f / tot;
    const int row = wave * 32 * QT + qt * 32 + lr;
#pragma unroll
    for (int mt = 0; mt < 2; ++mt)
#pragma unroll
      for (int gq = 0; gq < 4; ++gq) {
        uint2 w;
        w.x = pack2(o[qt][mt][4 * gq + 0] * inv, o[qt][mt][4 * gq + 1] * inv);
        w.y = pack2(o[qt][mt][4 * gq + 2] * inv, o[qt][mt][4 * gq + 3] * inv);
        *(uint2*)(out + (size_t)row * ldo + mt * 32 + 8 * gq + 4 * lh) = w;
      }
  }
}

DI void hyena_pass(const Params& p, int l, const MixBufs& m, const float* __restrict__ gT, int L, int segoff, int c, char* smem) {
  const int RS = L + 16, US = L + 16;
  unsigned* Rc = (unsigned*)smem;
  u16* U = (u16*)(smem + (size_t)2 * RS * 4);
  const int tid = ltid(), lane = tid & 63, wave = tid >> 6;
  for (int d = tid; d < L; d += NTHR) {
    const int q = 2 * d;
    const float r0 = gT[(size_t)(2 * L - 2 - q) * 256 + c];
    const float r1 = (q + 1 <= 2 * L - 2) ? gT[(size_t)(2 * L - 3 - q) * 256 + c] : 0.f;
    const float r2 = (q + 2 <= 2 * L - 2) ? gT[(size_t)(2 * L - 4 - q) * 256 + c] : 0.f;
    Rc[d] = pack2(r0, r1);
    Rc[RS + d] = pack2(r1, r2);
  }
  const float* cw = p.hy_conv_w + l * 3 * 768;
  const float* cb = p.hy_conv_b + l * 768;
  {
    const float w0a = cw[c], w1a = cw[768 + c], w2a = cw[1536 + c], ba = cb[c];
    const float w0v = cw[512 + c], w1v = cw[768 + 512 + c], w2v = cw[1536 + 512 + c], bv = cb[512 + c];
    for (int b = 0; b < BG; ++b) {
      const u16* x1p = m.pt + (size_t)c * TG + b * LT + segoff;
      const u16* vp = m.pt + (size_t)(512 + c) * TG + b * LT + segoff;
      for (int t = tid; t < L; t += NTHR) {
        float x1 = bf2f(x1p[t]) * w1a + ba;
        float vv = bf2f(vp[t]) * w1v + bv;
        if (t > 0) { x1 += bf2f(x1p[t - 1]) * w0a; vv += bf2f(vp[t - 1]) * w0v; }
        if (t < L - 1) { x1 += bf2f(x1p[t + 1]) * w2a; vv += bf2f(vp[t + 1]) * w2v; }
        U[b * US + t] = f2bf(x1 * vv);
      }
    }
  }
  __syncthreads();
  const int i = lane & 31, h = lane >> 5, bn = i & 3, mb = i >> 2;
  const int par = (L - 1 - i) & 1;
  const float bias = p.hy_bias[l * 256 + c];
  const float w0x = cw[256 + c], w1x = cw[768 + 256 + c], w2x = cw[1536 + 256 + c], bx = cb[256 + c];
  const int nsteps = (L + 208) / 16 + 1;
  for (int sp = wave; sp < L / 256; sp += 4) {
    const int T0 = sp * 256;
    f32x16 acc;
#pragma unroll
    for (int r = 0; r < 16; ++r) acc[r] = 0.f;
    const int delta0 = T0 + 224;
    const int q0 = (L - 1) - delta0 - i + 8 * h;
    const unsigned* ap = Rc + par * RS + (q0 >> 1);
    int s0 = T0 + 32 * mb - delta0;
    const u16* bp = U + bn * US + s0 + 8 * h;
#pragma unroll 2
    for (int st = 0; st < nsteps; ++st) {
      uint4 aw;
      aw.x = ap[0]; aw.y = ap[1]; aw.z = ap[2]; aw.w = ap[3];
      uint4 bw = make_uint4(0u, 0u, 0u, 0u);
      if (s0 >= 0 && s0 <= L - 16) bw = *(const uint4*)bp;
      acc = MFMA32(__builtin_bit_cast(bf16x8, aw), __builtin_bit_cast(bf16x8, bw), acc);
      ap += 8;
      s0 += 16;
      bp += 16;
    }
    const u16* x2p = m.pt + (size_t)(256 + c) * TG + bn * LT + segoff;
    u16* yp = m.u + (size_t)c * TG + bn * LT + segoff;
#pragma unroll
    for (int gq = 0; gq < 4; ++gq) {
      const int t4 = T0 + 32 * mb + 8 * gq + 4 * h;
      float e[6];
#pragma unroll
      for (int k = 0; k < 6; ++k) {
        const int tt = t4 - 1 + k;
        e[k] = (tt >= 0 && tt < L) ? bf2f(x2p[tt]) : 0.f;
      }
      const uint2 uu = *(const uint2*)(U + bn * US + t4);
      const float u0 = bflo_(uu.x), u1 = bfhi_(uu.x), u2 = bflo_(uu.y), u3 = bfhi_(uu.y);
      const float y0 = (e[0] * w0x + e[1] * w1x + e[2] * w2x + bx) * (acc[4 * gq + 0] + u0 * bias);
      const float y1 = (e[1] * w0x + e[2] * w1x + e[3] * w2x + bx) * (acc[4 * gq + 1] + u1 * bias);
      const float y2 = (e[2] * w0x + e[3] * w1x + e[4] * w2x + bx) * (acc[4 * gq + 2] + u2 * bias);
      const float y3 = (e[3] * w0x + e[4] * w1x + e[5] * w2x + bx) * (acc[4 * gq + 3] + u3 * bias);
      uint2 w;
      w.x = pack2(y0, y1);
      w.y = pack2(y2, y3);
      *(uint2*)(yp + t4) = w;
    }
  }
  __syncthreads();
}

#define DPP_ROR(v, n) __builtin_bit_cast(float, __builtin_amdgcn_update_dpp(0, __builtin_bit_cast(int, (v)), 0x120 + (n), 0xf, 0xf, true))
DI float row_allsum(float v) {
  v += DPP_ROR(v, 8);
  v += DPP_ROR(v, 4);
  v += DPP_ROR(v, 2);
  v += DPP_ROR(v, 1);
  return v;
}
DI float bflo(unsigned w) { return __uint_as_float(w << 16); }
DI float bfhi(unsigned w) { return __uint_as_float(w & 0xffff0000u); }
DI void scan_item(const Params& p, int l, const MixBufs& m, int bl, int hd, int dir, int rq, char* smem) {
  constexpr int TC = 16;
  constexpr int NCH = LT / TC;
  constexpr int BUF = 5 * TC * 64 + TC * 16;
  float* sbase = (float*)smem;
  float* sy = sbase + 2 * BUF;
  const int tid = ltid(), lane = tid & 63, wave = tid >> 6;
  const int kq = lane & 15, rloc = wave * 4 + (lane >> 4);
  const u16* eD = dir ? m.eb : m.ef;
  const u16* aD = dir ? m.ab : m.af;
  float* yD = dir ? m.yb : m.yf;
  const size_t rbase = (size_t)bl * LT;
  const int ss = tid >> 4, su = tid & 15, sc = su & 7;
  float kav[8];
#pragma unroll
  for (int i = 0; i < 8; ++i) kav[i] = p.rw_k_a[l * 256 + hd * 64 + sc * 8 + i];
  uint4 g0, g1, g2;
  g2.x = g2.y = g2.z = g2.w = 0u;
#define SCAN_JMAP(i) (dir ? ((i) < LC ? LC - 1 - (i) : LT - 1 - ((i) - LC)) : (i))
#define SCAN_GLOAD(i0)                                                                         \
  {                                                                                            \
    const int ii_ = (i0) + ss;                                                                 \
    const int j_ = SCAN_JMAP(ii_);                                                             \
    const size_t o_ = (rbase + j_) * 256 + hd * 64 + sc * 8;                                   \
    if (su < 8) {                                                                              \
      g0 = *(const uint4*)(m.rkk + o_);                                                        \
      g1 = *(const uint4*)(aD + o_);                                                           \
      g2 = *(const uint4*)(m.rk + o_);                                                         \
    } else {                                                                                   \
      g0 = *(const uint4*)(eD + o_);                                                           \
      g1 = *(const uint4*)(m.rr + o_);                                                         \
      if (sc < 2) g2 = *(const uint4*)(m.rv + (rbase + j_) * 256 + hd * 64 + rq * 16 + sc * 8); \
    }                                                                                          \
  }
#define SCAN_LSTORE(buf_)                                                                      \
  {                                                                                            \
    float* B_ = sbase + (buf_) * BUF;                                                          \
    const unsigned w0_[4] = {g0.x, g0.y, g0.z, g0.w};                                          \
    const unsigned w1_[4] = {g1.x, g1.y, g1.z, g1.w};                                          \
    const unsigned w2_[4] = {g2.x, g2.y, g2.z, g2.w};                                          \
    if (su < 8) {                                                                              \
      float kk_[8], bb_[8], dd_[8];                                                            \
      _Pragma("unroll") for (int q_ = 0; q_ < 4; ++q_) {                                       \
        const float k0_ = bflo(w0_[q_]), k1_ = bfhi(w0_[q_]);                                  \
        const float a0_ = bflo(w1_[q_]), a1_ = bfhi(w1_[q_]);                                  \
        const float v0_ = bflo(w2_[q_]), v1_ = bfhi(w2_[q_]);                                  \
        kk_[2 * q_] = k0_; kk_[2 * q_ + 1] = k1_;                                              \
        bb_[2 * q_] = k0_ * a0_; bb_[2 * q_ + 1] = k1_ * a1_;                                  \
        dd_[2 * q_] = v0_ * (1.f + (a0_ - 1.f) * kav[2 * q_]);                                 \
        dd_[2 * q_ + 1] = v1_ * (1.f + (a1_ - 1.f) * kav[2 * q_ + 1]);                         \
      }                                                                                        \
      float* d0_ = B_ + ss * 64 + sc * 8;                                                      \
      *(float4*)(d0_) = make_float4(kk_[0], kk_[1], kk_[2], kk_[3]);                           \
      *(float4*)(d0_ + 4) = make_float4(kk_[4], kk_[5], kk_[6], kk_[7]);                       \
      *(float4*)(d0_ + 2048) = make_float4(bb_[0], bb_[1], bb_[2], bb_[3]);                    \
      *(float4*)(d0_ + 2052) = make_float4(bb_[4], bb_[5], bb_[6], bb_[7]);                    \
      *(float4*)(d0_ + 3072) = make_float4(dd_[0], dd_[1], dd_[2], dd_[3]);                    \
      *(float4*)(d0_ + 3076) = make_float4(dd_[4], dd_[5], dd_[6], dd_[7]);                    \
    } else {                                                                                   \
      float ww_[8], rr_[8], vv_[8];                                                            \
      _Pragma("unroll") for (int q_ = 0; q_ < 4; ++q_) {                                       \
        ww_[2 * q_] = 1.f - bflo(w0_[q_]); ww_[2 * q_ + 1] = 1.f - bfhi(w0_[q_]);              \
        rr_[2 * q_] = bflo(w1_[q_]); rr_[2 * q_ + 1] = bfhi(w1_[q_]);                          \
        vv_[2 * q_] = bflo(w2_[q_]); vv_[2 * q_ + 1] = bfhi(w2_[q_]);                          \
      }                                                                                        \
      float* d0_ = B_ + ss * 64 + sc * 8;                                                      \
      *(float4*)(d0_ + 1024) = make_float4(ww_[0], ww_[1], ww_[2], ww_[3]);                    \
      *(float4*)(d0_ + 1028) = make_float4(ww_[4], ww_[5], ww_[6], ww_[7]);                    \
      *(float4*)(d0_ + 4096) = make_float4(rr_[0], rr_[1], rr_[2], rr_[3]);                    \
      *(float4*)(d0_ + 4100) = make_float4(rr_[4], rr_[5], rr_[6], rr_[7]);                    \
      if (sc < 2) {                                                                            \
        float* d1_ = B_ + 5120 + ss * 16 + sc * 8;                                             \
        *(float4*)(d1_) = make_float4(vv_[0], vv_[1], vv_[2], vv_[3]);                         \
        *(float4*)(d1_ + 4) = make_float4(vv_[4], vv_[5], vv_[6], vv_[7]);                     \
      }                                                                                        \
    }                                                                                          \
  }
  f32x2_t SA = {0.f, 0.f}, SB = {0.f, 0.f};
  __builtin_amdgcn_s_setprio(3);
  SCAN_GLOAD(0);
  SCAN_LSTORE(0);
  __syncthreads();
  for (int c = 0; c < NCH; ++c) {
    const int buf = c & 1;
    if (c + 1 < NCH) SCAN_GLOAD((c + 1) * TC);
    const float* B = sbase + buf * BUF;
    float* syb = sy + buf * TC * 16;
    float ypart[TC];
    float4 kkv[TC], wwv[TC], bbv[TC], ddv[TC], rrv[TC];
    float vvv[TC];
    constexpr int PF = 2;
#pragma unroll
    for (int st = 0; st < PF; ++st) {
      kkv[st] = *(const float4*)(B + st * 64 + kq * 4);
      wwv[st] = *(const float4*)(B + 1024 + st * 64 + kq * 4);
      bbv[st] = *(const float4*)(B + 2048 + st * 64 + kq * 4);
      ddv[st] = *(const float4*)(B + 3072 + st * 64 + kq * 4);
      rrv[st] = *(const float4*)(B + 4096 + st * 64 + kq * 4);
      vvv[st] = B[5120 + st * 16 + rloc];
    }
    __builtin_amdgcn_sched_barrier(0);
#pragma unroll
    for (int st = 0; st < TC; ++st) {
      if (st + PF < TC) {
        kkv[st + PF] = *(const float4*)(B + (st + PF) * 64 + kq * 4);
        wwv[st + PF] = *(const float4*)(B + 1024 + (st + PF) * 64 + kq * 4);
        bbv[st + PF] = *(const float4*)(B + 2048 + (st + PF) * 64 + kq * 4);
        ddv[st + PF] = *(const float4*)(B + 3072 + (st + PF) * 64 + kq * 4);
        rrv[st + PF] = *(const float4*)(B + 4096 + (st + PF) * 64 + kq * 4);
        vvv[st + PF] = B[5120 + (st + PF) * 16 + rloc];
      }
      __builtin_amdgcn_sched_barrier(0);
      const float4 kk = kkv[st], ww = wwv[st], bb = bbv[st], dd = ddv[st], rr = rrv[st];
      const float vv = vvv[st];
      const f32x2_t k01 = {kk.x, kk.y}, k23 = {kk.z, kk.w}, w01 = {ww.x, ww.y}, w23 = {ww.z, ww.w};
      const f32x2_t b01 = {bb.x, bb.y}, b23 = {bb.z, bb.w}, d01 = {dd.x, dd.y}, d23 = {dd.z, dd.w};
      const f32x2_t r01 = {rr.x, rr.y}, r23 = {rr.z, rr.w}, v2 = {vv, vv};
      const f32x2_t pp2 = SA * k01 + SB * k23;
      const float part = pp2.x + pp2.y;
      const f32x2_t cA = SA * w01 + v2 * d01, cB = SB * w23 + v2 * d23;
      const float sa = -row_allsum(part);
      const f32x2_t sa2 = {sa, sa};
      SA = cA + sa2 * b01;
      SB = cB + sa2 * b23;
      const f32x2_t yy2 = SA * r01 + SB * r23;
      ypart[st] = yy2.x + yy2.y;
    }
#pragma unroll
    for (int st = 0; st < TC; ++st) ypart[st] = row_allsum(ypart[st]);
    if (kq == 0) {
#pragma unroll
      for (int st = 0; st < TC; ++st) syb[st * 16 + rloc] = ypart[st];
    }
    if (c + 1 < NCH) SCAN_LSTORE(buf ^ 1);
    __syncthreads();
    {
      const int st = tid >> 4, r_ = tid & 15;
      const int ii = c * TC + st;
      const int j = SCAN_JMAP(ii);
      yD[(rbase + j) * 256 + hd * 64 + rq * 16 + r_] = syb[st * 16 + r_];
    }
  }
  __builtin_amdgcn_s_setprio(0);
  __syncthreads();
}

DI void readout_hy_phase(int g, const MixBufs& m, u16* __restrict__ ymix, bool skip_ctx, char* smem) {
  const int tid = ltid();
  {
    u16* tile = (u16*)smem;
    for (int tl = blockIdx.x; tl < (TG / 64) * 4; tl += gridDim.x) {
      const int rl0 = (tl >> 2) * 64, c0 = (tl & 3) * 64;
      const int r0 = g * TG + rl0;
      if (skip_ctx && (r0 % LT) < LC) continue;
#pragma unroll
      for (int k = 0; k < 2; ++k) {
        const int id = tid + NTHR * k, ch = id >> 3, part = id & 7;
        *(uint4*)(tile + ch * 72 + part * 8) = *(const uint4*)(m.u + (size_t)(c0 + ch) * TG + rl0 + part * 8);
      }
      __syncthreads();
#pragma unroll
      for (int k = 0; k < 2; ++k) {
        const int id = tid + NTHR * k, tok = id >> 3, part = id & 7;
        const u16* tp = tile + (part * 8) * 72 + tok;
        uint4 w;
        w.x = (unsigned)tp[0] | ((unsigned)tp[72] << 16);
        w.y = (unsigned)tp[2 * 72] | ((unsigned)tp[3 * 72] << 16);
        w.z = (unsigned)tp[4 * 72] | ((unsigned)tp[5 * 72] << 16);
        w.w = (unsigned)tp[6 * 72] | ((unsigned)tp[7 * 72] << 16);
        *(uint4*)(ymix + (size_t)(r0 + tok) * D + c0 + part * 8) = w;
      }
      __syncthreads();
    }
  }
}

DI void readout_rw_phase(const Params& p, int l, int g, const MixBufs& m, u16* __restrict__ ymix, bool skip_ctx) {
  const int tid = ltid();
  for (int rl = blockIdx.x; rl < TG; rl += gridDim.x) {
    const int r = g * TG + rl;
    const int j = r % LT;
    if (skip_ctx && j < LC) continue;
    const size_t o = (size_t)rl * 256 + tid;
    float y = m.yf[o] + m.yb[o];
    float mean = wave_sum(y) * (1.f / 64.f);
    float dv = y - mean;
    float var = wave_sum(dv * dv) * (1.f / 64.f);
    float yn = dv * rsqrtf(var + 64e-5f) * p.rw_ln_w[l * 256 + tid] + p.rw_ln_b[l * 256 + tid];
    const float rr = bf2f(m.rr[o]), kv = bf2f(m.rk[o]), vv = bf2f(m.rv[o]);
    const float kaa = p.rw_k_a[l * 256 + tid], rk = p.rw_r_k[l * 256 + tid];
    const float af = bf2f(m.af[o]), ab = bf2f(m.ab[o]);
    float t1 = rr * kv * (1.f + (af - 1.f) * kaa) * rk + rr * kv * (1.f + (ab - 1.f) * kaa) * rk;
    float bonus = wave_sum(t1) * vv;
    ymix[(size_t)r * D + 768 + tid] = f2bf((yn + bonus) * bf2f(m.gg[o]));
  }
}

#define XB_TMO      128
#define XB_XCNT(j)  (256  + 64 * (j))
#define XB_XSUB(j)  (1280 + 64 * (j))
#define XB_XGEN(j)  (2304 + 64 * (j))
#define XB_TOP      3328
#define XB_TOPGEN   3392
#define XCD_BAR_WORDS 3456
#define XB_SPIN_CAP (1u << 21)
#define LAS __attribute__((address_space(3)))
DI unsigned xb_ld(unsigned* p) { return __hip_atomic_load(p, __ATOMIC_RELAXED, __HIP_MEMORY_SCOPE_AGENT); }
DI unsigned xb_add(unsigned* p, unsigned v) { return __hip_atomic_fetch_add(p, v, __ATOMIC_RELAXED, __HIP_MEMORY_SCOPE_AGENT); }
DI unsigned xb_xcc_id() { return (unsigned)__builtin_amdgcn_s_getreg((3 << 11) | 20) & 0xFu; }
#define XB_SPIN(cond, bar) do { unsigned _sp = 0; while (cond) { __builtin_amdgcn_s_sleep(1); \
    if ((++_sp & 255u) == 0u) { if (xb_ld(&(bar)[XB_TMO])) break; if (_sp > XB_SPIN_CAP) { atomicAdd(&(bar)[XB_TMO], 1u); break; } } } } while (0)
struct XcdBarrier { unsigned* bar; unsigned x; volatile LAS unsigned* st; };
DI XcdBarrier xcd_barrier_post(unsigned* bar, volatile LAS unsigned* st) {
  XcdBarrier b; b.bar = bar; b.x = xb_xcc_id(); b.st = st;
  if (threadIdx.x == 0) (void)xb_add(&bar[XB_XCNT(b.x)], 1u);
  return b;
}
DI void xcd_barrier_complete(unsigned* bar, unsigned x, unsigned& nloc, unsigned& nx) {
  const unsigned G = gridDim.x * gridDim.y * gridDim.z;
  unsigned sum, cnt, mine, sp = 0u;
  for (;;) {
    sum = 0u; cnt = 0u; mine = 0u;
#pragma unroll
    for (unsigned j = 0; j < 16; ++j) { const unsigned c = xb_ld(&bar[XB_XCNT(j)]); sum += c; cnt += (c > 0u) ? 1u : 0u; mine = (j == x) ? c : mine; }
    if (sum == G) break;
    __builtin_amdgcn_s_sleep(1);
    if ((++sp & 255u) == 0u) { if (xb_ld(&bar[XB_TMO])) break; if (sp > XB_SPIN_CAP) { atomicAdd(&bar[XB_TMO], 1u); break; } }
  }
  nloc = mine > 0u ? mine : 1u; nx = cnt > 0u ? cnt : 1u;
}
DI void xcd_barrier(const XcdBarrier& b) {
  asm volatile("s_waitcnt vmcnt(0)" ::: "memory");
  __syncthreads();
  if (threadIdx.x == 0) {
    unsigned* bar = b.bar;
    __builtin_amdgcn_s_waitcnt(0);
    unsigned nloc = b.st[0], nx = b.st[1];
    if (nloc == 0u) { xcd_barrier_complete(bar, b.x, nloc, nx); b.st[0] = nloc; b.st[1] = nx; }
    const unsigned old = xb_add(&bar[XB_XSUB(b.x)], 1u);
    const unsigned gen = old / nloc;
    if (old + 1u == (gen + 1u) * nloc) {
      __builtin_amdgcn_fence(__ATOMIC_RELEASE, "agent");
      asm volatile("s_waitcnt vmcnt(0)" ::: "memory");
      const unsigned og = xb_add(&bar[XB_TOP], 1u);
      const unsigned tg = og / nx;
      if (og + 1u == (tg + 1u) * nx) xb_add(&bar[XB_TOPGEN], 1u);
      else XB_SPIN(xb_ld(&bar[XB_TOPGEN]) == tg, bar);
      __builtin_amdgcn_fence(__ATOMIC_ACQUIRE, "agent");
      xb_add(&bar[XB_XGEN(b.x)], 1u);
      asm volatile("s_waitcnt vmcnt(0)" ::: "memory");
    } else {
      XB_SPIN(xb_ld(&bar[XB_XGEN(b.x)]) == gen, bar);
      __builtin_amdgcn_fence(__ATOMIC_ACQUIRE, "agent");
      asm volatile("s_waitcnt vmcnt(0)" ::: "memory");
    }
  }
  __syncthreads();
}

DI void convert_layer(const Params& p, int l, u16* W, char* smem) {
  convT(p.ffn1_gate + (size_t)l * D * DFF, D, DFF, W + W_GU1, 1, smem);
  convT(p.ffn1_up + (size_t)l * D * DFF, D, DFF, W + W_GU1, 2, smem);
  convT(p.ffn1_down + (size_t)l * D * DFF, DFF, D, W + W_D1, 0, smem);
  convT(p.ffn2_gate + (size_t)l * D * DFF, D, DFF, W + W_GU2, 1, smem);
  convT(p.ffn2_up + (size_t)l * D * DFF, D, DFF, W + W_GU2, 2, smem);
  convT(p.ffn2_down + (size_t)l * D * DFF, DFF, D, W + W_D2, 0, smem);
  convT(p.w_in + (size_t)l * D * DIN, D, DIN, W + W_IN, 0, smem);
  convT(p.w_out + (size_t)l * D * D, D, D, W + W_OUT, 0, smem);
  convT(p.mla_w_uq + (size_t)l * 256 * 384, 256, 384, W + W_UQ, 0, smem);
  convT(p.mla_w_ukv + (size_t)l * 128 * 512, 128, 512, W + W_UKV, 0, smem);
  for (int d = 0; d < 2; ++d) {
    convT(p.rw_w2 + (size_t)(l * 2 + d) * 64 * 256, 64, 256, W + W_W2 + (size_t)d * 256 * 64, 0, smem);
    convT(p.rw_a2 + (size_t)(l * 2 + d) * 64 * 256, 64, 256, W + W_A2 + (size_t)d * 256 * 64, 0, smem);
  }
  convT(p.rw_g2 + (size_t)l * 128 * 256, 128, 256, W + W_G2, 0, smem);
}

__global__ void __launch_bounds__(NTHR, 2) fwd_megakernel(Params p) {
  cg::grid_group grid = cg::this_grid();
  __shared__ __attribute__((aligned(16))) char smem[73728];
  __shared__ int s_item;
  __shared__ uint4 xb_words;
  if (threadIdx.x == 0) xb_words = make_uint4(0u, 0u, 0u, 0u);
  __syncthreads();
  const XcdBarrier xb = xcd_barrier_post((unsigned*)(p.ws + OFF_BAR), (volatile LAS unsigned*)&xb_words);
  char* ws = p.ws;
  float* ctxs = (float*)(ws + OFF_CTX);
  float* mod = (float*)(ws + OFF_MOD);
  u16* hbuf = (u16*)(ws + OFF_H);
  char* big = ws + OFF_BIG;
  u16* Gbuf = (u16*)big;
  u16* const Wl = (u16*)(ws + OFF_W);
  float* const filt = (float*)(ws + OFF_FILT);

  convert_layer(p, 0, Wl, smem);
  hyfilt_phase(p, 0, LQ, filt, smem);
  hyfilt_phase(p, 0, LC, (float*)(ws + OFF_FILTC), smem);
  rope_table_phase((float2*)(ws + OFF_ROPEG), (float2*)(ws + OFF_ROPEM));
  mod_phase(p, mod, smem);
  grid.sync();

  for (int l = 0; l < 2; ++l) {
    const bool last = (l == 1);
    const u16* W = Wl;
    if (l == 1) {
      convert_layer(p, 1, Wl, smem);
      hyfilt_phase(p, 1, LQ, filt, smem);
      xcd_barrier(xb);
    }
    const float* modl = mod + (size_t)l * 9 * 9216;
    const float* lat_in = (l == 0) ? p.x : p.out;
    const float* ctx_in = (l == 0) ? p.ctx : ctxs;

    adaln_phase(lat_in, ctx_in, p.norm_ffn1 + l * D, modl, 0, hbuf, false);
    xcd_barrier(xb);
    {
      EpiGU e{Gbuf};
      for (int rep = 0; rep < REP_GU; ++rep) gemm_phase<true>(hbuf, D, W + W_GU1, D, D, T / 128, 44, 0, false, smem, e);
    }
    xcd_barrier(xb);
    {
      EpiRes e{lat_in, ctx_in, p.out, ctxs, modl, 2, 0.5f, nullptr, nullptr, nullptr, 0};
      gemm_phase<false>(Gbuf, DFF, W + W_D1, DFF, DFF, T / 128, 8, 0, false, smem, e);
    }
    xcd_barrier(xb);
    adaln_phase(p.out, ctxs, p.norm_mix + l * D, modl, 1, hbuf, false);
    xcd_barrier(xb);
    for (int g = 0; g < NG; ++g) {
      const MixBufs m = mixbufs(big, g);
      const u16* hg = hbuf + (size_t)g * TG * D;
      {
        EpiWin e{m.p, m.pt};
        gemm_phase<false>(hg, D, W + W_IN, D, D, TG / 128, 23, 0, false, smem, e);
      }
      xcd_barrier(xb);
      for (int rep = 0; rep < REP_ROW; ++rep) prep_phase(p, l, g, m, (const float2*)(ws + OFF_ROPEG), smem);
      xcd_barrier(xb);
      {
        EpiStore e1{m.qup, 384, 384};
        gemm_phase<false>(m.cqn, 256, W + W_UQ, 256, 256, TG / 128, 3, 0, false, smem, e1);
        EpiStore e2{m.kvup, 512, 512};
        gemm_phase<false>(m.ckvn, 128, W + W_UKV, 128, 128, TG / 128, 4, 0, false, smem, e2);
        EpiLoraW e3{m.ef, p.rw_w0 + (l * 2 + 0) * 256};
        gemm_phase<false>(m.lwf, 64, W + W_W2, 64, 64, TG / 128, 2, 0, false, smem, e3);
        EpiLoraW e4{m.eb, p.rw_w0 + (l * 2 + 1) * 256};
        gemm_phase<false>(m.lwb, 64, W + W_W2 + 256 * 64, 64, 64, TG / 128, 2, 0, false, smem, e4);
        EpiLoraA e5{m.af, p.rw_a0 + (l * 2 + 0) * 256};
        gemm_phase<false>(m.laf, 64, W + W_A2, 64, 64, TG / 128, 2, 0, false, smem, e5);
        EpiLoraA e6{m.ab, p.rw_a0 + (l * 2 + 1) * 256};
        gemm_phase<false>(m.lab, 64, W + W_A2 + 256 * 64, 64, 64, TG / 128, 2, 0, false, smem, e6);
        EpiStore e7{m.gg, 256, 256};
        gemm_phase<false>(m.lg, 128, W + W_G2, 128, 128, TG / 128, 2, 0, false, smem, e7);
      }
      xcd_barrier(xb);
      for (int rep = 0; rep < REP_ROW; ++rep) mla_fin_phase(p, l, g, m, (const float2*)(ws + OFF_ROPEM));
      xcd_barrier(xb);
      {
        u16* ymix = hbuf;
        const int n_scan = (g == NG - 1) ? NG * BG * 4 * 2 * 4 : 0;
        const int qt_per_b = last ? 32 : 34;
        const int n_att = BG * 4 * qt_per_b;
        const int n_hy = 256;
        const int total = n_scan + 2 * n_att + n_hy;
        float gq = 0.f, gk = 0.f, mq = 0.f, mk = 0.f;
        for (int i = 0; i < 64; ++i) { gq = fmaxf(gq, fabsf(p.gqa_q_norm[l * 64 + i])); gk = fmaxf(gk, fabsf(p.gqa_k_norm[l * 64 + i])); }
        for (int i = 0; i < 96; ++i) { mq = fmaxf(mq, fabsf(p.mla_q_norm[l * 96 + i])); mk = fmaxf(mk, fabsf(p.mla_k_norm[l * 96 + i])); }
        const float L2E = 1.4426950408889634f;
        const float sc_g = 0.125f, sc_m = 0.10206207261596575f;
        const float sh_g = (64.f * gq * gk * sc_g * 1.02f + 0.5f) * L2E;
        const float sh_m = (96.f * mq * mk * sc_m * 1.02f + 0.5f) * L2E;
        int* cnt = (int*)(ws + OFF_CNT) + (l * NG + g);
        for (;;) {
          if (threadIdx.x == 0) s_item = atomicAdd(cnt, 1);
          __syncthreads();
          const int it = s_item;
          __syncthreads();
          if (it >= total) break;
          if (it < n_scan) {
            const int sg = it >> 7, bl = (it >> 5) & 3, hd = (it >> 3) & 3, dir = (it >> 2) & 1, rq = it & 3;
            const MixBufs ms = mixbufs(big, sg);
            scan_item(p, l, ms, bl, hd, dir, rq, smem);
          } else if (it < n_scan + 2 * n_att) {
            int a = it - n_scan;
            const int kind = a / n_att;
            a -= kind * n_att;
            const int bl = a / (4 * qt_per_b);
            int rem = a - bl * 4 * qt_per_b;
            const int hd = rem / qt_per_b;
            const int qt = rem - hd * qt_per_b;
            const int j0 = qt < 32 ? LC + qt * 128 : (qt - 32) * 128;
            const int nkeys = qt < 32 ? LT : LC;
            const size_t rl0 = (size_t)bl * LT + j0;
            const size_t rg0 = (size_t)(g * BG + bl) * LT + j0;
            if (kind == 0) {
              const int kvh = hd >> 1;
              attn_item<64, 1>(m.qg + rl0 * 256 + hd * 64, 256, m.kg + (size_t)bl * LT * 128 + kvh * 64, 128,
                            m.vtg + (size_t)(bl * 2 + kvh) * 64 * LT, ymix + rg0 * D + 256 + hd * 64, D, nkeys, sc_g * L2E, sh_g, smem);
            } else {
              attn_item<96, 1>(m.qm + rl0 * 384 + hd * 96, 384, m.km + (size_t)bl * LT * 384 + hd * 96, 384,
                            m.vtm + (size_t)(bl * 4 + hd) * 64 * LT, ymix + rg0 * D + 512 + hd * 64, D, nkeys, sc_m * L2E, sh_m, smem);
            }
          } else {
            const int c = it - n_scan - 2 * n_att;
            hyena_pass(p, l, m, filt, LQ, LC, c, smem);
            if (!last) hyena_pass(p, l, m, (const float*)(ws + OFF_FILTC), LC, 0, c, smem);
          }
        }
        xcd_barrier(xb);
        readout_hy_phase(g, m, ymix, last, smem);
        if (g == NG - 1) {
          for (int rg = 0; rg < NG; ++rg) {
            const MixBufs mr = mixbufs(big, rg);
            readout_rw_phase(p, l, rg, mr, ymix, last);
          }
          xcd_barrier(xb);
        }
      }
    }
    {
      EpiRes e{p.out, ctxs, p.out, ctxs, modl, 5, 1.0f, nullptr, nullptr, nullptr, 0};
      gemm_phase<false>(hbuf, D, W + W_OUT, D, D, T / 128, 8, 0, last, smem, e);
    }
    xcd_barrier(xb);
    adaln_phase(p.out, ctxs, p.norm_ffn2 + l * D, modl, 2, hbuf, last);
    xcd_barrier(xb);
    {
      EpiGU e{Gbuf};
      for (int rep = 0; rep < REP_GU; ++rep) gemm_phase<true>(hbuf, D, W + W_GU2, D, D, T / 128, 44, 0, last, smem, e);
    }
    xcd_barrier(xb);
    {
      EpiRes e{p.out, ctxs, p.out, ctxs, modl, 8, 0.5f, nullptr, nullptr, nullptr, 0};
      gemm_phase<false>(Gbuf, DFF, W + W_D2, DFF, DFF, T / 128, 8, 0, last, smem, e);
    }
    xcd_barrier(xb);
  }
}

extern "C" void kernel_launch(void* const* d_in, const int* in_sizes, int n_in, void* d_out, int out_size, void* d_ws,
                              size_t ws_size, hipStream_t stream) {
  static int grid_blocks = 0;
  if (!grid_blocks) {
    int dev = 0, cus = 0, per_cu = 0;
    (void)hipGetDevice(&dev);
    (void)hipDeviceGetAttribute(&cus, hipDeviceAttributeMultiprocessorCount, dev);
    (void)hipOccupancyMaxActiveBlocksPerMultiprocessor(&per_cu, fwd_megakernel, NTHR, 0);
    if (per_cu > 2) per_cu = 2;
    if (per_cu < 1) per_cu = 1;
    grid_blocks = cus * per_cu;
  }
  Params p{};
  const float** pp = (const float**)&p;
  for (int i = 0; i < 47; ++i) pp[i] = (const float*)d_in[i];
  p.out = (float*)d_out;
  p.ws = (char*)d_ws;
  (void)hipMemsetAsync((char*)d_ws + OFF_CNT, 0, 256 + 3456 * 4, stream);
  void* args[] = {&p};
  hipError_t e = hipLaunchCooperativeKernel((void*)fwd_megakernel, dim3(grid_blocks), dim3(NTHR), args, 0, stream);
  if (e != hipSuccess) fprintf(stderr, "cooperative launch failed: %s (grid %d)\n", hipGetErrorString(e), grid_blocks);
}
```

```cpp
#include <hip/hip_runtime.h>
#include <hip/hip_bf16.h>
#include <hip/hip_cooperative_groups.h>
#include <cstdio>
namespace cg = cooperative_groups;

#define DI __device__ __forceinline__
typedef unsigned short u16;
using bf16x8 = __attribute__((ext_vector_type(8))) short;
using f32x16 = __attribute__((ext_vector_type(16))) float;
typedef __bf16 bf16x2_t __attribute__((ext_vector_type(2)));
typedef float f32x2_t __attribute__((ext_vector_type(2)));
#define MFMA32(a, b, c) __builtin_amdgcn_mfma_f32_32x32x16_bf16((a), (b), (c), 0, 0, 0)

constexpr int D = 1024, NB = 8, LQ = 4096, LC = 256, LT = 4352, T = NB * LT, DFF = 2816, DIN = 2848;
constexpr int HYC = 768, DINP = DIN - HYC;
constexpr int NG = 2, BG = NB / NG, TG = BG * LT;
constexpr int NTHR = 256;
#define REP_MIX 1
#define REP_GU 1
#define REP_MISC 1
#define REP_ROW 1
constexpr float EPS = 1e-6f;

constexpr size_t al(size_t x) { return (x + 255) & ~(size_t)255; }
constexpr size_t OFF_CTX = 0;
constexpr size_t OFF_MOD = OFF_CTX + al((size_t)NB * LC * D * 4);
constexpr size_t SZ_FILT_L = (size_t)(2 * LQ - 1) * 256 * 4;
constexpr size_t SZ_FILT_C = (size_t)(2 * LC - 1) * 256 * 4;
constexpr size_t OFF_CNT = OFF_MOD + al((size_t)2 * 9 * 9216 * 4);
constexpr size_t OFF_BAR = OFF_CNT + 256;
constexpr size_t OFF_FILT = OFF_BAR + al((size_t)3456 * 4);
constexpr size_t OFF_FILTC = OFF_FILT + al(SZ_FILT_L);
constexpr size_t OFF_ROPEG = OFF_FILTC + al(SZ_FILT_C);
constexpr size_t OFF_ROPEM = OFF_ROPEG + al((size_t)LQ * 32 * 8);
constexpr size_t OFF_W = OFF_ROPEM + al((size_t)LQ * 16 * 8);
constexpr size_t W_GU1 = 0;
constexpr size_t W_D1 = W_GU1 + (size_t)5632 * 1024;
constexpr size_t W_GU2 = W_D1 + (size_t)1024 * 2816;
constexpr size_t W_D2 = W_GU2 + (size_t)5632 * 1024;
constexpr size_t W_IN = W_D2 + (size_t)1024 * 2816;
constexpr size_t W_OUT = W_IN + (size_t)2944 * 1024;
constexpr size_t W_UQ = W_OUT + (size_t)1024 * 1024;
constexpr size_t W_UKV = W_UQ + (size_t)384 * 256;
constexpr size_t W_W2 = W_UKV + (size_t)512 * 128;
constexpr size_t W_A2 = W_W2 + (size_t)2 * 256 * 64;
constexpr size_t W_G2 = W_A2 + (size_t)2 * 256 * 64;
constexpr size_t W_LAYER = W_G2 + (size_t)256 * 128;
constexpr size_t OFF_H = OFF_W + al(W_LAYER * 2);
constexpr size_t OFF_BIG = OFF_H + al((size_t)T * D * 2);
constexpr size_t M_P = 0;
constexpr size_t M_PT = M_P + al((size_t)TG * DINP * 2);
constexpr size_t M_U = M_PT + al((size_t)HYC * TG * 2);
constexpr size_t M_CQN = M_U + al((size_t)TG * 256 * 2);
constexpr size_t M_CKVN = M_CQN + al((size_t)TG * 256 * 2);
constexpr size_t M_QUP = M_CKVN + al((size_t)TG * 128 * 2);
constexpr size_t M_KVUP = M_QUP + al((size_t)TG * 384 * 2);
constexpr size_t M_QM = M_KVUP + al((size_t)TG * 512 * 2);
constexpr size_t M_KM = M_QM + al((size_t)TG * 384 * 2);
constexpr size_t M_VTM = M_KM + al((size_t)TG * 384 * 2);
constexpr size_t M_LWF = M_VTM + al((size_t)TG * 256 * 2);
constexpr size_t M_LWB = M_LWF + al((size_t)TG * 64 * 2);
constexpr size_t M_LAF = M_LWB + al((size_t)TG * 64 * 2);
constexpr size_t M_LAB = M_LAF + al((size_t)TG * 64 * 2);
constexpr size_t M_LG = M_LAB + al((size_t)TG * 64 * 2);
constexpr size_t SZ_SC = al((size_t)TG * 256 * 2);
constexpr size_t M_SCAN = M_LG + al((size_t)TG * 128 * 2);
constexpr size_t SCAN_STRIDE = 11 * SZ_SC;
constexpr size_t M_END = M_SCAN + 2 * SCAN_STRIDE;
static_assert((size_t)4 * TG * 256 * 4 <= al((size_t)TG * DINP * 2), "yf/yb do not fit the p region");
constexpr size_t SZ_G = (size_t)T * DFF * 2;
constexpr size_t WS_NEED = OFF_BIG + (M_END > SZ_G ? M_END : SZ_G);
static_assert(WS_NEED <= (size_t)512 * 1024 * 1024, "workspace too large");

struct Params {
  const float *x, *c, *ctx, *c_ctx, *ada_w, *ada_b, *norm_ffn1, *norm_mix, *norm_ffn2;
  const float *ffn1_gate, *ffn1_up, *ffn1_down, *ffn2_gate, *ffn2_up, *ffn2_down, *w_in, *w_out;
  const float *hy_conv_w, *hy_conv_b, *hy_f_w1, *hy_f_b1, *hy_f_w2, *hy_f_b2, *hy_f_w3, *hy_f_b3, *hy_f_w4, *hy_f_freq, *hy_bias;
  const float *gqa_q_norm, *gqa_k_norm, *mla_cq_norm, *mla_ckv_norm, *mla_w_uq, *mla_w_ukv, *mla_q_norm, *mla_k_norm;
  const float *rw_mu, *rw_w0, *rw_w2, *rw_a0, *rw_a2, *rw_g2, *rw_k_k, *rw_k_a, *rw_r_k, *rw_ln_w, *rw_ln_b;
  float* out;
  char* ws;
};

DI u16 f2bf(float x) {
  unsigned u = __float_as_uint(x);
  u += 0x7fffu + ((u >> 16) & 1u);
  return (u16)(u >> 16);
}
DI float bf2f(u16 b) { return __uint_as_float(((unsigned)b) << 16); }
DI float bflo_(unsigned w) { return __uint_as_float(w << 16); }
DI float bfhi_(unsigned w) { return __uint_as_float(w & 0xffff0000u); }
DI unsigned pack2(float a, float b) {
  f32x2_t v = {a, b};
  bf16x2_t r = __builtin_convertvector(v, bf16x2_t);
  return __builtin_bit_cast(unsigned, r);
}
DI int ltid() {
  int t = threadIdx.x;
  asm volatile("" : "+v"(t));
  return t;
}
DI float wave_sum(float v) {
#pragma unroll
  for (int o = 32; o > 0; o >>= 1) v += __shfl_xor(v, o);
  return v;
}
DI float wave_max(float v) {
#pragma unroll
  for (int o = 32; o > 0; o >>= 1) v = fmaxf(v, __shfl_xor(v, o));
  return v;
}
DI float sigmoidf_(float x) { return __builtin_amdgcn_rcpf(1.f + __expf(-x)); }
DI int crow(int i, int h) { return (i & 3) + 8 * (i >> 2) + 4 * h; }

DI float rope_apply(float val, int idx, int nfreq, int t, int lane) {
  int pi = idx >> 1;
  int row = t >> 6, col = t & 63;
  float pos = pi < nfreq ? (float)row : (float)col;
  int f = pi < nfreq ? pi : pi - nfreq;
  float inv = exp2f(-(float)f / (float)nfreq * 13.287712379549449f);
  float ang = pos * inv;
  float cs = cosf(ang), sn = sinf(ang);
  float other = __shfl_xor(val, 1);
  return (lane & 1) ? other * sn + val * cs : val * cs - other * sn;
}

DI float rope_tab(float val, int idx, const float2* __restrict__ tab, int lane) {
  const float2 cs = tab[idx >> 1];
  const float other = __shfl_xor(val, 1);
  return (lane & 1) ? other * cs.y + val * cs.x : val * cs.x - other * cs.y;
}
DI void rope_table_phase(float2* __restrict__ tg, float2* __restrict__ tm) {
  const int tid = ltid();
  for (int e = blockIdx.x * NTHR + tid; e < LQ * 48; e += gridDim.x * NTHR) {
    const int t = e / 48, k = e - t * 48;
    const bool isg = k < 32;
    const int pi = isg ? k : k - 32, nfreq = isg ? 16 : 8;
    const int row = t >> 6, col = t & 63;
    const float pos = pi < nfreq ? (float)row : (float)col;
    const int f = pi < nfreq ? pi : pi - nfreq;
    const float inv = exp2f(-(float)f / (float)nfreq * 13.287712379549449f);
    const float ang = pos * inv;
    const float2 v = make_float2(cosf(ang), sinf(ang));
    if (isg) tg[t * 32 + pi] = v; else tm[t * 16 + pi] = v;
  }
}

DI int gu_row(int n, int half) { return (n >> 6) * 128 + ((n >> 5) & 1) * 64 + half * 32 + (n & 31); }
DI void convT(const float* __restrict__ src, int K, int N, u16* __restrict__ dst, int mode, char* smem) {
  float* tile = (float*)smem;
  const int tk = K / 64, tn = (N + 63) / 64;
  const int tid_ = ltid();
  const int j = tid_ & 63, i0 = tid_ >> 6;
  for (int t = blockIdx.x; t < tk * tn; t += gridDim.x) {
    const int k0 = (t / tn) * 64, n0 = (t % tn) * 64;
    for (int i = i0; i < 64; i += 4) {
      int n = n0 + j;
      tile[i * 65 + j] = n < N ? src[(size_t)(k0 + i) * N + n] : 0.f;
    }
    __syncthreads();
    for (int i = i0; i < 64; i += 4) {
      int n = n0 + i;
      if (n < N) {
        int row = mode == 0 ? n : gu_row(n, mode - 1);
        dst[(size_t)row * K + k0 + j] = f2bf(tile[j * 65 + i]);
      }
    }
    __syncthreads();
  }
}

DI void mod_phase(const Params& p, float* __restrict__ mod, char* smem) {
  float* sc = (float*)smem;
  float* red = sc + 9 * 1024;
  const int tid_ = ltid();
  for (int i = tid_; i < 9 * 1024; i += NTHR) {
    float v = i < 8192 ? p.c[i] : p.c_ctx[i - 8192];
    sc[i] = v / (1.f + expf(-v));
  }
  __syncthreads();
  const int lane = tid_ & 63, kp = tid_ >> 6;
  for (int it = blockIdx.x; it < 2 * 144; it += gridDim.x) {
    const int l = it / 144, nb = (it % 144) * 64;
    const float* w = p.ada_w + (size_t)l * 1024 * 9216 + nb + lane;
    float acc[9];
#pragma unroll
    for (int b = 0; b < 9; ++b) acc[b] = 0.f;
    for (int k = kp * 256; k < kp * 256 + 256; ++k) {
      float wv = w[(size_t)k * 9216];
#pragma unroll
      for (int b = 0; b < 9; ++b) acc[b] += sc[b * 1024 + k] * wv;
    }
#pragma unroll
    for (int b = 0; b < 9; ++b) red[(kp * 9 + b) * 64 + lane] = acc[b];
    __syncthreads();
    for (int o = tid_; o < 9 * 64; o += NTHR) {
      int b = o >> 6, ln = o & 63;
      float s = red[(0 * 9 + b) * 64 + ln] + red[(1 * 9 + b) * 64 + ln] + red[(2 * 9 + b) * 64 + ln] + red[(3 * 9 + b) * 64 + ln];
      mod[((size_t)l * 9 + b) * 9216 + nb + ln] = s + p.ada_b[l * 9216 + nb + ln];
    }
    __syncthreads();
  }
}

DI void hyfilt_phase(const Params& p, int l, int L, float* __restrict__ gT, char* smem) {
  float* z = (float*)smem;
  float* h1 = z + 64;
  float* h2 = h1 + 64;
  float* h3 = h2 + 64;
  float* w1s = z + 256;
  float* w2s = w1s + 33 * 64;
  float* w3s = w2s + 64 * 64;
  const float* w4 = p.hy_f_w4 + l * 64 * 512;
  const int tid = ltid();
  for (int i = tid; i < 33 * 64; i += NTHR) w1s[i] = p.hy_f_w1[l * 33 * 64 + i];
  for (int i = tid; i < 64 * 64; i += NTHR) { w2s[i] = p.hy_f_w2[l * 4096 + i]; w3s[i] = p.hy_f_w3[l * 4096 + i]; }
  float b1v = 0.f, b2v = 0.f, b3v = 0.f, frv = 0.f;
  if (tid < 64) { b1v = p.hy_f_b1[l * 64 + tid]; b2v = p.hy_f_b2[l * 64 + tid]; b3v = p.hy_f_b3[l * 64 + tid]; frv = p.hy_f_freq[l * 64 + tid]; }
  const float min_decay = logf(1e-2f) / 1.5f, max_decay = logf(1e-2f) / 0.3f;
  const float delta = fabsf(min_decay + (max_decay - min_decay) * (float)tid / 255.f);
  __syncthreads();
  for (int t = blockIdx.x; t < L; t += gridDim.x) {
    const float t01 = (float)t / (float)(L - 1);
    if (tid < 33) {
      float zz;
      if (tid == 0) zz = t01;
      else {
        int i = (tid - 1) & 15;
        float f = 1e-4f + (float)i * ((15.f - 1e-4f) / 15.f);
        float wang = 6.283185307179586f * (float)t / (float)L;
        zz = tid <= 16 ? cosf(f * wang) : -sinf(f * wang);
      }
      z[tid] = zz;
    }
    __syncthreads();
    if (tid < 64) {
      float a = b1v;
#pragma unroll 11
      for (int i = 0; i < 33; ++i) a += z[i] * w1s[i * 64 + tid];
      h1[tid] = sinf(frv * a);
    }
    __syncthreads();
    if (tid < 64) {
      float a = b2v;
#pragma unroll 16
      for (int i = 0; i < 64; ++i) a += h1[i] * w2s[i * 64 + tid];
      h2[tid] = sinf(frv * a);
    }
    __syncthreads();
    if (tid < 64) {
      float a = b3v;
#pragma unroll 16
      for (int i = 0; i < 64; ++i) a += h2[i] * w3s[i * 64 + tid];
      h3[tid] = sinf(frv * a);
    }
    __syncthreads();
    float af = 0.f, ab = 0.f;
#pragma unroll 8
    for (int i = 0; i < 64; ++i) {
      af += h3[i] * w4[i * 512 + tid];
      ab += h3[i] * w4[i * 512 + 256 + tid];
    }
    const float dec = expf(-t01 * delta);
    af *= dec;
    ab *= dec;
    if (t == 0) gT[(size_t)(L - 1) * 256 + tid] = af + ab;
    else {
      gT[(size_t)(L - 1 + t) * 256 + tid] = af;
      gT[(size_t)(L - 1 - t) * 256 + tid] = ab;
    }
    __syncthreads();
  }
  __syncthreads();
}

DI void adaln_phase(const float* __restrict__ lat, const float* __restrict__ ctxp, const float* __restrict__ gain,
                    const float* __restrict__ modl, int idx, u16* __restrict__ h, bool skip_ctx) {
  const int tid_ = ltid();
  const int wave = tid_ >> 6, lane = tid_ & 63;
  for (int r = blockIdx.x * 4 + wave; r < T; r += gridDim.x * 4) {
    const int b = r / LT, j = r - b * LT;
    if (skip_ctx && j < LC) continue;
    const float* xr = j < LC ? ctxp + ((size_t)(b * LC + j) << 10) : lat + ((size_t)(b * LQ + j - LC) << 10);
    const int bb = j < LC ? 8 : b;
    const float* shift = modl + bb * 9216 + (3 * idx) * 1024;
    const float* scale = shift + 1024;
    float4 v[4];
    float ss = 0.f;
#pragma unroll
    for (int q = 0; q < 4; ++q) {
      v[q] = *(const float4*)(xr + q * 256 + lane * 4);
      ss += v[q].x * v[q].x + v[q].y * v[q].y + v[q].z * v[q].z + v[q].w * v[q].w;
    }
    ss = wave_sum(ss);
    const float rstd = rsqrtf(ss * (1.f / 1024.f) + EPS);
#pragma unroll
    for (int q = 0; q < 4; ++q) {
      const int c = q * 256 + lane * 4;
      float4 g = *(const float4*)(gain + c), sc = *(const float4*)(scale + c), sh = *(const float4*)(shift + c);
      float y0 = v[q].x * rstd * g.x * (1.f + sc.x) + sh.x;
      float y1 = v[q].y * rstd * g.y * (1.f + sc.y) + sh.y;
      float y2 = v[q].z * rstd * g.z * (1.f + sc.z) + sh.z;
      float y3 = v[q].w * rstd * g.w * (1.f + sc.w) + sh.w;
      uint2 o;
      o.x = pack2(y0, y1);
      o.y = pack2(y2, y3);
      *(uint2*)(h + (size_t)r * D + c) = o;
    }
  }
}

DI bool gemm_decode(int t, int mtiles, int ntiles, int mt_off, bool skip_ctx, int& mt, int& nt) {
  const int mtx = mtiles >> 3;
  const int xcd = t & 7, q = t >> 3;
  const int sr = q / (8 * ntiles);
  const int rem = q - sr * 8 * ntiles;
  const int rows_in = min(8, mtx - sr * 8);
  const int sc = rem / (rows_in * 8);
  const int r2 = rem - sc * rows_in * 8;
  const int i = r2 % rows_in, j = r2 / rows_in;
  mt = (sr * 8 + i) * 8 + xcd;
  nt = sc * 8 + j;
  return !(skip_ctx && ((mt + mt_off) % 34) < 2);
}
template <bool PAIRED, class Epi>
DI void gemm_phase(const u16* __restrict__ A, int lda, const u16* __restrict__ Bt, int ldb, int K, int mtiles, int ntiles,
                   int mt_off, bool skip_ctx, char* smem, Epi& epi) {
  u16* As = (u16*)smem;
  u16* Bs = As + 2 * 128 * 72;
  const int tid = ltid(), lane = tid & 63, wave = tid >> 6;
  const int wm = wave >> 1, wn = wave & 1, lr = lane & 31, lh = lane >> 5;
  const int lrow = tid >> 3, lkc = (tid & 7) * 8;
  const int total = mtiles * ntiles, nk = K >> 6;
  uint4 ra00, ra01, ra02, ra03, rb00, rb01, rb02, rb03, ra10, ra11, ra12, ra13, rb10, rb11, rb12, rb13;
  const u16* Agl;
  const u16* Bgl;
#define GEMM_GLOAD(S, kt_)                                            \
  {                                                                   \
    const int k0_ = (kt_) << 6;                                       \
    ra##S##0 = *(const uint4*)(Agl + k0_);                            \
    ra##S##1 = *(const uint4*)(Agl + (size_t)32 * lda + k0_);         \
    ra##S##2 = *(const uint4*)(Agl + (size_t)64 * lda + k0_);         \
    ra##S##3 = *(const uint4*)(Agl + (size_t)96 * lda + k0_);         \
    rb##S##0 = *(const uint4*)(Bgl + k0_);                            \
    rb##S##1 = *(const uint4*)(Bgl + (size_t)32 * ldb + k0_);         \
    rb##S##2 = *(const uint4*)(Bgl + (size_t)64 * ldb + k0_);         \
    rb##S##3 = *(const uint4*)(Bgl + (size_t)96 * ldb + k0_);         \
  }
#define GEMM_LSTORE(S, buf_)                                          \
  {                                                                   \
    u16* ad_ = As + (buf_) * 128 * 72 + lrow * 72 + lkc;              \
    u16* bd_ = Bs + (buf_) * 128 * 72 + lrow * 72 + lkc;              \
    *(uint4*)(ad_) = ra##S##0;                                        \
    *(uint4*)(ad_ + 32 * 72) = ra##S##1;                              \
    *(uint4*)(ad_ + 64 * 72) = ra##S##2;                              \
    *(uint4*)(ad_ + 96 * 72) = ra##S##3;                              \
    *(uint4*)(bd_) = rb##S##0;                                        \
    *(uint4*)(bd_ + 32 * 72) = rb##S##1;                              \
    *(uint4*)(bd_ + 64 * 72) = rb##S##2;                              \
    *(uint4*)(bd_ + 96 * 72) = rb##S##3;                              \
  }
#define GEMM_COMPUTE(buf_)                                                        \
  {                                                                               \
    const u16* as = As + (buf_) * 128 * 72 + (wm * 64 + lr) * 72 + lh * 8;        \
    const u16* bs = Bs + (buf_) * 128 * 72 + (wn * 64 + lr) * 72 + lh * 8;        \
    _Pragma("unroll") for (int ks = 0; ks < 4; ++ks) {                            \
      bf16x8 a0 = *(const bf16x8*)(as + ks * 16);                                 \
      bf16x8 a1 = *(const bf16x8*)(as + 32 * 72 + ks * 16);                       \
      bf16x8 b0 = *(const bf16x8*)(bs + ks * 16);                                 \
      bf16x8 b1 = *(const bf16x8*)(bs + 32 * 72 + ks * 16);                       \
      acc[0][0] = MFMA32(a0, b0, acc[0][0]);                                      \
      acc[0][1] = MFMA32(a0, b1, acc[0][1]);                                      \
      acc[1][0] = MFMA32(a1, b0, acc[1][0]);                                      \
      acc[1][1] = MFMA32(a1, b1, acc[1][1]);                                      \
    }                                                                             \
  }
  int t = blockIdx.x, mt = 0, nt = 0;
  while (t < total && !gemm_decode(t, mtiles, ntiles, mt_off, skip_ctx, mt, nt)) t += gridDim.x;
  if (t < total) {
    Agl = A + (size_t)(mt * 128 + lrow) * lda + lkc;
    Bgl = Bt + (size_t)(nt * 128 + lrow) * ldb + lkc;
    GEMM_GLOAD(0, 0);
  }
  while (t < total) {
    const int m0 = mt * 128, n0 = nt * 128;
    int tn = t + gridDim.x, mtn = 0, ntn = 0;
    while (tn < total && !gemm_decode(tn, mtiles, ntiles, mt_off, skip_ctx, mtn, ntn)) tn += gridDim.x;
    f32x16 acc[2][2];
#pragma unroll
    for (int a = 0; a < 2; ++a)
#pragma unroll
      for (int b = 0; b < 2; ++b)
#pragma unroll
        for (int i = 0; i < 16; ++i) acc[a][b][i] = 0.f;
    GEMM_LSTORE(0, 0);
    __syncthreads();
    if (nk > 1) GEMM_GLOAD(0, 1);
    for (int kt = 0; kt < nk; kt += 2) {
      if (kt + 2 < nk) GEMM_GLOAD(1, kt + 2);
      GEMM_COMPUTE(0);
      if (kt + 1 < nk) GEMM_LSTORE(0, 1);
      __syncthreads();
      if (kt + 1 >= nk) break;
      if (kt + 3 < nk) GEMM_GLOAD(0, kt + 3);
      GEMM_COMPUTE(1);
      if (kt + 2 < nk) GEMM_LSTORE(1, 0);
      __syncthreads();
    }
    if (tn < total) {
      Agl = A + (size_t)(mtn * 128 + lrow) * lda + lkc;
      Bgl = Bt + (size_t)(ntn * 128 + lrow) * ldb + lkc;
      GEMM_GLOAD(0, 0);
    }
    epi.tile(m0);
    if constexpr (PAIRED) {
      float* stg = (float*)smem + wave * 64 * 36;
#pragma unroll
      for (int mi = 0; mi < 2; ++mi)
#pragma unroll
        for (int i = 0; i < 16; ++i) stg[(mi * 32 + crow(i, lh)) * 36 + lr] = epi.combine(acc[mi][0][i], acc[mi][1][i]);
      __syncthreads();
#pragma unroll
      for (int k = 0; k < 8; ++k) {
        const int idx = lane + 64 * k, row = idx >> 3, c4 = idx & 7;
        const float4 v = *(const float4*)(stg + row * 36 + c4 * 4);
        epi.store4(m0 + wm * 64 + row, (n0 >> 1) + wn * 32 + c4 * 4, v);
      }
      __syncthreads();
    } else if constexpr (Epi::kStaged) {
      float* stg = (float*)smem + wave * 64 * 68;
#pragma unroll
      for (int mi = 0; mi < 2; ++mi)
#pragma unroll
        for (int ni = 0; ni < 2; ++ni)
#pragma unroll
          for (int i = 0; i < 16; ++i) stg[(mi * 32 + crow(i, lh)) * 68 + ni * 32 + lr] = acc[mi][ni][i];
      __syncthreads();
#pragma unroll 4
      for (int k = 0; k < 16; ++k) {
        const int idx = lane + 64 * k, row = idx >> 4, c4 = idx & 15;
        const float4 v = *(const float4*)(stg + row * 68 + c4 * 4);
        epi.row4(m0 + wm * 64 + row, n0 + wn * 64 + c4 * 4, v);
      }
      __syncthreads();
    } else {
#pragma unroll
      for (int mi = 0; mi < 2; ++mi) {
#pragma unroll
        for (int gq = 0; gq < 4; ++gq) {
          const int row0 = m0 + wm * 64 + mi * 32 + 8 * gq + 4 * lh;
          if (PAIRED) {
            const int col = (n0 >> 1) + wn * 32 + lr;
#pragma unroll
            for (int e = 0; e < 4; ++e) epi.pair(row0 + e, col, acc[mi][0][4 * gq + e], acc[mi][1][4 * gq + e]);
          } else {
            epi.quad(row0, n0 + wn * 64 + lr, acc[mi][0][4 * gq], acc[mi][0][4 * gq + 1], acc[mi][0][4 * gq + 2], acc[mi][0][4 * gq + 3]);
            epi.quad(row0, n0 + wn * 64 + 32 + lr, acc[mi][1][4 * gq], acc[mi][1][4 * gq + 1], acc[mi][1][4 * gq + 2], acc[mi][1][4 * gq + 3]);
          }
        }
      }
    }
    t = tn; mt = mtn; nt = ntn;
  }
}

#define EPI_DEFAULT_QUAD                                                   \
  static constexpr bool kStaged = false;                                   \
  DI void row4(int, int, float4) const {}                                  \
  DI void tile(int) {}                                                     \
  DI void quad(int row0, int col, float a, float b, float c, float d) const { \
    (*this)(row0, col, a);                                                 \
    (*this)(row0 + 1, col, b);                                             \
    (*this)(row0 + 2, col, c);                                             \
    (*this)(row0 + 3, col, d);                                             \
  }
struct EpiGU {
  u16* G;
  DI float combine(float g, float u) const { return g * __builtin_amdgcn_rcpf(1.f + __expf(-g)) * u; }
  DI void store4(int row, int col, float4 v) const {
    uint2 w;
    w.x = pack2(v.x, v.y);
    w.y = pack2(v.z, v.w);
    *(uint2*)(G + (size_t)row * DFF + col) = w;
  }
  DI void pair(int row, int col, float g, float u) const {
    float s = g / (1.f + __expf(-g));
    G[(size_t)row * DFF + col] = f2bf(s * u);
  }
  DI void operator()(int, int, float) const {}
  EPI_DEFAULT_QUAD
};
struct EpiRes {
  const float* lat_in; const float* ctx_in; float* lat_out; float* ctx_out; const float* modl; int gate_chunk; float coef;
  const float* tin; float* tout; const float* gate; int tm0;
  static constexpr bool kStaged = true;
  DI void row4(int row, int col, float4 v) const {
    const size_t o = ((size_t)(row - tm0) << 10) + col;
    const float4 x = *(const float4*)(tin + o);
    const float4 g = *(const float4*)(gate + col);
    float4 y;
    y.x = x.x + coef * g.x * v.x;
    y.y = x.y + coef * g.y * v.y;
    y.z = x.z + coef * g.z * v.z;
    y.w = x.w + coef * g.w * v.w;
    *(float4*)(tout + o) = y;
  }
  DI void tile(int m0) {
    const int b = m0 / LT, j = m0 - b * LT;
    const bool isc = j < LC;
    const size_t off = isc ? (((size_t)(b * LC + j)) << 10) : (((size_t)(b * LQ + j - LC)) << 10);
    tin = (isc ? ctx_in : lat_in) + off;
    tout = (isc ? ctx_out : lat_out) + off;
    gate = modl + (isc ? 8 : b) * 9216 + gate_chunk * 1024;
    tm0 = m0;
  }
  DI void operator()(int row, int col, float v) const {
    const size_t o = ((size_t)(row - tm0) << 10) + col;
    tout[o] = tin[o] + coef * gate[col] * v;
  }
  DI void pair(int, int, float, float) const {}
  DI void quad(int row0, int col, float a, float b, float c, float d) const {
    const float gc = coef * gate[col];
    const size_t o = ((size_t)(row0 - tm0) << 10) + col;
    tout[o] = tin[o] + gc * a;
    tout[o + 1024] = tin[o + 1024] + gc * b;
    tout[o + 2048] = tin[o + 2048] + gc * c;
    tout[o + 3072] = tin[o + 3072] + gc * d;
  }
};
struct EpiStore {
  u16* C; int ldc; int N;
  DI void operator()(int row, int col, float v) const { if (col < N) C[(size_t)row * ldc + col] = f2bf(v); }
  DI void pair(int, int, float, float) const {}
  EPI_DEFAULT_QUAD
};
struct EpiWin {
  u16* p; u16* pT;
  static constexpr bool kStaged = false;
  DI void row4(int, int, float4) const {}
  DI void tile(int) {}
  DI void quad(int row0, int col, float a, float b, float c, float d) const {
    if (col < HYC) {
      uint2 w;
      w.x = pack2(a, b);
      w.y = pack2(c, d);
      *(uint2*)(pT + (size_t)col * TG + row0) = w;
    } else if (col < DIN) {
      u16* q = p + (size_t)row0 * DINP + (col - HYC);
      q[0] = f2bf(a);
      q[DINP] = f2bf(b);
      q[2 * DINP] = f2bf(c);
      q[3 * DINP] = f2bf(d);
    }
  }
  DI void pair(int, int, float, float) const {}
};
struct EpiLoraW {
  u16* C; const float* w0;
  DI void operator()(int row, int col, float v) const {
    float zz = -(w0[col] + v);
    float sp = fmaxf(zz, 0.f) + log1pf(expf(-fabsf(zz)));
    C[(size_t)row * 256 + col] = f2bf(-expm1f(-expf(-sp - 0.5f)));
  }
  DI void pair(int, int, float, float) const {}
  EPI_DEFAULT_QUAD
};
struct EpiLoraA {
  u16* C; const float* a0;
  DI void operator()(int row, int col, float v) const { C[(size_t)row * 256 + col] = f2bf(sigmoidf_(a0[col] + v)); }
  DI void pair(int, int, float, float) const {}
  EPI_DEFAULT_QUAD
};

struct MixBufs {
  u16 *p, *pt, *u, *qg, *kg, *vtg, *cqn, *ckvn, *qup, *kvup, *qm, *km, *vtm, *rr, *rk, *rv, *rkk, *lwf, *lwb, *laf, *lab, *lg, *ef, *eb, *af, *ab, *gg;
  float *yf, *yb;
};
DI MixBufs mixbufs(char* big, int g) {
  MixBufs m;
  m.p = (u16*)(big + M_P); m.pt = (u16*)(big + M_PT); m.u = (u16*)(big + M_U);
  m.cqn = (u16*)(big + M_CQN); m.ckvn = (u16*)(big + M_CKVN); m.qup = (u16*)(big + M_QUP);
  m.kvup = (u16*)(big + M_KVUP); m.qm = (u16*)(big + M_QM); m.km = (u16*)(big + M_KM); m.vtm = (u16*)(big + M_VTM);
  m.lwf = (u16*)(big + M_LWF); m.lwb = (u16*)(big + M_LWB); m.laf = (u16*)(big + M_LAF); m.lab = (u16*)(big + M_LAB);
  m.lg = (u16*)(big + M_LG);
  char* sc = big + M_SCAN + (size_t)g * SCAN_STRIDE;
  m.rr = (u16*)(sc + 0 * SZ_SC); m.rk = (u16*)(sc + 1 * SZ_SC); m.rv = (u16*)(sc + 2 * SZ_SC); m.rkk = (u16*)(sc + 3 * SZ_SC);
  m.ef = (u16*)(sc + 4 * SZ_SC); m.eb = (u16*)(sc + 5 * SZ_SC); m.af = (u16*)(sc + 6 * SZ_SC); m.ab = (u16*)(sc + 7 * SZ_SC);
  m.gg = (u16*)(sc + 8 * SZ_SC);
  m.qg = (u16*)(sc + 9 * SZ_SC); m.kg = (u16*)(sc + 10 * SZ_SC); m.vtg = m.kg + (size_t)TG * 128;
  m.yf = (float*)(big + M_P) + (size_t)g * 2 * TG * 256;
  m.yb = m.yf + (size_t)TG * 256;
  return m;
}

DI void prep_phase(const Params& p, int l, int g, const MixBufs& m, const float2* __restrict__ ropeg, char* smem) {
  const int tid = ltid(), lane = tid & 63, wave = tid >> 6;
  const float* mu = p.rw_mu + l * 1152;
  for (int rl = blockIdx.x * 4 + wave; rl < TG; rl += gridDim.x * 4) {
    const int r = g * TG + rl;
    const int b = r / LT, j = r - b * LT, bl = b - g * BG;
    const bool lat = j >= LC;
    const bool hp = lat ? (j > LC) : (j > 0);
    const bool hn = lat ? (j < LT - 1) : (j < LC - 1);
    const u16* pc = m.p + (size_t)rl * DINP;
    const u16* pp = pc - DINP;
    const u16* pn = pc + DINP;
    auto tshift = [&](int crel) -> float {
      const int c = 1696 - HYC + crel;
      float u0 = bf2f(pc[c]);
      float nb = 0.f;
      if (hp) nb += bf2f(pp[c]);
      if (hn) nb += bf2f(pn[c]);
      return u0 + mu[crel] * (0.5f * nb - u0);
    };
#pragma unroll
    for (int hd = 0; hd < 4; ++hd) {
      const int c = hd * 64 + lane;
      const float sr = tshift(c), sk = tshift(256 + c), sv = tshift(512 + c);
      m.rr[(size_t)rl * 256 + c] = f2bf(sr);
      m.rk[(size_t)rl * 256 + c] = f2bf(sk);
      m.rv[(size_t)rl * 256 + c] = f2bf(sv);
      const float kx = sk * p.rw_k_k[l * 256 + c];
      const float ss = wave_sum(kx * kx);
      m.rkk[(size_t)rl * 256 + c] = f2bf(kx / fmaxf(sqrtf(ss), 1e-12f));
    }
    {
      const float s0 = tshift(768 + lane), s1 = tshift(832 + lane), s2 = tshift(896 + lane), s3 = tshift(960 + lane);
      const float s4 = tshift(1024 + lane), s5 = tshift(1088 + lane);
      m.lwf[(size_t)rl * 64 + lane] = f2bf(tanhf(s0));
      m.lwb[(size_t)rl * 64 + lane] = f2bf(tanhf(s1));
      m.laf[(size_t)rl * 64 + lane] = f2bf(s2);
      m.lab[(size_t)rl * 64 + lane] = f2bf(s3);
      m.lg[(size_t)rl * 128 + lane] = f2bf(sigmoidf_(s4));
      m.lg[(size_t)rl * 128 + 64 + lane] = f2bf(sigmoidf_(s5));
    }
    {
      float cq[4], ckv[2];
      float s1 = 0.f, s2 = 0.f;
#pragma unroll
      for (int q = 0; q < 4; ++q) { cq[q] = bf2f(pc[1280 - HYC + lane + 64 * q]); s1 += cq[q] * cq[q]; }
#pragma unroll
      for (int q = 0; q < 2; ++q) { ckv[q] = bf2f(pc[1536 - HYC + lane + 64 * q]); s2 += ckv[q] * ckv[q]; }
      s1 = wave_sum(s1);
      s2 = wave_sum(s2);
      const float r1 = rsqrtf(s1 * (1.f / 256.f) + EPS), r2 = rsqrtf(s2 * (1.f / 128.f) + EPS);
#pragma unroll
      for (int q = 0; q < 4; ++q) m.cqn[(size_t)rl * 256 + lane + 64 * q] = f2bf(cq[q] * r1 * p.mla_cq_norm[l * 256 + lane + 64 * q]);
#pragma unroll
      for (int q = 0; q < 2; ++q) m.ckvn[(size_t)rl * 128 + lane + 64 * q] = f2bf(ckv[q] * r2 * p.mla_ckv_norm[l * 128 + lane + 64 * q]);
    }
    const float2* rt = ropeg + (size_t)(lat ? j - LC : 0) * 32;
    const float gq_ = p.gqa_q_norm[l * 64 + lane], gk_ = p.gqa_k_norm[l * 64 + lane];
#pragma unroll
    for (int hh = 0; hh < 6; ++hh) {
      float val = bf2f(pc[hh * 64 + lane]);
      const float ss = wave_sum(val * val);
      val = val * rsqrtf(ss * (1.f / 64.f) + EPS) * (hh < 4 ? gq_ : gk_);
      const float rv = rope_tab(val, lane, rt, lane);
      if (lat) val = rv;
      if (hh < 4) m.qg[(size_t)rl * 256 + hh * 64 + lane] = f2bf(val);
      else m.kg[(size_t)rl * 128 + (hh - 4) * 64 + lane] = f2bf(val);
    }
#pragma unroll
    for (int kvh = 0; kvh < 2; ++kvh) m.vtg[((size_t)(bl * 2 + kvh) * 64 + lane) * LT + j] = pc[1152 - HYC + kvh * 64 + lane];
  }
}

DI void mla_fin_phase(const Params& p, int l, int g, const MixBufs& m, const float2* __restrict__ ropem) {
  const int tid = ltid(), lane = tid & 63, wave = tid >> 6;
  for (int rl = blockIdx.x; rl < TG; rl += gridDim.x) {
    const int r = g * TG + rl;
    const int b = r / LT, j = r - b * LT, bl = b - g * BG;
    const bool lat = j >= LC;
    for (int s = wave; s < 8; s += 4) {
      const int hd = s & 3;
      const bool isq = s < 4;
      float x0, x1;
      if (isq) {
        x0 = bf2f(m.qup[(size_t)rl * 384 + hd * 96 + lane]);
        x1 = lane < 32 ? bf2f(m.qup[(size_t)rl * 384 + hd * 96 + 64 + lane]) : 0.f;
      } else {
        x0 = bf2f(m.kvup[(size_t)rl * 512 + hd * 128 + lane]);
        x1 = lane < 32 ? bf2f(m.p[(size_t)rl * DINP + 1664 - HYC + lane]) : 0.f;
      }
      float ss = wave_sum(x0 * x0 + x1 * x1);
      const float rstd = rsqrtf(ss * (1.f / 96.f) + EPS);
      const float* gn = isq ? p.mla_q_norm + l * 96 : p.mla_k_norm + l * 96;
      float y0 = x0 * rstd * gn[lane];
      float y1 = lane < 32 ? x1 * rstd * gn[64 + lane] : 0.f;
      float ry = rope_tab(y1, lane & 31, ropem + (size_t)(lat ? j - LC : 0) * 16, lane);
      if (lat) y1 = ry;
      u16* dst = (isq ? m.qm : m.km) + (size_t)rl * 384 + hd * 96;
      dst[lane] = f2bf(y0);
      if (lane < 32) dst[64 + lane] = f2bf(y1);
      if (!isq) m.vtm[((size_t)(bl * 4 + hd) * 64 + lane) * LT + j] = m.kvup[(size_t)rl * 512 + hd * 128 + 64 + lane];
    }
  }
}

template <int DQK, int QT>
DI void attn_item(const u16* __restrict__ q, int ldq, const u16* __restrict__ k, int ldk, const u16* __restrict__ vT,
                  u16* __restrict__ out, int ldo, int nkeys, float sl2, float sh2, char* smem) {
  constexpr int KS = DQK + 8;
  constexpr int NKS = DQK / 16;
  constexpr int KCH = DQK / 8;
  constexpr int KPT = 64 * KCH / NTHR;
  u16* Ks = (u16*)smem;
  u16* Vs = Ks + 2 * 64 * KS;
  const int tid = ltid(), lane = tid & 63, wave = tid >> 6, lr = lane & 31, lh = lane >> 5;
  bf16x8 qf[QT][NKS];
#pragma unroll
  for (int qt = 0; qt < QT; ++qt)
#pragma unroll
    for (int ks = 0; ks < NKS; ++ks)
      qf[qt][ks] = *(const bf16x8*)(q + (size_t)(wave * 32 * QT + qt * 32 + lr) * ldq + ks * 16 + lh * 8);
  f32x16 o[QT][2];
#pragma unroll
  for (int a = 0; a < QT; ++a)
#pragma unroll
    for (int b = 0; b < 2; ++b)
#pragma unroll
      for (int i = 0; i < 16; ++i) o[a][b][i] = 0.f;
  float lsum[QT];
#pragma unroll
  for (int a = 0; a < QT; ++a) lsum[a] = 0.f;
  uint4 rk[KPT], rv[2];
#define ATT_GLOAD(key0)                                                                   \
  {                                                                                       \
    _Pragma("unroll") for (int i = 0; i < KPT; ++i) {                                     \
      const int id = tid + NTHR * i, row = id / KCH, ch = id - row * KCH;                 \
      rk[i] = *(const uint4*)(k + (size_t)((key0) + row) * ldk + ch * 8);                 \
    }                                                                                     \
    _Pragma("unroll") for (int i = 0; i < 2; ++i) {                                       \
      const int id = tid + NTHR * i, row = id >> 3, ch = id & 7;                          \
      rv[i] = *(const uint4*)(vT + (size_t)row * LT + (key0) + ch * 8);                   \
    }                                                                                     \
  }
#define ATT_LSTORE(buf_)                                                                  \
  {                                                                                       \
    _Pragma("unroll") for (int i = 0; i < KPT; ++i) {                                     \
      const int id = tid + NTHR * i, row = id / KCH, ch = id - row * KCH;                 \
      *(uint4*)(Ks + (buf_) * 64 * KS + row * KS + ch * 8) = rk[i];                       \
    }                                                                                     \
    _Pragma("unroll") for (int i = 0; i < 2; ++i) {                                       \
      const int id = tid + NTHR * i, row = id >> 3, ch = id & 7;                          \
      *(uint4*)(Vs + (buf_) * 64 * 72 + row * 72 + ch * 8) = rv[i];                       \
    }                                                                                     \
  }
  ATT_GLOAD(0);
  ATT_LSTORE(0);
  __syncthreads();
  const int nkt = nkeys >> 6;
  for (int kt = 0; kt < nkt; ++kt) {
    const int buf = kt & 1;
    if (kt + 1 < nkt) ATT_GLOAD((kt + 1) << 6);
    const u16* kb = Ks + buf * 64 * KS;
    const u16* vb = Vs + buf * 64 * 72;
#pragma unroll
    for (int half = 0; half < 2; ++half) {
      f32x16 s[QT];
#pragma unroll
      for (int qt = 0; qt < QT; ++qt)
#pragma unroll
        for (int i = 0; i < 16; ++i) s[qt][i] = 0.f;
      bf16x8 kf[NKS];
#pragma unroll
      for (int ks = 0; ks < NKS; ++ks) kf[ks] = *(const bf16x8*)(kb + (half * 32 + lr) * KS + ks * 16 + lh * 8);
#pragma unroll
      for (int ks = 0; ks < NKS; ++ks) {
#pragma unroll
        for (int qt = 0; qt < QT; ++qt) s[qt] = MFMA32(kf[ks], qf[qt][ks], s[qt]);
      }
#pragma unroll
      for (int qt = 0; qt < QT; ++qt)
#pragma unroll
        for (int i = 0; i < 16; ++i) {
          float pv = __builtin_amdgcn_exp2f(s[qt][i] * sl2 - sh2);
          lsum[qt] += pv;
          s[qt][i] = pv;
        }
#pragma unroll
      for (int st = 0; st < 2; ++st) {
        bf16x8 pb[QT];
#pragma unroll
        for (int qt = 0; qt < QT; ++qt) {
          uint4 w;
          w.x = pack2(s[qt][8 * st + 0], s[qt][8 * st + 1]);
          w.y = pack2(s[qt][8 * st + 2], s[qt][8 * st + 3]);
          w.z = pack2(s[qt][8 * st + 4], s[qt][8 * st + 5]);
          w.w = pack2(s[qt][8 * st + 6], s[qt][8 * st + 7]);
          pb[qt] = __builtin_bit_cast(bf16x8, w);
        }
        bf16x8 vf[2];
#pragma unroll
        for (int mt = 0; mt < 2; ++mt) {
          const u16* vp = vb + (mt * 32 + lr) * 72 + half * 32 + st * 16 + lh * 4;
          uint2 v0 = *(const uint2*)(vp);
          uint2 v1 = *(const uint2*)(vp + 8);
          uint4 w;
          w.x = v0.x; w.y = v0.y; w.z = v1.x; w.w = v1.y;
          vf[mt] = __builtin_bit_cast(bf16x8, w);
        }
#pragma unroll
        for (int mt = 0; mt < 2; ++mt) {
#pragma unroll
          for (int qt = 0; qt < QT; ++qt) o[qt][mt] = MFMA32(vf[mt], pb[qt], o[qt][mt]);
        }
      }
    }
    if (kt + 1 < nkt) ATT_LSTORE(buf ^ 1);
    __syncthreads();
  }
#pragma unroll
  for (int qt = 0; qt < QT; ++qt) {
    float tot = lsum[qt] + __shfl_xor(lsum[qt], 32);
    float inv = 1.f / tot;
    const int row = wave * 32 * QT + qt * 32 + lr;
#pragma unroll
    for (int mt = 0; mt < 2; ++mt)
#pragma unroll
      for (int gq = 0; gq < 4; ++gq) {
        uint2 w;
        w.x = pack2(o[qt][mt][4 * gq + 0] * inv, o[qt][mt][4 * gq + 1] * inv);
        w.y = pack2(o[qt][mt][4 * gq + 2] * inv, o[qt][mt][4 * gq + 3] * inv);
        *(uint2*)(out + (size_t)row * ldo + mt * 32 + 8 * gq + 4 * lh) = w;
      }
  }
}

DI void hyena_pass(const Params& p, int l, const MixBufs& m, const float* __restrict__ gT, int L, int segoff, int c, char* smem) {
  const int RS = L + 16, US = L + 16;
  unsigned* Rc = (unsigned*)smem;
  u16* U = (u16*)(smem + (size_t)2 * RS * 4);
  const int tid = ltid(), lane = tid & 63, wave = tid >> 6;
  for (int d = tid; d < L; d += NTHR) {
    const int q = 2 * d;
    const float r0 = gT[(size_t)(2 * L - 2 - q) * 256 + c];
    const float r1 = (q + 1 <= 2 * L - 2) ? gT[(size_t)(2 * L - 3 - q) * 256 + c] : 0.f;
    const float r2 = (q + 2 <= 2 * L - 2) ? gT[(size_t)(2 * L - 4 - q) * 256 + c] : 0.f;
    Rc[d] = pack2(r0, r1);
    Rc[RS + d] = pack2(r1, r2);
  }
  const float* cw = p.hy_conv_w + l * 3 * 768;
  const float* cb = p.hy_conv_b + l * 768;
  {
    const float w0a = cw[c], w1a = cw[768 + c], w2a = cw[1536 + c], ba = cb[c];
    const float w0v = cw[512 + c], w1v = cw[768 + 512 + c], w2v = cw[1536 + 512 + c], bv = cb[512 + c];
    for (int b = 0; b < BG; ++b) {
      const u16* x1p = m.pt + (size_t)c * TG + b * LT + segoff;
      const u16* vp = m.pt + (size_t)(512 + c) * TG + b * LT + segoff;
      for (int t = tid; t < L; t += NTHR) {
        float x1 = bf2f(x1p[t]) * w1a + ba;
        float vv = bf2f(vp[t]) * w1v + bv;
        if (t > 0) { x1 += bf2f(x1p[t - 1]) * w0a; vv += bf2f(vp[t - 1]) * w0v; }
        if (t < L - 1) { x1 += bf2f(x1p[t + 1]) * w2a; vv += bf2f(vp[t + 1]) * w2v; }
        U[b * US + t] = f2bf(x1 * vv);
      }
    }
  }
  __syncthreads();
  const int i = lane & 31, h = lane >> 5, bn = i & 3, mb = i >> 2;
  const int par = (L - 1 - i) & 1;
  const float bias = p.hy_bias[l * 256 + c];
  const float w0x = cw[256 + c], w1x = cw[768 + 256 + c], w2x = cw[1536 + 256 + c], bx = cb[256 + c];
  const int nsteps = (L + 208) / 16 + 1;
  for (int sp = wave; sp < L / 256; sp += 4) {
    const int T0 = sp * 256;
    f32x16 acc;
#pragma unroll
    for (int r = 0; r < 16; ++r) acc[r] = 0.f;
    const int delta0 = T0 + 224;
    const int q0 = (L - 1) - delta0 - i + 8 * h;
    const unsigned* ap = Rc + par * RS + (q0 >> 1);
    int s0 = T0 + 32 * mb - delta0;
    const u16* bp = U + bn * US + s0 + 8 * h;
#pragma unroll 2
    for (int st = 0; st < nsteps; ++st) {
      uint4 aw;
      aw.x = ap[0]; aw.y = ap[1]; aw.z = ap[2]; aw.w = ap[3];
      uint4 bw = make_uint4(0u, 0u, 0u, 0u);
      if (s0 >= 0 && s0 <= L - 16) bw = *(const uint4*)bp;
      acc = MFMA32(__builtin_bit_cast(bf16x8, aw), __builtin_bit_cast(bf16x8, bw), acc);
      ap += 8;
      s0 += 16;
      bp += 16;
    }
    const u16* x2p = m.pt + (size_t)(256 + c) * TG + bn * LT + segoff;
    u16* yp = m.u + (size_t)c * TG + bn * LT + segoff;
#pragma unroll
    for (int gq = 0; gq < 4; ++gq) {
      const int t4 = T0 + 32 * mb + 8 * gq + 4 * h;
      float e[6];
#pragma unroll
      for (int k = 0; k < 6; ++k) {
        const int tt = t4 - 1 + k;
        e[k] = (tt >= 0 && tt < L) ? bf2f(x2p[tt]) : 0.f;
      }
      const uint2 uu = *(const uint2*)(U + bn * US + t4);
      const float u0 = bflo_(uu.x), u1 = bfhi_(uu.x), u2 = bflo_(uu.y), u3 = bfhi_(uu.y);
      const float y0 = (e[0] * w0x + e[1] * w1x + e[2] * w2x + bx) * (acc[4 * gq + 0] + u0 * bias);
      const float y1 = (e[1] * w0x + e[2] * w1x + e[3] * w2x + bx) * (acc[4 * gq + 1] + u1 * bias);
      const float y2 = (e[2] * w0x + e[3] * w1x + e[4] * w2x + bx) * (acc[4 * gq + 2] + u2 * bias);
      const float y3 = (e[3] * w0x + e[4] * w1x + e[5] * w2x + bx) * (acc[4 * gq + 3] + u3 * bias);
      uint2 w;
      w.x = pack2(y0, y1);
      w.y = pack2(y2, y3);
      *(uint2*)(yp + t4) = w;
    }
  }
  __syncthreads();
}

#define DPP_ROR(v, n) __builtin_bit_cast(float, __builtin_amdgcn_update_dpp(0, __builtin_bit_cast(int, (v)), 0x120 + (n), 0xf, 0xf, true))
DI float row_allsum(float v) {
  v += DPP_ROR(v, 8);
  v += DPP_ROR(v, 4);
  v += DPP_ROR(v, 2);
  v += DPP_ROR(v, 1);
  return v;
}
DI float bflo(unsigned w) { return __uint_as_float(w << 16); }
DI float bfhi(unsigned w) { return __uint_as_float(w & 0xffff0000u); }
DI void scan_item(const Params& p, int l, const MixBufs& m, int bl, int hd, int dir, int rq, char* smem) {
  constexpr int TC = 16;
  constexpr int NCH = LT / TC;
  constexpr int BUF = 5 * TC * 64 + TC * 16;
  float* sbase = (float*)smem;
  float* sy = sbase + 2 * BUF;
  const int tid = ltid(), lane = tid & 63, wave = tid >> 6;
  const int kq = lane & 15, rloc = wave * 4 + (lane >> 4);
  const u16* eD = dir ? m.eb : m.ef;
  const u16* aD = dir ? m.ab : m.af;
  float* yD = dir ? m.yb : m.yf;
  const size_t rbase = (size_t)bl * LT;
  const int ss = tid >> 4, su = tid & 15, sc = su & 7;
  float kav[8];
#pragma unroll
  for (int i = 0; i < 8; ++i) kav[i] = p.rw_k_a[l * 256 + hd * 64 + sc * 8 + i];
  uint4 g0, g1, g2;
  g2.x = g2.y = g2.z = g2.w = 0u;
#define SCAN_JMAP(i) (dir ? ((i) < LC ? LC - 1 - (i) : LT - 1 - ((i) - LC)) : (i))
#define SCAN_GLOAD(i0)                                                                         \
  {                                                                                            \
    const int ii_ = (i0) + ss;                                                                 \
    const int j_ = SCAN_JMAP(ii_);                                                             \
    const size_t o_ = (rbase + j_) * 256 + hd * 64 + sc * 8;                                   \
    if (su < 8) {                                                                              \
      g0 = *(const uint4*)(m.rkk + o_);                                                        \
      g1 = *(const uint4*)(aD + o_);                                                           \
      g2 = *(const uint4*)(m.rk + o_);                                                         \
    } else {                                                                                   \
      g0 = *(const uint4*)(eD + o_);                                                           \
      g1 = *(const uint4*)(m.rr + o_);                                                         \
      if (sc < 2) g2 = *(const uint4*)(m.rv + (rbase + j_) * 256 + hd * 64 + rq * 16 + sc * 8); \
    }                                                                                          \
  }
#define SCAN_LSTORE(buf_)                                                                      \
  {                                                                                            \
    float* B_ = sbase + (buf_) * BUF;                                                          \
    const unsigned w0_[4] = {g0.x, g0.y, g0.z, g0.w};                                          \
    const unsigned w1_[4] = {g1.x, g1.y, g1.z, g1.w};                                          \
    const unsigned w2_[4] = {g2.x, g2.y, g2.z, g2.w};                                          \
    if (su < 8) {                                                                              \
      float kk_[8], bb_[8], dd_[8];                                                            \
      _Pragma("unroll") for (int q_ = 0; q_ < 4; ++q_) {                                       \
        const float k0_ = bflo(w0_[q_]), k1_ = bfhi(w0_[q_]);                                  \
        const float a0_ = bflo(w1_[q_]), a1_ = bfhi(w1_[q_]);                                  \
        const float v0_ = bflo(w2_[q_]), v1_ = bfhi(w2_[q_]);                                  \
        kk_[2 * q_] = k0_; kk_[2 * q_ + 1] = k1_;                                              \
        bb_[2 * q_] = k0_ * a0_; bb_[2 * q_ + 1] = k1_ * a1_;                                  \
        dd_[2 * q_] = v0_ * (1.f + (a0_ - 1.f) * kav[2 * q_]);                                 \
        dd_[2 * q_ + 1] = v1_ * (1.f + (a1_ - 1.f) * kav[2 * q_ + 1]);                         \
      }                                                                                        \
      float* d0_ = B_ + ss * 64 + sc * 8;                                                      \
      *(float4*)(d0_) = make_float4(kk_[0], kk_[1], kk_[2], kk_[3]);                           \
      *(float4*)(d0_ + 4) = make_float4(kk_[4], kk_[5], kk_[6], kk_[7]);                       \
      *(float4*)(d0_ + 2048) = make_float4(bb_[0], bb_[1], bb_[2], bb_[3]);                    \
      *(float4*)(d0_ + 2052) = make_float4(bb_[4], bb_[5], bb_[6], bb_[7]);                    \
      *(float4*)(d0_ + 3072) = make_float4(dd_[0], dd_[1], dd_[2], dd_[3]);                    \
      *(float4*)(d0_ + 3076) = make_float4(dd_[4], dd_[5], dd_[6], dd_[7]);                    \
    } else {                                                                                   \
      float ww_[8], rr_[8], vv_[8];                                                            \
      _Pragma("unroll") for (int q_ = 0; q_ < 4; ++q_) {                                       \
        ww_[2 * q_] = 1.f - bflo(w0_[q_]); ww_[2 * q_ + 1] = 1.f - bfhi(w0_[q_]);              \
        rr_[2 * q_] = bflo(w1_[q_]); rr_[2 * q_ + 1] = bfhi(w1_[q_]);                          \
        vv_[2 * q_] = bflo(w2_[q_]); vv_[2 * q_ + 1] = bfhi(w2_[q_]);                          \
      }                                                                                        \
      float* d0_ = B_ + ss * 64 + sc * 8;                                                      \
      *(float4*)(d0_ + 1024) = make_float4(ww_[0], ww_[1], ww_[2], ww_[3]);                    \
      *(float4*)(d0_ + 1028) = make_float4(ww_[4], ww_[5], ww_[6], ww_[7]);                    \
      *(float4*)(d0_ + 4096) = make_float4(rr_[0], rr_[1], rr_[2], rr_[3]);                    \
      *(float4*)(d0_ + 4100) = make_float4(rr_[4], rr_[5], rr_[6], rr_[7]);                    \
      if (sc < 2) {                                                                            \
        float* d1_ = B_ + 5120 + ss * 16 + sc * 8;                                             \
        *(float4*)(d1_) = make_float4(vv_[0], vv_[1], vv_[2], vv_[3]);                         \
        *(float4*)(d1_ + 4) = make_float4(vv_[4], vv_[5], vv_[6], vv_[7]);                     \
      }                                                                                        \
    }                                                                                          \
  }
  f32x2_t SA = {0.f, 0.f}, SB = {0.f, 0.f};
  __builtin_amdgcn_s_setprio(3);
  SCAN_GLOAD(0);
  SCAN_LSTORE(0);
  __syncthreads();
  for (int c = 0; c < NCH; ++c) {
    const int buf = c & 1;
    if (c + 1 < NCH) SCAN_GLOAD((c + 1) * TC);
    const float* B = sbase + buf * BUF;
    float* syb = sy + buf * TC * 16;
    float ypart[TC];
    float4 kkv[TC], wwv[TC], bbv[TC], ddv[TC], rrv[TC];
    float vvv[TC];
    constexpr int PF = 2;
#pragma unroll
    for (int st = 0; st < PF; ++st) {
      kkv[st] = *(const float4*)(B + st * 64 + kq * 4);
      wwv[st] = *(const float4*)(B + 1024 + st * 64 + kq * 4);
      bbv[st] = *(const float4*)(B + 2048 + st * 64 + kq * 4);
      ddv[st] = *(const float4*)(B + 3072 + st * 64 + kq * 4);
      rrv[st] = *(const float4*)(B + 4096 + st * 64 + kq * 4);
      vvv[st] = B[5120 + st * 16 + rloc];
    }
    __builtin_amdgcn_sched_barrier(0);
#pragma unroll
    for (int st = 0; st < TC; ++st) {
      if (st + PF < TC) {
        kkv[st + PF] = *(const float4*)(B + (st + PF) * 64 + kq * 4);
        wwv[st + PF] = *(const float4*)(B + 1024 + (st + PF) * 64 + kq * 4);
        bbv[st + PF] = *(const float4*)(B + 2048 + (st + PF) * 64 + kq * 4);
        ddv[st + PF] = *(const float4*)(B + 3072 + (st + PF) * 64 + kq * 4);
        rrv[st + PF] = *(const float4*)(B + 4096 + (st + PF) * 64 + kq * 4);
        vvv[st + PF] = B[5120 + (st + PF) * 16 + rloc];
      }
      __builtin_amdgcn_sched_barrier(0);
      const float4 kk = kkv[st], ww = wwv[st], bb = bbv[st], dd = ddv[st], rr = rrv[st];
      const float vv = vvv[st];
      const f32x2_t k01 = {kk.x, kk.y}, k23 = {kk.z, kk.w}, w01 = {ww.x, ww.y}, w23 = {ww.z, ww.w};
      const f32x2_t b01 = {bb.x, bb.y}, b23 = {bb.z, bb.w}, d01 = {dd.x, dd.y}, d23 = {dd.z, dd.w};
      const f32x2_t r01 = {rr.x, rr.y}, r23 = {rr.z, rr.w}, v2 = {vv, vv};
      const f32x2_t pp2 = SA * k01 + SB * k23;
      const float part = pp2.x + pp2.y;
      const f32x2_t cA = SA * w01 + v2 * d01, cB = SB * w23 + v2 * d23;
      const float sa = -row_allsum(part);
      const f32x2_t sa2 = {sa, sa};
      SA = cA + sa2 * b01;
      SB = cB + sa2 * b23;
      const f32x2_t yy2 = SA * r01 + SB * r23;
      ypart[st] = yy2.x + yy2.y;
    }
#pragma unroll
    for (int st = 0; st < TC; ++st) ypart[st] = row_allsum(ypart[st]);
    if (kq == 0) {
#pragma unroll
      for (int st = 0; st < TC; ++st) syb[st * 16 + rloc] = ypart[st];
    }
    if (c + 1 < NCH) SCAN_LSTORE(buf ^ 1);
    __syncthreads();
    {
      const int st = tid >> 4, r_ = tid & 15;
      const int ii = c * TC + st;
      const int j = SCAN_JMAP(ii);
      yD[(rbase + j) * 256 + hd * 64 + rq * 16 + r_] = syb[st * 16 + r_];
    }
  }
  __builtin_amdgcn_s_setprio(0);
  __syncthreads();
}

DI void readout_hy_phase(int g, const MixBufs& m, u16* __restrict__ ymix, bool skip_ctx, char* smem) {
  const int tid = ltid();
  {
    u16* tile = (u16*)smem;
    for (int tl = blockIdx.x; tl < (TG / 64) * 4; tl += gridDim.x) {
      const int rl0 = (tl >> 2) * 64, c0 = (tl & 3) * 64;
      const int r0 = g * TG + rl0;
      if (skip_ctx && (r0 % LT) < LC) continue;
#pragma unroll
      for (int k = 0; k < 2; ++k) {
        const int id = tid + NTHR * k, ch = id >> 3, part = id & 7;
        *(uint4*)(tile + ch * 72 + part * 8) = *(const uint4*)(m.u + (size_t)(c0 + ch) * TG + rl0 + part * 8);
      }
      __syncthreads();
#pragma unroll
      for (int k = 0; k < 2; ++k) {
        const int id = tid + NTHR * k, tok = id >> 3, part = id & 7;
        const u16* tp = tile + (part * 8) * 72 + tok;
        uint4 w;
        w.x = (unsigned)tp[0] | ((unsigned)tp[72] << 16);
        w.y = (unsigned)tp[2 * 72] | ((unsigned)tp[3 * 72] << 16);
        w.z = (unsigned)tp[4 * 72] | ((unsigned)tp[5 * 72] << 16);
        w.w = (unsigned)tp[6 * 72] | ((unsigned)tp[7 * 72] << 16);
        *(uint4*)(ymix + (size_t)(r0 + tok) * D + c0 + part * 8) = w;
      }
      __syncthreads();
    }
  }
}

DI void readout_rw_phase(const Params& p, int l, int g, const MixBufs& m, u16* __restrict__ ymix, bool skip_ctx) {
  const int tid = ltid();
  for (int rl = blockIdx.x; rl < TG; rl += gridDim.x) {
    const int r = g * TG + rl;
    const int j = r % LT;
    if (skip_ctx && j < LC) continue;
    const size_t o = (size_t)rl * 256 + tid;
    float y = m.yf[o] + m.yb[o];
    float mean = wave_sum(y) * (1.f / 64.f);
    float dv = y - mean;
    float var = wave_sum(dv * dv) * (1.f / 64.f);
    float yn = dv * rsqrtf(var + 64e-5f) * p.rw_ln_w[l * 256 + tid] + p.rw_ln_b[l * 256 + tid];
    const float rr = bf2f(m.rr[o]), kv = bf2f(m.rk[o]), vv = bf2f(m.rv[o]);
    const float kaa = p.rw_k_a[l * 256 + tid], rk = p.rw_r_k[l * 256 + tid];
    const float af = bf2f(m.af[o]), ab = bf2f(m.ab[o]);
    float t1 = rr * kv * (1.f + (af - 1.f) * kaa) * rk + rr * kv * (1.f + (ab - 1.f) * kaa) * rk;
    float bonus = wave_sum(t1) * vv;
    ymix[(size_t)r * D + 768 + tid] = f2bf((yn + bonus) * bf2f(m.gg[o]));
  }
}

#define XB_TMO      128
#define XB_XCNT(j)  (256  + 64 * (j))
#define XB_XSUB(j)  (1280 + 64 * (j))
#define XB_XGEN(j)  (2304 + 64 * (j))
#define XB_TOP      3328
#define XB_TOPGEN   3392
#define XCD_BAR_WORDS 3456
#define XB_SPIN_CAP (1u << 21)
#define LAS __attribute__((address_space(3)))
DI unsigned xb_ld(unsigned* p) { return __hip_atomic_load(p, __ATOMIC_RELAXED, __HIP_MEMORY_SCOPE_AGENT); }
DI unsigned xb_add(unsigned* p, unsigned v) { return __hip_atomic_fetch_add(p, v, __ATOMIC_RELAXED, __HIP_MEMORY_SCOPE_AGENT); }
DI unsigned xb_xcc_id() { return (unsigned)__builtin_amdgcn_s_getreg((3 << 11) | 20) & 0xFu; }
#define XB_SPIN(cond, bar) do { unsigned _sp = 0; while (cond) { __builtin_amdgcn_s_sleep(1); \
    if ((++_sp & 255u) == 0u) { if (xb_ld(&(bar)[XB_TMO])) break; if (_sp > XB_SPIN_CAP) { atomicAdd(&(bar)[XB_TMO], 1u); break; } } } } while (0)
struct XcdBarrier { unsigned* bar; unsigned x; volatile LAS unsigned* st; };
DI XcdBarrier xcd_barrier_post(unsigned* bar, volatile LAS unsigned* st) {
  XcdBarrier b; b.bar = bar; b.x = xb_xcc_id(); b.st = st;
  if (threadIdx.x == 0) (void)xb_add(&bar[XB_XCNT(b.x)], 1u);
  return b;
}
DI void xcd_barrier_complete(unsigned* bar, unsigned x, unsigned& nloc, unsigned& nx) {
  const unsigned G = gridDim.x * gridDim.y * gridDim.z;
  unsigned sum, cnt, mine, sp = 0u;
  for (;;) {
    sum = 0u; cnt = 0u; mine = 0u;
#pragma unroll
    for (unsigned j = 0; j < 16; ++j) { const unsigned c = xb_ld(&bar[XB_XCNT(j)]); sum += c; cnt += (c > 0u) ? 1u : 0u; mine = (j == x) ? c : mine; }
    if (sum == G) break;
    __builtin_amdgcn_s_sleep(1);
    if ((++sp & 255u) == 0u) { if (xb_ld(&bar[XB_TMO])) break; if (sp > XB_SPIN_CAP) { atomicAdd(&bar[XB_TMO], 1u); break; } }
  }
  nloc = mine > 0u ? mine : 1u; nx = cnt > 0u ? cnt : 1u;
}
DI void xcd_barrier(const XcdBarrier& b) {
  asm volatile("s_waitcnt vmcnt(0)" ::: "memory");
  __syncthreads();
  if (threadIdx.x == 0) {
    unsigned* bar = b.bar;
    __builtin_amdgcn_s_waitcnt(0);
    unsigned nloc = b.st[0], nx = b.st[1];
    if (nloc == 0u) { xcd_barrier_complete(bar, b.x, nloc, nx); b.st[0] = nloc; b.st[1] = nx; }
    const unsigned old = xb_add(&bar[XB_XSUB(b.x)], 1u);
    const unsigned gen = old / nloc;
    if (old + 1u == (gen + 1u) * nloc) {
      __builtin_amdgcn_fence(__ATOMIC_RELEASE, "agent");
      asm volatile("s_waitcnt vmcnt(0)" ::: "memory");
      const unsigned og = xb_add(&bar[XB_TOP], 1u);
      const unsigned tg = og / nx;
      if (og + 1u == (tg + 1u) * nx) xb_add(&bar[XB_TOPGEN], 1u);
      else XB_SPIN(xb_ld(&bar[XB_TOPGEN]) == tg, bar);
      __builtin_amdgcn_fence(__ATOMIC_ACQUIRE, "agent");
      xb_add(&bar[XB_XGEN(b.x)], 1u);
      asm volatile("s_waitcnt vmcnt(0)" ::: "memory");
    } else {
      XB_SPIN(xb_ld(&bar[XB_XGEN(b.x)]) == gen, bar);
      __builtin_amdgcn_fence(__ATOMIC_ACQUIRE, "agent");
      asm volatile("s_waitcnt vmcnt(0)" ::: "memory");
    }
  }
  __syncthreads();
}

DI void convert_layer(const Params& p, int l, u16* W, char* smem) {
  convT(p.ffn1_gate + (size_t)l * D * DFF, D, DFF, W + W_GU1, 1, smem);
  convT(p.ffn1_up + (size_t)l * D * DFF, D, DFF, W + W_GU1, 2, smem);
  convT(p.ffn1_down + (size_t)l * D * DFF, DFF, D, W + W_D1, 0, smem);
  convT(p.ffn2_gate + (size_t)l * D * DFF, D, DFF, W + W_GU2, 1, smem);
  convT(p.ffn2_up + (size_t)l * D * DFF, D, DFF, W + W_GU2, 2, smem);
  convT(p.ffn2_down + (size_t)l * D * DFF, DFF, D, W + W_D2, 0, smem);
  convT(p.w_in + (size_t)l * D * DIN, D, DIN, W + W_IN, 0, smem);
  convT(p.w_out + (size_t)l * D * D, D, D, W + W_OUT, 0, smem);
  convT(p.mla_w_uq + (size_t)l * 256 * 384, 256, 384, W + W_UQ, 0, smem);
  convT(p.mla_w_ukv + (size_t)l * 128 * 512, 128, 512, W + W_UKV, 0, smem);
  for (int d = 0; d < 2; ++d) {
    convT(p.rw_w2 + (size_t)(l * 2 + d) * 64 * 256, 64, 256, W + W_W2 + (size_t)d * 256 * 64, 0, smem);
    convT(p.rw_a2 + (size_t)(l * 2 + d) * 64 * 256, 64, 256, W + W_A2 + (size_t)d * 256 * 64, 0, smem);
  }
  convT(p.rw_g2 + (size_t)l * 128 * 256, 128, 256, W + W_G2, 0, smem);
}

__global__ void __launch_bounds__(NTHR, 2) fwd_megakernel(Params p) {
  cg::grid_group grid = cg::this_grid();
  __shared__ __attribute__((aligned(16))) char smem[73728];
  __shared__ int s_item;
  __shared__ uint4 xb_words;
  if (threadIdx.x == 0) xb_words = make_uint4(0u, 0u, 0u, 0u);
  __syncthreads();
  const XcdBarrier xb = xcd_barrier_post((unsigned*)(p.ws + OFF_BAR), (volatile LAS unsigned*)&xb_words);
  char* ws = p.ws;
  float* ctxs = (float*)(ws + OFF_CTX);
  float* mod = (float*)(ws + OFF_MOD);
  u16* hbuf = (u16*)(ws + OFF_H);
  char* big = ws + OFF_BIG;
  u16* Gbuf = (u16*)big;
  u16* const Wl = (u16*)(ws + OFF_W);
  float* const filt = (float*)(ws + OFF_FILT);

  convert_layer(p, 0, Wl, smem);
  hyfilt_phase(p, 0, LQ, filt, smem);
  hyfilt_phase(p, 0, LC, (float*)(ws + OFF_FILTC), smem);
  rope_table_phase((float2*)(ws + OFF_ROPEG), (float2*)(ws + OFF_ROPEM));
  mod_phase(p, mod, smem);
  grid.sync();

  for (int l = 0; l < 2; ++l) {
    const bool last = (l == 1);
    const u16* W = Wl;
    if (l == 1) {
      convert_layer(p, 1, Wl, smem);
      hyfilt_phase(p, 1, LQ, filt, smem);
      xcd_barrier(xb);
    }
    const float* modl = mod + (size_t)l * 9 * 9216;
    const float* lat_in = (l == 0) ? p.x : p.out;
    const float* ctx_in = (l == 0) ? p.ctx : ctxs;

    adaln_phase(lat_in, ctx_in, p.norm_ffn1 + l * D, modl, 0, hbuf, false);
    xcd_barrier(xb);
    {
      EpiGU e{Gbuf};
      for (int rep = 0; rep < REP_GU; ++rep) gemm_phase<true>(hbuf, D, W + W_GU1, D, D, T / 128, 44, 0, false, smem, e);
    }
    xcd_barrier(xb);
    {
      EpiRes e{lat_in, ctx_in, p.out, ctxs, modl, 2, 0.5f, nullptr, nullptr, nullptr, 0};
      gemm_phase<false>(Gbuf, DFF, W + W_D1, DFF, DFF, T / 128, 8, 0, false, smem, e);
    }
    xcd_barrier(xb);
    adaln_phase(p.out, ctxs, p.norm_mix + l * D, modl, 1, hbuf, false);
    xcd_barrier(xb);
    for (int g = 0; g < NG; ++g) {
      const MixBufs m = mixbufs(big, g);
      const u16* hg = hbuf + (size_t)g * TG * D;
      {
        EpiWin e{m.p, m.pt};
        gemm_phase<false>(hg, D, W + W_IN, D, D, TG / 128, 23, 0, false, smem, e);
      }
      xcd_barrier(xb);
      for (int rep = 0; rep < REP_ROW; ++rep) prep_phase(p, l, g, m, (const float2*)(ws + OFF_ROPEG), smem);
      xcd_barrier(xb);
      {
        EpiStore e1{m.qup, 384, 384};
        gemm_phase<false>(m.cqn, 256, W + W_UQ, 256, 256, TG / 128, 3, 0, false, smem, e1);
        EpiStore e2{m.kvup, 512, 512};
        gemm_phase<false>(m.ckvn, 128, W + W_UKV, 128, 128, TG / 128, 4, 0, false, smem, e2);
        EpiLoraW e3{m.ef, p.rw_w0 + (l * 2 + 0) * 256};
        gemm_phase<false>(m.lwf, 64, W + W_W2, 64, 64, TG / 128, 2, 0, false, smem, e3);
        EpiLoraW e4{m.eb, p.rw_w0 + (l * 2 + 1) * 256};
        gemm_phase<false>(m.lwb, 64, W + W_W2 + 256 * 64, 64, 64, TG / 128, 2, 0, false, smem, e4);
        EpiLoraA e5{m.af, p.rw_a0 + (l * 2 + 0) * 256};
        gemm_phase<false>(m.laf, 64, W + W_A2, 64, 64, TG / 128, 2, 0, false, smem, e5);
        EpiLoraA e6{m.ab, p.rw_a0 + (l * 2 + 1) * 256};
        gemm_phase<false>(m.lab, 64, W + W_A2 + 256 * 64, 64, 64, TG / 128, 2, 0, false, smem, e6);
        EpiStore e7{m.gg, 256, 256};
        gemm_phase<false>(m.lg, 128, W + W_G2, 128, 128, TG / 128, 2, 0, false, smem, e7);
      }
      xcd_barrier(xb);
      for (int rep = 0; rep < REP_ROW; ++rep) mla_fin_phase(p, l, g, m, (const float2*)(ws + OFF_ROPEM));
      xcd_barrier(xb);
      {
        u16* ymix = hbuf;
        const int n_scan = (g == NG - 1) ? NG * BG * 4 * 2 * 4 : 0;
        const int qt_per_b = last ? 16 : 17;
        const int n_att = BG * 4 * qt_per_b;
        const int n_gqa = (g == NG - 1) ? NG * n_att : 0;
        const int n_hy = 256;
        const int total = n_scan + n_att + n_gqa + n_hy;
        float gq = 0.f, gk = 0.f, mq = 0.f, mk = 0.f;
        for (int i = 0; i < 64; ++i) { gq = fmaxf(gq, fabsf(p.gqa_q_norm[l * 64 + i])); gk = fmaxf(gk, fabsf(p.gqa_k_norm[l * 64 + i])); }
        for (int i = 0; i < 96; ++i) { mq = fmaxf(mq, fabsf(p.mla_q_norm[l * 96 + i])); mk = fmaxf(mk, fabsf(p.mla_k_norm[l * 96 + i])); }
        const float L2E = 1.4426950408889634f;
        const float sc_g = 0.125f, sc_m = 0.10206207261596575f;
        const float sh_g = (64.f * gq * gk * sc_g * 1.02f + 0.5f) * L2E;
        const float sh_m = (96.f * mq * mk * sc_m * 1.02f + 0.5f) * L2E;
        int* cnt = (int*)(ws + OFF_CNT) + (l * NG + g);
        for (;;) {
          if (threadIdx.x == 0) s_item = atomicAdd(cnt, 1);
          __syncthreads();
          const int it = s_item;
          __syncthreads();
          if (it >= total) break;
          if (it < n_scan) {
            const int sg = it >> 7, bl = (it >> 5) & 3, hd = (it >> 3) & 3, dir = (it >> 2) & 1, rq = it & 3;
            const MixBufs ms = mixbufs(big, sg);
            scan_item(p, l, ms, bl, hd, dir, rq, smem);
          } else if (it < n_scan + n_att + n_gqa) {
            int a = it - n_scan;
            const int kind = a < n_att ? 0 : 1;
            int ag = g;
            if (kind == 1) { a -= n_att; ag = a / n_att; a -= ag * n_att; }
            const int bl = a / (4 * qt_per_b);
            int rem = a - bl * 4 * qt_per_b;
            const int hd = rem / qt_per_b;
            const int qt = rem - hd * qt_per_b;
            const int j0 = qt < 16 ? LC + qt * 256 : 0;
            const int nkeys = qt < 16 ? LT : LC;
            const size_t rl0 = (size_t)bl * LT + j0;
            const size_t rg0 = (size_t)(ag * BG + bl) * LT + j0;
            if (kind == 1) {
              const MixBufs ma = mixbufs(big, ag);
              const int kvh = hd >> 1;
              attn_item<64, 2>(ma.qg + rl0 * 256 + hd * 64, 256, ma.kg + (size_t)bl * LT * 128 + kvh * 64, 128,
                            ma.vtg + (size_t)(bl * 2 + kvh) * 64 * LT, ymix + rg0 * D + 256 + hd * 64, D, nkeys, sc_g * L2E, sh_g, smem);
            } else {
              attn_item<96, 2>(m.qm + rl0 * 384 + hd * 96, 384, m.km + (size_t)bl * LT * 384 + hd * 96, 384,
                            m.vtm + (size_t)(bl * 4 + hd) * 64 * LT, ymix + rg0 * D + 512 + hd * 64, D, nkeys, sc_m * L2E, sh_m, smem);
            }
          } else {
            const int c = it - n_scan - n_att - n_gqa;
            hyena_pass(p, l, m, filt, LQ, LC, c, smem);
            if (!last) hyena_pass(p, l, m, (const float*)(ws + OFF_FILTC), LC, 0, c, smem);
          }
        }
        xcd_barrier(xb);
        readout_hy_phase(g, m, ymix, last, smem);
        if (g == NG - 1) {
          for (int rg = 0; rg < NG; ++rg) {
            const MixBufs mr = mixbufs(big, rg);
            readout_rw_phase(p, l, rg, mr, ymix, last);
          }
          xcd_barrier(xb);
        }
      }
    }
    {
      EpiRes e{p.out, ctxs, p.out, ctxs, modl, 5, 1.0f, nullptr, nullptr, nullptr, 0};
      gemm_phase<false>(hbuf, D, W + W_OUT, D, D, T / 128, 8, 0, last, smem, e);
    }
    xcd_barrier(xb);
    adaln_phase(p.out, ctxs, p.norm_ffn2 + l * D, modl, 2, hbuf, last);
    xcd_barrier(xb);
    {
      EpiGU e{Gbuf};
      for (int rep = 0; rep < REP_GU; ++rep) gemm_phase<true>(hbuf, D, W + W_GU2, D, D, T / 128, 44, 0, last, smem, e);
    }
    xcd_barrier(xb);
    {
      EpiRes e{p.out, ctxs, p.out, ctxs, modl, 8, 0.5f, nullptr, nullptr, nullptr, 0};
      gemm_phase<false>(Gbuf, DFF, W + W_D2, DFF, DFF, T / 128, 8, 0, last, smem, e);
    }
    xcd_barrier(xb);
  }
}

extern "C" void kernel_launch(void* const* d_in, const int* in_sizes, int n_in, void* d_out, int out_size, void* d_ws,
                              size_t ws_size, hipStream_t stream) {
  static int grid_blocks = 0;
  if (!grid_blocks) {
    int dev = 0, cus = 0, per_cu = 0;
    (void)hipGetDevice(&dev);
    (void)hipDeviceGetAttribute(&cus, hipDeviceAttributeMultiprocessorCount, dev);
    (void)hipOccupancyMaxActiveBlocksPerMultiprocessor(&per_cu, fwd_megakernel, NTHR, 0);
    if (per_cu > 2) per_cu = 2;
    if (per_cu < 1) per_cu = 1;
    grid_blocks = cus * per_cu;
  }
  Params p{};
  const float** pp = (const float**)&p;
  for (int i = 0; i < 47; ++i) pp[i] = (const float*)d_in[i];
  p.out = (float*)d_out;
  p.ws = (char*)d_ws;
  (void)hipMemsetAsync((char*)d_ws + OFF_CNT, 0, 256 + 3456 * 4, stream);
  void* args[] = {&p};
  hipError_t e = hipLaunchCooperativeKernel((void*)fwd_megakernel, dim3(grid_blocks), dim3(NTHR), args, 0, stream);
  if (e != hipSuccess) fprintf(stderr, "cooperative launch failed: %s (grid %d)\n", hipGetErrorString(e), grid_blocks);
}
```

```cpp
#include <hip/hip_runtime.h>
#include <hip/hip_bf16.h>
#include <hip/hip_cooperative_groups.h>
#include <cstdio>
namespace cg = cooperative_groups;

#define DI __device__ __forceinline__
typedef unsigned short u16;
using bf16x8 = __attribute__((ext_vector_type(8))) short;
using f32x16 = __attribute__((ext_vector_type(16))) float;
typedef __bf16 bf16x2_t __attribute__((ext_vector_type(2)));
typedef float f32x2_t __attribute__((ext_vector_type(2)));
#define MFMA32(a, b, c) __builtin_amdgcn_mfma_f32_32x32x16_bf16((a), (b), (c), 0, 0, 0)

constexpr int D = 1024, NB = 8, LQ = 4096, LC = 256, LT = 4352, T = NB * LT, DFF = 2816, DIN = 2848;
constexpr int HYC = 768, DINP = DIN - HYC;
constexpr int NG = 2, BG = NB / NG, TG = BG * LT;
constexpr int NTHR = 256;
#define REP_MIX 1
#define REP_GU 1
#define REP_MISC 1
#define REP_ROW 1
constexpr float EPS = 1e-6f;

constexpr size_t al(size_t x) { return (x + 255) & ~(size_t)255; }
constexpr size_t OFF_CTX = 0;
constexpr size_t OFF_MOD = OFF_CTX + al((size_t)NB * LC * D * 4);
constexpr size_t SZ_FILT_L = (size_t)(2 * LQ - 1) * 256 * 4;
constexpr size_t SZ_FILT_C = (size_t)(2 * LC - 1) * 256 * 4;
constexpr size_t OFF_CNT = OFF_MOD + al((size_t)2 * 9 * 9216 * 4);
constexpr size_t OFF_BAR = OFF_CNT + 256;
constexpr size_t OFF_FILT = OFF_BAR + al((size_t)3456 * 4);
constexpr size_t OFF_FILTC = OFF_FILT + al(SZ_FILT_L);
constexpr size_t OFF_ROPEG = OFF_FILTC + al(SZ_FILT_C);
constexpr size_t OFF_ROPEM = OFF_ROPEG + al((size_t)LQ * 32 * 8);
constexpr size_t OFF_W = OFF_ROPEM + al((size_t)LQ * 16 * 8);
constexpr size_t W_GU1 = 0;
constexpr size_t W_D1 = W_GU1 + (size_t)5632 * 1024;
constexpr size_t W_GU2 = W_D1 + (size_t)1024 * 2816;
constexpr size_t W_D2 = W_GU2 + (size_t)5632 * 1024;
constexpr size_t W_IN = W_D2 + (size_t)1024 * 2816;
constexpr size_t W_OUT = W_IN + (size_t)2944 * 1024;
constexpr size_t W_UQ = W_OUT + (size_t)1024 * 1024;
constexpr size_t W_UKV = W_UQ + (size_t)384 * 256;
constexpr size_t W_W2 = W_UKV + (size_t)512 * 128;
constexpr size_t W_A2 = W_W2 + (size_t)2 * 256 * 64;
constexpr size_t W_G2 = W_A2 + (size_t)2 * 256 * 64;
constexpr size_t W_LAYER = W_G2 + (size_t)256 * 128;
constexpr size_t OFF_H = OFF_W + al(W_LAYER * 2);
constexpr size_t OFF_BIG = OFF_H + al((size_t)T * D * 2);
constexpr size_t M_P = 0;
constexpr size_t M_PT = M_P + al((size_t)TG * DINP * 2);
constexpr size_t M_U = M_PT + al((size_t)HYC * TG * 2);
constexpr size_t M_CQN = M_U + al((size_t)TG * 256 * 2);
constexpr size_t M_CKVN = M_CQN + al((size_t)TG * 256 * 2);
constexpr size_t M_QUP = M_CKVN + al((size_t)TG * 128 * 2);
constexpr size_t M_KVUP = M_QUP + al((size_t)TG * 384 * 2);
constexpr size_t M_QM = M_KVUP + al((size_t)TG * 512 * 2);
constexpr size_t M_KM = M_QM + al((size_t)TG * 384 * 2);
constexpr size_t M_VTM = M_KM + al((size_t)TG * 384 * 2);
constexpr size_t M_LWF = M_VTM + al((size_t)TG * 256 * 2);
constexpr size_t M_LWB = M_LWF + al((size_t)TG * 64 * 2);
constexpr size_t M_LAF = M_LWB + al((size_t)TG * 64 * 2);
constexpr size_t M_LAB = M_LAF + al((size_t)TG * 64 * 2);
constexpr size_t M_LG = M_LAB + al((size_t)TG * 64 * 2);
constexpr size_t SZ_SC = al((size_t)TG * 256 * 2);
constexpr size_t M_SCAN = M_LG + al((size_t)TG * 128 * 2);
constexpr size_t SCAN_STRIDE = 11 * SZ_SC;
constexpr size_t M_END = M_SCAN + 2 * SCAN_STRIDE;
static_assert((size_t)4 * TG * 256 * 4 <= al((size_t)TG * DINP * 2), "yf/yb do not fit the p region");
constexpr size_t SZ_G = (size_t)T * DFF * 2;
constexpr size_t WS_NEED = OFF_BIG + (M_END > SZ_G ? M_END : SZ_G);
static_assert(WS_NEED <= (size_t)512 * 1024 * 1024, "workspace too large");

struct Params {
  const float *x, *c, *ctx, *c_ctx, *ada_w, *ada_b, *norm_ffn1, *norm_mix, *norm_ffn2;
  const float *ffn1_gate, *ffn1_up, *ffn1_down, *ffn2_gate, *ffn2_up, *ffn2_down, *w_in, *w_out;
  const float *hy_conv_w, *hy_conv_b, *hy_f_w1, *hy_f_b1, *hy_f_w2, *hy_f_b2, *hy_f_w3, *hy_f_b3, *hy_f_w4, *hy_f_freq, *hy_bias;
  const float *gqa_q_norm, *gqa_k_norm, *mla_cq_norm, *mla_ckv_norm, *mla_w_uq, *mla_w_ukv, *mla_q_norm, *mla_k_norm;
  const float *rw_mu, *rw_w0, *rw_w2, *rw_a0, *rw_a2, *rw_g2, *rw_k_k, *rw_k_a, *rw_r_k, *rw_ln_w, *rw_ln_b;
  float* out;
  char* ws;
};

DI u16 f2bf(float x) {
  unsigned u = __float_as_uint(x);
  u += 0x7fffu + ((u >> 16) & 1u);
  return (u16)(u >> 16);
}
DI float bf2f(u16 b) { return __uint_as_float(((unsigned)b) << 16); }
DI float bflo_(unsigned w) { return __uint_as_float(w << 16); }
DI float bfhi_(unsigned w) { return __uint_as_float(w & 0xffff0000u); }
DI unsigned pack2(float a, float b) {
  f32x2_t v = {a, b};
  bf16x2_t r = __builtin_convertvector(v, bf16x2_t);
  return __builtin_bit_cast(unsigned, r);
}
DI int ltid() {
  int t = threadIdx.x;
  asm volatile("" : "+v"(t));
  return t;
}
DI float wave_sum(float v) {
#pragma unroll
  for (int o = 32; o > 0; o >>= 1) v += __shfl_xor(v, o);
  return v;
}
DI float wave_max(float v) {
#pragma unroll
  for (int o = 32; o > 0; o >>= 1) v = fmaxf(v, __shfl_xor(v, o));
  return v;
}
DI float sigmoidf_(float x) { return __builtin_amdgcn_rcpf(1.f + __expf(-x)); }
DI int crow(int i, int h) { return (i & 3) + 8 * (i >> 2) + 4 * h; }

DI float rope_apply(float val, int idx, int nfreq, int t, int lane) {
  int pi = idx >> 1;
  int row = t >> 6, col = t & 63;
  float pos = pi < nfreq ? (float)row : (float)col;
  int f = pi < nfreq ? pi : pi - nfreq;
  float inv = exp2f(-(float)f / (float)nfreq * 13.287712379549449f);
  float ang = pos * inv;
  float cs = cosf(ang), sn = sinf(ang);
  float other = __shfl_xor(val, 1);
  return (lane & 1) ? other * sn + val * cs : val * cs - other * sn;
}

DI float rope_tab(float val, int idx, const float2* __restrict__ tab, int lane) {
  const float2 cs = tab[idx >> 1];
  const float other = __shfl_xor(val, 1);
  return (lane & 1) ? other * cs.y + val * cs.x : val * cs.x - other * cs.y;
}
DI void rope_table_phase(float2* __restrict__ tg, float2* __restrict__ tm) {
  const int tid = ltid();
  for (int e = blockIdx.x * NTHR + tid; e < LQ * 48; e += gridDim.x * NTHR) {
    const int t = e / 48, k = e - t * 48;
    const bool isg = k < 32;
    const int pi = isg ? k : k - 32, nfreq = isg ? 16 : 8;
    const int row = t >> 6, col = t & 63;
    const float pos = pi < nfreq ? (float)row : (float)col;
    const int f = pi < nfreq ? pi : pi - nfreq;
    const float inv = exp2f(-(float)f / (float)nfreq * 13.287712379549449f);
    const float ang = pos * inv;
    const float2 v = make_float2(cosf(ang), sinf(ang));
    if (isg) tg[t * 32 + pi] = v; else tm[t * 16 + pi] = v;
  }
}

DI int gu_row(int n, int half) { return (n >> 6) * 128 + ((n >> 5) & 1) * 64 + half * 32 + (n & 31); }
DI void convT_tile(const float* __restrict__ src, int K, int N, u16* __restrict__ dst, int mode, int t, char* smem) {
  float* tile = (float*)smem;
  const int tn = (N + 63) / 64;
  const int tid_ = ltid();
  const int j = tid_ & 63, i0 = tid_ >> 6;
  const int k0 = (t / tn) * 64, n0 = (t % tn) * 64;
  for (int i = i0; i < 64; i += 4) {
    int n = n0 + j;
    tile[i * 65 + j] = n < N ? src[(size_t)(k0 + i) * N + n] : 0.f;
  }
  __syncthreads();
  for (int i = i0; i < 64; i += 4) {
    int n = n0 + i;
    if (n < N) {
      int row = mode == 0 ? n : gu_row(n, mode - 1);
      dst[(size_t)row * K + k0 + j] = f2bf(tile[j * 65 + i]);
    }
  }
  __syncthreads();
}
DI void convT(const float* __restrict__ src, int K, int N, u16* __restrict__ dst, int mode, char* smem) {
  const int tk = K / 64, tn = (N + 63) / 64;
  for (int t = blockIdx.x; t < tk * tn; t += gridDim.x) convT_tile(src, K, N, dst, mode, t, smem);
}

DI void mod_phase(const Params& p, float* __restrict__ mod, char* smem) {
  float* sc = (float*)smem;
  float* red = sc + 9 * 1024;
  const int tid_ = ltid();
  for (int i = tid_; i < 9 * 1024; i += NTHR) {
    float v = i < 8192 ? p.c[i] : p.c_ctx[i - 8192];
    sc[i] = v / (1.f + expf(-v));
  }
  __syncthreads();
  const int lane = tid_ & 63, kp = tid_ >> 6;
  for (int it = blockIdx.x; it < 2 * 144; it += gridDim.x) {
    const int l = it / 144, nb = (it % 144) * 64;
    const float* w = p.ada_w + (size_t)l * 1024 * 9216 + nb + lane;
    float acc[9];
#pragma unroll
    for (int b = 0; b < 9; ++b) acc[b] = 0.f;
    for (int k = kp * 256; k < kp * 256 + 256; ++k) {
      float wv = w[(size_t)k * 9216];
#pragma unroll
      for (int b = 0; b < 9; ++b) acc[b] += sc[b * 1024 + k] * wv;
    }
#pragma unroll
    for (int b = 0; b < 9; ++b) red[(kp * 9 + b) * 64 + lane] = acc[b];
    __syncthreads();
    for (int o = tid_; o < 9 * 64; o += NTHR) {
      int b = o >> 6, ln = o & 63;
      float s = red[(0 * 9 + b) * 64 + ln] + red[(1 * 9 + b) * 64 + ln] + red[(2 * 9 + b) * 64 + ln] + red[(3 * 9 + b) * 64 + ln];
      mod[((size_t)l * 9 + b) * 9216 + nb + ln] = s + p.ada_b[l * 9216 + nb + ln];
    }
    __syncthreads();
  }
}

DI void hyfilt_phase(const Params& p, int l, int L, float* __restrict__ gT, char* smem) {
  float* z = (float*)smem;
  float* h1 = z + 64;
  float* h2 = h1 + 64;
  float* h3 = h2 + 64;
  float* w1s = z + 256;
  float* w2s = w1s + 33 * 64;
  float* w3s = w2s + 64 * 64;
  const float* w4 = p.hy_f_w4 + l * 64 * 512;
  const int tid = ltid();
  for (int i = tid; i < 33 * 64; i += NTHR) w1s[i] = p.hy_f_w1[l * 33 * 64 + i];
  for (int i = tid; i < 64 * 64; i += NTHR) { w2s[i] = p.hy_f_w2[l * 4096 + i]; w3s[i] = p.hy_f_w3[l * 4096 + i]; }
  float b1v = 0.f, b2v = 0.f, b3v = 0.f, frv = 0.f;
  if (tid < 64) { b1v = p.hy_f_b1[l * 64 + tid]; b2v = p.hy_f_b2[l * 64 + tid]; b3v = p.hy_f_b3[l * 64 + tid]; frv = p.hy_f_freq[l * 64 + tid]; }
  const float min_decay = logf(1e-2f) / 1.5f, max_decay = logf(1e-2f) / 0.3f;
  const float delta = fabsf(min_decay + (max_decay - min_decay) * (float)tid / 255.f);
  __syncthreads();
  for (int t = blockIdx.x; t < L; t += gridDim.x) {
    const float t01 = (float)t / (float)(L - 1);
    if (tid < 33) {
      float zz;
      if (tid == 0) zz = t01;
      else {
        int i = (tid - 1) & 15;
        float f = 1e-4f + (float)i * ((15.f - 1e-4f) / 15.f);
        float wang = 6.283185307179586f * (float)t / (float)L;
        zz = tid <= 16 ? cosf(f * wang) : -sinf(f * wang);
      }
      z[tid] = zz;
    }
    __syncthreads();
    if (tid < 64) {
      float a = b1v;
#pragma unroll 11
      for (int i = 0; i < 33; ++i) a += z[i] * w1s[i * 64 + tid];
      h1[tid] = sinf(frv * a);
    }
    __syncthreads();
    if (tid < 64) {
      float a = b2v;
#pragma unroll 16
      for (int i = 0; i < 64; ++i) a += h1[i] * w2s[i * 64 + tid];
      h2[tid] = sinf(frv * a);
    }
    __syncthreads();
    if (tid < 64) {
      float a = b3v;
#pragma unroll 16
      for (int i = 0; i < 64; ++i) a += h2[i] * w3s[i * 64 + tid];
      h3[tid] = sinf(frv * a);
    }
    __syncthreads();
    float af = 0.f, ab = 0.f;
#pragma unroll 8
    for (int i = 0; i < 64; ++i) {
      af += h3[i] * w4[i * 512 + tid];
      ab += h3[i] * w4[i * 512 + 256 + tid];
    }
    const float dec = expf(-t01 * delta);
    af *= dec;
    ab *= dec;
    if (t == 0) gT[(size_t)(L - 1) * 256 + tid] = af + ab;
    else {
      gT[(size_t)(L - 1 + t) * 256 + tid] = af;
      gT[(size_t)(L - 1 - t) * 256 + tid] = ab;
    }
    __syncthreads();
  }
  __syncthreads();
}

DI void adaln_phase(const float* __restrict__ lat, const float* __restrict__ ctxp, const float* __restrict__ gain,
                    const float* __restrict__ modl, int idx, u16* __restrict__ h, bool skip_ctx) {
  const int tid_ = ltid();
  const int wave = tid_ >> 6, lane = tid_ & 63;
  for (int r = blockIdx.x * 4 + wave; r < T; r += gridDim.x * 4) {
    const int b = r / LT, j = r - b * LT;
    if (skip_ctx && j < LC) continue;
    const float* xr = j < LC ? ctxp + ((size_t)(b * LC + j) << 10) : lat + ((size_t)(b * LQ + j - LC) << 10);
    const int bb = j < LC ? 8 : b;
    const float* shift = modl + bb * 9216 + (3 * idx) * 1024;
    const float* scale = shift + 1024;
    float4 v[4];
    float ss = 0.f;
#pragma unroll
    for (int q = 0; q < 4; ++q) {
      v[q] = *(const float4*)(xr + q * 256 + lane * 4);
      ss += v[q].x * v[q].x + v[q].y * v[q].y + v[q].z * v[q].z + v[q].w * v[q].w;
    }
    ss = wave_sum(ss);
    const float rstd = rsqrtf(ss * (1.f / 1024.f) + EPS);
#pragma unroll
    for (int q = 0; q < 4; ++q) {
      const int c = q * 256 + lane * 4;
      float4 g = *(const float4*)(gain + c), sc = *(const float4*)(scale + c), sh = *(const float4*)(shift + c);
      float y0 = v[q].x * rstd * g.x * (1.f + sc.x) + sh.x;
      float y1 = v[q].y * rstd * g.y * (1.f + sc.y) + sh.y;
      float y2 = v[q].z * rstd * g.z * (1.f + sc.z) + sh.z;
      float y3 = v[q].w * rstd * g.w * (1.f + sc.w) + sh.w;
      uint2 o;
      o.x = pack2(y0, y1);
      o.y = pack2(y2, y3);
      *(uint2*)(h + (size_t)r * D + c) = o;
    }
  }
}

DI bool gemm_decode(int t, int mtiles, int ntiles, int mt_off, bool skip_ctx, int& mt, int& nt) {
  const int mtx = mtiles >> 3;
  const int xcd = t & 7, q = t >> 3;
  const int sr = q / (8 * ntiles);
  const int rem = q - sr * 8 * ntiles;
  const int rows_in = min(8, mtx - sr * 8);
  const int sc = rem / (rows_in * 8);
  const int r2 = rem - sc * rows_in * 8;
  const int i = r2 % rows_in, j = r2 / rows_in;
  mt = (sr * 8 + i) * 8 + xcd;
  nt = sc * 8 + j;
  return !(skip_ctx && ((mt + mt_off) % 34) < 2);
}
template <bool PAIRED, class Epi>
DI void gemm_phase(const u16* __restrict__ A, int lda, const u16* __restrict__ Bt, int ldb, int K, int mtiles, int ntiles,
                   int mt_off, bool skip_ctx, char* smem, Epi& epi) {
  u16* As = (u16*)smem;
  u16* Bs = As + 2 * 128 * 72;
  const int tid = ltid(), lane = tid & 63, wave = tid >> 6;
  const int wm = wave >> 1, wn = wave & 1, lr = lane & 31, lh = lane >> 5;
  const int lrow = tid >> 3, lkc = (tid & 7) * 8;
  const int total = mtiles * ntiles, nk = K >> 6;
  uint4 ra00, ra01, ra02, ra03, rb00, rb01, rb02, rb03, ra10, ra11, ra12, ra13, rb10, rb11, rb12, rb13;
  const u16* Agl;
  const u16* Bgl;
#define GEMM_GLOAD(S, kt_)                                            \
  {                                                                   \
    const int k0_ = (kt_) << 6;                                       \
    ra##S##0 = *(const uint4*)(Agl + k0_);                            \
    ra##S##1 = *(const uint4*)(Agl + (size_t)32 * lda + k0_);         \
    ra##S##2 = *(const uint4*)(Agl + (size_t)64 * lda + k0_);         \
    ra##S##3 = *(const uint4*)(Agl + (size_t)96 * lda + k0_);         \
    rb##S##0 = *(const uint4*)(Bgl + k0_);                            \
    rb##S##1 = *(const uint4*)(Bgl + (size_t)32 * ldb + k0_);         \
    rb##S##2 = *(const uint4*)(Bgl + (size_t)64 * ldb + k0_);         \
    rb##S##3 = *(const uint4*)(Bgl + (size_t)96 * ldb + k0_);         \
  }
#define GEMM_LSTORE(S, buf_)                                          \
  {                                                                   \
    u16* ad_ = As + (buf_) * 128 * 72 + lrow * 72 + lkc;              \
    u16* bd_ = Bs + (buf_) * 128 * 72 + lrow * 72 + lkc;              \
    *(uint4*)(ad_) = ra##S##0;                                        \
    *(uint4*)(ad_ + 32 * 72) = ra##S##1;                              \
    *(uint4*)(ad_ + 64 * 72) = ra##S##2;                              \
    *(uint4*)(ad_ + 96 * 72) = ra##S##3;                              \
    *(uint4*)(bd_) = rb##S##0;                                        \
    *(uint4*)(bd_ + 32 * 72) = rb##S##1;                              \
    *(uint4*)(bd_ + 64 * 72) = rb##S##2;                              \
    *(uint4*)(bd_ + 96 * 72) = rb##S##3;                              \
  }
#define GEMM_COMPUTE(buf_)                                                        \
  {                                                                               \
    const u16* as = As + (buf_) * 128 * 72 + (wm * 64 + lr) * 72 + lh * 8;        \
    const u16* bs = Bs + (buf_) * 128 * 72 + (wn * 64 + lr) * 72 + lh * 8;        \
    _Pragma("unroll") for (int ks = 0; ks < 4; ++ks) {                            \
      bf16x8 a0 = *(const bf16x8*)(as + ks * 16);                                 \
      bf16x8 a1 = *(const bf16x8*)(as + 32 * 72 + ks * 16);                       \
      bf16x8 b0 = *(const bf16x8*)(bs + ks * 16);                                 \
      bf16x8 b1 = *(const bf16x8*)(bs + 32 * 72 + ks * 16);                       \
      acc[0][0] = MFMA32(a0, b0, acc[0][0]);                                      \
      acc[0][1] = MFMA32(a0, b1, acc[0][1]);                                      \
      acc[1][0] = MFMA32(a1, b0, acc[1][0]);                                      \
      acc[1][1] = MFMA32(a1, b1, acc[1][1]);                                      \
    }                                                                             \
  }
  int t = blockIdx.x, mt = 0, nt = 0;
  while (t < total && !gemm_decode(t, mtiles, ntiles, mt_off, skip_ctx, mt, nt)) t += gridDim.x;
  if (t < total) {
    Agl = A + (size_t)(mt * 128 + lrow) * lda + lkc;
    Bgl = Bt + (size_t)(nt * 128 + lrow) * ldb + lkc;
    GEMM_GLOAD(0, 0);
  }
  while (t < total) {
    const int m0 = mt * 128, n0 = nt * 128;
    int tn = t + gridDim.x, mtn = 0, ntn = 0;
    while (tn < total && !gemm_decode(tn, mtiles, ntiles, mt_off, skip_ctx, mtn, ntn)) tn += gridDim.x;
    f32x16 acc[2][2];
#pragma unroll
    for (int a = 0; a < 2; ++a)
#pragma unroll
      for (int b = 0; b < 2; ++b)
#pragma unroll
        for (int i = 0; i < 16; ++i) acc[a][b][i] = 0.f;
    GEMM_LSTORE(0, 0);
    __syncthreads();
    if (nk > 1) GEMM_GLOAD(0, 1);
    for (int kt = 0; kt < nk; kt += 2) {
      if (kt + 2 < nk) GEMM_GLOAD(1, kt + 2);
      GEMM_COMPUTE(0);
      if (kt + 1 < nk) GEMM_LSTORE(0, 1);
      __syncthreads();
      if (kt + 1 >= nk) break;
      if (kt + 3 < nk) GEMM_GLOAD(0, kt + 3);
      GEMM_COMPUTE(1);
      if (kt + 2 < nk) GEMM_LSTORE(1, 0);
      __syncthreads();
    }
    if (tn < total) {
      Agl = A + (size_t)(mtn * 128 + lrow) * lda + lkc;
      Bgl = Bt + (size_t)(ntn * 128 + lrow) * ldb + lkc;
      GEMM_GLOAD(0, 0);
    }
    epi.tile(m0);
    if constexpr (PAIRED) {
      float* stg = (float*)smem + wave * 64 * 36;
#pragma unroll
      for (int mi = 0; mi < 2; ++mi)
#pragma unroll
        for (int i = 0; i < 16; ++i) stg[(mi * 32 + crow(i, lh)) * 36 + lr] = epi.combine(acc[mi][0][i], acc[mi][1][i]);
      __syncthreads();
#pragma unroll
      for (int k = 0; k < 8; ++k) {
        const int idx = lane + 64 * k, row = idx >> 3, c4 = idx & 7;
        const float4 v = *(const float4*)(stg + row * 36 + c4 * 4);
        epi.store4(m0 + wm * 64 + row, (n0 >> 1) + wn * 32 + c4 * 4, v);
      }
      __syncthreads();
    } else if constexpr (Epi::kStaged) {
      float* stg = (float*)smem + wave * 64 * 68;
#pragma unroll
      for (int mi = 0; mi < 2; ++mi)
#pragma unroll
        for (int ni = 0; ni < 2; ++ni)
#pragma unroll
          for (int i = 0; i < 16; ++i) stg[(mi * 32 + crow(i, lh)) * 68 + ni * 32 + lr] = acc[mi][ni][i];
      __syncthreads();
#pragma unroll 4
      for (int k = 0; k < 16; ++k) {
        const int idx = lane + 64 * k, row = idx >> 4, c4 = idx & 15;
        const float4 v = *(const float4*)(stg + row * 68 + c4 * 4);
        epi.row4(m0 + wm * 64 + row, n0 + wn * 64 + c4 * 4, v);
      }
      __syncthreads();
    } else {
#pragma unroll
      for (int mi = 0; mi < 2; ++mi) {
#pragma unroll
        for (int gq = 0; gq < 4; ++gq) {
          const int row0 = m0 + wm * 64 + mi * 32 + 8 * gq + 4 * lh;
          if (PAIRED) {
            const int col = (n0 >> 1) + wn * 32 + lr;
#pragma unroll
            for (int e = 0; e < 4; ++e) epi.pair(row0 + e, col, acc[mi][0][4 * gq + e], acc[mi][1][4 * gq + e]);
          } else {
            epi.quad(row0, n0 + wn * 64 + lr, acc[mi][0][4 * gq], acc[mi][0][4 * gq + 1], acc[mi][0][4 * gq + 2], acc[mi][0][4 * gq + 3]);
            epi.quad(row0, n0 + wn * 64 + 32 + lr, acc[mi][1][4 * gq], acc[mi][1][4 * gq + 1], acc[mi][1][4 * gq + 2], acc[mi][1][4 * gq + 3]);
          }
        }
      }
    }
    t = tn; mt = mtn; nt = ntn;
  }
}

#define EPI_DEFAULT_QUAD                                                   \
  static constexpr bool kStaged = false;                                   \
  DI void row4(int, int, float4) const {}                                  \
  DI void tile(int) {}                                                     \
  DI void quad(int row0, int col, float a, float b, float c, float d) const { \
    (*this)(row0, col, a);                                                 \
    (*this)(row0 + 1, col, b);                                             \
    (*this)(row0 + 2, col, c);                                             \
    (*this)(row0 + 3, col, d);                                             \
  }
struct EpiGU {
  u16* G;
  DI float combine(float g, float u) const { return g * __builtin_amdgcn_rcpf(1.f + __expf(-g)) * u; }
  DI void store4(int row, int col, float4 v) const {
    uint2 w;
    w.x = pack2(v.x, v.y);
    w.y = pack2(v.z, v.w);
    *(uint2*)(G + (size_t)row * DFF + col) = w;
  }
  DI void pair(int row, int col, float g, float u) const {
    float s = g / (1.f + __expf(-g));
    G[(size_t)row * DFF + col] = f2bf(s * u);
  }
  DI void operator()(int, int, float) const {}
  EPI_DEFAULT_QUAD
};
struct EpiRes {
  const float* lat_in; const float* ctx_in; float* lat_out; float* ctx_out; const float* modl; int gate_chunk; float coef;
  const float* tin; float* tout; const float* gate; int tm0;
  static constexpr bool kStaged = true;
  DI void row4(int row, int col, float4 v) const {
    const size_t o = ((size_t)(row - tm0) << 10) + col;
    const float4 x = *(const float4*)(tin + o);
    const float4 g = *(const float4*)(gate + col);
    float4 y;
    y.x = x.x + coef * g.x * v.x;
    y.y = x.y + coef * g.y * v.y;
    y.z = x.z + coef * g.z * v.z;
    y.w = x.w + coef * g.w * v.w;
    *(float4*)(tout + o) = y;
  }
  DI void tile(int m0) {
    const int b = m0 / LT, j = m0 - b * LT;
    const bool isc = j < LC;
    const size_t off = isc ? (((size_t)(b * LC + j)) << 10) : (((size_t)(b * LQ + j - LC)) << 10);
    tin = (isc ? ctx_in : lat_in) + off;
    tout = (isc ? ctx_out : lat_out) + off;
    gate = modl + (isc ? 8 : b) * 9216 + gate_chunk * 1024;
    tm0 = m0;
  }
  DI void operator()(int row, int col, float v) const {
    const size_t o = ((size_t)(row - tm0) << 10) + col;
    tout[o] = tin[o] + coef * gate[col] * v;
  }
  DI void pair(int, int, float, float) const {}
  DI void quad(int row0, int col, float a, float b, float c, float d) const {
    const float gc = coef * gate[col];
    const size_t o = ((size_t)(row0 - tm0) << 10) + col;
    tout[o] = tin[o] + gc * a;
    tout[o + 1024] = tin[o + 1024] + gc * b;
    tout[o + 2048] = tin[o + 2048] + gc * c;
    tout[o + 3072] = tin[o + 3072] + gc * d;
  }
};
struct EpiStore {
  u16* C; int ldc; int N;
  DI void operator()(int row, int col, float v) const { if (col < N) C[(size_t)row * ldc + col] = f2bf(v); }
  DI void pair(int, int, float, float) const {}
  EPI_DEFAULT_QUAD
};
struct EpiWin {
  u16* p; u16* pT;
  static constexpr bool kStaged = false;
  DI void row4(int, int, float4) const {}
  DI void tile(int) {}
  DI void quad(int row0, int col, float a, float b, float c, float d) const {
    if (col < HYC) {
      uint2 w;
      w.x = pack2(a, b);
      w.y = pack2(c, d);
      *(uint2*)(pT + (size_t)col * TG + row0) = w;
    } else if (col < DIN) {
      u16* q = p + (size_t)row0 * DINP + (col - HYC);
      q[0] = f2bf(a);
      q[DINP] = f2bf(b);
      q[2 * DINP] = f2bf(c);
      q[3 * DINP] = f2bf(d);
    }
  }
  DI void pair(int, int, float, float) const {}
};
struct EpiLoraW {
  u16* C; const float* w0;
  DI void operator()(int row, int col, float v) const {
    float zz = -(w0[col] + v);
    float sp = fmaxf(zz, 0.f) + log1pf(expf(-fabsf(zz)));
    C[(size_t)row * 256 + col] = f2bf(-expm1f(-expf(-sp - 0.5f)));
  }
  DI void pair(int, int, float, float) const {}
  EPI_DEFAULT_QUAD
};
struct EpiLoraA {
  u16* C; const float* a0;
  DI void operator()(int row, int col, float v) const { C[(size_t)row * 256 + col] = f2bf(sigmoidf_(a0[col] + v)); }
  DI void pair(int, int, float, float) const {}
  EPI_DEFAULT_QUAD
};

struct MixBufs {
  u16 *p, *pt, *u, *qg, *kg, *vtg, *cqn, *ckvn, *qup, *kvup, *qm, *km, *vtm, *rr, *rk, *rv, *rkk, *lwf, *lwb, *laf, *lab, *lg, *ef, *eb, *af, *ab, *gg;
  float *yf, *yb;
};
DI MixBufs mixbufs(char* big, int g) {
  MixBufs m;
  m.p = (u16*)(big + M_P); m.pt = (u16*)(big + M_PT); m.u = (u16*)(big + M_U);
  m.cqn = (u16*)(big + M_CQN); m.ckvn = (u16*)(big + M_CKVN); m.qup = (u16*)(big + M_QUP);
  m.kvup = (u16*)(big + M_KVUP); m.qm = (u16*)(big + M_QM); m.km = (u16*)(big + M_KM); m.vtm = (u16*)(big + M_VTM);
  m.lwf = (u16*)(big + M_LWF); m.lwb = (u16*)(big + M_LWB); m.laf = (u16*)(big + M_LAF); m.lab = (u16*)(big + M_LAB);
  m.lg = (u16*)(big + M_LG);
  char* sc = big + M_SCAN + (size_t)g * SCAN_STRIDE;
  m.rr = (u16*)(sc + 0 * SZ_SC); m.rk = (u16*)(sc + 1 * SZ_SC); m.rv = (u16*)(sc + 2 * SZ_SC); m.rkk = (u16*)(sc + 3 * SZ_SC);
  m.ef = (u16*)(sc + 4 * SZ_SC); m.eb = (u16*)(sc + 5 * SZ_SC); m.af = (u16*)(sc + 6 * SZ_SC); m.ab = (u16*)(sc + 7 * SZ_SC);
  m.gg = (u16*)(sc + 8 * SZ_SC);
  m.qg = (u16*)(sc + 9 * SZ_SC); m.kg = (u16*)(sc + 10 * SZ_SC); m.vtg = m.kg + (size_t)TG * 128;
  m.yf = (float*)(big + M_P) + (size_t)g * 2 * TG * 256;
  m.yb = m.yf + (size_t)TG * 256;
  return m;
}

DI void prep_phase(const Params& p, int l, int g, const MixBufs& m, const float2* __restrict__ ropeg, char* smem) {
  const int tid = ltid(), lane = tid & 63, wave = tid >> 6;
  const float* mu = p.rw_mu + l * 1152;
  for (int rl = blockIdx.x * 4 + wave; rl < TG; rl += gridDim.x * 4) {
    const int r = g * TG + rl;
    const int b = r / LT, j = r - b * LT, bl = b - g * BG;
    const bool lat = j >= LC;
    const bool hp = lat ? (j > LC) : (j > 0);
    const bool hn = lat ? (j < LT - 1) : (j < LC - 1);
    const u16* pc = m.p + (size_t)rl * DINP;
    const u16* pp = pc - DINP;
    const u16* pn = pc + DINP;
    auto tshift = [&](int crel) -> float {
      const int c = 1696 - HYC + crel;
      float u0 = bf2f(pc[c]);
      float nb = 0.f;
      if (hp) nb += bf2f(pp[c]);
      if (hn) nb += bf2f(pn[c]);
      return u0 + mu[crel] * (0.5f * nb - u0);
    };
#pragma unroll
    for (int hd = 0; hd < 4; ++hd) {
      const int c = hd * 64 + lane;
      const float sr = tshift(c), sk = tshift(256 + c), sv = tshift(512 + c);
      m.rr[(size_t)rl * 256 + c] = f2bf(sr);
      m.rk[(size_t)rl * 256 + c] = f2bf(sk);
      m.rv[(size_t)rl * 256 + c] = f2bf(sv);
      const float kx = sk * p.rw_k_k[l * 256 + c];
      const float ss = wave_sum(kx * kx);
      m.rkk[(size_t)rl * 256 + c] = f2bf(kx / fmaxf(sqrtf(ss), 1e-12f));
    }
    {
      const float s0 = tshift(768 + lane), s1 = tshift(832 + lane), s2 = tshift(896 + lane), s3 = tshift(960 + lane);
      const float s4 = tshift(1024 + lane), s5 = tshift(1088 + lane);
      m.lwf[(size_t)rl * 64 + lane] = f2bf(tanhf(s0));
      m.lwb[(size_t)rl * 64 + lane] = f2bf(tanhf(s1));
      m.laf[(size_t)rl * 64 + lane] = f2bf(s2);
      m.lab[(size_t)rl * 64 + lane] = f2bf(s3);
      m.lg[(size_t)rl * 128 + lane] = f2bf(sigmoidf_(s4));
      m.lg[(size_t)rl * 128 + 64 + lane] = f2bf(sigmoidf_(s5));
    }
    {
      float cq[4], ckv[2];
      float s1 = 0.f, s2 = 0.f;
#pragma unroll
      for (int q = 0; q < 4; ++q) { cq[q] = bf2f(pc[1280 - HYC + lane + 64 * q]); s1 += cq[q] * cq[q]; }
#pragma unroll
      for (int q = 0; q < 2; ++q) { ckv[q] = bf2f(pc[1536 - HYC + lane + 64 * q]); s2 += ckv[q] * ckv[q]; }
      s1 = wave_sum(s1);
      s2 = wave_sum(s2);
      const float r1 = rsqrtf(s1 * (1.f / 256.f) + EPS), r2 = rsqrtf(s2 * (1.f / 128.f) + EPS);
#pragma unroll
      for (int q = 0; q < 4; ++q) m.cqn[(size_t)rl * 256 + lane + 64 * q] = f2bf(cq[q] * r1 * p.mla_cq_norm[l * 256 + lane + 64 * q]);
#pragma unroll
      for (int q = 0; q < 2; ++q) m.ckvn[(size_t)rl * 128 + lane + 64 * q] = f2bf(ckv[q] * r2 * p.mla_ckv_norm[l * 128 + lane + 64 * q]);
    }
    const float2* rt = ropeg + (size_t)(lat ? j - LC : 0) * 32;
    const float gq_ = p.gqa_q_norm[l * 64 + lane], gk_ = p.gqa_k_norm[l * 64 + lane];
#pragma unroll
    for (int hh = 0; hh < 6; ++hh) {
      float val = bf2f(pc[hh * 64 + lane]);
      const float ss = wave_sum(val * val);
      val = val * rsqrtf(ss * (1.f / 64.f) + EPS) * (hh < 4 ? gq_ : gk_);
      const float rv = rope_tab(val, lane, rt, lane);
      if (lat) val = rv;
      if (hh < 4) m.qg[(size_t)rl * 256 + hh * 64 + lane] = f2bf(val);
      else m.kg[(size_t)rl * 128 + (hh - 4) * 64 + lane] = f2bf(val);
    }
#pragma unroll
    for (int kvh = 0; kvh < 2; ++kvh) m.vtg[((size_t)(bl * 2 + kvh) * 64 + lane) * LT + j] = pc[1152 - HYC + kvh * 64 + lane];
  }
}

DI void mla_fin_phase(const Params& p, int l, int g, const MixBufs& m, const float2* __restrict__ ropem) {
  const int tid = ltid(), lane = tid & 63, wave = tid >> 6;
  for (int rl = blockIdx.x; rl < TG; rl += gridDim.x) {
    const int r = g * TG + rl;
    const int b = r / LT, j = r - b * LT, bl = b - g * BG;
    const bool lat = j >= LC;
    for (int s = wave; s < 8; s += 4) {
      const int hd = s & 3;
      const bool isq = s < 4;
      float x0, x1;
      if (isq) {
        x0 = bf2f(m.qup[(size_t)rl * 384 + hd * 96 + lane]);
        x1 = lane < 32 ? bf2f(m.qup[(size_t)rl * 384 + hd * 96 + 64 + lane]) : 0.f;
      } else {
        x0 = bf2f(m.kvup[(size_t)rl * 512 + hd * 128 + lane]);
        x1 = lane < 32 ? bf2f(m.p[(size_t)rl * DINP + 1664 - HYC + lane]) : 0.f;
      }
      float ss = wave_sum(x0 * x0 + x1 * x1);
      const float rstd = rsqrtf(ss * (1.f / 96.f) + EPS);
      const float* gn = isq ? p.mla_q_norm + l * 96 : p.mla_k_norm + l * 96;
      float y0 = x0 * rstd * gn[lane];
      float y1 = lane < 32 ? x1 * rstd * gn[64 + lane] : 0.f;
      float ry = rope_tab(y1, lane & 31, ropem + (size_t)(lat ? j - LC : 0) * 16, lane);
      if (lat) y1 = ry;
      u16* dst = (isq ? m.qm : m.km) + (size_t)rl * 384 + hd * 96;
      dst[lane] = f2bf(y0);
      if (lane < 32) dst[64 + lane] = f2bf(y1);
      if (!isq) m.vtm[((size_t)(bl * 4 + hd) * 64 + lane) * LT + j] = m.kvup[(size_t)rl * 512 + hd * 128 + 64 + lane];
    }
  }
}

template <int DQK, int QT>
DI void attn_item(const u16* __restrict__ q, int ldq, const u16* __restrict__ k, int ldk, const u16* __restrict__ vT,
                  u16* __restrict__ out, int ldo, int nkeys, float sl2, float sh2, char* smem) {
  constexpr int KS = DQK + 8;
  constexpr int NKS = DQK / 16;
  constexpr int KCH = DQK / 8;
  constexpr int KPT = 64 * KCH / NTHR;
  u16* Ks = (u16*)smem;
  u16* Vs = Ks + 2 * 64 * KS;
  const int tid = ltid(), lane = tid & 63, wave = tid >> 6, lr = lane & 31, lh = lane >> 5;
  bf16x8 qf[QT][NKS];
#pragma unroll
  for (int qt = 0; qt < QT; ++qt)
#pragma unroll
    for (int ks = 0; ks < NKS; ++ks)
      qf[qt][ks] = *(const bf16x8*)(q + (size_t)(wave * 32 * QT + qt * 32 + lr) * ldq + ks * 16 + lh * 8);
  f32x16 o[QT][2];
#pragma unroll
  for (int a = 0; a < QT; ++a)
#pragma unroll
    for (int b = 0; b < 2; ++b)
#pragma unroll
      for (int i = 0; i < 16; ++i) o[a][b][i] = 0.f;
  float lsum[QT];
#pragma unroll
  for (int a = 0; a < QT; ++a) lsum[a] = 0.f;
  uint4 rk[KPT], rv[2];
#define ATT_GLOAD(key0)                                                                   \
  {                                                                                       \
    _Pragma("unroll") for (int i = 0; i < KPT; ++i) {                                     \
      const int id = tid + NTHR * i, row = id / KCH, ch = id - row * KCH;                 \
      rk[i] = *(const uint4*)(k + (size_t)((key0) + row) * ldk + ch * 8);                 \
    }                                                                                     \
    _Pragma("unroll") for (int i = 0; i < 2; ++i) {                                       \
      const int id = tid + NTHR * i, row = id >> 3, ch = id & 7;                          \
      rv[i] = *(const uint4*)(vT + (size_t)row * LT + (key0) + ch * 8);                   \
    }                                                                                     \
  }
#define ATT_LSTORE(buf_)                                                                  \
  {                                                                                       \
    _Pragma("unroll") for (int i = 0; i < KPT; ++i) {                                     \
      const int id = tid + NTHR * i, row = id / KCH, ch = id - row * KCH;                 \
      *(uint4*)(Ks + (buf_) * 64 * KS + row * KS + ch * 8) = rk[i];                       \
    }                                                                                     \
    _Pragma("unroll") for (int i = 0; i < 2; ++i) {                                       \
      const int id = tid + NTHR * i, row = id >> 3, ch = id & 7;                          \
      *(uint4*)(Vs + (buf_) * 64 * 72 + row * 72 + ch * 8) = rv[i];                       \
    }                                                                                     \
  }
  ATT_GLOAD(0);
  ATT_LSTORE(0);
  __syncthreads();
  const int nkt = nkeys >> 6;
  for (int kt = 0; kt < nkt; ++kt) {
    const int buf = kt & 1;
    if (kt + 1 < nkt) ATT_GLOAD((kt + 1) << 6);
    const u16* kb = Ks + buf * 64 * KS;
    const u16* vb = Vs + buf * 64 * 72;
#pragma unroll
    for (int half = 0; half < 2; ++half) {
      f32x16 s[QT];
#pragma unroll
      for (int qt = 0; qt < QT; ++qt)
#pragma unroll
        for (int i = 0; i < 16; ++i) s[qt][i] = 0.f;
      bf16x8 kf[NKS];
#pragma unroll
      for (int ks = 0; ks < NKS; ++ks) kf[ks] = *(const bf16x8*)(kb + (half * 32 + lr) * KS + ks * 16 + lh * 8);
#pragma unroll
      for (int ks = 0; ks < NKS; ++ks) {
#pragma unroll
        for (int qt = 0; qt < QT; ++qt) s[qt] = MFMA32(kf[ks], qf[qt][ks], s[qt]);
      }
#pragma unroll
      for (int qt = 0; qt < QT; ++qt)
#pragma unroll
        for (int i = 0; i < 16; ++i) {
          float pv = __builtin_amdgcn_exp2f(s[qt][i] * sl2 - sh2);
          lsum[qt] += pv;
          s[qt][i] = pv;
        }
#pragma unroll
      for (int st = 0; st < 2; ++st) {
        bf16x8 pb[QT];
#pragma unroll
        for (int qt = 0; qt < QT; ++qt) {
          uint4 w;
          w.x = pack2(s[qt][8 * st + 0], s[qt][8 * st + 1]);
          w.y = pack2(s[qt][8 * st + 2], s[qt][8 * st + 3]);
          w.z = pack2(s[qt][8 * st + 4], s[qt][8 * st + 5]);
          w.w = pack2(s[qt][8 * st + 6], s[qt][8 * st + 7]);
          pb[qt] = __builtin_bit_cast(bf16x8, w);
        }
        bf16x8 vf[2];
#pragma unroll
        for (int mt = 0; mt < 2; ++mt) {
          const u16* vp = vb + (mt * 32 + lr) * 72 + half * 32 + st * 16 + lh * 4;
          uint2 v0 = *(const uint2*)(vp);
          uint2 v1 = *(const uint2*)(vp + 8);
          uint4 w;
          w.x = v0.x; w.y = v0.y; w.z = v1.x; w.w = v1.y;
          vf[mt] = __builtin_bit_cast(bf16x8, w);
        }
#pragma unroll
        for (int mt = 0; mt < 2; ++mt) {
#pragma unroll
          for (int qt = 0; qt < QT; ++qt) o[qt][mt] = MFMA32(vf[mt], pb[qt], o[qt][mt]);
        }
      }
    }
    if (kt + 1 < nkt) ATT_LSTORE(buf ^ 1);
    __syncthreads();
  }
#pragma unroll
  for (int qt = 0; qt < QT; ++qt) {
    float tot = lsum[qt] + __shfl_xor(lsum[qt], 32);
    float inv = 1.f / tot;
    const int row = wave * 32 * QT + qt * 32 + lr;
#pragma unroll
    for (int mt = 0; mt < 2; ++mt)
#pragma unroll
      for (int gq = 0; gq < 4; ++gq) {
        uint2 w;
        w.x = pack2(o[qt][mt][4 * gq + 0] * inv, o[qt][mt][4 * gq + 1] * inv);
        w.y = pack2(o[qt][mt][4 * gq + 2] * inv, o[qt][mt][4 * gq + 3] * inv);
        *(uint2*)(out + (size_t)row * ldo + mt * 32 + 8 * gq + 4 * lh) = w;
      }
  }
}

DI void hyena_pass(const Params& p, int l, const MixBufs& m, const float* __restrict__ gT, int L, int segoff, int c, char* smem) {
  const int RS = L + 16, US = L + 16;
  unsigned* Rc = (unsigned*)smem;
  u16* U = (u16*)(smem + (size_t)2 * RS * 4);
  const int tid = ltid(), lane = tid & 63, wave = tid >> 6;
  for (int d = tid; d < L; d += NTHR) {
    const int q = 2 * d;
    const float r0 = gT[(size_t)(2 * L - 2 - q) * 256 + c];
    const float r1 = (q + 1 <= 2 * L - 2) ? gT[(size_t)(2 * L - 3 - q) * 256 + c] : 0.f;
    const float r2 = (q + 2 <= 2 * L - 2) ? gT[(size_t)(2 * L - 4 - q) * 256 + c] : 0.f;
    Rc[d] = pack2(r0, r1);
    Rc[RS + d] = pack2(r1, r2);
  }
  const float* cw = p.hy_conv_w + l * 3 * 768;
  const float* cb = p.hy_conv_b + l * 768;
  {
    const float w0a = cw[c], w1a = cw[768 + c], w2a = cw[1536 + c], ba = cb[c];
    const float w0v = cw[512 + c], w1v = cw[768 + 512 + c], w2v = cw[1536 + 512 + c], bv = cb[512 + c];
    for (int b = 0; b < BG; ++b) {
      const u16* x1p = m.pt + (size_t)c * TG + b * LT + segoff;
      const u16* vp = m.pt + (size_t)(512 + c) * TG + b * LT + segoff;
      for (int t = tid; t < L; t += NTHR) {
        float x1 = bf2f(x1p[t]) * w1a + ba;
        float vv = bf2f(vp[t]) * w1v + bv;
        if (t > 0) { x1 += bf2f(x1p[t - 1]) * w0a; vv += bf2f(vp[t - 1]) * w0v; }
        if (t < L - 1) { x1 += bf2f(x1p[t + 1]) * w2a; vv += bf2f(vp[t + 1]) * w2v; }
        U[b * US + t] = f2bf(x1 * vv);
      }
    }
  }
  __syncthreads();
  const int i = lane & 31, h = lane >> 5, bn = i & 3, mb = i >> 2;
  const int par = (L - 1 - i) & 1;
  const float bias = p.hy_bias[l * 256 + c];
  const float w0x = cw[256 + c], w1x = cw[768 + 256 + c], w2x = cw[1536 + 256 + c], bx = cb[256 + c];
  const int nsteps = (L + 208) / 16 + 1;
  for (int sp = wave; sp < L / 256; sp += 4) {
    const int T0 = sp * 256;
    f32x16 acc;
#pragma unroll
    for (int r = 0; r < 16; ++r) acc[r] = 0.f;
    const int delta0 = T0 + 224;
    const int q0 = (L - 1) - delta0 - i + 8 * h;
    const unsigned* ap = Rc + par * RS + (q0 >> 1);
    int s0 = T0 + 32 * mb - delta0;
    const u16* bp = U + bn * US + s0 + 8 * h;
#pragma unroll 2
    for (int st = 0; st < nsteps; ++st) {
      uint4 aw;
      aw.x = ap[0]; aw.y = ap[1]; aw.z = ap[2]; aw.w = ap[3];
      uint4 bw = make_uint4(0u, 0u, 0u, 0u);
      if (s0 >= 0 && s0 <= L - 16) bw = *(const uint4*)bp;
      acc = MFMA32(__builtin_bit_cast(bf16x8, aw), __builtin_bit_cast(bf16x8, bw), acc);
      ap += 8;
      s0 += 16;
      bp += 16;
    }
    const u16* x2p = m.pt + (size_t)(256 + c) * TG + bn * LT + segoff;
    u16* yp = m.u + (size_t)c * TG + bn * LT + segoff;
#pragma unroll
    for (int gq = 0; gq < 4; ++gq) {
      const int t4 = T0 + 32 * mb + 8 * gq + 4 * h;
      float e[6];
#pragma unroll
      for (int k = 0; k < 6; ++k) {
        const int tt = t4 - 1 + k;
        e[k] = (tt >= 0 && tt < L) ? bf2f(x2p[tt]) : 0.f;
      }
      const uint2 uu = *(const uint2*)(U + bn * US + t4);
      const float u0 = bflo_(uu.x), u1 = bfhi_(uu.x), u2 = bflo_(uu.y), u3 = bfhi_(uu.y);
      const float y0 = (e[0] * w0x + e[1] * w1x + e[2] * w2x + bx) * (acc[4 * gq + 0] + u0 * bias);
      const float y1 = (e[1] * w0x + e[2] * w1x + e[3] * w2x + bx) * (acc[4 * gq + 1] + u1 * bias);
      const float y2 = (e[2] * w0x + e[3] * w1x + e[4] * w2x + bx) * (acc[4 * gq + 2] + u2 * bias);
      const float y3 = (e[3] * w0x + e[4] * w1x + e[5] * w2x + bx) * (acc[4 * gq + 3] + u3 * bias);
      uint2 w;
      w.x = pack2(y0, y1);
      w.y = pack2(y2, y3);
      *(uint2*)(yp + t4) = w;
    }
  }
  __syncthreads();
}

#define DPP_ROR(v, n) __builtin_bit_cast(float, __builtin_amdgcn_update_dpp(0, __builtin_bit_cast(int, (v)), 0x120 + (n), 0xf, 0xf, true))
DI float row_allsum(float v) {
  v += DPP_ROR(v, 8);
  v += DPP_ROR(v, 4);
  v += DPP_ROR(v, 2);
  v += DPP_ROR(v, 1);
  return v;
}
DI float bflo(unsigned w) { return __uint_as_float(w << 16); }
DI float bfhi(unsigned w) { return __uint_as_float(w & 0xffff0000u); }
DI void scan_item(const Params& p, int l, const MixBufs& m, int bl, int hd, int dir, int rq, char* smem) {
  constexpr int TC = 16;
  constexpr int NCH = LT / TC;
  constexpr int BUF = 5 * TC * 64 + TC * 16;
  float* sbase = (float*)smem;
  float* sy = sbase + 2 * BUF;
  const int tid = ltid(), lane = tid & 63, wave = tid >> 6;
  const int kq = lane & 15, rloc = wave * 4 + (lane >> 4);
  const u16* eD = dir ? m.eb : m.ef;
  const u16* aD = dir ? m.ab : m.af;
  float* yD = dir ? m.yb : m.yf;
  const size_t rbase = (size_t)bl * LT;
  const int ss = tid >> 4, su = tid & 15, sc = su & 7;
  float kav[8];
#pragma unroll
  for (int i = 0; i < 8; ++i) kav[i] = p.rw_k_a[l * 256 + hd * 64 + sc * 8 + i];
  uint4 g0, g1, g2;
  g2.x = g2.y = g2.z = g2.w = 0u;
#define SCAN_JMAP(i) (dir ? ((i) < LC ? LC - 1 - (i) : LT - 1 - ((i) - LC)) : (i))
#define SCAN_GLOAD(i0)                                                                         \
  {                                                                                            \
    const int ii_ = (i0) + ss;                                                                 \
    const int j_ = SCAN_JMAP(ii_);                                                             \
    const size_t o_ = (rbase + j_) * 256 + hd * 64 + sc * 8;                                   \
    if (su < 8) {                                                                              \
      g0 = *(const uint4*)(m.rkk + o_);                                                        \
      g1 = *(const uint4*)(aD + o_);                                                           \
      g2 = *(const uint4*)(m.rk + o_);                                                         \
    } else {                                                                                   \
      g0 = *(const uint4*)(eD + o_);                                                           \
      g1 = *(const uint4*)(m.rr + o_);                                                         \
      if (sc < 2) g2 = *(const uint4*)(m.rv + (rbase + j_) * 256 + hd * 64 + rq * 16 + sc * 8); \
    }                                                                                          \
  }
#define SCAN_LSTORE(buf_)                                                                      \
  {                                                                                            \
    float* B_ = sbase + (buf_) * BUF;                                                          \
    const unsigned w0_[4] = {g0.x, g0.y, g0.z, g0.w};                                          \
    const unsigned w1_[4] = {g1.x, g1.y, g1.z, g1.w};                                          \
    const unsigned w2_[4] = {g2.x, g2.y, g2.z, g2.w};                                          \
    if (su < 8) {                                                                              \
      float kk_[8], bb_[8], dd_[8];                                                            \
      _Pragma("unroll") for (int q_ = 0; q_ < 4; ++q_) {                                       \
        const float k0_ = bflo(w0_[q_]), k1_ = bfhi(w0_[q_]);                                  \
        const float a0_ = bflo(w1_[q_]), a1_ = bfhi(w1_[q_]);                                  \
        const float v0_ = bflo(w2_[q_]), v1_ = bfhi(w2_[q_]);                                  \
        kk_[2 * q_] = k0_; kk_[2 * q_ + 1] = k1_;                                              \
        bb_[2 * q_] = k0_ * a0_; bb_[2 * q_ + 1] = k1_ * a1_;                                  \
        dd_[2 * q_] = v0_ * (1.f + (a0_ - 1.f) * kav[2 * q_]);                                 \
        dd_[2 * q_ + 1] = v1_ * (1.f + (a1_ - 1.f) * kav[2 * q_ + 1]);                         \
      }                                                                                        \
      float* d0_ = B_ + ss * 64 + sc * 8;                                                      \
      *(float4*)(d0_) = make_float4(kk_[0], kk_[1], kk_[2], kk_[3]);                           \
      *(float4*)(d0_ + 4) = make_float4(kk_[4], kk_[5], kk_[6], kk_[7]);                       \
      *(float4*)(d0_ + 2048) = make_float4(bb_[0], bb_[1], bb_[2], bb_[3]);                    \
      *(float4*)(d0_ + 2052) = make_float4(bb_[4], bb_[5], bb_[6], bb_[7]);                    \
      *(float4*)(d0_ + 3072) = make_float4(dd_[0], dd_[1], dd_[2], dd_[3]);                    \
      *(float4*)(d0_ + 3076) = make_float4(dd_[4], dd_[5], dd_[6], dd_[7]);                    \
    } else {                                                                                   \
      float ww_[8], rr_[8], vv_[8];                                                            \
      _Pragma("unroll") for (int q_ = 0; q_ < 4; ++q_) {                                       \
        ww_[2 * q_] = 1.f - bflo(w0_[q_]); ww_[2 * q_ + 1] = 1.f - bfhi(w0_[q_]);              \
        rr_[2 * q_] = bflo(w1_[q_]); rr_[2 * q_ + 1] = bfhi(w1_[q_]);                          \
        vv_[2 * q_] = bflo(w2_[q_]); vv_[2 * q_ + 1] = bfhi(w2_[q_]);                          \
      }                                                                                        \
      float* d0_ = B_ + ss * 64 + sc * 8;                                                      \
      *(float4*)(d0_ + 1024) = make_float4(ww_[0], ww_[1], ww_[2], ww_[3]);                    \
      *(float4*)(d0_ + 1028) = make_float4(ww_[4], ww_[5], ww_[6], ww_[7]);                    \
      *(float4*)(d0_ + 4096) = make_float4(rr_[0], rr_[1], rr_[2], rr_[3]);                    \
      *(float4*)(d0_ + 4100) = make_float4(rr_[4], rr_[5], rr_[6], rr_[7]);                    \
      if (sc < 2) {                                                                            \
        float* d1_ = B_ + 5120 + ss * 16 + sc * 8;                                             \
        *(float4*)(d1_) = make_float4(vv_[0], vv_[1], vv_[2], vv_[3]);                         \
        *(float4*)(d1_ + 4) = make_float4(vv_[4], vv_[5], vv_[6], vv_[7]);                     \
      }                                                                                        \
    }                                                                                          \
  }
  f32x2_t SA = {0.f, 0.f}, SB = {0.f, 0.f};
  __builtin_amdgcn_s_setprio(3);
  SCAN_GLOAD(0);
  SCAN_LSTORE(0);
  __syncthreads();
  for (int c = 0; c < NCH; ++c) {
    const int buf = c & 1;
    if (c + 1 < NCH) SCAN_GLOAD((c + 1) * TC);
    const float* B = sbase + buf * BUF;
    float* syb = sy + buf * TC * 16;
    float ypart[TC];
    float4 kkv[TC], wwv[TC], bbv[TC], ddv[TC], rrv[TC];
    float vvv[TC];
    constexpr int PF = 2;
#pragma unroll
    for (int st = 0; st < PF; ++st) {
      kkv[st] = *(const float4*)(B + st * 64 + kq * 4);
      wwv[st] = *(const float4*)(B + 1024 + st * 64 + kq * 4);
      bbv[st] = *(const float4*)(B + 2048 + st * 64 + kq * 4);
      ddv[st] = *(const float4*)(B + 3072 + st * 64 + kq * 4);
      rrv[st] = *(const float4*)(B + 4096 + st * 64 + kq * 4);
      vvv[st] = B[5120 + st * 16 + rloc];
    }
    __builtin_amdgcn_sched_barrier(0);
#pragma unroll
    for (int st = 0; st < TC; ++st) {
      if (st + PF < TC) {
        kkv[st + PF] = *(const float4*)(B + (st + PF) * 64 + kq * 4);
        wwv[st + PF] = *(const float4*)(B + 1024 + (st + PF) * 64 + kq * 4);
        bbv[st + PF] = *(const float4*)(B + 2048 + (st + PF) * 64 + kq * 4);
        ddv[st + PF] = *(const float4*)(B + 3072 + (st + PF) * 64 + kq * 4);
        rrv[st + PF] = *(const float4*)(B + 4096 + (st + PF) * 64 + kq * 4);
        vvv[st + PF] = B[5120 + (st + PF) * 16 + rloc];
      }
      __builtin_amdgcn_sched_barrier(0);
      const float4 kk = kkv[st], ww = wwv[st], bb = bbv[st], dd = ddv[st], rr = rrv[st];
      const float vv = vvv[st];
      const f32x2_t k01 = {kk.x, kk.y}, k23 = {kk.z, kk.w}, w01 = {ww.x, ww.y}, w23 = {ww.z, ww.w};
      const f32x2_t b01 = {bb.x, bb.y}, b23 = {bb.z, bb.w}, d01 = {dd.x, dd.y}, d23 = {dd.z, dd.w};
      const f32x2_t r01 = {rr.x, rr.y}, r23 = {rr.z, rr.w}, v2 = {vv, vv};
      const f32x2_t pp2 = SA * k01 + SB * k23;
      const float part = pp2.x + pp2.y;
      const f32x2_t cA = SA * w01 + v2 * d01, cB = SB * w23 + v2 * d23;
      const float sa = -row_allsum(part);
      const f32x2_t sa2 = {sa, sa};
      SA = cA + sa2 * b01;
      SB = cB + sa2 * b23;
      const f32x2_t yy2 = SA * r01 + SB * r23;
      ypart[st] = yy2.x + yy2.y;
    }
#pragma unroll
    for (int st = 0; st < TC; ++st) ypart[st] = row_allsum(ypart[st]);
    if (kq == 0) {
#pragma unroll
      for (int st = 0; st < TC; ++st) syb[st * 16 + rloc] = ypart[st];
    }
    if (c + 1 < NCH) SCAN_LSTORE(buf ^ 1);
    __syncthreads();
    {
      const int st = tid >> 4, r_ = tid & 15;
      const int ii = c * TC + st;
      const int j = SCAN_JMAP(ii);
      yD[(rbase + j) * 256 + hd * 64 + rq * 16 + r_] = syb[st * 16 + r_];
    }
  }
  __builtin_amdgcn_s_setprio(0);
  __syncthreads();
}

DI void readout_hy_phase(int g, const MixBufs& m, u16* __restrict__ ymix, bool skip_ctx, char* smem) {
  const int tid = ltid();
  {
    u16* tile = (u16*)smem;
    for (int tl = blockIdx.x; tl < (TG / 64) * 4; tl += gridDim.x) {
      const int rl0 = (tl >> 2) * 64, c0 = (tl & 3) * 64;
      const int r0 = g * TG + rl0;
      if (skip_ctx && (r0 % LT) < LC) continue;
#pragma unroll
      for (int k = 0; k < 2; ++k) {
        const int id = tid + NTHR * k, ch = id >> 3, part = id & 7;
        *(uint4*)(tile + ch * 72 + part * 8) = *(const uint4*)(m.u + (size_t)(c0 + ch) * TG + rl0 + part * 8);
      }
      __syncthreads();
#pragma unroll
      for (int k = 0; k < 2; ++k) {
        const int id = tid + NTHR * k, tok = id >> 3, part = id & 7;
        const u16* tp = tile + (part * 8) * 72 + tok;
        uint4 w;
        w.x = (unsigned)tp[0] | ((unsigned)tp[72] << 16);
        w.y = (unsigned)tp[2 * 72] | ((unsigned)tp[3 * 72] << 16);
        w.z = (unsigned)tp[4 * 72] | ((unsigned)tp[5 * 72] << 16);
        w.w = (unsigned)tp[6 * 72] | ((unsigned)tp[7 * 72] << 16);
        *(uint4*)(ymix + (size_t)(r0 + tok) * D + c0 + part * 8) = w;
      }
      __syncthreads();
    }
  }
}

DI void readout_rw_phase(const Params& p, int l, int g, const MixBufs& m, u16* __restrict__ ymix, bool skip_ctx) {
  const int tid = ltid();
  for (int rl = blockIdx.x; rl < TG; rl += gridDim.x) {
    const int r = g * TG + rl;
    const int j = r % LT;
    if (skip_ctx && j < LC) continue;
    const size_t o = (size_t)rl * 256 + tid;
    float y = m.yf[o] + m.yb[o];
    float mean = wave_sum(y) * (1.f / 64.f);
    float dv = y - mean;
    float var = wave_sum(dv * dv) * (1.f / 64.f);
    float yn = dv * rsqrtf(var + 64e-5f) * p.rw_ln_w[l * 256 + tid] + p.rw_ln_b[l * 256 + tid];
    const float rr = bf2f(m.rr[o]), kv = bf2f(m.rk[o]), vv = bf2f(m.rv[o]);
    const float kaa = p.rw_k_a[l * 256 + tid], rk = p.rw_r_k[l * 256 + tid];
    const float af = bf2f(m.af[o]), ab = bf2f(m.ab[o]);
    float t1 = rr * kv * (1.f + (af - 1.f) * kaa) * rk + rr * kv * (1.f + (ab - 1.f) * kaa) * rk;
    float bonus = wave_sum(t1) * vv;
    ymix[(size_t)r * D + 768 + tid] = f2bf((yn + bonus) * bf2f(m.gg[o]));
  }
}

#define XB_TMO      128
#define XB_XCNT(j)  (256  + 64 * (j))
#define XB_XSUB(j)  (1280 + 64 * (j))
#define XB_XGEN(j)  (2304 + 64 * (j))
#define XB_TOP      3328
#define XB_TOPGEN   3392
#define XCD_BAR_WORDS 3456
#define XB_SPIN_CAP (1u << 21)
#define LAS __attribute__((address_space(3)))
DI unsigned xb_ld(unsigned* p) { return __hip_atomic_load(p, __ATOMIC_RELAXED, __HIP_MEMORY_SCOPE_AGENT); }
DI unsigned xb_add(unsigned* p, unsigned v) { return __hip_atomic_fetch_add(p, v, __ATOMIC_RELAXED, __HIP_MEMORY_SCOPE_AGENT); }
DI unsigned xb_xcc_id() { return (unsigned)__builtin_amdgcn_s_getreg((3 << 11) | 20) & 0xFu; }
#define XB_SPIN(cond, bar) do { unsigned _sp = 0; while (cond) { __builtin_amdgcn_s_sleep(1); \
    if ((++_sp & 255u) == 0u) { if (xb_ld(&(bar)[XB_TMO])) break; if (_sp > XB_SPIN_CAP) { atomicAdd(&(bar)[XB_TMO], 1u); break; } } } } while (0)
struct XcdBarrier { unsigned* bar; unsigned x; volatile LAS unsigned* st; };
DI XcdBarrier xcd_barrier_post(unsigned* bar, volatile LAS unsigned* st) {
  XcdBarrier b; b.bar = bar; b.x = xb_xcc_id(); b.st = st;
  if (threadIdx.x == 0) (void)xb_add(&bar[XB_XCNT(b.x)], 1u);
  return b;
}
DI void xcd_barrier_complete(unsigned* bar, unsigned x, unsigned& nloc, unsigned& nx) {
  const unsigned G = gridDim.x * gridDim.y * gridDim.z;
  unsigned sum, cnt, mine, sp = 0u;
  for (;;) {
    sum = 0u; cnt = 0u; mine = 0u;
#pragma unroll
    for (unsigned j = 0; j < 16; ++j) { const unsigned c = xb_ld(&bar[XB_XCNT(j)]); sum += c; cnt += (c > 0u) ? 1u : 0u; mine = (j == x) ? c : mine; }
    if (sum == G) break;
    __builtin_amdgcn_s_sleep(1);
    if ((++sp & 255u) == 0u) { if (xb_ld(&bar[XB_TMO])) break; if (sp > XB_SPIN_CAP) { atomicAdd(&bar[XB_TMO], 1u); break; } }
  }
  nloc = mine > 0u ? mine : 1u; nx = cnt > 0u ? cnt : 1u;
}
DI void xcd_barrier(const XcdBarrier& b) {
  asm volatile("s_waitcnt vmcnt(0)" ::: "memory");
  __syncthreads();
  if (threadIdx.x == 0) {
    unsigned* bar = b.bar;
    __builtin_amdgcn_s_waitcnt(0);
    unsigned nloc = b.st[0], nx = b.st[1];
    if (nloc == 0u) { xcd_barrier_complete(bar, b.x, nloc, nx); b.st[0] = nloc; b.st[1] = nx; }
    const unsigned old = xb_add(&bar[XB_XSUB(b.x)], 1u);
    const unsigned gen = old / nloc;
    if (old + 1u == (gen + 1u) * nloc) {
      __builtin_amdgcn_fence(__ATOMIC_RELEASE, "agent");
      asm volatile("s_waitcnt vmcnt(0)" ::: "memory");
      const unsigned og = xb_add(&bar[XB_TOP], 1u);
      const unsigned tg = og / nx;
      if (og + 1u == (tg + 1u) * nx) xb_add(&bar[XB_TOPGEN], 1u);
      else XB_SPIN(xb_ld(&bar[XB_TOPGEN]) == tg, bar);
      __builtin_amdgcn_fence(__ATOMIC_ACQUIRE, "agent");
      xb_add(&bar[XB_XGEN(b.x)], 1u);
      asm volatile("s_waitcnt vmcnt(0)" ::: "memory");
    } else {
      XB_SPIN(xb_ld(&bar[XB_XGEN(b.x)]) == gen, bar);
      __builtin_amdgcn_fence(__ATOMIC_ACQUIRE, "agent");
      asm volatile("s_waitcnt vmcnt(0)" ::: "memory");
    }
  }
  __syncthreads();
}

DI int conv_job_tiles(int j) {
  return (j <= 2 || j >= 12) ? 704 : j == 3 ? 720 : j == 4 ? 24 : j == 5 ? 16 : j <= 9 ? 4 : j == 10 ? 8 : 256;
}
DI void conv_job_tile(const Params& p, int l, int j, int t, u16* W, char* smem) {
  switch (j) {
    case 0: convT_tile(p.ffn1_gate + (size_t)l * D * DFF, D, DFF, W + W_GU1, 1, t, smem); break;
    case 1: convT_tile(p.ffn1_up + (size_t)l * D * DFF, D, DFF, W + W_GU1, 2, t, smem); break;
    case 2: convT_tile(p.ffn1_down + (size_t)l * D * DFF, DFF, D, W + W_D1, 0, t, smem); break;
    case 3: convT_tile(p.w_in + (size_t)l * D * DIN, D, DIN, W + W_IN, 0, t, smem); break;
    case 4: convT_tile(p.mla_w_uq + (size_t)l * 256 * 384, 256, 384, W + W_UQ, 0, t, smem); break;
    case 5: convT_tile(p.mla_w_ukv + (size_t)l * 128 * 512, 128, 512, W + W_UKV, 0, t, smem); break;
    case 6: convT_tile(p.rw_w2 + (size_t)(l * 2 + 0) * 64 * 256, 64, 256, W + W_W2, 0, t, smem); break;
    case 7: convT_tile(p.rw_w2 + (size_t)(l * 2 + 1) * 64 * 256, 64, 256, W + W_W2 + (size_t)256 * 64, 0, t, smem); break;
    case 8: convT_tile(p.rw_a2 + (size_t)(l * 2 + 0) * 64 * 256, 64, 256, W + W_A2, 0, t, smem); break;
    case 9: convT_tile(p.rw_a2 + (size_t)(l * 2 + 1) * 64 * 256, 64, 256, W + W_A2 + (size_t)256 * 64, 0, t, smem); break;
    case 10: convT_tile(p.rw_g2 + (size_t)l * 128 * 256, 128, 256, W + W_G2, 0, t, smem); break;
    case 11: convT_tile(p.w_out + (size_t)l * D * D, D, D, W + W_OUT, 0, t, smem); break;
    case 12: convT_tile(p.ffn2_gate + (size_t)l * D * DFF, D, DFF, W + W_GU2, 1, t, smem); break;
    case 13: convT_tile(p.ffn2_up + (size_t)l * D * DFF, D, DFF, W + W_GU2, 2, t, smem); break;
    default: convT_tile(p.ffn2_down + (size_t)l * D * DFF, DFF, D, W + W_D2, 0, t, smem); break;
  }
}
constexpr int AUX_EARLY = 704 * 3 + 720 + 24 + 16 + 16 + 8;
constexpr int AUX_LATE = 256 + 704 * 3;
DI void aux_tile(const Params& p, int l, int a, u16* W, char* smem) {
  int jl = 1, j0 = 11;
  if (l == 0 && a < AUX_EARLY) j0 = 0;
  else if (l == 0) { a -= AUX_EARLY; jl = 0; }
  int j = j0;
  for (;;) {
    const int n = conv_job_tiles(j);
    if (a < n) break;
    a -= n;
    ++j;
  }
  conv_job_tile(p, jl, j, a, W, smem);
}

__global__ void __launch_bounds__(NTHR, 2) fwd_megakernel(Params p) {
  cg::grid_group grid = cg::this_grid();
  __shared__ __attribute__((aligned(16))) char smem[73728];
  __shared__ int s_item;
  __shared__ uint4 xb_words;
  if (threadIdx.x == 0) xb_words = make_uint4(0u, 0u, 0u, 0u);
  __syncthreads();
  const XcdBarrier xb = xcd_barrier_post((unsigned*)(p.ws + OFF_BAR), (volatile LAS unsigned*)&xb_words);
  char* ws = p.ws;
  float* ctxs = (float*)(ws + OFF_CTX);
  float* mod = (float*)(ws + OFF_MOD);
  u16* hbuf = (u16*)(ws + OFF_H);
  char* big = ws + OFF_BIG;
  u16* Gbuf = (u16*)big;
  u16* const Wl = (u16*)(ws + OFF_W);
  float* const filt = (float*)(ws + OFF_FILT);

  for (int j = 0; j <= 10; ++j)
    for (int t = blockIdx.x; t < conv_job_tiles(j); t += gridDim.x) conv_job_tile(p, 0, j, t, Wl, smem);
  hyfilt_phase(p, 0, LQ, filt, smem);
  hyfilt_phase(p, 0, LC, (float*)(ws + OFF_FILTC), smem);
  rope_table_phase((float2*)(ws + OFF_ROPEG), (float2*)(ws + OFF_ROPEM));
  mod_phase(p, mod, smem);
  grid.sync();

  for (int l = 0; l < 2; ++l) {
    const bool last = (l == 1);
    const u16* W = Wl;
    if (l == 1) {
      hyfilt_phase(p, 1, LQ, filt, smem);
    }
    const float* modl = mod + (size_t)l * 9 * 9216;
    const float* lat_in = (l == 0) ? p.x : p.out;
    const float* ctx_in = (l == 0) ? p.ctx : ctxs;

    adaln_phase(lat_in, ctx_in, p.norm_ffn1 + l * D, modl, 0, hbuf, false);
    xcd_barrier(xb);
    {
      EpiGU e{Gbuf};
      for (int rep = 0; rep < REP_GU; ++rep) gemm_phase<true>(hbuf, D, W + W_GU1, D, D, T / 128, 44, 0, false, smem, e);
    }
    xcd_barrier(xb);
    {
      EpiRes e{lat_in, ctx_in, p.out, ctxs, modl, 2, 0.5f, nullptr, nullptr, nullptr, 0};
      gemm_phase<false>(Gbuf, DFF, W + W_D1, DFF, DFF, T / 128, 8, 0, false, smem, e);
    }
    xcd_barrier(xb);
    adaln_phase(p.out, ctxs, p.norm_mix + l * D, modl, 1, hbuf, false);
    xcd_barrier(xb);
    for (int g = 0; g < NG; ++g) {
      const MixBufs m = mixbufs(big, g);
      const u16* hg = hbuf + (size_t)g * TG * D;
      {
        EpiWin e{m.p, m.pt};
        gemm_phase<false>(hg, D, W + W_IN, D, D, TG / 128, 23, 0, false, smem, e);
      }
      xcd_barrier(xb);
      for (int rep = 0; rep < REP_ROW; ++rep) prep_phase(p, l, g, m, (const float2*)(ws + OFF_ROPEG), smem);
      xcd_barrier(xb);
      {
        EpiStore e1{m.qup, 384, 384};
        gemm_phase<false>(m.cqn, 256, W + W_UQ, 256, 256, TG / 128, 3, 0, false, smem, e1);
        EpiStore e2{m.kvup, 512, 512};
        gemm_phase<false>(m.ckvn, 128, W + W_UKV, 128, 128, TG / 128, 4, 0, false, smem, e2);
        EpiLoraW e3{m.ef, p.rw_w0 + (l * 2 + 0) * 256};
        gemm_phase<false>(m.lwf, 64, W + W_W2, 64, 64, TG / 128, 2, 0, false, smem, e3);
        EpiLoraW e4{m.eb, p.rw_w0 + (l * 2 + 1) * 256};
        gemm_phase<false>(m.lwb, 64, W + W_W2 + 256 * 64, 64, 64, TG / 128, 2, 0, false, smem, e4);
        EpiLoraA e5{m.af, p.rw_a0 + (l * 2 + 0) * 256};
        gemm_phase<false>(m.laf, 64, W + W_A2, 64, 64, TG / 128, 2, 0, false, smem, e5);
        EpiLoraA e6{m.ab, p.rw_a0 + (l * 2 + 1) * 256};
        gemm_phase<false>(m.lab, 64, W + W_A2 + 256 * 64, 64, 64, TG / 128, 2, 0, false, smem, e6);
        EpiStore e7{m.gg, 256, 256};
        gemm_phase<false>(m.lg, 128, W + W_G2, 128, 128, TG / 128, 2, 0, false, smem, e7);
      }
      xcd_barrier(xb);
      for (int rep = 0; rep < REP_ROW; ++rep) mla_fin_phase(p, l, g, m, (const float2*)(ws + OFF_ROPEM));
      xcd_barrier(xb);
      {
        u16* ymix = hbuf;
        const int n_scan = (g == NG - 1) ? NG * BG * 4 * 2 * 4 : 0;
        const int qt_per_b = last ? 16 : 17;
        const int n_att = BG * 4 * qt_per_b;
        const int n_gqa = (g == NG - 1) ? NG * n_att : 0;
        const int n_hy = 256;
        const int total = n_scan + n_att + n_gqa + n_hy;
        float gq = 0.f, gk = 0.f, mq = 0.f, mk = 0.f;
        for (int i = 0; i < 64; ++i) { gq = fmaxf(gq, fabsf(p.gqa_q_norm[l * 64 + i])); gk = fmaxf(gk, fabsf(p.gqa_k_norm[l * 64 + i])); }
        for (int i = 0; i < 96; ++i) { mq = fmaxf(mq, fabsf(p.mla_q_norm[l * 96 + i])); mk = fmaxf(mk, fabsf(p.mla_k_norm[l * 96 + i])); }
        const float L2E = 1.4426950408889634f;
        const float sc_g = 0.125f, sc_m = 0.10206207261596575f;
        const float sh_g = (64.f * gq * gk * sc_g * 1.02f + 0.5f) * L2E;
        const float sh_m = (96.f * mq * mk * sc_m * 1.02f + 0.5f) * L2E;
        int* cnt = (int*)(ws + OFF_CNT) + (l * NG + g);
        for (;;) {
          if (threadIdx.x == 0) s_item = atomicAdd(cnt, 1);
          __syncthreads();
          const int it = s_item;
          __syncthreads();
          if (it >= total) break;
          if (it < n_scan) {
            const int sg = it >> 7, bl = (it >> 5) & 3, hd = (it >> 3) & 3, dir = (it >> 2) & 1, rq = it & 3;
            const MixBufs ms = mixbufs(big, sg);
            scan_item(p, l, ms, bl, hd, dir, rq, smem);
          } else if (it < n_scan + n_att + n_gqa) {
            int a = it - n_scan;
            const int kind = a < n_att ? 0 : 1;
            int ag = g;
            if (kind == 1) { a -= n_att; ag = a / n_att; a -= ag * n_att; }
            const int bl = a / (4 * qt_per_b);
            int rem = a - bl * 4 * qt_per_b;
            const int hd = rem / qt_per_b;
            const int qt = rem - hd * qt_per_b;
            const int j0 = qt < 16 ? LC + qt * 256 : 0;
            const int nkeys = qt < 16 ? LT : LC;
            const size_t rl0 = (size_t)bl * LT + j0;
            const size_t rg0 = (size_t)(ag * BG + bl) * LT + j0;
            if (kind == 1) {
              const MixBufs ma = mixbufs(big, ag);
              const int kvh = hd >> 1;
              attn_item<64, 2>(ma.qg + rl0 * 256 + hd * 64, 256, ma.kg + (size_t)bl * LT * 128 + kvh * 64, 128,
                            ma.vtg + (size_t)(bl * 2 + kvh) * 64 * LT, ymix + rg0 * D + 256 + hd * 64, D, nkeys, sc_g * L2E, sh_g, smem);
            } else {
              attn_item<96, 2>(m.qm + rl0 * 384 + hd * 96, 384, m.km + (size_t)bl * LT * 384 + hd * 96, 384,
                            m.vtm + (size_t)(bl * 4 + hd) * 64 * LT, ymix + rg0 * D + 512 + hd * 64, D, nkeys, sc_m * L2E, sh_m, smem);
            }
          } else {
            const int c = it - n_scan - n_att - n_gqa;
            hyena_pass(p, l, m, filt, LQ, LC, c, smem);
            if (!last) hyena_pass(p, l, m, (const float*)(ws + OFF_FILTC), LC, 0, c, smem);
          }
        }
        if (g == NG - 1) {
          int* acnt = (int*)(ws + OFF_CNT) + 16 + l;
          const int n_aux = l == 0 ? AUX_EARLY + AUX_LATE : AUX_LATE;
          for (;;) {
            if (threadIdx.x == 0) s_item = atomicAdd(acnt, 1);
            __syncthreads();
            const int a = s_item;
            __syncthreads();
            if (a >= n_aux) break;
            aux_tile(p, l, a, Wl, smem);
          }
        }
        xcd_barrier(xb);
        readout_hy_phase(g, m, ymix, last, smem);
        if (g == NG - 1) {
          for (int rg = 0; rg < NG; ++rg) {
            const MixBufs mr = mixbufs(big, rg);
            readout_rw_phase(p, l, rg, mr, ymix, last);
          }
          xcd_barrier(xb);
        }
      }
    }
    {
      EpiRes e{p.out, ctxs, p.out, ctxs, modl, 5, 1.0f, nullptr, nullptr, nullptr, 0};
      gemm_phase<false>(hbuf, D, W + W_OUT, D, D, T / 128, 8, 0, last, smem, e);
    }
    xcd_barrier(xb);
    adaln_phase(p.out, ctxs, p.norm_ffn2 + l * D, modl, 2, hbuf, last);
    xcd_barrier(xb);
    {
      EpiGU e{Gbuf};
      for (int rep = 0; rep < REP_GU; ++rep) gemm_phase<true>(hbuf, D, W + W_GU2, D, D, T / 128, 44, 0, last, smem, e);
    }
    xcd_barrier(xb);
    {
      EpiRes e{p.out, ctxs, p.out, ctxs, modl, 8, 0.5f, nullptr, nullptr, nullptr, 0};
      gemm_phase<false>(Gbuf, DFF, W + W_D2, DFF, DFF, T / 128, 8, 0, last, smem, e);
    }
    xcd_barrier(xb);
  }
}

extern "C" void kernel_launch(void* const* d_in, const int* in_sizes, int n_in, void* d_out, int out_size, void* d_ws,
                              size_t ws_size, hipStream_t stream) {
  static int grid_blocks = 0;
  if (!grid_blocks) {
    int dev = 0, cus = 0, per_cu = 0;
    (void)hipGetDevice(&dev);
    (void)hipDeviceGetAttribute(&cus, hipDeviceAttributeMultiprocessorCount, dev);
    (void)hipOccupancyMaxActiveBlocksPerMultiprocessor(&per_cu, fwd_megakernel, NTHR, 0);
    if (per_cu > 2) per_cu = 2;
    if (per_cu < 1) per_cu = 1;
    grid_blocks = cus * per_cu;
  }
  Params p{};
  const float** pp = (const float**)&p;
  for (int i = 0; i < 47; ++i) pp[i] = (const float*)d_in[i];
  p.out = (float*)d_out;
  p.ws = (char*)d_ws;
  (void)hipMemsetAsync((char*)d_ws + OFF_CNT, 0, 256 + 3456 * 4, stream);
  void* args[] = {&p};
  hipError_t e = hipLaunchCooperativeKernel((void*)fwd_megakernel, dim3(grid_blocks), dim3(NTHR), args, 0, stream);
  if (e != hipSuccess) fprintf(stderr, "cooperative launch failed: %s (grid %d)\n", hipGetErrorString(e), grid_blocks);
}
```

```cpp
#include <hip/hip_runtime.h>
#include <hip/hip_bf16.h>
#include <hip/hip_cooperative_groups.h>
#include <cstdio>
namespace cg = cooperative_groups;

#define DI __device__ __forceinline__
typedef unsigned short u16;
using bf16x8 = __attribute__((ext_vector_type(8))) short;
using f32x16 = __attribute__((ext_vector_type(16))) float;
typedef __bf16 bf16x2_t __attribute__((ext_vector_type(2)));
typedef float f32x2_t __attribute__((ext_vector_type(2)));
#define MFMA32(a, b, c) __builtin_amdgcn_mfma_f32_32x32x16_bf16((a), (b), (c), 0, 0, 0)

constexpr int D = 1024, NB = 8, LQ = 4096, LC = 256, LT = 4352, T = NB * LT, DFF = 2816, DIN = 2848;
constexpr int HYC = 768, DINP = DIN - HYC;
constexpr int NG = 2, BG = NB / NG, TG = BG * LT;
constexpr int NTHR = 256;
#define REP_MIX 1
#define REP_GU 1
#define REP_MISC 1
#define REP_ROW 1
constexpr float EPS = 1e-6f;

constexpr size_t al(size_t x) { return (x + 255) & ~(size_t)255; }
constexpr size_t OFF_CTX = 0;
constexpr size_t OFF_MOD = OFF_CTX + al((size_t)NB * LC * D * 4);
constexpr size_t SZ_FILT_L = (size_t)(2 * LQ - 1) * 256 * 4;
constexpr size_t SZ_FILT_C = (size_t)(2 * LC - 1) * 256 * 4;
constexpr size_t OFF_CNT = OFF_MOD + al((size_t)2 * 9 * 9216 * 4);
constexpr size_t OFF_BAR = OFF_CNT + 256;
constexpr size_t OFF_FILT = OFF_BAR + al((size_t)3456 * 4);
constexpr size_t OFF_FILTC = OFF_FILT + al(SZ_FILT_L);
constexpr size_t OFF_ROPEG = OFF_FILTC + al(SZ_FILT_C);
constexpr size_t OFF_ROPEM = OFF_ROPEG + al((size_t)LQ * 32 * 8);
constexpr size_t OFF_W = OFF_ROPEM + al((size_t)LQ * 16 * 8);
constexpr size_t W_GU1 = 0;
constexpr size_t W_D1 = W_GU1 + (size_t)5632 * 1024;
constexpr size_t W_GU2 = W_D1 + (size_t)1024 * 2816;
constexpr size_t W_D2 = W_GU2 + (size_t)5632 * 1024;
constexpr size_t W_IN = W_D2 + (size_t)1024 * 2816;
constexpr size_t W_OUT = W_IN + (size_t)2944 * 1024;
constexpr size_t W_UQ = W_OUT + (size_t)1024 * 1024;
constexpr size_t W_UKV = W_UQ + (size_t)384 * 256;
constexpr size_t W_W2 = W_UKV + (size_t)512 * 128;
constexpr size_t W_A2 = W_W2 + (size_t)2 * 256 * 64;
constexpr size_t W_G2 = W_A2 + (size_t)2 * 256 * 64;
constexpr size_t W_LAYER = W_G2 + (size_t)256 * 128;
constexpr size_t OFF_H = OFF_W + al(W_LAYER * 2);
constexpr size_t OFF_BIG = OFF_H + al((size_t)T * D * 2);
constexpr size_t M_P = 0;
constexpr size_t M_PT = M_P + al((size_t)TG * DINP * 2);
constexpr size_t M_U = M_PT + al((size_t)HYC * TG * 2);
constexpr size_t M_CQN = M_U + al((size_t)TG * 256 * 2);
constexpr size_t M_CKVN = M_CQN + al((size_t)TG * 256 * 2);
constexpr size_t M_QUP = M_CKVN + al((size_t)TG * 128 * 2);
constexpr size_t M_KVUP = M_QUP + al((size_t)TG * 384 * 2);
constexpr size_t M_QM = M_KVUP + al((size_t)TG * 512 * 2);
constexpr size_t M_KM = M_QM + al((size_t)TG * 384 * 2);
constexpr size_t M_VTM = M_KM + al((size_t)TG * 384 * 2);
constexpr size_t M_LWF = M_VTM + al((size_t)TG * 256 * 2);
constexpr size_t M_LWB = M_LWF + al((size_t)TG * 64 * 2);
constexpr size_t M_LAF = M_LWB + al((size_t)TG * 64 * 2);
constexpr size_t M_LAB = M_LAF + al((size_t)TG * 64 * 2);
constexpr size_t M_LG = M_LAB + al((size_t)TG * 64 * 2);
constexpr size_t SZ_SC = al((size_t)TG * 256 * 2);
constexpr size_t M_SCAN = M_LG + al((size_t)TG * 128 * 2);
constexpr size_t SCAN_STRIDE = 11 * SZ_SC;
constexpr size_t M_END = M_SCAN + 2 * SCAN_STRIDE;
static_assert((size_t)4 * TG * 256 * 4 <= al((size_t)TG * DINP * 2), "yf/yb do not fit the p region");
constexpr size_t SZ_G = (size_t)T * DFF * 2;
constexpr size_t WS_NEED = OFF_BIG + (M_END > SZ_G ? M_END : SZ_G);
static_assert(WS_NEED <= (size_t)512 * 1024 * 1024, "workspace too large");

struct Params {
  const float *x, *c, *ctx, *c_ctx, *ada_w, *ada_b, *norm_ffn1, *norm_mix, *norm_ffn2;
  const float *ffn1_gate, *ffn1_up, *ffn1_down, *ffn2_gate, *ffn2_up, *ffn2_down, *w_in, *w_out;
  const float *hy_conv_w, *hy_conv_b, *hy_f_w1, *hy_f_b1, *hy_f_w2, *hy_f_b2, *hy_f_w3, *hy_f_b3, *hy_f_w4, *hy_f_freq, *hy_bias;
  const float *gqa_q_norm, *gqa_k_norm, *mla_cq_norm, *mla_ckv_norm, *mla_w_uq, *mla_w_ukv, *mla_q_norm, *mla_k_norm;
  const float *rw_mu, *rw_w0, *rw_w2, *rw_a0, *rw_a2, *rw_g2, *rw_k_k, *rw_k_a, *rw_r_k, *rw_ln_w, *rw_ln_b;
  float* out;
  char* ws;
};

DI u16 f2bf(float x) {
  unsigned u = __float_as_uint(x);
  u += 0x7fffu + ((u >> 16) & 1u);
  return (u16)(u >> 16);
}
DI float bf2f(u16 b) { return __uint_as_float(((unsigned)b) << 16); }
DI float bflo_(unsigned w) { return __uint_as_float(w << 16); }
DI float bfhi_(unsigned w) { return __uint_as_float(w & 0xffff0000u); }
DI unsigned pack2(float a, float b) {
  f32x2_t v = {a, b};
  bf16x2_t r = __builtin_convertvector(v, bf16x2_t);
  return __builtin_bit_cast(unsigned, r);
}
DI int ltid() {
  int t = threadIdx.x;
  asm volatile("" : "+v"(t));
  return t;
}
DI float wave_sum(float v) {
#pragma unroll
  for (int o = 32; o > 0; o >>= 1) v += __shfl_xor(v, o);
  return v;
}
DI float wave_max(float v) {
#pragma unroll
  for (int o = 32; o > 0; o >>= 1) v = fmaxf(v, __shfl_xor(v, o));
  return v;
}
DI float sigmoidf_(float x) { return __builtin_amdgcn_rcpf(1.f + __expf(-x)); }
DI int crow(int i, int h) { return (i & 3) + 8 * (i >> 2) + 4 * h; }

DI float rope_apply(float val, int idx, int nfreq, int t, int lane) {
  int pi = idx >> 1;
  int row = t >> 6, col = t & 63;
  float pos = pi < nfreq ? (float)row : (float)col;
  int f = pi < nfreq ? pi : pi - nfreq;
  float inv = exp2f(-(float)f / (float)nfreq * 13.287712379549449f);
  float ang = pos * inv;
  float cs = cosf(ang), sn = sinf(ang);
  float other = __shfl_xor(val, 1);
  return (lane & 1) ? other * sn + val * cs : val * cs - other * sn;
}

DI float rope_tab(float val, int idx, const float2* __restrict__ tab, int lane) {
  const float2 cs = tab[idx >> 1];
  const float other = __shfl_xor(val, 1);
  return (lane & 1) ? other * cs.y + val * cs.x : val * cs.x - other * cs.y;
}
DI void rope_table_phase(float2* __restrict__ tg, float2* __restrict__ tm) {
  const int tid = ltid();
  for (int e = blockIdx.x * NTHR + tid; e < LQ * 48; e += gridDim.x * NTHR) {
    const int t = e / 48, k = e - t * 48;
    const bool isg = k < 32;
    const int pi = isg ? k : k - 32, nfreq = isg ? 16 : 8;
    const int row = t >> 6, col = t & 63;
    const float pos = pi < nfreq ? (float)row : (float)col;
    const int f = pi < nfreq ? pi : pi - nfreq;
    const float inv = exp2f(-(float)f / (float)nfreq * 13.287712379549449f);
    const float ang = pos * inv;
    const float2 v = make_float2(cosf(ang), sinf(ang));
    if (isg) tg[t * 32 + pi] = v; else tm[t * 16 + pi] = v;
  }
}

DI int gu_row(int n, int half) { return (n >> 7) * 256 + ((n >> 6) & 1) * 128 + ((n >> 5) & 1) * 64 + half * 32 + (n & 31); }
DI void convT_tile(const float* __restrict__ src, int K, int N, u16* __restrict__ dst, int mode, int t, char* smem) {
  float* tile = (float*)smem;
  const int tn = (N + 63) / 64;
  const int tid_ = ltid();
  const int j = tid_ & 63, i0 = tid_ >> 6;
  const int k0 = (t / tn) * 64, n0 = (t % tn) * 64;
  for (int i = i0; i < 64; i += 4) {
    int n = n0 + j;
    tile[i * 65 + j] = n < N ? src[(size_t)(k0 + i) * N + n] : 0.f;
  }
  __syncthreads();
  for (int i = i0; i < 64; i += 4) {
    int n = n0 + i;
    if (n < N) {
      int row = mode == 0 ? n : gu_row(n, mode - 1);
      dst[(size_t)row * K + k0 + j] = f2bf(tile[j * 65 + i]);
    }
  }
  __syncthreads();
}
DI void convT(const float* __restrict__ src, int K, int N, u16* __restrict__ dst, int mode, char* smem) {
  const int tk = K / 64, tn = (N + 63) / 64;
  for (int t = blockIdx.x; t < tk * tn; t += gridDim.x) convT_tile(src, K, N, dst, mode, t, smem);
}

DI void mod_phase(const Params& p, float* __restrict__ mod, char* smem) {
  float* sc = (float*)smem;
  float* red = sc + 9 * 1024;
  const int tid_ = ltid();
  for (int i = tid_; i < 9 * 1024; i += NTHR) {
    float v = i < 8192 ? p.c[i] : p.c_ctx[i - 8192];
    sc[i] = v / (1.f + expf(-v));
  }
  __syncthreads();
  const int lane = tid_ & 63, kp = tid_ >> 6;
  for (int it = blockIdx.x; it < 2 * 144; it += gridDim.x) {
    const int l = it / 144, nb = (it % 144) * 64;
    const float* w = p.ada_w + (size_t)l * 1024 * 9216 + nb + lane;
    float acc[9];
#pragma unroll
    for (int b = 0; b < 9; ++b) acc[b] = 0.f;
    for (int k = kp * 256; k < kp * 256 + 256; ++k) {
      float wv = w[(size_t)k * 9216];
#pragma unroll
      for (int b = 0; b < 9; ++b) acc[b] += sc[b * 1024 + k] * wv;
    }
#pragma unroll
    for (int b = 0; b < 9; ++b) red[(kp * 9 + b) * 64 + lane] = acc[b];
    __syncthreads();
    for (int o = tid_; o < 9 * 64; o += NTHR) {
      int b = o >> 6, ln = o & 63;
      float s = red[(0 * 9 + b) * 64 + ln] + red[(1 * 9 + b) * 64 + ln] + red[(2 * 9 + b) * 64 + ln] + red[(3 * 9 + b) * 64 + ln];
      mod[((size_t)l * 9 + b) * 9216 + nb + ln] = s + p.ada_b[l * 9216 + nb + ln];
    }
    __syncthreads();
  }
}

DI void hyfilt_phase(const Params& p, int l, int L, float* __restrict__ gT, char* smem) {
  float* z = (float*)smem;
  float* h1 = z + 64;
  float* h2 = h1 + 64;
  float* h3 = h2 + 64;
  float* w1s = z + 256;
  float* w2s = w1s + 33 * 64;
  float* w3s = w2s + 64 * 64;
  const float* w4 = p.hy_f_w4 + l * 64 * 512;
  const int tid = ltid();
  for (int i = tid; i < 33 * 64; i += NTHR) w1s[i] = p.hy_f_w1[l * 33 * 64 + i];
  for (int i = tid; i < 64 * 64; i += NTHR) { w2s[i] = p.hy_f_w2[l * 4096 + i]; w3s[i] = p.hy_f_w3[l * 4096 + i]; }
  float b1v = 0.f, b2v = 0.f, b3v = 0.f, frv = 0.f;
  if (tid < 64) { b1v = p.hy_f_b1[l * 64 + tid]; b2v = p.hy_f_b2[l * 64 + tid]; b3v = p.hy_f_b3[l * 64 + tid]; frv = p.hy_f_freq[l * 64 + tid]; }
  const float min_decay = logf(1e-2f) / 1.5f, max_decay = logf(1e-2f) / 0.3f;
  const float delta = fabsf(min_decay + (max_decay - min_decay) * (float)tid / 255.f);
  __syncthreads();
  for (int t = blockIdx.x; t < L; t += gridDim.x) {
    const float t01 = (float)t / (float)(L - 1);
    if (tid < 33) {
      float zz;
      if (tid == 0) zz = t01;
      else {
        int i = (tid - 1) & 15;
        float f = 1e-4f + (float)i * ((15.f - 1e-4f) / 15.f);
        float wang = 6.283185307179586f * (float)t / (float)L;
        zz = tid <= 16 ? cosf(f * wang) : -sinf(f * wang);
      }
      z[tid] = zz;
    }
    __syncthreads();
    if (tid < 64) {
      float a = b1v;
#pragma unroll 11
      for (int i = 0; i < 33; ++i) a += z[i] * w1s[i * 64 + tid];
      h1[tid] = sinf(frv * a);
    }
    __syncthreads();
    if (tid < 64) {
      float a = b2v;
#pragma unroll 16
      for (int i = 0; i < 64; ++i) a += h1[i] * w2s[i * 64 + tid];
      h2[tid] = sinf(frv * a);
    }
    __syncthreads();
    if (tid < 64) {
      float a = b3v;
#pragma unroll 16
      for (int i = 0; i < 64; ++i) a += h2[i] * w3s[i * 64 + tid];
      h3[tid] = sinf(frv * a);
    }
    __syncthreads();
    float af = 0.f, ab = 0.f;
#pragma unroll 8
    for (int i = 0; i < 64; ++i) {
      af += h3[i] * w4[i * 512 + tid];
      ab += h3[i] * w4[i * 512 + 256 + tid];
    }
    const float dec = expf(-t01 * delta);
    af *= dec;
    ab *= dec;
    if (t == 0) gT[(size_t)(L - 1) * 256 + tid] = af + ab;
    else {
      gT[(size_t)(L - 1 + t) * 256 + tid] = af;
      gT[(size_t)(L - 1 - t) * 256 + tid] = ab;
    }
    __syncthreads();
  }
  __syncthreads();
}

DI void adaln_phase(const float* __restrict__ lat, const float* __restrict__ ctxp, const float* __restrict__ gain,
                    const float* __restrict__ modl, int idx, u16* __restrict__ h, bool skip_ctx) {
  const int tid_ = ltid();
  const int wave = tid_ >> 6, lane = tid_ & 63;
  for (int r = blockIdx.x * 4 + wave; r < T; r += gridDim.x * 4) {
    const int b = r / LT, j = r - b * LT;
    if (skip_ctx && j < LC) continue;
    const float* xr = j < LC ? ctxp + ((size_t)(b * LC + j) << 10) : lat + ((size_t)(b * LQ + j - LC) << 10);
    const int bb = j < LC ? 8 : b;
    const float* shift = modl + bb * 9216 + (3 * idx) * 1024;
    const float* scale = shift + 1024;
    float4 v[4];
    float ss = 0.f;
#pragma unroll
    for (int q = 0; q < 4; ++q) {
      v[q] = *(const float4*)(xr + q * 256 + lane * 4);
      ss += v[q].x * v[q].x + v[q].y * v[q].y + v[q].z * v[q].z + v[q].w * v[q].w;
    }
    ss = wave_sum(ss);
    const float rstd = rsqrtf(ss * (1.f / 1024.f) + EPS);
#pragma unroll
    for (int q = 0; q < 4; ++q) {
      const int c = q * 256 + lane * 4;
      float4 g = *(const float4*)(gain + c), sc = *(const float4*)(scale + c), sh = *(const float4*)(shift + c);
      float y0 = v[q].x * rstd * g.x * (1.f + sc.x) + sh.x;
      float y1 = v[q].y * rstd * g.y * (1.f + sc.y) + sh.y;
      float y2 = v[q].z * rstd * g.z * (1.f + sc.z) + sh.z;
      float y3 = v[q].w * rstd * g.w * (1.f + sc.w) + sh.w;
      uint2 o;
      o.x = pack2(y0, y1);
      o.y = pack2(y2, y3);
      *(uint2*)(h + (size_t)r * D + c) = o;
    }
  }
}

DI bool gemm_decode(int t, int mtiles, int ntiles, int mt_off, bool skip_ctx, int& mt, int& nt) {
  const int mtx = mtiles >> 3;
  const int xcd = t & 7, q = t >> 3;
  const int sr = q / (8 * ntiles);
  const int rem = q - sr * 8 * ntiles;
  const int rows_in = min(8, mtx - sr * 8);
  const int sc = rem / (rows_in * 8);
  const int r2 = rem - sc * rows_in * 8;
  const int i = r2 % rows_in, j = r2 / rows_in;
  mt = (sr * 8 + i) * 8 + xcd;
  nt = sc * 8 + j;
  return !(skip_ctx && ((mt + mt_off) % 34) < 2);
}
template <bool PAIRED, class Epi>
DI void gemm_phase(const u16* __restrict__ A, int lda, const u16* __restrict__ Bt, int ldb, int K, int mtiles, int ntiles,
                   int mt_off, bool skip_ctx, char* smem, Epi& epi) {
  u16* As = (u16*)smem;
  u16* Bs = As + 2 * 128 * 72;
  const int tid = ltid(), lane = tid & 63, wave = tid >> 6;
  const int wm = wave >> 1, wn = wave & 1, lr = lane & 31, lh = lane >> 5;
  const int lrow = tid >> 3, lkc = (tid & 7) * 8;
  const int total = mtiles * ntiles, nk = K >> 6;
  uint4 ra00, ra01, ra02, ra03, rb00, rb01, rb02, rb03, ra10, ra11, ra12, ra13, rb10, rb11, rb12, rb13;
  const u16* Agl;
  const u16* Bgl;
#define GEMM_GLOAD(S, kt_)                                            \
  {                                                                   \
    const int k0_ = (kt_) << 6;                                       \
    ra##S##0 = *(const uint4*)(Agl + k0_);                            \
    ra##S##1 = *(const uint4*)(Agl + (size_t)32 * lda + k0_);         \
    ra##S##2 = *(const uint4*)(Agl + (size_t)64 * lda + k0_);         \
    ra##S##3 = *(const uint4*)(Agl + (size_t)96 * lda + k0_);         \
    rb##S##0 = *(const uint4*)(Bgl + k0_);                            \
    rb##S##1 = *(const uint4*)(Bgl + (size_t)32 * ldb + k0_);         \
    rb##S##2 = *(const uint4*)(Bgl + (size_t)64 * ldb + k0_);         \
    rb##S##3 = *(const uint4*)(Bgl + (size_t)96 * ldb + k0_);         \
  }
#define GEMM_LSTORE(S, buf_)                                          \
  {                                                                   \
    u16* ad_ = As + (buf_) * 128 * 72 + lrow * 72 + lkc;              \
    u16* bd_ = Bs + (buf_) * 128 * 72 + lrow * 72 + lkc;              \
    *(uint4*)(ad_) = ra##S##0;                                        \
    *(uint4*)(ad_ + 32 * 72) = ra##S##1;                              \
    *(uint4*)(ad_ + 64 * 72) = ra##S##2;                              \
    *(uint4*)(ad_ + 96 * 72) = ra##S##3;                              \
    *(uint4*)(bd_) = rb##S##0;                                        \
    *(uint4*)(bd_ + 32 * 72) = rb##S##1;                              \
    *(uint4*)(bd_ + 64 * 72) = rb##S##2;                              \
    *(uint4*)(bd_ + 96 * 72) = rb##S##3;                              \
  }
#define GEMM_COMPUTE(buf_)                                                        \
  {                                                                               \
    const u16* as = As + (buf_) * 128 * 72 + (wm * 64 + lr) * 72 + lh * 8;        \
    const u16* bs = Bs + (buf_) * 128 * 72 + (wn * 64 + lr) * 72 + lh * 8;        \
    _Pragma("unroll") for (int ks = 0; ks < 4; ++ks) {                            \
      bf16x8 a0 = *(const bf16x8*)(as + ks * 16);                                 \
      bf16x8 a1 = *(const bf16x8*)(as + 32 * 72 + ks * 16);                       \
      bf16x8 b0 = *(const bf16x8*)(bs + ks * 16);                                 \
      bf16x8 b1 = *(const bf16x8*)(bs + 32 * 72 + ks * 16);                       \
      acc[0][0] = MFMA32(a0, b0, acc[0][0]);                                      \
      acc[0][1] = MFMA32(a0, b1, acc[0][1]);                                      \
      acc[1][0] = MFMA32(a1, b0, acc[1][0]);                                      \
      acc[1][1] = MFMA32(a1, b1, acc[1][1]);                                      \
    }                                                                             \
  }
  int t = blockIdx.x, mt = 0, nt = 0;
  while (t < total && !gemm_decode(t, mtiles, ntiles, mt_off, skip_ctx, mt, nt)) t += gridDim.x;
  if (t < total) {
    Agl = A + (size_t)(mt * 128 + lrow) * lda + lkc;
    Bgl = Bt + (size_t)(nt * 128 + lrow) * ldb + lkc;
    GEMM_GLOAD(0, 0);
  }
  while (t < total) {
    const int m0 = mt * 128, n0 = nt * 128;
    int tn = t + gridDim.x, mtn = 0, ntn = 0;
    while (tn < total && !gemm_decode(tn, mtiles, ntiles, mt_off, skip_ctx, mtn, ntn)) tn += gridDim.x;
    f32x16 acc[2][2];
#pragma unroll
    for (int a = 0; a < 2; ++a)
#pragma unroll
      for (int b = 0; b < 2; ++b)
#pragma unroll
        for (int i = 0; i < 16; ++i) acc[a][b][i] = 0.f;
    GEMM_LSTORE(0, 0);
    __syncthreads();
    if (nk > 1) GEMM_GLOAD(0, 1);
    for (int kt = 0; kt < nk; kt += 2) {
      if (kt + 2 < nk) GEMM_GLOAD(1, kt + 2);
      GEMM_COMPUTE(0);
      if (kt + 1 < nk) GEMM_LSTORE(0, 1);
      __syncthreads();
      if (kt + 1 >= nk) break;
      if (kt + 3 < nk) GEMM_GLOAD(0, kt + 3);
      GEMM_COMPUTE(1);
      if (kt + 2 < nk) GEMM_LSTORE(1, 0);
      __syncthreads();
    }
    if (tn < total) {
      Agl = A + (size_t)(mtn * 128 + lrow) * lda + lkc;
      Bgl = Bt + (size_t)(ntn * 128 + lrow) * ldb + lkc;
      GEMM_GLOAD(0, 0);
    }
    epi.tile(m0);
    if constexpr (PAIRED) {
      float* stg = (float*)smem + wave * 64 * 36;
#pragma unroll
      for (int mi = 0; mi < 2; ++mi)
#pragma unroll
        for (int i = 0; i < 16; ++i) stg[(mi * 32 + crow(i, lh)) * 36 + lr] = epi.combine(acc[mi][0][i], acc[mi][1][i]);
      __syncthreads();
#pragma unroll
      for (int k = 0; k < 8; ++k) {
        const int idx = lane + 64 * k, row = idx >> 3, c4 = idx & 7;
        const float4 v = *(const float4*)(stg + row * 36 + c4 * 4);
        epi.store4(m0 + wm * 64 + row, (n0 >> 1) + wn * 32 + c4 * 4, v);
      }
      __syncthreads();
    } else if constexpr (Epi::kStaged) {
      float* stg = (float*)smem + wave * 64 * 68;
#pragma unroll
      for (int mi = 0; mi < 2; ++mi)
#pragma unroll
        for (int ni = 0; ni < 2; ++ni)
#pragma unroll
          for (int i = 0; i < 16; ++i) stg[(mi * 32 + crow(i, lh)) * 68 + ni * 32 + lr] = acc[mi][ni][i];
      __syncthreads();
#pragma unroll 4
      for (int k = 0; k < 16; ++k) {
        const int idx = lane + 64 * k, row = idx >> 4, c4 = idx & 15;
        const float4 v = *(const float4*)(stg + row * 68 + c4 * 4);
        epi.row4(m0 + wm * 64 + row, n0 + wn * 64 + c4 * 4, v);
      }
      __syncthreads();
    } else {
#pragma unroll
      for (int mi = 0; mi < 2; ++mi) {
#pragma unroll
        for (int gq = 0; gq < 4; ++gq) {
          const int row0 = m0 + wm * 64 + mi * 32 + 8 * gq + 4 * lh;
          if (PAIRED) {
            const int col = (n0 >> 1) + wn * 32 + lr;
#pragma unroll
            for (int e = 0; e < 4; ++e) epi.pair(row0 + e, col, acc[mi][0][4 * gq + e], acc[mi][1][4 * gq + e]);
          } else {
            epi.quad(row0, n0 + wn * 64 + lr, acc[mi][0][4 * gq], acc[mi][0][4 * gq + 1], acc[mi][0][4 * gq + 2], acc[mi][0][4 * gq + 3]);
            epi.quad(row0, n0 + wn * 64 + 32 + lr, acc[mi][1][4 * gq], acc[mi][1][4 * gq + 1], acc[mi][1][4 * gq + 2], acc[mi][1][4 * gq + 3]);
          }
        }
      }
    }
    t = tn; mt = mtn; nt = ntn;
  }
}

template <class Epi>
DI void gemm_gu_phase(const u16* __restrict__ A, const u16* __restrict__ Bt, int mtiles, bool skip_ctx, char* smem, Epi& epi) {
  constexpr int lda = D, ldb = D, K = D, ntiles = 22, RS = 40;
  u16* As = (u16*)smem;
  u16* Bs = As + 2 * 128 * RS;
  const int tid = ltid(), lane = tid & 63, wave = tid >> 6;
  const int wm = wave >> 1, wn = wave & 1, lr = lane & 31, lh = lane >> 5;
  const int lrow = tid >> 2, lkc = (tid & 3) * 8;
  const int total = mtiles * ntiles, nk = K >> 5;
  uint4 ra00, ra01, rb00, rb01, rb02, rb03, ra10, ra11, rb10, rb11, rb12, rb13;
  const u16* Agl;
  const u16* Bgl;
#define GU_GLOAD(S, kt_)                                              \
  {                                                                   \
    const int k0_ = (kt_) << 5;                                       \
    ra##S##0 = *(const uint4*)(Agl + k0_);                            \
    ra##S##1 = *(const uint4*)(Agl + (size_t)64 * lda + k0_);         \
    rb##S##0 = *(const uint4*)(Bgl + k0_);                            \
    rb##S##1 = *(const uint4*)(Bgl + (size_t)64 * ldb + k0_);         \
    rb##S##2 = *(const uint4*)(Bgl + (size_t)128 * ldb + k0_);        \
    rb##S##3 = *(const uint4*)(Bgl + (size_t)192 * ldb + k0_);        \
  }
#define GU_LSTORE(S, buf_)                                            \
  {                                                                   \
    u16* ad_ = As + (buf_) * 128 * RS + lrow * RS + lkc;              \
    u16* bd_ = Bs + (buf_) * 256 * RS + lrow * RS + lkc;              \
    *(uint4*)(ad_) = ra##S##0;                                        \
    *(uint4*)(ad_ + 64 * RS) = ra##S##1;                              \
    *(uint4*)(bd_) = rb##S##0;                                        \
    *(uint4*)(bd_ + 64 * RS) = rb##S##1;                              \
    *(uint4*)(bd_ + 128 * RS) = rb##S##2;                             \
    *(uint4*)(bd_ + 192 * RS) = rb##S##3;                             \
  }
#define GU_COMPUTE(buf_)                                                          \
  {                                                                               \
    const u16* as = As + (buf_) * 128 * RS + (wm * 64 + lr) * RS + lh * 8;        \
    const u16* bs = Bs + (buf_) * 256 * RS + (wn * 128 + lr) * RS + lh * 8;       \
    _Pragma("unroll") for (int ks = 0; ks < 2; ++ks) {                            \
      bf16x8 a0 = *(const bf16x8*)(as + ks * 16);                                 \
      bf16x8 a1 = *(const bf16x8*)(as + 32 * RS + ks * 16);                       \
      bf16x8 b0 = *(const bf16x8*)(bs + ks * 16);                                 \
      bf16x8 b1 = *(const bf16x8*)(bs + 32 * RS + ks * 16);                       \
      bf16x8 b2 = *(const bf16x8*)(bs + 64 * RS + ks * 16);                       \
      bf16x8 b3 = *(const bf16x8*)(bs + 96 * RS + ks * 16);                       \
      acc[0][0] = MFMA32(a0, b0, acc[0][0]);                                      \
      acc[0][1] = MFMA32(a0, b1, acc[0][1]);                                      \
      acc[0][2] = MFMA32(a0, b2, acc[0][2]);                                      \
      acc[0][3] = MFMA32(a0, b3, acc[0][3]);                                      \
      acc[1][0] = MFMA32(a1, b0, acc[1][0]);                                      \
      acc[1][1] = MFMA32(a1, b1, acc[1][1]);                                      \
      acc[1][2] = MFMA32(a1, b2, acc[1][2]);                                      \
      acc[1][3] = MFMA32(a1, b3, acc[1][3]);                                      \
    }                                                                             \
  }
  int t = blockIdx.x, mt = 0, nt = 0;
  while (t < total && !gemm_decode(t, mtiles, ntiles, 0, skip_ctx, mt, nt)) t += gridDim.x;
  if (t < total) {
    Agl = A + (size_t)(mt * 128 + lrow) * lda + lkc;
    Bgl = Bt + (size_t)(nt * 256 + lrow) * ldb + lkc;
    GU_GLOAD(0, 0);
  }
  while (t < total) {
    const int m0 = mt * 128, n0 = nt * 256;
    int tn = t + gridDim.x, mtn = 0, ntn = 0;
    while (tn < total && !gemm_decode(tn, mtiles, ntiles, 0, skip_ctx, mtn, ntn)) tn += gridDim.x;
    f32x16 acc[2][4];
#pragma unroll
    for (int a = 0; a < 2; ++a)
#pragma unroll
      for (int b = 0; b < 4; ++b)
#pragma unroll
        for (int i = 0; i < 16; ++i) acc[a][b][i] = 0.f;
    GU_LSTORE(0, 0);
    __syncthreads();
    GU_GLOAD(0, 1);
    for (int kt = 0; kt < nk; kt += 2) {
      if (kt + 2 < nk) GU_GLOAD(1, kt + 2);
      GU_COMPUTE(0);
      GU_LSTORE(0, 1);
      __syncthreads();
      if (kt + 3 < nk) GU_GLOAD(0, kt + 3);
      GU_COMPUTE(1);
      if (kt + 2 < nk) GU_LSTORE(1, 0);
      __syncthreads();
    }
    if (tn < total) {
      Agl = A + (size_t)(mtn * 128 + lrow) * lda + lkc;
      Bgl = Bt + (size_t)(ntn * 256 + lrow) * ldb + lkc;
      GU_GLOAD(0, 0);
    }
    {
      float* stg = (float*)smem + wave * 64 * 68;
#pragma unroll
      for (int mi = 0; mi < 2; ++mi)
#pragma unroll
        for (int pi = 0; pi < 2; ++pi)
#pragma unroll
          for (int i = 0; i < 16; ++i)
            stg[(mi * 32 + crow(i, lh)) * 68 + pi * 32 + lr] = epi.combine(acc[mi][2 * pi][i], acc[mi][2 * pi + 1][i]);
      __syncthreads();
#pragma unroll 4
      for (int k = 0; k < 16; ++k) {
        const int idx = lane + 64 * k, row = idx >> 4, c4 = idx & 15;
        const float4 v = *(const float4*)(stg + row * 68 + c4 * 4);
        epi.store4(m0 + wm * 64 + row, (n0 >> 1) + wn * 64 + c4 * 4, v);
      }
      __syncthreads();
    }
    t = tn; mt = mtn; nt = ntn;
  }
}

#define EPI_DEFAULT_QUAD                                                   \
  static constexpr bool kStaged = false;                                   \
  DI void row4(int, int, float4) const {}                                  \
  DI void tile(int) {}                                                     \
  DI void quad(int row0, int col, float a, float b, float c, float d) const { \
    (*this)(row0, col, a);                                                 \
    (*this)(row0 + 1, col, b);                                             \
    (*this)(row0 + 2, col, c);                                             \
    (*this)(row0 + 3, col, d);                                             \
  }
struct EpiGU {
  u16* G;
  DI float combine(float g, float u) const { return g * __builtin_amdgcn_rcpf(1.f + __expf(-g)) * u; }
  DI void store4(int row, int col, float4 v) const {
    uint2 w;
    w.x = pack2(v.x, v.y);
    w.y = pack2(v.z, v.w);
    *(uint2*)(G + (size_t)row * DFF + col) = w;
  }
  DI void pair(int row, int col, float g, float u) const {
    float s = g / (1.f + __expf(-g));
    G[(size_t)row * DFF + col] = f2bf(s * u);
  }
  DI void operator()(int, int, float) const {}
  EPI_DEFAULT_QUAD
};
struct EpiRes {
  const float* lat_in; const float* ctx_in; float* lat_out; float* ctx_out; const float* modl; int gate_chunk; float coef;
  const float* tin; float* tout; const float* gate; int tm0;
  static constexpr bool kStaged = true;
  DI void row4(int row, int col, float4 v) const {
    const size_t o = ((size_t)(row - tm0) << 10) + col;
    const float4 x = *(const float4*)(tin + o);
    const float4 g = *(const float4*)(gate + col);
    float4 y;
    y.x = x.x + coef * g.x * v.x;
    y.y = x.y + coef * g.y * v.y;
    y.z = x.z + coef * g.z * v.z;
    y.w = x.w + coef * g.w * v.w;
    *(float4*)(tout + o) = y;
  }
  DI void tile(int m0) {
    const int b = m0 / LT, j = m0 - b * LT;
    const bool isc = j < LC;
    const size_t off = isc ? (((size_t)(b * LC + j)) << 10) : (((size_t)(b * LQ + j - LC)) << 10);
    tin = (isc ? ctx_in : lat_in) + off;
    tout = (isc ? ctx_out : lat_out) + off;
    gate = modl + (isc ? 8 : b) * 9216 + gate_chunk * 1024;
    tm0 = m0;
  }
  DI void operator()(int row, int col, float v) const {
    const size_t o = ((size_t)(row - tm0) << 10) + col;
    tout[o] = tin[o] + coef * gate[col] * v;
  }
  DI void pair(int, int, float, float) const {}
  DI void quad(int row0, int col, float a, float b, float c, float d) const {
    const float gc = coef * gate[col];
    const size_t o = ((size_t)(row0 - tm0) << 10) + col;
    tout[o] = tin[o] + gc * a;
    tout[o + 1024] = tin[o + 1024] + gc * b;
    tout[o + 2048] = tin[o + 2048] + gc * c;
    tout[o + 3072] = tin[o + 3072] + gc * d;
  }
};
struct EpiStore {
  u16* C; int ldc; int N;
  DI void operator()(int row, int col, float v) const { if (col < N) C[(size_t)row * ldc + col] = f2bf(v); }
  DI void pair(int, int, float, float) const {}
  EPI_DEFAULT_QUAD
};
struct EpiWin {
  u16* p; u16* pT;
  static constexpr bool kStaged = false;
  DI void row4(int, int, float4) const {}
  DI void tile(int) {}
  DI void quad(int row0, int col, float a, float b, float c, float d) const {
    if (col < HYC) {
      uint2 w;
      w.x = pack2(a, b);
      w.y = pack2(c, d);
      *(uint2*)(pT + (size_t)col * TG + row0) = w;
    } else if (col < DIN) {
      u16* q = p + (size_t)row0 * DINP + (col - HYC);
      q[0] = f2bf(a);
      q[DINP] = f2bf(b);
      q[2 * DINP] = f2bf(c);
      q[3 * DINP] = f2bf(d);
    }
  }
  DI void pair(int, int, float, float) const {}
};
struct EpiLoraW {
  u16* C; const float* w0;
  DI void operator()(int row, int col, float v) const {
    float zz = -(w0[col] + v);
    float sp = fmaxf(zz, 0.f) + log1pf(expf(-fabsf(zz)));
    C[(size_t)row * 256 + col] = f2bf(-expm1f(-expf(-sp - 0.5f)));
  }
  DI void pair(int, int, float, float) const {}
  EPI_DEFAULT_QUAD
};
struct EpiLoraA {
  u16* C; const float* a0;
  DI void operator()(int row, int col, float v) const { C[(size_t)row * 256 + col] = f2bf(sigmoidf_(a0[col] + v)); }
  DI void pair(int, int, float, float) const {}
  EPI_DEFAULT_QUAD
};

struct MixBufs {
  u16 *p, *pt, *u, *qg, *kg, *vtg, *cqn, *ckvn, *qup, *kvup, *qm, *km, *vtm, *rr, *rk, *rv, *rkk, *lwf, *lwb, *laf, *lab, *lg, *ef, *eb, *af, *ab, *gg;
  float *yf, *yb;
};
DI MixBufs mixbufs(char* big, int g) {
  MixBufs m;
  m.p = (u16*)(big + M_P); m.pt = (u16*)(big + M_PT); m.u = (u16*)(big + M_U);
  m.cqn = (u16*)(big + M_CQN); m.ckvn = (u16*)(big + M_CKVN); m.qup = (u16*)(big + M_QUP);
  m.kvup = (u16*)(big + M_KVUP); m.qm = (u16*)(big + M_QM); m.km = (u16*)(big + M_KM); m.vtm = (u16*)(big + M_VTM);
  m.lwf = (u16*)(big + M_LWF); m.lwb = (u16*)(big + M_LWB); m.laf = (u16*)(big + M_LAF); m.lab = (u16*)(big + M_LAB);
  m.lg = (u16*)(big + M_LG);
  char* sc = big + M_SCAN + (size_t)g * SCAN_STRIDE;
  m.rr = (u16*)(sc + 0 * SZ_SC); m.rk = (u16*)(sc + 1 * SZ_SC); m.rv = (u16*)(sc + 2 * SZ_SC); m.rkk = (u16*)(sc + 3 * SZ_SC);
  m.ef = (u16*)(sc + 4 * SZ_SC); m.eb = (u16*)(sc + 5 * SZ_SC); m.af = (u16*)(sc + 6 * SZ_SC); m.ab = (u16*)(sc + 7 * SZ_SC);
  m.gg = (u16*)(sc + 8 * SZ_SC);
  m.qg = (u16*)(sc + 9 * SZ_SC); m.kg = (u16*)(sc + 10 * SZ_SC); m.vtg = m.kg + (size_t)TG * 128;
  m.yf = (float*)(big + M_P) + (size_t)g * 2 * TG * 256;
  m.yb = m.yf + (size_t)TG * 256;
  return m;
}

DI void prep_phase(const Params& p, int l, int g, const MixBufs& m, const float2* __restrict__ ropeg, char* smem) {
  const int tid = ltid(), lane = tid & 63, wave = tid >> 6;
  const float* mu = p.rw_mu + l * 1152;
  for (int rl = blockIdx.x * 4 + wave; rl < TG; rl += gridDim.x * 4) {
    const int r = g * TG + rl;
    const int b = r / LT, j = r - b * LT, bl = b - g * BG;
    const bool lat = j >= LC;
    const bool hp = lat ? (j > LC) : (j > 0);
    const bool hn = lat ? (j < LT - 1) : (j < LC - 1);
    const u16* pc = m.p + (size_t)rl * DINP;
    const u16* pp = pc - DINP;
    const u16* pn = pc + DINP;
    auto tshift = [&](int crel) -> float {
      const int c = 1696 - HYC + crel;
      float u0 = bf2f(pc[c]);
      float nb = 0.f;
      if (hp) nb += bf2f(pp[c]);
      if (hn) nb += bf2f(pn[c]);
      return u0 + mu[crel] * (0.5f * nb - u0);
    };
#pragma unroll
    for (int hd = 0; hd < 4; ++hd) {
      const int c = hd * 64 + lane;
      const float sr = tshift(c), sk = tshift(256 + c), sv = tshift(512 + c);
      m.rr[(size_t)rl * 256 + c] = f2bf(sr);
      m.rk[(size_t)rl * 256 + c] = f2bf(sk);
      m.rv[(size_t)rl * 256 + c] = f2bf(sv);
      const float kx = sk * p.rw_k_k[l * 256 + c];
      const float ss = wave_sum(kx * kx);
      m.rkk[(size_t)rl * 256 + c] = f2bf(kx / fmaxf(sqrtf(ss), 1e-12f));
    }
    {
      const float s0 = tshift(768 + lane), s1 = tshift(832 + lane), s2 = tshift(896 + lane), s3 = tshift(960 + lane);
      const float s4 = tshift(1024 + lane), s5 = tshift(1088 + lane);
      m.lwf[(size_t)rl * 64 + lane] = f2bf(tanhf(s0));
      m.lwb[(size_t)rl * 64 + lane] = f2bf(tanhf(s1));
      m.laf[(size_t)rl * 64 + lane] = f2bf(s2);
      m.lab[(size_t)rl * 64 + lane] = f2bf(s3);
      m.lg[(size_t)rl * 128 + lane] = f2bf(sigmoidf_(s4));
      m.lg[(size_t)rl * 128 + 64 + lane] = f2bf(sigmoidf_(s5));
    }
    {
      float cq[4], ckv[2];
      float s1 = 0.f, s2 = 0.f;
#pragma unroll
      for (int q = 0; q < 4; ++q) { cq[q] = bf2f(pc[1280 - HYC + lane + 64 * q]); s1 += cq[q] * cq[q]; }
#pragma unroll
      for (int q = 0; q < 2; ++q) { ckv[q] = bf2f(pc[1536 - HYC + lane + 64 * q]); s2 += ckv[q] * ckv[q]; }
      s1 = wave_sum(s1);
      s2 = wave_sum(s2);
      const float r1 = rsqrtf(s1 * (1.f / 256.f) + EPS), r2 = rsqrtf(s2 * (1.f / 128.f) + EPS);
#pragma unroll
      for (int q = 0; q < 4; ++q) m.cqn[(size_t)rl * 256 + lane + 64 * q] = f2bf(cq[q] * r1 * p.mla_cq_norm[l * 256 + lane + 64 * q]);
#pragma unroll
      for (int q = 0; q < 2; ++q) m.ckvn[(size_t)rl * 128 + lane + 64 * q] = f2bf(ckv[q] * r2 * p.mla_ckv_norm[l * 128 + lane + 64 * q]);
    }
    const float2* rt = ropeg + (size_t)(lat ? j - LC : 0) * 32;
    const float gq_ = p.gqa_q_norm[l * 64 + lane], gk_ = p.gqa_k_norm[l * 64 + lane];
#pragma unroll
    for (int hh = 0; hh < 6; ++hh) {
      float val = bf2f(pc[hh * 64 + lane]);
      const float ss = wave_sum(val * val);
      val = val * rsqrtf(ss * (1.f / 64.f) + EPS) * (hh < 4 ? gq_ : gk_);
      const float rv = rope_tab(val, lane, rt, lane);
      if (lat) val = rv;
      if (hh < 4) m.qg[(size_t)rl * 256 + hh * 64 + lane] = f2bf(val);
      else m.kg[(size_t)rl * 128 + (hh - 4) * 64 + lane] = f2bf(val);
    }
#pragma unroll
    for (int kvh = 0; kvh < 2; ++kvh) m.vtg[((size_t)(bl * 2 + kvh) * 64 + lane) * LT + j] = pc[1152 - HYC + kvh * 64 + lane];
  }
}

DI void mla_fin_phase(const Params& p, int l, int g, const MixBufs& m, const float2* __restrict__ ropem) {
  const int tid = ltid(), lane = tid & 63, wave = tid >> 6;
  for (int rl = blockIdx.x; rl < TG; rl += gridDim.x) {
    const int r = g * TG + rl;
    const int b = r / LT, j = r - b * LT, bl = b - g * BG;
    const bool lat = j >= LC;
    for (int s = wave; s < 8; s += 4) {
      const int hd = s & 3;
      const bool isq = s < 4;
      float x0, x1;
      if (isq) {
        x0 = bf2f(m.qup[(size_t)rl * 384 + hd * 96 + lane]);
        x1 = lane < 32 ? bf2f(m.qup[(size_t)rl * 384 + hd * 96 + 64 + lane]) : 0.f;
      } else {
        x0 = bf2f(m.kvup[(size_t)rl * 512 + hd * 128 + lane]);
        x1 = lane < 32 ? bf2f(m.p[(size_t)rl * DINP + 1664 - HYC + lane]) : 0.f;
      }
      float ss = wave_sum(x0 * x0 + x1 * x1);
      const float rstd = rsqrtf(ss * (1.f / 96.f) + EPS);
      const float* gn = isq ? p.mla_q_norm + l * 96 : p.mla_k_norm + l * 96;
      float y0 = x0 * rstd * gn[lane];
      float y1 = lane < 32 ? x1 * rstd * gn[64 + lane] : 0.f;
      float ry = rope_tab(y1, lane & 31, ropem + (size_t)(lat ? j - LC : 0) * 16, lane);
      if (lat) y1 = ry;
      u16* dst = (isq ? m.qm : m.km) + (size_t)rl * 384 + hd * 96;
      dst[lane] = f2bf(y0);
      if (lane < 32) dst[64 + lane] = f2bf(y1);
      if (!isq) m.vtm[((size_t)(bl * 4 + hd) * 64 + lane) * LT + j] = m.kvup[(size_t)rl * 512 + hd * 128 + 64 + lane];
    }
  }
}

template <int DQK, int QT>
DI void attn_item(const u16* __restrict__ q, int ldq, const u16* __restrict__ k, int ldk, const u16* __restrict__ vT,
                  u16* __restrict__ out, int ldo, int nkeys, float sl2, float sh2, char* smem) {
  constexpr int KS = DQK + 8;
  constexpr int NKS = DQK / 16;
  constexpr int KCH = DQK / 8;
  constexpr int KPT = 64 * KCH / NTHR;
  u16* Ks = (u16*)smem;
  u16* Vs = Ks + 2 * 64 * KS;
  const int tid = ltid(), lane = tid & 63, wave = tid >> 6, lr = lane & 31, lh = lane >> 5;
  bf16x8 qf[QT][NKS];
#pragma unroll
  for (int qt = 0; qt < QT; ++qt)
#pragma unroll
    for (int ks = 0; ks < NKS; ++ks)
      qf[qt][ks] = *(const bf16x8*)(q + (size_t)(wave * 32 * QT + qt * 32 + lr) * ldq + ks * 16 + lh * 8);
  f32x16 o[QT][2];
#pragma unroll
  for (int a = 0; a < QT; ++a)
#pragma unroll
    for (int b = 0; b < 2; ++b)
#pragma unroll
      for (int i = 0; i < 16; ++i) o[a][b][i] = 0.f;
  float lsum[QT];
#pragma unroll
  for (int a = 0; a < QT; ++a) lsum[a] = 0.f;
  uint4 rk[KPT], rv[2];
#define ATT_GLOAD(key0)                                                                   \
  {                                                                                       \
    _Pragma("unroll") for (int i = 0; i < KPT; ++i) {                                     \
      const int id = tid + NTHR * i, row = id / KCH, ch = id - row * KCH;                 \
      rk[i] = *(const uint4*)(k + (size_t)((key0) + row) * ldk + ch * 8);                 \
    }                                                                                     \
    _Pragma("unroll") for (int i = 0; i < 2; ++i) {                                       \
      const int id = tid + NTHR * i, row = id >> 3, ch = id & 7;                          \
      rv[i] = *(const uint4*)(vT + (size_t)row * LT + (key0) + ch * 8);                   \
    }                                                                                     \
  }
#define ATT_LSTORE(buf_)                                                                  \
  {                                                                                       \
    _Pragma("unroll") for (int i = 0; i < KPT; ++i) {                                     \
      const int id = tid + NTHR * i, row = id / KCH, ch = id - row * KCH;                 \
      *(uint4*)(Ks + (buf_) * 64 * KS + row * KS + ch * 8) = rk[i];                       \
    }                                                                                     \
    _Pragma("unroll") for (int i = 0; i < 2; ++i) {                                       \
      const int id = tid + NTHR * i, row = id >> 3, ch = id & 7;                          \
      *(uint4*)(Vs + (buf_) * 64 * 72 + row * 72 + ch * 8) = rv[i];                       \
    }                                                                                     \
  }
  ATT_GLOAD(0);
  ATT_LSTORE(0);
  __syncthreads();
  const int nkt = nkeys >> 6;
  for (int kt = 0; kt < nkt; ++kt) {
    const int buf = kt & 1;
    if (kt + 1 < nkt) ATT_GLOAD((kt + 1) << 6);
    const u16* kb = Ks + buf * 64 * KS;
    const u16* vb = Vs + buf * 64 * 72;
#pragma unroll
    for (int half = 0; half < 2; ++half) {
      f32x16 s[QT];
#pragma unroll
      for (int qt = 0; qt < QT; ++qt)
#pragma unroll
        for (int i = 0; i < 16; ++i) s[qt][i] = 0.f;
      bf16x8 kf[NKS];
#pragma unroll
      for (int ks = 0; ks < NKS; ++ks) kf[ks] = *(const bf16x8*)(kb + (half * 32 + lr) * KS + ks * 16 + lh * 8);
#pragma unroll
      for (int ks = 0; ks < NKS; ++ks) {
#pragma unroll
        for (int qt = 0; qt < QT; ++qt) s[qt] = MFMA32(kf[ks], qf[qt][ks], s[qt]);
      }
#pragma unroll
      for (int qt = 0; qt < QT; ++qt)
#pragma unroll
        for (int i = 0; i < 16; ++i) {
          float pv = __builtin_amdgcn_exp2f(s[qt][i] * sl2 - sh2);
          lsum[qt] += pv;
          s[qt][i] = pv;
        }
#pragma unroll
      for (int st = 0; st < 2; ++st) {
        bf16x8 pb[QT];
#pragma unroll
        for (int qt = 0; qt < QT; ++qt) {
          uint4 w;
          w.x = pack2(s[qt][8 * st + 0], s[qt][8 * st + 1]);
          w.y = pack2(s[qt][8 * st + 2], s[qt][8 * st + 3]);
          w.z = pack2(s[qt][8 * st + 4], s[qt][8 * st + 5]);
          w.w = pack2(s[qt][8 * st + 6], s[qt][8 * st + 7]);
          pb[qt] = __builtin_bit_cast(bf16x8, w);
        }
        bf16x8 vf[2];
#pragma unroll
        for (int mt = 0; mt < 2; ++mt) {
          const u16* vp = vb + (mt * 32 + lr) * 72 + half * 32 + st * 16 + lh * 4;
          uint2 v0 = *(const uint2*)(vp);
          uint2 v1 = *(const uint2*)(vp + 8);
          uint4 w;
          w.x = v0.x; w.y = v0.y; w.z = v1.x; w.w = v1.y;
          vf[mt] = __builtin_bit_cast(bf16x8, w);
        }
#pragma unroll
        for (int mt = 0; mt < 2; ++mt) {
#pragma unroll
          for (int qt = 0; qt < QT; ++qt) o[qt][mt] = MFMA32(vf[mt], pb[qt], o[qt][mt]);
        }
      }
    }
    if (kt + 1 < nkt) ATT_LSTORE(buf ^ 1);
    __syncthreads();
  }
#pragma unroll
  for (int qt = 0; qt < QT; ++qt) {
    float tot = lsum[qt] + __shfl_xor(lsum[qt], 32);
    float inv = 1.f / tot;
    const int row = wave * 32 * QT + qt * 32 + lr;
#pragma unroll
    for (int mt = 0; mt < 2; ++mt)
#pragma unroll
      for (int gq = 0; gq < 4; ++gq) {
        uint2 w;
        w.x = pack2(o[qt][mt][4 * gq + 0] * inv, o[qt][mt][4 * gq + 1] * inv);
        w.y = pack2(o[qt][mt][4 * gq + 2] * inv, o[qt][mt][4 * gq + 3] * inv);
        *(uint2*)(out + (size_t)row * ldo + mt * 32 + 8 * gq + 4 * lh) = w;
      }
  }
}

DI void hyena_pass(const Params& p, int l, const MixBufs& m, const float* __restrict__ gT, int L, int segoff, int c, char* smem) {
  const int RS = L + 16, US = L + 16;
  unsigned* Rc = (unsigned*)smem;
  u16* U = (u16*)(smem + (size_t)2 * RS * 4);
  const int tid = ltid(), lane = tid & 63, wave = tid >> 6;
  for (int d = tid; d < L; d += NTHR) {
    const int q = 2 * d;
    const float r0 = gT[(size_t)(2 * L - 2 - q) * 256 + c];
    const float r1 = (q + 1 <= 2 * L - 2) ? gT[(size_t)(2 * L - 3 - q) * 256 + c] : 0.f;
    const float r2 = (q + 2 <= 2 * L - 2) ? gT[(size_t)(2 * L - 4 - q) * 256 + c] : 0.f;
    Rc[d] = pack2(r0, r1);
    Rc[RS + d] = pack2(r1, r2);
  }
  const float* cw = p.hy_conv_w + l * 3 * 768;
  const float* cb = p.hy_conv_b + l * 768;
  {
    const float w0a = cw[c], w1a = cw[768 + c], w2a = cw[1536 + c], ba = cb[c];
    const float w0v = cw[512 + c], w1v = cw[768 + 512 + c], w2v = cw[1536 + 512 + c], bv = cb[512 + c];
    for (int b = 0; b < BG; ++b) {
      const u16* x1p = m.pt + (size_t)c * TG + b * LT + segoff;
      const u16* vp = m.pt + (size_t)(512 + c) * TG + b * LT + segoff;
      for (int t = tid; t < L; t += NTHR) {
        float x1 = bf2f(x1p[t]) * w1a + ba;
        float vv = bf2f(vp[t]) * w1v + bv;
        if (t > 0) { x1 += bf2f(x1p[t - 1]) * w0a; vv += bf2f(vp[t - 1]) * w0v; }
        if (t < L - 1) { x1 += bf2f(x1p[t + 1]) * w2a; vv += bf2f(vp[t + 1]) * w2v; }
        U[b * US + t] = f2bf(x1 * vv);
      }
    }
  }
  __syncthreads();
  const int i = lane & 31, h = lane >> 5, bn = i & 3, mb = i >> 2;
  const int par = (L - 1 - i) & 1;
  const float bias = p.hy_bias[l * 256 + c];
  const float w0x = cw[256 + c], w1x = cw[768 + 256 + c], w2x = cw[1536 + 256 + c], bx = cb[256 + c];
  const int nsteps = (L + 208) / 16 + 1;
  for (int sp = wave; sp < L / 256; sp += 4) {
    const int T0 = sp * 256;
    f32x16 acc;
#pragma unroll
    for (int r = 0; r < 16; ++r) acc[r] = 0.f;
    const int delta0 = T0 + 224;
    const int q0 = (L - 1) - delta0 - i + 8 * h;
    const unsigned* ap = Rc + par * RS + (q0 >> 1);
    int s0 = T0 + 32 * mb - delta0;
    const u16* bp = U + bn * US + s0 + 8 * h;
#pragma unroll 2
    for (int st = 0; st < nsteps; ++st) {
      uint4 aw;
      aw.x = ap[0]; aw.y = ap[1]; aw.z = ap[2]; aw.w = ap[3];
      uint4 bw = make_uint4(0u, 0u, 0u, 0u);
      if (s0 >= 0 && s0 <= L - 16) bw = *(const uint4*)bp;
      acc = MFMA32(__builtin_bit_cast(bf16x8, aw), __builtin_bit_cast(bf16x8, bw), acc);
      ap += 8;
      s0 += 16;
      bp += 16;
    }
    const u16* x2p = m.pt + (size_t)(256 + c) * TG + bn * LT + segoff;
    u16* yp = m.u + (size_t)c * TG + bn * LT + segoff;
#pragma unroll
    for (int gq = 0; gq < 4; ++gq) {
      const int t4 = T0 + 32 * mb + 8 * gq + 4 * h;
      float e[6];
#pragma unroll
      for (int k = 0; k < 6; ++k) {
        const int tt = t4 - 1 + k;
        e[k] = (tt >= 0 && tt < L) ? bf2f(x2p[tt]) : 0.f;
      }
      const uint2 uu = *(const uint2*)(U + bn * US + t4);
      const float u0 = bflo_(uu.x), u1 = bfhi_(uu.x), u2 = bflo_(uu.y), u3 = bfhi_(uu.y);
      const float y0 = (e[0] * w0x + e[1] * w1x + e[2] * w2x + bx) * (acc[4 * gq + 0] + u0 * bias);
      const float y1 = (e[1] * w0x + e[2] * w1x + e[3] * w2x + bx) * (acc[4 * gq + 1] + u1 * bias);
      const float y2 = (e[2] * w0x + e[3] * w1x + e[4] * w2x + bx) * (acc[4 * gq + 2] + u2 * bias);
      const float y3 = (e[3] * w0x + e[4] * w1x + e[5] * w2x + bx) * (acc[4 * gq + 3] + u3 * bias);
      uint2 w;
      w.x = pack2(y0, y1);
      w.y = pack2(y2, y3);
      *(uint2*)(yp + t4) = w;
    }
  }
  __syncthreads();
}

#define DPP_ROR(v, n) __builtin_bit_cast(float, __builtin_amdgcn_update_dpp(0, __builtin_bit_cast(int, (v)), 0x120 + (n), 0xf, 0xf, true))
DI float row_allsum(float v) {
  v += DPP_ROR(v, 8);
  v += DPP_ROR(v, 4);
  v += DPP_ROR(v, 2);
  v += DPP_ROR(v, 1);
  return v;
}
DI float bflo(unsigned w) { return __uint_as_float(w << 16); }
DI float bfhi(unsigned w) { return __uint_as_float(w & 0xffff0000u); }
DI void scan_item(const Params& p, int l, const MixBufs& m, int bl, int hd, int dir, int rq, char* smem) {
  constexpr int TC = 16;
  constexpr int NCH = LT / TC;
  constexpr int BUF = 5 * TC * 64 + TC * 16;
  float* sbase = (float*)smem;
  float* sy = sbase + 2 * BUF;
  const int tid = ltid(), lane = tid & 63, wave = tid >> 6;
  const int kq = lane & 15, rloc = wave * 4 + (lane >> 4);
  const u16* eD = dir ? m.eb : m.ef;
  const u16* aD = dir ? m.ab : m.af;
  float* yD = dir ? m.yb : m.yf;
  const size_t rbase = (size_t)bl * LT;
  const int ss = tid >> 4, su = tid & 15, sc = su & 7;
  float kav[8];
#pragma unroll
  for (int i = 0; i < 8; ++i) kav[i] = p.rw_k_a[l * 256 + hd * 64 + sc * 8 + i];
  uint4 g0, g1, g2;
  g2.x = g2.y = g2.z = g2.w = 0u;
#define SCAN_JMAP(i) (dir ? ((i) < LC ? LC - 1 - (i) : LT - 1 - ((i) - LC)) : (i))
#define SCAN_GLOAD(i0)                                                                         \
  {                                                                                            \
    const int ii_ = (i0) + ss;                                                                 \
    const int j_ = SCAN_JMAP(ii_);                                                             \
    const size_t o_ = (rbase + j_) * 256 + hd * 64 + sc * 8;                                   \
    if (su < 8) {                                                                              \
      g0 = *(const uint4*)(m.rkk + o_);                                                        \
      g1 = *(const uint4*)(aD + o_);                                                           \
      g2 = *(const uint4*)(m.rk + o_);                                                         \
    } else {                                                                                   \
      g0 = *(const uint4*)(eD + o_);                                                           \
      g1 = *(const uint4*)(m.rr + o_);                                                         \
      if (sc < 2) g2 = *(const uint4*)(m.rv + (rbase + j_) * 256 + hd * 64 + rq * 16 + sc * 8); \
    }                                                                                          \
  }
#define SCAN_LSTORE(buf_)                                                                      \
  {                                                                                            \
    float* B_ = sbase + (buf_) * BUF;                                                          \
    const unsigned w0_[4] = {g0.x, g0.y, g0.z, g0.w};                                          \
    const unsigned w1_[4] = {g1.x, g1.y, g1.z, g1.w};                                          \
    const unsigned w2_[4] = {g2.x, g2.y, g2.z, g2.w};                                          \
    if (su < 8) {                                                                              \
      float kk_[8], bb_[8], dd_[8];                                                            \
      _Pragma("unroll") for (int q_ = 0; q_ < 4; ++q_) {                                       \
        const float k0_ = bflo(w0_[q_]), k1_ = bfhi(w0_[q_]);                                  \
        const float a0_ = bflo(w1_[q_]), a1_ = bfhi(w1_[q_]);                                  \
        const float v0_ = bflo(w2_[q_]), v1_ = bfhi(w2_[q_]);                                  \
        kk_[2 * q_] = k0_; kk_[2 * q_ + 1] = k1_;                                              \
        bb_[2 * q_] = k0_ * a0_; bb_[2 * q_ + 1] = k1_ * a1_;                                  \
        dd_[2 * q_] = v0_ * (1.f + (a0_ - 1.f) * kav[2 * q_]);                                 \
        dd_[2 * q_ + 1] = v1_ * (1.f + (a1_ - 1.f) * kav[2 * q_ + 1]);                         \
      }                                                                                        \
      float* d0_ = B_ + ss * 64 + sc * 8;                                                      \
      *(float4*)(d0_) = make_float4(kk_[0], kk_[1], kk_[2], kk_[3]);                           \
      *(float4*)(d0_ + 4) = make_float4(kk_[4], kk_[5], kk_[6], kk_[7]);                       \
      *(float4*)(d0_ + 2048) = make_float4(bb_[0], bb_[1], bb_[2], bb_[3]);                    \
      *(float4*)(d0_ + 2052) = make_float4(bb_[4], bb_[5], bb_[6], bb_[7]);                    \
      *(float4*)(d0_ + 3072) = make_float4(dd_[0], dd_[1], dd_[2], dd_[3]);                    \
      *(float4*)(d0_ + 3076) = make_float4(dd_[4], dd_[5], dd_[6], dd_[7]);                    \
    } else {                                                                                   \
      float ww_[8], rr_[8], vv_[8];                                                            \
      _Pragma("unroll") for (int q_ = 0; q_ < 4; ++q_) {                                       \
        ww_[2 * q_] = 1.f - bflo(w0_[q_]); ww_[2 * q_ + 1] = 1.f - bfhi(w0_[q_]);              \
        rr_[2 * q_] = bflo(w1_[q_]); rr_[2 * q_ + 1] = bfhi(w1_[q_]);                          \
        vv_[2 * q_] = bflo(w2_[q_]); vv_[2 * q_ + 1] = bfhi(w2_[q_]);                          \
      }                                                                                        \
      float* d0_ = B_ + ss * 64 + sc * 8;                                                      \
      *(float4*)(d0_ + 1024) = make_float4(ww_[0], ww_[1], ww_[2], ww_[3]);                    \
      *(float4*)(d0_ + 1028) = make_float4(ww_[4], ww_[5], ww_[6], ww_[7]);                    \
      *(float4*)(d0_ + 4096) = make_float4(rr_[0], rr_[1], rr_[2], rr_[3]);                    \
      *(float4*)(d0_ + 4100) = make_float4(rr_[4], rr_[5], rr_[6], rr_[7]);                    \
      if (sc < 2) {                                                                            \
        float* d1_ = B_ + 5120 + ss * 16 + sc * 8;                                             \
        *(float4*)(d1_) = make_float4(vv_[0], vv_[1], vv_[2], vv_[3]);                         \
        *(float4*)(d1_ + 4) = make_float4(vv_[4], vv_[5], vv_[6], vv_[7]);                     \
      }                                                                                        \
    }                                                                                          \
  }
  f32x2_t SA = {0.f, 0.f}, SB = {0.f, 0.f};
  __builtin_amdgcn_s_setprio(3);
  SCAN_GLOAD(0);
  SCAN_LSTORE(0);
  __syncthreads();
  for (int c = 0; c < NCH; ++c) {
    const int buf = c & 1;
    if (c + 1 < NCH) SCAN_GLOAD((c + 1) * TC);
    const float* B = sbase + buf * BUF;
    float* syb = sy + buf * TC * 16;
    float ypart[TC];
    float4 kkv[TC], wwv[TC], bbv[TC], ddv[TC], rrv[TC];
    float vvv[TC];
    constexpr int PF = 2;
#pragma unroll
    for (int st = 0; st < PF; ++st) {
      kkv[st] = *(const float4*)(B + st * 64 + kq * 4);
      wwv[st] = *(const float4*)(B + 1024 + st * 64 + kq * 4);
      bbv[st] = *(const float4*)(B + 2048 + st * 64 + kq * 4);
      ddv[st] = *(const float4*)(B + 3072 + st * 64 + kq * 4);
      rrv[st] = *(const float4*)(B + 4096 + st * 64 + kq * 4);
      vvv[st] = B[5120 + st * 16 + rloc];
    }
    __builtin_amdgcn_sched_barrier(0);
#pragma unroll
    for (int st = 0; st < TC; ++st) {
      if (st + PF < TC) {
        kkv[st + PF] = *(const float4*)(B + (st + PF) * 64 + kq * 4);
        wwv[st + PF] = *(const float4*)(B + 1024 + (st + PF) * 64 + kq * 4);
        bbv[st + PF] = *(const float4*)(B + 2048 + (st + PF) * 64 + kq * 4);
        ddv[st + PF] = *(const float4*)(B + 3072 + (st + PF) * 64 + kq * 4);
        rrv[st + PF] = *(const float4*)(B + 4096 + (st + PF) * 64 + kq * 4);
        vvv[st + PF] = B[5120 + (st + PF) * 16 + rloc];
      }
      __builtin_amdgcn_sched_barrier(0);
      const float4 kk = kkv[st], ww = wwv[st], bb = bbv[st], dd = ddv[st], rr = rrv[st];
      const float vv = vvv[st];
      const f32x2_t k01 = {kk.x, kk.y}, k23 = {kk.z, kk.w}, w01 = {ww.x, ww.y}, w23 = {ww.z, ww.w};
      const f32x2_t b01 = {bb.x, bb.y}, b23 = {bb.z, bb.w}, d01 = {dd.x, dd.y}, d23 = {dd.z, dd.w};
      const f32x2_t r01 = {rr.x, rr.y}, r23 = {rr.z, rr.w}, v2 = {vv, vv};
      const f32x2_t pp2 = SA * k01 + SB * k23;
      const float part = pp2.x + pp2.y;
      const f32x2_t cA = SA * w01 + v2 * d01, cB = SB * w23 + v2 * d23;
      const float sa = -row_allsum(part);
      const f32x2_t sa2 = {sa, sa};
      SA = cA + sa2 * b01;
      SB = cB + sa2 * b23;
      const f32x2_t yy2 = SA * r01 + SB * r23;
      ypart[st] = yy2.x + yy2.y;
    }
#pragma unroll
    for (int st = 0; st < TC; ++st) ypart[st] = row_allsum(ypart[st]);
    if (kq == 0) {
#pragma unroll
      for (int st = 0; st < TC; ++st) syb[st * 16 + rloc] = ypart[st];
    }
    if (c + 1 < NCH) SCAN_LSTORE(buf ^ 1);
    __syncthreads();
    {
      const int st = tid >> 4, r_ = tid & 15;
      const int ii = c * TC + st;
      const int j = SCAN_JMAP(ii);
      yD[(rbase + j) * 256 + hd * 64 + rq * 16 + r_] = syb[st * 16 + r_];
    }
  }
  __builtin_amdgcn_s_setprio(0);
  __syncthreads();
}

DI void readout_hy_phase(int g, const MixBufs& m, u16* __restrict__ ymix, bool skip_ctx, char* smem) {
  const int tid = ltid();
  {
    u16* tile = (u16*)smem;
    for (int tl = blockIdx.x; tl < (TG / 64) * 4; tl += gridDim.x) {
      const int rl0 = (tl >> 2) * 64, c0 = (tl & 3) * 64;
      const int r0 = g * TG + rl0;
      if (skip_ctx && (r0 % LT) < LC) continue;
#pragma unroll
      for (int k = 0; k < 2; ++k) {
        const int id = tid + NTHR * k, ch = id >> 3, part = id & 7;
        *(uint4*)(tile + ch * 72 + part * 8) = *(const uint4*)(m.u + (size_t)(c0 + ch) * TG + rl0 + part * 8);
      }
      __syncthreads();
#pragma unroll
      for (int k = 0; k < 2; ++k) {
        const int id = tid + NTHR * k, tok = id >> 3, part = id & 7;
        const u16* tp = tile + (part * 8) * 72 + tok;
        uint4 w;
        w.x = (unsigned)tp[0] | ((unsigned)tp[72] << 16);
        w.y = (unsigned)tp[2 * 72] | ((unsigned)tp[3 * 72] << 16);
        w.z = (unsigned)tp[4 * 72] | ((unsigned)tp[5 * 72] << 16);
        w.w = (unsigned)tp[6 * 72] | ((unsigned)tp[7 * 72] << 16);
        *(uint4*)(ymix + (size_t)(r0 + tok) * D + c0 + part * 8) = w;
      }
      __syncthreads();
    }
  }
}

DI void readout_rw_phase(const Params& p, int l, int g, const MixBufs& m, u16* __restrict__ ymix, bool skip_ctx) {
  const int tid = ltid();
  for (int rl = blockIdx.x; rl < TG; rl += gridDim.x) {
    const int r = g * TG + rl;
    const int j = r % LT;
    if (skip_ctx && j < LC) continue;
    const size_t o = (size_t)rl * 256 + tid;
    float y = m.yf[o] + m.yb[o];
    float mean = wave_sum(y) * (1.f / 64.f);
    float dv = y - mean;
    float var = wave_sum(dv * dv) * (1.f / 64.f);
    float yn = dv * rsqrtf(var + 64e-5f) * p.rw_ln_w[l * 256 + tid] + p.rw_ln_b[l * 256 + tid];
    const float rr = bf2f(m.rr[o]), kv = bf2f(m.rk[o]), vv = bf2f(m.rv[o]);
    const float kaa = p.rw_k_a[l * 256 + tid], rk = p.rw_r_k[l * 256 + tid];
    const float af = bf2f(m.af[o]), ab = bf2f(m.ab[o]);
    float t1 = rr * kv * (1.f + (af - 1.f) * kaa) * rk + rr * kv * (1.f + (ab - 1.f) * kaa) * rk;
    float bonus = wave_sum(t1) * vv;
    ymix[(size_t)r * D + 768 + tid] = f2bf((yn + bonus) * bf2f(m.gg[o]));
  }
}

#define XB_TMO      128
#define XB_XCNT(j)  (256  + 64 * (j))
#define XB_XSUB(j)  (1280 + 64 * (j))
#define XB_XGEN(j)  (2304 + 64 * (j))
#define XB_TOP      3328
#define XB_TOPGEN   3392
#define XCD_BAR_WORDS 3456
#define XB_SPIN_CAP (1u << 21)
#define LAS __attribute__((address_space(3)))
DI unsigned xb_ld(unsigned* p) { return __hip_atomic_load(p, __ATOMIC_RELAXED, __HIP_MEMORY_SCOPE_AGENT); }
DI unsigned xb_add(unsigned* p, unsigned v) { return __hip_atomic_fetch_add(p, v, __ATOMIC_RELAXED, __HIP_MEMORY_SCOPE_AGENT); }
DI unsigned xb_xcc_id() { return (unsigned)__builtin_amdgcn_s_getreg((3 << 11) | 20) & 0xFu; }
#define XB_SPIN(cond, bar) do { unsigned _sp = 0; while (cond) { __builtin_amdgcn_s_sleep(1); \
    if ((++_sp & 255u) == 0u) { if (xb_ld(&(bar)[XB_TMO])) break; if (_sp > XB_SPIN_CAP) { atomicAdd(&(bar)[XB_TMO], 1u); break; } } } } while (0)
struct XcdBarrier { unsigned* bar; unsigned x; volatile LAS unsigned* st; };
DI XcdBarrier xcd_barrier_post(unsigned* bar, volatile LAS unsigned* st) {
  XcdBarrier b; b.bar = bar; b.x = xb_xcc_id(); b.st = st;
  if (threadIdx.x == 0) (void)xb_add(&bar[XB_XCNT(b.x)], 1u);
  return b;
}
DI void xcd_barrier_complete(unsigned* bar, unsigned x, unsigned& nloc, unsigned& nx) {
  const unsigned G = gridDim.x * gridDim.y * gridDim.z;
  unsigned sum, cnt, mine, sp = 0u;
  for (;;) {
    sum = 0u; cnt = 0u; mine = 0u;
#pragma unroll
    for (unsigned j = 0; j < 16; ++j) { const unsigned c = xb_ld(&bar[XB_XCNT(j)]); sum += c; cnt += (c > 0u) ? 1u : 0u; mine = (j == x) ? c : mine; }
    if (sum == G) break;
    __builtin_amdgcn_s_sleep(1);
    if ((++sp & 255u) == 0u) { if (xb_ld(&bar[XB_TMO])) break; if (sp > XB_SPIN_CAP) { atomicAdd(&bar[XB_TMO], 1u); break; } }
  }
  nloc = mine > 0u ? mine : 1u; nx = cnt > 0u ? cnt : 1u;
}
DI void xcd_barrier(const XcdBarrier& b) {
  asm volatile("s_waitcnt vmcnt(0)" ::: "memory");
  __syncthreads();
  if (threadIdx.x == 0) {
    unsigned* bar = b.bar;
    __builtin_amdgcn_s_waitcnt(0);
    unsigned nloc = b.st[0], nx = b.st[1];
    if (nloc == 0u) { xcd_barrier_complete(bar, b.x, nloc, nx); b.st[0] = nloc; b.st[1] = nx; }
    const unsigned old = xb_add(&bar[XB_XSUB(b.x)], 1u);
    const unsigned gen = old / nloc;
    if (old + 1u == (gen + 1u) * nloc) {
      __builtin_amdgcn_fence(__ATOMIC_RELEASE, "agent");
      asm volatile("s_waitcnt vmcnt(0)" ::: "memory");
      const unsigned og = xb_add(&bar[XB_TOP], 1u);
      const unsigned tg = og / nx;
      if (og + 1u == (tg + 1u) * nx) xb_add(&bar[XB_TOPGEN], 1u);
      else XB_SPIN(xb_ld(&bar[XB_TOPGEN]) == tg, bar);
      __builtin_amdgcn_fence(__ATOMIC_ACQUIRE, "agent");
      xb_add(&bar[XB_XGEN(b.x)], 1u);
      asm volatile("s_waitcnt vmcnt(0)" ::: "memory");
    } else {
      XB_SPIN(xb_ld(&bar[XB_XGEN(b.x)]) == gen, bar);
      __builtin_amdgcn_fence(__ATOMIC_ACQUIRE, "agent");
      asm volatile("s_waitcnt vmcnt(0)" ::: "memory");
    }
  }
  __syncthreads();
}

DI int conv_job_tiles(int j) {
  return (j <= 2 || j >= 12) ? 704 : j == 3 ? 720 : j == 4 ? 24 : j == 5 ? 16 : j <= 9 ? 4 : j == 10 ? 8 : 256;
}
DI void conv_job_tile(const Params& p, int l, int j, int t, u16* W, char* smem) {
  switch (j) {
    case 0: convT_tile(p.ffn1_gate + (size_t)l * D * DFF, D, DFF, W + W_GU1, 1, t, smem); break;
    case 1: convT_tile(p.ffn1_up + (size_t)l * D * DFF, D, DFF, W + W_GU1, 2, t, smem); break;
    case 2: convT_tile(p.ffn1_down + (size_t)l * D * DFF, DFF, D, W + W_D1, 0, t, smem); break;
    case 3: convT_tile(p.w_in + (size_t)l * D * DIN, D, DIN, W + W_IN, 0, t, smem); break;
    case 4: convT_tile(p.mla_w_uq + (size_t)l * 256 * 384, 256, 384, W + W_UQ, 0, t, smem); break;
    case 5: convT_tile(p.mla_w_ukv + (size_t)l * 128 * 512, 128, 512, W + W_UKV, 0, t, smem); break;
    case 6: convT_tile(p.rw_w2 + (size_t)(l * 2 + 0) * 64 * 256, 64, 256, W + W_W2, 0, t, smem); break;
    case 7: convT_tile(p.rw_w2 + (size_t)(l * 2 + 1) * 64 * 256, 64, 256, W + W_W2 + (size_t)256 * 64, 0, t, smem); break;
    case 8: convT_tile(p.rw_a2 + (size_t)(l * 2 + 0) * 64 * 256, 64, 256, W + W_A2, 0, t, smem); break;
    case 9: convT_tile(p.rw_a2 + (size_t)(l * 2 + 1) * 64 * 256, 64, 256, W + W_A2 + (size_t)256 * 64, 0, t, smem); break;
    case 10: convT_tile(p.rw_g2 + (size_t)l * 128 * 256, 128, 256, W + W_G2, 0, t, smem); break;
    case 11: convT_tile(p.w_out + (size_t)l * D * D, D, D, W + W_OUT, 0, t, smem); break;
    case 12: convT_tile(p.ffn2_gate + (size_t)l * D * DFF, D, DFF, W + W_GU2, 1, t, smem); break;
    case 13: convT_tile(p.ffn2_up + (size_t)l * D * DFF, D, DFF, W + W_GU2, 2, t, smem); break;
    default: convT_tile(p.ffn2_down + (size_t)l * D * DFF, DFF, D, W + W_D2, 0, t, smem); break;
  }
}
constexpr int AUX_EARLY = 704 * 3 + 720 + 24 + 16 + 16 + 8;
constexpr int AUX_LATE = 256 + 704 * 3;
DI void aux_tile(const Params& p, int l, int a, u16* W, char* smem) {
  int jl = 1, j0 = 11;
  if (l == 0 && a < AUX_EARLY) j0 = 0;
  else if (l == 0) { a -= AUX_EARLY; jl = 0; }
  int j = j0;
  for (;;) {
    const int n = conv_job_tiles(j);
    if (a < n) break;
    a -= n;
    ++j;
  }
  conv_job_tile(p, jl, j, a, W, smem);
}

__global__ void __launch_bounds__(NTHR, 2) fwd_megakernel(Params p) {
  cg::grid_group grid = cg::this_grid();
  __shared__ __attribute__((aligned(16))) char smem[73728];
  __shared__ int s_item;
  __shared__ uint4 xb_words;
  if (threadIdx.x == 0) xb_words = make_uint4(0u, 0u, 0u, 0u);
  __syncthreads();
  const XcdBarrier xb = xcd_barrier_post((unsigned*)(p.ws + OFF_BAR), (volatile LAS unsigned*)&xb_words);
  char* ws = p.ws;
  float* ctxs = (float*)(ws + OFF_CTX);
  float* mod = (float*)(ws + OFF_MOD);
  u16* hbuf = (u16*)(ws + OFF_H);
  char* big = ws + OFF_BIG;
  u16* Gbuf = (u16*)big;
  u16* const Wl = (u16*)(ws + OFF_W);
  float* const filt = (float*)(ws + OFF_FILT);

  for (int j = 0; j <= 10; ++j)
    for (int t = blockIdx.x; t < conv_job_tiles(j); t += gridDim.x) conv_job_tile(p, 0, j, t, Wl, smem);
  hyfilt_phase(p, 0, LQ, filt, smem);
  hyfilt_phase(p, 0, LC, (float*)(ws + OFF_FILTC), smem);
  rope_table_phase((float2*)(ws + OFF_ROPEG), (float2*)(ws + OFF_ROPEM));
  mod_phase(p, mod, smem);
  grid.sync();

  for (int l = 0; l < 2; ++l) {
    const bool last = (l == 1);
    const u16* W = Wl;
    if (l == 1) {
      hyfilt_phase(p, 1, LQ, filt, smem);
    }
    const float* modl = mod + (size_t)l * 9 * 9216;
    const float* lat_in = (l == 0) ? p.x : p.out;
    const float* ctx_in = (l == 0) ? p.ctx : ctxs;

    adaln_phase(lat_in, ctx_in, p.norm_ffn1 + l * D, modl, 0, hbuf, false);
    xcd_barrier(xb);
    {
      EpiGU e{Gbuf};
      gemm_gu_phase(hbuf, W + W_GU1, T / 128, false, smem, e);
    }
    xcd_barrier(xb);
    {
      EpiRes e{lat_in, ctx_in, p.out, ctxs, modl, 2, 0.5f, nullptr, nullptr, nullptr, 0};
      gemm_phase<false>(Gbuf, DFF, W + W_D1, DFF, DFF, T / 128, 8, 0, false, smem, e);
    }
    xcd_barrier(xb);
    adaln_phase(p.out, ctxs, p.norm_mix + l * D, modl, 1, hbuf, false);
    xcd_barrier(xb);
    for (int g = 0; g < NG; ++g) {
      const MixBufs m = mixbufs(big, g);
      const u16* hg = hbuf + (size_t)g * TG * D;
      {
        EpiWin e{m.p, m.pt};
        gemm_phase<false>(hg, D, W + W_IN, D, D, TG / 128, 23, 0, false, smem, e);
      }
      xcd_barrier(xb);
      for (int rep = 0; rep < REP_ROW; ++rep) prep_phase(p, l, g, m, (const float2*)(ws + OFF_ROPEG), smem);
      xcd_barrier(xb);
      {
        EpiStore e1{m.qup, 384, 384};
        gemm_phase<false>(m.cqn, 256, W + W_UQ, 256, 256, TG / 128, 3, 0, false, smem, e1);
        EpiStore e2{m.kvup, 512, 512};
        gemm_phase<false>(m.ckvn, 128, W + W_UKV, 128, 128, TG / 128, 4, 0, false, smem, e2);
        EpiLoraW e3{m.ef, p.rw_w0 + (l * 2 + 0) * 256};
        gemm_phase<false>(m.lwf, 64, W + W_W2, 64, 64, TG / 128, 2, 0, false, smem, e3);
        EpiLoraW e4{m.eb, p.rw_w0 + (l * 2 + 1) * 256};
        gemm_phase<false>(m.lwb, 64, W + W_W2 + 256 * 64, 64, 64, TG / 128, 2, 0, false, smem, e4);
        EpiLoraA e5{m.af, p.rw_a0 + (l * 2 + 0) * 256};
        gemm_phase<false>(m.laf, 64, W + W_A2, 64, 64, TG / 128, 2, 0, false, smem, e5);
        EpiLoraA e6{m.ab, p.rw_a0 + (l * 2 + 1) * 256};
        gemm_phase<false>(m.lab, 64, W + W_A2 + 256 * 64, 64, 64, TG / 128, 2, 0, false, smem, e6);
        EpiStore e7{m.gg, 256, 256};
        gemm_phase<false>(m.lg, 128, W + W_G2, 128, 128, TG / 128, 2, 0, false, smem, e7);
      }
      xcd_barrier(xb);
      for (int rep = 0; rep < REP_ROW; ++rep) mla_fin_phase(p, l, g, m, (const float2*)(ws + OFF_ROPEM));
      xcd_barrier(xb);
      {
        u16* ymix = hbuf;
        const int n_scan = (g == NG - 1) ? NG * BG * 4 * 2 * 4 : 0;
        const int qt_per_b = last ? 16 : 17;
        const int n_att = BG * 4 * qt_per_b;
        const int n_gqa = (g == NG - 1) ? NG * n_att : 0;
        const int n_hy = 256;
        const int total = n_scan + n_att + n_gqa + n_hy;
        float gq = 0.f, gk = 0.f, mq = 0.f, mk = 0.f;
        for (int i = 0; i < 64; ++i) { gq = fmaxf(gq, fabsf(p.gqa_q_norm[l * 64 + i])); gk = fmaxf(gk, fabsf(p.gqa_k_norm[l * 64 + i])); }
        for (int i = 0; i < 96; ++i) { mq = fmaxf(mq, fabsf(p.mla_q_norm[l * 96 + i])); mk = fmaxf(mk, fabsf(p.mla_k_norm[l * 96 + i])); }
        const float L2E = 1.4426950408889634f;
        const float sc_g = 0.125f, sc_m = 0.10206207261596575f;
        const float sh_g = (64.f * gq * gk * sc_g * 1.02f + 0.5f) * L2E;
        const float sh_m = (96.f * mq * mk * sc_m * 1.02f + 0.5f) * L2E;
        int* cnt = (int*)(ws + OFF_CNT) + (l * NG + g);
        for (;;) {
          if (threadIdx.x == 0) s_item = atomicAdd(cnt, 1);
          __syncthreads();
          const int it = s_item;
          __syncthreads();
          if (it >= total) break;
          if (it < n_scan) {
            const int sg = it >> 7, bl = (it >> 5) & 3, hd = (it >> 3) & 3, dir = (it >> 2) & 1, rq = it & 3;
            const MixBufs ms = mixbufs(big, sg);
            scan_item(p, l, ms, bl, hd, dir, rq, smem);
          } else if (it < n_scan + n_att + n_gqa) {
            int a = it - n_scan;
            const int kind = a < n_att ? 0 : 1;
            int ag = g;
            if (kind == 1) { a -= n_att; ag = a / n_att; a -= ag * n_att; }
            const int bl = a / (4 * qt_per_b);
            int rem = a - bl * 4 * qt_per_b;
            const int hd = rem / qt_per_b;
            const int qt = rem - hd * qt_per_b;
            const int j0 = qt < 16 ? LC + qt * 256 : 0;
            const int nkeys = qt < 16 ? LT : LC;
            const size_t rl0 = (size_t)bl * LT + j0;
            const size_t rg0 = (size_t)(ag * BG + bl) * LT + j0;
            if (kind == 1) {
              const MixBufs ma = mixbufs(big, ag);
              const int kvh = hd >> 1;
              attn_item<64, 2>(ma.qg + rl0 * 256 + hd * 64, 256, ma.kg + (size_t)bl * LT * 128 + kvh * 64, 128,
                            ma.vtg + (size_t)(bl * 2 + kvh) * 64 * LT, ymix + rg0 * D + 256 + hd * 64, D, nkeys, sc_g * L2E, sh_g, smem);
            } else {
              attn_item<96, 2>(m.qm + rl0 * 384 + hd * 96, 384, m.km + (size_t)bl * LT * 384 + hd * 96, 384,
                            m.vtm + (size_t)(bl * 4 + hd) * 64 * LT, ymix + rg0 * D + 512 + hd * 64, D, nkeys, sc_m * L2E, sh_m, smem);
            }
          } else {
            const int c = it - n_scan - n_att - n_gqa;
            hyena_pass(p, l, m, filt, LQ, LC, c, smem);
            if (!last) hyena_pass(p, l, m, (const float*)(ws + OFF_FILTC), LC, 0, c, smem);
          }
        }
        if (g == NG - 1) {
          int* acnt = (int*)(ws + OFF_CNT) + 16 + l;
          const int n_aux = l == 0 ? AUX_EARLY + AUX_LATE : AUX_LATE;
          for (;;) {
            if (threadIdx.x == 0) s_item = atomicAdd(acnt, 1);
            __syncthreads();
            const int a = s_item;
            __syncthreads();
            if (a >= n_aux) break;
            aux_tile(p, l, a, Wl, smem);
          }
        }
        xcd_barrier(xb);
        readout_hy_phase(g, m, ymix, last, smem);
        if (g == NG - 1) {
          for (int rg = 0; rg < NG; ++rg) {
            const MixBufs mr = mixbufs(big, rg);
            readout_rw_phase(p, l, rg, mr, ymix, last);
          }
          xcd_barrier(xb);
        }
      }
    }
    {
      EpiRes e{p.out, ctxs, p.out, ctxs, modl, 5, 1.0f, nullptr, nullptr, nullptr, 0};
      gemm_phase<false>(hbuf, D, W + W_OUT, D, D, T / 128, 8, 0, last, smem, e);
    }
    xcd_barrier(xb);
    adaln_phase(p.out, ctxs, p.norm_ffn2 + l * D, modl, 2, hbuf, last);
    xcd_barrier(xb);
    {
      EpiGU e{Gbuf};
      gemm_gu_phase(hbuf, W + W_GU2, T / 128, last, smem, e);
    }
    xcd_barrier(xb);
    {
      EpiRes e{p.out, ctxs, p.out, ctxs, modl, 8, 0.5f, nullptr, nullptr, nullptr, 0};
      gemm_phase<false>(Gbuf, DFF, W + W_D2, DFF, DFF, T / 128, 8, 0, last, smem, e);
    }
    xcd_barrier(xb);
  }
}

extern "C" void kernel_launch(void* const* d_in, const int* in_sizes, int n_in, void* d_out, int out_size, void* d_ws,
                              size_t ws_size, hipStream_t stream) {
  static int grid_blocks = 0;
  if (!grid_blocks) {
    int dev = 0, cus = 0, per_cu = 0;
    (void)hipGetDevice(&dev);
    (void)hipDeviceGetAttribute(&cus, hipDeviceAttributeMultiprocessorCount, dev);
    (void)hipOccupancyMaxActiveBlocksPerMultiprocessor(&per_cu, fwd_megakernel, NTHR, 0);
    if (per_cu > 2) per_cu = 2;
    if (per_cu < 1) per_cu = 1;
    grid_blocks = cus * per_cu;
  }
  Params p{};
  const float** pp = (const float**)&p;
  for (int i = 0; i < 47; ++i) pp[i] = (const float*)d_in[i];
  p.out = (float*)d_out;
  p.ws = (char*)d_ws;
  (void)hipMemsetAsync((char*)d_ws + OFF_CNT, 0, 256 + 3456 * 4, stream);
  void* args[] = {&p};
  hipError_t e = hipLaunchCooperativeKernel((void*)fwd_megakernel, dim3(grid_blocks), dim3(NTHR), args, 0, stream);
  if (e != hipSuccess) fprintf(stderr, "cooperative launch failed: %s (grid %d)\n", hipGetErrorString(e), grid_blocks);
}
```

```cpp
#include <hip/hip_runtime.h>
#include <hip/hip_bf16.h>
#include <hip/hip_cooperative_groups.h>
#include <cstdio>
namespace cg = cooperative_groups;

#define DI __device__ __forceinline__
typedef unsigned short u16;
using bf16x8 = __attribute__((ext_vector_type(8))) short;
using f32x16 = __attribute__((ext_vector_type(16))) float;
typedef __bf16 bf16x2_t __attribute__((ext_vector_type(2)));
typedef float f32x2_t __attribute__((ext_vector_type(2)));
#define MFMA32(a, b, c) __builtin_amdgcn_mfma_f32_32x32x16_bf16((a), (b), (c), 0, 0, 0)

constexpr int D = 1024, NB = 8, LQ = 4096, LC = 256, LT = 4352, T = NB * LT, DFF = 2816, DIN = 2848;
constexpr int HYC = 768, DINP = DIN - HYC;
constexpr int NG = 2, BG = NB / NG, TG = BG * LT;
constexpr int NTHR = 256;
#define REP_MIX 1
#define REP_GU 1
#define REP_MISC 1
#define REP_ROW 1
constexpr float EPS = 1e-6f;

constexpr size_t al(size_t x) { return (x + 255) & ~(size_t)255; }
constexpr size_t OFF_CTX = 0;
constexpr size_t OFF_MOD = OFF_CTX + al((size_t)NB * LC * D * 4);
constexpr size_t SZ_FILT_L = (size_t)(2 * LQ - 1) * 256 * 4;
constexpr size_t SZ_FILT_C = (size_t)(2 * LC - 1) * 256 * 4;
constexpr size_t OFF_CNT = OFF_MOD + al((size_t)2 * 9 * 9216 * 4);
constexpr size_t OFF_BAR = OFF_CNT + 256;
constexpr size_t OFF_FILT = OFF_BAR + al((size_t)3456 * 4);
constexpr size_t OFF_FILTC = OFF_FILT + al(SZ_FILT_L);
constexpr size_t OFF_ROPEG = OFF_FILTC + al(SZ_FILT_C);
constexpr size_t OFF_ROPEM = OFF_ROPEG + al((size_t)LQ * 32 * 8);
constexpr size_t OFF_W = OFF_ROPEM + al((size_t)LQ * 16 * 8);
constexpr size_t W_GU1 = 0;
constexpr size_t W_D1 = W_GU1 + (size_t)5632 * 1024;
constexpr size_t W_GU2 = W_D1 + (size_t)1024 * 2816;
constexpr size_t W_D2 = W_GU2 + (size_t)5632 * 1024;
constexpr size_t W_IN = W_D2 + (size_t)1024 * 2816;
constexpr size_t W_OUT = W_IN + (size_t)2944 * 1024;
constexpr size_t W_UQ = W_OUT + (size_t)1024 * 1024;
constexpr size_t W_UKV = W_UQ + (size_t)384 * 256;
constexpr size_t W_W2 = W_UKV + (size_t)512 * 128;
constexpr size_t W_A2 = W_W2 + (size_t)2 * 256 * 64;
constexpr size_t W_G2 = W_A2 + (size_t)2 * 256 * 64;
constexpr size_t W_LAYER = W_G2 + (size_t)256 * 128;
constexpr size_t OFF_H = OFF_W + al(W_LAYER * 2);
constexpr size_t OFF_BIG = OFF_H + al((size_t)T * D * 2);
constexpr size_t M_P = 0;
constexpr size_t M_PT = M_P + al((size_t)TG * DINP * 2);
constexpr size_t M_U = M_PT + al((size_t)HYC * TG * 2);
constexpr size_t M_CQN = M_U + al((size_t)TG * 256 * 2);
constexpr size_t M_CKVN = M_CQN + al((size_t)TG * 256 * 2);
constexpr size_t M_QUP = M_CKVN + al((size_t)TG * 128 * 2);
constexpr size_t M_KVUP = M_QUP + al((size_t)TG * 384 * 2);
constexpr size_t M_QM = M_KVUP + al((size_t)TG * 512 * 2);
constexpr size_t M_KM = M_QM + al((size_t)TG * 384 * 2);
constexpr size_t M_VTM = M_KM + al((size_t)TG * 384 * 2);
constexpr size_t M_LWF = M_VTM + al((size_t)TG * 256 * 2);
constexpr size_t M_LWB = M_LWF + al((size_t)TG * 64 * 2);
constexpr size_t M_LAF = M_LWB + al((size_t)TG * 64 * 2);
constexpr size_t M_LAB = M_LAF + al((size_t)TG * 64 * 2);
constexpr size_t M_LG = M_LAB + al((size_t)TG * 64 * 2);
constexpr size_t SZ_SC = al((size_t)TG * 256 * 2);
constexpr size_t M_SCAN = M_LG + al((size_t)TG * 128 * 2);
constexpr size_t SCAN_STRIDE = 11 * SZ_SC;
constexpr size_t M_END = M_SCAN + 2 * SCAN_STRIDE;
static_assert((size_t)4 * TG * 256 * 4 <= al((size_t)TG * DINP * 2), "yf/yb do not fit the p region");
constexpr size_t SZ_G = (size_t)T * DFF * 2;
constexpr size_t WS_NEED = OFF_BIG + (M_END > SZ_G ? M_END : SZ_G);
static_assert(WS_NEED <= (size_t)512 * 1024 * 1024, "workspace too large");

struct Params {
  const float *x, *c, *ctx, *c_ctx, *ada_w, *ada_b, *norm_ffn1, *norm_mix, *norm_ffn2;
  const float *ffn1_gate, *ffn1_up, *ffn1_down, *ffn2_gate, *ffn2_up, *ffn2_down, *w_in, *w_out;
  const float *hy_conv_w, *hy_conv_b, *hy_f_w1, *hy_f_b1, *hy_f_w2, *hy_f_b2, *hy_f_w3, *hy_f_b3, *hy_f_w4, *hy_f_freq, *hy_bias;
  const float *gqa_q_norm, *gqa_k_norm, *mla_cq_norm, *mla_ckv_norm, *mla_w_uq, *mla_w_ukv, *mla_q_norm, *mla_k_norm;
  const float *rw_mu, *rw_w0, *rw_w2, *rw_a0, *rw_a2, *rw_g2, *rw_k_k, *rw_k_a, *rw_r_k, *rw_ln_w, *rw_ln_b;
  float* out;
  char* ws;
};

DI u16 f2bf(float x) {
  unsigned u = __float_as_uint(x);
  u += 0x7fffu + ((u >> 16) & 1u);
  return (u16)(u >> 16);
}
DI float bf2f(u16 b) { return __uint_as_float(((unsigned)b) << 16); }
DI float bflo_(unsigned w) { return __uint_as_float(w << 16); }
DI float bfhi_(unsigned w) { return __uint_as_float(w & 0xffff0000u); }
DI unsigned pack2(float a, float b) {
  f32x2_t v = {a, b};
  bf16x2_t r = __builtin_convertvector(v, bf16x2_t);
  return __builtin_bit_cast(unsigned, r);
}
DI int ltid() {
  int t = threadIdx.x;
  asm volatile("" : "+v"(t));
  return t;
}
DI float wave_sum(float v) {
#pragma unroll
  for (int o = 32; o > 0; o >>= 1) v += __shfl_xor(v, o);
  return v;
}
DI float wave_max(float v) {
#pragma unroll
  for (int o = 32; o > 0; o >>= 1) v = fmaxf(v, __shfl_xor(v, o));
  return v;
}
DI float sigmoidf_(float x) { return __builtin_amdgcn_rcpf(1.f + __expf(-x)); }
DI int crow(int i, int h) { return (i & 3) + 8 * (i >> 2) + 4 * h; }

DI float rope_apply(float val, int idx, int nfreq, int t, int lane) {
  int pi = idx >> 1;
  int row = t >> 6, col = t & 63;
  float pos = pi < nfreq ? (float)row : (float)col;
  int f = pi < nfreq ? pi : pi - nfreq;
  float inv = exp2f(-(float)f / (float)nfreq * 13.287712379549449f);
  float ang = pos * inv;
  float cs = cosf(ang), sn = sinf(ang);
  float other = __shfl_xor(val, 1);
  return (lane & 1) ? other * sn + val * cs : val * cs - other * sn;
}

DI float rope_tab(float val, int idx, const float2* __restrict__ tab, int lane) {
  const float2 cs = tab[idx >> 1];
  const float other = __shfl_xor(val, 1);
  return (lane & 1) ? other * cs.y + val * cs.x : val * cs.x - other * cs.y;
}
DI void rope_table_phase(float2* __restrict__ tg, float2* __restrict__ tm) {
  const int tid = ltid();
  for (int e = blockIdx.x * NTHR + tid; e < LQ * 48; e += gridDim.x * NTHR) {
    const int t = e / 48, k = e - t * 48;
    const bool isg = k < 32;
    const int pi = isg ? k : k - 32, nfreq = isg ? 16 : 8;
    const int row = t >> 6, col = t & 63;
    const float pos = pi < nfreq ? (float)row : (float)col;
    const int f = pi < nfreq ? pi : pi - nfreq;
    const float inv = exp2f(-(float)f / (float)nfreq * 13.287712379549449f);
    const float ang = pos * inv;
    const float2 v = make_float2(cosf(ang), sinf(ang));
    if (isg) tg[t * 32 + pi] = v; else tm[t * 16 + pi] = v;
  }
}

DI int gu_row(int n, int half) { return (n >> 7) * 256 + ((n >> 6) & 1) * 128 + ((n >> 5) & 1) * 64 + half * 32 + (n & 31); }
DI void convT_tile(const float* __restrict__ src, int K, int N, u16* __restrict__ dst, int mode, int t, char* smem) {
  float* tile = (float*)smem;
  const int tn = (N + 63) / 64;
  const int tid_ = ltid();
  const int j = tid_ & 63, i0 = tid_ >> 6;
  const int k0 = (t / tn) * 64, n0 = (t % tn) * 64;
  for (int i = i0; i < 64; i += 4) {
    int n = n0 + j;
    tile[i * 65 + j] = n < N ? src[(size_t)(k0 + i) * N + n] : 0.f;
  }
  __syncthreads();
  for (int i = i0; i < 64; i += 4) {
    int n = n0 + i;
    if (n < N) {
      int row = mode == 0 ? n : gu_row(n, mode - 1);
      dst[(size_t)row * K + k0 + j] = f2bf(tile[j * 65 + i]);
    }
  }
  __syncthreads();
}
DI void convT(const float* __restrict__ src, int K, int N, u16* __restrict__ dst, int mode, char* smem) {
  const int tk = K / 64, tn = (N + 63) / 64;
  for (int t = blockIdx.x; t < tk * tn; t += gridDim.x) convT_tile(src, K, N, dst, mode, t, smem);
}

DI void mod_phase(const Params& p, float* __restrict__ mod, char* smem) {
  float* sc = (float*)smem;
  float* red = sc + 9 * 1024;
  const int tid_ = ltid();
  for (int i = tid_; i < 9 * 1024; i += NTHR) {
    float v = i < 8192 ? p.c[i] : p.c_ctx[i - 8192];
    sc[i] = v / (1.f + expf(-v));
  }
  __syncthreads();
  const int lane = tid_ & 63, kp = tid_ >> 6;
  for (int it = blockIdx.x; it < 2 * 144; it += gridDim.x) {
    const int l = it / 144, nb = (it % 144) * 64;
    const float* w = p.ada_w + (size_t)l * 1024 * 9216 + nb + lane;
    float acc[9];
#pragma unroll
    for (int b = 0; b < 9; ++b) acc[b] = 0.f;
    for (int k = kp * 256; k < kp * 256 + 256; ++k) {
      float wv = w[(size_t)k * 9216];
#pragma unroll
      for (int b = 0; b < 9; ++b) acc[b] += sc[b * 1024 + k] * wv;
    }
#pragma unroll
    for (int b = 0; b < 9; ++b) red[(kp * 9 + b) * 64 + lane] = acc[b];
    __syncthreads();
    for (int o = tid_; o < 9 * 64; o += NTHR) {
      int b = o >> 6, ln = o & 63;
      float s = red[(0 * 9 + b) * 64 + ln] + red[(1 * 9 + b) * 64 + ln] + red[(2 * 9 + b) * 64 + ln] + red[(3 * 9 + b) * 64 + ln];
      mod[((size_t)l * 9 + b) * 9216 + nb + ln] = s + p.ada_b[l * 9216 + nb + ln];
    }
    __syncthreads();
  }
}

DI void hyfilt_phase(const Params& p, int l, int L, float* __restrict__ gT, char* smem) {
  float* z = (float*)smem;
  float* h1 = z + 64;
  float* h2 = h1 + 64;
  float* h3 = h2 + 64;
  float* w1s = z + 256;
  float* w2s = w1s + 33 * 64;
  float* w3s = w2s + 64 * 64;
  const float* w4 = p.hy_f_w4 + l * 64 * 512;
  const int tid = ltid();
  for (int i = tid; i < 33 * 64; i += NTHR) w1s[i] = p.hy_f_w1[l * 33 * 64 + i];
  for (int i = tid; i < 64 * 64; i += NTHR) { w2s[i] = p.hy_f_w2[l * 4096 + i]; w3s[i] = p.hy_f_w3[l * 4096 + i]; }
  float b1v = 0.f, b2v = 0.f, b3v = 0.f, frv = 0.f;
  if (tid < 64) { b1v = p.hy_f_b1[l * 64 + tid]; b2v = p.hy_f_b2[l * 64 + tid]; b3v = p.hy_f_b3[l * 64 + tid]; frv = p.hy_f_freq[l * 64 + tid]; }
  const float min_decay = logf(1e-2f) / 1.5f, max_decay = logf(1e-2f) / 0.3f;
  const float delta = fabsf(min_decay + (max_decay - min_decay) * (float)tid / 255.f);
  __syncthreads();
  for (int t = blockIdx.x; t < L; t += gridDim.x) {
    const float t01 = (float)t / (float)(L - 1);
    if (tid < 33) {
      float zz;
      if (tid == 0) zz = t01;
      else {
        int i = (tid - 1) & 15;
        float f = 1e-4f + (float)i * ((15.f - 1e-4f) / 15.f);
        float wang = 6.283185307179586f * (float)t / (float)L;
        zz = tid <= 16 ? cosf(f * wang) : -sinf(f * wang);
      }
      z[tid] = zz;
    }
    __syncthreads();
    if (tid < 64) {
      float a = b1v;
#pragma unroll 11
      for (int i = 0; i < 33; ++i) a += z[i] * w1s[i * 64 + tid];
      h1[tid] = sinf(frv * a);
    }
    __syncthreads();
    if (tid < 64) {
      float a = b2v;
#pragma unroll 16
      for (int i = 0; i < 64; ++i) a += h1[i] * w2s[i * 64 + tid];
      h2[tid] = sinf(frv * a);
    }
    __syncthreads();
    if (tid < 64) {
      float a = b3v;
#pragma unroll 16
      for (int i = 0; i < 64; ++i) a += h2[i] * w3s[i * 64 + tid];
      h3[tid] = sinf(frv * a);
    }
    __syncthreads();
    float af = 0.f, ab = 0.f;
#pragma unroll 8
    for (int i = 0; i < 64; ++i) {
      af += h3[i] * w4[i * 512 + tid];
      ab += h3[i] * w4[i * 512 + 256 + tid];
    }
    const float dec = expf(-t01 * delta);
    af *= dec;
    ab *= dec;
    if (t == 0) gT[(size_t)(L - 1) * 256 + tid] = af + ab;
    else {
      gT[(size_t)(L - 1 + t) * 256 + tid] = af;
      gT[(size_t)(L - 1 - t) * 256 + tid] = ab;
    }
    __syncthreads();
  }
  __syncthreads();
}

DI void adaln_phase(const float* __restrict__ lat, const float* __restrict__ ctxp, const float* __restrict__ gain,
                    const float* __restrict__ modl, int idx, u16* __restrict__ h, bool skip_ctx) {
  const int tid_ = ltid();
  const int wave = tid_ >> 6, lane = tid_ & 63;
  for (int r = blockIdx.x * 4 + wave; r < T; r += gridDim.x * 4) {
    const int b = r / LT, j = r - b * LT;
    if (skip_ctx && j < LC) continue;
    const float* xr = j < LC ? ctxp + ((size_t)(b * LC + j) << 10) : lat + ((size_t)(b * LQ + j - LC) << 10);
    const int bb = j < LC ? 8 : b;
    const float* shift = modl + bb * 9216 + (3 * idx) * 1024;
    const float* scale = shift + 1024;
    float4 v[4];
    float ss = 0.f;
#pragma unroll
    for (int q = 0; q < 4; ++q) {
      v[q] = *(const float4*)(xr + q * 256 + lane * 4);
      ss += v[q].x * v[q].x + v[q].y * v[q].y + v[q].z * v[q].z + v[q].w * v[q].w;
    }
    ss = wave_sum(ss);
    const float rstd = rsqrtf(ss * (1.f / 1024.f) + EPS);
#pragma unroll
    for (int q = 0; q < 4; ++q) {
      const int c = q * 256 + lane * 4;
      float4 g = *(const float4*)(gain + c), sc = *(const float4*)(scale + c), sh = *(const float4*)(shift + c);
      float y0 = v[q].x * rstd * g.x * (1.f + sc.x) + sh.x;
      float y1 = v[q].y * rstd * g.y * (1.f + sc.y) + sh.y;
      float y2 = v[q].z * rstd * g.z * (1.f + sc.z) + sh.z;
      float y3 = v[q].w * rstd * g.w * (1.f + sc.w) + sh.w;
      uint2 o;
      o.x = pack2(y0, y1);
      o.y = pack2(y2, y3);
      *(uint2*)(h + (size_t)r * D + c) = o;
    }
  }
}

DI bool gemm_decode(int t, int mtiles, int ntiles, int mt_off, bool skip_ctx, int& mt, int& nt) {
  const int mtx = mtiles >> 3;
  const int xcd = t & 7, q = t >> 3;
  const int sr = q / (8 * ntiles);
  const int rem = q - sr * 8 * ntiles;
  const int rows_in = min(8, mtx - sr * 8);
  const int sc = rem / (rows_in * 8);
  const int r2 = rem - sc * rows_in * 8;
  const int i = r2 % rows_in, j = r2 / rows_in;
  mt = (sr * 8 + i) * 8 + xcd;
  nt = sc * 8 + j;
  return !(skip_ctx && ((mt + mt_off) % 34) < 2);
}
template <bool PAIRED, class Epi>
DI void gemm_phase(const u16* __restrict__ A, int lda, const u16* __restrict__ Bt, int ldb, int K, int mtiles, int ntiles,
                   int mt_off, bool skip_ctx, char* smem, Epi& epi) {
  u16* As = (u16*)smem;
  u16* Bs = As + 2 * 128 * 72;
  const int tid = ltid(), lane = tid & 63, wave = tid >> 6;
  const int wm = wave >> 1, wn = wave & 1, lr = lane & 31, lh = lane >> 5;
  const int lrow = tid >> 3, lkc = (tid & 7) * 8;
  const int total = mtiles * ntiles, nk = K >> 6;
  uint4 ra00, ra01, ra02, ra03, rb00, rb01, rb02, rb03, ra10, ra11, ra12, ra13, rb10, rb11, rb12, rb13;
  const u16* Agl;
  const u16* Bgl;
#define GEMM_GLOAD(S, kt_)                                            \
  {                                                                   \
    const int k0_ = (kt_) << 6;                                       \
    ra##S##0 = *(const uint4*)(Agl + k0_);                            \
    ra##S##1 = *(const uint4*)(Agl + (size_t)32 * lda + k0_);         \
    ra##S##2 = *(const uint4*)(Agl + (size_t)64 * lda + k0_);         \
    ra##S##3 = *(const uint4*)(Agl + (size_t)96 * lda + k0_);         \
    rb##S##0 = *(const uint4*)(Bgl + k0_);                            \
    rb##S##1 = *(const uint4*)(Bgl + (size_t)32 * ldb + k0_);         \
    rb##S##2 = *(const uint4*)(Bgl + (size_t)64 * ldb + k0_);         \
    rb##S##3 = *(const uint4*)(Bgl + (size_t)96 * ldb + k0_);         \
  }
#define GEMM_LSTORE(S, buf_)                                          \
  {                                                                   \
    u16* ad_ = As + (buf_) * 128 * 72 + lrow * 72 + lkc;              \
    u16* bd_ = Bs + (buf_) * 128 * 72 + lrow * 72 + lkc;              \
    *(uint4*)(ad_) = ra##S##0;                                        \
    *(uint4*)(ad_ + 32 * 72) = ra##S##1;                              \
    *(uint4*)(ad_ + 64 * 72) = ra##S##2;                              \
    *(uint4*)(ad_ + 96 * 72) = ra##S##3;                              \
    *(uint4*)(bd_) = rb##S##0;                                        \
    *(uint4*)(bd_ + 32 * 72) = rb##S##1;                              \
    *(uint4*)(bd_ + 64 * 72) = rb##S##2;                              \
    *(uint4*)(bd_ + 96 * 72) = rb##S##3;                              \
  }
#define GEMM_COMPUTE(buf_)                                                        \
  {                                                                               \
    const u16* as = As + (buf_) * 128 * 72 + (wm * 64 + lr) * 72 + lh * 8;        \
    const u16* bs = Bs + (buf_) * 128 * 72 + (wn * 64 + lr) * 72 + lh * 8;        \
    _Pragma("unroll") for (int ks = 0; ks < 4; ++ks) {                            \
      bf16x8 a0 = *(const bf16x8*)(as + ks * 16);                                 \
      bf16x8 a1 = *(const bf16x8*)(as + 32 * 72 + ks * 16);                       \
      bf16x8 b0 = *(const bf16x8*)(bs + ks * 16);                                 \
      bf16x8 b1 = *(const bf16x8*)(bs + 32 * 72 + ks * 16);                       \
      acc[0][0] = MFMA32(a0, b0, acc[0][0]);                                      \
      acc[0][1] = MFMA32(a0, b1, acc[0][1]);                                      \
      acc[1][0] = MFMA32(a1, b0, acc[1][0]);                                      \
      acc[1][1] = MFMA32(a1, b1, acc[1][1]);                                      \
    }                                                                             \
  }
  int t = blockIdx.x, mt = 0, nt = 0;
  while (t < total && !gemm_decode(t, mtiles, ntiles, mt_off, skip_ctx, mt, nt)) t += gridDim.x;
  if (t < total) {
    Agl = A + (size_t)(mt * 128 + lrow) * lda + lkc;
    Bgl = Bt + (size_t)(nt * 128 + lrow) * ldb + lkc;
    GEMM_GLOAD(0, 0);
  }
  while (t < total) {
    const int m0 = mt * 128, n0 = nt * 128;
    int tn = t + gridDim.x, mtn = 0, ntn = 0;
    while (tn < total && !gemm_decode(tn, mtiles, ntiles, mt_off, skip_ctx, mtn, ntn)) tn += gridDim.x;
    f32x16 acc[2][2];
#pragma unroll
    for (int a = 0; a < 2; ++a)
#pragma unroll
      for (int b = 0; b < 2; ++b)
#pragma unroll
        for (int i = 0; i < 16; ++i) acc[a][b][i] = 0.f;
    GEMM_LSTORE(0, 0);
    __syncthreads();
    if (nk > 1) GEMM_GLOAD(0, 1);
    for (int kt = 0; kt < nk; kt += 2) {
      if (kt + 2 < nk) GEMM_GLOAD(1, kt + 2);
      GEMM_COMPUTE(0);
      if (kt + 1 < nk) GEMM_LSTORE(0, 1);
      __syncthreads();
      if (kt + 1 >= nk) break;
      if (kt + 3 < nk) GEMM_GLOAD(0, kt + 3);
      GEMM_COMPUTE(1);
      if (kt + 2 < nk) GEMM_LSTORE(1, 0);
      __syncthreads();
    }
    if (tn < total) {
      Agl = A + (size_t)(mtn * 128 + lrow) * lda + lkc;
      Bgl = Bt + (size_t)(ntn * 128 + lrow) * ldb + lkc;
      GEMM_GLOAD(0, 0);
    }
    epi.tile(m0);
    if constexpr (PAIRED) {
      float* stg = (float*)smem + wave * 64 * 36;
#pragma unroll
      for (int mi = 0; mi < 2; ++mi)
#pragma unroll
        for (int i = 0; i < 16; ++i) stg[(mi * 32 + crow(i, lh)) * 36 + lr] = epi.combine(acc[mi][0][i], acc[mi][1][i]);
      __syncthreads();
#pragma unroll
      for (int k = 0; k < 8; ++k) {
        const int idx = lane + 64 * k, row = idx >> 3, c4 = idx & 7;
        const float4 v = *(const float4*)(stg + row * 36 + c4 * 4);
        epi.store4(m0 + wm * 64 + row, (n0 >> 1) + wn * 32 + c4 * 4, v);
      }
      __syncthreads();
    } else if constexpr (Epi::kStaged) {
      float* stg = (float*)smem + wave * 64 * 68;
#pragma unroll
      for (int mi = 0; mi < 2; ++mi)
#pragma unroll
        for (int ni = 0; ni < 2; ++ni)
#pragma unroll
          for (int i = 0; i < 16; ++i) stg[(mi * 32 + crow(i, lh)) * 68 + ni * 32 + lr] = acc[mi][ni][i];
      __syncthreads();
#pragma unroll 4
      for (int k = 0; k < 16; ++k) {
        const int idx = lane + 64 * k, row = idx >> 4, c4 = idx & 15;
        const float4 v = *(const float4*)(stg + row * 68 + c4 * 4);
        epi.row4(m0 + wm * 64 + row, n0 + wn * 64 + c4 * 4, v);
      }
      __syncthreads();
    } else {
#pragma unroll
      for (int mi = 0; mi < 2; ++mi) {
#pragma unroll
        for (int gq = 0; gq < 4; ++gq) {
          const int row0 = m0 + wm * 64 + mi * 32 + 8 * gq + 4 * lh;
          if (PAIRED) {
            const int col = (n0 >> 1) + wn * 32 + lr;
#pragma unroll
            for (int e = 0; e < 4; ++e) epi.pair(row0 + e, col, acc[mi][0][4 * gq + e], acc[mi][1][4 * gq + e]);
          } else {
            epi.quad(row0, n0 + wn * 64 + lr, acc[mi][0][4 * gq], acc[mi][0][4 * gq + 1], acc[mi][0][4 * gq + 2], acc[mi][0][4 * gq + 3]);
            epi.quad(row0, n0 + wn * 64 + 32 + lr, acc[mi][1][4 * gq], acc[mi][1][4 * gq + 1], acc[mi][1][4 * gq + 2], acc[mi][1][4 * gq + 3]);
          }
        }
      }
    }
    t = tn; mt = mtn; nt = ntn;
  }
}

template <class Epi>
DI void gemm_gu_phase(const u16* __restrict__ A, const u16* __restrict__ Bt, int mtiles, bool skip_ctx, char* smem, Epi& epi) {
  constexpr int lda = D, ldb = D, K = D, ntiles = 22, RS = 40;
  u16* As = (u16*)smem;
  u16* Bs = As + 2 * 128 * RS;
  const int tid = ltid(), lane = tid & 63, wave = tid >> 6;
  const int wm = wave >> 1, wn = wave & 1, lr = lane & 31, lh = lane >> 5;
  const int lrow = tid >> 2, lkc = (tid & 3) * 8;
  const int total = mtiles * ntiles, nk = K >> 5;
  uint4 ra00, ra01, rb00, rb01, rb02, rb03, ra10, ra11, rb10, rb11, rb12, rb13;
  const u16* Agl;
  const u16* Bgl;
#define GU_GLOAD(S, kt_)                                              \
  {                                                                   \
    const int k0_ = (kt_) << 5;                                       \
    ra##S##0 = *(const uint4*)(Agl + k0_);                            \
    ra##S##1 = *(const uint4*)(Agl + (size_t)64 * lda + k0_);         \
    rb##S##0 = *(const uint4*)(Bgl + k0_);                            \
    rb##S##1 = *(const uint4*)(Bgl + (size_t)64 * ldb + k0_);         \
    rb##S##2 = *(const uint4*)(Bgl + (size_t)128 * ldb + k0_);        \
    rb##S##3 = *(const uint4*)(Bgl + (size_t)192 * ldb + k0_);        \
  }
#define GU_LSTORE(S, buf_)                                            \
  {                                                                   \
    u16* ad_ = As + (buf_) * 128 * RS + lrow * RS + lkc;              \
    u16* bd_ = Bs + (buf_) * 256 * RS + lrow * RS + lkc;              \
    *(uint4*)(ad_) = ra##S##0;                                        \
    *(uint4*)(ad_ + 64 * RS) = ra##S##1;                              \
    *(uint4*)(bd_) = rb##S##0;                                        \
    *(uint4*)(bd_ + 64 * RS) = rb##S##1;                              \
    *(uint4*)(bd_ + 128 * RS) = rb##S##2;                             \
    *(uint4*)(bd_ + 192 * RS) = rb##S##3;                             \
  }
#define GU_COMPUTE(buf_)                                                          \
  {                                                                               \
    const u16* as = As + (buf_) * 128 * RS + (wm * 64 + lr) * RS + lh * 8;        \
    const u16* bs = Bs + (buf_) * 256 * RS + (wn * 128 + lr) * RS + lh * 8;       \
    _Pragma("unroll") for (int ks = 0; ks < 2; ++ks) {                            \
      bf16x8 a0 = *(const bf16x8*)(as + ks * 16);                                 \
      bf16x8 a1 = *(const bf16x8*)(as + 32 * RS + ks * 16);                       \
      bf16x8 b0 = *(const bf16x8*)(bs + ks * 16);                                 \
      bf16x8 b1 = *(const bf16x8*)(bs + 32 * RS + ks * 16);                       \
      bf16x8 b2 = *(const bf16x8*)(bs + 64 * RS + ks * 16);                       \
      bf16x8 b3 = *(const bf16x8*)(bs + 96 * RS + ks * 16);                       \
      acc[0][0] = MFMA32(a0, b0, acc[0][0]);                                      \
      acc[0][1] = MFMA32(a0, b1, acc[0][1]);                                      \
      acc[0][2] = MFMA32(a0, b2, acc[0][2]);                                      \
      acc[0][3] = MFMA32(a0, b3, acc[0][3]);                                      \
      acc[1][0] = MFMA32(a1, b0, acc[1][0]);                                      \
      acc[1][1] = MFMA32(a1, b1, acc[1][1]);                                      \
      acc[1][2] = MFMA32(a1, b2, acc[1][2]);                                      \
      acc[1][3] = MFMA32(a1, b3, acc[1][3]);                                      \
    }                                                                             \
  }
  int t = blockIdx.x, mt = 0, nt = 0;
  while (t < total && !gemm_decode(t, mtiles, ntiles, 0, skip_ctx, mt, nt)) t += gridDim.x;
  if (t < total) {
    Agl = A + (size_t)(mt * 128 + lrow) * lda + lkc;
    Bgl = Bt + (size_t)(nt * 256 + lrow) * ldb + lkc;
    GU_GLOAD(0, 0);
  }
  while (t < total) {
    const int m0 = mt * 128, n0 = nt * 256;
    int tn = t + gridDim.x, mtn = 0, ntn = 0;
    while (tn < total && !gemm_decode(tn, mtiles, ntiles, 0, skip_ctx, mtn, ntn)) tn += gridDim.x;
    f32x16 acc[2][4];
#pragma unroll
    for (int a = 0; a < 2; ++a)
#pragma unroll
      for (int b = 0; b < 4; ++b)
#pragma unroll
        for (int i = 0; i < 16; ++i) acc[a][b][i] = 0.f;
    GU_LSTORE(0, 0);
    __syncthreads();
    GU_GLOAD(0, 1);
    for (int kt = 0; kt < nk; kt += 2) {
      if (kt + 2 < nk) GU_GLOAD(1, kt + 2);
      GU_COMPUTE(0);
      GU_LSTORE(0, 1);
      __syncthreads();
      if (kt + 3 < nk) GU_GLOAD(0, kt + 3);
      GU_COMPUTE(1);
      if (kt + 2 < nk) GU_LSTORE(1, 0);
      __syncthreads();
    }
    if (tn < total) {
      Agl = A + (size_t)(mtn * 128 + lrow) * lda + lkc;
      Bgl = Bt + (size_t)(ntn * 256 + lrow) * ldb + lkc;
      GU_GLOAD(0, 0);
    }
    {
      float* stg = (float*)smem + wave * 64 * 68;
#pragma unroll
      for (int mi = 0; mi < 2; ++mi)
#pragma unroll
        for (int pi = 0; pi < 2; ++pi)
#pragma unroll
          for (int i = 0; i < 16; ++i)
            stg[(mi * 32 + crow(i, lh)) * 68 + pi * 32 + lr] = epi.combine(acc[mi][2 * pi][i], acc[mi][2 * pi + 1][i]);
      __syncthreads();
#pragma unroll 4
      for (int k = 0; k < 16; ++k) {
        const int idx = lane + 64 * k, row = idx >> 4, c4 = idx & 15;
        const float4 v = *(const float4*)(stg + row * 68 + c4 * 4);
        epi.store4(m0 + wm * 64 + row, (n0 >> 1) + wn * 64 + c4 * 4, v);
      }
      __syncthreads();
    }
    t = tn; mt = mtn; nt = ntn;
  }
}

#define EPI_DEFAULT_QUAD                                                   \
  static constexpr bool kStaged = false;                                   \
  DI void row4(int, int, float4) const {}                                  \
  DI void tile(int) {}                                                     \
  DI void quad(int row0, int col, float a, float b, float c, float d) const { \
    (*this)(row0, col, a);                                                 \
    (*this)(row0 + 1, col, b);                                             \
    (*this)(row0 + 2, col, c);                                             \
    (*this)(row0 + 3, col, d);                                             \
  }
struct EpiGU {
  u16* G;
  DI float combine(float g, float u) const { return g * __builtin_amdgcn_rcpf(1.f + __expf(-g)) * u; }
  DI void store4(int row, int col, float4 v) const {
    uint2 w;
    w.x = pack2(v.x, v.y);
    w.y = pack2(v.z, v.w);
    *(uint2*)(G + (size_t)row * DFF + col) = w;
  }
  DI void pair(int row, int col, float g, float u) const {
    float s = g / (1.f + __expf(-g));
    G[(size_t)row * DFF + col] = f2bf(s * u);
  }
  DI void operator()(int, int, float) const {}
  EPI_DEFAULT_QUAD
};
struct EpiRes {
  const float* lat_in; const float* ctx_in; float* lat_out; float* ctx_out; const float* modl; int gate_chunk; float coef;
  const float* tin; float* tout; const float* gate; int tm0;
  static constexpr bool kStaged = true;
  DI void row4(int row, int col, float4 v) const {
    const size_t o = ((size_t)(row - tm0) << 10) + col;
    const float4 x = *(const float4*)(tin + o);
    const float4 g = *(const float4*)(gate + col);
    float4 y;
    y.x = x.x + coef * g.x * v.x;
    y.y = x.y + coef * g.y * v.y;
    y.z = x.z + coef * g.z * v.z;
    y.w = x.w + coef * g.w * v.w;
    *(float4*)(tout + o) = y;
  }
  DI void tile(int m0) {
    const int b = m0 / LT, j = m0 - b * LT;
    const bool isc = j < LC;
    const size_t off = isc ? (((size_t)(b * LC + j)) << 10) : (((size_t)(b * LQ + j - LC)) << 10);
    tin = (isc ? ctx_in : lat_in) + off;
    tout = (isc ? ctx_out : lat_out) + off;
    gate = modl + (isc ? 8 : b) * 9216 + gate_chunk * 1024;
    tm0 = m0;
  }
  DI void operator()(int row, int col, float v) const {
    const size_t o = ((size_t)(row - tm0) << 10) + col;
    tout[o] = tin[o] + coef * gate[col] * v;
  }
  DI void pair(int, int, float, float) const {}
  DI void quad(int row0, int col, float a, float b, float c, float d) const {
    const float gc = coef * gate[col];
    const size_t o = ((size_t)(row0 - tm0) << 10) + col;
    tout[o] = tin[o] + gc * a;
    tout[o + 1024] = tin[o + 1024] + gc * b;
    tout[o + 2048] = tin[o + 2048] + gc * c;
    tout[o + 3072] = tin[o + 3072] + gc * d;
  }
};
struct EpiStore {
  u16* C; int ldc; int N;
  DI void operator()(int row, int col, float v) const { if (col < N) C[(size_t)row * ldc + col] = f2bf(v); }
  DI void pair(int, int, float, float) const {}
  EPI_DEFAULT_QUAD
};
struct EpiWin {
  u16* p; u16* pT;
  static constexpr bool kStaged = false;
  DI void row4(int, int, float4) const {}
  DI void tile(int) {}
  DI void quad(int row0, int col, float a, float b, float c, float d) const {
    if (col < HYC) {
      uint2 w;
      w.x = pack2(a, b);
      w.y = pack2(c, d);
      *(uint2*)(pT + (size_t)col * TG + row0) = w;
    } else if (col < DIN) {
      u16* q = p + (size_t)row0 * DINP + (col - HYC);
      q[0] = f2bf(a);
      q[DINP] = f2bf(b);
      q[2 * DINP] = f2bf(c);
      q[3 * DINP] = f2bf(d);
    }
  }
  DI void pair(int, int, float, float) const {}
};
struct EpiLoraW {
  u16* C; const float* w0;
  DI void operator()(int row, int col, float v) const {
    float zz = -(w0[col] + v);
    float sp = fmaxf(zz, 0.f) + log1pf(expf(-fabsf(zz)));
    C[(size_t)row * 256 + col] = f2bf(-expm1f(-expf(-sp - 0.5f)));
  }
  DI void pair(int, int, float, float) const {}
  EPI_DEFAULT_QUAD
};
struct EpiLoraA {
  u16* C; const float* a0;
  DI void operator()(int row, int col, float v) const { C[(size_t)row * 256 + col] = f2bf(sigmoidf_(a0[col] + v)); }
  DI void pair(int, int, float, float) const {}
  EPI_DEFAULT_QUAD
};

struct MixBufs {
  u16 *p, *pt, *u, *qg, *kg, *vtg, *cqn, *ckvn, *qup, *kvup, *qm, *km, *vtm, *rr, *rk, *rv, *rkk, *lwf, *lwb, *laf, *lab, *lg, *ef, *eb, *af, *ab, *gg;
  float *yf, *yb;
};
DI MixBufs mixbufs(char* big, int g) {
  MixBufs m;
  m.p = (u16*)(big + M_P); m.pt = (u16*)(big + M_PT); m.u = (u16*)(big + M_U);
  m.cqn = (u16*)(big + M_CQN); m.ckvn = (u16*)(big + M_CKVN); m.qup = (u16*)(big + M_QUP);
  m.kvup = (u16*)(big + M_KVUP); m.qm = (u16*)(big + M_QM); m.km = (u16*)(big + M_KM); m.vtm = (u16*)(big + M_VTM);
  m.lwf = (u16*)(big + M_LWF); m.lwb = (u16*)(big + M_LWB); m.laf = (u16*)(big + M_LAF); m.lab = (u16*)(big + M_LAB);
  m.lg = (u16*)(big + M_LG);
  char* sc = big + M_SCAN + (size_t)g * SCAN_STRIDE;
  m.rr = (u16*)(sc + 0 * SZ_SC); m.rk = (u16*)(sc + 1 * SZ_SC); m.rv = (u16*)(sc + 2 * SZ_SC); m.rkk = (u16*)(sc + 3 * SZ_SC);
  m.ef = (u16*)(sc + 4 * SZ_SC); m.eb = (u16*)(sc + 5 * SZ_SC); m.af = (u16*)(sc + 6 * SZ_SC); m.ab = (u16*)(sc + 7 * SZ_SC);
  m.gg = (u16*)(sc + 8 * SZ_SC);
  m.qg = (u16*)(sc + 9 * SZ_SC); m.kg = (u16*)(sc + 10 * SZ_SC); m.vtg = m.kg + (size_t)TG * 128;
  m.yf = (float*)(big + M_P) + (size_t)g * 2 * TG * 256;
  m.yb = m.yf + (size_t)TG * 256;
  return m;
}

DI void prep_phase(const Params& p, int l, int g, const MixBufs& m, const float2* __restrict__ ropeg, char* smem) {
  const int tid = ltid(), lane = tid & 63, wave = tid >> 6;
  const float* mu = p.rw_mu + l * 1152;
  for (int rl = blockIdx.x * 4 + wave; rl < TG; rl += gridDim.x * 4) {
    const int r = g * TG + rl;
    const int b = r / LT, j = r - b * LT, bl = b - g * BG;
    const bool lat = j >= LC;
    const bool hp = lat ? (j > LC) : (j > 0);
    const bool hn = lat ? (j < LT - 1) : (j < LC - 1);
    const u16* pc = m.p + (size_t)rl * DINP;
    const u16* pp = pc - DINP;
    const u16* pn = pc + DINP;
    auto tshift = [&](int crel) -> float {
      const int c = 1696 - HYC + crel;
      float u0 = bf2f(pc[c]);
      float nb = 0.f;
      if (hp) nb += bf2f(pp[c]);
      if (hn) nb += bf2f(pn[c]);
      return u0 + mu[crel] * (0.5f * nb - u0);
    };
#pragma unroll
    for (int hd = 0; hd < 4; ++hd) {
      const int c = hd * 64 + lane;
      const float sr = tshift(c), sk = tshift(256 + c), sv = tshift(512 + c);
      m.rr[(size_t)rl * 256 + c] = f2bf(sr);
      m.rk[(size_t)rl * 256 + c] = f2bf(sk);
      m.rv[(size_t)rl * 256 + c] = f2bf(sv);
      const float kx = sk * p.rw_k_k[l * 256 + c];
      const float ss = wave_sum(kx * kx);
      m.rkk[(size_t)rl * 256 + c] = f2bf(kx / fmaxf(sqrtf(ss), 1e-12f));
    }
    {
      const float s0 = tshift(768 + lane), s1 = tshift(832 + lane), s2 = tshift(896 + lane), s3 = tshift(960 + lane);
      const float s4 = tshift(1024 + lane), s5 = tshift(1088 + lane);
      m.lwf[(size_t)rl * 64 + lane] = f2bf(tanhf(s0));
      m.lwb[(size_t)rl * 64 + lane] = f2bf(tanhf(s1));
      m.laf[(size_t)rl * 64 + lane] = f2bf(s2);
      m.lab[(size_t)rl * 64 + lane] = f2bf(s3);
      m.lg[(size_t)rl * 128 + lane] = f2bf(sigmoidf_(s4));
      m.lg[(size_t)rl * 128 + 64 + lane] = f2bf(sigmoidf_(s5));
    }
    {
      float cq[4], ckv[2];
      float s1 = 0.f, s2 = 0.f;
#pragma unroll
      for (int q = 0; q < 4; ++q) { cq[q] = bf2f(pc[1280 - HYC + lane + 64 * q]); s1 += cq[q] * cq[q]; }
#pragma unroll
      for (int q = 0; q < 2; ++q) { ckv[q] = bf2f(pc[1536 - HYC + lane + 64 * q]); s2 += ckv[q] * ckv[q]; }
      s1 = wave_sum(s1);
      s2 = wave_sum(s2);
      const float r1 = rsqrtf(s1 * (1.f / 256.f) + EPS), r2 = rsqrtf(s2 * (1.f / 128.f) + EPS);
#pragma unroll
      for (int q = 0; q < 4; ++q) m.cqn[(size_t)rl * 256 + lane + 64 * q] = f2bf(cq[q] * r1 * p.mla_cq_norm[l * 256 + lane + 64 * q]);
#pragma unroll
      for (int q = 0; q < 2; ++q) m.ckvn[(size_t)rl * 128 + lane + 64 * q] = f2bf(ckv[q] * r2 * p.mla_ckv_norm[l * 128 + lane + 64 * q]);
    }
    const float2* rt = ropeg + (size_t)(lat ? j - LC : 0) * 32;
    const float gq_ = p.gqa_q_norm[l * 64 + lane], gk_ = p.gqa_k_norm[l * 64 + lane];
#pragma unroll
    for (int hh = 0; hh < 6; ++hh) {
      float val = bf2f(pc[hh * 64 + lane]);
      const float ss = wave_sum(val * val);
      val = val * rsqrtf(ss * (1.f / 64.f) + EPS) * (hh < 4 ? gq_ : gk_);
      const float rv = rope_tab(val, lane, rt, lane);
      if (lat) val = rv;
      if (hh < 4) m.qg[(size_t)rl * 256 + hh * 64 + lane] = f2bf(val);
      else m.kg[(size_t)rl * 128 + (hh - 4) * 64 + lane] = f2bf(val);
    }
#pragma unroll
    for (int kvh = 0; kvh < 2; ++kvh) m.vtg[((size_t)(bl * 2 + kvh) * 64 + lane) * LT + j] = pc[1152 - HYC + kvh * 64 + lane];
  }
}

DI void mla_fin_phase(const Params& p, int l, int g, const MixBufs& m, const float2* __restrict__ ropem) {
  const int tid = ltid(), lane = tid & 63, wave = tid >> 6;
  const float qn0 = p.mla_q_norm[l * 96 + lane], kn0 = p.mla_k_norm[l * 96 + lane];
  const float qn1 = lane < 32 ? p.mla_q_norm[l * 96 + 64 + lane] : 0.f;
  const float kn1 = lane < 32 ? p.mla_k_norm[l * 96 + 64 + lane] : 0.f;
#pragma unroll 2
  for (int rl = blockIdx.x * 4 + wave; rl < TG; rl += gridDim.x * 4) {
    const int r = g * TG + rl;
    const int b = r / LT, j = r - b * LT, bl = b - g * BG;
    const bool lat = j >= LC;
    const u16* qrow = m.qup + (size_t)rl * 384;
    const u16* kvrow = m.kvup + (size_t)rl * 512;
    float q0[4], q1[4], k0[4];
    u16 vraw[4];
    const float kr = lane < 32 ? bf2f(m.p[(size_t)rl * DINP + 1664 - HYC + lane]) : 0.f;
    const float2 cs = ropem[(size_t)(lat ? j - LC : 0) * 16 + ((lane & 31) >> 1)];
#pragma unroll
    for (int hd = 0; hd < 4; ++hd) {
      q0[hd] = bf2f(qrow[hd * 96 + lane]);
      q1[hd] = lane < 32 ? bf2f(qrow[hd * 96 + 64 + lane]) : 0.f;
      k0[hd] = bf2f(kvrow[hd * 128 + lane]);
      vraw[hd] = kvrow[hd * 128 + 64 + lane];
    }
#pragma unroll
    for (int hd = 0; hd < 4; ++hd) {
      const float sq = wave_sum(q0[hd] * q0[hd] + q1[hd] * q1[hd]);
      const float sk = wave_sum(k0[hd] * k0[hd] + kr * kr);
      const float rq = rsqrtf(sq * (1.f / 96.f) + EPS), rk = rsqrtf(sk * (1.f / 96.f) + EPS);
      const float yq0 = q0[hd] * rq * qn0, yk0 = k0[hd] * rk * kn0;
      float yq1 = q1[hd] * rq * qn1, yk1 = kr * rk * kn1;
      const float oq = __shfl_xor(yq1, 1), ok = __shfl_xor(yk1, 1);
      if (lat) {
        yq1 = (lane & 1) ? oq * cs.y + yq1 * cs.x : yq1 * cs.x - oq * cs.y;
        yk1 = (lane & 1) ? ok * cs.y + yk1 * cs.x : yk1 * cs.x - ok * cs.y;
      }
      u16* dq = m.qm + (size_t)rl * 384 + hd * 96;
      u16* dk = m.km + (size_t)rl * 384 + hd * 96;
      dq[lane] = f2bf(yq0);
      dk[lane] = f2bf(yk0);
      if (lane < 32) {
        dq[64 + lane] = f2bf(yq1);
        dk[64 + lane] = f2bf(yk1);
      }
      m.vtm[((size_t)(bl * 4 + hd) * 64 + lane) * LT + j] = vraw[hd];
    }
  }
}

template <int DQK, int QT>
DI void attn_item(const u16* __restrict__ q, int ldq, const u16* __restrict__ k, int ldk, const u16* __restrict__ vT,
                  u16* __restrict__ out, int ldo, int nkeys, float sl2, float sh2, char* smem) {
  constexpr int KS = DQK + 8;
  constexpr int NKS = DQK / 16;
  constexpr int KCH = DQK / 8;
  constexpr int KPT = 64 * KCH / NTHR;
  u16* Ks = (u16*)smem;
  u16* Vs = Ks + 2 * 64 * KS;
  const int tid = ltid(), lane = tid & 63, wave = tid >> 6, lr = lane & 31, lh = lane >> 5;
  bf16x8 qf[QT][NKS];
#pragma unroll
  for (int qt = 0; qt < QT; ++qt)
#pragma unroll
    for (int ks = 0; ks < NKS; ++ks)
      qf[qt][ks] = *(const bf16x8*)(q + (size_t)(wave * 32 * QT + qt * 32 + lr) * ldq + ks * 16 + lh * 8);
  f32x16 o[QT][2];
#pragma unroll
  for (int a = 0; a < QT; ++a)
#pragma unroll
    for (int b = 0; b < 2; ++b)
#pragma unroll
      for (int i = 0; i < 16; ++i) o[a][b][i] = 0.f;
  float lsum[QT];
#pragma unroll
  for (int a = 0; a < QT; ++a) lsum[a] = 0.f;
  uint4 rk[KPT], rv[2];
#define ATT_GLOAD(key0)                                                                   \
  {                                                                                       \
    _Pragma("unroll") for (int i = 0; i < KPT; ++i) {                                     \
      const int id = tid + NTHR * i, row = id / KCH, ch = id - row * KCH;                 \
      rk[i] = *(const uint4*)(k + (size_t)((key0) + row) * ldk + ch * 8);                 \
    }                                                                                     \
    _Pragma("unroll") for (int i = 0; i < 2; ++i) {                                       \
      const int id = tid + NTHR * i, row = id >> 3, ch = id & 7;                          \
      rv[i] = *(const uint4*)(vT + (size_t)row * LT + (key0) + ch * 8);                   \
    }                                                                                     \
  }
#define ATT_LSTORE(buf_)                                                                  \
  {                                                                                       \
    _Pragma("unroll") for (int i = 0; i < KPT; ++i) {                                     \
      const int id = tid + NTHR * i, row = id / KCH, ch = id - row * KCH;                 \
      *(uint4*)(Ks + (buf_) * 64 * KS + row * KS + ch * 8) = rk[i];                       \
    }                                                                                     \
    _Pragma("unroll") for (int i = 0; i < 2; ++i) {                                       \
      const int id = tid + NTHR * i, row = id >> 3, ch = id & 7;                          \
      *(uint4*)(Vs + (buf_) * 64 * 72 + row * 72 + ch * 8) = rv[i];                       \
    }                                                                                     \
  }
  ATT_GLOAD(0);
  ATT_LSTORE(0);
  __syncthreads();
  const int nkt = nkeys >> 6;
  for (int kt = 0; kt < nkt; ++kt) {
    const int buf = kt & 1;
    if (kt + 1 < nkt) ATT_GLOAD((kt + 1) << 6);
    const u16* kb = Ks + buf * 64 * KS;
    const u16* vb = Vs + buf * 64 * 72;
#pragma unroll
    for (int half = 0; half < 2; ++half) {
      f32x16 s[QT];
#pragma unroll
      for (int qt = 0; qt < QT; ++qt)
#pragma unroll
        for (int i = 0; i < 16; ++i) s[qt][i] = 0.f;
      bf16x8 kf[NKS];
#pragma unroll
      for (int ks = 0; ks < NKS; ++ks) kf[ks] = *(const bf16x8*)(kb + (half * 32 + lr) * KS + ks * 16 + lh * 8);
#pragma unroll
      for (int ks = 0; ks < NKS; ++ks) {
#pragma unroll
        for (int qt = 0; qt < QT; ++qt) s[qt] = MFMA32(kf[ks], qf[qt][ks], s[qt]);
      }
#pragma unroll
      for (int qt = 0; qt < QT; ++qt)
#pragma unroll
        for (int i = 0; i < 16; ++i) {
          float pv = __builtin_amdgcn_exp2f(s[qt][i] * sl2 - sh2);
          lsum[qt] += pv;
          s[qt][i] = pv;
        }
#pragma unroll
      for (int st = 0; st < 2; ++st) {
        bf16x8 pb[QT];
#pragma unroll
        for (int qt = 0; qt < QT; ++qt) {
          uint4 w;
          w.x = pack2(s[qt][8 * st + 0], s[qt][8 * st + 1]);
          w.y = pack2(s[qt][8 * st + 2], s[qt][8 * st + 3]);
          w.z = pack2(s[qt][8 * st + 4], s[qt][8 * st + 5]);
          w.w = pack2(s[qt][8 * st + 6], s[qt][8 * st + 7]);
          pb[qt] = __builtin_bit_cast(bf16x8, w);
        }
        bf16x8 vf[2];
#pragma unroll
        for (int mt = 0; mt < 2; ++mt) {
          const u16* vp = vb + (mt * 32 + lr) * 72 + half * 32 + st * 16 + lh * 4;
          uint2 v0 = *(const uint2*)(vp);
          uint2 v1 = *(const uint2*)(vp + 8);
          uint4 w;
          w.x = v0.x; w.y = v0.y; w.z = v1.x; w.w = v1.y;
          vf[mt] = __builtin_bit_cast(bf16x8, w);
        }
#pragma unroll
        for (int mt = 0; mt < 2; ++mt) {
#pragma unroll
          for (int qt = 0; qt < QT; ++qt) o[qt][mt] = MFMA32(vf[mt], pb[qt], o[qt][mt]);
        }
      }
    }
    if (kt + 1 < nkt) ATT_LSTORE(buf ^ 1);
    __syncthreads();
  }
#pragma unroll
  for (int qt = 0; qt < QT; ++qt) {
    float tot = lsum[qt] + __shfl_xor(lsum[qt], 32);
    float inv = 1.f / tot;
    const int row = wave * 32 * QT + qt * 32 + lr;
#pragma unroll
    for (int mt = 0; mt < 2; ++mt)
#pragma unroll
      for (int gq = 0; gq < 4; ++gq) {
        uint2 w;
        w.x = pack2(o[qt][mt][4 * gq + 0] * inv, o[qt][mt][4 * gq + 1] * inv);
        w.y = pack2(o[qt][mt][4 * gq + 2] * inv, o[qt][mt][4 * gq + 3] * inv);
        *(uint2*)(out + (size_t)row * ldo + mt * 32 + 8 * gq + 4 * lh) = w;
      }
  }
}

DI void hyena_pass(const Params& p, int l, const MixBufs& m, const float* __restrict__ gT, int L, int segoff, int c, char* smem) {
  const int RS = L + 16, US = L + 16;
  unsigned* Rc = (unsigned*)smem;
  u16* U = (u16*)(smem + (size_t)2 * RS * 4);
  const int tid = ltid(), lane = tid & 63, wave = tid >> 6;
  for (int d = tid; d < L; d += NTHR) {
    const int q = 2 * d;
    const float r0 = gT[(size_t)(2 * L - 2 - q) * 256 + c];
    const float r1 = (q + 1 <= 2 * L - 2) ? gT[(size_t)(2 * L - 3 - q) * 256 + c] : 0.f;
    const float r2 = (q + 2 <= 2 * L - 2) ? gT[(size_t)(2 * L - 4 - q) * 256 + c] : 0.f;
    Rc[d] = pack2(r0, r1);
    Rc[RS + d] = pack2(r1, r2);
  }
  const float* cw = p.hy_conv_w + l * 3 * 768;
  const float* cb = p.hy_conv_b + l * 768;
  {
    const float w0a = cw[c], w1a = cw[768 + c], w2a = cw[1536 + c], ba = cb[c];
    const float w0v = cw[512 + c], w1v = cw[768 + 512 + c], w2v = cw[1536 + 512 + c], bv = cb[512 + c];
    for (int b = 0; b < BG; ++b) {
      const u16* x1p = m.pt + (size_t)c * TG + b * LT + segoff;
      const u16* vp = m.pt + (size_t)(512 + c) * TG + b * LT + segoff;
      for (int t = tid; t < L; t += NTHR) {
        float x1 = bf2f(x1p[t]) * w1a + ba;
        float vv = bf2f(vp[t]) * w1v + bv;
        if (t > 0) { x1 += bf2f(x1p[t - 1]) * w0a; vv += bf2f(vp[t - 1]) * w0v; }
        if (t < L - 1) { x1 += bf2f(x1p[t + 1]) * w2a; vv += bf2f(vp[t + 1]) * w2v; }
        U[b * US + t] = f2bf(x1 * vv);
      }
    }
  }
  __syncthreads();
  const int i = lane & 31, h = lane >> 5, bn = i & 3, mb = i >> 2;
  const int par = (L - 1 - i) & 1;
  const float bias = p.hy_bias[l * 256 + c];
  const float w0x = cw[256 + c], w1x = cw[768 + 256 + c], w2x = cw[1536 + 256 + c], bx = cb[256 + c];
  const int nsteps = (L + 208) / 16 + 1;
  for (int sp = wave; sp < L / 256; sp += 4) {
    const int T0 = sp * 256;
    f32x16 acc;
#pragma unroll
    for (int r = 0; r < 16; ++r) acc[r] = 0.f;
    const int delta0 = T0 + 224;
    const int q0 = (L - 1) - delta0 - i + 8 * h;
    const unsigned* ap = Rc + par * RS + (q0 >> 1);
    int s0 = T0 + 32 * mb - delta0;
    const u16* bp = U + bn * US + s0 + 8 * h;
#pragma unroll 2
    for (int st = 0; st < nsteps; ++st) {
      uint4 aw;
      aw.x = ap[0]; aw.y = ap[1]; aw.z = ap[2]; aw.w = ap[3];
      uint4 bw = make_uint4(0u, 0u, 0u, 0u);
      if (s0 >= 0 && s0 <= L - 16) bw = *(const uint4*)bp;
      acc = MFMA32(__builtin_bit_cast(bf16x8, aw), __builtin_bit_cast(bf16x8, bw), acc);
      ap += 8;
      s0 += 16;
      bp += 16;
    }
    const u16* x2p = m.pt + (size_t)(256 + c) * TG + bn * LT + segoff;
    u16* yp = m.u + (size_t)c * TG + bn * LT + segoff;
#pragma unroll
    for (int gq = 0; gq < 4; ++gq) {
      const int t4 = T0 + 32 * mb + 8 * gq + 4 * h;
      float e[6];
#pragma unroll
      for (int k = 0; k < 6; ++k) {
        const int tt = t4 - 1 + k;
        e[k] = (tt >= 0 && tt < L) ? bf2f(x2p[tt]) : 0.f;
      }
      const uint2 uu = *(const uint2*)(U + bn * US + t4);
      const float u0 = bflo_(uu.x), u1 = bfhi_(uu.x), u2 = bflo_(uu.y), u3 = bfhi_(uu.y);
      const float y0 = (e[0] * w0x + e[1] * w1x + e[2] * w2x + bx) * (acc[4 * gq + 0] + u0 * bias);
      const float y1 = (e[1] * w0x + e[2] * w1x + e[3] * w2x + bx) * (acc[4 * gq + 1] + u1 * bias);
      const float y2 = (e[2] * w0x + e[3] * w1x + e[4] * w2x + bx) * (acc[4 * gq + 2] + u2 * bias);
      const float y3 = (e[3] * w0x + e[4] * w1x + e[5] * w2x + bx) * (acc[4 * gq + 3] + u3 * bias);
      uint2 w;
      w.x = pack2(y0, y1);
      w.y = pack2(y2, y3);
      *(uint2*)(yp + t4) = w;
    }
  }
  __syncthreads();
}

#define DPP_ROR(v, n) __builtin_bit_cast(float, __builtin_amdgcn_update_dpp(0, __builtin_bit_cast(int, (v)), 0x120 + (n), 0xf, 0xf, true))
DI float row_allsum(float v) {
  v += DPP_ROR(v, 8);
  v += DPP_ROR(v, 4);
  v += DPP_ROR(v, 2);
  v += DPP_ROR(v, 1);
  return v;
}
DI float bflo(unsigned w) { return __uint_as_float(w << 16); }
DI float bfhi(unsigned w) { return __uint_as_float(w & 0xffff0000u); }
DI void scan_item(const Params& p, int l, const MixBufs& m, int bl, int hd, int dir, int rq, char* smem) {
  constexpr int TC = 16;
  constexpr int NCH = LT / TC;
  constexpr int BUF = 5 * TC * 64 + TC * 16;
  float* sbase = (float*)smem;
  float* sy = sbase + 2 * BUF;
  const int tid = ltid(), lane = tid & 63, wave = tid >> 6;
  const int kq = lane & 15, rloc = wave * 4 + (lane >> 4);
  const u16* eD = dir ? m.eb : m.ef;
  const u16* aD = dir ? m.ab : m.af;
  float* yD = dir ? m.yb : m.yf;
  const size_t rbase = (size_t)bl * LT;
  const int ss = tid >> 4, su = tid & 15, sc = su & 7;
  float kav[8];
#pragma unroll
  for (int i = 0; i < 8; ++i) kav[i] = p.rw_k_a[l * 256 + hd * 64 + sc * 8 + i];
  uint4 g0, g1, g2;
  g2.x = g2.y = g2.z = g2.w = 0u;
#define SCAN_JMAP(i) (dir ? ((i) < LC ? LC - 1 - (i) : LT - 1 - ((i) - LC)) : (i))
#define SCAN_GLOAD(i0)                                                                         \
  {                                                                                            \
    const int ii_ = (i0) + ss;                                                                 \
    const int j_ = SCAN_JMAP(ii_);                                                             \
    const size_t o_ = (rbase + j_) * 256 + hd * 64 + sc * 8;                                   \
    if (su < 8) {                                                                              \
      g0 = *(const uint4*)(m.rkk + o_);                                                        \
      g1 = *(const uint4*)(aD + o_);                                                           \
      g2 = *(const uint4*)(m.rk + o_);                                                         \
    } else {                                                                                   \
      g0 = *(const uint4*)(eD + o_);                                                           \
      g1 = *(const uint4*)(m.rr + o_);                                                         \
      if (sc < 2) g2 = *(const uint4*)(m.rv + (rbase + j_) * 256 + hd * 64 + rq * 16 + sc * 8); \
    }                                                                                          \
  }
#define SCAN_LSTORE(buf_)                                                                      \
  {                                                                                            \
    float* B_ = sbase + (buf_) * BUF;                                                          \
    const unsigned w0_[4] = {g0.x, g0.y, g0.z, g0.w};                                          \
    const unsigned w1_[4] = {g1.x, g1.y, g1.z, g1.w};                                          \
    const unsigned w2_[4] = {g2.x, g2.y, g2.z, g2.w};                                          \
    if (su < 8) {                                                                              \
      float kk_[8], bb_[8], dd_[8];                                                            \
      _Pragma("unroll") for (int q_ = 0; q_ < 4; ++q_) {                                       \
        const float k0_ = bflo(w0_[q_]), k1_ = bfhi(w0_[q_]);                                  \
        const float a0_ = bflo(w1_[q_]), a1_ = bfhi(w1_[q_]);                                  \
        const float v0_ = bflo(w2_[q_]), v1_ = bfhi(w2_[q_]);                                  \
        kk_[2 * q_] = k0_; kk_[2 * q_ + 1] = k1_;                                              \
        bb_[2 * q_] = k0_ * a0_; bb_[2 * q_ + 1] = k1_ * a1_;                                  \
        dd_[2 * q_] = v0_ * (1.f + (a0_ - 1.f) * kav[2 * q_]);                                 \
        dd_[2 * q_ + 1] = v1_ * (1.f + (a1_ - 1.f) * kav[2 * q_ + 1]);                         \
      }                                                                                        \
      float* d0_ = B_ + ss * 64 + sc * 8;                                                      \
      *(float4*)(d0_) = make_float4(kk_[0], kk_[1], kk_[2], kk_[3]);                           \
      *(float4*)(d0_ + 4) = make_float4(kk_[4], kk_[5], kk_[6], kk_[7]);                       \
      *(float4*)(d0_ + 2048) = make_float4(bb_[0], bb_[1], bb_[2], bb_[3]);                    \
      *(float4*)(d0_ + 2052) = make_float4(bb_[4], bb_[5], bb_[6], bb_[7]);                    \
      *(float4*)(d0_ + 3072) = make_float4(dd_[0], dd_[1], dd_[2], dd_[3]);                    \
      *(float4*)(d0_ + 3076) = make_float4(dd_[4], dd_[5], dd_[6], dd_[7]);                    \
    } else {                                                                                   \
      float ww_[8], rr_[8], vv_[8];                                                            \
      _Pragma("unroll") for (int q_ = 0; q_ < 4; ++q_) {                                       \
        ww_[2 * q_] = 1.f - bflo(w0_[q_]); ww_[2 * q_ + 1] = 1.f - bfhi(w0_[q_]);              \
        rr_[2 * q_] = bflo(w1_[q_]); rr_[2 * q_ + 1] = bfhi(w1_[q_]);                          \
        vv_[2 * q_] = bflo(w2_[q_]); vv_[2 * q_ + 1] = bfhi(w2_[q_]);                          \
      }                                                                                        \
      float* d0_ = B_ + ss * 64 + sc * 8;                                                      \
      *(float4*)(d0_ + 1024) = make_float4(ww_[0], ww_[1], ww_[2], ww_[3]);                    \
      *(float4*)(d0_ + 1028) = make_float4(ww_[4], ww_[5], ww_[6], ww_[7]);                    \
      *(float4*)(d0_ + 4096) = make_float4(rr_[0], rr_[1], rr_[2], rr_[3]);                    \
      *(float4*)(d0_ + 4100) = make_float4(rr_[4], rr_[5], rr_[6], rr_[7]);                    \
      if (sc < 2) {                                                                            \
        float* d1_ = B_ + 5120 + ss * 16 + sc * 8;                                             \
        *(float4*)(d1_) = make_float4(vv_[0], vv_[1], vv_[2], vv_[3]);                         \
        *(float4*)(d1_ + 4) = make_float4(vv_[4], vv_[5], vv_[6], vv_[7]);                     \
      }                                                                                        \
    }                                                                                          \
  }
  f32x2_t SA = {0.f, 0.f}, SB = {0.f, 0.f};
  __builtin_amdgcn_s_setprio(3);
  SCAN_GLOAD(0);
  SCAN_LSTORE(0);
  __syncthreads();
  for (int c = 0; c < NCH; ++c) {
    const int buf = c & 1;
    if (c + 1 < NCH) SCAN_GLOAD((c + 1) * TC);
    const float* B = sbase + buf * BUF;
    float* syb = sy + buf * TC * 16;
    float ypart[TC];
    float4 kkv[TC], wwv[TC], bbv[TC], ddv[TC], rrv[TC];
    float vvv[TC];
    constexpr int PF = 2;
#pragma unroll
    for (int st = 0; st < PF; ++st) {
      kkv[st] = *(const float4*)(B + st * 64 + kq * 4);
      wwv[st] = *(const float4*)(B + 1024 + st * 64 + kq * 4);
      bbv[st] = *(const float4*)(B + 2048 + st * 64 + kq * 4);
      ddv[st] = *(const float4*)(B + 3072 + st * 64 + kq * 4);
      rrv[st] = *(const float4*)(B + 4096 + st * 64 + kq * 4);
      vvv[st] = B[5120 + st * 16 + rloc];
    }
    __builtin_amdgcn_sched_barrier(0);
#pragma unroll
    for (int st = 0; st < TC; ++st) {
      if (st + PF < TC) {
        kkv[st + PF] = *(const float4*)(B + (st + PF) * 64 + kq * 4);
        wwv[st + PF] = *(const float4*)(B + 1024 + (st + PF) * 64 + kq * 4);
        bbv[st + PF] = *(const float4*)(B + 2048 + (st + PF) * 64 + kq * 4);
        ddv[st + PF] = *(const float4*)(B + 3072 + (st + PF) * 64 + kq * 4);
        rrv[st + PF] = *(const float4*)(B + 4096 + (st + PF) * 64 + kq * 4);
        vvv[st + PF] = B[5120 + (st + PF) * 16 + rloc];
      }
      __builtin_amdgcn_sched_barrier(0);
      const float4 kk = kkv[st], ww = wwv[st], bb = bbv[st], dd = ddv[st], rr = rrv[st];
      const float vv = vvv[st];
      const f32x2_t k01 = {kk.x, kk.y}, k23 = {kk.z, kk.w}, w01 = {ww.x, ww.y}, w23 = {ww.z, ww.w};
      const f32x2_t b01 = {bb.x, bb.y}, b23 = {bb.z, bb.w}, d01 = {dd.x, dd.y}, d23 = {dd.z, dd.w};
      const f32x2_t r01 = {rr.x, rr.y}, r23 = {rr.z, rr.w}, v2 = {vv, vv};
      const f32x2_t pp2 = SA * k01 + SB * k23;
      const float part = pp2.x + pp2.y;
      const f32x2_t cA = SA * w01 + v2 * d01, cB = SB * w23 + v2 * d23;
      const float sa = -row_allsum(part);
      const f32x2_t sa2 = {sa, sa};
      SA = cA + sa2 * b01;
      SB = cB + sa2 * b23;
      const f32x2_t yy2 = SA * r01 + SB * r23;
      ypart[st] = yy2.x + yy2.y;
    }
#pragma unroll
    for (int st = 0; st < TC; ++st) ypart[st] = row_allsum(ypart[st]);
    if (kq == 0) {
#pragma unroll
      for (int st = 0; st < TC; ++st) syb[st * 16 + rloc] = ypart[st];
    }
    if (c + 1 < NCH) SCAN_LSTORE(buf ^ 1);
    __syncthreads();
    {
      const int st = tid >> 4, r_ = tid & 15;
      const int ii = c * TC + st;
      const int j = SCAN_JMAP(ii);
      yD[(rbase + j) * 256 + hd * 64 + rq * 16 + r_] = syb[st * 16 + r_];
    }
  }
  __builtin_amdgcn_s_setprio(0);
  __syncthreads();
}

DI void readout_hy_phase(int g, const MixBufs& m, u16* __restrict__ ymix, bool skip_ctx, char* smem) {
  const int tid = ltid();
  {
    u16* tile = (u16*)smem;
    for (int tl = blockIdx.x; tl < (TG / 64) * 4; tl += gridDim.x) {
      const int rl0 = (tl >> 2) * 64, c0 = (tl & 3) * 64;
      const int r0 = g * TG + rl0;
      if (skip_ctx && (r0 % LT) < LC) continue;
#pragma unroll
      for (int k = 0; k < 2; ++k) {
        const int id = tid + NTHR * k, ch = id >> 3, part = id & 7;
        *(uint4*)(tile + ch * 72 + part * 8) = *(const uint4*)(m.u + (size_t)(c0 + ch) * TG + rl0 + part * 8);
      }
      __syncthreads();
#pragma unroll
      for (int k = 0; k < 2; ++k) {
        const int id = tid + NTHR * k, tok = id >> 3, part = id & 7;
        const u16* tp = tile + (part * 8) * 72 + tok;
        uint4 w;
        w.x = (unsigned)tp[0] | ((unsigned)tp[72] << 16);
        w.y = (unsigned)tp[2 * 72] | ((unsigned)tp[3 * 72] << 16);
        w.z = (unsigned)tp[4 * 72] | ((unsigned)tp[5 * 72] << 16);
        w.w = (unsigned)tp[6 * 72] | ((unsigned)tp[7 * 72] << 16);
        *(uint4*)(ymix + (size_t)(r0 + tok) * D + c0 + part * 8) = w;
      }
      __syncthreads();
    }
  }
}

DI void readout_rw_phase(const Params& p, int l, int g, const MixBufs& m, u16* __restrict__ ymix, bool skip_ctx) {
  const int tid = ltid();
  for (int rl = blockIdx.x; rl < TG; rl += gridDim.x) {
    const int r = g * TG + rl;
    const int j = r % LT;
    if (skip_ctx && j < LC) continue;
    const size_t o = (size_t)rl * 256 + tid;
    float y = m.yf[o] + m.yb[o];
    float mean = wave_sum(y) * (1.f / 64.f);
    float dv = y - mean;
    float var = wave_sum(dv * dv) * (1.f / 64.f);
    float yn = dv * rsqrtf(var + 64e-5f) * p.rw_ln_w[l * 256 + tid] + p.rw_ln_b[l * 256 + tid];
    const float rr = bf2f(m.rr[o]), kv = bf2f(m.rk[o]), vv = bf2f(m.rv[o]);
    const float kaa = p.rw_k_a[l * 256 + tid], rk = p.rw_r_k[l * 256 + tid];
    const float af = bf2f(m.af[o]), ab = bf2f(m.ab[o]);
    float t1 = rr * kv * (1.f + (af - 1.f) * kaa) * rk + rr * kv * (1.f + (ab - 1.f) * kaa) * rk;
    float bonus = wave_sum(t1) * vv;
    ymix[(size_t)r * D + 768 + tid] = f2bf((yn + bonus) * bf2f(m.gg[o]));
  }
}

#define XB_TMO      128
#define XB_XCNT(j)  (256  + 64 * (j))
#define XB_XSUB(j)  (1280 + 64 * (j))
#define XB_XGEN(j)  (2304 + 64 * (j))
#define XB_TOP      3328
#define XB_TOPGEN   3392
#define XCD_BAR_WORDS 3456
#define XB_SPIN_CAP (1u << 21)
#define LAS __attribute__((address_space(3)))
DI unsigned xb_ld(unsigned* p) { return __hip_atomic_load(p, __ATOMIC_RELAXED, __HIP_MEMORY_SCOPE_AGENT); }
DI unsigned xb_add(unsigned* p, unsigned v) { return __hip_atomic_fetch_add(p, v, __ATOMIC_RELAXED, __HIP_MEMORY_SCOPE_AGENT); }
DI unsigned xb_xcc_id() { return (unsigned)__builtin_amdgcn_s_getreg((3 << 11) | 20) & 0xFu; }
#define XB_SPIN(cond, bar) do { unsigned _sp = 0; while (cond) { __builtin_amdgcn_s_sleep(1); \
    if ((++_sp & 255u) == 0u) { if (xb_ld(&(bar)[XB_TMO])) break; if (_sp > XB_SPIN_CAP) { atomicAdd(&(bar)[XB_TMO], 1u); break; } } } } while (0)
struct XcdBarrier { unsigned* bar; unsigned x; volatile LAS unsigned* st; };
DI XcdBarrier xcd_barrier_post(unsigned* bar, volatile LAS unsigned* st) {
  XcdBarrier b; b.bar = bar; b.x = xb_xcc_id(); b.st = st;
  if (threadIdx.x == 0) (void)xb_add(&bar[XB_XCNT(b.x)], 1u);
  return b;
}
DI void xcd_barrier_complete(unsigned* bar, unsigned x, unsigned& nloc, unsigned& nx) {
  const unsigned G = gridDim.x * gridDim.y * gridDim.z;
  unsigned sum, cnt, mine, sp = 0u;
  for (;;) {
    sum = 0u; cnt = 0u; mine = 0u;
#pragma unroll
    for (unsigned j = 0; j < 16; ++j) { const unsigned c = xb_ld(&bar[XB_XCNT(j)]); sum += c; cnt += (c > 0u) ? 1u : 0u; mine = (j == x) ? c : mine; }
    if (sum == G) break;
    __builtin_amdgcn_s_sleep(1);
    if ((++sp & 255u) == 0u) { if (xb_ld(&bar[XB_TMO])) break; if (sp > XB_SPIN_CAP) { atomicAdd(&bar[XB_TMO], 1u); break; } }
  }
  nloc = mine > 0u ? mine : 1u; nx = cnt > 0u ? cnt : 1u;
}
DI void xcd_barrier(const XcdBarrier& b) {
  asm volatile("s_waitcnt vmcnt(0)" ::: "memory");
  __syncthreads();
  if (threadIdx.x == 0) {
    unsigned* bar = b.bar;
    __builtin_amdgcn_s_waitcnt(0);
    unsigned nloc = b.st[0], nx = b.st[1];
    if (nloc == 0u) { xcd_barrier_complete(bar, b.x, nloc, nx); b.st[0] = nloc; b.st[1] = nx; }
    const unsigned old = xb_add(&bar[XB_XSUB(b.x)], 1u);
    const unsigned gen = old / nloc;
    if (old + 1u == (gen + 1u) * nloc) {
      __builtin_amdgcn_fence(__ATOMIC_RELEASE, "agent");
      asm volatile("s_waitcnt vmcnt(0)" ::: "memory");
      const unsigned og = xb_add(&bar[XB_TOP], 1u);
      const unsigned tg = og / nx;
      if (og + 1u == (tg + 1u) * nx) xb_add(&bar[XB_TOPGEN], 1u);
      else XB_SPIN(xb_ld(&bar[XB_TOPGEN]) == tg, bar);
      __builtin_amdgcn_fence(__ATOMIC_ACQUIRE, "agent");
      xb_add(&bar[XB_XGEN(b.x)], 1u);
      asm volatile("s_waitcnt vmcnt(0)" ::: "memory");
    } else {
      XB_SPIN(xb_ld(&bar[XB_XGEN(b.x)]) == gen, bar);
      __builtin_amdgcn_fence(__ATOMIC_ACQUIRE, "agent");
      asm volatile("s_waitcnt vmcnt(0)" ::: "memory");
    }
  }
  __syncthreads();
}

DI int conv_job_tiles(int j) {
  return (j <= 2 || j >= 12) ? 704 : j == 3 ? 720 : j == 4 ? 24 : j == 5 ? 16 : j <= 9 ? 4 : j == 10 ? 8 : 256;
}
DI void conv_job_tile(const Params& p, int l, int j, int t, u16* W, char* smem) {
  switch (j) {
    case 0: convT_tile(p.ffn1_gate + (size_t)l * D * DFF, D, DFF, W + W_GU1, 1, t, smem); break;
    case 1: convT_tile(p.ffn1_up + (size_t)l * D * DFF, D, DFF, W + W_GU1, 2, t, smem); break;
    case 2: convT_tile(p.ffn1_down + (size_t)l * D * DFF, DFF, D, W + W_D1, 0, t, smem); break;
    case 3: convT_tile(p.w_in + (size_t)l * D * DIN, D, DIN, W + W_IN, 0, t, smem); break;
    case 4: convT_tile(p.mla_w_uq + (size_t)l * 256 * 384, 256, 384, W + W_UQ, 0, t, smem); break;
    case 5: convT_tile(p.mla_w_ukv + (size_t)l * 128 * 512, 128, 512, W + W_UKV, 0, t, smem); break;
    case 6: convT_tile(p.rw_w2 + (size_t)(l * 2 + 0) * 64 * 256, 64, 256, W + W_W2, 0, t, smem); break;
    case 7: convT_tile(p.rw_w2 + (size_t)(l * 2 + 1) * 64 * 256, 64, 256, W + W_W2 + (size_t)256 * 64, 0, t, smem); break;
    case 8: convT_tile(p.rw_a2 + (size_t)(l * 2 + 0) * 64 * 256, 64, 256, W + W_A2, 0, t, smem); break;
    case 9: convT_tile(p.rw_a2 + (size_t)(l * 2 + 1) * 64 * 256, 64, 256, W + W_A2 + (size_t)256 * 64, 0, t, smem); break;
    case 10: convT_tile(p.rw_g2 + (size_t)l * 128 * 256, 128, 256, W + W_G2, 0, t, smem); break;
    case 11: convT_tile(p.w_out + (size_t)l * D * D, D, D, W + W_OUT, 0, t, smem); break;
    case 12: convT_tile(p.ffn2_gate + (size_t)l * D * DFF, D, DFF, W + W_GU2, 1, t, smem); break;
    case 13: convT_tile(p.ffn2_up + (size_t)l * D * DFF, D, DFF, W + W_GU2, 2, t, smem); break;
    default: convT_tile(p.ffn2_down + (size_t)l * D * DFF, DFF, D, W + W_D2, 0, t, smem); break;
  }
}
constexpr int AUX_EARLY = 704 * 3 + 720 + 24 + 16 + 16 + 8;
constexpr int AUX_LATE = 256 + 704 * 3;
DI void aux_tile(const Params& p, int l, int a, u16* W, char* smem) {
  int jl = 1, j0 = 11;
  if (l == 0 && a < AUX_EARLY) j0 = 0;
  else if (l == 0) { a -= AUX_EARLY; jl = 0; }
  int j = j0;
  for (;;) {
    const int n = conv_job_tiles(j);
    if (a < n) break;
    a -= n;
    ++j;
  }
  conv_job_tile(p, jl, j, a, W, smem);
}

__global__ void __launch_bounds__(NTHR, 2) fwd_megakernel(Params p) {
  cg::grid_group grid = cg::this_grid();
  __shared__ __attribute__((aligned(16))) char smem[73728];
  __shared__ int s_item;
  __shared__ uint4 xb_words;
  if (threadIdx.x == 0) xb_words = make_uint4(0u, 0u, 0u, 0u);
  __syncthreads();
  const XcdBarrier xb = xcd_barrier_post((unsigned*)(p.ws + OFF_BAR), (volatile LAS unsigned*)&xb_words);
  char* ws = p.ws;
  float* ctxs = (float*)(ws + OFF_CTX);
  float* mod = (float*)(ws + OFF_MOD);
  u16* hbuf = (u16*)(ws + OFF_H);
  char* big = ws + OFF_BIG;
  u16* Gbuf = (u16*)big;
  u16* const Wl = (u16*)(ws + OFF_W);
  float* const filt = (float*)(ws + OFF_FILT);

  for (int j = 0; j <= 10; ++j)
    for (int t = blockIdx.x; t < conv_job_tiles(j); t += gridDim.x) conv_job_tile(p, 0, j, t, Wl, smem);
  hyfilt_phase(p, 0, LQ, filt, smem);
  hyfilt_phase(p, 0, LC, (float*)(ws + OFF_FILTC), smem);
  rope_table_phase((float2*)(ws + OFF_ROPEG), (float2*)(ws + OFF_ROPEM));
  mod_phase(p, mod, smem);
  grid.sync();

  for (int l = 0; l < 2; ++l) {
    const bool last = (l == 1);
    const u16* W = Wl;
    if (l == 1) {
      hyfilt_phase(p, 1, LQ, filt, smem);
    }
    const float* modl = mod + (size_t)l * 9 * 9216;
    const float* lat_in = (l == 0) ? p.x : p.out;
    const float* ctx_in = (l == 0) ? p.ctx : ctxs;

    adaln_phase(lat_in, ctx_in, p.norm_ffn1 + l * D, modl, 0, hbuf, false);
    xcd_barrier(xb);
    {
      EpiGU e{Gbuf};
      gemm_gu_phase(hbuf, W + W_GU1, T / 128, false, smem, e);
    }
    xcd_barrier(xb);
    {
      EpiRes e{lat_in, ctx_in, p.out, ctxs, modl, 2, 0.5f, nullptr, nullptr, nullptr, 0};
      gemm_phase<false>(Gbuf, DFF, W + W_D1, DFF, DFF, T / 128, 8, 0, false, smem, e);
    }
    xcd_barrier(xb);
    adaln_phase(p.out, ctxs, p.norm_mix + l * D, modl, 1, hbuf, false);
    xcd_barrier(xb);
    for (int g = 0; g < NG; ++g) {
      const MixBufs m = mixbufs(big, g);
      const u16* hg = hbuf + (size_t)g * TG * D;
      {
        EpiWin e{m.p, m.pt};
        gemm_phase<false>(hg, D, W + W_IN, D, D, TG / 128, 23, 0, false, smem, e);
      }
      xcd_barrier(xb);
      for (int rep = 0; rep < REP_ROW; ++rep) prep_phase(p, l, g, m, (const float2*)(ws + OFF_ROPEG), smem);
      xcd_barrier(xb);
      {
        EpiStore e1{m.qup, 384, 384};
        gemm_phase<false>(m.cqn, 256, W + W_UQ, 256, 256, TG / 128, 3, 0, false, smem, e1);
        EpiStore e2{m.kvup, 512, 512};
        gemm_phase<false>(m.ckvn, 128, W + W_UKV, 128, 128, TG / 128, 4, 0, false, smem, e2);
        EpiLoraW e3{m.ef, p.rw_w0 + (l * 2 + 0) * 256};
        gemm_phase<false>(m.lwf, 64, W + W_W2, 64, 64, TG / 128, 2, 0, false, smem, e3);
        EpiLoraW e4{m.eb, p.rw_w0 + (l * 2 + 1) * 256};
        gemm_phase<false>(m.lwb, 64, W + W_W2 + 256 * 64, 64, 64, TG / 128, 2, 0, false, smem, e4);
        EpiLoraA e5{m.af, p.rw_a0 + (l * 2 + 0) * 256};
        gemm_phase<false>(m.laf, 64, W + W_A2, 64, 64, TG / 128, 2, 0, false, smem, e5);
        EpiLoraA e6{m.ab, p.rw_a0 + (l * 2 + 1) * 256};
        gemm_phase<false>(m.lab, 64, W + W_A2 + 256 * 64, 64, 64, TG / 128, 2, 0, false, smem, e6);
        EpiStore e7{m.gg, 256, 256};
        gemm_phase<false>(m.lg, 128, W + W_G2, 128, 128, TG / 128, 2, 0, false, smem, e7);
      }
      xcd_barrier(xb);
      for (int rep = 0; rep < REP_ROW; ++rep) mla_fin_phase(p, l, g, m, (const float2*)(ws + OFF_ROPEM));
      xcd_barrier(xb);
      {
        u16* ymix = hbuf;
        const int n_scan = (g == NG - 1) ? NG * BG * 4 * 2 * 4 : 0;
        const int qt_per_b = last ? 16 : 17;
        const int n_att = BG * 4 * qt_per_b;
        const int n_gqa = (g == NG - 1) ? NG * n_att : 0;
        const int n_hy = 256;
        const int total = n_scan + n_att + n_gqa + n_hy;
        float gq = 0.f, gk = 0.f, mq = 0.f, mk = 0.f;
        for (int i = 0; i < 64; ++i) { gq = fmaxf(gq, fabsf(p.gqa_q_norm[l * 64 + i])); gk = fmaxf(gk, fabsf(p.gqa_k_norm[l * 64 + i])); }
        for (int i = 0; i < 96; ++i) { mq = fmaxf(mq, fabsf(p.mla_q_norm[l * 96 + i])); mk = fmaxf(mk, fabsf(p.mla_k_norm[l * 96 + i])); }
        const float L2E = 1.4426950408889634f;
        const float sc_g = 0.125f, sc_m = 0.10206207261596575f;
        const float sh_g = (64.f * gq * gk * sc_g * 1.02f + 0.5f) * L2E;
        const float sh_m = (96.f * mq * mk * sc_m * 1.02f + 0.5f) * L2E;
        int* cnt = (int*)(ws + OFF_CNT) + (l * NG + g);
        for (;;) {
          if (threadIdx.x == 0) s_item = atomicAdd(cnt, 1);
          __syncthreads();
          const int it = s_item;
          __syncthreads();
          if (it >= total) break;
          if (it < n_scan) {
            const int sg = it >> 7, bl = (it >> 5) & 3, hd = (it >> 3) & 3, dir = (it >> 2) & 1, rq = it & 3;
            const MixBufs ms = mixbufs(big, sg);
            scan_item(p, l, ms, bl, hd, dir, rq, smem);
          } else if (it < n_scan + n_att + n_gqa) {
            int a = it - n_scan;
            const int kind = a < n_att ? 0 : 1;
            int ag = g;
            if (kind == 1) { a -= n_att; ag = a / n_att; a -= ag * n_att; }
            const int bl = a / (4 * qt_per_b);
            int rem = a - bl * 4 * qt_per_b;
            const int hd = rem / qt_per_b;
            const int qt = rem - hd * qt_per_b;
            const int j0 = qt < 16 ? LC + qt * 256 : 0;
            const int nkeys = qt < 16 ? LT : LC;
            const size_t rl0 = (size_t)bl * LT + j0;
            const size_t rg0 = (size_t)(ag * BG + bl) * LT + j0;
            if (kind == 1) {
              const MixBufs ma = mixbufs(big, ag);
              const int kvh = hd >> 1;
              attn_item<64, 2>(ma.qg + rl0 * 256 + hd * 64, 256, ma.kg + (size_t)bl * LT * 128 + kvh * 64, 128,
                            ma.vtg + (size_t)(bl * 2 + kvh) * 64 * LT, ymix + rg0 * D + 256 + hd * 64, D, nkeys, sc_g * L2E, sh_g, smem);
            } else {
              attn_item<96, 2>(m.qm + rl0 * 384 + hd * 96, 384, m.km + (size_t)bl * LT * 384 + hd * 96, 384,
                            m.vtm + (size_t)(bl * 4 + hd) * 64 * LT, ymix + rg0 * D + 512 + hd * 64, D, nkeys, sc_m * L2E, sh_m, smem);
            }
          } else {
            const int c = it - n_scan - n_att - n_gqa;
            hyena_pass(p, l, m, filt, LQ, LC, c, smem);
            if (!last) hyena_pass(p, l, m, (const float*)(ws + OFF_FILTC), LC, 0, c, smem);
          }
        }
        if (g == NG - 1) {
          int* acnt = (int*)(ws + OFF_CNT) + 16 + l;
          const int n_aux = l == 0 ? AUX_EARLY + AUX_LATE : AUX_LATE;
          for (;;) {
            if (threadIdx.x == 0) s_item = atomicAdd(acnt, 1);
            __syncthreads();
            const int a = s_item;
            __syncthreads();
            if (a >= n_aux) break;
            aux_tile(p, l, a, Wl, smem);
          }
        }
        xcd_barrier(xb);
        readout_hy_phase(g, m, ymix, last, smem);
        if (g == NG - 1) {
          for (int rg = 0; rg < NG; ++rg) {
            const MixBufs mr = mixbufs(big, rg);
            readout_rw_phase(p, l, rg, mr, ymix, last);
          }
          xcd_barrier(xb);
        }
      }
    }
    {
      EpiRes e{p.out, ctxs, p.out, ctxs, modl, 5, 1.0f, nullptr, nullptr, nullptr, 0};
      gemm_phase<false>(hbuf, D, W + W_OUT, D, D, T / 128, 8, 0, last, smem, e);
    }
    xcd_barrier(xb);
    adaln_phase(p.out, ctxs, p.norm_ffn2 + l * D, modl, 2, hbuf, last);
    xcd_barrier(xb);
    {
      EpiGU e{Gbuf};
      gemm_gu_phase(hbuf, W + W_GU2, T / 128, last, smem, e);
    }
    xcd_barrier(xb);
    {
      EpiRes e{p.out, ctxs, p.out, ctxs, modl, 8, 0.5f, nullptr, nullptr, nullptr, 0};
      gemm_phase<false>(Gbuf, DFF, W + W_D2, DFF, DFF, T / 128, 8, 0, last, smem, e);
    }
    xcd_barrier(xb);
  }
}

extern "C" void kernel_launch(void* const* d_in, const int* in_sizes, int n_in, void* d_out, int out_size, void* d_ws,
                              size_t ws_size, hipStream_t stream) {
  static int grid_blocks = 0;
  if (!grid_blocks) {
    int dev = 0, cus = 0, per_cu = 0;
    (void)hipGetDevice(&dev);
    (void)hipDeviceGetAttribute(&cus, hipDeviceAttributeMultiprocessorCount, dev);
    (void)hipOccupancyMaxActiveBlocksPerMultiprocessor(&per_cu, fwd_megakernel, NTHR, 0);
    if (per_cu > 2) per_cu = 2;
    if (per_cu < 1) per_cu = 1;
    grid_blocks = cus * per_cu;
  }
  Params p{};
  const float** pp = (const float**)&p;
  for (int i = 0; i < 47; ++i) pp[i] = (const float*)d_in[i];
  p.out = (float*)d_out;
  p.ws = (char*)d_ws;
  (void)hipMemsetAsync((char*)d_ws + OFF_CNT, 0, 256 + 3456 * 4, stream);
  void* args[] = {&p};
  hipError_t e = hipLaunchCooperativeKernel((void*)fwd_megakernel, dim3(grid_blocks), dim3(NTHR), args, 0, stream);
  if (e != hipSuccess) fprintf(stderr, "cooperative launch failed: %s (grid %d)\n", hipGetErrorString(e), grid_blocks);
}
```

```cpp
#include <hip/hip_runtime.h>
#include <hip/hip_bf16.h>
#include <hip/hip_cooperative_groups.h>
#include <cstdio>
namespace cg = cooperative_groups;

#define DI __device__ __forceinline__
typedef unsigned short u16;
using bf16x8 = __attribute__((ext_vector_type(8))) short;
using f32x16 = __attribute__((ext_vector_type(16))) float;
typedef __bf16 bf16x2_t __attribute__((ext_vector_type(2)));
typedef float f32x2_t __attribute__((ext_vector_type(2)));
#define MFMA32(a, b, c) __builtin_amdgcn_mfma_f32_32x32x16_bf16((a), (b), (c), 0, 0, 0)

constexpr int D = 1024, NB = 8, LQ = 4096, LC = 256, LT = 4352, T = NB * LT, DFF = 2816, DIN = 2848;
constexpr int HYC = 768, DINP = DIN - HYC;
constexpr int NG = 2, BG = NB / NG, TG = BG * LT;
constexpr int NTHR = 256;
#define REP_MIX 1
#define REP_GU 1
#define REP_MISC 1
#define REP_ROW 1
constexpr float EPS = 1e-6f;

constexpr size_t al(size_t x) { return (x + 255) & ~(size_t)255; }
constexpr size_t OFF_CTX = 0;
constexpr size_t OFF_MOD = OFF_CTX + al((size_t)NB * LC * D * 4);
constexpr size_t SZ_FILT_L = (size_t)(2 * LQ - 1) * 256 * 4;
constexpr size_t SZ_FILT_C = (size_t)(2 * LC - 1) * 256 * 4;
constexpr size_t OFF_CNT = OFF_MOD + al((size_t)2 * 9 * 9216 * 4);
constexpr size_t OFF_BAR = OFF_CNT + 256;
constexpr size_t OFF_FILT = OFF_BAR + al((size_t)3456 * 4);
constexpr size_t OFF_FILTC = OFF_FILT + al(SZ_FILT_L);
constexpr size_t OFF_ROPEG = OFF_FILTC + al(SZ_FILT_C);
constexpr size_t OFF_ROPEM = OFF_ROPEG + al((size_t)LQ * 32 * 8);
constexpr size_t OFF_W = OFF_ROPEM + al((size_t)LQ * 16 * 8);
constexpr size_t W_GU1 = 0;
constexpr size_t W_D1 = W_GU1 + (size_t)5632 * 1024;
constexpr size_t W_GU2 = W_D1 + (size_t)1024 * 2816;
constexpr size_t W_D2 = W_GU2 + (size_t)5632 * 1024;
constexpr size_t W_IN = W_D2 + (size_t)1024 * 2816;
constexpr size_t W_OUT = W_IN + (size_t)2944 * 1024;
constexpr size_t W_UQ = W_OUT + (size_t)1024 * 1024;
constexpr size_t W_UKV = W_UQ + (size_t)384 * 256;
constexpr size_t W_W2 = W_UKV + (size_t)512 * 128;
constexpr size_t W_A2 = W_W2 + (size_t)2 * 256 * 64;
constexpr size_t W_G2 = W_A2 + (size_t)2 * 256 * 64;
constexpr size_t W_LAYER = W_G2 + (size_t)256 * 128;
constexpr size_t OFF_H = OFF_W + al(W_LAYER * 2);
constexpr size_t OFF_BIG = OFF_H + al((size_t)T * D * 2);
constexpr size_t M_P = 0;
constexpr size_t M_PT = M_P + al((size_t)TG * DINP * 2);
constexpr size_t M_U = M_PT + al((size_t)HYC * TG * 2);
constexpr size_t M_CQN = M_U + al((size_t)TG * 256 * 2);
constexpr size_t M_CKVN = M_CQN + al((size_t)TG * 256 * 2);
constexpr size_t M_QUP = M_CKVN + al((size_t)TG * 128 * 2);
constexpr size_t M_KVUP = M_QUP + al((size_t)TG * 384 * 2);
constexpr size_t M_QM = M_KVUP + al((size_t)TG * 512 * 2);
constexpr size_t M_KM = M_QM + al((size_t)TG * 384 * 2);
constexpr size_t M_VTM = M_KM + al((size_t)TG * 384 * 2);
constexpr size_t M_LWF = M_VTM + al((size_t)TG * 256 * 2);
constexpr size_t M_LWB = M_LWF + al((size_t)TG * 64 * 2);
constexpr size_t M_LAF = M_LWB + al((size_t)TG * 64 * 2);
constexpr size_t M_LAB = M_LAF + al((size_t)TG * 64 * 2);
constexpr size_t M_LG = M_LAB + al((size_t)TG * 64 * 2);
constexpr size_t SZ_SC = al((size_t)TG * 256 * 2);
constexpr size_t M_SCAN = M_LG + al((size_t)TG * 128 * 2);
constexpr size_t SCAN_STRIDE = 11 * SZ_SC;
constexpr size_t M_END = M_SCAN + 2 * SCAN_STRIDE;
static_assert((size_t)4 * TG * 256 * 4 <= al((size_t)TG * DINP * 2), "yf/yb do not fit the p region");
constexpr size_t SZ_G = (size_t)T * DFF * 2;
constexpr size_t WS_NEED = OFF_BIG + (M_END > SZ_G ? M_END : SZ_G);
static_assert(WS_NEED <= (size_t)512 * 1024 * 1024, "workspace too large");

struct Params {
  const float *x, *c, *ctx, *c_ctx, *ada_w, *ada_b, *norm_ffn1, *norm_mix, *norm_ffn2;
  const float *ffn1_gate, *ffn1_up, *ffn1_down, *ffn2_gate, *ffn2_up, *ffn2_down, *w_in, *w_out;
  const float *hy_conv_w, *hy_conv_b, *hy_f_w1, *hy_f_b1, *hy_f_w2, *hy_f_b2, *hy_f_w3, *hy_f_b3, *hy_f_w4, *hy_f_freq, *hy_bias;
  const float *gqa_q_norm, *gqa_k_norm, *mla_cq_norm, *mla_ckv_norm, *mla_w_uq, *mla_w_ukv, *mla_q_norm, *mla_k_norm;
  const float *rw_mu, *rw_w0, *rw_w2, *rw_a0, *rw_a2, *rw_g2, *rw_k_k, *rw_k_a, *rw_r_k, *rw_ln_w, *rw_ln_b;
  float* out;
  char* ws;
};

DI u16 f2bf(float x) {
  unsigned u = __float_as_uint(x);
  u += 0x7fffu + ((u >> 16) & 1u);
  return (u16)(u >> 16);
}
DI float bf2f(u16 b) { return __uint_as_float(((unsigned)b) << 16); }
DI float bflo_(unsigned w) { return __uint_as_float(w << 16); }
DI float bfhi_(unsigned w) { return __uint_as_float(w & 0xffff0000u); }
DI unsigned pack2(float a, float b) {
  f32x2_t v = {a, b};
  bf16x2_t r = __builtin_convertvector(v, bf16x2_t);
  return __builtin_bit_cast(unsigned, r);
}
DI int ltid() {
  int t = threadIdx.x;
  asm volatile("" : "+v"(t));
  return t;
}
DI float wave_sum(float v) {
#pragma unroll
  for (int o = 32; o > 0; o >>= 1) v += __shfl_xor(v, o);
  return v;
}
DI float wave_max(float v) {
#pragma unroll
  for (int o = 32; o > 0; o >>= 1) v = fmaxf(v, __shfl_xor(v, o));
  return v;
}
DI float sigmoidf_(float x) { return __builtin_amdgcn_rcpf(1.f + __expf(-x)); }
DI int crow(int i, int h) { return (i & 3) + 8 * (i >> 2) + 4 * h; }

DI float rope_apply(float val, int idx, int nfreq, int t, int lane) {
  int pi = idx >> 1;
  int row = t >> 6, col = t & 63;
  float pos = pi < nfreq ? (float)row : (float)col;
  int f = pi < nfreq ? pi : pi - nfreq;
  float inv = exp2f(-(float)f / (float)nfreq * 13.287712379549449f);
  float ang = pos * inv;
  float cs = cosf(ang), sn = sinf(ang);
  float other = __shfl_xor(val, 1);
  return (lane & 1) ? other * sn + val * cs : val * cs - other * sn;
}

DI float rope_tab(float val, int idx, const float2* __restrict__ tab, int lane) {
  const float2 cs = tab[idx >> 1];
  const float other = __shfl_xor(val, 1);
  return (lane & 1) ? other * cs.y + val * cs.x : val * cs.x - other * cs.y;
}
DI void rope_table_phase(float2* __restrict__ tg, float2* __restrict__ tm) {
  const int tid = ltid();
  for (int e = blockIdx.x * NTHR + tid; e < LQ * 48; e += gridDim.x * NTHR) {
    const int t = e / 48, k = e - t * 48;
    const bool isg = k < 32;
    const int pi = isg ? k : k - 32, nfreq = isg ? 16 : 8;
    const int row = t >> 6, col = t & 63;
    const float pos = pi < nfreq ? (float)row : (float)col;
    const int f = pi < nfreq ? pi : pi - nfreq;
    const float inv = exp2f(-(float)f / (float)nfreq * 13.287712379549449f);
    const float ang = pos * inv;
    const float2 v = make_float2(cosf(ang), sinf(ang));
    if (isg) tg[t * 32 + pi] = v; else tm[t * 16 + pi] = v;
  }
}

DI int gu_row(int n, int half) { return (n >> 7) * 256 + ((n >> 6) & 1) * 128 + ((n >> 5) & 1) * 64 + half * 32 + (n & 31); }
DI void convT_tile(const float* __restrict__ src, int K, int N, u16* __restrict__ dst, int mode, int t, char* smem) {
  float* tile = (float*)smem;
  const int tn = (N + 63) / 64;
  const int tid_ = ltid();
  const int j = tid_ & 63, i0 = tid_ >> 6;
  const int k0 = (t / tn) * 64, n0 = (t % tn) * 64;
  for (int i = i0; i < 64; i += 4) {
    int n = n0 + j;
    tile[i * 65 + j] = n < N ? src[(size_t)(k0 + i) * N + n] : 0.f;
  }
  __syncthreads();
  for (int i = i0; i < 64; i += 4) {
    int n = n0 + i;
    if (n < N) {
      int row = mode == 0 ? n : gu_row(n, mode - 1);
      dst[(size_t)row * K + k0 + j] = f2bf(tile[j * 65 + i]);
    }
  }
  __syncthreads();
}
DI void convT(const float* __restrict__ src, int K, int N, u16* __restrict__ dst, int mode, char* smem) {
  const int tk = K / 64, tn = (N + 63) / 64;
  for (int t = blockIdx.x; t < tk * tn; t += gridDim.x) convT_tile(src, K, N, dst, mode, t, smem);
}

DI void mod_phase(const Params& p, float* __restrict__ mod, char* smem) {
  float* sc = (float*)smem;
  float* red = sc + 9 * 1024;
  const int tid_ = ltid();
  for (int i = tid_; i < 9 * 1024; i += NTHR) {
    float v = i < 8192 ? p.c[i] : p.c_ctx[i - 8192];
    sc[i] = v / (1.f + expf(-v));
  }
  __syncthreads();
  const int lane = tid_ & 63, kp = tid_ >> 6;
  for (int it = blockIdx.x; it < 2 * 144; it += gridDim.x) {
    const int l = it / 144, nb = (it % 144) * 64;
    const float* w = p.ada_w + (size_t)l * 1024 * 9216 + nb + lane;
    float acc[9];
#pragma unroll
    for (int b = 0; b < 9; ++b) acc[b] = 0.f;
    for (int k = kp * 256; k < kp * 256 + 256; ++k) {
      float wv = w[(size_t)k * 9216];
#pragma unroll
      for (int b = 0; b < 9; ++b) acc[b] += sc[b * 1024 + k] * wv;
    }
#pragma unroll
    for (int b = 0; b < 9; ++b) red[(kp * 9 + b) * 64 + lane] = acc[b];
    __syncthreads();
    for (int o = tid_; o < 9 * 64; o += NTHR) {
      int b = o >> 6, ln = o & 63;
      float s = red[(0 * 9 + b) * 64 + ln] + red[(1 * 9 + b) * 64 + ln] + red[(2 * 9 + b) * 64 + ln] + red[(3 * 9 + b) * 64 + ln];
      mod[((size_t)l * 9 + b) * 9216 + nb + ln] = s + p.ada_b[l * 9216 + nb + ln];
    }
    __syncthreads();
  }
}

DI void hyfilt_phase(const Params& p, int l, int L, float* __restrict__ gT, char* smem) {
  float* z = (float*)smem;
  float* h1 = z + 64;
  float* h2 = h1 + 64;
  float* h3 = h2 + 64;
  float* w1s = z + 256;
  float* w2s = w1s + 33 * 64;
  float* w3s = w2s + 64 * 64;
  const float* w4 = p.hy_f_w4 + l * 64 * 512;
  const int tid = ltid();
  for (int i = tid; i < 33 * 64; i += NTHR) w1s[i] = p.hy_f_w1[l * 33 * 64 + i];
  for (int i = tid; i < 64 * 64; i += NTHR) { w2s[i] = p.hy_f_w2[l * 4096 + i]; w3s[i] = p.hy_f_w3[l * 4096 + i]; }
  float b1v = 0.f, b2v = 0.f, b3v = 0.f, frv = 0.f;
  if (tid < 64) { b1v = p.hy_f_b1[l * 64 + tid]; b2v = p.hy_f_b2[l * 64 + tid]; b3v = p.hy_f_b3[l * 64 + tid]; frv = p.hy_f_freq[l * 64 + tid]; }
  const float min_decay = logf(1e-2f) / 1.5f, max_decay = logf(1e-2f) / 0.3f;
  const float delta = fabsf(min_decay + (max_decay - min_decay) * (float)tid / 255.f);
  __syncthreads();
  for (int t = blockIdx.x; t < L; t += gridDim.x) {
    const float t01 = (float)t / (float)(L - 1);
    if (tid < 33) {
      float zz;
      if (tid == 0) zz = t01;
      else {
        int i = (tid - 1) & 15;
        float f = 1e-4f + (float)i * ((15.f - 1e-4f) / 15.f);
        float wang = 6.283185307179586f * (float)t / (float)L;
        zz = tid <= 16 ? cosf(f * wang) : -sinf(f * wang);
      }
      z[tid] = zz;
    }
    __syncthreads();
    if (tid < 64) {
      float a = b1v;
#pragma unroll 11
      for (int i = 0; i < 33; ++i) a += z[i] * w1s[i * 64 + tid];
      h1[tid] = sinf(frv * a);
    }
    __syncthreads();
    if (tid < 64) {
      float a = b2v;
#pragma unroll 16
      for (int i = 0; i < 64; ++i) a += h1[i] * w2s[i * 64 + tid];
      h2[tid] = sinf(frv * a);
    }
    __syncthreads();
    if (tid < 64) {
      float a = b3v;
#pragma unroll 16
      for (int i = 0; i < 64; ++i) a += h2[i] * w3s[i * 64 + tid];
      h3[tid] = sinf(frv * a);
    }
    __syncthreads();
    float af = 0.f, ab = 0.f;
#pragma unroll 8
    for (int i = 0; i < 64; ++i) {
      af += h3[i] * w4[i * 512 + tid];
      ab += h3[i] * w4[i * 512 + 256 + tid];
    }
    const float dec = expf(-t01 * delta);
    af *= dec;
    ab *= dec;
    if (t == 0) gT[(size_t)(L - 1) * 256 + tid] = af + ab;
    else {
      gT[(size_t)(L - 1 + t) * 256 + tid] = af;
      gT[(size_t)(L - 1 - t) * 256 + tid] = ab;
    }
    __syncthreads();
  }
  __syncthreads();
}

DI void adaln_phase(const float* __restrict__ lat, const float* __restrict__ ctxp, const float* __restrict__ gain,
                    const float* __restrict__ modl, int idx, u16* __restrict__ h, bool skip_ctx) {
  const int tid_ = ltid();
  const int wave = tid_ >> 6, lane = tid_ & 63;
  for (int r = blockIdx.x * 4 + wave; r < T; r += gridDim.x * 4) {
    const int b = r / LT, j = r - b * LT;
    if (skip_ctx && j < LC) continue;
    const float* xr = j < LC ? ctxp + ((size_t)(b * LC + j) << 10) : lat + ((size_t)(b * LQ + j - LC) << 10);
    const int bb = j < LC ? 8 : b;
    const float* shift = modl + bb * 9216 + (3 * idx) * 1024;
    const float* scale = shift + 1024;
    float4 v[4];
    float ss = 0.f;
#pragma unroll
    for (int q = 0; q < 4; ++q) {
      v[q] = *(const float4*)(xr + q * 256 + lane * 4);
      ss += v[q].x * v[q].x + v[q].y * v[q].y + v[q].z * v[q].z + v[q].w * v[q].w;
    }
    ss = wave_sum(ss);
    const float rstd = rsqrtf(ss * (1.f / 1024.f) + EPS);
#pragma unroll
    for (int q = 0; q < 4; ++q) {
      const int c = q * 256 + lane * 4;
      float4 g = *(const float4*)(gain + c), sc = *(const float4*)(scale + c), sh = *(const float4*)(shift + c);
      float y0 = v[q].x * rstd * g.x * (1.f + sc.x) + sh.x;
      float y1 = v[q].y * rstd * g.y * (1.f + sc.y) + sh.y;
      float y2 = v[q].z * rstd * g.z * (1.f + sc.z) + sh.z;
      float y3 = v[q].w * rstd * g.w * (1.f + sc.w) + sh.w;
      uint2 o;
      o.x = pack2(y0, y1);
      o.y = pack2(y2, y3);
      *(uint2*)(h + (size_t)r * D + c) = o;
    }
  }
}

DI bool gemm_decode(int t, int mtiles, int ntiles, int mt_off, bool skip_ctx, int& mt, int& nt) {
  const int mtx = mtiles >> 3;
  const int xcd = t & 7, q = t >> 3;
  const int sr = q / (8 * ntiles);
  const int rem = q - sr * 8 * ntiles;
  const int rows_in = min(8, mtx - sr * 8);
  const int sc = rem / (rows_in * 8);
  const int r2 = rem - sc * rows_in * 8;
  const int i = r2 % rows_in, j = r2 / rows_in;
  mt = (sr * 8 + i) * 8 + xcd;
  nt = sc * 8 + j;
  return !(skip_ctx && ((mt + mt_off) % 34) < 2);
}
template <bool PAIRED, class Epi>
DI void gemm_phase(const u16* __restrict__ A, int lda, const u16* __restrict__ Bt, int ldb, int K, int mtiles, int ntiles,
                   int mt_off, bool skip_ctx, char* smem, Epi& epi) {
  u16* As = (u16*)smem;
  u16* Bs = As + 2 * 128 * 72;
  const int tid = ltid(), lane = tid & 63, wave = tid >> 6;
  const int wm = wave >> 1, wn = wave & 1, lr = lane & 31, lh = lane >> 5;
  const int lrow = tid >> 3, lkc = (tid & 7) * 8;
  const int total = mtiles * ntiles, nk = K >> 6;
  uint4 ra00, ra01, ra02, ra03, rb00, rb01, rb02, rb03, ra10, ra11, ra12, ra13, rb10, rb11, rb12, rb13;
  const u16* Agl;
  const u16* Bgl;
#define GEMM_GLOAD(S, kt_)                                            \
  {                                                                   \
    const int k0_ = (kt_) << 6;                                       \
    ra##S##0 = *(const uint4*)(Agl + k0_);                            \
    ra##S##1 = *(const uint4*)(Agl + (size_t)32 * lda + k0_);         \
    ra##S##2 = *(const uint4*)(Agl + (size_t)64 * lda + k0_);         \
    ra##S##3 = *(const uint4*)(Agl + (size_t)96 * lda + k0_);         \
    rb##S##0 = *(const uint4*)(Bgl + k0_);                            \
    rb##S##1 = *(const uint4*)(Bgl + (size_t)32 * ldb + k0_);         \
    rb##S##2 = *(const uint4*)(Bgl + (size_t)64 * ldb + k0_);         \
    rb##S##3 = *(const uint4*)(Bgl + (size_t)96 * ldb + k0_);         \
  }
#define GEMM_LSTORE(S, buf_)                                          \
  {                                                                   \
    u16* ad_ = As + (buf_) * 128 * 72 + lrow * 72 + lkc;              \
    u16* bd_ = Bs + (buf_) * 128 * 72 + lrow * 72 + lkc;              \
    *(uint4*)(ad_) = ra##S##0;                                        \
    *(uint4*)(ad_ + 32 * 72) = ra##S##1;                              \
    *(uint4*)(ad_ + 64 * 72) = ra##S##2;                              \
    *(uint4*)(ad_ + 96 * 72) = ra##S##3;                              \
    *(uint4*)(bd_) = rb##S##0;                                        \
    *(uint4*)(bd_ + 32 * 72) = rb##S##1;                              \
    *(uint4*)(bd_ + 64 * 72) = rb##S##2;                              \
    *(uint4*)(bd_ + 96 * 72) = rb##S##3;                              \
  }
#define GEMM_COMPUTE(buf_)                                                        \
  {                                                                               \
    const u16* as = As + (buf_) * 128 * 72 + (wm * 64 + lr) * 72 + lh * 8;        \
    const u16* bs = Bs + (buf_) * 128 * 72 + (wn * 64 + lr) * 72 + lh * 8;        \
    _Pragma("unroll") for (int ks = 0; ks < 4; ++ks) {                            \
      bf16x8 a0 = *(const bf16x8*)(as + ks * 16);                                 \
      bf16x8 a1 = *(const bf16x8*)(as + 32 * 72 + ks * 16);                       \
      bf16x8 b0 = *(const bf16x8*)(bs + ks * 16);                                 \
      bf16x8 b1 = *(const bf16x8*)(bs + 32 * 72 + ks * 16);                       \
      acc[0][0] = MFMA32(a0, b0, acc[0][0]);                                      \
      acc[0][1] = MFMA32(a0, b1, acc[0][1]);                                      \
      acc[1][0] = MFMA32(a1, b0, acc[1][0]);                                      \
      acc[1][1] = MFMA32(a1, b1, acc[1][1]);                                      \
    }                                                                             \
  }
  int t = blockIdx.x, mt = 0, nt = 0;
  while (t < total && !gemm_decode(t, mtiles, ntiles, mt_off, skip_ctx, mt, nt)) t += gridDim.x;
  if (t < total) {
    Agl = A + (size_t)(mt * 128 + lrow) * lda + lkc;
    Bgl = Bt + (size_t)(nt * 128 + lrow) * ldb + lkc;
    GEMM_GLOAD(0, 0);
  }
  while (t < total) {
    const int m0 = mt * 128, n0 = nt * 128;
    int tn = t + gridDim.x, mtn = 0, ntn = 0;
    while (tn < total && !gemm_decode(tn, mtiles, ntiles, mt_off, skip_ctx, mtn, ntn)) tn += gridDim.x;
    f32x16 acc[2][2];
#pragma unroll
    for (int a = 0; a < 2; ++a)
#pragma unroll
      for (int b = 0; b < 2; ++b)
#pragma unroll
        for (int i = 0; i < 16; ++i) acc[a][b][i] = 0.f;
    GEMM_LSTORE(0, 0);
    __syncthreads();
    if (nk > 1) GEMM_GLOAD(0, 1);
    for (int kt = 0; kt < nk; kt += 2) {
      if (kt + 2 < nk) GEMM_GLOAD(1, kt + 2);
      GEMM_COMPUTE(0);
      if (kt + 1 < nk) GEMM_LSTORE(0, 1);
      __syncthreads();
      if (kt + 1 >= nk) break;
      if (kt + 3 < nk) GEMM_GLOAD(0, kt + 3);
      GEMM_COMPUTE(1);
      if (kt + 2 < nk) GEMM_LSTORE(1, 0);
      __syncthreads();
    }
    if (tn < total) {
      Agl = A + (size_t)(mtn * 128 + lrow) * lda + lkc;
      Bgl = Bt + (size_t)(ntn * 128 + lrow) * ldb + lkc;
      GEMM_GLOAD(0, 0);
    }
    epi.tile(m0);
    if constexpr (PAIRED) {
      float* stg = (float*)smem + wave * 64 * 36;
#pragma unroll
      for (int mi = 0; mi < 2; ++mi)
#pragma unroll
        for (int i = 0; i < 16; ++i) stg[(mi * 32 + crow(i, lh)) * 36 + lr] = epi.combine(acc[mi][0][i], acc[mi][1][i]);
      __syncthreads();
#pragma unroll
      for (int k = 0; k < 8; ++k) {
        const int idx = lane + 64 * k, row = idx >> 3, c4 = idx & 7;
        const float4 v = *(const float4*)(stg + row * 36 + c4 * 4);
        epi.store4(m0 + wm * 64 + row, (n0 >> 1) + wn * 32 + c4 * 4, v);
      }
      __syncthreads();
    } else if constexpr (Epi::kStaged) {
      float* stg = (float*)smem + wave * 64 * 68;
#pragma unroll
      for (int mi = 0; mi < 2; ++mi)
#pragma unroll
        for (int ni = 0; ni < 2; ++ni)
#pragma unroll
          for (int i = 0; i < 16; ++i) stg[(mi * 32 + crow(i, lh)) * 68 + ni * 32 + lr] = acc[mi][ni][i];
      __syncthreads();
#pragma unroll 4
      for (int k = 0; k < 16; ++k) {
        const int idx = lane + 64 * k, row = idx >> 4, c4 = idx & 15;
        const float4 v = *(const float4*)(stg + row * 68 + c4 * 4);
        epi.row4(m0 + wm * 64 + row, n0 + wn * 64 + c4 * 4, v);
      }
      __syncthreads();
    } else {
#pragma unroll
      for (int mi = 0; mi < 2; ++mi) {
#pragma unroll
        for (int gq = 0; gq < 4; ++gq) {
          const int row0 = m0 + wm * 64 + mi * 32 + 8 * gq + 4 * lh;
          if (PAIRED) {
            const int col = (n0 >> 1) + wn * 32 + lr;
#pragma unroll
            for (int e = 0; e < 4; ++e) epi.pair(row0 + e, col, acc[mi][0][4 * gq + e], acc[mi][1][4 * gq + e]);
          } else {
            epi.quad(row0, n0 + wn * 64 + lr, acc[mi][0][4 * gq], acc[mi][0][4 * gq + 1], acc[mi][0][4 * gq + 2], acc[mi][0][4 * gq + 3]);
            epi.quad(row0, n0 + wn * 64 + 32 + lr, acc[mi][1][4 * gq], acc[mi][1][4 * gq + 1], acc[mi][1][4 * gq + 2], acc[mi][1][4 * gq + 3]);
          }
        }
      }
    }
    t = tn; mt = mtn; nt = ntn;
  }
}

template <class Epi>
DI void gemm_gu_phase(const u16* __restrict__ A, const u16* __restrict__ Bt, int mtiles, bool skip_ctx, char* smem, Epi& epi) {
  constexpr int lda = D, ldb = D, K = D, ntiles = 22, RS = 40;
  u16* As = (u16*)smem;
  u16* Bs = As + 2 * 128 * RS;
  const int tid = ltid(), lane = tid & 63, wave = tid >> 6;
  const int wm = wave >> 1, wn = wave & 1, lr = lane & 31, lh = lane >> 5;
  const int lrow = tid >> 2, lkc = (tid & 3) * 8;
  const int total = mtiles * ntiles, nk = K >> 5;
  uint4 ra00, ra01, rb00, rb01, rb02, rb03, ra10, ra11, rb10, rb11, rb12, rb13;
  const u16* Agl;
  const u16* Bgl;
#define GU_GLOAD(S, kt_)                                              \
  {                                                                   \
    const int k0_ = (kt_) << 5;                                       \
    ra##S##0 = *(const uint4*)(Agl + k0_);                            \
    ra##S##1 = *(const uint4*)(Agl + (size_t)64 * lda + k0_);         \
    rb##S##0 = *(const uint4*)(Bgl + k0_);                            \
    rb##S##1 = *(const uint4*)(Bgl + (size_t)64 * ldb + k0_);         \
    rb##S##2 = *(const uint4*)(Bgl + (size_t)128 * ldb + k0_);        \
    rb##S##3 = *(const uint4*)(Bgl + (size_t)192 * ldb + k0_);        \
  }
#define GU_LSTORE(S, buf_)                                            \
  {                                                                   \
    u16* ad_ = As + (buf_) * 128 * RS + lrow * RS + lkc;              \
    u16* bd_ = Bs + (buf_) * 256 * RS + lrow * RS + lkc;              \
    *(uint4*)(ad_) = ra##S##0;                                        \
    *(uint4*)(ad_ + 64 * RS) = ra##S##1;                              \
    *(uint4*)(bd_) = rb##S##0;                                        \
    *(uint4*)(bd_ + 64 * RS) = rb##S##1;                              \
    *(uint4*)(bd_ + 128 * RS) = rb##S##2;                             \
    *(uint4*)(bd_ + 192 * RS) = rb##S##3;                             \
  }
#define GU_COMPUTE(buf_)                                                          \
  {                                                                               \
    const u16* as = As + (buf_) * 128 * RS + (wm * 64 + lr) * RS + lh * 8;        \
    const u16* bs = Bs + (buf_) * 256 * RS + (wn * 128 + lr) * RS + lh * 8;       \
    _Pragma("unroll") for (int ks = 0; ks < 2; ++ks) {                            \
      bf16x8 a0 = *(const bf16x8*)(as + ks * 16);                                 \
      bf16x8 a1 = *(const bf16x8*)(as + 32 * RS + ks * 16);                       \
      bf16x8 b0 = *(const bf16x8*)(bs + ks * 16);                                 \
      bf16x8 b1 = *(const bf16x8*)(bs + 32 * RS + ks * 16);                       \
      bf16x8 b2 = *(const bf16x8*)(bs + 64 * RS + ks * 16);                       \
      bf16x8 b3 = *(const bf16x8*)(bs + 96 * RS + ks * 16);                       \
      acc[0][0] = MFMA32(a0, b0, acc[0][0]);                                      \
      acc[0][1] = MFMA32(a0, b1, acc[0][1]);                                      \
      acc[0][2] = MFMA32(a0, b2, acc[0][2]);                                      \
      acc[0][3] = MFMA32(a0, b3, acc[0][3]);                                      \
      acc[1][0] = MFMA32(a1, b0, acc[1][0]);                                      \
      acc[1][1] = MFMA32(a1, b1, acc[1][1]);                                      \
      acc[1][2] = MFMA32(a1, b2, acc[1][2]);                                      \
      acc[1][3] = MFMA32(a1, b3, acc[1][3]);                                      \
    }                                                                             \
  }
  int t = blockIdx.x, mt = 0, nt = 0;
  while (t < total && !gemm_decode(t, mtiles, ntiles, 0, skip_ctx, mt, nt)) t += gridDim.x;
  if (t < total) {
    Agl = A + (size_t)(mt * 128 + lrow) * lda + lkc;
    Bgl = Bt + (size_t)(nt * 256 + lrow) * ldb + lkc;
    GU_GLOAD(0, 0);
  }
  while (t < total) {
    const int m0 = mt * 128, n0 = nt * 256;
    int tn = t + gridDim.x, mtn = 0, ntn = 0;
    while (tn < total && !gemm_decode(tn, mtiles, ntiles, 0, skip_ctx, mtn, ntn)) tn += gridDim.x;
    f32x16 acc[2][4];
#pragma unroll
    for (int a = 0; a < 2; ++a)
#pragma unroll
      for (int b = 0; b < 4; ++b)
#pragma unroll
        for (int i = 0; i < 16; ++i) acc[a][b][i] = 0.f;
    GU_LSTORE(0, 0);
    __syncthreads();
    GU_GLOAD(0, 1);
    for (int kt = 0; kt < nk; kt += 2) {
      if (kt + 2 < nk) GU_GLOAD(1, kt + 2);
      GU_COMPUTE(0);
      GU_LSTORE(0, 1);
      __syncthreads();
      if (kt + 3 < nk) GU_GLOAD(0, kt + 3);
      GU_COMPUTE(1);
      if (kt + 2 < nk) GU_LSTORE(1, 0);
      __syncthreads();
    }
    if (tn < total) {
      Agl = A + (size_t)(mtn * 128 + lrow) * lda + lkc;
      Bgl = Bt + (size_t)(ntn * 256 + lrow) * ldb + lkc;
      GU_GLOAD(0, 0);
    }
    {
      float* stg = (float*)smem + wave * 64 * 68;
#pragma unroll
      for (int mi = 0; mi < 2; ++mi)
#pragma unroll
        for (int pi = 0; pi < 2; ++pi)
#pragma unroll
          for (int i = 0; i < 16; ++i)
            stg[(mi * 32 + crow(i, lh)) * 68 + pi * 32 + lr] = epi.combine(acc[mi][2 * pi][i], acc[mi][2 * pi + 1][i]);
      __syncthreads();
#pragma unroll 4
      for (int k = 0; k < 16; ++k) {
        const int idx = lane + 64 * k, row = idx >> 4, c4 = idx & 15;
        const float4 v = *(const float4*)(stg + row * 68 + c4 * 4);
        epi.store4(m0 + wm * 64 + row, (n0 >> 1) + wn * 64 + c4 * 4, v);
      }
      __syncthreads();
    }
    t = tn; mt = mtn; nt = ntn;
  }
}

#define EPI_DEFAULT_QUAD                                                   \
  static constexpr bool kStaged = false;                                   \
  DI void row4(int, int, float4) const {}                                  \
  DI void tile(int) {}                                                     \
  DI void quad(int row0, int col, float a, float b, float c, float d) const { \
    (*this)(row0, col, a);                                                 \
    (*this)(row0 + 1, col, b);                                             \
    (*this)(row0 + 2, col, c);                                             \
    (*this)(row0 + 3, col, d);                                             \
  }
struct EpiGU {
  u16* G;
  DI float combine(float g, float u) const { return g * __builtin_amdgcn_rcpf(1.f + __expf(-g)) * u; }
  DI void store4(int row, int col, float4 v) const {
    uint2 w;
    w.x = pack2(v.x, v.y);
    w.y = pack2(v.z, v.w);
    *(uint2*)(G + (size_t)row * DFF + col) = w;
  }
  DI void pair(int row, int col, float g, float u) const {
    float s = g / (1.f + __expf(-g));
    G[(size_t)row * DFF + col] = f2bf(s * u);
  }
  DI void operator()(int, int, float) const {}
  EPI_DEFAULT_QUAD
};
struct EpiRes {
  const float* lat_in; const float* ctx_in; float* lat_out; float* ctx_out; const float* modl; int gate_chunk; float coef;
  const float* tin; float* tout; const float* gate; int tm0;
  static constexpr bool kStaged = true;
  DI void row4(int row, int col, float4 v) const {
    const size_t o = ((size_t)(row - tm0) << 10) + col;
    const float4 x = *(const float4*)(tin + o);
    const float4 g = *(const float4*)(gate + col);
    float4 y;
    y.x = x.x + coef * g.x * v.x;
    y.y = x.y + coef * g.y * v.y;
    y.z = x.z + coef * g.z * v.z;
    y.w = x.w + coef * g.w * v.w;
    *(float4*)(tout + o) = y;
  }
  DI void tile(int m0) {
    const int b = m0 / LT, j = m0 - b * LT;
    const bool isc = j < LC;
    const size_t off = isc ? (((size_t)(b * LC + j)) << 10) : (((size_t)(b * LQ + j - LC)) << 10);
    tin = (isc ? ctx_in : lat_in) + off;
    tout = (isc ? ctx_out : lat_out) + off;
    gate = modl + (isc ? 8 : b) * 9216 + gate_chunk * 1024;
    tm0 = m0;
  }
  DI void operator()(int row, int col, float v) const {
    const size_t o = ((size_t)(row - tm0) << 10) + col;
    tout[o] = tin[o] + coef * gate[col] * v;
  }
  DI void pair(int, int, float, float) const {}
  DI void quad(int row0, int col, float a, float b, float c, float d) const {
    const float gc = coef * gate[col];
    const size_t o = ((size_t)(row0 - tm0) << 10) + col;
    tout[o] = tin[o] + gc * a;
    tout[o + 1024] = tin[o + 1024] + gc * b;
    tout[o + 2048] = tin[o + 2048] + gc * c;
    tout[o + 3072] = tin[o + 3072] + gc * d;
  }
};
struct EpiStore {
  u16* C; int ldc; int N;
  DI void operator()(int row, int col, float v) const { if (col < N) C[(size_t)row * ldc + col] = f2bf(v); }
  DI void pair(int, int, float, float) const {}
  EPI_DEFAULT_QUAD
};
struct EpiWin {
  u16* p; u16* pT;
  static constexpr bool kStaged = false;
  DI void row4(int, int, float4) const {}
  DI void tile(int) {}
  DI void quad(int row0, int col, float a, float b, float c, float d) const {
    if (col < HYC) {
      uint2 w;
      w.x = pack2(a, b);
      w.y = pack2(c, d);
      *(uint2*)(pT + (size_t)col * TG + row0) = w;
    } else if (col < DIN) {
      u16* q = p + (size_t)row0 * DINP + (col - HYC);
      q[0] = f2bf(a);
      q[DINP] = f2bf(b);
      q[2 * DINP] = f2bf(c);
      q[3 * DINP] = f2bf(d);
    }
  }
  DI void pair(int, int, float, float) const {}
};
struct EpiLoraW {
  u16* C; const float* w0;
  DI void operator()(int row, int col, float v) const {
    float zz = -(w0[col] + v);
    float sp = fmaxf(zz, 0.f) + log1pf(expf(-fabsf(zz)));
    C[(size_t)row * 256 + col] = f2bf(-expm1f(-expf(-sp - 0.5f)));
  }
  DI void pair(int, int, float, float) const {}
  EPI_DEFAULT_QUAD
};
struct EpiLoraA {
  u16* C; const float* a0;
  DI void operator()(int row, int col, float v) const { C[(size_t)row * 256 + col] = f2bf(sigmoidf_(a0[col] + v)); }
  DI void pair(int, int, float, float) const {}
  EPI_DEFAULT_QUAD
};

struct MixBufs {
  u16 *p, *pt, *u, *qg, *kg, *vtg, *cqn, *ckvn, *qup, *kvup, *qm, *km, *vtm, *rr, *rk, *rv, *rkk, *lwf, *lwb, *laf, *lab, *lg, *ef, *eb, *af, *ab, *gg;
  float *yf, *yb;
};
DI MixBufs mixbufs(char* big, int g) {
  MixBufs m;
  m.p = (u16*)(big + M_P); m.pt = (u16*)(big + M_PT); m.u = (u16*)(big + M_U);
  m.cqn = (u16*)(big + M_CQN); m.ckvn = (u16*)(big + M_CKVN); m.qup = (u16*)(big + M_QUP);
  m.kvup = (u16*)(big + M_KVUP); m.qm = (u16*)(big + M_QM); m.km = (u16*)(big + M_KM); m.vtm = (u16*)(big + M_VTM);
  m.lwf = (u16*)(big + M_LWF); m.lwb = (u16*)(big + M_LWB); m.laf = (u16*)(big + M_LAF); m.lab = (u16*)(big + M_LAB);
  m.lg = (u16*)(big + M_LG);
  char* sc = big + M_SCAN + (size_t)g * SCAN_STRIDE;
  m.rr = (u16*)(sc + 0 * SZ_SC); m.rk = (u16*)(sc + 1 * SZ_SC); m.rv = (u16*)(sc + 2 * SZ_SC); m.rkk = (u16*)(sc + 3 * SZ_SC);
  m.ef = (u16*)(sc + 4 * SZ_SC); m.eb = (u16*)(sc + 5 * SZ_SC); m.af = (u16*)(sc + 6 * SZ_SC); m.ab = (u16*)(sc + 7 * SZ_SC);
  m.gg = (u16*)(sc + 8 * SZ_SC);
  m.qg = (u16*)(sc + 9 * SZ_SC); m.kg = (u16*)(sc + 10 * SZ_SC); m.vtg = m.kg + (size_t)TG * 128;
  m.yf = (float*)(big + M_P) + (size_t)g * 2 * TG * 256;
  m.yb = m.yf + (size_t)TG * 256;
  return m;
}

DI void prep_phase(const Params& p, int l, int g, const MixBufs& m, const float2* __restrict__ ropeg, char* smem) {
  const int tid = ltid(), lane = tid & 63, wave = tid >> 6;
  float muv[18];
#pragma unroll
  for (int q = 0; q < 18; ++q) {
    const int crel = q < 12 ? (q % 3) * 256 + (q / 3) * 64 + lane : 768 + (q - 12) * 64 + lane;
    muv[q] = p.rw_mu[l * 1152 + crel];
  }
  float kkw[4], cqg[4], ckg[2];
#pragma unroll
  for (int hd = 0; hd < 4; ++hd) kkw[hd] = p.rw_k_k[l * 256 + hd * 64 + lane];
#pragma unroll
  for (int q = 0; q < 4; ++q) cqg[q] = p.mla_cq_norm[l * 256 + lane + 64 * q];
#pragma unroll
  for (int q = 0; q < 2; ++q) ckg[q] = p.mla_ckv_norm[l * 128 + lane + 64 * q];
  const float gq_ = p.gqa_q_norm[l * 64 + lane], gk_ = p.gqa_k_norm[l * 64 + lane];
  for (int rl = blockIdx.x * 4 + wave; rl < TG; rl += gridDim.x * 4) {
    const int r = g * TG + rl;
    const int b = r / LT, j = r - b * LT, bl = b - g * BG;
    const bool lat = j >= LC;
    const bool hp = lat ? (j > LC) : (j > 0);
    const bool hn = lat ? (j < LT - 1) : (j < LC - 1);
    const u16* pc = m.p + (size_t)rl * DINP;
    const u16* pp = hp ? pc - DINP : pc;
    const u16* pn = hn ? pc + DINP : pc;
    float ts[18];
#pragma unroll
    for (int q = 0; q < 18; ++q) {
      const int crel = q < 12 ? (q % 3) * 256 + (q / 3) * 64 + lane : 768 + (q - 12) * 64 + lane;
      const int c = 1696 - HYC + crel;
      const float u0 = bf2f(pc[c]);
      const float up = bf2f(pp[c]), un = bf2f(pn[c]);
      const float nb = (hp ? up : 0.f) + (hn ? un : 0.f);
      ts[q] = u0 + muv[q] * (0.5f * nb - u0);
    }
    float cq[4], ckv[2], gv[6];
    u16 vraw[2];
#pragma unroll
    for (int q = 0; q < 4; ++q) cq[q] = bf2f(pc[1280 - HYC + lane + 64 * q]);
#pragma unroll
    for (int q = 0; q < 2; ++q) ckv[q] = bf2f(pc[1536 - HYC + lane + 64 * q]);
#pragma unroll
    for (int hh = 0; hh < 6; ++hh) gv[hh] = bf2f(pc[hh * 64 + lane]);
#pragma unroll
    for (int kvh = 0; kvh < 2; ++kvh) vraw[kvh] = pc[1152 - HYC + kvh * 64 + lane];
    const float2 cs = ropeg[(size_t)(lat ? j - LC : 0) * 32 + (lane >> 1)];
#pragma unroll
    for (int hd = 0; hd < 4; ++hd) {
      const int c = hd * 64 + lane;
      const float sr = ts[hd * 3 + 0], sk = ts[hd * 3 + 1], sv = ts[hd * 3 + 2];
      m.rr[(size_t)rl * 256 + c] = f2bf(sr);
      m.rk[(size_t)rl * 256 + c] = f2bf(sk);
      m.rv[(size_t)rl * 256 + c] = f2bf(sv);
      const float kx = sk * kkw[hd];
      const float ss = wave_sum(kx * kx);
      m.rkk[(size_t)rl * 256 + c] = f2bf(kx / fmaxf(sqrtf(ss), 1e-12f));
    }
    m.lwf[(size_t)rl * 64 + lane] = f2bf(tanhf(ts[12]));
    m.lwb[(size_t)rl * 64 + lane] = f2bf(tanhf(ts[13]));
    m.laf[(size_t)rl * 64 + lane] = f2bf(ts[14]);
    m.lab[(size_t)rl * 64 + lane] = f2bf(ts[15]);
    m.lg[(size_t)rl * 128 + lane] = f2bf(sigmoidf_(ts[16]));
    m.lg[(size_t)rl * 128 + 64 + lane] = f2bf(sigmoidf_(ts[17]));
    {
      float s1 = 0.f, s2 = 0.f;
#pragma unroll
      for (int q = 0; q < 4; ++q) s1 += cq[q] * cq[q];
#pragma unroll
      for (int q = 0; q < 2; ++q) s2 += ckv[q] * ckv[q];
      s1 = wave_sum(s1);
      s2 = wave_sum(s2);
      const float r1 = rsqrtf(s1 * (1.f / 256.f) + EPS), r2 = rsqrtf(s2 * (1.f / 128.f) + EPS);
#pragma unroll
      for (int q = 0; q < 4; ++q) m.cqn[(size_t)rl * 256 + lane + 64 * q] = f2bf(cq[q] * r1 * cqg[q]);
#pragma unroll
      for (int q = 0; q < 2; ++q) m.ckvn[(size_t)rl * 128 + lane + 64 * q] = f2bf(ckv[q] * r2 * ckg[q]);
    }
#pragma unroll
    for (int hh = 0; hh < 6; ++hh) {
      float val = gv[hh];
      const float ss = wave_sum(val * val);
      val = val * rsqrtf(ss * (1.f / 64.f) + EPS) * (hh < 4 ? gq_ : gk_);
      const float other = __shfl_xor(val, 1);
      if (lat) val = (lane & 1) ? other * cs.y + val * cs.x : val * cs.x - other * cs.y;
      if (hh < 4) m.qg[(size_t)rl * 256 + hh * 64 + lane] = f2bf(val);
      else m.kg[(size_t)rl * 128 + (hh - 4) * 64 + lane] = f2bf(val);
    }
#pragma unroll
    for (int kvh = 0; kvh < 2; ++kvh) m.vtg[((size_t)(bl * 2 + kvh) * 64 + lane) * LT + j] = vraw[kvh];
  }
}

DI void mla_fin_phase(const Params& p, int l, int g, const MixBufs& m, const float2* __restrict__ ropem) {
  const int tid = ltid(), lane = tid & 63, wave = tid >> 6;
  const float qn0 = p.mla_q_norm[l * 96 + lane], kn0 = p.mla_k_norm[l * 96 + lane];
  const float qn1 = lane < 32 ? p.mla_q_norm[l * 96 + 64 + lane] : 0.f;
  const float kn1 = lane < 32 ? p.mla_k_norm[l * 96 + 64 + lane] : 0.f;
#pragma unroll 2
  for (int rl = blockIdx.x * 4 + wave; rl < TG; rl += gridDim.x * 4) {
    const int r = g * TG + rl;
    const int b = r / LT, j = r - b * LT, bl = b - g * BG;
    const bool lat = j >= LC;
    const u16* qrow = m.qup + (size_t)rl * 384;
    const u16* kvrow = m.kvup + (size_t)rl * 512;
    float q0[4], q1[4], k0[4];
    u16 vraw[4];
    const float kr = lane < 32 ? bf2f(m.p[(size_t)rl * DINP + 1664 - HYC + lane]) : 0.f;
    const float2 cs = ropem[(size_t)(lat ? j - LC : 0) * 16 + ((lane & 31) >> 1)];
#pragma unroll
    for (int hd = 0; hd < 4; ++hd) {
      q0[hd] = bf2f(qrow[hd * 96 + lane]);
      q1[hd] = lane < 32 ? bf2f(qrow[hd * 96 + 64 + lane]) : 0.f;
      k0[hd] = bf2f(kvrow[hd * 128 + lane]);
      vraw[hd] = kvrow[hd * 128 + 64 + lane];
    }
#pragma unroll
    for (int hd = 0; hd < 4; ++hd) {
      const float sq = wave_sum(q0[hd] * q0[hd] + q1[hd] * q1[hd]);
      const float sk = wave_sum(k0[hd] * k0[hd] + kr * kr);
      const float rq = rsqrtf(sq * (1.f / 96.f) + EPS), rk = rsqrtf(sk * (1.f / 96.f) + EPS);
      const float yq0 = q0[hd] * rq * qn0, yk0 = k0[hd] * rk * kn0;
      float yq1 = q1[hd] * rq * qn1, yk1 = kr * rk * kn1;
      const float oq = __shfl_xor(yq1, 1), ok = __shfl_xor(yk1, 1);
      if (lat) {
        yq1 = (lane & 1) ? oq * cs.y + yq1 * cs.x : yq1 * cs.x - oq * cs.y;
        yk1 = (lane & 1) ? ok * cs.y + yk1 * cs.x : yk1 * cs.x - ok * cs.y;
      }
      u16* dq = m.qm + (size_t)rl * 384 + hd * 96;
      u16* dk = m.km + (size_t)rl * 384 + hd * 96;
      dq[lane] = f2bf(yq0);
      dk[lane] = f2bf(yk0);
      if (lane < 32) {
        dq[64 + lane] = f2bf(yq1);
        dk[64 + lane] = f2bf(yk1);
      }
      m.vtm[((size_t)(bl * 4 + hd) * 64 + lane) * LT + j] = vraw[hd];
    }
  }
}

template <int DQK, int QT>
DI void attn_item(const u16* __restrict__ q, int ldq, const u16* __restrict__ k, int ldk, const u16* __restrict__ vT,
                  u16* __restrict__ out, int ldo, int nkeys, float sl2, float sh2, char* smem) {
  constexpr int KS = DQK + 8;
  constexpr int NKS = DQK / 16;
  constexpr int KCH = DQK / 8;
  constexpr int KPT = 64 * KCH / NTHR;
  u16* Ks = (u16*)smem;
  u16* Vs = Ks + 2 * 64 * KS;
  const int tid = ltid(), lane = tid & 63, wave = tid >> 6, lr = lane & 31, lh = lane >> 5;
  bf16x8 qf[QT][NKS];
#pragma unroll
  for (int qt = 0; qt < QT; ++qt)
#pragma unroll
    for (int ks = 0; ks < NKS; ++ks)
      qf[qt][ks] = *(const bf16x8*)(q + (size_t)(wave * 32 * QT + qt * 32 + lr) * ldq + ks * 16 + lh * 8);
  f32x16 o[QT][2];
#pragma unroll
  for (int a = 0; a < QT; ++a)
#pragma unroll
    for (int b = 0; b < 2; ++b)
#pragma unroll
      for (int i = 0; i < 16; ++i) o[a][b][i] = 0.f;
  float lsum[QT];
#pragma unroll
  for (int a = 0; a < QT; ++a) lsum[a] = 0.f;
  uint4 rk[KPT], rv[2];
#define ATT_GLOAD(key0)                                                                   \
  {                                                                                       \
    _Pragma("unroll") for (int i = 0; i < KPT; ++i) {                                     \
      const int id = tid + NTHR * i, row = id / KCH, ch = id - row * KCH;                 \
      rk[i] = *(const uint4*)(k + (size_t)((key0) + row) * ldk + ch * 8);                 \
    }                                                                                     \
    _Pragma("unroll") for (int i = 0; i < 2; ++i) {                                       \
      const int id = tid + NTHR * i, row = id >> 3, ch = id & 7;                          \
      rv[i] = *(const uint4*)(vT + (size_t)row * LT + (key0) + ch * 8);                   \
    }                                                                                     \
  }
#define ATT_LSTORE(buf_)                                                                  \
  {                                                                                       \
    _Pragma("unroll") for (int i = 0; i < KPT; ++i) {                                     \
      const int id = tid + NTHR * i, row = id / KCH, ch = id - row * KCH;                 \
      *(uint4*)(Ks + (buf_) * 64 * KS + row * KS + ch * 8) = rk[i];                       \
    }                                                                                     \
    _Pragma("unroll") for (int i = 0; i < 2; ++i) {                                       \
      const int id = tid + NTHR * i, row = id >> 3, ch = id & 7;                          \
      *(uint4*)(Vs + (buf_) * 64 * 72 + row * 72 + ch * 8) = rv[i];                       \
    }                                                                                     \
  }
  ATT_GLOAD(0);
  ATT_LSTORE(0);
  __syncthreads();
  const int nkt = nkeys >> 6;
  for (int kt = 0; kt < nkt; ++kt) {
    const int buf = kt & 1;
    if (kt + 1 < nkt) ATT_GLOAD((kt + 1) << 6);
    const u16* kb = Ks + buf * 64 * KS;
    const u16* vb = Vs + buf * 64 * 72;
#pragma unroll
    for (int half = 0; half < 2; ++half) {
      f32x16 s[QT];
#pragma unroll
      for (int qt = 0; qt < QT; ++qt)
#pragma unroll
        for (int i = 0; i < 16; ++i) s[qt][i] = 0.f;
      bf16x8 kf[NKS];
#pragma unroll
      for (int ks = 0; ks < NKS; ++ks) kf[ks] = *(const bf16x8*)(kb + (half * 32 + lr) * KS + ks * 16 + lh * 8);
#pragma unroll
      for (int ks = 0; ks < NKS; ++ks) {
#pragma unroll
        for (int qt = 0; qt < QT; ++qt) s[qt] = MFMA32(kf[ks], qf[qt][ks], s[qt]);
      }
#pragma unroll
      for (int qt = 0; qt < QT; ++qt)
#pragma unroll
        for (int i = 0; i < 16; ++i) {
          float pv = __builtin_amdgcn_exp2f(s[qt][i] * sl2 - sh2);
          lsum[qt] += pv;
          s[qt][i] = pv;
        }
#pragma unroll
      for (int st = 0; st < 2; ++st) {
        bf16x8 pb[QT];
#pragma unroll
        for (int qt = 0; qt < QT; ++qt) {
          uint4 w;
          w.x = pack2(s[qt][8 * st + 0], s[qt][8 * st + 1]);
          w.y = pack2(s[qt][8 * st + 2], s[qt][8 * st + 3]);
          w.z = pack2(s[qt][8 * st + 4], s[qt][8 * st + 5]);
          w.w = pack2(s[qt][8 * st + 6], s[qt][8 * st + 7]);
          pb[qt] = __builtin_bit_cast(bf16x8, w);
        }
        bf16x8 vf[2];
#pragma unroll
        for (int mt = 0; mt < 2; ++mt) {
          const u16* vp = vb + (mt * 32 + lr) * 72 + half * 32 + st * 16 + lh * 4;
          uint2 v0 = *(const uint2*)(vp);
          uint2 v1 = *(const uint2*)(vp + 8);
          uint4 w;
          w.x = v0.x; w.y = v0.y; w.z = v1.x; w.w = v1.y;
          vf[mt] = __builtin_bit_cast(bf16x8, w);
        }
#pragma unroll
        for (int mt = 0; mt < 2; ++mt) {
#pragma unroll
          for (int qt = 0; qt < QT; ++qt) o[qt][mt] = MFMA32(vf[mt], pb[qt], o[qt][mt]);
        }
      }
    }
    if (kt + 1 < nkt) ATT_LSTORE(buf ^ 1);
    __syncthreads();
  }
#pragma unroll
  for (int qt = 0; qt < QT; ++qt) {
    float tot = lsum[qt] + __shfl_xor(lsum[qt], 32);
    float inv = 1.f / tot;
    const int row = wave * 32 * QT + qt * 32 + lr;
#pragma unroll
    for (int mt = 0; mt < 2; ++mt)
#pragma unroll
      for (int gq = 0; gq < 4; ++gq) {
        uint2 w;
        w.x = pack2(o[qt][mt][4 * gq + 0] * inv, o[qt][mt][4 * gq + 1] * inv);
        w.y = pack2(o[qt][mt][4 * gq + 2] * inv, o[qt][mt][4 * gq + 3] * inv);
        *(uint2*)(out + (size_t)row * ldo + mt * 32 + 8 * gq + 4 * lh) = w;
      }
  }
}

DI void hyena_pass(const Params& p, int l, const MixBufs& m, const float* __restrict__ gT, int L, int segoff, int c, char* smem) {
  const int RS = L + 16, US = L + 16;
  unsigned* Rc = (unsigned*)smem;
  u16* U = (u16*)(smem + (size_t)2 * RS * 4);
  const int tid = ltid(), lane = tid & 63, wave = tid >> 6;
  for (int d = tid; d < L; d += NTHR) {
    const int q = 2 * d;
    const float r0 = gT[(size_t)(2 * L - 2 - q) * 256 + c];
    const float r1 = (q + 1 <= 2 * L - 2) ? gT[(size_t)(2 * L - 3 - q) * 256 + c] : 0.f;
    const float r2 = (q + 2 <= 2 * L - 2) ? gT[(size_t)(2 * L - 4 - q) * 256 + c] : 0.f;
    Rc[d] = pack2(r0, r1);
    Rc[RS + d] = pack2(r1, r2);
  }
  const float* cw = p.hy_conv_w + l * 3 * 768;
  const float* cb = p.hy_conv_b + l * 768;
  {
    const float w0a = cw[c], w1a = cw[768 + c], w2a = cw[1536 + c], ba = cb[c];
    const float w0v = cw[512 + c], w1v = cw[768 + 512 + c], w2v = cw[1536 + 512 + c], bv = cb[512 + c];
    for (int b = 0; b < BG; ++b) {
      const u16* x1p = m.pt + (size_t)c * TG + b * LT + segoff;
      const u16* vp = m.pt + (size_t)(512 + c) * TG + b * LT + segoff;
      for (int t = tid; t < L; t += NTHR) {
        float x1 = bf2f(x1p[t]) * w1a + ba;
        float vv = bf2f(vp[t]) * w1v + bv;
        if (t > 0) { x1 += bf2f(x1p[t - 1]) * w0a; vv += bf2f(vp[t - 1]) * w0v; }
        if (t < L - 1) { x1 += bf2f(x1p[t + 1]) * w2a; vv += bf2f(vp[t + 1]) * w2v; }
        U[b * US + t] = f2bf(x1 * vv);
      }
    }
  }
  __syncthreads();
  const int i = lane & 31, h = lane >> 5, bn = i & 3, mb = i >> 2;
  const int par = (L - 1 - i) & 1;
  const float bias = p.hy_bias[l * 256 + c];
  const float w0x = cw[256 + c], w1x = cw[768 + 256 + c], w2x = cw[1536 + 256 + c], bx = cb[256 + c];
  const int nsteps = (L + 208) / 16 + 1;
  for (int sp = wave; sp < L / 256; sp += 4) {
    const int T0 = sp * 256;
    f32x16 acc;
#pragma unroll
    for (int r = 0; r < 16; ++r) acc[r] = 0.f;
    const int delta0 = T0 + 224;
    const int q0 = (L - 1) - delta0 - i + 8 * h;
    const unsigned* ap = Rc + par * RS + (q0 >> 1);
    int s0 = T0 + 32 * mb - delta0;
    const u16* bp = U + bn * US + s0 + 8 * h;
#pragma unroll 2
    for (int st = 0; st < nsteps; ++st) {
      uint4 aw;
      aw.x = ap[0]; aw.y = ap[1]; aw.z = ap[2]; aw.w = ap[3];
      uint4 bw = make_uint4(0u, 0u, 0u, 0u);
      if (s0 >= 0 && s0 <= L - 16) bw = *(const uint4*)bp;
      acc = MFMA32(__builtin_bit_cast(bf16x8, aw), __builtin_bit_cast(bf16x8, bw), acc);
      ap += 8;
      s0 += 16;
      bp += 16;
    }
    const u16* x2p = m.pt + (size_t)(256 + c) * TG + bn * LT + segoff;
    u16* yp = m.u + (size_t)c * TG + bn * LT + segoff;
#pragma unroll
    for (int gq = 0; gq < 4; ++gq) {
      const int t4 = T0 + 32 * mb + 8 * gq + 4 * h;
      float e[6];
#pragma unroll
      for (int k = 0; k < 6; ++k) {
        const int tt = t4 - 1 + k;
        e[k] = (tt >= 0 && tt < L) ? bf2f(x2p[tt]) : 0.f;
      }
      const uint2 uu = *(const uint2*)(U + bn * US + t4);
      const float u0 = bflo_(uu.x), u1 = bfhi_(uu.x), u2 = bflo_(uu.y), u3 = bfhi_(uu.y);
      const float y0 = (e[0] * w0x + e[1] * w1x + e[2] * w2x + bx) * (acc[4 * gq + 0] + u0 * bias);
      const float y1 = (e[1] * w0x + e[2] * w1x + e[3] * w2x + bx) * (acc[4 * gq + 1] + u1 * bias);
      const float y2 = (e[2] * w0x + e[3] * w1x + e[4] * w2x + bx) * (acc[4 * gq + 2] + u2 * bias);
      const float y3 = (e[3] * w0x + e[4] * w1x + e[5] * w2x + bx) * (acc[4 * gq + 3] + u3 * bias);
      uint2 w;
      w.x = pack2(y0, y1);
      w.y = pack2(y2, y3);
      *(uint2*)(yp + t4) = w;
    }
  }
  __syncthreads();
}

#define DPP_ROR(v, n) __builtin_bit_cast(float, __builtin_amdgcn_update_dpp(0, __builtin_bit_cast(int, (v)), 0x120 + (n), 0xf, 0xf, true))
DI float row_allsum(float v) {
  v += DPP_ROR(v, 8);
  v += DPP_ROR(v, 4);
  v += DPP_ROR(v, 2);
  v += DPP_ROR(v, 1);
  return v;
}
DI float bflo(unsigned w) { return __uint_as_float(w << 16); }
DI float bfhi(unsigned w) { return __uint_as_float(w & 0xffff0000u); }
DI void scan_item(const Params& p, int l, const MixBufs& m, int bl, int hd, int dir, int rq, char* smem) {
  constexpr int TC = 16;
  constexpr int NCH = LT / TC;
  constexpr int BUF = 5 * TC * 64 + TC * 16;
  float* sbase = (float*)smem;
  float* sy = sbase + 2 * BUF;
  const int tid = ltid(), lane = tid & 63, wave = tid >> 6;
  const int kq = lane & 15, rloc = wave * 4 + (lane >> 4);
  const u16* eD = dir ? m.eb : m.ef;
  const u16* aD = dir ? m.ab : m.af;
  float* yD = dir ? m.yb : m.yf;
  const size_t rbase = (size_t)bl * LT;
  const int ss = tid >> 4, su = tid & 15, sc = su & 7;
  float kav[8];
#pragma unroll
  for (int i = 0; i < 8; ++i) kav[i] = p.rw_k_a[l * 256 + hd * 64 + sc * 8 + i];
  uint4 g0, g1, g2;
  g2.x = g2.y = g2.z = g2.w = 0u;
#define SCAN_JMAP(i) (dir ? ((i) < LC ? LC - 1 - (i) : LT - 1 - ((i) - LC)) : (i))
#define SCAN_GLOAD(i0)                                                                         \
  {                                                                                            \
    const int ii_ = (i0) + ss;                                                                 \
    const int j_ = SCAN_JMAP(ii_);                                                             \
    const size_t o_ = (rbase + j_) * 256 + hd * 64 + sc * 8;                                   \
    if (su < 8) {                                                                              \
      g0 = *(const uint4*)(m.rkk + o_);                                                        \
      g1 = *(const uint4*)(aD + o_);                                                           \
      g2 = *(const uint4*)(m.rk + o_);                                                         \
    } else {                                                                                   \
      g0 = *(const uint4*)(eD + o_);                                                           \
      g1 = *(const uint4*)(m.rr + o_);                                                         \
      if (sc < 2) g2 = *(const uint4*)(m.rv + (rbase + j_) * 256 + hd * 64 + rq * 16 + sc * 8); \
    }                                                                                          \
  }
#define SCAN_LSTORE(buf_)                                                                      \
  {                                                                                            \
    float* B_ = sbase + (buf_) * BUF;                                                          \
    const unsigned w0_[4] = {g0.x, g0.y, g0.z, g0.w};                                          \
    const unsigned w1_[4] = {g1.x, g1.y, g1.z, g1.w};                                          \
    const unsigned w2_[4] = {g2.x, g2.y, g2.z, g2.w};                                          \
    if (su < 8) {                                                                              \
      float kk_[8], bb_[8], dd_[8];                                                            \
      _Pragma("unroll") for (int q_ = 0; q_ < 4; ++q_) {                                       \
        const float k0_ = bflo(w0_[q_]), k1_ = bfhi(w0_[q_]);                                  \
        const float a0_ = bflo(w1_[q_]), a1_ = bfhi(w1_[q_]);                                  \
        const float v0_ = bflo(w2_[q_]), v1_ = bfhi(w2_[q_]);                                  \
        kk_[2 * q_] = k0_; kk_[2 * q_ + 1] = k1_;                                              \
        bb_[2 * q_] = k0_ * a0_; bb_[2 * q_ + 1] = k1_ * a1_;                                  \
        dd_[2 * q_] = v0_ * (1.f + (a0_ - 1.f) * kav[2 * q_]);                                 \
        dd_[2 * q_ + 1] = v1_ * (1.f + (a1_ - 1.f) * kav[2 * q_ + 1]);                         \
      }                                                                                        \
      float* d0_ = B_ + ss * 64 + sc * 8;                                                      \
      *(float4*)(d0_) = make_float4(kk_[0], kk_[1], kk_[2], kk_[3]);                           \
      *(float4*)(d0_ + 4) = make_float4(kk_[4], kk_[5], kk_[6], kk_[7]);                       \
      *(float4*)(d0_ + 2048) = make_float4(bb_[0], bb_[1], bb_[2], bb_[3]);                    \
      *(float4*)(d0_ + 2052) = make_float4(bb_[4], bb_[5], bb_[6], bb_[7]);                    \
      *(float4*)(d0_ + 3072) = make_float4(dd_[0], dd_[1], dd_[2], dd_[3]);                    \
      *(float4*)(d0_ + 3076) = make_float4(dd_[4], dd_[5], dd_[6], dd_[7]);                    \
    } else {                                                                                   \
      float ww_[8], rr_[8], vv_[8];                                                            \
      _Pragma("unroll") for (int q_ = 0; q_ < 4; ++q_) {                                       \
        ww_[2 * q_] = 1.f - bflo(w0_[q_]); ww_[2 * q_ + 1] = 1.f - bfhi(w0_[q_]);              \
        rr_[2 * q_] = bflo(w1_[q_]); rr_[2 * q_ + 1] = bfhi(w1_[q_]);                          \
        vv_[2 * q_] = bflo(w2_[q_]); vv_[2 * q_ + 1] = bfhi(w2_[q_]);                          \
      }                                                                                        \
      float* d0_ = B_ + ss * 64 + sc * 8;                                                      \
      *(float4*)(d0_ + 1024) = make_float4(ww_[0], ww_[1], ww_[2], ww_[3]);                    \
      *(float4*)(d0_ + 1028) = make_float4(ww_[4], ww_[5], ww_[6], ww_[7]);                    \
      *(float4*)(d0_ + 4096) = make_float4(rr_[0], rr_[1], rr_[2], rr_[3]);                    \
      *(float4*)(d0_ + 4100) = make_float4(rr_[4], rr_[5], rr_[6], rr_[7]);                    \
      if (sc < 2) {                                                                            \
        float* d1_ = B_ + 5120 + ss * 16 + sc * 8;                                             \
        *(float4*)(d1_) = make_float4(vv_[0], vv_[1], vv_[2], vv_[3]);                         \
        *(float4*)(d1_ + 4) = make_float4(vv_[4], vv_[5], vv_[6], vv_[7]);                     \
      }                                                                                        \
    }                                                                                          \
  }
  f32x2_t SA = {0.f, 0.f}, SB = {0.f, 0.f};
  __builtin_amdgcn_s_setprio(3);
  SCAN_GLOAD(0);
  SCAN_LSTORE(0);
  __syncthreads();
  for (int c = 0; c < NCH; ++c) {
    const int buf = c & 1;
    if (c + 1 < NCH) SCAN_GLOAD((c + 1) * TC);
    const float* B = sbase + buf * BUF;
    float* syb = sy + buf * TC * 16;
    float ypart[TC];
    float4 kkv[TC], wwv[TC], bbv[TC], ddv[TC], rrv[TC];
    float vvv[TC];
    constexpr int PF = 2;
#pragma unroll
    for (int st = 0; st < PF; ++st) {
      kkv[st] = *(const float4*)(B + st * 64 + kq * 4);
      wwv[st] = *(const float4*)(B + 1024 + st * 64 + kq * 4);
      bbv[st] = *(const float4*)(B + 2048 + st * 64 + kq * 4);
      ddv[st] = *(const float4*)(B + 3072 + st * 64 + kq * 4);
      rrv[st] = *(const float4*)(B + 4096 + st * 64 + kq * 4);
      vvv[st] = B[5120 + st * 16 + rloc];
    }
    __builtin_amdgcn_sched_barrier(0);
#pragma unroll
    for (int st = 0; st < TC; ++st) {
      if (st + PF < TC) {
        kkv[st + PF] = *(const float4*)(B + (st + PF) * 64 + kq * 4);
        wwv[st + PF] = *(const float4*)(B + 1024 + (st + PF) * 64 + kq * 4);
        bbv[st + PF] = *(const float4*)(B + 2048 + (st + PF) * 64 + kq * 4);
        ddv[st + PF] = *(const float4*)(B + 3072 + (st + PF) * 64 + kq * 4);
        rrv[st + PF] = *(const float4*)(B + 4096 + (st + PF) * 64 + kq * 4);
        vvv[st + PF] = B[5120 + (st + PF) * 16 + rloc];
      }
      __builtin_amdgcn_sched_barrier(0);
      const float4 kk = kkv[st], ww = wwv[st], bb = bbv[st], dd = ddv[st], rr = rrv[st];
      const float vv = vvv[st];
      const f32x2_t k01 = {kk.x, kk.y}, k23 = {kk.z, kk.w}, w01 = {ww.x, ww.y}, w23 = {ww.z, ww.w};
      const f32x2_t b01 = {bb.x, bb.y}, b23 = {bb.z, bb.w}, d01 = {dd.x, dd.y}, d23 = {dd.z, dd.w};
      const f32x2_t r01 = {rr.x, rr.y}, r23 = {rr.z, rr.w}, v2 = {vv, vv};
      const f32x2_t pp2 = SA * k01 + SB * k23;
      const float part = pp2.x + pp2.y;
      const f32x2_t cA = SA * w01 + v2 * d01, cB = SB * w23 + v2 * d23;
      const float sa = -row_allsum(part);
      const f32x2_t sa2 = {sa, sa};
      SA = cA + sa2 * b01;
      SB = cB + sa2 * b23;
      const f32x2_t yy2 = SA * r01 + SB * r23;
      ypart[st] = yy2.x + yy2.y;
    }
#pragma unroll
    for (int st = 0; st < TC; ++st) ypart[st] = row_allsum(ypart[st]);
    if (kq == 0) {
#pragma unroll
      for (int st = 0; st < TC; ++st) syb[st * 16 + rloc] = ypart[st];
    }
    if (c + 1 < NCH) SCAN_LSTORE(buf ^ 1);
    __syncthreads();
    {
      const int st = tid >> 4, r_ = tid & 15;
      const int ii = c * TC + st;
      const int j = SCAN_JMAP(ii);
      yD[(rbase + j) * 256 + hd * 64 + rq * 16 + r_] = syb[st * 16 + r_];
    }
  }
  __builtin_amdgcn_s_setprio(0);
  __syncthreads();
}

DI void readout_hy_phase(int g, const MixBufs& m, u16* __restrict__ ymix, bool skip_ctx, char* smem) {
  const int tid = ltid();
  {
    u16* tile = (u16*)smem;
    for (int tl = blockIdx.x; tl < (TG / 64) * 4; tl += gridDim.x) {
      const int rl0 = (tl >> 2) * 64, c0 = (tl & 3) * 64;
      const int r0 = g * TG + rl0;
      if (skip_ctx && (r0 % LT) < LC) continue;
#pragma unroll
      for (int k = 0; k < 2; ++k) {
        const int id = tid + NTHR * k, ch = id >> 3, part = id & 7;
        *(uint4*)(tile + ch * 72 + part * 8) = *(const uint4*)(m.u + (size_t)(c0 + ch) * TG + rl0 + part * 8);
      }
      __syncthreads();
#pragma unroll
      for (int k = 0; k < 2; ++k) {
        const int id = tid + NTHR * k, tok = id >> 3, part = id & 7;
        const u16* tp = tile + (part * 8) * 72 + tok;
        uint4 w;
        w.x = (unsigned)tp[0] | ((unsigned)tp[72] << 16);
        w.y = (unsigned)tp[2 * 72] | ((unsigned)tp[3 * 72] << 16);
        w.z = (unsigned)tp[4 * 72] | ((unsigned)tp[5 * 72] << 16);
        w.w = (unsigned)tp[6 * 72] | ((unsigned)tp[7 * 72] << 16);
        *(uint4*)(ymix + (size_t)(r0 + tok) * D + c0 + part * 8) = w;
      }
      __syncthreads();
    }
  }
}

DI void readout_rw_phase(const Params& p, int l, int g, const MixBufs& m, u16* __restrict__ ymix, bool skip_ctx) {
  const int tid = ltid();
  for (int rl = blockIdx.x; rl < TG; rl += gridDim.x) {
    const int r = g * TG + rl;
    const int j = r % LT;
    if (skip_ctx && j < LC) continue;
    const size_t o = (size_t)rl * 256 + tid;
    float y = m.yf[o] + m.yb[o];
    float mean = wave_sum(y) * (1.f / 64.f);
    float dv = y - mean;
    float var = wave_sum(dv * dv) * (1.f / 64.f);
    float yn = dv * rsqrtf(var + 64e-5f) * p.rw_ln_w[l * 256 + tid] + p.rw_ln_b[l * 256 + tid];
    const float rr = bf2f(m.rr[o]), kv = bf2f(m.rk[o]), vv = bf2f(m.rv[o]);
    const float kaa = p.rw_k_a[l * 256 + tid], rk = p.rw_r_k[l * 256 + tid];
    const float af = bf2f(m.af[o]), ab = bf2f(m.ab[o]);
    float t1 = rr * kv * (1.f + (af - 1.f) * kaa) * rk + rr * kv * (1.f + (ab - 1.f) * kaa) * rk;
    float bonus = wave_sum(t1) * vv;
    ymix[(size_t)r * D + 768 + tid] = f2bf((yn + bonus) * bf2f(m.gg[o]));
  }
}

#define XB_TMO      128
#define XB_XCNT(j)  (256  + 64 * (j))
#define XB_XSUB(j)  (1280 + 64 * (j))
#define XB_XGEN(j)  (2304 + 64 * (j))
#define XB_TOP      3328
#define XB_TOPGEN   3392
#define XCD_BAR_WORDS 3456
#define XB_SPIN_CAP (1u << 21)
#define LAS __attribute__((address_space(3)))
DI unsigned xb_ld(unsigned* p) { return __hip_atomic_load(p, __ATOMIC_RELAXED, __HIP_MEMORY_SCOPE_AGENT); }
DI unsigned xb_add(unsigned* p, unsigned v) { return __hip_atomic_fetch_add(p, v, __ATOMIC_RELAXED, __HIP_MEMORY_SCOPE_AGENT); }
DI unsigned xb_xcc_id() { return (unsigned)__builtin_amdgcn_s_getreg((3 << 11) | 20) & 0xFu; }
#define XB_SPIN(cond, bar) do { unsigned _sp = 0; while (cond) { __builtin_amdgcn_s_sleep(1); \
    if ((++_sp & 255u) == 0u) { if (xb_ld(&(bar)[XB_TMO])) break; if (_sp > XB_SPIN_CAP) { atomicAdd(&(bar)[XB_TMO], 1u); break; } } } } while (0)
struct XcdBarrier { unsigned* bar; unsigned x; volatile LAS unsigned* st; };
DI XcdBarrier xcd_barrier_post(unsigned* bar, volatile LAS unsigned* st) {
  XcdBarrier b; b.bar = bar; b.x = xb_xcc_id(); b.st = st;
  if (threadIdx.x == 0) (void)xb_add(&bar[XB_XCNT(b.x)], 1u);
  return b;
}
DI void xcd_barrier_complete(unsigned* bar, unsigned x, unsigned& nloc, unsigned& nx) {
  const unsigned G = gridDim.x * gridDim.y * gridDim.z;
  unsigned sum, cnt, mine, sp = 0u;
  for (;;) {
    sum = 0u; cnt = 0u; mine = 0u;
#pragma unroll
    for (unsigned j = 0; j < 16; ++j) { const unsigned c = xb_ld(&bar[XB_XCNT(j)]); sum += c; cnt += (c > 0u) ? 1u : 0u; mine = (j == x) ? c : mine; }
    if (sum == G) break;
    __builtin_amdgcn_s_sleep(1);
    if ((++sp & 255u) == 0u) { if (xb_ld(&bar[XB_TMO])) break; if (sp > XB_SPIN_CAP) { atomicAdd(&bar[XB_TMO], 1u); break; } }
  }
  nloc = mine > 0u ? mine : 1u; nx = cnt > 0u ? cnt : 1u;
}
DI void xcd_barrier(const XcdBarrier& b) {
  asm volatile("s_waitcnt vmcnt(0)" ::: "memory");
  __syncthreads();
  if (threadIdx.x == 0) {
    unsigned* bar = b.bar;
    __builtin_amdgcn_s_waitcnt(0);
    unsigned nloc = b.st[0], nx = b.st[1];
    if (nloc == 0u) { xcd_barrier_complete(bar, b.x, nloc, nx); b.st[0] = nloc; b.st[1] = nx; }
    const unsigned old = xb_add(&bar[XB_XSUB(b.x)], 1u);
    const unsigned gen = old / nloc;
    if (old + 1u == (gen + 1u) * nloc) {
      __builtin_amdgcn_fence(__ATOMIC_RELEASE, "agent");
      asm volatile("s_waitcnt vmcnt(0)" ::: "memory");
      const unsigned og = xb_add(&bar[XB_TOP], 1u);
      const unsigned tg = og / nx;
      if (og + 1u == (tg + 1u) * nx) xb_add(&bar[XB_TOPGEN], 1u);
      else XB_SPIN(xb_ld(&bar[XB_TOPGEN]) == tg, bar);
      __builtin_amdgcn_fence(__ATOMIC_ACQUIRE, "agent");
      xb_add(&bar[XB_XGEN(b.x)], 1u);
      asm volatile("s_waitcnt vmcnt(0)" ::: "memory");
    } else {
      XB_SPIN(xb_ld(&bar[XB_XGEN(b.x)]) == gen, bar);
      __builtin_amdgcn_fence(__ATOMIC_ACQUIRE, "agent");
      asm volatile("s_waitcnt vmcnt(0)" ::: "memory");
    }
  }
  __syncthreads();
}

DI int conv_job_tiles(int j) {
  return (j <= 2 || j >= 12) ? 704 : j == 3 ? 720 : j == 4 ? 24 : j == 5 ? 16 : j <= 9 ? 4 : j == 10 ? 8 : 256;
}
DI void conv_job_tile(const Params& p, int l, int j, int t, u16* W, char* smem) {
  switch (j) {
    case 0: convT_tile(p.ffn1_gate + (size_t)l * D * DFF, D, DFF, W + W_GU1, 1, t, smem); break;
    case 1: convT_tile(p.ffn1_up + (size_t)l * D * DFF, D, DFF, W + W_GU1, 2, t, smem); break;
    case 2: convT_tile(p.ffn1_down + (size_t)l * D * DFF, DFF, D, W + W_D1, 0, t, smem); break;
    case 3: convT_tile(p.w_in + (size_t)l * D * DIN, D, DIN, W + W_IN, 0, t, smem); break;
    case 4: convT_tile(p.mla_w_uq + (size_t)l * 256 * 384, 256, 384, W + W_UQ, 0, t, smem); break;
    case 5: convT_tile(p.mla_w_ukv + (size_t)l * 128 * 512, 128, 512, W + W_UKV, 0, t, smem); break;
    case 6: convT_tile(p.rw_w2 + (size_t)(l * 2 + 0) * 64 * 256, 64, 256, W + W_W2, 0, t, smem); break;
    case 7: convT_tile(p.rw_w2 + (size_t)(l * 2 + 1) * 64 * 256, 64, 256, W + W_W2 + (size_t)256 * 64, 0, t, smem); break;
    case 8: convT_tile(p.rw_a2 + (size_t)(l * 2 + 0) * 64 * 256, 64, 256, W + W_A2, 0, t, smem); break;
    case 9: convT_tile(p.rw_a2 + (size_t)(l * 2 + 1) * 64 * 256, 64, 256, W + W_A2 + (size_t)256 * 64, 0, t, smem); break;
    case 10: convT_tile(p.rw_g2 + (size_t)l * 128 * 256, 128, 256, W + W_G2, 0, t, smem); break;
    case 11: convT_tile(p.w_out + (size_t)l * D * D, D, D, W + W_OUT, 0, t, smem); break;
    case 12: convT_tile(p.ffn2_gate + (size_t)l * D * DFF, D, DFF, W + W_GU2, 1, t, smem); break;
    case 13: convT_tile(p.ffn2_up + (size_t)l * D * DFF, D, DFF, W + W_GU2, 2, t, smem); break;
    default: convT_tile(p.ffn2_down + (size_t)l * D * DFF, DFF, D, W + W_D2, 0, t, smem); break;
  }
}
constexpr int AUX_EARLY = 704 * 3 + 720 + 24 + 16 + 16 + 8;
constexpr int AUX_LATE = 256 + 704 * 3;
DI void aux_tile(const Params& p, int l, int a, u16* W, char* smem) {
  int jl = 1, j0 = 11;
  if (l == 0 && a < AUX_EARLY) j0 = 0;
  else if (l == 0) { a -= AUX_EARLY; jl = 0; }
  int j = j0;
  for (;;) {
    const int n = conv_job_tiles(j);
    if (a < n) break;
    a -= n;
    ++j;
  }
  conv_job_tile(p, jl, j, a, W, smem);
}

__global__ void __launch_bounds__(NTHR, 2) fwd_megakernel(Params p) {
  cg::grid_group grid = cg::this_grid();
  __shared__ __attribute__((aligned(16))) char smem[73728];
  __shared__ int s_item;
  __shared__ uint4 xb_words;
  if (threadIdx.x == 0) xb_words = make_uint4(0u, 0u, 0u, 0u);
  __syncthreads();
  const XcdBarrier xb = xcd_barrier_post((unsigned*)(p.ws + OFF_BAR), (volatile LAS unsigned*)&xb_words);
  char* ws = p.ws;
  float* ctxs = (float*)(ws + OFF_CTX);
  float* mod = (float*)(ws + OFF_MOD);
  u16* hbuf = (u16*)(ws + OFF_H);
  char* big = ws + OFF_BIG;
  u16* Gbuf = (u16*)big;
  u16* const Wl = (u16*)(ws + OFF_W);
  float* const filt = (float*)(ws + OFF_FILT);

  for (int j = 0; j <= 10; ++j)
    for (int t = blockIdx.x; t < conv_job_tiles(j); t += gridDim.x) conv_job_tile(p, 0, j, t, Wl, smem);
  hyfilt_phase(p, 0, LQ, filt, smem);
  hyfilt_phase(p, 0, LC, (float*)(ws + OFF_FILTC), smem);
  rope_table_phase((float2*)(ws + OFF_ROPEG), (float2*)(ws + OFF_ROPEM));
  mod_phase(p, mod, smem);
  grid.sync();

  for (int l = 0; l < 2; ++l) {
    const bool last = (l == 1);
    const u16* W = Wl;
    if (l == 1) {
      hyfilt_phase(p, 1, LQ, filt, smem);
    }
    const float* modl = mod + (size_t)l * 9 * 9216;
    const float* lat_in = (l == 0) ? p.x : p.out;
    const float* ctx_in = (l == 0) ? p.ctx : ctxs;

    adaln_phase(lat_in, ctx_in, p.norm_ffn1 + l * D, modl, 0, hbuf, false);
    xcd_barrier(xb);
    {
      EpiGU e{Gbuf};
      gemm_gu_phase(hbuf, W + W_GU1, T / 128, false, smem, e);
    }
    xcd_barrier(xb);
    {
      EpiRes e{lat_in, ctx_in, p.out, ctxs, modl, 2, 0.5f, nullptr, nullptr, nullptr, 0};
      gemm_phase<false>(Gbuf, DFF, W + W_D1, DFF, DFF, T / 128, 8, 0, false, smem, e);
    }
    xcd_barrier(xb);
    adaln_phase(p.out, ctxs, p.norm_mix + l * D, modl, 1, hbuf, false);
    xcd_barrier(xb);
    for (int g = 0; g < NG; ++g) {
      const MixBufs m = mixbufs(big, g);
      const u16* hg = hbuf + (size_t)g * TG * D;
      {
        EpiWin e{m.p, m.pt};
        gemm_phase<false>(hg, D, W + W_IN, D, D, TG / 128, 23, 0, false, smem, e);
      }
      xcd_barrier(xb);
      for (int rep = 0; rep < REP_ROW; ++rep) prep_phase(p, l, g, m, (const float2*)(ws + OFF_ROPEG), smem);
      xcd_barrier(xb);
      {
        EpiStore e1{m.qup, 384, 384};
        gemm_phase<false>(m.cqn, 256, W + W_UQ, 256, 256, TG / 128, 3, 0, false, smem, e1);
        EpiStore e2{m.kvup, 512, 512};
        gemm_phase<false>(m.ckvn, 128, W + W_UKV, 128, 128, TG / 128, 4, 0, false, smem, e2);
        EpiLoraW e3{m.ef, p.rw_w0 + (l * 2 + 0) * 256};
        gemm_phase<false>(m.lwf, 64, W + W_W2, 64, 64, TG / 128, 2, 0, false, smem, e3);
        EpiLoraW e4{m.eb, p.rw_w0 + (l * 2 + 1) * 256};
        gemm_phase<false>(m.lwb, 64, W + W_W2 + 256 * 64, 64, 64, TG / 128, 2, 0, false, smem, e4);
        EpiLoraA e5{m.af, p.rw_a0 + (l * 2 + 0) * 256};
        gemm_phase<false>(m.laf, 64, W + W_A2, 64, 64, TG / 128, 2, 0, false, smem, e5);
        EpiLoraA e6{m.ab, p.rw_a0 + (l * 2 + 1) * 256};
        gemm_phase<false>(m.lab, 64, W + W_A2 + 256 * 64, 64, 64, TG / 128, 2, 0, false, smem, e6);
        EpiStore e7{m.gg, 256, 256};
        gemm_phase<false>(m.lg, 128, W + W_G2, 128, 128, TG / 128, 2, 0, false, smem, e7);
      }
      xcd_barrier(xb);
      for (int rep = 0; rep < REP_ROW; ++rep) mla_fin_phase(p, l, g, m, (const float2*)(ws + OFF_ROPEM));
      xcd_barrier(xb);
      {
        u16* ymix = hbuf;
        const int n_scan = (g == NG - 1) ? NG * BG * 4 * 2 * 4 : 0;
        const int qt_per_b = last ? 16 : 17;
        const int n_att = BG * 4 * qt_per_b;
        const int n_gqa = (g == NG - 1) ? NG * n_att : 0;
        const int n_hy = 256;
        const int total = n_scan + n_att + n_gqa + n_hy;
        float gq = 0.f, gk = 0.f, mq = 0.f, mk = 0.f;
        for (int i = 0; i < 64; ++i) { gq = fmaxf(gq, fabsf(p.gqa_q_norm[l * 64 + i])); gk = fmaxf(gk, fabsf(p.gqa_k_norm[l * 64 + i])); }
        for (int i = 0; i < 96; ++i) { mq = fmaxf(mq, fabsf(p.mla_q_norm[l * 96 + i])); mk = fmaxf(mk, fabsf(p.mla_k_norm[l * 96 + i])); }
        const float L2E = 1.4426950408889634f;
        const float sc_g = 0.125f, sc_m = 0.10206207261596575f;
        const float sh_g = (64.f * gq * gk * sc_g * 1.02f + 0.5f) * L2E;
        const float sh_m = (96.f * mq * mk * sc_m * 1.02f + 0.5f) * L2E;
        int* cnt = (int*)(ws + OFF_CNT) + (l * NG + g);
        for (;;) {
          if (threadIdx.x == 0) s_item = atomicAdd(cnt, 1);
          __syncthreads();
          const int it = s_item;
          __syncthreads();
          if (it >= total) break;
          if (it < n_scan) {
            const int sg = it >> 7, bl = (it >> 5) & 3, hd = (it >> 3) & 3, dir = (it >> 2) & 1, rq = it & 3;
            const MixBufs ms = mixbufs(big, sg);
            scan_item(p, l, ms, bl, hd, dir, rq, smem);
          } else if (it < n_scan + n_att + n_gqa) {
            int a = it - n_scan;
            const int kind = a < n_att ? 0 : 1;
            int ag = g;
            if (kind == 1) { a -= n_att; ag = a / n_att; a -= ag * n_att; }
            const int bl = a / (4 * qt_per_b);
            int rem = a - bl * 4 * qt_per_b;
            const int hd = rem / qt_per_b;
            const int qt = rem - hd * qt_per_b;
            const int j0 = qt < 16 ? LC + qt * 256 : 0;
            const int nkeys = qt < 16 ? LT : LC;
            const size_t rl0 = (size_t)bl * LT + j0;
            const size_t rg0 = (size_t)(ag * BG + bl) * LT + j0;
            if (kind == 1) {
              const MixBufs ma = mixbufs(big, ag);
              const int kvh = hd >> 1;
              attn_item<64, 2>(ma.qg + rl0 * 256 + hd * 64, 256, ma.kg + (size_t)bl * LT * 128 + kvh * 64, 128,
                            ma.vtg + (size_t)(bl * 2 + kvh) * 64 * LT, ymix + rg0 * D + 256 + hd * 64, D, nkeys, sc_g * L2E, sh_g, smem);
            } else {
              attn_item<96, 2>(m.qm + rl0 * 384 + hd * 96, 384, m.km + (size_t)bl * LT * 384 + hd * 96, 384,
                            m.vtm + (size_t)(bl * 4 + hd) * 64 * LT, ymix + rg0 * D + 512 + hd * 64, D, nkeys, sc_m * L2E, sh_m, smem);
            }
          } else {
            const int c = it - n_scan - n_att - n_gqa;
            hyena_pass(p, l, m, filt, LQ, LC, c, smem);
            if (!last) hyena_pass(p, l, m, (const float*)(ws + OFF_FILTC), LC, 0, c, smem);
          }
        }
        if (g == NG - 1) {
          int* acnt = (int*)(ws + OFF_CNT) + 16 + l;
          const int n_aux = l == 0 ? AUX_EARLY + AUX_LATE : AUX_LATE;
          for (;;) {
            if (threadIdx.x == 0) s_item = atomicAdd(acnt, 1);
            __syncthreads();
            const int a = s_item;
            __syncthreads();
            if (a >= n_aux) break;
            aux_tile(p, l, a, Wl, smem);
          }
        }
        xcd_barrier(xb);
        readout_hy_phase(g, m, ymix, last, smem);
        if (g == NG - 1) {
          for (int rg = 0; rg < NG; ++rg) {
            const MixBufs mr = mixbufs(big, rg);
            readout_rw_phase(p, l, rg, mr, ymix, last);
          }
          xcd_barrier(xb);
        }
      }
    }
    {
      EpiRes e{p.out, ctxs, p.out, ctxs, modl, 5, 1.0f, nullptr, nullptr, nullptr, 0};
      gemm_phase<false>(hbuf, D, W + W_OUT, D, D, T / 128, 8, 0, last, smem, e);
    }
    xcd_barrier(xb);
    adaln_phase(p.out, ctxs, p.norm_ffn2 + l * D, modl, 2, hbuf, last);
    xcd_barrier(xb);
    {
      EpiGU e{Gbuf};
      gemm_gu_phase(hbuf, W + W_GU2, T / 128, last, smem, e);
    }
    xcd_barrier(xb);
    {
      EpiRes e{p.out, ctxs, p.out, ctxs, modl, 8, 0.5f, nullptr, nullptr, nullptr, 0};
      gemm_phase<false>(Gbuf, DFF, W + W_D2, DFF, DFF, T / 128, 8, 0, last, smem, e);
    }
    xcd_barrier(xb);
  }
}

extern "C" void kernel_launch(void* const* d_in, const int* in_sizes, int n_in, void* d_out, int out_size, void* d_ws,
                              size_t ws_size, hipStream_t stream) {
  static int grid_blocks = 0;
  if (!grid_blocks) {
    int dev = 0, cus = 0, per_cu = 0;
    (void)hipGetDevice(&dev);
    (void)hipDeviceGetAttribute(&cus, hipDeviceAttributeMultiprocessorCount, dev);
    (void)hipOccupancyMaxActiveBlocksPerMultiprocessor(&per_cu, fwd_megakernel, NTHR, 0);
    if (per_cu > 2) per_cu = 2;
    if (per_cu < 1) per_cu = 1;
    grid_blocks = cus * per_cu;
  }
  Params p{};
  const float** pp = (const float**)&p;
  for (int i = 0; i < 47; ++i) pp[i] = (const float*)d_in[i];
  p.out = (float*)d_out;
  p.ws = (char*)d_ws;
  (void)hipMemsetAsync((char*)d_ws + OFF_CNT, 0, 256 + 3456 * 4, stream);
  void* args[] = {&p};
  hipError_t e = hipLaunchCooperativeKernel((void*)fwd_megakernel, dim3(grid_blocks), dim3(NTHR), args, 0, stream);
  if (e != hipSuccess) fprintf(stderr, "cooperative launch failed: %s (grid %d)\n", hipGetErrorString(e), grid_blocks);
}
```

```cpp
#include <hip/hip_runtime.h>
#include <hip/hip_bf16.h>
#include <hip/hip_cooperative_groups.h>
#include <cstdio>
namespace cg = cooperative_groups;

#define DI __device__ __forceinline__
typedef unsigned short u16;
using bf16x8 = __attribute__((ext_vector_type(8))) short;
using f32x16 = __attribute__((ext_vector_type(16))) float;
typedef __bf16 bf16x2_t __attribute__((ext_vector_type(2)));
typedef float f32x2_t __attribute__((ext_vector_type(2)));
#define MFMA32(a, b, c) __builtin_amdgcn_mfma_f32_32x32x16_bf16((a), (b), (c), 0, 0, 0)

constexpr int D = 1024, NB = 8, LQ = 4096, LC = 256, LT = 4352, T = NB * LT, DFF = 2816, DIN = 2848;
constexpr int HYC = 768, DINP = DIN - HYC;
constexpr int NG = 2, BG = NB / NG, TG = BG * LT;
constexpr int NTHR = 256;
#define REP_MIX 1
#define REP_GU 1
#define REP_MISC 1
#define REP_ROW 1
constexpr float EPS = 1e-6f;

constexpr size_t al(size_t x) { return (x + 255) & ~(size_t)255; }
constexpr size_t OFF_CTX = 0;
constexpr size_t OFF_MOD = OFF_CTX + al((size_t)NB * LC * D * 4);
constexpr size_t SZ_FILT_L = (size_t)(2 * LQ - 1) * 256 * 4;
constexpr size_t SZ_FILT_C = (size_t)(2 * LC - 1) * 256 * 4;
constexpr size_t OFF_CNT = OFF_MOD + al((size_t)2 * 9 * 9216 * 4);
constexpr size_t OFF_BAR = OFF_CNT + 256;
constexpr size_t OFF_FILT = OFF_BAR + al((size_t)3456 * 4);
constexpr size_t OFF_FILTC = OFF_FILT + al(SZ_FILT_L);
constexpr size_t OFF_ROPEG = OFF_FILTC + al(SZ_FILT_C);
constexpr size_t OFF_ROPEM = OFF_ROPEG + al((size_t)LQ * 32 * 8);
constexpr size_t OFF_W = OFF_ROPEM + al((size_t)LQ * 16 * 8);
constexpr size_t W_GU1 = 0;
constexpr size_t W_D1 = W_GU1 + (size_t)5632 * 1024;
constexpr size_t W_GU2 = W_D1 + (size_t)1024 * 2816;
constexpr size_t W_D2 = W_GU2 + (size_t)5632 * 1024;
constexpr size_t W_IN = W_D2 + (size_t)1024 * 2816;
constexpr size_t W_OUT = W_IN + (size_t)2944 * 1024;
constexpr size_t W_UQ = W_OUT + (size_t)1024 * 1024;
constexpr size_t W_UKV = W_UQ + (size_t)384 * 256;
constexpr size_t W_W2 = W_UKV + (size_t)512 * 128;
constexpr size_t W_A2 = W_W2 + (size_t)2 * 256 * 64;
constexpr size_t W_G2 = W_A2 + (size_t)2 * 256 * 64;
constexpr size_t W_LAYER = W_G2 + (size_t)256 * 128;
constexpr size_t OFF_H = OFF_W + al(W_LAYER * 2);
constexpr size_t OFF_BIG = OFF_H + al((size_t)T * D * 2);
constexpr size_t M_P = 0;
constexpr size_t M_PT = M_P + al((size_t)TG * DINP * 2);
constexpr size_t M_U = M_PT + al((size_t)HYC * TG * 2);
constexpr size_t M_CQN = M_U + al((size_t)TG * 256 * 2);
constexpr size_t M_CKVN = M_CQN + al((size_t)TG * 256 * 2);
constexpr size_t M_QUP = M_CKVN + al((size_t)TG * 128 * 2);
constexpr size_t M_KVUP = M_QUP + al((size_t)TG * 384 * 2);
constexpr size_t M_QM = M_KVUP + al((size_t)TG * 512 * 2);
constexpr size_t M_KM = M_QM + al((size_t)TG * 384 * 2);
constexpr size_t M_VTM = M_KM + al((size_t)TG * 384 * 2);
constexpr size_t M_LWF = M_VTM + al((size_t)TG * 256 * 2);
constexpr size_t M_LWB = M_LWF + al((size_t)TG * 64 * 2);
constexpr size_t M_LAF = M_LWB + al((size_t)TG * 64 * 2);
constexpr size_t M_LAB = M_LAF + al((size_t)TG * 64 * 2);
constexpr size_t M_LG = M_LAB + al((size_t)TG * 64 * 2);
constexpr size_t SZ_SC = al((size_t)TG * 256 * 2);
constexpr size_t M_SCAN = M_LG + al((size_t)TG * 128 * 2);
constexpr size_t SCAN_STRIDE = 11 * SZ_SC;
constexpr size_t M_END = M_SCAN + 2 * SCAN_STRIDE;
static_assert((size_t)4 * TG * 256 * 4 <= al((size_t)TG * DINP * 2), "yf/yb do not fit the p region");
constexpr size_t SZ_G = (size_t)T * DFF * 2;
constexpr size_t WS_NEED = OFF_BIG + (M_END > SZ_G ? M_END : SZ_G);
static_assert(WS_NEED <= (size_t)512 * 1024 * 1024, "workspace too large");

struct Params {
  const float *x, *c, *ctx, *c_ctx, *ada_w, *ada_b, *norm_ffn1, *norm_mix, *norm_ffn2;
  const float *ffn1_gate, *ffn1_up, *ffn1_down, *ffn2_gate, *ffn2_up, *ffn2_down, *w_in, *w_out;
  const float *hy_conv_w, *hy_conv_b, *hy_f_w1, *hy_f_b1, *hy_f_w2, *hy_f_b2, *hy_f_w3, *hy_f_b3, *hy_f_w4, *hy_f_freq, *hy_bias;
  const float *gqa_q_norm, *gqa_k_norm, *mla_cq_norm, *mla_ckv_norm, *mla_w_uq, *mla_w_ukv, *mla_q_norm, *mla_k_norm;
  const float *rw_mu, *rw_w0, *rw_w2, *rw_a0, *rw_a2, *rw_g2, *rw_k_k, *rw_k_a, *rw_r_k, *rw_ln_w, *rw_ln_b;
  float* out;
  char* ws;
};

DI u16 f2bf(float x) {
  unsigned u = __float_as_uint(x);
  u += 0x7fffu + ((u >> 16) & 1u);
  return (u16)(u >> 16);
}
DI float bf2f(u16 b) { return __uint_as_float(((unsigned)b) << 16); }
DI float bflo_(unsigned w) { return __uint_as_float(w << 16); }
DI float bfhi_(unsigned w) { return __uint_as_float(w & 0xffff0000u); }
DI unsigned pack2(float a, float b) {
  f32x2_t v = {a, b};
  bf16x2_t r = __builtin_convertvector(v, bf16x2_t);
  return __builtin_bit_cast(unsigned, r);
}
DI int ltid() {
  int t = threadIdx.x;
  asm volatile("" : "+v"(t));
  return t;
}
DI float wave_sum(float v) {
#pragma unroll
  for (int o = 32; o > 0; o >>= 1) v += __shfl_xor(v, o);
  return v;
}
DI float wave_max(float v) {
#pragma unroll
  for (int o = 32; o > 0; o >>= 1) v = fmaxf(v, __shfl_xor(v, o));
  return v;
}
DI float sigmoidf_(float x) { return __builtin_amdgcn_rcpf(1.f + __expf(-x)); }
DI int crow(int i, int h) { return (i & 3) + 8 * (i >> 2) + 4 * h; }

DI float rope_apply(float val, int idx, int nfreq, int t, int lane) {
  int pi = idx >> 1;
  int row = t >> 6, col = t & 63;
  float pos = pi < nfreq ? (float)row : (float)col;
  int f = pi < nfreq ? pi : pi - nfreq;
  float inv = exp2f(-(float)f / (float)nfreq * 13.287712379549449f);
  float ang = pos * inv;
  float cs = cosf(ang), sn = sinf(ang);
  float other = __shfl_xor(val, 1);
  return (lane & 1) ? other * sn + val * cs : val * cs - other * sn;
}

DI float rope_tab(float val, int idx, const float2* __restrict__ tab, int lane) {
  const float2 cs = tab[idx >> 1];
  const float other = __shfl_xor(val, 1);
  return (lane & 1) ? other * cs.y + val * cs.x : val * cs.x - other * cs.y;
}
DI void rope_table_phase(float2* __restrict__ tg, float2* __restrict__ tm) {
  const int tid = ltid();
  for (int e = blockIdx.x * NTHR + tid; e < LQ * 48; e += gridDim.x * NTHR) {
    const int t = e / 48, k = e - t * 48;
    const bool isg = k < 32;
    const int pi = isg ? k : k - 32, nfreq = isg ? 16 : 8;
    const int row = t >> 6, col = t & 63;
    const float pos = pi < nfreq ? (float)row : (float)col;
    const int f = pi < nfreq ? pi : pi - nfreq;
    const float inv = exp2f(-(float)f / (float)nfreq * 13.287712379549449f);
    const float ang = pos * inv;
    const float2 v = make_float2(cosf(ang), sinf(ang));
    if (isg) tg[t * 32 + pi] = v; else tm[t * 16 + pi] = v;
  }
}

DI int gu_row(int n, int half) { return (n >> 7) * 256 + ((n >> 6) & 1) * 128 + ((n >> 5) & 1) * 64 + half * 32 + (n & 31); }
DI void convT_tile(const float* __restrict__ src, int K, int N, u16* __restrict__ dst, int mode, int t, char* smem) {
  float* tile = (float*)smem;
  const int tn = (N + 63) / 64;
  const int tid_ = ltid();
  const int j = tid_ & 63, i0 = tid_ >> 6;
  const int k0 = (t / tn) * 64, n0 = (t % tn) * 64;
  for (int i = i0; i < 64; i += 4) {
    int n = n0 + j;
    tile[i * 65 + j] = n < N ? src[(size_t)(k0 + i) * N + n] : 0.f;
  }
  __syncthreads();
  for (int i = i0; i < 64; i += 4) {
    int n = n0 + i;
    if (n < N) {
      int row = mode == 0 ? n : gu_row(n, mode - 1);
      dst[(size_t)row * K + k0 + j] = f2bf(tile[j * 65 + i]);
    }
  }
  __syncthreads();
}
DI void convT(const float* __restrict__ src, int K, int N, u16* __restrict__ dst, int mode, char* smem) {
  const int tk = K / 64, tn = (N + 63) / 64;
  for (int t = blockIdx.x; t < tk * tn; t += gridDim.x) convT_tile(src, K, N, dst, mode, t, smem);
}

DI void mod_phase(const Params& p, float* __restrict__ mod, char* smem) {
  float* sc = (float*)smem;
  float* red = sc + 9 * 1024;
  const int tid_ = ltid();
  for (int i = tid_; i < 9 * 1024; i += NTHR) {
    float v = i < 8192 ? p.c[i] : p.c_ctx[i - 8192];
    sc[i] = v / (1.f + expf(-v));
  }
  __syncthreads();
  const int lane = tid_ & 63, kp = tid_ >> 6;
  for (int it = blockIdx.x; it < 2 * 144; it += gridDim.x) {
    const int l = it / 144, nb = (it % 144) * 64;
    const float* w = p.ada_w + (size_t)l * 1024 * 9216 + nb + lane;
    float acc[9];
#pragma unroll
    for (int b = 0; b < 9; ++b) acc[b] = 0.f;
    for (int k = kp * 256; k < kp * 256 + 256; ++k) {
      float wv = w[(size_t)k * 9216];
#pragma unroll
      for (int b = 0; b < 9; ++b) acc[b] += sc[b * 1024 + k] * wv;
    }
#pragma unroll
    for (int b = 0; b < 9; ++b) red[(kp * 9 + b) * 64 + lane] = acc[b];
    __syncthreads();
    for (int o = tid_; o < 9 * 64; o += NTHR) {
      int b = o >> 6, ln = o & 63;
      float s = red[(0 * 9 + b) * 64 + ln] + red[(1 * 9 + b) * 64 + ln] + red[(2 * 9 + b) * 64 + ln] + red[(3 * 9 + b) * 64 + ln];
      mod[((size_t)l * 9 + b) * 9216 + nb + ln] = s + p.ada_b[l * 9216 + nb + ln];
    }
    __syncthreads();
  }
}

DI void hyfilt_phase(const Params& p, int l, int L, float* __restrict__ gT, char* smem) {
  float* z = (float*)smem;
  float* h1 = z + 64;
  float* h2 = h1 + 64;
  float* h3 = h2 + 64;
  float* w1s = z + 256;
  float* w2s = w1s + 33 * 64;
  float* w3s = w2s + 64 * 64;
  const float* w4 = p.hy_f_w4 + l * 64 * 512;
  const int tid = ltid();
  for (int i = tid; i < 33 * 64; i += NTHR) w1s[i] = p.hy_f_w1[l * 33 * 64 + i];
  for (int i = tid; i < 64 * 64; i += NTHR) { w2s[i] = p.hy_f_w2[l * 4096 + i]; w3s[i] = p.hy_f_w3[l * 4096 + i]; }
  float b1v = 0.f, b2v = 0.f, b3v = 0.f, frv = 0.f;
  if (tid < 64) { b1v = p.hy_f_b1[l * 64 + tid]; b2v = p.hy_f_b2[l * 64 + tid]; b3v = p.hy_f_b3[l * 64 + tid]; frv = p.hy_f_freq[l * 64 + tid]; }
  const float min_decay = logf(1e-2f) / 1.5f, max_decay = logf(1e-2f) / 0.3f;
  const float delta = fabsf(min_decay + (max_decay - min_decay) * (float)tid / 255.f);
  __syncthreads();
  for (int t = blockIdx.x; t < L; t += gridDim.x) {
    const float t01 = (float)t / (float)(L - 1);
    if (tid < 33) {
      float zz;
      if (tid == 0) zz = t01;
      else {
        int i = (tid - 1) & 15;
        float f = 1e-4f + (float)i * ((15.f - 1e-4f) / 15.f);
        float wang = 6.283185307179586f * (float)t / (float)L;
        zz = tid <= 16 ? cosf(f * wang) : -sinf(f * wang);
      }
      z[tid] = zz;
    }
    __syncthreads();
    if (tid < 64) {
      float a = b1v;
#pragma unroll 11
      for (int i = 0; i < 33; ++i) a += z[i] * w1s[i * 64 + tid];
      h1[tid] = sinf(frv * a);
    }
    __syncthreads();
    if (tid < 64) {
      float a = b2v;
#pragma unroll 16
      for (int i = 0; i < 64; ++i) a += h1[i] * w2s[i * 64 + tid];
      h2[tid] = sinf(frv * a);
    }
    __syncthreads();
    if (tid < 64) {
      float a = b3v;
#pragma unroll 16
      for (int i = 0; i < 64; ++i) a += h2[i] * w3s[i * 64 + tid];
      h3[tid] = sinf(frv * a);
    }
    __syncthreads();
    float af = 0.f, ab = 0.f;
#pragma unroll 8
    for (int i = 0; i < 64; ++i) {
      af += h3[i] * w4[i * 512 + tid];
      ab += h3[i] * w4[i * 512 + 256 + tid];
    }
    const float dec = expf(-t01 * delta);
    af *= dec;
    ab *= dec;
    if (t == 0) gT[(size_t)(L - 1) * 256 + tid] = af + ab;
    else {
      gT[(size_t)(L - 1 + t) * 256 + tid] = af;
      gT[(size_t)(L - 1 - t) * 256 + tid] = ab;
    }
    __syncthreads();
  }
  __syncthreads();
}

DI void adaln_phase(const float* __restrict__ lat, const float* __restrict__ ctxp, const float* __restrict__ gain,
                    const float* __restrict__ modl, int idx, u16* __restrict__ h, bool skip_ctx) {
  const int tid_ = ltid();
  const int wave = tid_ >> 6, lane = tid_ & 63;
  for (int r = blockIdx.x * 4 + wave; r < T; r += gridDim.x * 4) {
    const int b = r / LT, j = r - b * LT;
    if (skip_ctx && j < LC) continue;
    const float* xr = j < LC ? ctxp + ((size_t)(b * LC + j) << 10) : lat + ((size_t)(b * LQ + j - LC) << 10);
    const int bb = j < LC ? 8 : b;
    const float* shift = modl + bb * 9216 + (3 * idx) * 1024;
    const float* scale = shift + 1024;
    float4 v[4];
    float ss = 0.f;
#pragma unroll
    for (int q = 0; q < 4; ++q) {
      v[q] = *(const float4*)(xr + q * 256 + lane * 4);
      ss += v[q].x * v[q].x + v[q].y * v[q].y + v[q].z * v[q].z + v[q].w * v[q].w;
    }
    ss = wave_sum(ss);
    const float rstd = rsqrtf(ss * (1.f / 1024.f) + EPS);
#pragma unroll
    for (int q = 0; q < 4; ++q) {
      const int c = q * 256 + lane * 4;
      float4 g = *(const float4*)(gain + c), sc = *(const float4*)(scale + c), sh = *(const float4*)(shift + c);
      float y0 = v[q].x * rstd * g.x * (1.f + sc.x) + sh.x;
      float y1 = v[q].y * rstd * g.y * (1.f + sc.y) + sh.y;
      float y2 = v[q].z * rstd * g.z * (1.f + sc.z) + sh.z;
      float y3 = v[q].w * rstd * g.w * (1.f + sc.w) + sh.w;
      uint2 o;
      o.x = pack2(y0, y1);
      o.y = pack2(y2, y3);
      *(uint2*)(h + (size_t)r * D + c) = o;
    }
  }
}

DI bool gemm_decode(int t, int mtiles, int ntiles, int mt_off, bool skip_ctx, int& mt, int& nt) {
  const int mtx = mtiles >> 3;
  const int xcd = t & 7, q = t >> 3;
  const int sr = q / (8 * ntiles);
  const int rem = q - sr * 8 * ntiles;
  const int rows_in = min(8, mtx - sr * 8);
  const int sc = rem / (rows_in * 8);
  const int r2 = rem - sc * rows_in * 8;
  const int i = r2 % rows_in, j = r2 / rows_in;
  mt = (sr * 8 + i) * 8 + xcd;
  nt = sc * 8 + j;
  return !(skip_ctx && ((mt + mt_off) % 34) < 2);
}
template <bool PAIRED, class Epi>
DI void gemm_phase(const u16* __restrict__ A, int lda, const u16* __restrict__ Bt, int ldb, int K, int mtiles, int ntiles,
                   int mt_off, bool skip_ctx, char* smem, Epi& epi) {
  u16* As = (u16*)smem;
  u16* Bs = As + 2 * 128 * 72;
  const int tid = ltid(), lane = tid & 63, wave = tid >> 6;
  const int wm = wave >> 1, wn = wave & 1, lr = lane & 31, lh = lane >> 5;
  const int lrow = tid >> 3, lkc = (tid & 7) * 8;
  const int total = mtiles * ntiles, nk = K >> 6;
  uint4 ra00, ra01, ra02, ra03, rb00, rb01, rb02, rb03, ra10, ra11, ra12, ra13, rb10, rb11, rb12, rb13;
  const u16* Agl;
  const u16* Bgl;
#define GEMM_GLOAD(S, kt_)                                            \
  {                                                                   \
    const int k0_ = (kt_) << 6;                                       \
    ra##S##0 = *(const uint4*)(Agl + k0_);                            \
    ra##S##1 = *(const uint4*)(Agl + (size_t)32 * lda + k0_);         \
    ra##S##2 = *(const uint4*)(Agl + (size_t)64 * lda + k0_);         \
    ra##S##3 = *(const uint4*)(Agl + (size_t)96 * lda + k0_);         \
    rb##S##0 = *(const uint4*)(Bgl + k0_);                            \
    rb##S##1 = *(const uint4*)(Bgl + (size_t)32 * ldb + k0_);         \
    rb##S##2 = *(const uint4*)(Bgl + (size_t)64 * ldb + k0_);         \
    rb##S##3 = *(const uint4*)(Bgl + (size_t)96 * ldb + k0_);         \
  }
#define GEMM_LSTORE(S, buf_)                                          \
  {                                                                   \
    u16* ad_ = As + (buf_) * 128 * 72 + lrow * 72 + lkc;              \
    u16* bd_ = Bs + (buf_) * 128 * 72 + lrow * 72 + lkc;              \
    *(uint4*)(ad_) = ra##S##0;                                        \
    *(uint4*)(ad_ + 32 * 72) = ra##S##1;                              \
    *(uint4*)(ad_ + 64 * 72) = ra##S##2;                              \
    *(uint4*)(ad_ + 96 * 72) = ra##S##3;                              \
    *(uint4*)(bd_) = rb##S##0;                                        \
    *(uint4*)(bd_ + 32 * 72) = rb##S##1;                              \
    *(uint4*)(bd_ + 64 * 72) = rb##S##2;                              \
    *(uint4*)(bd_ + 96 * 72) = rb##S##3;                              \
  }
#define GEMM_COMPUTE(buf_)                                                        \
  {                                                                               \
    const u16* as = As + (buf_) * 128 * 72 + (wm * 64 + lr) * 72 + lh * 8;        \
    const u16* bs = Bs + (buf_) * 128 * 72 + (wn * 64 + lr) * 72 + lh * 8;        \
    _Pragma("unroll") for (int ks = 0; ks < 4; ++ks) {                            \
      bf16x8 a0 = *(const bf16x8*)(as + ks * 16);                                 \
      bf16x8 a1 = *(const bf16x8*)(as + 32 * 72 + ks * 16);                       \
      bf16x8 b0 = *(const bf16x8*)(bs + ks * 16);                                 \
      bf16x8 b1 = *(const bf16x8*)(bs + 32 * 72 + ks * 16);                       \
      acc[0][0] = MFMA32(a0, b0, acc[0][0]);                                      \
      acc[0][1] = MFMA32(a0, b1, acc[0][1]);                                      \
      acc[1][0] = MFMA32(a1, b0, acc[1][0]);                                      \
      acc[1][1] = MFMA32(a1, b1, acc[1][1]);                                      \
    }                                                                             \
  }
  int t = blockIdx.x, mt = 0, nt = 0;
  while (t < total && !gemm_decode(t, mtiles, ntiles, mt_off, skip_ctx, mt, nt)) t += gridDim.x;
  if (t < total) {
    Agl = A + (size_t)(mt * 128 + lrow) * lda + lkc;
    Bgl = Bt + (size_t)(nt * 128 + lrow) * ldb + lkc;
    GEMM_GLOAD(0, 0);
  }
  while (t < total) {
    const int m0 = mt * 128, n0 = nt * 128;
    int tn = t + gridDim.x, mtn = 0, ntn = 0;
    while (tn < total && !gemm_decode(tn, mtiles, ntiles, mt_off, skip_ctx, mtn, ntn)) tn += gridDim.x;
    f32x16 acc[2][2];
#pragma unroll
    for (int a = 0; a < 2; ++a)
#pragma unroll
      for (int b = 0; b < 2; ++b)
#pragma unroll
        for (int i = 0; i < 16; ++i) acc[a][b][i] = 0.f;
    GEMM_LSTORE(0, 0);
    __syncthreads();
    if (nk > 1) GEMM_GLOAD(0, 1);
    for (int kt = 0; kt < nk; kt += 2) {
      if (kt + 2 < nk) GEMM_GLOAD(1, kt + 2);
      GEMM_COMPUTE(0);
      if (kt + 1 < nk) GEMM_LSTORE(0, 1);
      __syncthreads();
      if (kt + 1 >= nk) break;
      if (kt + 3 < nk) GEMM_GLOAD(0, kt + 3);
      GEMM_COMPUTE(1);
      if (kt + 2 < nk) GEMM_LSTORE(1, 0);
      __syncthreads();
    }
    if (tn < total) {
      Agl = A + (size_t)(mtn * 128 + lrow) * lda + lkc;
      Bgl = Bt + (size_t)(ntn * 128 + lrow) * ldb + lkc;
      GEMM_GLOAD(0, 0);
    }
    epi.tile(m0);
    if constexpr (PAIRED) {
      float* stg = (float*)smem + wave * 64 * 36;
#pragma unroll
      for (int mi = 0; mi < 2; ++mi)
#pragma unroll
        for (int i = 0; i < 16; ++i) stg[(mi * 32 + crow(i, lh)) * 36 + lr] = epi.combine(acc[mi][0][i], acc[mi][1][i]);
      __syncthreads();
#pragma unroll
      for (int k = 0; k < 8; ++k) {
        const int idx = lane + 64 * k, row = idx >> 3, c4 = idx & 7;
        const float4 v = *(const float4*)(stg + row * 36 + c4 * 4);
        epi.store4(m0 + wm * 64 + row, (n0 >> 1) + wn * 32 + c4 * 4, v);
      }
      __syncthreads();
    } else if constexpr (Epi::kStaged) {
      float* stg = (float*)smem + wave * 64 * 68;
#pragma unroll
      for (int mi = 0; mi < 2; ++mi)
#pragma unroll
        for (int ni = 0; ni < 2; ++ni)
#pragma unroll
          for (int i = 0; i < 16; ++i) stg[(mi * 32 + crow(i, lh)) * 68 + ni * 32 + lr] = acc[mi][ni][i];
      __syncthreads();
#pragma unroll 4
      for (int k = 0; k < 16; ++k) {
        const int idx = lane + 64 * k, row = idx >> 4, c4 = idx & 15;
        const float4 v = *(const float4*)(stg + row * 68 + c4 * 4);
        epi.row4(m0 + wm * 64 + row, n0 + wn * 64 + c4 * 4, v);
      }
      __syncthreads();
    } else {
#pragma unroll
      for (int mi = 0; mi < 2; ++mi) {
#pragma unroll
        for (int gq = 0; gq < 4; ++gq) {
          const int row0 = m0 + wm * 64 + mi * 32 + 8 * gq + 4 * lh;
          if (PAIRED) {
            const int col = (n0 >> 1) + wn * 32 + lr;
#pragma unroll
            for (int e = 0; e < 4; ++e) epi.pair(row0 + e, col, acc[mi][0][4 * gq + e], acc[mi][1][4 * gq + e]);
          } else {
            epi.quad(row0, n0 + wn * 64 + lr, acc[mi][0][4 * gq], acc[mi][0][4 * gq + 1], acc[mi][0][4 * gq + 2], acc[mi][0][4 * gq + 3]);
            epi.quad(row0, n0 + wn * 64 + 32 + lr, acc[mi][1][4 * gq], acc[mi][1][4 * gq + 1], acc[mi][1][4 * gq + 2], acc[mi][1][4 * gq + 3]);
          }
        }
      }
    }
    t = tn; mt = mtn; nt = ntn;
  }
}

template <class Epi>
DI void gemm_gu_phase(const u16* __restrict__ A, const u16* __restrict__ Bt, int mtiles, bool skip_ctx, char* smem, Epi& epi) {
  constexpr int lda = D, ldb = D, K = D, ntiles = 22, RS = 40;
  u16* As = (u16*)smem;
  u16* Bs = As + 2 * 128 * RS;
  const int tid = ltid(), lane = tid & 63, wave = tid >> 6;
  const int wm = wave >> 1, wn = wave & 1, lr = lane & 31, lh = lane >> 5;
  const int lrow = tid >> 2, lkc = (tid & 3) * 8;
  const int total = mtiles * ntiles, nk = K >> 5;
  uint4 ra00, ra01, rb00, rb01, rb02, rb03, ra10, ra11, rb10, rb11, rb12, rb13;
  const u16* Agl;
  const u16* Bgl;
#define GU_GLOAD(S, kt_)                                              \
  {                                                                   \
    const int k0_ = (kt_) << 5;                                       \
    ra##S##0 = *(const uint4*)(Agl + k0_);                            \
    ra##S##1 = *(const uint4*)(Agl + (size_t)64 * lda + k0_);         \
    rb##S##0 = *(const uint4*)(Bgl + k0_);                            \
    rb##S##1 = *(const uint4*)(Bgl + (size_t)64 * ldb + k0_);         \
    rb##S##2 = *(const uint4*)(Bgl + (size_t)128 * ldb + k0_);        \
    rb##S##3 = *(const uint4*)(Bgl + (size_t)192 * ldb + k0_);        \
  }
#define GU_LSTORE(S, buf_)                                            \
  {                                                                   \
    u16* ad_ = As + (buf_) * 128 * RS + lrow * RS + lkc;              \
    u16* bd_ = Bs + (buf_) * 256 * RS + lrow * RS + lkc;              \
    *(uint4*)(ad_) = ra##S##0;                                        \
    *(uint4*)(ad_ + 64 * RS) = ra##S##1;                              \
    *(uint4*)(bd_) = rb##S##0;                                        \
    *(uint4*)(bd_ + 64 * RS) = rb##S##1;                              \
    *(uint4*)(bd_ + 128 * RS) = rb##S##2;                             \
    *(uint4*)(bd_ + 192 * RS) = rb##S##3;                             \
  }
#define GU_COMPUTE(buf_)                                                          \
  {                                                                               \
    const u16* as = As + (buf_) * 128 * RS + (wm * 64 + lr) * RS + lh * 8;        \
    const u16* bs = Bs + (buf_) * 256 * RS + (wn * 128 + lr) * RS + lh * 8;       \
    _Pragma("unroll") for (int ks = 0; ks < 2; ++ks) {                            \
      bf16x8 a0 = *(const bf16x8*)(as + ks * 16);                                 \
      bf16x8 a1 = *(const bf16x8*)(as + 32 * RS + ks * 16);                       \
      bf16x8 b0 = *(const bf16x8*)(bs + ks * 16);                                 \
      bf16x8 b1 = *(const bf16x8*)(bs + 32 * RS + ks * 16);                       \
      bf16x8 b2 = *(const bf16x8*)(bs + 64 * RS + ks * 16);                       \
      bf16x8 b3 = *(const bf16x8*)(bs + 96 * RS + ks * 16);                       \
      acc[0][0] = MFMA32(a0, b0, acc[0][0]);                                      \
      acc[0][1] = MFMA32(a0, b1, acc[0][1]);                                      \
      acc[0][2] = MFMA32(a0, b2, acc[0][2]);                                      \
      acc[0][3] = MFMA32(a0, b3, acc[0][3]);                                      \
      acc[1][0] = MFMA32(a1, b0, acc[1][0]);                                      \
      acc[1][1] = MFMA32(a1, b1, acc[1][1]);                                      \
      acc[1][2] = MFMA32(a1, b2, acc[1][2]);                                      \
      acc[1][3] = MFMA32(a1, b3, acc[1][3]);                                      \
    }                                                                             \
  }
  int t = blockIdx.x, mt = 0, nt = 0;
  while (t < total && !gemm_decode(t, mtiles, ntiles, 0, skip_ctx, mt, nt)) t += gridDim.x;
  if (t < total) {
    Agl = A + (size_t)(mt * 128 + lrow) * lda + lkc;
    Bgl = Bt + (size_t)(nt * 256 + lrow) * ldb + lkc;
    GU_GLOAD(0, 0);
  }
  while (t < total) {
    const int m0 = mt * 128, n0 = nt * 256;
    int tn = t + gridDim.x, mtn = 0, ntn = 0;
    while (tn < total && !gemm_decode(tn, mtiles, ntiles, 0, skip_ctx, mtn, ntn)) tn += gridDim.x;
    f32x16 acc[2][4];
#pragma unroll
    for (int a = 0; a < 2; ++a)
#pragma unroll
      for (int b = 0; b < 4; ++b)
#pragma unroll
        for (int i = 0; i < 16; ++i) acc[a][b][i] = 0.f;
    GU_LSTORE(0, 0);
    __syncthreads();
    GU_GLOAD(0, 1);
    for (int kt = 0; kt < nk; kt += 2) {
      if (kt + 2 < nk) GU_GLOAD(1, kt + 2);
      GU_COMPUTE(0);
      GU_LSTORE(0, 1);
      __syncthreads();
      if (kt + 3 < nk) GU_GLOAD(0, kt + 3);
      GU_COMPUTE(1);
      if (kt + 2 < nk) GU_LSTORE(1, 0);
      __syncthreads();
    }
    if (tn < total) {
      Agl = A + (size_t)(mtn * 128 + lrow) * lda + lkc;
      Bgl = Bt + (size_t)(ntn * 256 + lrow) * ldb + lkc;
      GU_GLOAD(0, 0);
    }
    {
      float* stg = (float*)smem + wave * 64 * 68;
#pragma unroll
      for (int mi = 0; mi < 2; ++mi)
#pragma unroll
        for (int pi = 0; pi < 2; ++pi)
#pragma unroll
          for (int i = 0; i < 16; ++i)
            stg[(mi * 32 + crow(i, lh)) * 68 + pi * 32 + lr] = epi.combine(acc[mi][2 * pi][i], acc[mi][2 * pi + 1][i]);
      __syncthreads();
#pragma unroll 4
      for (int k = 0; k < 16; ++k) {
        const int idx = lane + 64 * k, row = idx >> 4, c4 = idx & 15;
        const float4 v = *(const float4*)(stg + row * 68 + c4 * 4);
        epi.store4(m0 + wm * 64 + row, (n0 >> 1) + wn * 64 + c4 * 4, v);
      }
      __syncthreads();
    }
    t = tn; mt = mtn; nt = ntn;
  }
}

#define EPI_DEFAULT_QUAD                                                   \
  static constexpr bool kStaged = false;                                   \
  DI void row4(int, int, float4) const {}                                  \
  DI void tile(int) {}                                                     \
  DI void quad(int row0, int col, float a, float b, float c, float d) const { \
    (*this)(row0, col, a);                                                 \
    (*this)(row0 + 1, col, b);                                             \
    (*this)(row0 + 2, col, c);                                             \
    (*this)(row0 + 3, col, d);                                             \
  }
struct EpiGU {
  u16* G;
  DI float combine(float g, float u) const { return g * __builtin_amdgcn_rcpf(1.f + __expf(-g)) * u; }
  DI void store4(int row, int col, float4 v) const {
    uint2 w;
    w.x = pack2(v.x, v.y);
    w.y = pack2(v.z, v.w);
    *(uint2*)(G + (size_t)row * DFF + col) = w;
  }
  DI void pair(int row, int col, float g, float u) const {
    float s = g / (1.f + __expf(-g));
    G[(size_t)row * DFF + col] = f2bf(s * u);
  }
  DI void operator()(int, int, float) const {}
  EPI_DEFAULT_QUAD
};
struct EpiRes {
  const float* lat_in; const float* ctx_in; float* lat_out; float* ctx_out; const float* modl; int gate_chunk; float coef;
  const float* tin; float* tout; const float* gate; int tm0;
  static constexpr bool kStaged = true;
  DI void row4(int row, int col, float4 v) const {
    const size_t o = ((size_t)(row - tm0) << 10) + col;
    const float4 x = *(const float4*)(tin + o);
    const float4 g = *(const float4*)(gate + col);
    float4 y;
    y.x = x.x + coef * g.x * v.x;
    y.y = x.y + coef * g.y * v.y;
    y.z = x.z + coef * g.z * v.z;
    y.w = x.w + coef * g.w * v.w;
    *(float4*)(tout + o) = y;
  }
  DI void tile(int m0) {
    const int b = m0 / LT, j = m0 - b * LT;
    const bool isc = j < LC;
    const size_t off = isc ? (((size_t)(b * LC + j)) << 10) : (((size_t)(b * LQ + j - LC)) << 10);
    tin = (isc ? ctx_in : lat_in) + off;
    tout = (isc ? ctx_out : lat_out) + off;
    gate = modl + (isc ? 8 : b) * 9216 + gate_chunk * 1024;
    tm0 = m0;
  }
  DI void operator()(int row, int col, float v) const {
    const size_t o = ((size_t)(row - tm0) << 10) + col;
    tout[o] = tin[o] + coef * gate[col] * v;
  }
  DI void pair(int, int, float, float) const {}
  DI void quad(int row0, int col, float a, float b, float c, float d) const {
    const float gc = coef * gate[col];
    const size_t o = ((size_t)(row0 - tm0) << 10) + col;
    tout[o] = tin[o] + gc * a;
    tout[o + 1024] = tin[o + 1024] + gc * b;
    tout[o + 2048] = tin[o + 2048] + gc * c;
    tout[o + 3072] = tin[o + 3072] + gc * d;
  }
};
struct EpiStore {
  u16* C; int ldc; int N;
  DI void operator()(int row, int col, float v) const { if (col < N) C[(size_t)row * ldc + col] = f2bf(v); }
  DI void pair(int, int, float, float) const {}
  EPI_DEFAULT_QUAD
};
struct EpiWin {
  u16* p; u16* pT;
  static constexpr bool kStaged = false;
  DI void row4(int, int, float4) const {}
  DI void tile(int) {}
  DI void quad(int row0, int col, float a, float b, float c, float d) const {
    if (col < HYC) {
      uint2 w;
      w.x = pack2(a, b);
      w.y = pack2(c, d);
      *(uint2*)(pT + (size_t)col * TG + row0) = w;
    } else if (col < DIN) {
      u16* q = p + (size_t)row0 * DINP + (col - HYC);
      q[0] = f2bf(a);
      q[DINP] = f2bf(b);
      q[2 * DINP] = f2bf(c);
      q[3 * DINP] = f2bf(d);
    }
  }
  DI void pair(int, int, float, float) const {}
};
struct EpiLoraW {
  u16* C; const float* w0;
  DI void operator()(int row, int col, float v) const {
    float zz = -(w0[col] + v);
    float sp = fmaxf(zz, 0.f) + log1pf(expf(-fabsf(zz)));
    C[(size_t)row * 256 + col] = f2bf(-expm1f(-expf(-sp - 0.5f)));
  }
  DI void pair(int, int, float, float) const {}
  EPI_DEFAULT_QUAD
};
struct EpiLoraA {
  u16* C; const float* a0;
  DI void operator()(int row, int col, float v) const { C[(size_t)row * 256 + col] = f2bf(sigmoidf_(a0[col] + v)); }
  DI void pair(int, int, float, float) const {}
  EPI_DEFAULT_QUAD
};

struct MixBufs {
  u16 *p, *pt, *u, *qg, *kg, *vtg, *cqn, *ckvn, *qup, *kvup, *qm, *km, *vtm, *rr, *rk, *rv, *rkk, *lwf, *lwb, *laf, *lab, *lg, *ef, *eb, *af, *ab, *gg;
  float *yf, *yb;
};
DI MixBufs mixbufs(char* big, int g) {
  MixBufs m;
  m.p = (u16*)(big + M_P); m.pt = (u16*)(big + M_PT); m.u = (u16*)(big + M_U);
  m.cqn = (u16*)(big + M_CQN); m.ckvn = (u16*)(big + M_CKVN); m.qup = (u16*)(big + M_QUP);
  m.kvup = (u16*)(big + M_KVUP); m.qm = (u16*)(big + M_QM); m.km = (u16*)(big + M_KM); m.vtm = (u16*)(big + M_VTM);
  m.lwf = (u16*)(big + M_LWF); m.lwb = (u16*)(big + M_LWB); m.laf = (u16*)(big + M_LAF); m.lab = (u16*)(big + M_LAB);
  m.lg = (u16*)(big + M_LG);
  char* sc = big + M_SCAN + (size_t)g * SCAN_STRIDE;
  m.rr = (u16*)(sc + 0 * SZ_SC); m.rk = (u16*)(sc + 1 * SZ_SC); m.rv = (u16*)(sc + 2 * SZ_SC); m.rkk = (u16*)(sc + 3 * SZ_SC);
  m.ef = (u16*)(sc + 4 * SZ_SC); m.eb = (u16*)(sc + 5 * SZ_SC); m.af = (u16*)(sc + 6 * SZ_SC); m.ab = (u16*)(sc + 7 * SZ_SC);
  m.gg = (u16*)(sc + 8 * SZ_SC);
  m.qg = (u16*)(sc + 9 * SZ_SC); m.kg = (u16*)(sc + 10 * SZ_SC); m.vtg = m.kg + (size_t)TG * 128;
  m.yf = (float*)(big + M_P) + (size_t)g * 2 * TG * 256;
  m.yb = m.yf + (size_t)TG * 256;
  return m;
}

DI void prep_phase(const Params& p, int l, int g, const MixBufs& m, const float2* __restrict__ ropeg, char* smem) {
  const int tid = ltid(), lane = tid & 63, wave = tid >> 6;
  float muv[18];
#pragma unroll
  for (int q = 0; q < 18; ++q) {
    const int crel = q < 12 ? (q % 3) * 256 + (q / 3) * 64 + lane : 768 + (q - 12) * 64 + lane;
    muv[q] = p.rw_mu[l * 1152 + crel];
  }
  float kkw[4], cqg[4], ckg[2];
#pragma unroll
  for (int hd = 0; hd < 4; ++hd) kkw[hd] = p.rw_k_k[l * 256 + hd * 64 + lane];
#pragma unroll
  for (int q = 0; q < 4; ++q) cqg[q] = p.mla_cq_norm[l * 256 + lane + 64 * q];
#pragma unroll
  for (int q = 0; q < 2; ++q) ckg[q] = p.mla_ckv_norm[l * 128 + lane + 64 * q];
  const float gq_ = p.gqa_q_norm[l * 64 + lane], gk_ = p.gqa_k_norm[l * 64 + lane];
  for (int rl = blockIdx.x * 4 + wave; rl < TG; rl += gridDim.x * 4) {
    const int r = g * TG + rl;
    const int b = r / LT, j = r - b * LT, bl = b - g * BG;
    const bool lat = j >= LC;
    const bool hp = lat ? (j > LC) : (j > 0);
    const bool hn = lat ? (j < LT - 1) : (j < LC - 1);
    const u16* pc = m.p + (size_t)rl * DINP;
    const u16* pp = hp ? pc - DINP : pc;
    const u16* pn = hn ? pc + DINP : pc;
    float ts[18];
#pragma unroll
    for (int q = 0; q < 18; ++q) {
      const int crel = q < 12 ? (q % 3) * 256 + (q / 3) * 64 + lane : 768 + (q - 12) * 64 + lane;
      const int c = 1696 - HYC + crel;
      const float u0 = bf2f(pc[c]);
      const float up = bf2f(pp[c]), un = bf2f(pn[c]);
      const float nb = (hp ? up : 0.f) + (hn ? un : 0.f);
      ts[q] = u0 + muv[q] * (0.5f * nb - u0);
    }
    float cq[4], ckv[2], gv[6];
    u16 vraw[2];
#pragma unroll
    for (int q = 0; q < 4; ++q) cq[q] = bf2f(pc[1280 - HYC + lane + 64 * q]);
#pragma unroll
    for (int q = 0; q < 2; ++q) ckv[q] = bf2f(pc[1536 - HYC + lane + 64 * q]);
#pragma unroll
    for (int hh = 0; hh < 6; ++hh) gv[hh] = bf2f(pc[hh * 64 + lane]);
#pragma unroll
    for (int kvh = 0; kvh < 2; ++kvh) vraw[kvh] = pc[1152 - HYC + kvh * 64 + lane];
    const float2 cs = ropeg[(size_t)(lat ? j - LC : 0) * 32 + (lane >> 1)];
#pragma unroll
    for (int hd = 0; hd < 4; ++hd) {
      const int c = hd * 64 + lane;
      const float sr = ts[hd * 3 + 0], sk = ts[hd * 3 + 1], sv = ts[hd * 3 + 2];
      m.rr[(size_t)rl * 256 + c] = f2bf(sr);
      m.rk[(size_t)rl * 256 + c] = f2bf(sk);
      m.rv[(size_t)rl * 256 + c] = f2bf(sv);
      const float kx = sk * kkw[hd];
      const float ss = wave_sum(kx * kx);
      m.rkk[(size_t)rl * 256 + c] = f2bf(kx / fmaxf(sqrtf(ss), 1e-12f));
    }
    m.lwf[(size_t)rl * 64 + lane] = f2bf(tanhf(ts[12]));
    m.lwb[(size_t)rl * 64 + lane] = f2bf(tanhf(ts[13]));
    m.laf[(size_t)rl * 64 + lane] = f2bf(ts[14]);
    m.lab[(size_t)rl * 64 + lane] = f2bf(ts[15]);
    m.lg[(size_t)rl * 128 + lane] = f2bf(sigmoidf_(ts[16]));
    m.lg[(size_t)rl * 128 + 64 + lane] = f2bf(sigmoidf_(ts[17]));
    {
      float s1 = 0.f, s2 = 0.f;
#pragma unroll
      for (int q = 0; q < 4; ++q) s1 += cq[q] * cq[q];
#pragma unroll
      for (int q = 0; q < 2; ++q) s2 += ckv[q] * ckv[q];
      s1 = wave_sum(s1);
      s2 = wave_sum(s2);
      const float r1 = rsqrtf(s1 * (1.f / 256.f) + EPS), r2 = rsqrtf(s2 * (1.f / 128.f) + EPS);
#pragma unroll
      for (int q = 0; q < 4; ++q) m.cqn[(size_t)rl * 256 + lane + 64 * q] = f2bf(cq[q] * r1 * cqg[q]);
#pragma unroll
      for (int q = 0; q < 2; ++q) m.ckvn[(size_t)rl * 128 + lane + 64 * q] = f2bf(ckv[q] * r2 * ckg[q]);
    }
#pragma unroll
    for (int hh = 0; hh < 6; ++hh) {
      float val = gv[hh];
      const float ss = wave_sum(val * val);
      val = val * rsqrtf(ss * (1.f / 64.f) + EPS) * (hh < 4 ? gq_ : gk_);
      const float other = __shfl_xor(val, 1);
      if (lat) val = (lane & 1) ? other * cs.y + val * cs.x : val * cs.x - other * cs.y;
      if (hh < 4) m.qg[(size_t)rl * 256 + hh * 64 + lane] = f2bf(val);
      else m.kg[(size_t)rl * 128 + (hh - 4) * 64 + lane] = f2bf(val);
    }
#pragma unroll
    for (int kvh = 0; kvh < 2; ++kvh) m.vtg[((size_t)(bl * 2 + kvh) * 64 + lane) * LT + j] = vraw[kvh];
  }
}

DI void mla_fin_phase(const Params& p, int l, int g, const MixBufs& m, const float2* __restrict__ ropem) {
  const int tid = ltid(), lane = tid & 63, wave = tid >> 6;
  const float qn0 = p.mla_q_norm[l * 96 + lane], kn0 = p.mla_k_norm[l * 96 + lane];
  const float qn1 = lane < 32 ? p.mla_q_norm[l * 96 + 64 + lane] : 0.f;
  const float kn1 = lane < 32 ? p.mla_k_norm[l * 96 + 64 + lane] : 0.f;
#pragma unroll 2
  for (int rl = blockIdx.x * 4 + wave; rl < TG; rl += gridDim.x * 4) {
    const int r = g * TG + rl;
    const int b = r / LT, j = r - b * LT, bl = b - g * BG;
    const bool lat = j >= LC;
    const u16* qrow = m.qup + (size_t)rl * 384;
    const u16* kvrow = m.kvup + (size_t)rl * 512;
    float q0[4], q1[4], k0[4];
    u16 vraw[4];
    const float kr = lane < 32 ? bf2f(m.p[(size_t)rl * DINP + 1664 - HYC + lane]) : 0.f;
    const float2 cs = ropem[(size_t)(lat ? j - LC : 0) * 16 + ((lane & 31) >> 1)];
#pragma unroll
    for (int hd = 0; hd < 4; ++hd) {
      q0[hd] = bf2f(qrow[hd * 96 + lane]);
      q1[hd] = lane < 32 ? bf2f(qrow[hd * 96 + 64 + lane]) : 0.f;
      k0[hd] = bf2f(kvrow[hd * 128 + lane]);
      vraw[hd] = kvrow[hd * 128 + 64 + lane];
    }
#pragma unroll
    for (int hd = 0; hd < 4; ++hd) {
      const float sq = wave_sum(q0[hd] * q0[hd] + q1[hd] * q1[hd]);
      const float sk = wave_sum(k0[hd] * k0[hd] + kr * kr);
      const float rq = rsqrtf(sq * (1.f / 96.f) + EPS), rk = rsqrtf(sk * (1.f / 96.f) + EPS);
      const float yq0 = q0[hd] * rq * qn0, yk0 = k0[hd] * rk * kn0;
      float yq1 = q1[hd] * rq * qn1, yk1 = kr * rk * kn1;
      const float oq = __shfl_xor(yq1, 1), ok = __shfl_xor(yk1, 1);
      if (lat) {
        yq1 = (lane & 1) ? oq * cs.y + yq1 * cs.x : yq1 * cs.x - oq * cs.y;
        yk1 = (lane & 1) ? ok * cs.y + yk1 * cs.x : yk1 * cs.x - ok * cs.y;
      }
      u16* dq = m.qm + (size_t)rl * 384 + hd * 96;
      u16* dk = m.km + (size_t)rl * 384 + hd * 96;
      dq[lane] = f2bf(yq0);
      dk[lane] = f2bf(yk0);
      if (lane < 32) {
        dq[64 + lane] = f2bf(yq1);
        dk[64 + lane] = f2bf(yk1);
      }
      m.vtm[((size_t)(bl * 4 + hd) * 64 + lane) * LT + j] = vraw[hd];
    }
  }
}

template <int DQK, int QT>
DI void attn_item(const u16* __restrict__ q, int ldq, const u16* __restrict__ k, int ldk, const u16* __restrict__ vT,
                  u16* __restrict__ out, int ldo, int nkeys, float sl2, float sh2, char* smem) {
  constexpr int KS = DQK + 8;
  constexpr int NKS = DQK / 16;
  constexpr int KCH = DQK / 8;
  constexpr int KPT = 64 * KCH / NTHR;
  u16* Ks = (u16*)smem;
  u16* Vs = Ks + 2 * 64 * KS;
  const int tid = ltid(), lane = tid & 63, wave = tid >> 6, lr = lane & 31, lh = lane >> 5;
  bf16x8 qf[QT][NKS];
#pragma unroll
  for (int qt = 0; qt < QT; ++qt)
#pragma unroll
    for (int ks = 0; ks < NKS; ++ks)
      qf[qt][ks] = *(const bf16x8*)(q + (size_t)(wave * 32 * QT + qt * 32 + lr) * ldq + ks * 16 + lh * 8);
  f32x16 o[QT][2];
#pragma unroll
  for (int a = 0; a < QT; ++a)
#pragma unroll
    for (int b = 0; b < 2; ++b)
#pragma unroll
      for (int i = 0; i < 16; ++i) o[a][b][i] = 0.f;
  float lsum[QT];
#pragma unroll
  for (int a = 0; a < QT; ++a) lsum[a] = 0.f;
  uint4 rk[KPT], rv[2];
#define ATT_GLOAD(key0)                                                                   \
  {                                                                                       \
    _Pragma("unroll") for (int i = 0; i < KPT; ++i) {                                     \
      const int id = tid + NTHR * i, row = id / KCH, ch = id - row * KCH;                 \
      rk[i] = *(const uint4*)(k + (size_t)((key0) + row) * ldk + ch * 8);                 \
    }                                                                                     \
    _Pragma("unroll") for (int i = 0; i < 2; ++i) {                                       \
      const int id = tid + NTHR * i, row = id >> 3, ch = id & 7;                          \
      rv[i] = *(const uint4*)(vT + (size_t)row * LT + (key0) + ch * 8);                   \
    }                                                                                     \
  }
#define ATT_LSTORE(buf_)                                                                  \
  {                                                                                       \
    _Pragma("unroll") for (int i = 0; i < KPT; ++i) {                                     \
      const int id = tid + NTHR * i, row = id / KCH, ch = id - row * KCH;                 \
      *(uint4*)(Ks + (buf_) * 64 * KS + row * KS + ch * 8) = rk[i];                       \
    }                                                                                     \
    _Pragma("unroll") for (int i = 0; i < 2; ++i) {                                       \
      const int id = tid + NTHR * i, row = id >> 3, ch = id & 7;                          \
      *(uint4*)(Vs + (buf_) * 64 * 72 + row * 72 + ch * 8) = rv[i];                       \
    }                                                                                     \
  }
  ATT_GLOAD(0);
  ATT_LSTORE(0);
  __syncthreads();
  const int nkt = nkeys >> 6;
  for (int kt = 0; kt < nkt; ++kt) {
    const int buf = kt & 1;
    if (kt + 1 < nkt) ATT_GLOAD((kt + 1) << 6);
    const u16* kb = Ks + buf * 64 * KS;
    const u16* vb = Vs + buf * 64 * 72;
#pragma unroll
    for (int half = 0; half < 2; ++half) {
      f32x16 s[QT];
#pragma unroll
      for (int qt = 0; qt < QT; ++qt)
#pragma unroll
        for (int i = 0; i < 16; ++i) s[qt][i] = 0.f;
      bf16x8 kf[NKS];
#pragma unroll
      for (int ks = 0; ks < NKS; ++ks) kf[ks] = *(const bf16x8*)(kb + (half * 32 + lr) * KS + ks * 16 + lh * 8);
#pragma unroll
      for (int ks = 0; ks < NKS; ++ks) {
#pragma unroll
        for (int qt = 0; qt < QT; ++qt) s[qt] = MFMA32(kf[ks], qf[qt][ks], s[qt]);
      }
#pragma unroll
      for (int qt = 0; qt < QT; ++qt)
#pragma unroll
        for (int i = 0; i < 16; ++i) {
          float pv = __builtin_amdgcn_exp2f(s[qt][i] * sl2 - sh2);
          lsum[qt] += pv;
          s[qt][i] = pv;
        }
#pragma unroll
      for (int st = 0; st < 2; ++st) {
        bf16x8 pb[QT];
#pragma unroll
        for (int qt = 0; qt < QT; ++qt) {
          uint4 w;
          w.x = pack2(s[qt][8 * st + 0], s[qt][8 * st + 1]);
          w.y = pack2(s[qt][8 * st + 2], s[qt][8 * st + 3]);
          w.z = pack2(s[qt][8 * st + 4], s[qt][8 * st + 5]);
          w.w = pack2(s[qt][8 * st + 6], s[qt][8 * st + 7]);
          pb[qt] = __builtin_bit_cast(bf16x8, w);
        }
        bf16x8 vf[2];
#pragma unroll
        for (int mt = 0; mt < 2; ++mt) {
          const u16* vp = vb + (mt * 32 + lr) * 72 + half * 32 + st * 16 + lh * 4;
          uint2 v0 = *(const uint2*)(vp);
          uint2 v1 = *(const uint2*)(vp + 8);
          uint4 w;
          w.x = v0.x; w.y = v0.y; w.z = v1.x; w.w = v1.y;
          vf[mt] = __builtin_bit_cast(bf16x8, w);
        }
#pragma unroll
        for (int mt = 0; mt < 2; ++mt) {
#pragma unroll
          for (int qt = 0; qt < QT; ++qt) o[qt][mt] = MFMA32(vf[mt], pb[qt], o[qt][mt]);
        }
      }
    }
    if (kt + 1 < nkt) ATT_LSTORE(buf ^ 1);
    __syncthreads();
  }
#pragma unroll
  for (int qt = 0; qt < QT; ++qt) {
    float tot = lsum[qt] + __shfl_xor(lsum[qt], 32);
    float inv = 1.f / tot;
    const int row = wave * 32 * QT + qt * 32 + lr;
#pragma unroll
    for (int mt = 0; mt < 2; ++mt)
#pragma unroll
      for (int gq = 0; gq < 4; ++gq) {
        uint2 w;
        w.x = pack2(o[qt][mt][4 * gq + 0] * inv, o[qt][mt][4 * gq + 1] * inv);
        w.y = pack2(o[qt][mt][4 * gq + 2] * inv, o[qt][mt][4 * gq + 3] * inv);
        *(uint2*)(out + (size_t)row * ldo + mt * 32 + 8 * gq + 4 * lh) = w;
      }
  }
}

DI void hyena_pass(const Params& p, int l, const MixBufs& m, const float* __restrict__ gT, int L, int segoff, int c, char* smem) {
  const int RS = L + 16, US = L + 16;
  unsigned* Rc = (unsigned*)smem;
  u16* U = (u16*)(smem + (size_t)2 * RS * 4);
  const int tid = ltid(), lane = tid & 63, wave = tid >> 6;
  for (int d = tid; d < L; d += NTHR) {
    const int q = 2 * d;
    const float r0 = gT[(size_t)(2 * L - 2 - q) * 256 + c];
    const float r1 = (q + 1 <= 2 * L - 2) ? gT[(size_t)(2 * L - 3 - q) * 256 + c] : 0.f;
    const float r2 = (q + 2 <= 2 * L - 2) ? gT[(size_t)(2 * L - 4 - q) * 256 + c] : 0.f;
    Rc[d] = pack2(r0, r1);
    Rc[RS + d] = pack2(r1, r2);
  }
  const float* cw = p.hy_conv_w + l * 3 * 768;
  const float* cb = p.hy_conv_b + l * 768;
  {
    const float w0a = cw[c], w1a = cw[768 + c], w2a = cw[1536 + c], ba = cb[c];
    const float w0v = cw[512 + c], w1v = cw[768 + 512 + c], w2v = cw[1536 + 512 + c], bv = cb[512 + c];
    for (int b = 0; b < BG; ++b) {
      const u16* x1p = m.pt + (size_t)c * TG + b * LT + segoff;
      const u16* vp = m.pt + (size_t)(512 + c) * TG + b * LT + segoff;
      for (int t = tid; t < L; t += NTHR) {
        float x1 = bf2f(x1p[t]) * w1a + ba;
        float vv = bf2f(vp[t]) * w1v + bv;
        if (t > 0) { x1 += bf2f(x1p[t - 1]) * w0a; vv += bf2f(vp[t - 1]) * w0v; }
        if (t < L - 1) { x1 += bf2f(x1p[t + 1]) * w2a; vv += bf2f(vp[t + 1]) * w2v; }
        U[b * US + t] = f2bf(x1 * vv);
      }
    }
  }
  __syncthreads();
  const int i = lane & 31, h = lane >> 5, bn = i & 3, mb = i >> 2;
  const int par = (L - 1 - i) & 1;
  const float bias = p.hy_bias[l * 256 + c];
  const float w0x = cw[256 + c], w1x = cw[768 + 256 + c], w2x = cw[1536 + 256 + c], bx = cb[256 + c];
  const int nsteps = (L + 208) / 16 + 1;
  for (int sp = wave; sp < L / 256; sp += 4) {
    const int T0 = sp * 256;
    f32x16 acc;
#pragma unroll
    for (int r = 0; r < 16; ++r) acc[r] = 0.f;
    const int delta0 = T0 + 224;
    const int q0 = (L - 1) - delta0 - i + 8 * h;
    const unsigned* ap = Rc + par * RS + (q0 >> 1);
    int s0 = T0 + 32 * mb - delta0;
    const u16* bp = U + bn * US + s0 + 8 * h;
#pragma unroll 2
    for (int st = 0; st < nsteps; ++st) {
      uint4 aw;
      aw.x = ap[0]; aw.y = ap[1]; aw.z = ap[2]; aw.w = ap[3];
      uint4 bw = make_uint4(0u, 0u, 0u, 0u);
      if (s0 >= 0 && s0 <= L - 16) bw = *(const uint4*)bp;
      acc = MFMA32(__builtin_bit_cast(bf16x8, aw), __builtin_bit_cast(bf16x8, bw), acc);
      ap += 8;
      s0 += 16;
      bp += 16;
    }
    const u16* x2p = m.pt + (size_t)(256 + c) * TG + bn * LT + segoff;
    u16* yp = m.u + (size_t)c * TG + bn * LT + segoff;
#pragma unroll
    for (int gq = 0; gq < 4; ++gq) {
      const int t4 = T0 + 32 * mb + 8 * gq + 4 * h;
      float e[6];
#pragma unroll
      for (int k = 0; k < 6; ++k) {
        const int tt = t4 - 1 + k;
        e[k] = (tt >= 0 && tt < L) ? bf2f(x2p[tt]) : 0.f;
      }
      const uint2 uu = *(const uint2*)(U + bn * US + t4);
      const float u0 = bflo_(uu.x), u1 = bfhi_(uu.x), u2 = bflo_(uu.y), u3 = bfhi_(uu.y);
      const float y0 = (e[0] * w0x + e[1] * w1x + e[2] * w2x + bx) * (acc[4 * gq + 0] + u0 * bias);
      const float y1 = (e[1] * w0x + e[2] * w1x + e[3] * w2x + bx) * (acc[4 * gq + 1] + u1 * bias);
      const float y2 = (e[2] * w0x + e[3] * w1x + e[4] * w2x + bx) * (acc[4 * gq + 2] + u2 * bias);
      const float y3 = (e[3] * w0x + e[4] * w1x + e[5] * w2x + bx) * (acc[4 * gq + 3] + u3 * bias);
      uint2 w;
      w.x = pack2(y0, y1);
      w.y = pack2(y2, y3);
      *(uint2*)(yp + t4) = w;
    }
  }
  __syncthreads();
}

#define DPP_ROR(v, n) __builtin_bit_cast(float, __builtin_amdgcn_update_dpp(0, __builtin_bit_cast(int, (v)), 0x120 + (n), 0xf, 0xf, true))
DI float row_allsum(float v) {
  v += DPP_ROR(v, 8);
  v += DPP_ROR(v, 4);
  v += DPP_ROR(v, 2);
  v += DPP_ROR(v, 1);
  return v;
}
DI float bflo(unsigned w) { return __uint_as_float(w << 16); }
DI float bfhi(unsigned w) { return __uint_as_float(w & 0xffff0000u); }
DI void scan_item(const Params& p, int l, const MixBufs& m, int bl, int hd, int dir, int rq, char* smem) {
  constexpr int TC = 16;
  constexpr int NCH = LT / TC;
  constexpr int BUF = 5 * TC * 64 + TC * 16;
  float* sbase = (float*)smem;
  float* sy = sbase + 2 * BUF;
  const int tid = ltid(), lane = tid & 63, wave = tid >> 6;
  const int kq = lane & 15, rloc = wave * 4 + (lane >> 4);
  const u16* eD = dir ? m.eb : m.ef;
  const u16* aD = dir ? m.ab : m.af;
  float* yD = dir ? m.yb : m.yf;
  const size_t rbase = (size_t)bl * LT;
  const int ss = tid >> 4, su = tid & 15, sc = su & 7;
  float kav[8];
#pragma unroll
  for (int i = 0; i < 8; ++i) kav[i] = p.rw_k_a[l * 256 + hd * 64 + sc * 8 + i];
  uint4 g0, g1, g2;
  g2.x = g2.y = g2.z = g2.w = 0u;
#define SCAN_JMAP(i) (dir ? ((i) < LC ? LC - 1 - (i) : LT - 1 - ((i) - LC)) : (i))
#define SCAN_GLOAD(i0)                                                                         \
  {                                                                                            \
    const int ii_ = (i0) + ss;                                                                 \
    const int j_ = SCAN_JMAP(ii_);                                                             \
    const size_t o_ = (rbase + j_) * 256 + hd * 64 + sc * 8;                                   \
    if (su < 8) {                                                                              \
      g0 = *(const uint4*)(m.rkk + o_);                                                        \
      g1 = *(const uint4*)(aD + o_);                                                           \
      g2 = *(const uint4*)(m.rk + o_);                                                         \
    } else {                                                                                   \
      g0 = *(const uint4*)(eD + o_);                                                           \
      g1 = *(const uint4*)(m.rr + o_);                                                         \
      if (sc < 2) g2 = *(const uint4*)(m.rv + (rbase + j_) * 256 + hd * 64 + rq * 16 + sc * 8); \
    }                                                                                          \
  }
#define SCAN_LSTORE(buf_)                                                                      \
  {                                                                                            \
    float* B_ = sbase + (buf_) * BUF;                                                          \
    const unsigned w0_[4] = {g0.x, g0.y, g0.z, g0.w};                                          \
    const unsigned w1_[4] = {g1.x, g1.y, g1.z, g1.w};                                          \
    const unsigned w2_[4] = {g2.x, g2.y, g2.z, g2.w};                                          \
    if (su < 8) {                                                                              \
      float kk_[8], bb_[8], dd_[8];                                                            \
      _Pragma("unroll") for (int q_ = 0; q_ < 4; ++q_) {                                       \
        const float k0_ = bflo(w0_[q_]), k1_ = bfhi(w0_[q_]);                                  \
        const float a0_ = bflo(w1_[q_]), a1_ = bfhi(w1_[q_]);                                  \
        const float v0_ = bflo(w2_[q_]), v1_ = bfhi(w2_[q_]);                                  \
        kk_[2 * q_] = k0_; kk_[2 * q_ + 1] = k1_;                                              \
        bb_[2 * q_] = k0_ * a0_; bb_[2 * q_ + 1] = k1_ * a1_;                                  \
        dd_[2 * q_] = v0_ * (1.f + (a0_ - 1.f) * kav[2 * q_]);                                 \
        dd_[2 * q_ + 1] = v1_ * (1.f + (a1_ - 1.f) * kav[2 * q_ + 1]);                         \
      }                                                                                        \
      float* d0_ = B_ + ss * 64 + sc * 8;                                                      \
      *(float4*)(d0_) = make_float4(kk_[0], kk_[1], kk_[2], kk_[3]);                           \
      *(float4*)(d0_ + 4) = make_float4(kk_[4], kk_[5], kk_[6], kk_[7]);                       \
      *(float4*)(d0_ + 2048) = make_float4(bb_[0], bb_[1], bb_[2], bb_[3]);                    \
      *(float4*)(d0_ + 2052) = make_float4(bb_[4], bb_[5], bb_[6], bb_[7]);                    \
      *(float4*)(d0_ + 3072) = make_float4(dd_[0], dd_[1], dd_[2], dd_[3]);                    \
      *(float4*)(d0_ + 3076) = make_float4(dd_[4], dd_[5], dd_[6], dd_[7]);                    \
    } else {                                                                                   \
      float ww_[8], rr_[8], vv_[8];                                                            \
      _Pragma("unroll") for (int q_ = 0; q_ < 4; ++q_) {                                       \
        ww_[2 * q_] = 1.f - bflo(w0_[q_]); ww_[2 * q_ + 1] = 1.f - bfhi(w0_[q_]);              \
        rr_[2 * q_] = bflo(w1_[q_]); rr_[2 * q_ + 1] = bfhi(w1_[q_]);                          \
        vv_[2 * q_] = bflo(w2_[q_]); vv_[2 * q_ + 1] = bfhi(w2_[q_]);                          \
      }                                                                                        \
      float* d0_ = B_ + ss * 64 + sc * 8;                                                      \
      *(float4*)(d0_ + 1024) = make_float4(ww_[0], ww_[1], ww_[2], ww_[3]);                    \
      *(float4*)(d0_ + 1028) = make_float4(ww_[4], ww_[5], ww_[6], ww_[7]);                    \
      *(float4*)(d0_ + 4096) = make_float4(rr_[0], rr_[1], rr_[2], rr_[3]);                    \
      *(float4*)(d0_ + 4100) = make_float4(rr_[4], rr_[5], rr_[6], rr_[7]);                    \
      if (sc < 2) {                                                                            \
        float* d1_ = B_ + 5120 + ss * 16 + sc * 8;                                             \
        *(float4*)(d1_) = make_float4(vv_[0], vv_[1], vv_[2], vv_[3]);                         \
        *(float4*)(d1_ + 4) = make_float4(vv_[4], vv_[5], vv_[6], vv_[7]);                     \
      }                                                                                        \
    }                                                                                          \
  }
  f32x2_t SA = {0.f, 0.f}, SB = {0.f, 0.f};
  __builtin_amdgcn_s_setprio(3);
  SCAN_GLOAD(0);
  SCAN_LSTORE(0);
  __syncthreads();
  for (int c = 0; c < NCH; ++c) {
    const int buf = c & 1;
    if (c + 1 < NCH) SCAN_GLOAD((c + 1) * TC);
    const float* B = sbase + buf * BUF;
    float* syb = sy + buf * TC * 16;
    float ypart[TC];
    float4 kkv[TC], wwv[TC], bbv[TC], ddv[TC], rrv[TC];
    float vvv[TC];
    constexpr int PF = 2;
#pragma unroll
    for (int st = 0; st < PF; ++st) {
      kkv[st] = *(const float4*)(B + st * 64 + kq * 4);
      wwv[st] = *(const float4*)(B + 1024 + st * 64 + kq * 4);
      bbv[st] = *(const float4*)(B + 2048 + st * 64 + kq * 4);
      ddv[st] = *(const float4*)(B + 3072 + st * 64 + kq * 4);
      rrv[st] = *(const float4*)(B + 4096 + st * 64 + kq * 4);
      vvv[st] = B[5120 + st * 16 + rloc];
    }
    __builtin_amdgcn_sched_barrier(0);
#pragma unroll
    for (int st = 0; st < TC; ++st) {
      if (st + PF < TC) {
        kkv[st + PF] = *(const float4*)(B + (st + PF) * 64 + kq * 4);
        wwv[st + PF] = *(const float4*)(B + 1024 + (st + PF) * 64 + kq * 4);
        bbv[st + PF] = *(const float4*)(B + 2048 + (st + PF) * 64 + kq * 4);
        ddv[st + PF] = *(const float4*)(B + 3072 + (st + PF) * 64 + kq * 4);
        rrv[st + PF] = *(const float4*)(B + 4096 + (st + PF) * 64 + kq * 4);
        vvv[st + PF] = B[5120 + (st + PF) * 16 + rloc];
      }
      __builtin_amdgcn_sched_barrier(0);
      const float4 kk = kkv[st], ww = wwv[st], bb = bbv[st], dd = ddv[st], rr = rrv[st];
      const float vv = vvv[st];
      const f32x2_t k01 = {kk.x, kk.y}, k23 = {kk.z, kk.w}, w01 = {ww.x, ww.y}, w23 = {ww.z, ww.w};
      const f32x2_t b01 = {bb.x, bb.y}, b23 = {bb.z, bb.w}, d01 = {dd.x, dd.y}, d23 = {dd.z, dd.w};
      const f32x2_t r01 = {rr.x, rr.y}, r23 = {rr.z, rr.w}, v2 = {vv, vv};
      const f32x2_t pp2 = SA * k01 + SB * k23;
      const float part = pp2.x + pp2.y;
      const f32x2_t cA = SA * w01 + v2 * d01, cB = SB * w23 + v2 * d23;
      const float sa = -row_allsum(part);
      const f32x2_t sa2 = {sa, sa};
      SA = cA + sa2 * b01;
      SB = cB + sa2 * b23;
      const f32x2_t yy2 = SA * r01 + SB * r23;
      ypart[st] = yy2.x + yy2.y;
    }
#pragma unroll
    for (int st = 0; st < TC; ++st) ypart[st] = row_allsum(ypart[st]);
    if (kq == 0) {
#pragma unroll
      for (int st = 0; st < TC; ++st) syb[st * 16 + rloc] = ypart[st];
    }
    if (c + 1 < NCH) SCAN_LSTORE(buf ^ 1);
    __syncthreads();
    {
      const int st = tid >> 4, r_ = tid & 15;
      const int ii = c * TC + st;
      const int j = SCAN_JMAP(ii);
      yD[(rbase + j) * 256 + hd * 64 + rq * 16 + r_] = syb[st * 16 + r_];
    }
  }
  __builtin_amdgcn_s_setprio(0);
  __syncthreads();
}

DI void readout_hy_phase(int g, const MixBufs& m, u16* __restrict__ ymix, bool skip_ctx, char* smem) {
  const int tid = ltid();
  {
    u16* tile = (u16*)smem;
    for (int tl = blockIdx.x; tl < (TG / 64) * 4; tl += gridDim.x) {
      const int rl0 = (tl >> 2) * 64, c0 = (tl & 3) * 64;
      const int r0 = g * TG + rl0;
      if (skip_ctx && (r0 % LT) < LC) continue;
#pragma unroll
      for (int k = 0; k < 2; ++k) {
        const int id = tid + NTHR * k, ch = id >> 3, part = id & 7;
        *(uint4*)(tile + ch * 72 + part * 8) = *(const uint4*)(m.u + (size_t)(c0 + ch) * TG + rl0 + part * 8);
      }
      __syncthreads();
#pragma unroll
      for (int k = 0; k < 2; ++k) {
        const int id = tid + NTHR * k, tok = id >> 3, part = id & 7;
        const u16* tp = tile + (part * 8) * 72 + tok;
        uint4 w;
        w.x = (unsigned)tp[0] | ((unsigned)tp[72] << 16);
        w.y = (unsigned)tp[2 * 72] | ((unsigned)tp[3 * 72] << 16);
        w.z = (unsigned)tp[4 * 72] | ((unsigned)tp[5 * 72] << 16);
        w.w = (unsigned)tp[6 * 72] | ((unsigned)tp[7 * 72] << 16);
        *(uint4*)(ymix + (size_t)(r0 + tok) * D + c0 + part * 8) = w;
      }
      __syncthreads();
    }
  }
}

DI void readout_rw_phase(const Params& p, int l, int g, const MixBufs& m, u16* __restrict__ ymix, bool skip_ctx) {
  const int tid = ltid(), lane = tid & 63, wave = tid >> 6;
  float lnw[4], lnb[4], kaa[4], rkw[4];
#pragma unroll
  for (int hd = 0; hd < 4; ++hd) {
    const int c = l * 256 + hd * 64 + lane;
    lnw[hd] = p.rw_ln_w[c];
    lnb[hd] = p.rw_ln_b[c];
    kaa[hd] = p.rw_k_a[c];
    rkw[hd] = p.rw_r_k[c];
  }
  for (int rl = blockIdx.x * 4 + wave; rl < TG; rl += gridDim.x * 4) {
    const int r = g * TG + rl;
    const int j = r % LT;
    if (skip_ctx && j < LC) continue;
    float y[4], rr[4], kv[4], vv[4], af[4], ab[4], gg[4];
#pragma unroll
    for (int hd = 0; hd < 4; ++hd) {
      const size_t o = (size_t)rl * 256 + hd * 64 + lane;
      y[hd] = m.yf[o] + m.yb[o];
      rr[hd] = bf2f(m.rr[o]);
      kv[hd] = bf2f(m.rk[o]);
      vv[hd] = bf2f(m.rv[o]);
      af[hd] = bf2f(m.af[o]);
      ab[hd] = bf2f(m.ab[o]);
      gg[hd] = bf2f(m.gg[o]);
    }
#pragma unroll
    for (int hd = 0; hd < 4; ++hd) {
      const float mean = wave_sum(y[hd]) * (1.f / 64.f);
      const float dv = y[hd] - mean;
      const float var = wave_sum(dv * dv) * (1.f / 64.f);
      const float yn = dv * rsqrtf(var + 64e-5f) * lnw[hd] + lnb[hd];
      const float t1 = rr[hd] * kv[hd] * (1.f + (af[hd] - 1.f) * kaa[hd]) * rkw[hd] + rr[hd] * kv[hd] * (1.f + (ab[hd] - 1.f) * kaa[hd]) * rkw[hd];
      const float bonus = wave_sum(t1) * vv[hd];
      ymix[(size_t)r * D + 768 + hd * 64 + lane] = f2bf((yn + bonus) * gg[hd]);
    }
  }
}

#define XB_TMO      128
#define XB_XCNT(j)  (256  + 64 * (j))
#define XB_XSUB(j)  (1280 + 64 * (j))
#define XB_XGEN(j)  (2304 + 64 * (j))
#define XB_TOP      3328
#define XB_TOPGEN   3392
#define XCD_BAR_WORDS 3456
#define XB_SPIN_CAP (1u << 21)
#define LAS __attribute__((address_space(3)))
DI unsigned xb_ld(unsigned* p) { return __hip_atomic_load(p, __ATOMIC_RELAXED, __HIP_MEMORY_SCOPE_AGENT); }
DI unsigned xb_add(unsigned* p, unsigned v) { return __hip_atomic_fetch_add(p, v, __ATOMIC_RELAXED, __HIP_MEMORY_SCOPE_AGENT); }
DI unsigned xb_xcc_id() { return (unsigned)__builtin_amdgcn_s_getreg((3 << 11) | 20) & 0xFu; }
#define XB_SPIN(cond, bar) do { unsigned _sp = 0; while (cond) { __builtin_amdgcn_s_sleep(1); \
    if ((++_sp & 255u) == 0u) { if (xb_ld(&(bar)[XB_TMO])) break; if (_sp > XB_SPIN_CAP) { atomicAdd(&(bar)[XB_TMO], 1u); break; } } } } while (0)
struct XcdBarrier { unsigned* bar; unsigned x; volatile LAS unsigned* st; };
DI XcdBarrier xcd_barrier_post(unsigned* bar, volatile LAS unsigned* st) {
  XcdBarrier b; b.bar = bar; b.x = xb_xcc_id(); b.st = st;
  if (threadIdx.x == 0) (void)xb_add(&bar[XB_XCNT(b.x)], 1u);
  return b;
}
DI void xcd_barrier_complete(unsigned* bar, unsigned x, unsigned& nloc, unsigned& nx) {
  const unsigned G = gridDim.x * gridDim.y * gridDim.z;
  unsigned sum, cnt, mine, sp = 0u;
  for (;;) {
    sum = 0u; cnt = 0u; mine = 0u;
#pragma unroll
    for (unsigned j = 0; j < 16; ++j) { const unsigned c = xb_ld(&bar[XB_XCNT(j)]); sum += c; cnt += (c > 0u) ? 1u : 0u; mine = (j == x) ? c : mine; }
    if (sum == G) break;
    __builtin_amdgcn_s_sleep(1);
    if ((++sp & 255u) == 0u) { if (xb_ld(&bar[XB_TMO])) break; if (sp > XB_SPIN_CAP) { atomicAdd(&bar[XB_TMO], 1u); break; } }
  }
  nloc = mine > 0u ? mine : 1u; nx = cnt > 0u ? cnt : 1u;
}
DI void xcd_barrier(const XcdBarrier& b) {
  asm volatile("s_waitcnt vmcnt(0)" ::: "memory");
  __syncthreads();
  if (threadIdx.x == 0) {
    unsigned* bar = b.bar;
    __builtin_amdgcn_s_waitcnt(0);
    unsigned nloc = b.st[0], nx = b.st[1];
    if (nloc == 0u) { xcd_barrier_complete(bar, b.x, nloc, nx); b.st[0] = nloc; b.st[1] = nx; }
    const unsigned old = xb_add(&bar[XB_XSUB(b.x)], 1u);
    const unsigned gen = old / nloc;
    if (old + 1u == (gen + 1u) * nloc) {
      __builtin_amdgcn_fence(__ATOMIC_RELEASE, "agent");
      asm volatile("s_waitcnt vmcnt(0)" ::: "memory");
      const unsigned og = xb_add(&bar[XB_TOP], 1u);
      const unsigned tg = og / nx;
      if (og + 1u == (tg + 1u) * nx) xb_add(&bar[XB_TOPGEN], 1u);
      else XB_SPIN(xb_ld(&bar[XB_TOPGEN]) == tg, bar);
      __builtin_amdgcn_fence(__ATOMIC_ACQUIRE, "agent");
      xb_add(&bar[XB_XGEN(b.x)], 1u);
      asm volatile("s_waitcnt vmcnt(0)" ::: "memory");
    } else {
      XB_SPIN(xb_ld(&bar[XB_XGEN(b.x)]) == gen, bar);
      __builtin_amdgcn_fence(__ATOMIC_ACQUIRE, "agent");
      asm volatile("s_waitcnt vmcnt(0)" ::: "memory");
    }
  }
  __syncthreads();
}

DI int conv_job_tiles(int j) {
  return (j <= 2 || j >= 12) ? 704 : j == 3 ? 720 : j == 4 ? 24 : j == 5 ? 16 : j <= 9 ? 4 : j == 10 ? 8 : 256;
}
DI void conv_job_tile(const Params& p, int l, int j, int t, u16* W, char* smem) {
  switch (j) {
    case 0: convT_tile(p.ffn1_gate + (size_t)l * D * DFF, D, DFF, W + W_GU1, 1, t, smem); break;
    case 1: convT_tile(p.ffn1_up + (size_t)l * D * DFF, D, DFF, W + W_GU1, 2, t, smem); break;
    case 2: convT_tile(p.ffn1_down + (size_t)l * D * DFF, DFF, D, W + W_D1, 0, t, smem); break;
    case 3: convT_tile(p.w_in + (size_t)l * D * DIN, D, DIN, W + W_IN, 0, t, smem); break;
    case 4: convT_tile(p.mla_w_uq + (size_t)l * 256 * 384, 256, 384, W + W_UQ, 0, t, smem); break;
    case 5: convT_tile(p.mla_w_ukv + (size_t)l * 128 * 512, 128, 512, W + W_UKV, 0, t, smem); break;
    case 6: convT_tile(p.rw_w2 + (size_t)(l * 2 + 0) * 64 * 256, 64, 256, W + W_W2, 0, t, smem); break;
    case 7: convT_tile(p.rw_w2 + (size_t)(l * 2 + 1) * 64 * 256, 64, 256, W + W_W2 + (size_t)256 * 64, 0, t, smem); break;
    case 8: convT_tile(p.rw_a2 + (size_t)(l * 2 + 0) * 64 * 256, 64, 256, W + W_A2, 0, t, smem); break;
    case 9: convT_tile(p.rw_a2 + (size_t)(l * 2 + 1) * 64 * 256, 64, 256, W + W_A2 + (size_t)256 * 64, 0, t, smem); break;
    case 10: convT_tile(p.rw_g2 + (size_t)l * 128 * 256, 128, 256, W + W_G2, 0, t, smem); break;
    case 11: convT_tile(p.w_out + (size_t)l * D * D, D, D, W + W_OUT, 0, t, smem); break;
    case 12: convT_tile(p.ffn2_gate + (size_t)l * D * DFF, D, DFF, W + W_GU2, 1, t, smem); break;
    case 13: convT_tile(p.ffn2_up + (size_t)l * D * DFF, D, DFF, W + W_GU2, 2, t, smem); break;
    default: convT_tile(p.ffn2_down + (size_t)l * D * DFF, DFF, D, W + W_D2, 0, t, smem); break;
  }
}
constexpr int AUX_EARLY = 704 * 3 + 720 + 24 + 16 + 16 + 8;
constexpr int AUX_LATE = 256 + 704 * 3;
DI void aux_tile(const Params& p, int l, int a, u16* W, char* smem) {
  int jl = 1, j0 = 11;
  if (l == 0 && a < AUX_EARLY) j0 = 0;
  else if (l == 0) { a -= AUX_EARLY; jl = 0; }
  int j = j0;
  for (;;) {
    const int n = conv_job_tiles(j);
    if (a < n) break;
    a -= n;
    ++j;
  }
  conv_job_tile(p, jl, j, a, W, smem);
}

__global__ void __launch_bounds__(NTHR, 2) fwd_megakernel(Params p) {
  cg::grid_group grid = cg::this_grid();
  __shared__ __attribute__((aligned(16))) char smem[73728];
  __shared__ int s_item;
  __shared__ uint4 xb_words;
  if (threadIdx.x == 0) xb_words = make_uint4(0u, 0u, 0u, 0u);
  __syncthreads();
  const XcdBarrier xb = xcd_barrier_post((unsigned*)(p.ws + OFF_BAR), (volatile LAS unsigned*)&xb_words);
  char* ws = p.ws;
  float* ctxs = (float*)(ws + OFF_CTX);
  float* mod = (float*)(ws + OFF_MOD);
  u16* hbuf = (u16*)(ws + OFF_H);
  char* big = ws + OFF_BIG;
  u16* Gbuf = (u16*)big;
  u16* const Wl = (u16*)(ws + OFF_W);
  float* const filt = (float*)(ws + OFF_FILT);

  for (int j = 0; j <= 10; ++j)
    for (int t = blockIdx.x; t < conv_job_tiles(j); t += gridDim.x) conv_job_tile(p, 0, j, t, Wl, smem);
  hyfilt_phase(p, 0, LQ, filt, smem);
  hyfilt_phase(p, 0, LC, (float*)(ws + OFF_FILTC), smem);
  rope_table_phase((float2*)(ws + OFF_ROPEG), (float2*)(ws + OFF_ROPEM));
  mod_phase(p, mod, smem);
  grid.sync();

  for (int l = 0; l < 2; ++l) {
    const bool last = (l == 1);
    const u16* W = Wl;
    if (l == 1) {
      hyfilt_phase(p, 1, LQ, filt, smem);
    }
    const float* modl = mod + (size_t)l * 9 * 9216;
    const float* lat_in = (l == 0) ? p.x : p.out;
    const float* ctx_in = (l == 0) ? p.ctx : ctxs;

    adaln_phase(lat_in, ctx_in, p.norm_ffn1 + l * D, modl, 0, hbuf, false);
    xcd_barrier(xb);
    {
      EpiGU e{Gbuf};
      gemm_gu_phase(hbuf, W + W_GU1, T / 128, false, smem, e);
    }
    xcd_barrier(xb);
    {
      EpiRes e{lat_in, ctx_in, p.out, ctxs, modl, 2, 0.5f, nullptr, nullptr, nullptr, 0};
      gemm_phase<false>(Gbuf, DFF, W + W_D1, DFF, DFF, T / 128, 8, 0, false, smem, e);
    }
    xcd_barrier(xb);
    adaln_phase(p.out, ctxs, p.norm_mix + l * D, modl, 1, hbuf, false);
    xcd_barrier(xb);
    for (int g = 0; g < NG; ++g) {
      const MixBufs m = mixbufs(big, g);
      const u16* hg = hbuf + (size_t)g * TG * D;
      {
        EpiWin e{m.p, m.pt};
        gemm_phase<false>(hg, D, W + W_IN, D, D, TG / 128, 23, 0, false, smem, e);
      }
      xcd_barrier(xb);
      for (int rep = 0; rep < REP_ROW; ++rep) prep_phase(p, l, g, m, (const float2*)(ws + OFF_ROPEG), smem);
      xcd_barrier(xb);
      {
        EpiStore e1{m.qup, 384, 384};
        gemm_phase<false>(m.cqn, 256, W + W_UQ, 256, 256, TG / 128, 3, 0, false, smem, e1);
        EpiStore e2{m.kvup, 512, 512};
        gemm_phase<false>(m.ckvn, 128, W + W_UKV, 128, 128, TG / 128, 4, 0, false, smem, e2);
        EpiLoraW e3{m.ef, p.rw_w0 + (l * 2 + 0) * 256};
        gemm_phase<false>(m.lwf, 64, W + W_W2, 64, 64, TG / 128, 2, 0, false, smem, e3);
        EpiLoraW e4{m.eb, p.rw_w0 + (l * 2 + 1) * 256};
        gemm_phase<false>(m.lwb, 64, W + W_W2 + 256 * 64, 64, 64, TG / 128, 2, 0, false, smem, e4);
        EpiLoraA e5{m.af, p.rw_a0 + (l * 2 + 0) * 256};
        gemm_phase<false>(m.laf, 64, W + W_A2, 64, 64, TG / 128, 2, 0, false, smem, e5);
        EpiLoraA e6{m.ab, p.rw_a0 + (l * 2 + 1) * 256};
        gemm_phase<false>(m.lab, 64, W + W_A2 + 256 * 64, 64, 64, TG / 128, 2, 0, false, smem, e6);
        EpiStore e7{m.gg, 256, 256};
        gemm_phase<false>(m.lg, 128, W + W_G2, 128, 128, TG / 128, 2, 0, false, smem, e7);
      }
      xcd_barrier(xb);
      for (int rep = 0; rep < REP_ROW; ++rep) mla_fin_phase(p, l, g, m, (const float2*)(ws + OFF_ROPEM));
      xcd_barrier(xb);
      {
        u16* ymix = hbuf;
        const int n_scan = (g == NG - 1) ? NG * BG * 4 * 2 * 4 : 0;
        const int qt_per_b = last ? 16 : 17;
        const int n_att = BG * 4 * qt_per_b;
        const int n_gqa = (g == NG - 1) ? NG * n_att : 0;
        const int n_hy = 256;
        const int total = n_scan + n_att + n_gqa + n_hy;
        float gq = 0.f, gk = 0.f, mq = 0.f, mk = 0.f;
        for (int i = 0; i < 64; ++i) { gq = fmaxf(gq, fabsf(p.gqa_q_norm[l * 64 + i])); gk = fmaxf(gk, fabsf(p.gqa_k_norm[l * 64 + i])); }
        for (int i = 0; i < 96; ++i) { mq = fmaxf(mq, fabsf(p.mla_q_norm[l * 96 + i])); mk = fmaxf(mk, fabsf(p.mla_k_norm[l * 96 + i])); }
        const float L2E = 1.4426950408889634f;
        const float sc_g = 0.125f, sc_m = 0.10206207261596575f;
        const float sh_g = (64.f * gq * gk * sc_g * 1.02f + 0.5f) * L2E;
        const float sh_m = (96.f * mq * mk * sc_m * 1.02f + 0.5f) * L2E;
        int* cnt = (int*)(ws + OFF_CNT) + (l * NG + g);
        for (;;) {
          if (threadIdx.x == 0) s_item = atomicAdd(cnt, 1);
          __syncthreads();
          const int it = s_item;
          __syncthreads();
          if (it >= total) break;
          if (it < n_scan) {
            const int sg = it >> 7, bl = (it >> 5) & 3, hd = (it >> 3) & 3, dir = (it >> 2) & 1, rq = it & 3;
            const MixBufs ms = mixbufs(big, sg);
            scan_item(p, l, ms, bl, hd, dir, rq, smem);
          } else if (it < n_scan + n_att + n_gqa) {
            int a = it - n_scan;
            const int kind = a < n_att ? 0 : 1;
            int ag = g;
            if (kind == 1) { a -= n_att; ag = a / n_att; a -= ag * n_att; }
            const int bl = a / (4 * qt_per_b);
            int rem = a - bl * 4 * qt_per_b;
            const int hd = rem / qt_per_b;
            const int qt = rem - hd * qt_per_b;
            const int j0 = qt < 16 ? LC + qt * 256 : 0;
            const int nkeys = qt < 16 ? LT : LC;
            const size_t rl0 = (size_t)bl * LT + j0;
            const size_t rg0 = (size_t)(ag * BG + bl) * LT + j0;
            if (kind == 1) {
              const MixBufs ma = mixbufs(big, ag);
              const int kvh = hd >> 1;
              attn_item<64, 2>(ma.qg + rl0 * 256 + hd * 64, 256, ma.kg + (size_t)bl * LT * 128 + kvh * 64, 128,
                            ma.vtg + (size_t)(bl * 2 + kvh) * 64 * LT, ymix + rg0 * D + 256 + hd * 64, D, nkeys, sc_g * L2E, sh_g, smem);
            } else {
              attn_item<96, 2>(m.qm + rl0 * 384 + hd * 96, 384, m.km + (size_t)bl * LT * 384 + hd * 96, 384,
                            m.vtm + (size_t)(bl * 4 + hd) * 64 * LT, ymix + rg0 * D + 512 + hd * 64, D, nkeys, sc_m * L2E, sh_m, smem);
            }
          } else {
            const int c = it - n_scan - n_att - n_gqa;
            hyena_pass(p, l, m, filt, LQ, LC, c, smem);
            if (!last) hyena_pass(p, l, m, (const float*)(ws + OFF_FILTC), LC, 0, c, smem);
          }
        }
        if (g == NG - 1) {
          int* acnt = (int*)(ws + OFF_CNT) + 16 + l;
          const int n_aux = l == 0 ? AUX_EARLY + AUX_LATE : AUX_LATE;
          for (;;) {
            if (threadIdx.x == 0) s_item = atomicAdd(acnt, 1);
            __syncthreads();
            const int a = s_item;
            __syncthreads();
            if (a >= n_aux) break;
            aux_tile(p, l, a, Wl, smem);
          }
        }
        xcd_barrier(xb);
        readout_hy_phase(g, m, ymix, last, smem);
        if (g == NG - 1) {
          for (int rg = 0; rg < NG; ++rg) {
            const MixBufs mr = mixbufs(big, rg);
            readout_rw_phase(p, l, rg, mr, ymix, last);
          }
          xcd_barrier(xb);
        }
      }
    }
    {
      EpiRes e{p.out, ctxs, p.out, ctxs, modl, 5, 1.0f, nullptr, nullptr, nullptr, 0};
      gemm_phase<false>(hbuf, D, W + W_OUT, D, D, T / 128, 8, 0, last, smem, e);
    }
    xcd_barrier(xb);
    adaln_phase(p.out, ctxs, p.norm_ffn2 + l * D, modl, 2, hbuf, last);
    xcd_barrier(xb);
    {
      EpiGU e{Gbuf};
      gemm_gu_phase(hbuf, W + W_GU2, T / 128, last, smem, e);
    }
    xcd_barrier(xb);
    {
      EpiRes e{p.out, ctxs, p.out, ctxs, modl, 8, 0.5f, nullptr, nullptr, nullptr, 0};
      gemm_phase<false>(Gbuf, DFF, W + W_D2, DFF, DFF, T / 128, 8, 0, last, smem, e);
    }
    xcd_barrier(xb);
  }
}

extern "C" void kernel_launch(void* const* d_in, const int* in_sizes, int n_in, void* d_out, int out_size, void* d_ws,
                              size_t ws_size, hipStream_t stream) {
  static int grid_blocks = 0;
  if (!grid_blocks) {
    int dev = 0, cus = 0, per_cu = 0;
    (void)hipGetDevice(&dev);
    (void)hipDeviceGetAttribute(&cus, hipDeviceAttributeMultiprocessorCount, dev);
    (void)hipOccupancyMaxActiveBlocksPerMultiprocessor(&per_cu, fwd_megakernel, NTHR, 0);
    if (per_cu > 2) per_cu = 2;
    if (per_cu < 1) per_cu = 1;
    grid_blocks = cus * per_cu;
  }
  Params p{};
  const float** pp = (const float**)&p;
  for (int i = 0; i < 47; ++i) pp[i] = (const float*)d_in[i];
  p.out = (float*)d_out;
  p.ws = (char*)d_ws;
  (void)hipMemsetAsync((char*)d_ws + OFF_CNT, 0, 256 + 3456 * 4, stream);
  void* args[] = {&p};
  hipError_t e = hipLaunchCooperativeKernel((void*)fwd_megakernel, dim3(grid_blocks), dim3(NTHR), args, 0, stream);
  if (e != hipSuccess) fprintf(stderr, "cooperative launch failed: %s (grid %d)\n", hipGetErrorString(e), grid_blocks);
}
```

```cpp
#include <hip/hip_runtime.h>
#include <hip/hip_bf16.h>
#include <hip/hip_cooperative_groups.h>
#include <cstdio>
namespace cg = cooperative_groups;

#define DI __device__ __forceinline__
typedef unsigned short u16;
using bf16x8 = __attribute__((ext_vector_type(8))) short;
using f32x16 = __attribute__((ext_vector_type(16))) float;
typedef __bf16 bf16x2_t __attribute__((ext_vector_type(2)));
typedef float f32x2_t __attribute__((ext_vector_type(2)));
#define MFMA32(a, b, c) __builtin_amdgcn_mfma_f32_32x32x16_bf16((a), (b), (c), 0, 0, 0)

constexpr int D = 1024, NB = 8, LQ = 4096, LC = 256, LT = 4352, T = NB * LT, DFF = 2816, DIN = 2848;
constexpr int HYC = 768, DINP = DIN - HYC;
constexpr int NG = 2, BG = NB / NG, TG = BG * LT;
constexpr int NTHR = 256;
#define REP_MIX 1
#define REP_GU 1
#define REP_MISC 1
#define REP_ROW 1
constexpr float EPS = 1e-6f;

constexpr size_t al(size_t x) { return (x + 255) & ~(size_t)255; }
constexpr size_t OFF_CTX = 0;
constexpr size_t OFF_MOD = OFF_CTX + al((size_t)NB * LC * D * 4);
constexpr size_t SZ_FILT_L = (size_t)(2 * LQ - 1) * 256 * 4;
constexpr size_t SZ_FILT_C = (size_t)(2 * LC - 1) * 256 * 4;
constexpr size_t OFF_CNT = OFF_MOD + al((size_t)2 * 9 * 9216 * 4);
constexpr size_t OFF_BAR = OFF_CNT + 256;
constexpr size_t OFF_FILT = OFF_BAR + al((size_t)3456 * 4);
constexpr size_t OFF_FILTC = OFF_FILT + al(SZ_FILT_L);
constexpr size_t OFF_ROPEG = OFF_FILTC + al(SZ_FILT_C);
constexpr size_t OFF_ROPEM = OFF_ROPEG + al((size_t)LQ * 32 * 8);
constexpr size_t OFF_W = OFF_ROPEM + al((size_t)LQ * 16 * 8);
constexpr size_t W_GU1 = 0;
constexpr size_t W_D1 = W_GU1 + (size_t)5632 * 1024;
constexpr size_t W_GU2 = W_D1 + (size_t)1024 * 2816;
constexpr size_t W_D2 = W_GU2 + (size_t)5632 * 1024;
constexpr size_t W_IN = W_D2 + (size_t)1024 * 2816;
constexpr size_t W_OUT = W_IN + (size_t)2944 * 1024;
constexpr size_t W_UQ = W_OUT + (size_t)1024 * 1024;
constexpr size_t W_UKV = W_UQ + (size_t)384 * 256;
constexpr size_t W_W2 = W_UKV + (size_t)512 * 128;
constexpr size_t W_A2 = W_W2 + (size_t)2 * 256 * 64;
constexpr size_t W_G2 = W_A2 + (size_t)2 * 256 * 64;
constexpr size_t W_LAYER = W_G2 + (size_t)256 * 128;
constexpr size_t OFF_H = OFF_W + al(W_LAYER * 2);
constexpr size_t OFF_BIG = OFF_H + al((size_t)T * D * 2);
constexpr size_t M_P = 0;
constexpr size_t M_PT = M_P + al((size_t)TG * DINP * 2);
constexpr size_t M_U = M_PT + al((size_t)HYC * TG * 2);
constexpr size_t M_CQN = M_U + al((size_t)TG * 256 * 2);
constexpr size_t M_CKVN = M_CQN + al((size_t)TG * 256 * 2);
constexpr size_t M_QUP = M_CKVN + al((size_t)TG * 128 * 2);
constexpr size_t M_KVUP = M_QUP + al((size_t)TG * 384 * 2);
constexpr size_t M_QM = M_KVUP + al((size_t)TG * 512 * 2);
constexpr size_t M_KM = M_QM + al((size_t)TG * 384 * 2);
constexpr size_t M_VTM = M_KM + al((size_t)TG * 384 * 2);
constexpr size_t M_LWF = M_VTM + al((size_t)TG * 256 * 2);
constexpr size_t M_LWB = M_LWF + al((size_t)TG * 64 * 2);
constexpr size_t M_LAF = M_LWB + al((size_t)TG * 64 * 2);
constexpr size_t M_LAB = M_LAF + al((size_t)TG * 64 * 2);
constexpr size_t M_LG = M_LAB + al((size_t)TG * 64 * 2);
constexpr size_t SZ_SC = al((size_t)TG * 256 * 2);
constexpr size_t M_SCAN = M_LG + al((size_t)TG * 128 * 2);
constexpr size_t SCAN_STRIDE = 11 * SZ_SC;
constexpr size_t M_END = M_SCAN + 2 * SCAN_STRIDE;
static_assert((size_t)4 * TG * 256 * 4 <= al((size_t)TG * DINP * 2), "yf/yb do not fit the p region");
constexpr size_t SZ_G = (size_t)T * DFF * 2;
constexpr size_t WS_NEED = OFF_BIG + (M_END > SZ_G ? M_END : SZ_G);
static_assert(WS_NEED <= (size_t)512 * 1024 * 1024, "workspace too large");

struct Params {
  const float *x, *c, *ctx, *c_ctx, *ada_w, *ada_b, *norm_ffn1, *norm_mix, *norm_ffn2;
  const float *ffn1_gate, *ffn1_up, *ffn1_down, *ffn2_gate, *ffn2_up, *ffn2_down, *w_in, *w_out;
  const float *hy_conv_w, *hy_conv_b, *hy_f_w1, *hy_f_b1, *hy_f_w2, *hy_f_b2, *hy_f_w3, *hy_f_b3, *hy_f_w4, *hy_f_freq, *hy_bias;
  const float *gqa_q_norm, *gqa_k_norm, *mla_cq_norm, *mla_ckv_norm, *mla_w_uq, *mla_w_ukv, *mla_q_norm, *mla_k_norm;
  const float *rw_mu, *rw_w0, *rw_w2, *rw_a0, *rw_a2, *rw_g2, *rw_k_k, *rw_k_a, *rw_r_k, *rw_ln_w, *rw_ln_b;
  float* out;
  char* ws;
};

DI u16 f2bf(float x) {
  unsigned u = __float_as_uint(x);
  u += 0x7fffu + ((u >> 16) & 1u);
  return (u16)(u >> 16);
}
DI float bf2f(u16 b) { return __uint_as_float(((unsigned)b) << 16); }
DI float bflo_(unsigned w) { return __uint_as_float(w << 16); }
DI float bfhi_(unsigned w) { return __uint_as_float(w & 0xffff0000u); }
DI unsigned pack2(float a, float b) {
  f32x2_t v = {a, b};
  bf16x2_t r = __builtin_convertvector(v, bf16x2_t);
  return __builtin_bit_cast(unsigned, r);
}
DI int ltid() {
  int t = threadIdx.x;
  asm volatile("" : "+v"(t));
  return t;
}
DI float wave_sum(float v) {
#pragma unroll
  for (int o = 32; o > 0; o >>= 1) v += __shfl_xor(v, o);
  return v;
}
DI float wave_max(float v) {
#pragma unroll
  for (int o = 32; o > 0; o >>= 1) v = fmaxf(v, __shfl_xor(v, o));
  return v;
}
DI float sigmoidf_(float x) { return __builtin_amdgcn_rcpf(1.f + __expf(-x)); }
DI int crow(int i, int h) { return (i & 3) + 8 * (i >> 2) + 4 * h; }

DI float rope_apply(float val, int idx, int nfreq, int t, int lane) {
  int pi = idx >> 1;
  int row = t >> 6, col = t & 63;
  float pos = pi < nfreq ? (float)row : (float)col;
  int f = pi < nfreq ? pi : pi - nfreq;
  float inv = exp2f(-(float)f / (float)nfreq * 13.287712379549449f);
  float ang = pos * inv;
  float cs = cosf(ang), sn = sinf(ang);
  float other = __shfl_xor(val, 1);
  return (lane & 1) ? other * sn + val * cs : val * cs - other * sn;
}

DI float rope_tab(float val, int idx, const float2* __restrict__ tab, int lane) {
  const float2 cs = tab[idx >> 1];
  const float other = __shfl_xor(val, 1);
  return (lane & 1) ? other * cs.y + val * cs.x : val * cs.x - other * cs.y;
}
DI void rope_table_phase(float2* __restrict__ tg, float2* __restrict__ tm) {
  const int tid = ltid();
  for (int e = blockIdx.x * NTHR + tid; e < LQ * 48; e += gridDim.x * NTHR) {
    const int t = e / 48, k = e - t * 48;
    const bool isg = k < 32;
    const int pi = isg ? k : k - 32, nfreq = isg ? 16 : 8;
    const int row = t >> 6, col = t & 63;
    const float pos = pi < nfreq ? (float)row : (float)col;
    const int f = pi < nfreq ? pi : pi - nfreq;
    const float inv = exp2f(-(float)f / (float)nfreq * 13.287712379549449f);
    const float ang = pos * inv;
    const float2 v = make_float2(cosf(ang), sinf(ang));
    if (isg) tg[t * 32 + pi] = v; else tm[t * 16 + pi] = v;
  }
}

DI int gu_row(int n, int half) { return (n >> 7) * 256 + ((n >> 6) & 1) * 128 + ((n >> 5) & 1) * 64 + half * 32 + (n & 31); }
DI void convT_tile(const float* __restrict__ src, int K, int N, u16* __restrict__ dst, int mode, int t, char* smem) {
  float* tile = (float*)smem;
  const int tn = (N + 63) / 64;
  const int tid_ = ltid();
  const int j = tid_ & 63, i0 = tid_ >> 6;
  const int k0 = (t / tn) * 64, n0 = (t % tn) * 64;
  for (int i = i0; i < 64; i += 4) {
    int n = n0 + j;
    tile[i * 65 + j] = n < N ? src[(size_t)(k0 + i) * N + n] : 0.f;
  }
  __syncthreads();
  for (int i = i0; i < 64; i += 4) {
    int n = n0 + i;
    if (n < N) {
      int row = mode == 0 ? n : gu_row(n, mode - 1);
      dst[(size_t)row * K + k0 + j] = f2bf(tile[j * 65 + i]);
    }
  }
  __syncthreads();
}
DI void convT(const float* __restrict__ src, int K, int N, u16* __restrict__ dst, int mode, char* smem) {
  const int tk = K / 64, tn = (N + 63) / 64;
  for (int t = blockIdx.x; t < tk * tn; t += gridDim.x) convT_tile(src, K, N, dst, mode, t, smem);
}

DI void mod_phase(const Params& p, float* __restrict__ mod, char* smem) {
  float* sc = (float*)smem;
  float* red = sc + 9 * 1024;
  const int tid_ = ltid();
  for (int i = tid_; i < 9 * 1024; i += NTHR) {
    float v = i < 8192 ? p.c[i] : p.c_ctx[i - 8192];
    sc[i] = v / (1.f + expf(-v));
  }
  __syncthreads();
  const int lane = tid_ & 63, kp = tid_ >> 6;
  for (int it = blockIdx.x; it < 2 * 144; it += gridDim.x) {
    const int l = it / 144, nb = (it % 144) * 64;
    const float* w = p.ada_w + (size_t)l * 1024 * 9216 + nb + lane;
    float acc[9];
#pragma unroll
    for (int b = 0; b < 9; ++b) acc[b] = 0.f;
    for (int k = kp * 256; k < kp * 256 + 256; ++k) {
      float wv = w[(size_t)k * 9216];
#pragma unroll
      for (int b = 0; b < 9; ++b) acc[b] += sc[b * 1024 + k] * wv;
    }
#pragma unroll
    for (int b = 0; b < 9; ++b) red[(kp * 9 + b) * 64 + lane] = acc[b];
    __syncthreads();
    for (int o = tid_; o < 9 * 64; o += NTHR) {
      int b = o >> 6, ln = o & 63;
      float s = red[(0 * 9 + b) * 64 + ln] + red[(1 * 9 + b) * 64 + ln] + red[(2 * 9 + b) * 64 + ln] + red[(3 * 9 + b) * 64 + ln];
      mod[((size_t)l * 9 + b) * 9216 + nb + ln] = s + p.ada_b[l * 9216 + nb + ln];
    }
    __syncthreads();
  }
}

DI void hyfilt_phase(const Params& p, int l, int L, float* __restrict__ gT, char* smem) {
  float* z = (float*)smem;
  float* h1 = z + 64;
  float* h2 = h1 + 64;
  float* h3 = h2 + 64;
  float* w1s = z + 256;
  float* w2s = w1s + 33 * 64;
  float* w3s = w2s + 64 * 64;
  const float* w4 = p.hy_f_w4 + l * 64 * 512;
  const int tid = ltid();
  for (int i = tid; i < 33 * 64; i += NTHR) w1s[i] = p.hy_f_w1[l * 33 * 64 + i];
  for (int i = tid; i < 64 * 64; i += NTHR) { w2s[i] = p.hy_f_w2[l * 4096 + i]; w3s[i] = p.hy_f_w3[l * 4096 + i]; }
  float b1v = 0.f, b2v = 0.f, b3v = 0.f, frv = 0.f;
  if (tid < 64) { b1v = p.hy_f_b1[l * 64 + tid]; b2v = p.hy_f_b2[l * 64 + tid]; b3v = p.hy_f_b3[l * 64 + tid]; frv = p.hy_f_freq[l * 64 + tid]; }
  const float min_decay = logf(1e-2f) / 1.5f, max_decay = logf(1e-2f) / 0.3f;
  const float delta = fabsf(min_decay + (max_decay - min_decay) * (float)tid / 255.f);
  __syncthreads();
  for (int t = blockIdx.x; t < L; t += gridDim.x) {
    const float t01 = (float)t / (float)(L - 1);
    if (tid < 33) {
      float zz;
      if (tid == 0) zz = t01;
      else {
        int i = (tid - 1) & 15;
        float f = 1e-4f + (float)i * ((15.f - 1e-4f) / 15.f);
        float wang = 6.283185307179586f * (float)t / (float)L;
        zz = tid <= 16 ? cosf(f * wang) : -sinf(f * wang);
      }
      z[tid] = zz;
    }
    __syncthreads();
    if (tid < 64) {
      float a = b1v;
#pragma unroll 11
      for (int i = 0; i < 33; ++i) a += z[i] * w1s[i * 64 + tid];
      h1[tid] = sinf(frv * a);
    }
    __syncthreads();
    if (tid < 64) {
      float a = b2v;
#pragma unroll 16
      for (int i = 0; i < 64; ++i) a += h1[i] * w2s[i * 64 + tid];
      h2[tid] = sinf(frv * a);
    }
    __syncthreads();
    if (tid < 64) {
      float a = b3v;
#pragma unroll 16
      for (int i = 0; i < 64; ++i) a += h2[i] * w3s[i * 64 + tid];
      h3[tid] = sinf(frv * a);
    }
    __syncthreads();
    float af = 0.f, ab = 0.f;
#pragma unroll 8
    for (int i = 0; i < 64; ++i) {
      af += h3[i] * w4[i * 512 + tid];
      ab += h3[i] * w4[i * 512 + 256 + tid];
    }
    const float dec = expf(-t01 * delta);
    af *= dec;
    ab *= dec;
    if (t == 0) gT[(size_t)(L - 1) * 256 + tid] = af + ab;
    else {
      gT[(size_t)(L - 1 + t) * 256 + tid] = af;
      gT[(size_t)(L - 1 - t) * 256 + tid] = ab;
    }
    __syncthreads();
  }
  __syncthreads();
}

DI void adaln_phase(const float* __restrict__ lat, const float* __restrict__ ctxp, const float* __restrict__ gain,
                    const float* __restrict__ modl, int idx, u16* __restrict__ h, bool skip_ctx) {
  const int tid_ = ltid();
  const int wave = tid_ >> 6, lane = tid_ & 63;
  for (int r = blockIdx.x * 4 + wave; r < T; r += gridDim.x * 4) {
    const int b = r / LT, j = r - b * LT;
    if (skip_ctx && j < LC) continue;
    const float* xr = j < LC ? ctxp + ((size_t)(b * LC + j) << 10) : lat + ((size_t)(b * LQ + j - LC) << 10);
    const int bb = j < LC ? 8 : b;
    const float* shift = modl + bb * 9216 + (3 * idx) * 1024;
    const float* scale = shift + 1024;
    float4 v[4];
    float ss = 0.f;
#pragma unroll
    for (int q = 0; q < 4; ++q) {
      v[q] = *(const float4*)(xr + q * 256 + lane * 4);
      ss += v[q].x * v[q].x + v[q].y * v[q].y + v[q].z * v[q].z + v[q].w * v[q].w;
    }
    ss = wave_sum(ss);
    const float rstd = rsqrtf(ss * (1.f / 1024.f) + EPS);
#pragma unroll
    for (int q = 0; q < 4; ++q) {
      const int c = q * 256 + lane * 4;
      float4 g = *(const float4*)(gain + c), sc = *(const float4*)(scale + c), sh = *(const float4*)(shift + c);
      float y0 = v[q].x * rstd * g.x * (1.f + sc.x) + sh.x;
      float y1 = v[q].y * rstd * g.y * (1.f + sc.y) + sh.y;
      float y2 = v[q].z * rstd * g.z * (1.f + sc.z) + sh.z;
      float y3 = v[q].w * rstd * g.w * (1.f + sc.w) + sh.w;
      uint2 o;
      o.x = pack2(y0, y1);
      o.y = pack2(y2, y3);
      *(uint2*)(h + (size_t)r * D + c) = o;
    }
  }
}

DI bool gemm_decode(int t, int mtiles, int ntiles, int mt_off, bool skip_ctx, int& mt, int& nt) {
  const int mtx = mtiles >> 3;
  const int xcd = t & 7, q = t >> 3;
  const int sr = q / (8 * ntiles);
  const int rem = q - sr * 8 * ntiles;
  const int rows_in = min(8, mtx - sr * 8);
  const int sc = rem / (rows_in * 8);
  const int r2 = rem - sc * rows_in * 8;
  const int i = r2 % rows_in, j = r2 / rows_in;
  mt = (sr * 8 + i) * 8 + xcd;
  nt = sc * 8 + j;
  return !(skip_ctx && ((mt + mt_off) % 34) < 2);
}
template <bool PAIRED, class Epi>
DI void gemm_phase(const u16* __restrict__ A, int lda, const u16* __restrict__ Bt, int ldb, int K, int mtiles, int ntiles,
                   int mt_off, bool skip_ctx, char* smem, Epi& epi) {
  u16* As = (u16*)smem;
  u16* Bs = As + 2 * 128 * 72;
  const int tid = ltid(), lane = tid & 63, wave = tid >> 6;
  const int wm = wave >> 1, wn = wave & 1, lr = lane & 31, lh = lane >> 5;
  const int lrow = tid >> 3, lkc = (tid & 7) * 8;
  const int total = mtiles * ntiles, nk = K >> 6;
  uint4 ra00, ra01, ra02, ra03, rb00, rb01, rb02, rb03, ra10, ra11, ra12, ra13, rb10, rb11, rb12, rb13;
  const u16* Agl;
  const u16* Bgl;
#define GEMM_GLOAD(S, kt_)                                            \
  {                                                                   \
    const int k0_ = (kt_) << 6;                                       \
    ra##S##0 = *(const uint4*)(Agl + k0_);                            \
    ra##S##1 = *(const uint4*)(Agl + (size_t)32 * lda + k0_);         \
    ra##S##2 = *(const uint4*)(Agl + (size_t)64 * lda + k0_);         \
    ra##S##3 = *(const uint4*)(Agl + (size_t)96 * lda + k0_);         \
    rb##S##0 = *(const uint4*)(Bgl + k0_);                            \
    rb##S##1 = *(const uint4*)(Bgl + (size_t)32 * ldb + k0_);         \
    rb##S##2 = *(const uint4*)(Bgl + (size_t)64 * ldb + k0_);         \
    rb##S##3 = *(const uint4*)(Bgl + (size_t)96 * ldb + k0_);         \
  }
#define GEMM_LSTORE(S, buf_)                                          \
  {                                                                   \
    u16* ad_ = As + (buf_) * 128 * 72 + lrow * 72 + lkc;              \
    u16* bd_ = Bs + (buf_) * 128 * 72 + lrow * 72 + lkc;              \
    *(uint4*)(ad_) = ra##S##0;                                        \
    *(uint4*)(ad_ + 32 * 72) = ra##S##1;                              \
    *(uint4*)(ad_ + 64 * 72) = ra##S##2;                              \
    *(uint4*)(ad_ + 96 * 72) = ra##S##3;                              \
    *(uint4*)(bd_) = rb##S##0;                                        \
    *(uint4*)(bd_ + 32 * 72) = rb##S##1;                              \
    *(uint4*)(bd_ + 64 * 72) = rb##S##2;                              \
    *(uint4*)(bd_ + 96 * 72) = rb##S##3;                              \
  }
#define GEMM_COMPUTE(buf_)                                                        \
  {                                                                               \
    const u16* as = As + (buf_) * 128 * 72 + (wm * 64 + lr) * 72 + lh * 8;        \
    const u16* bs = Bs + (buf_) * 128 * 72 + (wn * 64 + lr) * 72 + lh * 8;        \
    _Pragma("unroll") for (int ks = 0; ks < 4; ++ks) {                            \
      bf16x8 a0 = *(const bf16x8*)(as + ks * 16);                                 \
      bf16x8 a1 = *(const bf16x8*)(as + 32 * 72 + ks * 16);                       \
      bf16x8 b0 = *(const bf16x8*)(bs + ks * 16);                                 \
      bf16x8 b1 = *(const bf16x8*)(bs + 32 * 72 + ks * 16);                       \
      acc[0][0] = MFMA32(a0, b0, acc[0][0]);                                      \
      acc[0][1] = MFMA32(a0, b1, acc[0][1]);                                      \
      acc[1][0] = MFMA32(a1, b0, acc[1][0]);                                      \
      acc[1][1] = MFMA32(a1, b1, acc[1][1]);                                      \
    }                                                                             \
  }
  int t = blockIdx.x, mt = 0, nt = 0;
  while (t < total && !gemm_decode(t, mtiles, ntiles, mt_off, skip_ctx, mt, nt)) t += gridDim.x;
  if (t < total) {
    Agl = A + (size_t)(mt * 128 + lrow) * lda + lkc;
    Bgl = Bt + (size_t)(nt * 128 + lrow) * ldb + lkc;
    GEMM_GLOAD(0, 0);
  }
  while (t < total) {
    const int m0 = mt * 128, n0 = nt * 128;
    int tn = t + gridDim.x, mtn = 0, ntn = 0;
    while (tn < total && !gemm_decode(tn, mtiles, ntiles, mt_off, skip_ctx, mtn, ntn)) tn += gridDim.x;
    f32x16 acc[2][2];
#pragma unroll
    for (int a = 0; a < 2; ++a)
#pragma unroll
      for (int b = 0; b < 2; ++b)
#pragma unroll
        for (int i = 0; i < 16; ++i) acc[a][b][i] = 0.f;
    GEMM_LSTORE(0, 0);
    __syncthreads();
    if (nk > 1) GEMM_GLOAD(0, 1);
    for (int kt = 0; kt < nk; kt += 2) {
      if (kt + 2 < nk) GEMM_GLOAD(1, kt + 2);
      GEMM_COMPUTE(0);
      if (kt + 1 < nk) GEMM_LSTORE(0, 1);
      __syncthreads();
      if (kt + 1 >= nk) break;
      if (kt + 3 < nk) GEMM_GLOAD(0, kt + 3);
      GEMM_COMPUTE(1);
      if (kt + 2 < nk) GEMM_LSTORE(1, 0);
      __syncthreads();
    }
    if (tn < total) {
      Agl = A + (size_t)(mtn * 128 + lrow) * lda + lkc;
      Bgl = Bt + (size_t)(ntn * 128 + lrow) * ldb + lkc;
      GEMM_GLOAD(0, 0);
    }
    epi.tile(m0);
    if constexpr (PAIRED) {
      float* stg = (float*)smem + wave * 64 * 36;
#pragma unroll
      for (int mi = 0; mi < 2; ++mi)
#pragma unroll
        for (int i = 0; i < 16; ++i) stg[(mi * 32 + crow(i, lh)) * 36 + lr] = epi.combine(acc[mi][0][i], acc[mi][1][i]);
      __syncthreads();
#pragma unroll
      for (int k = 0; k < 8; ++k) {
        const int idx = lane + 64 * k, row = idx >> 3, c4 = idx & 7;
        const float4 v = *(const float4*)(stg + row * 36 + c4 * 4);
        epi.store4(m0 + wm * 64 + row, (n0 >> 1) + wn * 32 + c4 * 4, v);
      }
      __syncthreads();
    } else if constexpr (Epi::kStaged) {
      float* stg = (float*)smem + wave * 64 * 68;
#pragma unroll
      for (int mi = 0; mi < 2; ++mi)
#pragma unroll
        for (int ni = 0; ni < 2; ++ni)
#pragma unroll
          for (int i = 0; i < 16; ++i) stg[(mi * 32 + crow(i, lh)) * 68 + ni * 32 + lr] = acc[mi][ni][i];
      __syncthreads();
#pragma unroll 4
      for (int k = 0; k < 16; ++k) {
        const int idx = lane + 64 * k, row = idx >> 4, c4 = idx & 15;
        const float4 v = *(const float4*)(stg + row * 68 + c4 * 4);
        epi.row4(m0 + wm * 64 + row, n0 + wn * 64 + c4 * 4, v);
      }
      __syncthreads();
    } else {
#pragma unroll
      for (int mi = 0; mi < 2; ++mi) {
#pragma unroll
        for (int gq = 0; gq < 4; ++gq) {
          const int row0 = m0 + wm * 64 + mi * 32 + 8 * gq + 4 * lh;
          if (PAIRED) {
            const int col = (n0 >> 1) + wn * 32 + lr;
#pragma unroll
            for (int e = 0; e < 4; ++e) epi.pair(row0 + e, col, acc[mi][0][4 * gq + e], acc[mi][1][4 * gq + e]);
          } else {
            epi.quad(row0, n0 + wn * 64 + lr, acc[mi][0][4 * gq], acc[mi][0][4 * gq + 1], acc[mi][0][4 * gq + 2], acc[mi][0][4 * gq + 3]);
            epi.quad(row0, n0 + wn * 64 + 32 + lr, acc[mi][1][4 * gq], acc[mi][1][4 * gq + 1], acc[mi][1][4 * gq + 2], acc[mi][1][4 * gq + 3]);
          }
        }
      }
    }
    t = tn; mt = mtn; nt = ntn;
  }
}

template <class Epi>
DI void gemm_gu_phase(const u16* __restrict__ A, const u16* __restrict__ Bt, int mtiles, bool skip_ctx, char* smem, Epi& epi) {
  constexpr int lda = D, ldb = D, K = D, ntiles = 22, RS = 40;
  u16* As = (u16*)smem;
  u16* Bs = As + 2 * 128 * RS;
  const int tid = ltid(), lane = tid & 63, wave = tid >> 6;
  const int wm = wave >> 1, wn = wave & 1, lr = lane & 31, lh = lane >> 5;
  const int lrow = tid >> 2, lkc = (tid & 3) * 8;
  const int total = mtiles * ntiles, nk = K >> 5;
  uint4 ra00, ra01, rb00, rb01, rb02, rb03, ra10, ra11, rb10, rb11, rb12, rb13;
  const u16* Agl;
  const u16* Bgl;
#define GU_GLOAD(S, kt_)                                              \
  {                                                                   \
    const int k0_ = (kt_) << 5;                                       \
    ra##S##0 = *(const uint4*)(Agl + k0_);                            \
    ra##S##1 = *(const uint4*)(Agl + (size_t)64 * lda + k0_);         \
    rb##S##0 = *(const uint4*)(Bgl + k0_);                            \
    rb##S##1 = *(const uint4*)(Bgl + (size_t)64 * ldb + k0_);         \
    rb##S##2 = *(const uint4*)(Bgl + (size_t)128 * ldb + k0_);        \
    rb##S##3 = *(const uint4*)(Bgl + (size_t)192 * ldb + k0_);        \
  }
#define GU_LSTORE(S, buf_)                                            \
  {                                                                   \
    u16* ad_ = As + (buf_) * 128 * RS + lrow * RS + lkc;              \
    u16* bd_ = Bs + (buf_) * 256 * RS + lrow * RS + lkc;              \
    *(uint4*)(ad_) = ra##S##0;                                        \
    *(uint4*)(ad_ + 64 * RS) = ra##S##1;                              \
    *(uint4*)(bd_) = rb##S##0;                                        \
    *(uint4*)(bd_ + 64 * RS) = rb##S##1;                              \
    *(uint4*)(bd_ + 128 * RS) = rb##S##2;                             \
    *(uint4*)(bd_ + 192 * RS) = rb##S##3;                             \
  }
#define GU_COMPUTE(buf_)                                                          \
  {                                                                               \
    const u16* as = As + (buf_) * 128 * RS + (wm * 64 + lr) * RS + lh * 8;        \
    const u16* bs = Bs + (buf_) * 256 * RS + (wn * 128 + lr) * RS + lh * 8;       \
    _Pragma("unroll") for (int ks = 0; ks < 2; ++ks) {                            \
      bf16x8 a0 = *(const bf16x8*)(as + ks * 16);                                 \
      bf16x8 a1 = *(const bf16x8*)(as + 32 * RS + ks * 16);                       \
      bf16x8 b0 = *(const bf16x8*)(bs + ks * 16);                                 \
      bf16x8 b1 = *(const bf16x8*)(bs + 32 * RS + ks * 16);                       \
      bf16x8 b2 = *(const bf16x8*)(bs + 64 * RS + ks * 16);                       \
      bf16x8 b3 = *(const bf16x8*)(bs + 96 * RS + ks * 16);                       \
      acc[0][0] = MFMA32(a0, b0, acc[0][0]);                                      \
      acc[0][1] = MFMA32(a0, b1, acc[0][1]);                                      \
      acc[0][2] = MFMA32(a0, b2, acc[0][2]);                                      \
      acc[0][3] = MFMA32(a0, b3, acc[0][3]);                                      \
      acc[1][0] = MFMA32(a1, b0, acc[1][0]);                                      \
      acc[1][1] = MFMA32(a1, b1, acc[1][1]);                                      \
      acc[1][2] = MFMA32(a1, b2, acc[1][2]);                                      \
      acc[1][3] = MFMA32(a1, b3, acc[1][3]);                                      \
    }                                                                             \
  }
  int t = blockIdx.x, mt = 0, nt = 0;
  while (t < total && !gemm_decode(t, mtiles, ntiles, 0, skip_ctx, mt, nt)) t += gridDim.x;
  if (t < total) {
    Agl = A + (size_t)(mt * 128 + lrow) * lda + lkc;
    Bgl = Bt + (size_t)(nt * 256 + lrow) * ldb + lkc;
    GU_GLOAD(0, 0);
  }
  while (t < total) {
    const int m0 = mt * 128, n0 = nt * 256;
    int tn = t + gridDim.x, mtn = 0, ntn = 0;
    while (tn < total && !gemm_decode(tn, mtiles, ntiles, 0, skip_ctx, mtn, ntn)) tn += gridDim.x;
    f32x16 acc[2][4];
#pragma unroll
    for (int a = 0; a < 2; ++a)
#pragma unroll
      for (int b = 0; b < 4; ++b)
#pragma unroll
        for (int i = 0; i < 16; ++i) acc[a][b][i] = 0.f;
    GU_LSTORE(0, 0);
    __syncthreads();
    GU_GLOAD(0, 1);
    for (int kt = 0; kt < nk; kt += 2) {
      if (kt + 2 < nk) GU_GLOAD(1, kt + 2);
      GU_COMPUTE(0);
      GU_LSTORE(0, 1);
      __syncthreads();
      if (kt + 3 < nk) GU_GLOAD(0, kt + 3);
      GU_COMPUTE(1);
      if (kt + 2 < nk) GU_LSTORE(1, 0);
      __syncthreads();
    }
    if (tn < total) {
      Agl = A + (size_t)(mtn * 128 + lrow) * lda + lkc;
      Bgl = Bt + (size_t)(ntn * 256 + lrow) * ldb + lkc;
      GU_GLOAD(0, 0);
    }
    {
      float* stg = (float*)smem + wave * 64 * 68;
#pragma unroll
      for (int mi = 0; mi < 2; ++mi)
#pragma unroll
        for (int pi = 0; pi < 2; ++pi)
#pragma unroll
          for (int i = 0; i < 16; ++i)
            stg[(mi * 32 + crow(i, lh)) * 68 + pi * 32 + lr] = epi.combine(acc[mi][2 * pi][i], acc[mi][2 * pi + 1][i]);
      __syncthreads();
#pragma unroll 4
      for (int k = 0; k < 16; ++k) {
        const int idx = lane + 64 * k, row = idx >> 4, c4 = idx & 15;
        const float4 v = *(const float4*)(stg + row * 68 + c4 * 4);
        epi.store4(m0 + wm * 64 + row, (n0 >> 1) + wn * 64 + c4 * 4, v);
      }
      __syncthreads();
    }
    t = tn; mt = mtn; nt = ntn;
  }
}

#define EPI_DEFAULT_QUAD                                                   \
  static constexpr bool kStaged = false;                                   \
  DI void row4(int, int, float4) const {}                                  \
  DI void tile(int) {}                                                     \
  DI void quad(int row0, int col, float a, float b, float c, float d) const { \
    (*this)(row0, col, a);                                                 \
    (*this)(row0 + 1, col, b);                                             \
    (*this)(row0 + 2, col, c);                                             \
    (*this)(row0 + 3, col, d);                                             \
  }
struct EpiGU {
  u16* G;
  DI float combine(float g, float u) const { return g * __builtin_amdgcn_rcpf(1.f + __expf(-g)) * u; }
  DI void store4(int row, int col, float4 v) const {
    uint2 w;
    w.x = pack2(v.x, v.y);
    w.y = pack2(v.z, v.w);
    *(uint2*)(G + (size_t)row * DFF + col) = w;
  }
  DI void pair(int row, int col, float g, float u) const {
    float s = g / (1.f + __expf(-g));
    G[(size_t)row * DFF + col] = f2bf(s * u);
  }
  DI void operator()(int, int, float) const {}
  EPI_DEFAULT_QUAD
};
struct EpiRes {
  const float* lat_in; const float* ctx_in; float* lat_out; float* ctx_out; const float* modl; int gate_chunk; float coef;
  const float* tin; float* tout; const float* gate; int tm0;
  static constexpr bool kStaged = true;
  DI void row4(int row, int col, float4 v) const {
    const size_t o = ((size_t)(row - tm0) << 10) + col;
    const float4 x = *(const float4*)(tin + o);
    const float4 g = *(const float4*)(gate + col);
    float4 y;
    y.x = x.x + coef * g.x * v.x;
    y.y = x.y + coef * g.y * v.y;
    y.z = x.z + coef * g.z * v.z;
    y.w = x.w + coef * g.w * v.w;
    *(float4*)(tout + o) = y;
  }
  DI void tile(int m0) {
    const int b = m0 / LT, j = m0 - b * LT;
    const bool isc = j < LC;
    const size_t off = isc ? (((size_t)(b * LC + j)) << 10) : (((size_t)(b * LQ + j - LC)) << 10);
    tin = (isc ? ctx_in : lat_in) + off;
    tout = (isc ? ctx_out : lat_out) + off;
    gate = modl + (isc ? 8 : b) * 9216 + gate_chunk * 1024;
    tm0 = m0;
  }
  DI void operator()(int row, int col, float v) const {
    const size_t o = ((size_t)(row - tm0) << 10) + col;
    tout[o] = tin[o] + coef * gate[col] * v;
  }
  DI void pair(int, int, float, float) const {}
  DI void quad(int row0, int col, float a, float b, float c, float d) const {
    const float gc = coef * gate[col];
    const size_t o = ((size_t)(row0 - tm0) << 10) + col;
    tout[o] = tin[o] + gc * a;
    tout[o + 1024] = tin[o + 1024] + gc * b;
    tout[o + 2048] = tin[o + 2048] + gc * c;
    tout[o + 3072] = tin[o + 3072] + gc * d;
  }
};
struct EpiStore {
  u16* C; int ldc; int N;
  DI void operator()(int row, int col, float v) const { if (col < N) C[(size_t)row * ldc + col] = f2bf(v); }
  DI void pair(int, int, float, float) const {}
  EPI_DEFAULT_QUAD
};
struct EpiWin {
  u16* p; u16* pT;
  static constexpr bool kStaged = false;
  DI void row4(int, int, float4) const {}
  DI void tile(int) {}
  DI void quad(int row0, int col, float a, float b, float c, float d) const {
    if (col < HYC) {
      uint2 w;
      w.x = pack2(a, b);
      w.y = pack2(c, d);
      *(uint2*)(pT + (size_t)col * TG + row0) = w;
    } else if (col < DIN) {
      u16* q = p + (size_t)row0 * DINP + (col - HYC);
      q[0] = f2bf(a);
      q[DINP] = f2bf(b);
      q[2 * DINP] = f2bf(c);
      q[3 * DINP] = f2bf(d);
    }
  }
  DI void pair(int, int, float, float) const {}
};
struct EpiLoraW {
  u16* C; const float* w0;
  DI void operator()(int row, int col, float v) const {
    float zz = -(w0[col] + v);
    float sp = fmaxf(zz, 0.f) + __logf(1.f + __expf(-fabsf(zz)));
    C[(size_t)row * 256 + col] = f2bf(1.f - __expf(-__expf(-sp - 0.5f)));
  }
  DI void pair(int, int, float, float) const {}
  EPI_DEFAULT_QUAD
};
struct EpiLoraA {
  u16* C; const float* a0;
  DI void operator()(int row, int col, float v) const { C[(size_t)row * 256 + col] = f2bf(sigmoidf_(a0[col] + v)); }
  DI void pair(int, int, float, float) const {}
  EPI_DEFAULT_QUAD
};

struct MixBufs {
  u16 *p, *pt, *u, *qg, *kg, *vtg, *cqn, *ckvn, *qup, *kvup, *qm, *km, *vtm, *rr, *rk, *rv, *rkk, *lwf, *lwb, *laf, *lab, *lg, *ef, *eb, *af, *ab, *gg;
  float *yf, *yb;
};
DI MixBufs mixbufs(char* big, int g) {
  MixBufs m;
  m.p = (u16*)(big + M_P); m.pt = (u16*)(big + M_PT); m.u = (u16*)(big + M_U);
  m.cqn = (u16*)(big + M_CQN); m.ckvn = (u16*)(big + M_CKVN); m.qup = (u16*)(big + M_QUP);
  m.kvup = (u16*)(big + M_KVUP); m.qm = (u16*)(big + M_QM); m.km = (u16*)(big + M_KM); m.vtm = (u16*)(big + M_VTM);
  m.lwf = (u16*)(big + M_LWF); m.lwb = (u16*)(big + M_LWB); m.laf = (u16*)(big + M_LAF); m.lab = (u16*)(big + M_LAB);
  m.lg = (u16*)(big + M_LG);
  char* sc = big + M_SCAN + (size_t)g * SCAN_STRIDE;
  m.rr = (u16*)(sc + 0 * SZ_SC); m.rk = (u16*)(sc + 1 * SZ_SC); m.rv = (u16*)(sc + 2 * SZ_SC); m.rkk = (u16*)(sc + 3 * SZ_SC);
  m.ef = (u16*)(sc + 4 * SZ_SC); m.eb = (u16*)(sc + 5 * SZ_SC); m.af = (u16*)(sc + 6 * SZ_SC); m.ab = (u16*)(sc + 7 * SZ_SC);
  m.gg = (u16*)(sc + 8 * SZ_SC);
  m.qg = (u16*)(sc + 9 * SZ_SC); m.kg = (u16*)(sc + 10 * SZ_SC); m.vtg = m.kg + (size_t)TG * 128;
  m.yf = (float*)(big + M_P) + (size_t)g * 2 * TG * 256;
  m.yb = m.yf + (size_t)TG * 256;
  return m;
}

DI void prep_phase(const Params& p, int l, int g, const MixBufs& m, const float2* __restrict__ ropeg, char* smem) {
  const int tid = ltid(), lane = tid & 63, wave = tid >> 6;
  float muv[18];
#pragma unroll
  for (int q = 0; q < 18; ++q) {
    const int crel = q < 12 ? (q % 3) * 256 + (q / 3) * 64 + lane : 768 + (q - 12) * 64 + lane;
    muv[q] = p.rw_mu[l * 1152 + crel];
  }
  float kkw[4], cqg[4], ckg[2];
#pragma unroll
  for (int hd = 0; hd < 4; ++hd) kkw[hd] = p.rw_k_k[l * 256 + hd * 64 + lane];
#pragma unroll
  for (int q = 0; q < 4; ++q) cqg[q] = p.mla_cq_norm[l * 256 + lane + 64 * q];
#pragma unroll
  for (int q = 0; q < 2; ++q) ckg[q] = p.mla_ckv_norm[l * 128 + lane + 64 * q];
  const float gq_ = p.gqa_q_norm[l * 64 + lane], gk_ = p.gqa_k_norm[l * 64 + lane];
  for (int rl = blockIdx.x * 4 + wave; rl < TG; rl += gridDim.x * 4) {
    const int r = g * TG + rl;
    const int b = r / LT, j = r - b * LT, bl = b - g * BG;
    const bool lat = j >= LC;
    const bool hp = lat ? (j > LC) : (j > 0);
    const bool hn = lat ? (j < LT - 1) : (j < LC - 1);
    const u16* pc = m.p + (size_t)rl * DINP;
    const u16* pp = hp ? pc - DINP : pc;
    const u16* pn = hn ? pc + DINP : pc;
    float ts[18];
#pragma unroll
    for (int q = 0; q < 18; ++q) {
      const int crel = q < 12 ? (q % 3) * 256 + (q / 3) * 64 + lane : 768 + (q - 12) * 64 + lane;
      const int c = 1696 - HYC + crel;
      const float u0 = bf2f(pc[c]);
      const float up = bf2f(pp[c]), un = bf2f(pn[c]);
      const float nb = (hp ? up : 0.f) + (hn ? un : 0.f);
      ts[q] = u0 + muv[q] * (0.5f * nb - u0);
    }
    float cq[4], ckv[2], gv[6];
    u16 vraw[2];
#pragma unroll
    for (int q = 0; q < 4; ++q) cq[q] = bf2f(pc[1280 - HYC + lane + 64 * q]);
#pragma unroll
    for (int q = 0; q < 2; ++q) ckv[q] = bf2f(pc[1536 - HYC + lane + 64 * q]);
#pragma unroll
    for (int hh = 0; hh < 6; ++hh) gv[hh] = bf2f(pc[hh * 64 + lane]);
#pragma unroll
    for (int kvh = 0; kvh < 2; ++kvh) vraw[kvh] = pc[1152 - HYC + kvh * 64 + lane];
    const float2 cs = ropeg[(size_t)(lat ? j - LC : 0) * 32 + (lane >> 1)];
#pragma unroll
    for (int hd = 0; hd < 4; ++hd) {
      const int c = hd * 64 + lane;
      const float sr = ts[hd * 3 + 0], sk = ts[hd * 3 + 1], sv = ts[hd * 3 + 2];
      m.rr[(size_t)rl * 256 + c] = f2bf(sr);
      m.rk[(size_t)rl * 256 + c] = f2bf(sk);
      m.rv[(size_t)rl * 256 + c] = f2bf(sv);
      const float kx = sk * kkw[hd];
      const float ss = wave_sum(kx * kx);
      m.rkk[(size_t)rl * 256 + c] = f2bf(kx / fmaxf(sqrtf(ss), 1e-12f));
    }
    m.lwf[(size_t)rl * 64 + lane] = f2bf(tanhf(ts[12]));
    m.lwb[(size_t)rl * 64 + lane] = f2bf(tanhf(ts[13]));
    m.laf[(size_t)rl * 64 + lane] = f2bf(ts[14]);
    m.lab[(size_t)rl * 64 + lane] = f2bf(ts[15]);
    m.lg[(size_t)rl * 128 + lane] = f2bf(sigmoidf_(ts[16]));
    m.lg[(size_t)rl * 128 + 64 + lane] = f2bf(sigmoidf_(ts[17]));
    {
      float s1 = 0.f, s2 = 0.f;
#pragma unroll
      for (int q = 0; q < 4; ++q) s1 += cq[q] * cq[q];
#pragma unroll
      for (int q = 0; q < 2; ++q) s2 += ckv[q] * ckv[q];
      s1 = wave_sum(s1);
      s2 = wave_sum(s2);
      const float r1 = rsqrtf(s1 * (1.f / 256.f) + EPS), r2 = rsqrtf(s2 * (1.f / 128.f) + EPS);
#pragma unroll
      for (int q = 0; q < 4; ++q) m.cqn[(size_t)rl * 256 + lane + 64 * q] = f2bf(cq[q] * r1 * cqg[q]);
#pragma unroll
      for (int q = 0; q < 2; ++q) m.ckvn[(size_t)rl * 128 + lane + 64 * q] = f2bf(ckv[q] * r2 * ckg[q]);
    }
#pragma unroll
    for (int hh = 0; hh < 6; ++hh) {
      float val = gv[hh];
      const float ss = wave_sum(val * val);
      val = val * rsqrtf(ss * (1.f / 64.f) + EPS) * (hh < 4 ? gq_ : gk_);
      const float other = __shfl_xor(val, 1);
      if (lat) val = (lane & 1) ? other * cs.y + val * cs.x : val * cs.x - other * cs.y;
      if (hh < 4) m.qg[(size_t)rl * 256 + hh * 64 + lane] = f2bf(val);
      else m.kg[(size_t)rl * 128 + (hh - 4) * 64 + lane] = f2bf(val);
    }
#pragma unroll
    for (int kvh = 0; kvh < 2; ++kvh) m.vtg[((size_t)(bl * 2 + kvh) * 64 + lane) * LT + j] = vraw[kvh];
  }
}

DI void mla_fin_phase(const Params& p, int l, int g, const MixBufs& m, const float2* __restrict__ ropem) {
  const int tid = ltid(), lane = tid & 63, wave = tid >> 6;
  const float qn0 = p.mla_q_norm[l * 96 + lane], kn0 = p.mla_k_norm[l * 96 + lane];
  const float qn1 = lane < 32 ? p.mla_q_norm[l * 96 + 64 + lane] : 0.f;
  const float kn1 = lane < 32 ? p.mla_k_norm[l * 96 + 64 + lane] : 0.f;
#pragma unroll 2
  for (int rl = blockIdx.x * 4 + wave; rl < TG; rl += gridDim.x * 4) {
    const int r = g * TG + rl;
    const int b = r / LT, j = r - b * LT, bl = b - g * BG;
    const bool lat = j >= LC;
    const u16* qrow = m.qup + (size_t)rl * 384;
    const u16* kvrow = m.kvup + (size_t)rl * 512;
    float q0[4], q1[4], k0[4];
    u16 vraw[4];
    const float kr = lane < 32 ? bf2f(m.p[(size_t)rl * DINP + 1664 - HYC + lane]) : 0.f;
    const float2 cs = ropem[(size_t)(lat ? j - LC : 0) * 16 + ((lane & 31) >> 1)];
#pragma unroll
    for (int hd = 0; hd < 4; ++hd) {
      q0[hd] = bf2f(qrow[hd * 96 + lane]);
      q1[hd] = lane < 32 ? bf2f(qrow[hd * 96 + 64 + lane]) : 0.f;
      k0[hd] = bf2f(kvrow[hd * 128 + lane]);
      vraw[hd] = kvrow[hd * 128 + 64 + lane];
    }
#pragma unroll
    for (int hd = 0; hd < 4; ++hd) {
      const float sq = wave_sum(q0[hd] * q0[hd] + q1[hd] * q1[hd]);
      const float sk = wave_sum(k0[hd] * k0[hd] + kr * kr);
      const float rq = rsqrtf(sq * (1.f / 96.f) + EPS), rk = rsqrtf(sk * (1.f / 96.f) + EPS);
      const float yq0 = q0[hd] * rq * qn0, yk0 = k0[hd] * rk * kn0;
      float yq1 = q1[hd] * rq * qn1, yk1 = kr * rk * kn1;
      const float oq = __shfl_xor(yq1, 1), ok = __shfl_xor(yk1, 1);
      if (lat) {
        yq1 = (lane & 1) ? oq * cs.y + yq1 * cs.x : yq1 * cs.x - oq * cs.y;
        yk1 = (lane & 1) ? ok * cs.y + yk1 * cs.x : yk1 * cs.x - ok * cs.y;
      }
      u16* dq = m.qm + (size_t)rl * 384 + hd * 96;
      u16* dk = m.km + (size_t)rl * 384 + hd * 96;
      dq[lane] = f2bf(yq0);
      dk[lane] = f2bf(yk0);
      if (lane < 32) {
        dq[64 + lane] = f2bf(yq1);
        dk[64 + lane] = f2bf(yk1);
      }
      m.vtm[((size_t)(bl * 4 + hd) * 64 + lane) * LT + j] = vraw[hd];
    }
  }
}

template <int DQK, int QT>
DI void attn_item(const u16* __restrict__ q, int ldq, const u16* __restrict__ k, int ldk, const u16* __restrict__ vT,
                  u16* __restrict__ out, int ldo, int nkeys, float sl2, float sh2, char* smem) {
  constexpr int KS = DQK + 8;
  constexpr int NKS = DQK / 16;
  constexpr int KCH = DQK / 8;
  constexpr int KPT = 64 * KCH / NTHR;
  u16* Ks = (u16*)smem;
  u16* Vs = Ks + 2 * 64 * KS;
  const int tid = ltid(), lane = tid & 63, wave = tid >> 6, lr = lane & 31, lh = lane >> 5;
  bf16x8 qf[QT][NKS];
#pragma unroll
  for (int qt = 0; qt < QT; ++qt)
#pragma unroll
    for (int ks = 0; ks < NKS; ++ks)
      qf[qt][ks] = *(const bf16x8*)(q + (size_t)(wave * 32 * QT + qt * 32 + lr) * ldq + ks * 16 + lh * 8);
  f32x16 o[QT][2];
#pragma unroll
  for (int a = 0; a < QT; ++a)
#pragma unroll
    for (int b = 0; b < 2; ++b)
#pragma unroll
      for (int i = 0; i < 16; ++i) o[a][b][i] = 0.f;
  float lsum[QT];
#pragma unroll
  for (int a = 0; a < QT; ++a) lsum[a] = 0.f;
  uint4 rk[KPT], rv[2];
#define ATT_GLOAD(key0)                                                                   \
  {                                                                                       \
    _Pragma("unroll") for (int i = 0; i < KPT; ++i) {                                     \
      const int id = tid + NTHR * i, row = id / KCH, ch = id - row * KCH;                 \
      rk[i] = *(const uint4*)(k + (size_t)((key0) + row) * ldk + ch * 8);                 \
    }                                                                                     \
    _Pragma("unroll") for (int i = 0; i < 2; ++i) {                                       \
      const int id = tid + NTHR * i, row = id >> 3, ch = id & 7;                          \
      rv[i] = *(const uint4*)(vT + (size_t)row * LT + (key0) + ch * 8);                   \
    }                                                                                     \
  }
#define ATT_LSTORE(buf_)                                                                  \
  {                                                                                       \
    _Pragma("unroll") for (int i = 0; i < KPT; ++i) {                                     \
      const int id = tid + NTHR * i, row = id / KCH, ch = id - row * KCH;                 \
      *(uint4*)(Ks + (buf_) * 64 * KS + row * KS + ch * 8) = rk[i];                       \
    }                                                                                     \
    _Pragma("unroll") for (int i = 0; i < 2; ++i) {                                       \
      const int id = tid + NTHR * i, row = id >> 3, ch = id & 7;                          \
      *(uint4*)(Vs + (buf_) * 64 * 72 + row * 72 + ch * 8) = rv[i];                       \
    }                                                                                     \
  }
  ATT_GLOAD(0);
  ATT_LSTORE(0);
  __syncthreads();
  const int nkt = nkeys >> 6;
  for (int kt = 0; kt < nkt; ++kt) {
    const int buf = kt & 1;
    if (kt + 1 < nkt) ATT_GLOAD((kt + 1) << 6);
    const u16* kb = Ks + buf * 64 * KS;
    const u16* vb = Vs + buf * 64 * 72;
#pragma unroll
    for (int half = 0; half < 2; ++half) {
      f32x16 s[QT];
#pragma unroll
      for (int qt = 0; qt < QT; ++qt)
#pragma unroll
        for (int i = 0; i < 16; ++i) s[qt][i] = 0.f;
      bf16x8 kf[NKS];
#pragma unroll
      for (int ks = 0; ks < NKS; ++ks) kf[ks] = *(const bf16x8*)(kb + (half * 32 + lr) * KS + ks * 16 + lh * 8);
#pragma unroll
      for (int ks = 0; ks < NKS; ++ks) {
#pragma unroll
        for (int qt = 0; qt < QT; ++qt) s[qt] = MFMA32(kf[ks], qf[qt][ks], s[qt]);
      }
#pragma unroll
      for (int qt = 0; qt < QT; ++qt)
#pragma unroll
        for (int i = 0; i < 16; ++i) {
          float pv = __builtin_amdgcn_exp2f(s[qt][i] * sl2 - sh2);
          lsum[qt] += pv;
          s[qt][i] = pv;
        }
#pragma unroll
      for (int st = 0; st < 2; ++st) {
        bf16x8 pb[QT];
#pragma unroll
        for (int qt = 0; qt < QT; ++qt) {
          uint4 w;
          w.x = pack2(s[qt][8 * st + 0], s[qt][8 * st + 1]);
          w.y = pack2(s[qt][8 * st + 2], s[qt][8 * st + 3]);
          w.z = pack2(s[qt][8 * st + 4], s[qt][8 * st + 5]);
          w.w = pack2(s[qt][8 * st + 6], s[qt][8 * st + 7]);
          pb[qt] = __builtin_bit_cast(bf16x8, w);
        }
        bf16x8 vf[2];
#pragma unroll
        for (int mt = 0; mt < 2; ++mt) {
          const u16* vp = vb + (mt * 32 + lr) * 72 + half * 32 + st * 16 + lh * 4;
          uint2 v0 = *(const uint2*)(vp);
          uint2 v1 = *(const uint2*)(vp + 8);
          uint4 w;
          w.x = v0.x; w.y = v0.y; w.z = v1.x; w.w = v1.y;
          vf[mt] = __builtin_bit_cast(bf16x8, w);
        }
#pragma unroll
        for (int mt = 0; mt < 2; ++mt) {
#pragma unroll
          for (int qt = 0; qt < QT; ++qt) o[qt][mt] = MFMA32(vf[mt], pb[qt], o[qt][mt]);
        }
      }
    }
    if (kt + 1 < nkt) ATT_LSTORE(buf ^ 1);
    __syncthreads();
  }
#pragma unroll
  for (int qt = 0; qt < QT; ++qt) {
    float tot = lsum[qt] + __shfl_xor(lsum[qt], 32);
    float inv = 1.f / tot;
    const int row = wave * 32 * QT + qt * 32 + lr;
#pragma unroll
    for (int mt = 0; mt < 2; ++mt)
#pragma unroll
      for (int gq = 0; gq < 4; ++gq) {
        uint2 w;
        w.x = pack2(o[qt][mt][4 * gq + 0] * inv, o[qt][mt][4 * gq + 1] * inv);
        w.y = pack2(o[qt][mt][4 * gq + 2] * inv, o[qt][mt][4 * gq + 3] * inv);
        *(uint2*)(out + (size_t)row * ldo + mt * 32 + 8 * gq + 4 * lh) = w;
      }
  }
}

DI void hyena_pass(const Params& p, int l, const MixBufs& m, const float* __restrict__ gT, int L, int segoff, int c, char* smem) {
  const int RS = L + 16, US = L + 16;
  unsigned* Rc = (unsigned*)smem;
  u16* U = (u16*)(smem + (size_t)2 * RS * 4);
  const int tid = ltid(), lane = tid & 63, wave = tid >> 6;
  for (int d = tid; d < L; d += NTHR) {
    const int q = 2 * d;
    const float r0 = gT[(size_t)(2 * L - 2 - q) * 256 + c];
    const float r1 = (q + 1 <= 2 * L - 2) ? gT[(size_t)(2 * L - 3 - q) * 256 + c] : 0.f;
    const float r2 = (q + 2 <= 2 * L - 2) ? gT[(size_t)(2 * L - 4 - q) * 256 + c] : 0.f;
    Rc[d] = pack2(r0, r1);
    Rc[RS + d] = pack2(r1, r2);
  }
  const float* cw = p.hy_conv_w + l * 3 * 768;
  const float* cb = p.hy_conv_b + l * 768;
  {
    const float w0a = cw[c], w1a = cw[768 + c], w2a = cw[1536 + c], ba = cb[c];
    const float w0v = cw[512 + c], w1v = cw[768 + 512 + c], w2v = cw[1536 + 512 + c], bv = cb[512 + c];
    for (int b = 0; b < BG; ++b) {
      const u16* x1p = m.pt + (size_t)c * TG + b * LT + segoff;
      const u16* vp = m.pt + (size_t)(512 + c) * TG + b * LT + segoff;
      for (int t = tid; t < L; t += NTHR) {
        float x1 = bf2f(x1p[t]) * w1a + ba;
        float vv = bf2f(vp[t]) * w1v + bv;
        if (t > 0) { x1 += bf2f(x1p[t - 1]) * w0a; vv += bf2f(vp[t - 1]) * w0v; }
        if (t < L - 1) { x1 += bf2f(x1p[t + 1]) * w2a; vv += bf2f(vp[t + 1]) * w2v; }
        U[b * US + t] = f2bf(x1 * vv);
      }
    }
  }
  __syncthreads();
  const int i = lane & 31, h = lane >> 5, bn = i & 3, mb = i >> 2;
  const int par = (L - 1 - i) & 1;
  const float bias = p.hy_bias[l * 256 + c];
  const float w0x = cw[256 + c], w1x = cw[768 + 256 + c], w2x = cw[1536 + 256 + c], bx = cb[256 + c];
  const int nsteps = (L + 208) / 16 + 1;
  for (int sp = wave; sp < L / 256; sp += 4) {
    const int T0 = sp * 256;
    f32x16 acc;
#pragma unroll
    for (int r = 0; r < 16; ++r) acc[r] = 0.f;
    const int delta0 = T0 + 224;
    const int q0 = (L - 1) - delta0 - i + 8 * h;
    const unsigned* ap = Rc + par * RS + (q0 >> 1);
    int s0 = T0 + 32 * mb - delta0;
    const u16* bp = U + bn * US + s0 + 8 * h;
#pragma unroll 2
    for (int st = 0; st < nsteps; ++st) {
      uint4 aw;
      aw.x = ap[0]; aw.y = ap[1]; aw.z = ap[2]; aw.w = ap[3];
      uint4 bw = make_uint4(0u, 0u, 0u, 0u);
      if (s0 >= 0 && s0 <= L - 16) bw = *(const uint4*)bp;
      acc = MFMA32(__builtin_bit_cast(bf16x8, aw), __builtin_bit_cast(bf16x8, bw), acc);
      ap += 8;
      s0 += 16;
      bp += 16;
    }
    const u16* x2p = m.pt + (size_t)(256 + c) * TG + bn * LT + segoff;
    u16* yp = m.u + (size_t)c * TG + bn * LT + segoff;
#pragma unroll
    for (int gq = 0; gq < 4; ++gq) {
      const int t4 = T0 + 32 * mb + 8 * gq + 4 * h;
      float e[6];
#pragma unroll
      for (int k = 0; k < 6; ++k) {
        const int tt = t4 - 1 + k;
        e[k] = (tt >= 0 && tt < L) ? bf2f(x2p[tt]) : 0.f;
      }
      const uint2 uu = *(const uint2*)(U + bn * US + t4);
      const float u0 = bflo_(uu.x), u1 = bfhi_(uu.x), u2 = bflo_(uu.y), u3 = bfhi_(uu.y);
      const float y0 = (e[0] * w0x + e[1] * w1x + e[2] * w2x + bx) * (acc[4 * gq + 0] + u0 * bias);
      const float y1 = (e[1] * w0x + e[2] * w1x + e[3] * w2x + bx) * (acc[4 * gq + 1] + u1 * bias);
      const float y2 = (e[2] * w0x + e[3] * w1x + e[4] * w2x + bx) * (acc[4 * gq + 2] + u2 * bias);
      const float y3 = (e[3] * w0x + e[4] * w1x + e[5] * w2x + bx) * (acc[4 * gq + 3] + u3 * bias);
      uint2 w;
      w.x = pack2(y0, y1);
      w.y = pack2(y2, y3);
      *(uint2*)(yp + t4) = w;
    }
  }
  __syncthreads();
}

#define DPP_ROR(v, n) __builtin_bit_cast(float, __builtin_amdgcn_update_dpp(0, __builtin_bit_cast(int, (v)), 0x120 + (n), 0xf, 0xf, true))
DI float row_allsum(float v) {
  v += DPP_ROR(v, 8);
  v += DPP_ROR(v, 4);
  v += DPP_ROR(v, 2);
  v += DPP_ROR(v, 1);
  return v;
}
DI float bflo(unsigned w) { return __uint_as_float(w << 16); }
DI float bfhi(unsigned w) { return __uint_as_float(w & 0xffff0000u); }
DI void scan_item(const Params& p, int l, const MixBufs& m, int bl, int hd, int dir, int rq, char* smem) {
  constexpr int TC = 16;
  constexpr int NCH = LT / TC;
  constexpr int BUF = 5 * TC * 64 + TC * 16;
  float* sbase = (float*)smem;
  float* sy = sbase + 2 * BUF;
  const int tid = ltid(), lane = tid & 63, wave = tid >> 6;
  const int kq = lane & 15, rloc = wave * 4 + (lane >> 4);
  const u16* eD = dir ? m.eb : m.ef;
  const u16* aD = dir ? m.ab : m.af;
  float* yD = dir ? m.yb : m.yf;
  const size_t rbase = (size_t)bl * LT;
  const int ss = tid >> 4, su = tid & 15, sc = su & 7;
  float kav[8];
#pragma unroll
  for (int i = 0; i < 8; ++i) kav[i] = p.rw_k_a[l * 256 + hd * 64 + sc * 8 + i];
  uint4 g0, g1, g2;
  g2.x = g2.y = g2.z = g2.w = 0u;
#define SCAN_JMAP(i) (dir ? ((i) < LC ? LC - 1 - (i) : LT - 1 - ((i) - LC)) : (i))
#define SCAN_GLOAD(i0)                                                                         \
  {                                                                                            \
    const int ii_ = (i0) + ss;                                                                 \
    const int j_ = SCAN_JMAP(ii_);                                                             \
    const size_t o_ = (rbase + j_) * 256 + hd * 64 + sc * 8;                                   \
    if (su < 8) {                                                                              \
      g0 = *(const uint4*)(m.rkk + o_);                                                        \
      g1 = *(const uint4*)(aD + o_);                                                           \
      g2 = *(const uint4*)(m.rk + o_);                                                         \
    } else {                                                                                   \
      g0 = *(const uint4*)(eD + o_);                                                           \
      g1 = *(const uint4*)(m.rr + o_);                                                         \
      if (sc < 2) g2 = *(const uint4*)(m.rv + (rbase + j_) * 256 + hd * 64 + rq * 16 + sc * 8); \
    }                                                                                          \
  }
#define SCAN_LSTORE(buf_)                                                                      \
  {                                                                                            \
    float* B_ = sbase + (buf_) * BUF;                                                          \
    const unsigned w0_[4] = {g0.x, g0.y, g0.z, g0.w};                                          \
    const unsigned w1_[4] = {g1.x, g1.y, g1.z, g1.w};                                          \
    const unsigned w2_[4] = {g2.x, g2.y, g2.z, g2.w};                                          \
    if (su < 8) {                                                                              \
      float kk_[8], bb_[8], dd_[8];                                                            \
      _Pragma("unroll") for (int q_ = 0; q_ < 4; ++q_) {                                       \
        const float k0_ = bflo(w0_[q_]), k1_ = bfhi(w0_[q_]);                                  \
        const float a0_ = bflo(w1_[q_]), a1_ = bfhi(w1_[q_]);                                  \
        const float v0_ = bflo(w2_[q_]), v1_ = bfhi(w2_[q_]);                                  \
        kk_[2 * q_] = k0_; kk_[2 * q_ + 1] = k1_;                                              \
        bb_[2 * q_] = k0_ * a0_; bb_[2 * q_ + 1] = k1_ * a1_;                                  \
        dd_[2 * q_] = v0_ * (1.f + (a0_ - 1.f) * kav[2 * q_]);                                 \
        dd_[2 * q_ + 1] = v1_ * (1.f + (a1_ - 1.f) * kav[2 * q_ + 1]);                         \
      }                                                                                        \
      float* d0_ = B_ + ss * 64 + sc * 8;                                                      \
      *(float4*)(d0_) = make_float4(kk_[0], kk_[1], kk_[2], kk_[3]);                           \
      *(float4*)(d0_ + 4) = make_float4(kk_[4], kk_[5], kk_[6], kk_[7]);                       \
      *(float4*)(d0_ + 2048) = make_float4(bb_[0], bb_[1], bb_[2], bb_[3]);                    \
      *(float4*)(d0_ + 2052) = make_float4(bb_[4], bb_[5], bb_[6], bb_[7]);                    \
      *(float4*)(d0_ + 3072) = make_float4(dd_[0], dd_[1], dd_[2], dd_[3]);                    \
      *(float4*)(d0_ + 3076) = make_float4(dd_[4], dd_[5], dd_[6], dd_[7]);                    \
    } else {                                                                                   \
      float ww_[8], rr_[8], vv_[8];                                                            \
      _Pragma("unroll") for (int q_ = 0; q_ < 4; ++q_) {                                       \
        ww_[2 * q_] = 1.f - bflo(w0_[q_]); ww_[2 * q_ + 1] = 1.f - bfhi(w0_[q_]);              \
        rr_[2 * q_] = bflo(w1_[q_]); rr_[2 * q_ + 1] = bfhi(w1_[q_]);                          \
        vv_[2 * q_] = bflo(w2_[q_]); vv_[2 * q_ + 1] = bfhi(w2_[q_]);                          \
      }                                                                                        \
      float* d0_ = B_ + ss * 64 + sc * 8;                                                      \
      *(float4*)(d0_ + 1024) = make_float4(ww_[0], ww_[1], ww_[2], ww_[3]);                    \
      *(float4*)(d0_ + 1028) = make_float4(ww_[4], ww_[5], ww_[6], ww_[7]);                    \
      *(float4*)(d0_ + 4096) = make_float4(rr_[0], rr_[1], rr_[2], rr_[3]);                    \
      *(float4*)(d0_ + 4100) = make_float4(rr_[4], rr_[5], rr_[6], rr_[7]);                    \
      if (sc < 2) {                                                                            \
        float* d1_ = B_ + 5120 + ss * 16 + sc * 8;                                             \
        *(float4*)(d1_) = make_float4(vv_[0], vv_[1], vv_[2], vv_[3]);                         \
        *(float4*)(d1_ + 4) = make_float4(vv_[4], vv_[5], vv_[6], vv_[7]);                     \
      }                                                                                        \
    }                                                                                          \
  }
  f32x2_t SA = {0.f, 0.f}, SB = {0.f, 0.f};
  __builtin_amdgcn_s_setprio(3);
  SCAN_GLOAD(0);
  SCAN_LSTORE(0);
  __syncthreads();
  for (int c = 0; c < NCH; ++c) {
    const int buf = c & 1;
    if (c + 1 < NCH) SCAN_GLOAD((c + 1) * TC);
    const float* B = sbase + buf * BUF;
    float* syb = sy + buf * TC * 16;
    float ypart[TC];
    float4 kkv[TC], wwv[TC], bbv[TC], ddv[TC], rrv[TC];
    float vvv[TC];
    constexpr int PF = 2;
#pragma unroll
    for (int st = 0; st < PF; ++st) {
      kkv[st] = *(const float4*)(B + st * 64 + kq * 4);
      wwv[st] = *(const float4*)(B + 1024 + st * 64 + kq * 4);
      bbv[st] = *(const float4*)(B + 2048 + st * 64 + kq * 4);
      ddv[st] = *(const float4*)(B + 3072 + st * 64 + kq * 4);
      rrv[st] = *(const float4*)(B + 4096 + st * 64 + kq * 4);
      vvv[st] = B[5120 + st * 16 + rloc];
    }
    __builtin_amdgcn_sched_barrier(0);
#pragma unroll
    for (int st = 0; st < TC; ++st) {
      if (st + PF < TC) {
        kkv[st + PF] = *(const float4*)(B + (st + PF) * 64 + kq * 4);
        wwv[st + PF] = *(const float4*)(B + 1024 + (st + PF) * 64 + kq * 4);
        bbv[st + PF] = *(const float4*)(B + 2048 + (st + PF) * 64 + kq * 4);
        ddv[st + PF] = *(const float4*)(B + 3072 + (st + PF) * 64 + kq * 4);
        rrv[st + PF] = *(const float4*)(B + 4096 + (st + PF) * 64 + kq * 4);
        vvv[st + PF] = B[5120 + (st + PF) * 16 + rloc];
      }
      __builtin_amdgcn_sched_barrier(0);
      const float4 kk = kkv[st], ww = wwv[st], bb = bbv[st], dd = ddv[st], rr = rrv[st];
      const float vv = vvv[st];
      const f32x2_t k01 = {kk.x, kk.y}, k23 = {kk.z, kk.w}, w01 = {ww.x, ww.y}, w23 = {ww.z, ww.w};
      const f32x2_t b01 = {bb.x, bb.y}, b23 = {bb.z, bb.w}, d01 = {dd.x, dd.y}, d23 = {dd.z, dd.w};
      const f32x2_t r01 = {rr.x, rr.y}, r23 = {rr.z, rr.w}, v2 = {vv, vv};
      const f32x2_t pp2 = SA * k01 + SB * k23;
      const float part = pp2.x + pp2.y;
      const f32x2_t cA = SA * w01 + v2 * d01, cB = SB * w23 + v2 * d23;
      const float sa = -row_allsum(part);
      const f32x2_t sa2 = {sa, sa};
      SA = cA + sa2 * b01;
      SB = cB + sa2 * b23;
      const f32x2_t yy2 = SA * r01 + SB * r23;
      ypart[st] = yy2.x + yy2.y;
    }
#pragma unroll
    for (int st = 0; st < TC; ++st) ypart[st] = row_allsum(ypart[st]);
    if (kq == 0) {
#pragma unroll
      for (int st = 0; st < TC; ++st) syb[st * 16 + rloc] = ypart[st];
    }
    if (c + 1 < NCH) SCAN_LSTORE(buf ^ 1);
    __syncthreads();
    {
      const int st = tid >> 4, r_ = tid & 15;
      const int ii = c * TC + st;
      const int j = SCAN_JMAP(ii);
      yD[(rbase + j) * 256 + hd * 64 + rq * 16 + r_] = syb[st * 16 + r_];
    }
  }
  __builtin_amdgcn_s_setprio(0);
  __syncthreads();
}

DI void readout_hy_phase(int g, const MixBufs& m, u16* __restrict__ ymix, bool skip_ctx, char* smem) {
  const int tid = ltid();
  {
    u16* tile = (u16*)smem;
    for (int tl = blockIdx.x; tl < (TG / 64) * 4; tl += gridDim.x) {
      const int rl0 = (tl >> 2) * 64, c0 = (tl & 3) * 64;
      const int r0 = g * TG + rl0;
      if (skip_ctx && (r0 % LT) < LC) continue;
#pragma unroll
      for (int k = 0; k < 2; ++k) {
        const int id = tid + NTHR * k, ch = id >> 3, part = id & 7;
        *(uint4*)(tile + ch * 72 + part * 8) = *(const uint4*)(m.u + (size_t)(c0 + ch) * TG + rl0 + part * 8);
      }
      __syncthreads();
#pragma unroll
      for (int k = 0; k < 2; ++k) {
        const int id = tid + NTHR * k, tok = id >> 3, part = id & 7;
        const u16* tp = tile + (part * 8) * 72 + tok;
        uint4 w;
        w.x = (unsigned)tp[0] | ((unsigned)tp[72] << 16);
        w.y = (unsigned)tp[2 * 72] | ((unsigned)tp[3 * 72] << 16);
        w.z = (unsigned)tp[4 * 72] | ((unsigned)tp[5 * 72] << 16);
        w.w = (unsigned)tp[6 * 72] | ((unsigned)tp[7 * 72] << 16);
        *(uint4*)(ymix + (size_t)(r0 + tok) * D + c0 + part * 8) = w;
      }
      __syncthreads();
    }
  }
}

DI void readout_rw_phase(const Params& p, int l, int g, const MixBufs& m, u16* __restrict__ ymix, bool skip_ctx) {
  const int tid = ltid(), lane = tid & 63, wave = tid >> 6;
  float lnw[4], lnb[4], kaa[4], rkw[4];
#pragma unroll
  for (int hd = 0; hd < 4; ++hd) {
    const int c = l * 256 + hd * 64 + lane;
    lnw[hd] = p.rw_ln_w[c];
    lnb[hd] = p.rw_ln_b[c];
    kaa[hd] = p.rw_k_a[c];
    rkw[hd] = p.rw_r_k[c];
  }
  for (int rl = blockIdx.x * 4 + wave; rl < TG; rl += gridDim.x * 4) {
    const int r = g * TG + rl;
    const int j = r % LT;
    if (skip_ctx && j < LC) continue;
    float y[4], rr[4], kv[4], vv[4], af[4], ab[4], gg[4];
#pragma unroll
    for (int hd = 0; hd < 4; ++hd) {
      const size_t o = (size_t)rl * 256 + hd * 64 + lane;
      y[hd] = m.yf[o] + m.yb[o];
      rr[hd] = bf2f(m.rr[o]);
      kv[hd] = bf2f(m.rk[o]);
      vv[hd] = bf2f(m.rv[o]);
      af[hd] = bf2f(m.af[o]);
      ab[hd] = bf2f(m.ab[o]);
      gg[hd] = bf2f(m.gg[o]);
    }
#pragma unroll
    for (int hd = 0; hd < 4; ++hd) {
      const float mean = wave_sum(y[hd]) * (1.f / 64.f);
      const float dv = y[hd] - mean;
      const float var = wave_sum(dv * dv) * (1.f / 64.f);
      const float yn = dv * rsqrtf(var + 64e-5f) * lnw[hd] + lnb[hd];
      const float t1 = rr[hd] * kv[hd] * (1.f + (af[hd] - 1.f) * kaa[hd]) * rkw[hd] + rr[hd] * kv[hd] * (1.f + (ab[hd] - 1.f) * kaa[hd]) * rkw[hd];
      const float bonus = wave_sum(t1) * vv[hd];
      ymix[(size_t)r * D + 768 + hd * 64 + lane] = f2bf((yn + bonus) * gg[hd]);
    }
  }
}

#define XB_TMO      128
#define XB_XCNT(j)  (256  + 64 * (j))
#define XB_XSUB(j)  (1280 + 64 * (j))
#define XB_XGEN(j)  (2304 + 64 * (j))
#define XB_TOP      3328
#define XB_TOPGEN   3392
#define XCD_BAR_WORDS 3456
#define XB_SPIN_CAP (1u << 21)
#define LAS __attribute__((address_space(3)))
DI unsigned xb_ld(unsigned* p) { return __hip_atomic_load(p, __ATOMIC_RELAXED, __HIP_MEMORY_SCOPE_AGENT); }
DI unsigned xb_add(unsigned* p, unsigned v) { return __hip_atomic_fetch_add(p, v, __ATOMIC_RELAXED, __HIP_MEMORY_SCOPE_AGENT); }
DI unsigned xb_xcc_id() { return (unsigned)__builtin_amdgcn_s_getreg((3 << 11) | 20) & 0xFu; }
#define XB_SPIN(cond, bar) do { unsigned _sp = 0; while (cond) { __builtin_amdgcn_s_sleep(1); \
    if ((++_sp & 255u) == 0u) { if (xb_ld(&(bar)[XB_TMO])) break; if (_sp > XB_SPIN_CAP) { atomicAdd(&(bar)[XB_TMO], 1u); break; } } } } while (0)
struct XcdBarrier { unsigned* bar; unsigned x; volatile LAS unsigned* st; };
DI XcdBarrier xcd_barrier_post(unsigned* bar, volatile LAS unsigned* st) {
  XcdBarrier b; b.bar = bar; b.x = xb_xcc_id(); b.st = st;
  if (threadIdx.x == 0) (void)xb_add(&bar[XB_XCNT(b.x)], 1u);
  return b;
}
DI void xcd_barrier_complete(unsigned* bar, unsigned x, unsigned& nloc, unsigned& nx) {
  const unsigned G = gridDim.x * gridDim.y * gridDim.z;
  unsigned sum, cnt, mine, sp = 0u;
  for (;;) {
    sum = 0u; cnt = 0u; mine = 0u;
#pragma unroll
    for (unsigned j = 0; j < 16; ++j) { const unsigned c = xb_ld(&bar[XB_XCNT(j)]); sum += c; cnt += (c > 0u) ? 1u : 0u; mine = (j == x) ? c : mine; }
    if (sum == G) break;
    __builtin_amdgcn_s_sleep(1);
    if ((++sp & 255u) == 0u) { if (xb_ld(&bar[XB_TMO])) break; if (sp > XB_SPIN_CAP) { atomicAdd(&bar[XB_TMO], 1u); break; } }
  }
  nloc = mine > 0u ? mine : 1u; nx = cnt > 0u ? cnt : 1u;
}
DI void xcd_barrier(const XcdBarrier& b) {
  asm volatile("s_waitcnt vmcnt(0)" ::: "memory");
  __syncthreads();
  if (threadIdx.x == 0) {
    unsigned* bar = b.bar;
    __builtin_amdgcn_s_waitcnt(0);
    unsigned nloc = b.st[0], nx = b.st[1];
    if (nloc == 0u) { xcd_barrier_complete(bar, b.x, nloc, nx); b.st[0] = nloc; b.st[1] = nx; }
    const unsigned old = xb_add(&bar[XB_XSUB(b.x)], 1u);
    const unsigned gen = old / nloc;
    if (old + 1u == (gen + 1u) * nloc) {
      __builtin_amdgcn_fence(__ATOMIC_RELEASE, "agent");
      asm volatile("s_waitcnt vmcnt(0)" ::: "memory");
      const unsigned og = xb_add(&bar[XB_TOP], 1u);
      const unsigned tg = og / nx;
      if (og + 1u == (tg + 1u) * nx) xb_add(&bar[XB_TOPGEN], 1u);
      else XB_SPIN(xb_ld(&bar[XB_TOPGEN]) == tg, bar);
      __builtin_amdgcn_fence(__ATOMIC_ACQUIRE, "agent");
      xb_add(&bar[XB_XGEN(b.x)], 1u);
      asm volatile("s_waitcnt vmcnt(0)" ::: "memory");
    } else {
      XB_SPIN(xb_ld(&bar[XB_XGEN(b.x)]) == gen, bar);
      __builtin_amdgcn_fence(__ATOMIC_ACQUIRE, "agent");
      asm volatile("s_waitcnt vmcnt(0)" ::: "memory");
    }
  }
  __syncthreads();
}

DI int conv_job_tiles(int j) {
  return (j <= 2 || j >= 12) ? 704 : j == 3 ? 720 : j == 4 ? 24 : j == 5 ? 16 : j <= 9 ? 4 : j == 10 ? 8 : 256;
}
DI void conv_job_tile(const Params& p, int l, int j, int t, u16* W, char* smem) {
  switch (j) {
    case 0: convT_tile(p.ffn1_gate + (size_t)l * D * DFF, D, DFF, W + W_GU1, 1, t, smem); break;
    case 1: convT_tile(p.ffn1_up + (size_t)l * D * DFF, D, DFF, W + W_GU1, 2, t, smem); break;
    case 2: convT_tile(p.ffn1_down + (size_t)l * D * DFF, DFF, D, W + W_D1, 0, t, smem); break;
    case 3: convT_tile(p.w_in + (size_t)l * D * DIN, D, DIN, W + W_IN, 0, t, smem); break;
    case 4: convT_tile(p.mla_w_uq + (size_t)l * 256 * 384, 256, 384, W + W_UQ, 0, t, smem); break;
    case 5: convT_tile(p.mla_w_ukv + (size_t)l * 128 * 512, 128, 512, W + W_UKV, 0, t, smem); break;
    case 6: convT_tile(p.rw_w2 + (size_t)(l * 2 + 0) * 64 * 256, 64, 256, W + W_W2, 0, t, smem); break;
    case 7: convT_tile(p.rw_w2 + (size_t)(l * 2 + 1) * 64 * 256, 64, 256, W + W_W2 + (size_t)256 * 64, 0, t, smem); break;
    case 8: convT_tile(p.rw_a2 + (size_t)(l * 2 + 0) * 64 * 256, 64, 256, W + W_A2, 0, t, smem); break;
    case 9: convT_tile(p.rw_a2 + (size_t)(l * 2 + 1) * 64 * 256, 64, 256, W + W_A2 + (size_t)256 * 64, 0, t, smem); break;
    case 10: convT_tile(p.rw_g2 + (size_t)l * 128 * 256, 128, 256, W + W_G2, 0, t, smem); break;
    case 11: convT_tile(p.w_out + (size_t)l * D * D, D, D, W + W_OUT, 0, t, smem); break;
    case 12: convT_tile(p.ffn2_gate + (size_t)l * D * DFF, D, DFF, W + W_GU2, 1, t, smem); break;
    case 13: convT_tile(p.ffn2_up + (size_t)l * D * DFF, D, DFF, W + W_GU2, 2, t, smem); break;
    default: convT_tile(p.ffn2_down + (size_t)l * D * DFF, DFF, D, W + W_D2, 0, t, smem); break;
  }
}
constexpr int AUX_EARLY = 704 * 3 + 720 + 24 + 16 + 16 + 8;
constexpr int AUX_LATE = 256 + 704 * 3;
DI void aux_tile(const Params& p, int l, int a, u16* W, char* smem) {
  int jl = 1, j0 = 11;
  if (l == 0 && a < AUX_EARLY) j0 = 0;
  else if (l == 0) { a -= AUX_EARLY; jl = 0; }
  int j = j0;
  for (;;) {
    const int n = conv_job_tiles(j);
    if (a < n) break;
    a -= n;
    ++j;
  }
  conv_job_tile(p, jl, j, a, W, smem);
}

__global__ void __launch_bounds__(NTHR, 2) fwd_megakernel(Params p) {
  cg::grid_group grid = cg::this_grid();
  __shared__ __attribute__((aligned(16))) char smem[73728];
  __shared__ int s_item;
  __shared__ uint4 xb_words;
  if (threadIdx.x == 0) xb_words = make_uint4(0u, 0u, 0u, 0u);
  __syncthreads();
  const XcdBarrier xb = xcd_barrier_post((unsigned*)(p.ws + OFF_BAR), (volatile LAS unsigned*)&xb_words);
  char* ws = p.ws;
  float* ctxs = (float*)(ws + OFF_CTX);
  float* mod = (float*)(ws + OFF_MOD);
  u16* hbuf = (u16*)(ws + OFF_H);
  char* big = ws + OFF_BIG;
  u16* Gbuf = (u16*)big;
  u16* const Wl = (u16*)(ws + OFF_W);
  float* const filt = (float*)(ws + OFF_FILT);

  for (int j = 0; j <= 10; ++j)
    for (int t = blockIdx.x; t < conv_job_tiles(j); t += gridDim.x) conv_job_tile(p, 0, j, t, Wl, smem);
  hyfilt_phase(p, 0, LQ, filt, smem);
  hyfilt_phase(p, 0, LC, (float*)(ws + OFF_FILTC), smem);
  rope_table_phase((float2*)(ws + OFF_ROPEG), (float2*)(ws + OFF_ROPEM));
  mod_phase(p, mod, smem);
  grid.sync();

  for (int l = 0; l < 2; ++l) {
    const bool last = (l == 1);
    const u16* W = Wl;
    if (l == 1) {
      hyfilt_phase(p, 1, LQ, filt, smem);
    }
    const float* modl = mod + (size_t)l * 9 * 9216;
    const float* lat_in = (l == 0) ? p.x : p.out;
    const float* ctx_in = (l == 0) ? p.ctx : ctxs;

    adaln_phase(lat_in, ctx_in, p.norm_ffn1 + l * D, modl, 0, hbuf, false);
    xcd_barrier(xb);
    {
      EpiGU e{Gbuf};
      gemm_gu_phase(hbuf, W + W_GU1, T / 128, false, smem, e);
    }
    xcd_barrier(xb);
    {
      EpiRes e{lat_in, ctx_in, p.out, ctxs, modl, 2, 0.5f, nullptr, nullptr, nullptr, 0};
      gemm_phase<false>(Gbuf, DFF, W + W_D1, DFF, DFF, T / 128, 8, 0, false, smem, e);
    }
    xcd_barrier(xb);
    adaln_phase(p.out, ctxs, p.norm_mix + l * D, modl, 1, hbuf, false);
    xcd_barrier(xb);
    for (int g = 0; g < NG; ++g) {
      const MixBufs m = mixbufs(big, g);
      const u16* hg = hbuf + (size_t)g * TG * D;
      {
        EpiWin e{m.p, m.pt};
        gemm_phase<false>(hg, D, W + W_IN, D, D, TG / 128, 23, 0, false, smem, e);
      }
      xcd_barrier(xb);
      for (int rep = 0; rep < REP_ROW; ++rep) prep_phase(p, l, g, m, (const float2*)(ws + OFF_ROPEG), smem);
      xcd_barrier(xb);
      {
        EpiStore e1{m.qup, 384, 384};
        gemm_phase<false>(m.cqn, 256, W + W_UQ, 256, 256, TG / 128, 3, 0, false, smem, e1);
        EpiStore e2{m.kvup, 512, 512};
        gemm_phase<false>(m.ckvn, 128, W + W_UKV, 128, 128, TG / 128, 4, 0, false, smem, e2);
        EpiLoraW e3{m.ef, p.rw_w0 + (l * 2 + 0) * 256};
        gemm_phase<false>(m.lwf, 64, W + W_W2, 64, 64, TG / 128, 2, 0, false, smem, e3);
        EpiLoraW e4{m.eb, p.rw_w0 + (l * 2 + 1) * 256};
        gemm_phase<false>(m.lwb, 64, W + W_W2 + 256 * 64, 64, 64, TG / 128, 2, 0, false, smem, e4);
        EpiLoraA e5{m.af, p.rw_a0 + (l * 2 + 0) * 256};
        gemm_phase<false>(m.laf, 64, W + W_A2, 64, 64, TG / 128, 2, 0, false, smem, e5);
        EpiLoraA e6{m.ab, p.rw_a0 + (l * 2 + 1) * 256};
        gemm_phase<false>(m.lab, 64, W + W_A2 + 256 * 64, 64, 64, TG / 128, 2, 0, false, smem, e6);
        EpiStore e7{m.gg, 256, 256};
        gemm_phase<false>(m.lg, 128, W + W_G2, 128, 128, TG / 128, 2, 0, false, smem, e7);
      }
      xcd_barrier(xb);
      for (int rep = 0; rep < REP_ROW; ++rep) mla_fin_phase(p, l, g, m, (const float2*)(ws + OFF_ROPEM));
      xcd_barrier(xb);
      {
        u16* ymix = hbuf;
        const int n_scan = (g == NG - 1) ? NG * BG * 4 * 2 * 4 : 0;
        const int qt_per_b = last ? 16 : 17;
        const int n_att = BG * 4 * qt_per_b;
        const int n_gqa = (g == NG - 1) ? NG * n_att : 0;
        const int n_hy = 256;
        const bool fine = (g != NG - 1);
        const int qt_mla = fine ? 2 * qt_per_b : qt_per_b;
        const int n_mla = BG * 4 * qt_mla;
        const int total = n_scan + n_mla + n_gqa + n_hy;
        float gq = 0.f, gk = 0.f, mq = 0.f, mk = 0.f;
        for (int i = 0; i < 64; ++i) { gq = fmaxf(gq, fabsf(p.gqa_q_norm[l * 64 + i])); gk = fmaxf(gk, fabsf(p.gqa_k_norm[l * 64 + i])); }
        for (int i = 0; i < 96; ++i) { mq = fmaxf(mq, fabsf(p.mla_q_norm[l * 96 + i])); mk = fmaxf(mk, fabsf(p.mla_k_norm[l * 96 + i])); }
        const float L2E = 1.4426950408889634f;
        const float sc_g = 0.125f, sc_m = 0.10206207261596575f;
        const float sh_g = (64.f * gq * gk * sc_g * 1.02f + 0.5f) * L2E;
        const float sh_m = (96.f * mq * mk * sc_m * 1.02f + 0.5f) * L2E;
        int* cnt = (int*)(ws + OFF_CNT) + (l * NG + g);
        for (;;) {
          if (threadIdx.x == 0) s_item = atomicAdd(cnt, 1);
          __syncthreads();
          const int it = s_item;
          __syncthreads();
          if (it >= total) break;
          if (it < n_scan) {
            const int sg = it >> 7, bl = (it >> 5) & 3, hd = (it >> 3) & 3, dir = (it >> 2) & 1, rq = it & 3;
            const MixBufs ms = mixbufs(big, sg);
            scan_item(p, l, ms, bl, hd, dir, rq, smem);
          } else if (it < n_scan + n_mla + n_gqa) {
            int a = it - n_scan;
            if (a < n_mla) {
              const int bl = a / (4 * qt_mla);
              const int rem = a - bl * 4 * qt_mla;
              const int hd = rem / qt_mla;
              const int qt = rem - hd * qt_mla;
              if (fine) {
                const int j0 = qt < 32 ? LC + qt * 128 : (qt - 32) * 128;
                const int nkeys = qt < 32 ? LT : LC;
                const size_t rl0 = (size_t)bl * LT + j0, rg0 = (size_t)(g * BG + bl) * LT + j0;
                attn_item<96, 1>(m.qm + rl0 * 384 + hd * 96, 384, m.km + (size_t)bl * LT * 384 + hd * 96, 384,
                              m.vtm + (size_t)(bl * 4 + hd) * 64 * LT, ymix + rg0 * D + 512 + hd * 64, D, nkeys, sc_m * L2E, sh_m, smem);
              } else {
                const int j0 = qt < 16 ? LC + qt * 256 : 0;
                const int nkeys = qt < 16 ? LT : LC;
                const size_t rl0 = (size_t)bl * LT + j0, rg0 = (size_t)(g * BG + bl) * LT + j0;
                attn_item<96, 2>(m.qm + rl0 * 384 + hd * 96, 384, m.km + (size_t)bl * LT * 384 + hd * 96, 384,
                              m.vtm + (size_t)(bl * 4 + hd) * 64 * LT, ymix + rg0 * D + 512 + hd * 64, D, nkeys, sc_m * L2E, sh_m, smem);
              }
            } else {
              a -= n_mla;
              const int ag = a / n_att;
              a -= ag * n_att;
              const int bl = a / (4 * qt_per_b);
              const int rem = a - bl * 4 * qt_per_b;
              const int hd = rem / qt_per_b;
              const int qt = rem - hd * qt_per_b;
              const int j0 = qt < 16 ? LC + qt * 256 : 0;
              const int nkeys = qt < 16 ? LT : LC;
              const size_t rl0 = (size_t)bl * LT + j0, rg0 = (size_t)(ag * BG + bl) * LT + j0;
              const MixBufs ma = mixbufs(big, ag);
              const int kvh = hd >> 1;
              attn_item<64, 2>(ma.qg + rl0 * 256 + hd * 64, 256, ma.kg + (size_t)bl * LT * 128 + kvh * 64, 128,
                            ma.vtg + (size_t)(bl * 2 + kvh) * 64 * LT, ymix + rg0 * D + 256 + hd * 64, D, nkeys, sc_g * L2E, sh_g, smem);
            }
          } else {
            const int c = it - n_scan - n_mla - n_gqa;
            hyena_pass(p, l, m, filt, LQ, LC, c, smem);
            if (!last) hyena_pass(p, l, m, (const float*)(ws + OFF_FILTC), LC, 0, c, smem);
          }
        }
        if (g == NG - 1) {
          int* acnt = (int*)(ws + OFF_CNT) + 16 + l;
          const int n_aux = l == 0 ? AUX_EARLY + AUX_LATE : AUX_LATE;
          for (;;) {
            if (threadIdx.x == 0) s_item = atomicAdd(acnt, 1);
            __syncthreads();
            const int a = s_item;
            __syncthreads();
            if (a >= n_aux) break;
            aux_tile(p, l, a, Wl, smem);
          }
        }
        xcd_barrier(xb);
        readout_hy_phase(g, m, ymix, last, smem);
        if (g == NG - 1) {
          for (int rg = 0; rg < NG; ++rg) {
            const MixBufs mr = mixbufs(big, rg);
            readout_rw_phase(p, l, rg, mr, ymix, last);
          }
          xcd_barrier(xb);
        }
      }
    }
    {
      EpiRes e{p.out, ctxs, p.out, ctxs, modl, 5, 1.0f, nullptr, nullptr, nullptr, 0};
      gemm_phase<false>(hbuf, D, W + W_OUT, D, D, T / 128, 8, 0, last, smem, e);
    }
    xcd_barrier(xb);
    adaln_phase(p.out, ctxs, p.norm_ffn2 + l * D, modl, 2, hbuf, last);
    xcd_barrier(xb);
    {
      EpiGU e{Gbuf};
      gemm_gu_phase(hbuf, W + W_GU2, T / 128, last, smem, e);
    }
    xcd_barrier(xb);
    {
      EpiRes e{p.out, ctxs, p.out, ctxs, modl, 8, 0.5f, nullptr, nullptr, nullptr, 0};
      gemm_phase<false>(Gbuf, DFF, W + W_D2, DFF, DFF, T / 128, 8, 0, last, smem, e);
    }
    xcd_barrier(xb);
  }
}

extern "C" void kernel_launch(void* const* d_in, const int* in_sizes, int n_in, void* d_out, int out_size, void* d_ws,
                              size_t ws_size, hipStream_t stream) {
  static int grid_blocks = 0;
  if (!grid_blocks) {
    int dev = 0, cus = 0, per_cu = 0;
    (void)hipGetDevice(&dev);
    (void)hipDeviceGetAttribute(&cus, hipDeviceAttributeMultiprocessorCount, dev);
    (void)hipOccupancyMaxActiveBlocksPerMultiprocessor(&per_cu, fwd_megakernel, NTHR, 0);
    if (per_cu > 2) per_cu = 2;
    if (per_cu < 1) per_cu = 1;
    grid_blocks = cus * per_cu;
  }
  Params p{};
  const float** pp = (const float**)&p;
  for (int i = 0; i < 47; ++i) pp[i] = (const float*)d_in[i];
  p.out = (float*)d_out;
  p.ws = (char*)d_ws;
  (void)hipMemsetAsync((char*)d_ws + OFF_CNT, 0, 256 + 3456 * 4, stream);
  void* args[] = {&p};
  hipError_t e = hipLaunchCooperativeKernel((void*)fwd_megakernel, dim3(grid_blocks), dim3(NTHR), args, 0, stream);
  if (e != hipSuccess) fprintf(stderr, "cooperative launch failed: %s (grid %d)\n", hipGetErrorString(e), grid_blocks);
}
```
